# Optimizing an MI355X kernel written in HIP

```python
import math
import jax
import jax.numpy as jnp
from jax import lax
import numpy as np

D_MODEL = 1024
BATCH = 4
SEQ = 4096
DEPTH = 4
DEC_BATCH = 128
DEC_SEQ = 4
PAST_LEN = 8192
PAGE_SIZE = 128

BRANCH_WIDTH = D_MODEL
N_BRANCH = 4
SSD_D_INNER = BRANCH_WIDTH
SSD_HEAD_DIM = 64
SSD_HEADS = SSD_D_INNER // SSD_HEAD_DIM
SSD_GROUPS = 4
SSD_STATE = 64
SSD_CONV = 4
SSD_CHUNK = 128
SSD_CONV_DIM = SSD_D_INNER + 2 * SSD_GROUPS * SSD_STATE
SC_WIDTH = BRANCH_WIDTH
SC_CONV = 3
ATTN_HEAD_DIM = 64
ATTN_HEADS = BRANCH_WIDTH // ATTN_HEAD_DIM
ATTN_KV_HEADS = 4
ATTN_GROUP = ATTN_HEADS // ATTN_KV_HEADS
WINDOW = 128
GM_WIDTH = BRANCH_WIDTH
GM_GROUPS = 8
GM_CHUNK = 128
D_FF = 2816
FFN_CONV = 3
EPS = 1e-6

IN_SIZES = (SSD_D_INNER, SSD_CONV_DIM, SSD_HEADS, 3 * SC_WIDTH, ATTN_HEADS * ATTN_HEAD_DIM,
            ATTN_KV_HEADS * ATTN_HEAD_DIM, ATTN_KV_HEADS * ATTN_HEAD_DIM, 2 * GM_WIDTH, N_BRANCH * D_MODEL)
IN_OFFSETS = tuple(sum(IN_SIZES[:i + 1]) for i in range(len(IN_SIZES) - 1))
D_IN = sum(IN_SIZES)

kernel_name = 'hybrid_gated_ssd_conv_swa_gmlp_decoder_step'


def rmsnorm(x, g):
    xf = x.astype(jnp.float32)
    xf = xf * lax.rsqrt(jnp.mean(xf * xf, axis=-1, keepdims=True) + EPS)
    return (xf * g.astype(jnp.float32)).astype(x.dtype)


def layernorm(x, g, b):
    xf = x.astype(jnp.float32)
    xc = xf - jnp.mean(xf, axis=-1, keepdims=True)
    xf = xc * lax.rsqrt(jnp.mean(xc * xc, axis=-1, keepdims=True) + EPS)
    return (xf * g.astype(jnp.float32) + b.astype(jnp.float32)).astype(x.dtype)


def causal_dwconv(x, w, prev, b=None):
    K = w.shape[0]
    L = x.shape[1]
    xp = jnp.concatenate([prev.astype(x.dtype), x], axis=1)
    y = xp[:, 0:L] * w[0]
    for j in range(1, K):
        y = y + xp[:, j:j + L] * w[j]
    if b is not None:
        y = y + b
    return y, xp[:, L:]


def ssd_scan(xdt, dtA, Bm, Cm, s0):
    f32 = jnp.float32
    b, l, h, p = xdt.shape
    g, n = Bm.shape[2], Bm.shape[3]
    r = h // g
    T = min(SSD_CHUNK, l)
    c = l // T
    X = xdt.astype(f32).reshape(b, c, T, g, r, p)
    Bc = Bm.astype(f32).reshape(b, c, T, g, n)
    Cc = Cm.astype(f32).reshape(b, c, T, g, n)
    A_cs = jnp.cumsum(dtA.astype(f32).reshape(b, c, T, g, r), axis=2)
    diff = A_cs[:, :, :, None] - A_cs[:, :, None, :]
    causal = jnp.tril(jnp.ones((T, T), dtype=bool))[None, None, :, :, None, None]
    Lmat = jnp.exp(jnp.where(causal, diff, -jnp.inf))
    CB = jnp.einsum('bctgn,bcsgn->bctsg', Cc, Bc)
    y_diag = jnp.einsum('bctsgr,bcsgrp->bctgrp', CB[..., None] * Lmat, X)
    decay_s = jnp.exp(A_cs[:, :, -1:] - A_cs)
    states = jnp.einsum('bcsgn,bcsgr,bcsgrp->bcgrpn', Bc, decay_s, X)
    chunk_decay = jnp.exp(A_cs[:, :, -1])

    def step(S, inp):
        st, dec = inp
        return S * dec[..., None, None] + st, S

    S0 = s0.astype(f32).reshape(b, g, r, p, n)
    S_fin, S_in = lax.scan(step, S0, (jnp.moveaxis(states, 1, 0), jnp.moveaxis(chunk_decay, 1, 0)))
    S_in = jnp.moveaxis(S_in, 0, 1)
    y_off = jnp.einsum('bctgn,bcgrpn,bctgr->bctgrp', Cc, S_in, jnp.exp(A_cs))
    y = (y_diag + y_off).reshape(b, l, h, p)
    return y, S_fin.reshape(b, h, p, n)


def ssd_mixer(z, xbc, dtr, conv_prev, ssm_prev, conv_w, conv_b, dt_bias, a_log, d_skip, norm_g):
    f32 = jnp.float32
    b, l = xbc.shape[:2]
    xbc, conv_new = causal_dwconv(xbc, conv_w, conv_prev, conv_b)
    xbc = jax.nn.silu(xbc)
    xs, Bm, Cm = jnp.split(xbc, [SSD_D_INNER, SSD_D_INNER + SSD_GROUPS * SSD_STATE], axis=-1)
    xh = xs.reshape(b, l, SSD_HEADS, SSD_HEAD_DIM).astype(f32)
    Bm = Bm.reshape(b, l, SSD_GROUPS, SSD_STATE)
    Cm = Cm.reshape(b, l, SSD_GROUPS, SSD_STATE)
    dt = jax.nn.softplus(dtr.astype(f32) + dt_bias.astype(f32))
    A = -jnp.exp(a_log.astype(f32))
    y, s_new = ssd_scan(xh * dt[..., None], dt * A, Bm, Cm, ssm_prev)
    y = y + xh * d_skip.astype(f32)[:, None]
    y = y.reshape(b, l, SSD_D_INNER) * jax.nn.silu(z.astype(f32))
    yg = y.reshape(b, l, SSD_GROUPS, SSD_D_INNER // SSD_GROUPS)
    yg = yg * lax.rsqrt(jnp.mean(yg * yg, axis=-1, keepdims=True) + EPS)
    y = yg.reshape(b, l, SSD_D_INNER) * norm_g.astype(f32)
    return y.astype(z.dtype), conv_new, s_new.astype(ssm_prev.dtype)


def shortconv_mixer(bcx, conv_prev, conv_w):
    Bg, Cg, xs = jnp.split(bcx, 3, axis=-1)
    y, conv_new = causal_dwconv(Cg * xs, conv_w, conv_prev)
    return Bg * y, conv_new


def alibi_slopes():
    return 2.0 ** (-8.0 * jnp.arange(1, ATTN_HEADS + 1, dtype=jnp.float32) / ATTN_HEADS)


def attn_core(q, k, v, dist, valid, sinks):
    f32 = jnp.float32
    slopes = alibi_slopes().reshape(ATTN_KV_HEADS, ATTN_GROUP)[:, :, None, None]
    s = jnp.einsum('bnqhgd,bnkhd->bnhgqk', q.astype(f32), k.astype(f32)) * (ATTN_HEAD_DIM ** -0.5)
    s = s - slopes * dist[:, None, None]
    s = jnp.where(valid[:, None, None], s, -jnp.inf)
    sink = sinks.astype(f32).reshape(ATTN_KV_HEADS, ATTN_GROUP)[:, :, None, None]
    m = jnp.maximum(jnp.max(s, axis=-1, keepdims=True), sink)
    pr = jnp.exp(s - m)
    pr = pr / (jnp.sum(pr, axis=-1, keepdims=True) + jnp.exp(sink - m))
    return jnp.einsum('bnhgqk,bnkhd->bnqhgd', pr, v.astype(f32))


def swa_prompt(q, k, v, sinks):
    b, l = q.shape[:2]
    nb = l // WINDOW
    qb = q.reshape(b, nb, WINDOW, ATTN_KV_HEADS, ATTN_GROUP, ATTN_HEAD_DIM)
    kb = k.reshape(b, nb, WINDOW, ATTN_KV_HEADS, ATTN_HEAD_DIM)
    vb = v.reshape(b, nb, WINDOW, ATTN_KV_HEADS, ATTN_HEAD_DIM)
    pad = ((0, 0), (1, 0), (0, 0), (0, 0), (0, 0))
    kk = jnp.concatenate([jnp.pad(kb, pad)[:, :-1], kb], axis=2)
    vv = jnp.concatenate([jnp.pad(vb, pad)[:, :-1], vb], axis=2)
    qpos = jnp.arange(WINDOW)
    kpos = jnp.arange(2 * WINDOW) - WINDOW
    dist = qpos[:, None] - kpos[None, :]
    band = (dist >= 0) & (dist <= WINDOW)
    blk = jnp.arange(nb)
    valid = band[None] & ((blk[:, None, None] > 0) | (kpos[None, None, :] >= 0))
    o = attn_core(qb, kk, vv, dist[None].astype(jnp.float32), valid, sinks)
    nbuf = min(WINDOW, l)
    return o.reshape(b, l, ATTN_HEADS * ATTN_HEAD_DIM).astype(q.dtype), k[:, l - nbuf:], v[:, l - nbuf:]


def swa_sample(q, k, v, k_buf, v_buf, sinks):
    b, l = q.shape[:2]
    nbuf = k_buf.shape[1]
    kk = jnp.concatenate([k_buf.astype(k.dtype), k], axis=1)
    vv = jnp.concatenate([v_buf.astype(v.dtype), v], axis=1)
    dist = (nbuf + jnp.arange(l))[:, None] - jnp.arange(nbuf + l)[None, :]
    valid = (dist >= 0) & (dist <= WINDOW)
    o = attn_core(q[:, None], kk[:, None], vv[:, None], dist[None].astype(jnp.float32), valid[None], sinks)
    return o.reshape(b, l, ATTN_HEADS * ATTN_HEAD_DIM).astype(q.dtype), kk[:, l:], vv[:, l:]


def gmlp_mixer(uv, ln_g, ln_b, w_s, b_s):
    uv = jax.nn.gelu(uv)
    u, v = jnp.split(uv, 2, axis=-1)
    v = layernorm(v, ln_g, ln_b)
    b, l = v.shape[:2]
    T = min(GM_CHUNK, l)
    c = l // T
    vg = v.reshape(b, c, T, GM_GROUPS, GM_WIDTH // GM_GROUPS)
    W = jnp.tril(w_s[:, :T, :T])
    mixed = jnp.einsum('gts,bcsgf->bctgf', W, vg) + b_s[:, :T].T[None, None, :, :, None]
    return u * mixed.reshape(b, l, GM_WIDTH).astype(u.dtype), v


def conv_ffn(h, conv_prev, w_up, conv_w, conv_b, w_down):
    up, conv_new = causal_dwconv(h @ w_up, conv_w, conv_prev, conv_b)
    a, g = jnp.split(up, 2, axis=-1)
    return (jax.nn.silu(a) * g) @ w_down, conv_new


def run_group(x, c, is_prompt, ssm_st, ssd_conv_st, sc_conv_st, k_st, v_st, ffn_conv_st,
              w_ada, b_ada, g_norm_mix, w_in, ssd_conv_w, ssd_conv_b, ssd_dt_bias, ssd_a_log, ssd_d,
              ssd_norm_g, sc_conv_w, attn_sinks, gm_ln_g, gm_ln_b, gm_w_s, gm_b_s, w_branch, w_o,
              g_norm_ffn, ffn_w_up, ffn_conv_w, ffn_conv_b, ffn_w_down, g_final):
    b, l = x.shape[:2]
    dtp = x.dtype
    new = [[] for _ in range(6 if is_prompt else 7)]
    for i in range(DEPTH):
        mod = (jax.nn.silu(c) @ w_ada[i] + b_ada[i])[:, None, :]
        sh1, sc1, ga1, sh2, sc2, ga2 = jnp.split(mod, 6, axis=-1)
        h = rmsnorm(x, g_norm_mix[i]) * (1 + sc1) + sh1
        z, xbc, dtr, bcx, q, k, v, uv, gates = jnp.split(h @ w_in[i], IN_OFFSETS, axis=-1)
        if is_prompt:
            ssm0 = jnp.zeros((b, SSD_HEADS, SSD_HEAD_DIM, SSD_STATE), dtp)
            ssdc0 = jnp.zeros((b, SSD_CONV - 1, SSD_CONV_DIM), dtp)
            scc0 = jnp.zeros((b, SC_CONV - 1, SC_WIDTH), dtp)
            ffc0 = jnp.zeros((b, FFN_CONV - 1, 2 * D_FF), dtp)
        else:
            ssm0, ssdc0, scc0, ffc0 = ssm_st[i], ssd_conv_st[i], sc_conv_st[i], ffn_conv_st[i]
        ya, ssdc1, ssm1 = ssd_mixer(z, xbc, dtr, ssdc0, ssm0, ssd_conv_w[i], ssd_conv_b[i],
                                    ssd_dt_bias[i], ssd_a_log[i], ssd_d[i], ssd_norm_g[i])
        yb, scc1 = shortconv_mixer(bcx, scc0, sc_conv_w[i])
        q = q.reshape(b, l, ATTN_KV_HEADS, ATTN_GROUP, ATTN_HEAD_DIM)
        k = k.reshape(b, l, ATTN_KV_HEADS, ATTN_HEAD_DIM)
        v = v.reshape(b, l, ATTN_KV_HEADS, ATTN_HEAD_DIM)
        if is_prompt:
            yc, k1, v1 = swa_prompt(q, k, v, attn_sinks[i])
        else:
            yc, k1, v1 = swa_sample(q, k, v, k_st[i], v_st[i], attn_sinks[i])
        yd, v_rows = gmlp_mixer(uv, gm_ln_g[i], gm_ln_b[i], gm_w_s[i], gm_b_s[i])
        branches = jnp.stack([ya, yb.astype(dtp), yc, yd], axis=2)
        proj = jnp.einsum('blif,ifd->blid', branches, w_branch[i])
        gate = jax.nn.sigmoid(gates.astype(jnp.float32)).reshape(b, l, N_BRANCH, D_MODEL)
        merged = jnp.sum(gate * proj, axis=2).astype(dtp)
        x = x + ga1 * (merged @ w_o[i])
        h2 = rmsnorm(x, g_norm_ffn[i]) * (1 + sc2) + sh2
        yf, ffc1 = conv_ffn(h2, ffc0, ffn_w_up[i], ffn_conv_w[i], ffn_conv_b[i], ffn_w_down[i])
        x = x + ga2 * yf
        vals = (ssm1, ssdc1, scc1, k1, v1, ffc1) if is_prompt else (ssm1, ssdc1, scc1, k1, v1, ffc1, v_rows)
        for lst, val in zip(new, vals):
            lst.append(val)
    return rmsnorm(x, g_final), tuple(jnp.stack(lst, axis=0) for lst in new)


def setup_inputs(seed: int = 0) -> dict:
    key = jax.random.key(seed)
    keys = iter(jax.random.split(key, 64))

    def nrm(shape, scale):
        return scale * jax.random.normal(next(keys), shape, jnp.float32)

    n_buf = min(WINDOW, PAST_LEN)
    dt0 = jnp.exp(jax.random.uniform(next(keys), (DEPTH, SSD_HEADS), jnp.float32,
                                     math.log(1e-3), math.log(1e-1)))
    a0 = jax.random.uniform(next(keys), (DEPTH, SSD_HEADS), jnp.float32, 1.0, 16.0)
    return {
        'x_prompt': nrm((BATCH, SEQ, D_MODEL), 1.0),
        'x_sample': nrm((DEC_BATCH, DEC_SEQ, D_MODEL), 1.0),
        'c_prompt': nrm((BATCH, D_MODEL), 1.0),
        'c_sample': nrm((DEC_BATCH, D_MODEL), 1.0),
        'state_ssm': nrm((DEPTH, DEC_BATCH, SSD_HEADS, SSD_HEAD_DIM, SSD_STATE), 0.1),
        'state_ssd_conv': nrm((DEPTH, DEC_BATCH, SSD_CONV - 1, SSD_CONV_DIM), 1.0),
        'state_sc_conv': nrm((DEPTH, DEC_BATCH, SC_CONV - 1, SC_WIDTH), 1.0),
        'cache_k': nrm((DEPTH, DEC_BATCH, n_buf, ATTN_KV_HEADS, ATTN_HEAD_DIM), 1.0),
        'cache_v': nrm((DEPTH, DEC_BATCH, n_buf, ATTN_KV_HEADS, ATTN_HEAD_DIM), 1.0),
        'state_ffn_conv': nrm((DEPTH, DEC_BATCH, FFN_CONV - 1, 2 * D_FF), 1.0),
        'w_ada': nrm((DEPTH, D_MODEL, 6 * D_MODEL), 0.5 * D_MODEL ** -0.5),
        'b_ada': nrm((DEPTH, 6 * D_MODEL), 0.02),
        'g_norm_mix': 1.0 + nrm((DEPTH, D_MODEL), 0.02),
        'w_in': nrm((DEPTH, D_MODEL, D_IN), D_MODEL ** -0.5),
        'ssd_conv_w': nrm((DEPTH, SSD_CONV, SSD_CONV_DIM), SSD_CONV ** -0.5),
        'ssd_conv_b': nrm((DEPTH, SSD_CONV_DIM), 0.02),
        'ssd_dt_bias': dt0 + jnp.log(-jnp.expm1(-dt0)),
        'ssd_a_log': jnp.log(a0),
        'ssd_d': 1.0 + nrm((DEPTH, SSD_HEADS), 0.1),
        'ssd_norm_g': 1.0 + nrm((DEPTH, SSD_D_INNER), 0.02),
        'sc_conv_w': nrm((DEPTH, SC_CONV, SC_WIDTH), SC_CONV ** -0.5),
        'attn_sinks': nrm((DEPTH, ATTN_HEADS), 0.5),
        'gm_ln_g': 1.0 + nrm((DEPTH, GM_WIDTH), 0.02),
        'gm_ln_b': nrm((DEPTH, GM_WIDTH), 0.02),
        'gm_w_s': nrm((DEPTH, GM_GROUPS, GM_CHUNK, GM_CHUNK), GM_CHUNK ** -0.5),
        'gm_b_s': 1.0 + nrm((DEPTH, GM_GROUPS, GM_CHUNK), 0.1),
        'w_branch': nrm((DEPTH, N_BRANCH, BRANCH_WIDTH, D_MODEL), BRANCH_WIDTH ** -0.5),
        'w_o': nrm((DEPTH, D_MODEL, D_MODEL), D_MODEL ** -0.5),
        'g_norm_ffn': 1.0 + nrm((DEPTH, D_MODEL), 0.02),
        'ffn_w_up': nrm((DEPTH, D_MODEL, 2 * D_FF), D_MODEL ** -0.5),
        'ffn_conv_w': nrm((DEPTH, FFN_CONV, 2 * D_FF), FFN_CONV ** -0.5),
        'ffn_conv_b': nrm((DEPTH, 2 * D_FF), 0.02),
        'ffn_w_down': nrm((DEPTH, D_FF, D_MODEL), D_FF ** -0.5),
        'g_final': 1.0 + nrm((D_MODEL,), 0.02),
    }


def reference(x_prompt, x_sample, c_prompt, c_sample, state_ssm, state_ssd_conv, state_sc_conv,
              cache_k, cache_v, state_ffn_conv, w_ada, b_ada, g_norm_mix, w_in, ssd_conv_w, ssd_conv_b,
              ssd_dt_bias, ssd_a_log, ssd_d, ssd_norm_g, sc_conv_w, attn_sinks, gm_ln_g, gm_ln_b,
              gm_w_s, gm_b_s, w_branch, w_o, g_norm_ffn, ffn_w_up, ffn_conv_w, ffn_conv_b, ffn_w_down,
              g_final):
    weights = (w_ada, b_ada, g_norm_mix, w_in, ssd_conv_w, ssd_conv_b, ssd_dt_bias, ssd_a_log, ssd_d,
               ssd_norm_g, sc_conv_w, attn_sinks, gm_ln_g, gm_ln_b, gm_w_s, gm_b_s, w_branch, w_o,
               g_norm_ffn, ffn_w_up, ffn_conv_w, ffn_conv_b, ffn_w_down, g_final)
    y_prompt, (p_ssm, p_ssd_conv, p_sc_conv, p_k, p_v, p_ffn_conv) = run_group(
        x_prompt, c_prompt, True, None, None, None, None, None, None, *weights)
    y_sample, (s_ssm, s_ssd_conv, s_sc_conv, s_k, s_v, s_ffn_conv, s_gm_v) = run_group(
        x_sample, c_sample, False, state_ssm, state_ssd_conv, state_sc_conv, cache_k, cache_v,
        state_ffn_conv, *weights)
    return (y_prompt, y_sample, p_ssm, p_ssd_conv, p_sc_conv, p_k, p_v, p_ffn_conv,
            s_ssm, s_ssd_conv, s_sc_conv, s_k, s_v, s_ffn_conv, s_gm_v)
```

```cpp
#include <hip/hip_runtime.h>
#include <hip/hip_cooperative_groups.h>
#include <cstdio>
namespace cg = cooperative_groups;

typedef unsigned short bf16_t;
typedef short bf16x8 __attribute__((ext_vector_type(8)));
typedef float f32x4 __attribute__((ext_vector_type(4)));
typedef unsigned u32x4 __attribute__((ext_vector_type(4)));
typedef unsigned u32x2 __attribute__((ext_vector_type(2)));
#define LAS __attribute__((address_space(3)))

constexpr int NTOK = 16896, NPR = 16384;
constexpr int LDP = 13568;
constexpr int C_Z = 0, C_XBC = 1024, C_DTR = 2560, C_BCX = 2576, C_Q = 5648, C_K = 6672, C_V = 6928, C_UV = 7184, C_GATE = 9232, C_END = 13328;
constexpr int NCOND = 132;
constexpr float EPSF = 1e-6f;

constexpr size_t WS_WIN = 0;
constexpr size_t WS_WBR = WS_WIN + (size_t)4 * 13568 * 1024 * 2;
constexpr size_t WS_WO = WS_WBR + (size_t)16 * 1024 * 1024 * 2;
constexpr size_t WS_WUP = WS_WO + (size_t)4 * 1024 * 1024 * 2;
constexpr size_t WS_WDN = WS_WUP + (size_t)4 * 5632 * 1024 * 2;
constexpr size_t WS_WADA = WS_WDN + (size_t)4 * 1024 * 2816 * 2;
constexpr size_t WS_CACT = WS_WADA + (size_t)4 * 6144 * 1024 * 2;
constexpr size_t WS_MOD = WS_CACT + (size_t)256 * 1024 * 2;
constexpr size_t WS_H = WS_MOD + (size_t)4 * NCOND * 6144 * 4;
constexpr size_t WS_MSUM = WS_H + (size_t)NTOK * 1024 * 2;
constexpr size_t WS_PROJ = WS_MSUM + (size_t)NTOK * 1024 * 4;
constexpr size_t WS_END = WS_PROJ + (size_t)NTOK * LDP * 2;
constexpr size_t WS_BAR = WS_END;
constexpr size_t WS_SSDST = WS_WADA;
constexpr size_t WS_SSDDEC = WS_WADA + (size_t)4 * 32 * 16 * 4096 * 4;
constexpr size_t UP_BYTES = (size_t)NTOK * 5632 * 2;

constexpr size_t O_YP = 0, O_YS = 16777216, O_PSSM = O_YS + 524288, O_PSSDC = O_PSSM + 1048576, O_PSCC = O_PSSDC + 73728,
                 O_PK = O_PSCC + 32768, O_PV = O_PK + 524288, O_PFFC = O_PV + 524288, O_SSSM = O_PFFC + 180224,
                 O_SSSDC = O_SSSM + 33554432, O_SSCC = O_SSSDC + 2359296, O_SK = O_SSCC + 1048576, O_SV = O_SK + 16777216,
                 O_SFFC = O_SV + 16777216, O_SGMV = O_SFFC + 5767168, O_END = O_SGMV + 2097152;

struct Params { const float* in[34]; float* out; unsigned char* ws; int ph_lo, ph_hi; };

constexpr int LDS_BYTES = 155648;

__device__ __forceinline__ float bf2f(bf16_t v) { return __uint_as_float((unsigned)v << 16); }
__device__ __forceinline__ float bflo(unsigned v) { return __uint_as_float(v << 16); }
__device__ __forceinline__ float bfhi(unsigned v) { return __uint_as_float(v & 0xffff0000u); }
__device__ __forceinline__ unsigned pk2(float lo, float hi) { unsigned r; asm("v_cvt_pk_bf16_f32 %0, %1, %2" : "=v"(r) : "v"(lo), "v"(hi)); return r; }
__device__ __forceinline__ bf16_t f2bf(float f) { return (bf16_t)(pk2(f, 0.f) & 0xffffu); }
__device__ __forceinline__ float wave_sum(float v) {
#pragma unroll
    for (int o = 32; o > 0; o >>= 1) v += __shfl_xor(v, o);
    return v;
}
__device__ __forceinline__ int otid() { int t = threadIdx.x; asm volatile("" : "+v"(t)); return t; }
__device__ __forceinline__ float sigmoidf_(float x) { return 1.f / (1.f + __expf(-x)); }
__device__ __forceinline__ float siluf_(float x) { return x / (1.f + __expf(-x)); }
__device__ __forceinline__ float geluf_(float x) { const float u = 0.7978845608f * (x + 0.044715f * x * x * x); return x / (1.f + __expf(-2.f * u)); }
__device__ __forceinline__ float softplusf_(float x) { return fmaxf(x, 0.f) + log1pf(__expf(-fabsf(x))); }
__device__ __forceinline__ float silu_fast(float x) { return x * __builtin_amdgcn_rcpf(1.f + __expf(-x)); }
__device__ __forceinline__ float sigmoid_fast(float x) { return __builtin_amdgcn_rcpf(1.f + __expf(-x)); }
__device__ __forceinline__ float gelu_fast(float x) { const float u = 0.7978845608f * (x + 0.044715f * x * x * x); return x * __builtin_amdgcn_rcpf(1.f + __expf(-2.f * u)); }
__device__ __forceinline__ int cond_row(int r) { return r < NPR ? (r >> 12) : 4 + ((r - NPR) >> 2); }
__device__ __forceinline__ int seq_start(int r) { return r < NPR ? (r & ~4095) : NPR + ((r - NPR) & ~3); }

constexpr int BM = 256, BK = 64, HALF = 128, HTB = HALF * BK * 2;
__device__ __forceinline__ int lds_byte(int r, int c) { const int st = (r >> 4) * 2 + (c >> 5), rr = r & 15, cc = c & 31, ob = rr * 64 + cc * 2; return st * 1024 + (ob ^ (((ob >> 9) & 1) << 5)); }
__device__ __forceinline__ void stage_rc(int b, int& R, int& C) { const int st = b / 1024, sb = b % 1024, swz = sb ^ (((sb >> 9) & 1) << 5); R = (st >> 1) * 16 + swz / 64; C = (st & 1) * 32 + (swz % 64) / 2; }
__device__ __forceinline__ int perm32(int rho) { const int n = rho >> 4, i = rho & 15; return 8 * (i >> 2) + 4 * n + (i & 3); }

struct Unit { int pm, pn, z; };
struct Gemm { const bf16_t* A; const bf16_t* Bt; int lda, ldb, K, nM, nN; int ao0, ao1, ao2, ao3; size_t zB; };
__device__ __forceinline__ int gemm_aofs(const Gemm& g, int z) { return z == 0 ? g.ao0 : (z == 1 ? g.ao1 : (z == 2 ? g.ao2 : g.ao3)); }

template <int ZN> __device__ __forceinline__ bool unit_next(const Gemm& g, int i, Unit& u) {
    const int tile = i / ZN; u.z = i - tile * ZN;
    const long L = (long)tile * gridDim.x + blockIdx.x; const int nwg = g.nM * g.nN; if (L >= nwg) return false;
    int wgid = (int)L; { const int q = nwg / 8, r = nwg % 8, xcd = wgid % 8, off = wgid / 8; wgid = (xcd < r ? xcd * (q + 1) : r * (q + 1) + (xcd - r) * q) + off; }
    const int nig = 8 * g.nN, gid = wgid / nig, fm = gid * 8, gsz = (g.nM - fm) < 8 ? (g.nM - fm) : 8;
    u.pm = fm + ((wgid % nig) % gsz); u.pn = (wgid % nig) / gsz; return true;
}

template <class Epi, int ZN>
__device__ __forceinline__ void gemm_phase(LAS unsigned char* lds, const Gemm g, const Epi& E) {
    const int tid = otid(), wid = __builtin_amdgcn_readfirstlane(tid >> 6), lane = tid & 63, wr = wid >> 2, wc = wid & 3, fr = lane & 15, fq = lane >> 4;
    const int K = g.K, nt = K / BK;
    unsigned voffA[2], voffB[2];
#pragma unroll
    for (int i = 0; i < 2; ++i) { int R, C; stage_rc(tid * 16 + i * 8192, R, C); const int Rb = Epi::PERM ? ((R & ~31) + perm32(R & 31)) : R;
        voffA[i] = (unsigned)(R * g.lda + C) * 2u; voffB[i] = (unsigned)(Rb * g.ldb + C) * 2u; }
    const size_t kstep = (size_t)(BK * 2);
    const size_t hstepA = (size_t)HALF * g.lda * 2, hstepB = (size_t)HALF * g.ldb * 2;
    const size_t tstepA = 2 * hstepA, tstepB = 2 * hstepB;
    const unsigned ldsw = (unsigned)wid * 1024u;
    const int aoff = lds_byte(wr * 64 + fr, fq * 8), boff = lds_byte(wc * 32 + fr, fq * 8);
#define PG8_SA(b, h) (((b) * 2 + (h)) * HTB)
#define PG8_SB(b, h) ((4 + (b) * 2 + (h)) * HTB)
#define PG8_STAGE(bufoff, gbase, voff) do { _Pragma("unroll") for (int _i = 0; _i < 2; ++_i) \
        __builtin_amdgcn_global_load_lds((const unsigned*)((const char*)(gbase) + (voff)[_i]), (LAS unsigned*)(lds + (bufoff) + ldsw + _i * 8192), 16, 0, 0); } while (0)
#define PG8_LDA(dst, b, h) do { _Pragma("unroll") for (int m = 0; m < 4; ++m) _Pragma("unroll") for (int k = 0; k < 2; ++k) dst[m][k] = *(const LAS bf16x8*)(lds + PG8_SA(b, h) + aoff + m * 2048 + k * 1024); } while (0)
#define PG8_LDB(dst, b, h) do { _Pragma("unroll") for (int n = 0; n < 2; ++n) _Pragma("unroll") for (int k = 0; k < 2; ++k) dst[n][k] = *(const LAS bf16x8*)(lds + PG8_SB(b, h) + boff + n * 2048 + k * 1024); } while (0)
#define PG8_MMA(ai, bj, At, Bt) do { __builtin_amdgcn_s_setprio(1); _Pragma("unroll") for (int m = 0; m < 4; ++m) _Pragma("unroll") for (int n = 0; n < 2; ++n) _Pragma("unroll") for (int k = 0; k < 2; ++k) \
        acc[ai][bj][m][n] = __builtin_amdgcn_mfma_f32_16x16x32_bf16(Bt[n][k], At[m][k], acc[ai][bj][m][n], 0, 0, 0); __builtin_amdgcn_s_setprio(0); } while (0)
#define PG8_WAIT_V(n) asm volatile("s_waitcnt vmcnt(" #n ")" ::: "memory")
#define PG8_WAIT_L(n) asm volatile("s_waitcnt lgkmcnt(" #n ")" ::: "memory")
#define PG8_BAR __builtin_amdgcn_s_barrier()
#define PG8_SCHED __builtin_amdgcn_sched_barrier(0)
    Unit cur, nxt; int ui = 0;
    if (!unit_next<ZN>(g, 0, cur)) return;
    f32x4 acc[2][2][4][2];
#pragma unroll
    for (int a = 0; a < 2; ++a)
#pragma unroll
        for (int b = 0; b < 2; ++b)
#pragma unroll
            for (int m = 0; m < 4; ++m)
#pragma unroll
                for (int n = 0; n < 2; ++n) acc[a][b][m][n] = (f32x4){0.f, 0.f, 0.f, 0.f};
    bf16x8 At[4][2], B0[2][2], B1[2][2];
    const char* cA = (const char*)g.A + (size_t)cur.pm * tstepA + (size_t)gemm_aofs(g, cur.z) * 2;
    const char* cB = (const char*)g.Bt + (size_t)cur.pn * tstepB + (size_t)cur.z * g.zB * 2;
    PG8_WAIT_V(0);
    PG8_STAGE(PG8_SB(0, 0), cB, voffB); PG8_STAGE(PG8_SA(0, 0), cA, voffA); PG8_STAGE(PG8_SB(0, 1), cB + hstepB, voffB); PG8_STAGE(PG8_SA(0, 1), cA + hstepA, voffA);
    if (wr == 1) PG8_BAR;
    PG8_WAIT_V(4); PG8_BAR;
    PG8_STAGE(PG8_SB(1, 0), cB + kstep, voffB); PG8_STAGE(PG8_SA(1, 0), cA + kstep, voffA); PG8_STAGE(PG8_SB(1, 1), cB + hstepB + kstep, voffB);
    PG8_WAIT_V(6); PG8_BAR;
    for (;;) {
        const bool has_next = unit_next<ZN>(g, ui + 1, nxt);
        const char* nA = has_next ? (const char*)g.A + (size_t)nxt.pm * tstepA + (size_t)gemm_aofs(g, nxt.z) * 2 : cA;
        const char* nB = has_next ? (const char*)g.Bt + (size_t)nxt.pn * tstepB + (size_t)nxt.z * g.zB * 2 : cB;
        for (int t = 0; t < nt; t += 2) {
            const bool last = (t == nt - 2);
            const char* a1 = cA + (size_t)(t + 1) * kstep;
            const char* a2 = last ? nA : cA + (size_t)(t + 2) * kstep; const char* b2 = last ? nB : cB + (size_t)(t + 2) * kstep;
            const char* a3 = a2 + kstep; const char* b3 = b2 + kstep;
            PG8_LDB(B0, 0, 0); PG8_SCHED; PG8_LDA(At, 0, 0); PG8_STAGE(PG8_SA(1, 1), a1 + hstepA, voffA);
            PG8_WAIT_L(8); PG8_BAR; PG8_WAIT_L(0); PG8_MMA(0, 0, At, B0); PG8_BAR; PG8_SCHED;
            PG8_LDB(B1, 0, 1); PG8_STAGE(PG8_SB(0, 0), b2, voffB);
            PG8_BAR; PG8_WAIT_L(0); PG8_MMA(0, 1, At, B1); PG8_BAR;
            PG8_LDA(At, 0, 1); PG8_STAGE(PG8_SA(0, 0), a2, voffA);
            PG8_BAR; PG8_WAIT_L(0); PG8_MMA(1, 0, At, B0); PG8_BAR; PG8_SCHED;
            PG8_STAGE(PG8_SB(0, 1), b2 + hstepB, voffB);
            PG8_WAIT_V(6); PG8_BAR; PG8_MMA(1, 1, At, B1); PG8_BAR;
            PG8_LDB(B0, 1, 0); PG8_SCHED; PG8_LDA(At, 1, 0); PG8_STAGE(PG8_SA(0, 1), a2 + hstepA, voffA);
            PG8_WAIT_L(8); PG8_BAR; PG8_WAIT_L(0); PG8_MMA(0, 0, At, B0); PG8_BAR; PG8_SCHED;
            PG8_LDB(B1, 1, 1); PG8_STAGE(PG8_SB(1, 0), b3, voffB);
            PG8_BAR; PG8_WAIT_L(0); PG8_MMA(0, 1, At, B1); PG8_BAR;
            PG8_LDA(At, 1, 1); PG8_STAGE(PG8_SA(1, 0), a3, voffA);
            PG8_BAR; PG8_WAIT_L(0); PG8_MMA(1, 0, At, B0); PG8_BAR; PG8_SCHED;
            PG8_STAGE(PG8_SB(1, 1), b3 + hstepB, voffB);
            PG8_WAIT_V(6); PG8_BAR; PG8_MMA(1, 1, At, B1); PG8_BAR;
        }
        E(acc, cur, wr, wc, fr, fq);
        if (!has_next) break;
#pragma unroll
        for (int a = 0; a < 2; ++a)
#pragma unroll
            for (int b = 0; b < 2; ++b)
#pragma unroll
                for (int m = 0; m < 4; ++m)
#pragma unroll
                    for (int n = 0; n < 2; ++n) acc[a][b][m][n] = (f32x4){0.f, 0.f, 0.f, 0.f};
        cur = nxt; cA = nA; cB = nB; ++ui;
    }
    PG8_WAIT_V(0);
    if (wr == 0) PG8_BAR;
    PG8_BAR;
#undef PG8_SA
#undef PG8_SB
#undef PG8_STAGE
#undef PG8_LDA
#undef PG8_LDB
#undef PG8_MMA
#undef PG8_WAIT_V
#undef PG8_WAIT_L
#undef PG8_BAR
#undef PG8_SCHED
}

struct EpiMod {
    static constexpr bool PERM = false;
    float* mod; const float* bada;
    __device__ __forceinline__ void operator()(const f32x4 (&acc)[2][2][4][2], const Unit& u, int wr, int wc, int fr, int fq) const {
#pragma unroll
        for (int ai = 0; ai < 2; ++ai)
#pragma unroll
            for (int m = 0; m < 4; ++m) { const int r = u.pm * BM + ai * HALF + wr * 64 + m * 16 + fr; if (r >= NCOND) continue;
#pragma unroll
                for (int bj = 0; bj < 2; ++bj)
#pragma unroll
                    for (int n = 0; n < 2; ++n) { const int c = u.pn * BM + bj * HALF + wc * 32 + n * 16 + fq * 4; const int layer = c / 6144, cc = c - layer * 6144;
                        const f32x4 b = *(const f32x4*)(bada + c); *(f32x4*)(mod + ((size_t)(layer * NCOND + r)) * 6144 + cc) = acc[ai][bj][m][n] + b; } }
    }
};
struct EpiProj {
    static constexpr bool PERM = true;
    bf16_t* O;
    __device__ __forceinline__ void operator()(const f32x4 (&acc)[2][2][4][2], const Unit& u, int wr, int wc, int fr, int fq) const {
#pragma unroll
        for (int bj = 0; bj < 2; ++bj) { const int c = u.pn * BM + bj * HALF + wc * 32 + fq * 8; const int mode = (c >= C_GATE) ? 2 : (c >= C_UV ? 1 : 0);
#pragma unroll
            for (int ai = 0; ai < 2; ++ai)
#pragma unroll
                for (int m = 0; m < 4; ++m) { const int r = u.pm * BM + ai * HALF + wr * 64 + m * 16 + fr;
                    float v[8];
#pragma unroll
                    for (int i = 0; i < 8; ++i) { float x = acc[ai][bj][m][i >> 2][i & 3]; v[i] = mode == 2 ? sigmoid_fast(x) : (mode == 1 ? gelu_fast(x) : x); }
                    u32x4 o; o[0] = pk2(v[0], v[1]); o[1] = pk2(v[2], v[3]); o[2] = pk2(v[4], v[5]); o[3] = pk2(v[6], v[7]);
                    *(u32x4*)(O + (size_t)r * LDP + c) = o; } }
    }
};
struct EpiUp {
    static constexpr bool PERM = true;
    bf16_t* O;
    __device__ __forceinline__ void operator()(const f32x4 (&acc)[2][2][4][2], const Unit& u, int wr, int wc, int fr, int fq) const {
#pragma unroll
        for (int bj = 0; bj < 2; ++bj) { const int c = u.pn * BM + bj * HALF + wc * 32 + fq * 8;
#pragma unroll
            for (int ai = 0; ai < 2; ++ai)
#pragma unroll
                for (int m = 0; m < 4; ++m) { const int r = u.pm * BM + ai * HALF + wr * 64 + m * 16 + fr;
                    const f32x4 a = acc[ai][bj][m][0], b = acc[ai][bj][m][1];
                    u32x4 o; o[0] = pk2(a[0], a[1]); o[1] = pk2(a[2], a[3]); o[2] = pk2(b[0], b[1]); o[3] = pk2(b[2], b[3]);
                    *(u32x4*)(O + (size_t)r * 5632 + c) = o; } }
    }
};
struct EpiBranch {
    static constexpr bool PERM = true;
    const bf16_t* proj; float* msum; bf16_t* merged;
    __device__ __forceinline__ void operator()(const f32x4 (&acc)[2][2][4][2], const Unit& u, int wr, int wc, int fr, int fq) const {
        const int z = u.z;
#pragma unroll
        for (int bj = 0; bj < 2; ++bj) { const int c = u.pn * BM + bj * HALF + wc * 32 + fq * 8;
#pragma unroll
            for (int ai = 0; ai < 2; ++ai)
#pragma unroll
                for (int m = 0; m < 4; ++m) { const int r = u.pm * BM + ai * HALF + wr * 64 + m * 16 + fr;
                    const u32x4 gv = *(const u32x4*)(proj + (size_t)r * LDP + C_GATE + z * 1024 + c);
                    float* mp = msum + (size_t)r * 1024 + c;
                    f32x4 s0 = (f32x4){0.f, 0.f, 0.f, 0.f}, s1 = s0;
                    if (z > 0) { s0 = *(const f32x4*)mp; s1 = *(const f32x4*)(mp + 4); }
                    const f32x4 a = acc[ai][bj][m][0], b = acc[ai][bj][m][1];
                    s0[0] += bflo(gv[0]) * a[0]; s0[1] += bfhi(gv[0]) * a[1]; s0[2] += bflo(gv[1]) * a[2]; s0[3] += bfhi(gv[1]) * a[3];
                    s1[0] += bflo(gv[2]) * b[0]; s1[1] += bfhi(gv[2]) * b[1]; s1[2] += bflo(gv[3]) * b[2]; s1[3] += bfhi(gv[3]) * b[3];
                    if (z < 3) { *(f32x4*)mp = s0; *(f32x4*)(mp + 4) = s1; }
                    else { u32x4 o; o[0] = pk2(s0[0], s0[1]); o[1] = pk2(s0[2], s0[3]); o[2] = pk2(s1[0], s1[1]); o[3] = pk2(s1[2], s1[3]);
                        *(u32x4*)(merged + (size_t)r * 1024 + c) = o; } } }
    }
};
struct EpiResid {
    static constexpr bool PERM = false;
    const float* xin_p; const float* xin_s; float* xout; const float* ga;
    __device__ __forceinline__ void operator()(const f32x4 (&acc)[2][2][4][2], const Unit& u, int wr, int wc, int fr, int fq) const {
#pragma unroll
        for (int ai = 0; ai < 2; ++ai)
#pragma unroll
            for (int m = 0; m < 4; ++m) { const int r = u.pm * BM + ai * HALF + wr * 64 + m * 16 + fr;
                const float* xr = r < NPR ? xin_p + (size_t)r * 1024 : xin_s + (size_t)(r - NPR) * 1024;
                const float* gr = ga + (size_t)cond_row(r) * 6144;
#pragma unroll
                for (int bj = 0; bj < 2; ++bj)
#pragma unroll
                    for (int n = 0; n < 2; ++n) { const int c = u.pn * BM + bj * HALF + wc * 32 + n * 16 + fq * 4;
                        const f32x4 xv = *(const f32x4*)(xr + c), gv = *(const f32x4*)(gr + c);
                        *(f32x4*)(xout + (size_t)r * 1024 + c) = xv + gv * acc[ai][bj][m][n]; } }
    }
};

struct CTile { const float* src; bf16_t* dst; int K, N, k0, n0; };
__device__ __forceinline__ CTile conv_decode(const Params& P, int t) {
    constexpr int T_IN = 3392, T_BR = 1024, T_O = 256, T_UP = 1408, T_DN = 704, T_ADA = 1536, T_L = T_IN + T_BR + T_O + T_UP + T_DN + T_ADA;
    const int layer = t / T_L; int r = t - layer * T_L; CTile c;
    if (r < T_IN) { c.src = P.in[13] + (size_t)layer * 1024 * 13328; c.dst = (bf16_t*)(P.ws + WS_WIN) + (size_t)layer * 13568 * 1024; c.K = 1024; c.N = 13328; c.k0 = (r / 212) * 64; c.n0 = (r % 212) * 64; return c; }
    r -= T_IN;
    if (r < T_BR) { const int br = r >> 8, q = r & 255; c.src = P.in[26] + (size_t)(layer * 4 + br) * 1048576; c.dst = (bf16_t*)(P.ws + WS_WBR) + (size_t)(layer * 4 + br) * 1048576; c.K = 1024; c.N = 1024; c.k0 = (q >> 4) * 64; c.n0 = (q & 15) * 64; return c; }
    r -= T_BR;
    if (r < T_O) { c.src = P.in[27] + (size_t)layer * 1048576; c.dst = (bf16_t*)(P.ws + WS_WO) + (size_t)layer * 1048576; c.K = 1024; c.N = 1024; c.k0 = (r >> 4) * 64; c.n0 = (r & 15) * 64; return c; }
    r -= T_O;
    if (r < T_UP) { c.src = P.in[29] + (size_t)layer * 1024 * 5632; c.dst = (bf16_t*)(P.ws + WS_WUP) + (size_t)layer * 5632 * 1024; c.K = 1024; c.N = 5632; c.k0 = (r / 88) * 64; c.n0 = (r % 88) * 64; return c; }
    r -= T_UP;
    if (r < T_DN) { c.src = P.in[32] + (size_t)layer * 2816 * 1024; c.dst = (bf16_t*)(P.ws + WS_WDN) + (size_t)layer * 1024 * 2816; c.K = 2816; c.N = 1024; c.k0 = (r >> 4) * 64; c.n0 = (r & 15) * 64; return c; }
    r -= T_DN;
    c.src = P.in[10] + (size_t)layer * 1024 * 6144; c.dst = (bf16_t*)(P.ws + WS_WADA) + (size_t)layer * 6144 * 1024; c.K = 1024; c.N = 6144; c.k0 = (r / 96) * 64; c.n0 = (r % 96) * 64; return c;
}
__device__ void phase_convert(const Params& P, float* T) {
    constexpr int NT = 4 * 8320;
    const int tid = otid();
    int t = blockIdx.x;
    CTile cur = conv_decode(P, t < NT ? t : 0);
    float v[8], nv[8];
#pragma unroll
    for (int e = 0; e < 8; ++e) { const int idx = tid + e * 512, k = idx >> 6, n = idx & 63; v[e] = (t < NT && cur.n0 + n < cur.N) ? cur.src[(size_t)(cur.k0 + k) * cur.N + cur.n0 + n] : 0.f; }
    for (; t < NT; t += gridDim.x) {
        const int tn = t + gridDim.x; const bool hn = tn < NT; const CTile nxt = conv_decode(P, hn ? tn : 0);
#pragma unroll
        for (int e = 0; e < 8; ++e) { const int idx = tid + e * 512, k = idx >> 6, n = idx & 63; nv[e] = (hn && nxt.n0 + n < nxt.N) ? nxt.src[(size_t)(nxt.k0 + k) * nxt.N + nxt.n0 + n] : 0.f; }
#pragma unroll
        for (int e = 0; e < 8; ++e) { const int idx = tid + e * 512, k = idx >> 6, n = idx & 63; T[k * 65 + n] = v[e]; }
        __syncthreads();
        { const int n = tid >> 3, kc = (tid & 7) * 8; float x[8];
#pragma unroll
          for (int j = 0; j < 8; ++j) x[j] = T[(kc + j) * 65 + n];
          u32x4 o; o[0] = pk2(x[0], x[1]); o[1] = pk2(x[2], x[3]); o[2] = pk2(x[4], x[5]); o[3] = pk2(x[6], x[7]);
          *(u32x4*)(cur.dst + (size_t)(cur.n0 + n) * cur.K + cur.k0 + kc) = o; }
        __syncthreads();
#pragma unroll
        for (int e = 0; e < 8; ++e) v[e] = nv[e];
        cur = nxt;
    }
    bf16_t* cact = (bf16_t*)(P.ws + WS_CACT);
    for (int i = blockIdx.x * 512 + otid(); i < 256 * 1024; i += gridDim.x * 512) {
        const int r = i >> 10, c = i & 1023; float v = 0.f;
        if (r < 4) v = siluf_(P.in[2][r * 1024 + c]); else if (r < NCOND) v = siluf_(P.in[3][(r - 4) * 1024 + c]);
        cact[i] = f2bf(v);
    }
}

__device__ void phase_norm(const float* xp, const float* xs, const float* g, const float* modL, int shofs, int scofs, bf16_t* hout) {
    const int tid = otid(); const int w = tid >> 6, lane = tid & 63;
    for (int r = blockIdx.x * 8 + w; r < NTOK; r += gridDim.x * 8) {
        const float* x = r < NPR ? xp + (size_t)r * 1024 : xs + (size_t)(r - NPR) * 1024;
        const float* mr = modL + (size_t)cond_row(r) * 6144;
        f32x4 v[4]; float ss = 0.f;
#pragma unroll
        for (int i = 0; i < 4; ++i) { v[i] = *(const f32x4*)(x + i * 256 + lane * 4); ss += v[i][0] * v[i][0] + v[i][1] * v[i][1] + v[i][2] * v[i][2] + v[i][3] * v[i][3]; }
        ss = wave_sum(ss); const float rs = rsqrtf(ss * (1.f / 1024.f) + EPSF);
#pragma unroll
        for (int i = 0; i < 4; ++i) { const int c = i * 256 + lane * 4;
            const f32x4 gv = *(const f32x4*)(g + c), sc = *(const f32x4*)(mr + scofs + c), sh = *(const f32x4*)(mr + shofs + c);
            f32x4 o = v[i] * rs * gv * (sc + 1.f) + sh;
            u32x2 pk; pk[0] = pk2(o[0], o[1]); pk[1] = pk2(o[2], o[3]);
            *(u32x2*)(hout + (size_t)r * 1024 + c) = pk; }
    }
}
__device__ void phase_final_norm(float* x, const float* g) {
    const int tid = otid(); const int w = tid >> 6, lane = tid & 63;
    for (int r = blockIdx.x * 8 + w; r < NTOK; r += gridDim.x * 8) {
        float* xr = x + (size_t)r * 1024; f32x4 v[4]; float ss = 0.f;
#pragma unroll
        for (int i = 0; i < 4; ++i) { v[i] = *(const f32x4*)(xr + i * 256 + lane * 4); ss += v[i][0] * v[i][0] + v[i][1] * v[i][1] + v[i][2] * v[i][2] + v[i][3] * v[i][3]; }
        ss = wave_sum(ss); const float rs = rsqrtf(ss * (1.f / 1024.f) + EPSF);
#pragma unroll
        for (int i = 0; i < 4; ++i) { const int c = i * 256 + lane * 4; const f32x4 gv = *(const f32x4*)(g + c); *(f32x4*)(xr + c) = v[i] * rs * gv; }
    }
}

template <int MODE>
__device__ void ssd_item(const Params& P, int layer, int item, float* L) {
    const int tid = otid(), w = tid >> 6, lane = tid & 63;
    bf16_t* proj = (bf16_t*)(P.ws + WS_PROJ);
    float* states = (float*)(P.ws + WS_SSDST); float* decs = (float*)(P.ws + WS_SSDDEC);
    int r0, nsteps, half, seq0, b = 0, c = 0, sb = 0;
    if (MODE == 2) { sb = item >> 1; half = item & 1; r0 = NPR + sb * 4; nsteps = 4; seq0 = r0; }
    else { b = item >> 6; c = (item >> 1) & 31; half = item & 1; r0 = b * 4096 + c * 128; nsteps = 128; seq0 = b * 4096; }
    float* XS = L; float* ZS = XS + 16 * 512; float* BS = ZS + 16 * 512; float* CS = BS + 16 * 128; float* DTS = CS + 16 * 128; float* DAS = DTS + 128; float* SSQ = DAS + 128;
    const float* cw = P.in[14] + (size_t)layer * 4 * 1536; const float* cb = P.in[15] + (size_t)layer * 1536;
    const float* prev = P.in[5] + ((size_t)(layer * 128 + sb)) * 3 * 1536;
    const int hd = half * 8 + w, gl = w >> 2;
    float h[64];
    if (MODE == 0) {
#pragma unroll
        for (int n = 0; n < 64; ++n) h[n] = 0.f;
    } else {
        const float* s0p = (MODE == 1) ? states + ((size_t)((b * 32 + c) * 16 + hd)) * 4096 + lane * 64
                                       : P.in[4] + ((size_t)((layer * 128 + sb) * 16 + hd)) * 4096 + lane * 64;
#pragma unroll
        for (int n4 = 0; n4 < 16; ++n4) { const f32x4 v = *(const f32x4*)(s0p + n4 * 4); h[n4 * 4] = v[0]; h[n4 * 4 + 1] = v[1]; h[n4 * 4 + 2] = v[2]; h[n4 * 4 + 3] = v[3]; }
    }
    const float Dh = P.in[18][layer * 16 + hd];
    float decp = 1.f;
    for (int s0 = 0; s0 < nsteps; s0 += 16) {
        const int ns = (nsteps - s0) < 16 ? (nsteps - s0) : 16;
        __syncthreads();
        for (int idx = tid; idx < ns * 768; idx += 512) {
            const int t = idx / 768, ch = idx - t * 768;
            int cx;
            if (ch < 512) cx = half * 512 + ch; else if (ch < 640) cx = 1024 + half * 128 + (ch - 512); else cx = 1280 + half * 128 + (ch - 640);
            float a = cb[cx];
#pragma unroll
            for (int k = 0; k < 4; ++k) { const int step = s0 + t - 3 + k, rr = r0 + step; float raw;
                if (rr >= seq0) raw = bf2f(proj[(size_t)rr * LDP + C_XBC + cx]);
                else raw = (MODE == 2) ? prev[(3 + step) * 1536 + cx] : 0.f;
                a += cw[k * 1536 + cx] * raw; }
            a = siluf_(a);
            if (ch < 512) { XS[t * 512 + ch] = a; if (MODE != 0) ZS[t * 512 + ch] = bf2f(proj[(size_t)(r0 + s0 + t) * LDP + C_Z + cx]); }
            else if (ch < 640) BS[t * 128 + ch - 512] = a; else CS[t * 128 + ch - 640] = a;
        }
        if (tid < ns * 8) { const int t = tid >> 3, ww = tid & 7, hh = half * 8 + ww;
            const float dt = softplusf_(bf2f(proj[(size_t)(r0 + s0 + t) * LDP + C_DTR + hh]) + P.in[16][layer * 16 + hh]);
            DTS[t * 8 + ww] = dt; DAS[t * 8 + ww] = __expf(-dt * __expf(P.in[17][layer * 16 + hh])); }
        __syncthreads();
        for (int t = 0; t < ns; ++t) {
            const float a = DAS[t * 8 + w], dt = DTS[t * 8 + w], xv = XS[t * 512 + w * 64 + lane], xd = xv * dt; decp *= a;
            const f32x4* B4 = (const f32x4*)(BS + t * 128 + gl * 64);
#pragma unroll
            for (int n4 = 0; n4 < 16; ++n4) { const f32x4 bv = B4[n4];
                h[n4 * 4] = a * h[n4 * 4] + xd * bv[0]; h[n4 * 4 + 1] = a * h[n4 * 4 + 1] + xd * bv[1]; h[n4 * 4 + 2] = a * h[n4 * 4 + 2] + xd * bv[2]; h[n4 * 4 + 3] = a * h[n4 * 4 + 3] + xd * bv[3]; }
            if (MODE != 0) {
                const f32x4* C4 = (const f32x4*)(CS + t * 128 + gl * 64); float y0 = 0.f, y1 = 0.f;
#pragma unroll
                for (int n4 = 0; n4 < 16; ++n4) { const f32x4 cv = C4[n4]; y0 += h[n4 * 4] * cv[0] + h[n4 * 4 + 2] * cv[2]; y1 += h[n4 * 4 + 1] * cv[1] + h[n4 * 4 + 3] * cv[3]; }
                float y = y0 + y1 + Dh * xv; y *= siluf_(ZS[t * 512 + w * 64 + lane]);
                const float sq = wave_sum(y * y); if (lane == 0) SSQ[(s0 + t) * 8 + w] = sq;
                proj[(size_t)(r0 + s0 + t) * LDP + C_Z + hd * 64 + lane] = f2bf(y);
            }
        }
    }
    if (MODE == 0) {
        float* sp = states + ((size_t)((b * 32 + c) * 16 + hd)) * 4096 + lane * 64;
#pragma unroll
        for (int n4 = 0; n4 < 16; ++n4) *(f32x4*)(sp + n4 * 4) = (f32x4){h[n4 * 4], h[n4 * 4 + 1], h[n4 * 4 + 2], h[n4 * 4 + 3]};
        if (lane == 0) decs[(b * 32 + c) * 16 + hd] = decp;
    }
    if (MODE == 2) {
        float* sp = P.out + O_SSSM + ((size_t)((layer * 128 + sb) * 16 + hd)) * 4096 + lane * 64;
#pragma unroll
        for (int n4 = 0; n4 < 16; ++n4) *(f32x4*)(sp + n4 * 4) = (f32x4){h[n4 * 4], h[n4 * 4 + 1], h[n4 * 4 + 2], h[n4 * 4 + 3]};
    }
    if (MODE != 0) {
        __syncthreads();
        const float ng = P.in[19][layer * 1024 + hd * 64 + lane];
        for (int t = 0; t < nsteps; ++t) {
            const float tot = SSQ[t * 8 + gl * 4] + SSQ[t * 8 + gl * 4 + 1] + SSQ[t * 8 + gl * 4 + 2] + SSQ[t * 8 + gl * 4 + 3];
            const float sc = rsqrtf(tot * (1.f / 256.f) + EPSF) * ng;
            bf16_t* ap = proj + (size_t)(r0 + t) * LDP + C_Z + hd * 64 + lane; *ap = f2bf(bf2f(*ap) * sc);
        }
    }
}

__device__ __forceinline__ int xt_idx(int row, int t) { return row * 136 + ((((t >> 3) ^ ((row >> 3) & 15)) << 3) | (t & 7)); }
__device__ __forceinline__ void ssd_stage_dt(const Params& P, int layer, const bf16_t* proj, size_t r0, int g, float* DT, float* ACS, int tid) {
    { const int hh = tid >> 7, t = tid & 127, hd = g * 4 + hh;
      const float dt = softplusf_(bf2f(proj[(r0 + t) * LDP + C_DTR + hd]) + P.in[16][layer * 16 + hd]);
      DT[hh * 128 + t] = dt; ACS[hh * 128 + t] = -dt * __expf(P.in[17][layer * 16 + hd]); }
    __syncthreads();
    if (tid < 256) { const int hh = tid >> 6, l = tid & 63; const float a0 = ACS[hh * 128 + 2 * l], a1 = ACS[hh * 128 + 2 * l + 1]; float sum = a0 + a1;
#pragma unroll
        for (int o = 1; o < 64; o <<= 1) { const float v = __shfl_up(sum, o); if (l >= o) sum += v; }
        ACS[hh * 128 + 2 * l] = sum - a1; ACS[hh * 128 + 2 * l + 1] = sum; }
    __syncthreads();
}
template <int PASS>
__device__ __forceinline__ void ssd_stage_conv(const Params& P, int layer, const bf16_t* proj, size_t r0, bool first, int g, const float* DT, const float* ACS, bf16_t* XT4, bf16_t* Bx, bf16_t* Cs, int tid) {
    const int slot = tid & 63, seg = tid >> 6;
    if (slot < (PASS ? 48 : 40)) {
        int cx; if (slot < 32) cx = g * 256 + slot * 8; else if (slot < 40) cx = 1024 + g * 64 + (slot - 32) * 8; else cx = 1280 + g * 64 + (slot - 40) * 8;
        const float* cw = P.in[14] + (size_t)layer * 4 * 1536 + cx; const float* cb = P.in[15] + (size_t)layer * 1536 + cx;
        float wt[4][8], bb[8], win[3][8];
#pragma unroll
        for (int k = 0; k < 4; ++k) { const f32x4 a = *(const f32x4*)(cw + k * 1536), c = *(const f32x4*)(cw + k * 1536 + 4);
#pragma unroll
            for (int i = 0; i < 4; ++i) { wt[k][i] = a[i]; wt[k][4 + i] = c[i]; } }
        { const f32x4 a = *(const f32x4*)cb, c = *(const f32x4*)(cb + 4);
#pragma unroll
          for (int i = 0; i < 4; ++i) { bb[i] = a[i]; bb[4 + i] = c[i]; } }
        const int t0 = seg * 16;
#pragma unroll
        for (int k = 0; k < 3; ++k) { u32x4 raw = (u32x4){0u, 0u, 0u, 0u};
            if (!(first && seg == 0)) raw = *(const u32x4*)(proj + (r0 + t0 - 3 + k) * LDP + C_XBC + cx);
#pragma unroll
            for (int i = 0; i < 4; ++i) { win[k][2 * i] = bflo(raw[i]); win[k][2 * i + 1] = bfhi(raw[i]); } }
        u32x4 cur4[4], nxt4[4];
#pragma unroll
        for (int q = 0; q < 4; ++q) { cur4[q] = *(const u32x4*)(proj + (r0 + t0 + q) * LDP + C_XBC + cx); nxt4[q] = cur4[q]; }
        for (int gq = 0; gq < 4; ++gq) {
            if (gq < 3) {
#pragma unroll
                for (int q = 0; q < 4; ++q) nxt4[q] = *(const u32x4*)(proj + (r0 + t0 + gq * 4 + 4 + q) * LDP + C_XBC + cx); }
#pragma unroll
            for (int q = 0; q < 4; ++q) {
                const int t = t0 + gq * 4 + q; const u32x4 raw = cur4[q];
                float cur[8], o[8];
#pragma unroll
                for (int i = 0; i < 4; ++i) { cur[2 * i] = bflo(raw[i]); cur[2 * i + 1] = bfhi(raw[i]); }
#pragma unroll
                for (int i = 0; i < 8; ++i) { o[i] = siluf_(bb[i] + wt[0][i] * win[0][i] + wt[1][i] * win[1][i] + wt[2][i] * win[2][i] + wt[3][i] * cur[i]); win[0][i] = win[1][i]; win[1][i] = win[2][i]; win[2][i] = cur[i]; }
                if (slot < 32) { const int hh = slot >> 3, p0 = (slot & 7) * 8; float sc = DT[hh * 128 + t]; if (PASS == 0) sc *= __expf(ACS[hh * 128 + 127] - ACS[hh * 128 + t]);
#pragma unroll
                    for (int i = 0; i < 8; ++i) XT4[xt_idx(hh * 64 + p0 + i, t)] = f2bf(o[i] * sc); }
                else if (slot < 40) { const int n0 = (slot - 32) * 8;
                    if (PASS == 0) {
#pragma unroll
                        for (int i = 0; i < 8; ++i) Bx[xt_idx(n0 + i, t)] = f2bf(o[i]); }
                    else { u32x4 pk; pk[0] = pk2(o[0], o[1]); pk[1] = pk2(o[2], o[3]); pk[2] = pk2(o[4], o[5]); pk[3] = pk2(o[6], o[7]); *(u32x4*)(Bx + t * 72 + n0) = pk; } }
                else { const int n0 = (slot - 40) * 8; u32x4 pk; pk[0] = pk2(o[0], o[1]); pk[1] = pk2(o[2], o[3]); pk[2] = pk2(o[4], o[5]); pk[3] = pk2(o[6], o[7]); *(u32x4*)(Cs + t * 72 + n0) = pk; }
            }
#pragma unroll
            for (int q = 0; q < 4; ++q) cur4[q] = nxt4[q];
        }
    }
}
__device__ void ssd_pass1_item(const Params& P, int layer, int item, unsigned char* lds) {
    const int tid = otid(), w = __builtin_amdgcn_readfirstlane(tid >> 6), lane = tid & 63, fr = lane & 15, fq = lane >> 4;
    const int b = item >> 7, c = (item >> 2) & 31, g = item & 3; const size_t r0 = (size_t)b * 4096 + (size_t)c * 128;
    const bf16_t* proj = (const bf16_t*)(P.ws + WS_PROJ);
    float* states = (float*)(P.ws + WS_SSDST); float* decs = (float*)(P.ws + WS_SSDDEC);
    bf16_t* XT4 = (bf16_t*)lds; bf16_t* BT = XT4 + 256 * 136; float* DT = (float*)(BT + 64 * 136); float* ACS = DT + 512;
    __syncthreads();
    ssd_stage_dt(P, layer, proj, r0, g, DT, ACS, tid);
    ssd_stage_conv<0>(P, layer, proj, r0, c == 0, g, DT, ACS, XT4, BT, nullptr, tid);
    __syncthreads();
    const int hh = w >> 1, pb = (w & 1) * 2;
    f32x4 acc[2][4];
#pragma unroll
    for (int pi = 0; pi < 2; ++pi)
#pragma unroll
        for (int nt = 0; nt < 4; ++nt) acc[pi][nt] = (f32x4){0.f, 0.f, 0.f, 0.f};
#pragma unroll
    for (int ks = 0; ks < 4; ++ks) { bf16x8 a[2];
#pragma unroll
        for (int pi = 0; pi < 2; ++pi) a[pi] = *(const bf16x8*)(XT4 + xt_idx(hh * 64 + (pb + pi) * 16 + fr, ks * 32 + fq * 8));
#pragma unroll
        for (int nt = 0; nt < 4; ++nt) { const bf16x8 bv = *(const bf16x8*)(BT + xt_idx(nt * 16 + fr, ks * 32 + fq * 8));
#pragma unroll
            for (int pi = 0; pi < 2; ++pi) acc[pi][nt] = __builtin_amdgcn_mfma_f32_16x16x32_bf16(a[pi], bv, acc[pi][nt], 0, 0, 0); } }
    float* sp = states + ((size_t)((b * 32 + c) * 16 + g * 4 + hh)) * 4096;
#pragma unroll
    for (int pi = 0; pi < 2; ++pi)
#pragma unroll
        for (int nt = 0; nt < 4; ++nt)
#pragma unroll
            for (int j = 0; j < 4; ++j) sp[((pb + pi) * 16 + fq * 4 + j) * 64 + nt * 16 + fr] = acc[pi][nt][j];
    if (tid < 4) decs[(b * 32 + c) * 16 + g * 4 + tid] = __expf(ACS[tid * 128 + 127]);
}
__device__ void ssd_pass3_item(const Params& P, int layer, int item, unsigned char* lds) {
    const int tid = otid(), w = __builtin_amdgcn_readfirstlane(tid >> 6), lane = tid & 63, fr = lane & 15, fq = lane >> 4;
    const int b = item >> 7, c = (item >> 2) & 31, g = item & 3; const size_t r0 = (size_t)b * 4096 + (size_t)c * 128;
    bf16_t* proj = (bf16_t*)(P.ws + WS_PROJ);
    const float* states = (const float*)(P.ws + WS_SSDST);
    bf16_t* Cs = (bf16_t*)lds; bf16_t* Bs = Cs + 128 * 72; bf16_t* Sin = Bs; bf16_t* XT4 = Bs + 128 * 72; bf16_t* Ms = XT4 + 256 * 136; float* DT = (float*)(Ms + 128 * 136); float* ACS = DT + 512;
    __syncthreads();
    ssd_stage_dt(P, layer, proj, r0, g, DT, ACS, tid);
    ssd_stage_conv<1>(P, layer, proj, r0, c == 0, g, DT, ACS, XT4, Bs, Cs, tid);
    __syncthreads();
    f32x4 CB[8];
#pragma unroll
    for (int st = 0; st < 8; ++st) { CB[st] = (f32x4){0.f, 0.f, 0.f, 0.f};
        if (st <= w) {
#pragma unroll
            for (int ks = 0; ks < 2; ++ks) { const bf16x8 a = *(const bf16x8*)(Cs + (16 * w + fr) * 72 + ks * 32 + fq * 8), bv = *(const bf16x8*)(Bs + (16 * st + fr) * 72 + ks * 32 + fq * 8);
                CB[st] = __builtin_amdgcn_mfma_f32_16x16x32_bf16(a, bv, CB[st], 0, 0, 0); } } }
    float ssq[4] = {0.f, 0.f, 0.f, 0.f};
    const int nks = (w >> 1) + 1;
    bf16_t* zrow[4];
#pragma unroll
    for (int j = 0; j < 4; ++j) zrow[j] = proj + (r0 + 16 * w + fq * 4 + j) * LDP + C_Z + g * 256 + fr;
    for (int hh = 0; hh < 4; ++hh) {
        const int hd = g * 4 + hh;
        __syncthreads();
        { const int p = tid >> 3, n0 = (tid & 7) * 8; const float* sp = states + ((size_t)((b * 32 + c) * 16 + hd)) * 4096 + p * 64 + n0;
          const f32x4 a = *(const f32x4*)sp, cc = *(const f32x4*)(sp + 4); u32x4 pk; pk[0] = pk2(a[0], a[1]); pk[1] = pk2(a[2], a[3]); pk[2] = pk2(cc[0], cc[1]); pk[3] = pk2(cc[2], cc[3]);
          *(u32x4*)(Sin + p * 72 + n0) = pk; }
        float acs_t[4];
#pragma unroll
        for (int j = 0; j < 4; ++j) acs_t[j] = ACS[hh * 128 + 16 * w + fq * 4 + j];
#pragma unroll
        for (int st = 0; st < 8; ++st) { if (st <= (w | 1)) { const float acs_s = ACS[hh * 128 + 16 * st + fr];
#pragma unroll
            for (int j = 0; j < 4; ++j) { const int t = 16 * w + fq * 4 + j, sx = 16 * st + fr; const float v = (st <= w && sx <= t) ? CB[st][j] * __expf(acs_t[j] - acs_s) : 0.f; Ms[t * 136 + sx] = f2bf(v); } } }
        __syncthreads();
        bf16_t zv[4][4];
#pragma unroll
        for (int j = 0; j < 4; ++j)
#pragma unroll
            for (int pt = 0; pt < 4; ++pt) zv[j][pt] = *(zrow[j] + hh * 64 + pt * 16);
        f32x4 yd[4], yo[4];
#pragma unroll
        for (int pt = 0; pt < 4; ++pt) { yd[pt] = (f32x4){0.f, 0.f, 0.f, 0.f}; yo[pt] = (f32x4){0.f, 0.f, 0.f, 0.f}; }
        for (int ks = 0; ks < nks; ++ks) { const bf16x8 a = *(const bf16x8*)(Ms + (16 * w + fr) * 136 + ks * 32 + fq * 8);
#pragma unroll
            for (int pt = 0; pt < 4; ++pt) { const bf16x8 bv = *(const bf16x8*)(XT4 + xt_idx(hh * 64 + pt * 16 + fr, ks * 32 + fq * 8)); yd[pt] = __builtin_amdgcn_mfma_f32_16x16x32_bf16(a, bv, yd[pt], 0, 0, 0); } }
#pragma unroll
        for (int ks = 0; ks < 2; ++ks) { const bf16x8 a = *(const bf16x8*)(Cs + (16 * w + fr) * 72 + ks * 32 + fq * 8);
#pragma unroll
            for (int pt = 0; pt < 4; ++pt) { const bf16x8 bv = *(const bf16x8*)(Sin + (pt * 16 + fr) * 72 + ks * 32 + fq * 8); yo[pt] = __builtin_amdgcn_mfma_f32_16x16x32_bf16(a, bv, yo[pt], 0, 0, 0); } }
        const float Dh = P.in[18][layer * 16 + hd];
#pragma unroll
        for (int j = 0; j < 4; ++j) { const int t = 16 * w + fq * 4 + j; const float et = __expf(acs_t[j]), idt = 1.f / DT[hh * 128 + t];
#pragma unroll
            for (int pt = 0; pt < 4; ++pt) { const int p = pt * 16 + fr; const float x = bf2f(XT4[xt_idx(hh * 64 + p, t)]) * idt;
                bf16_t* zp = zrow[j] + hh * 64 + pt * 16;
                float y = yd[pt][j] + et * yo[pt][j] + Dh * x; y *= silu_fast(bf2f(zv[j][pt])); ssq[j] += y * y; *zp = f2bf(y); } }
    }
    asm volatile("s_waitcnt vmcnt(0)" ::: "memory");
    const float* ng = P.in[19] + layer * 1024 + g * 256 + fr;
#pragma unroll
    for (int j = 0; j < 4; ++j) { float v = ssq[j];
#pragma unroll
        for (int o = 8; o > 0; o >>= 1) v += __shfl_xor(v, o);
        ssq[j] = rsqrtf(v * (1.f / 256.f) + EPSF); }
    for (int hb = 0; hb < 16; hb += 4) { bf16_t yv[4][4]; float gv[4];
#pragma unroll
        for (int q = 0; q < 4; ++q) { gv[q] = ng[(hb + q) * 16];
#pragma unroll
            for (int j = 0; j < 4; ++j) yv[q][j] = *(zrow[j] + (hb + q) * 16); }
#pragma unroll
        for (int q = 0; q < 4; ++q)
#pragma unroll
            for (int j = 0; j < 4; ++j) *(zrow[j] + (hb + q) * 16) = f2bf(bf2f(yv[q][j]) * ssq[j] * gv[q]); }
}
__device__ void phase_ssd_scan(const Params& P, int layer) {
    float* states = (float*)(P.ws + WS_SSDST); const float* decs = (const float*)(P.ws + WS_SSDDEC);
    for (int e = blockIdx.x * 512 + otid(); e < 4 * 16 * 4096; e += gridDim.x * 512) {
        const int b = e >> 16, hd = (e >> 12) & 15, pn = e & 4095; float carry = 0.f;
        float st[32], dc[32];
#pragma unroll
        for (int c = 0; c < 32; ++c) { st[c] = states[((size_t)((b * 32 + c) * 16 + hd)) * 4096 + pn]; dc[c] = decs[(b * 32 + c) * 16 + hd]; }
#pragma unroll
        for (int c = 0; c < 32; ++c) { states[((size_t)((b * 32 + c) * 16 + hd)) * 4096 + pn] = carry; carry = carry * dc[c] + st[c]; }
        P.out[O_PSSM + ((size_t)((layer * 4 + b) * 16 + hd)) * 4096 + pn] = carry;
    }
}

__device__ void attn_prompt_item(const Params& P, int layer, int item, unsigned char* lds, bool dry = false) {
    const int tid = otid(), w = tid >> 6, lane = tid & 63, fr = lane & 15, fq = lane >> 4;
    const int b = item >> 7, nb = (item >> 2) & 31, kvh = item & 3;
    bf16_t* proj = (bf16_t*)(P.ws + WS_PROJ);
    bf16_t* Ks = (bf16_t*)lds;
    bf16_t* Vt = Ks + 256 * 72;
    bf16_t* Pw = Vt + 64 * 280 + w * 16 * 168;
    const long rowK0 = (long)b * 4096 + (long)(nb - 1) * 128;
    const bf16_t* qbase = proj + ((size_t)b * 4096 + (size_t)nb * 128 + w * 16 + fr) * LDP + C_Q + kvh * 256 + fq * 8;
    bf16x8 qa[2], qn[2];
#pragma unroll
    for (int ks = 0; ks < 2; ++ks) { qa[ks] = *(const bf16x8*)(qbase + ks * 32); qn[ks] = qa[ks]; }
    __syncthreads();
#pragma unroll
    for (int idx = tid; idx < 2048; idx += 512) { const int kj = idx >> 3, seg = idx & 7; u32x4 v = (u32x4){0u, 0u, 0u, 0u};
        if (nb > 0 || kj >= 128) v = *(const u32x4*)(proj + (size_t)(rowK0 + kj) * LDP + C_K + kvh * 64 + seg * 8);
        *(u32x4*)(Ks + kj * 72 + seg * 8) = v; }
#pragma unroll
    for (int idx = tid; idx < 2048; idx += 512) { const int seg = idx >> 8, kj = idx & 255; u32x4 v = (u32x4){0u, 0u, 0u, 0u};
        if (nb > 0 || kj >= 128) v = *(const u32x4*)(proj + (size_t)(rowK0 + kj) * LDP + C_V + kvh * 64 + seg * 8);
#pragma unroll
        for (int i = 0; i < 8; ++i) Vt[(seg * 8 + i) * 280 + kj] = (bf16_t)((v[i >> 1] >> ((i & 1) * 16)) & 0xffffu); }
    for (int idx = tid; idx < 64 * 24; idx += 512) { const int d = idx / 24, cc = 256 + idx % 24; Vt[d * 280 + cc] = 0; }
    for (int i = lane; i < 384; i += 64) Pw[(i / 24) * 168 + 144 + i % 24] = 0;
    __syncthreads();
    const int q0 = w * 16;
    const size_t qrow0 = (size_t)b * 4096 + (size_t)nb * 128 + q0;
    for (int gi = 0; gi < 4; ++gi) {
        const int hq = kvh * 4 + gi;
        const float slope = exp2f(-0.5f * (float)(hq + 1));
        const float sink = P.in[21][layer * 16 + hq];
        if (gi < 3) {
#pragma unroll
            for (int ks = 0; ks < 2; ++ks) qn[ks] = *(const bf16x8*)(qbase + (gi + 1) * 64 + ks * 32); }
        f32x4 S[9];
#pragma unroll
        for (int nt = 0; nt < 9; ++nt) { f32x4 a = (f32x4){0.f, 0.f, 0.f, 0.f}; const bf16_t* kp = Ks + (q0 + nt * 16 + fr) * 72 + fq * 8;
#pragma unroll
            for (int ks = 0; ks < 2; ++ks) { const bf16x8 kb = *(const bf16x8*)(kp + ks * 32); a = __builtin_amdgcn_mfma_f32_16x16x32_bf16(qa[ks], kb, a, 0, 0, 0); }
            S[nt] = a; }
        float mx[4] = {-INFINITY, -INFINITY, -INFINITY, -INFINITY};
#pragma unroll
        for (int nt = 0; nt < 9; ++nt)
#pragma unroll
            for (int j = 0; j < 4; ++j) { const int dist = (fq * 4 + j) - (nt * 16 + fr) + 128; const bool valid = dist >= 0 && dist <= 128 && (nb > 0 || (q0 + nt * 16 + fr) >= 128);
                const float s = valid ? S[nt][j] * 0.125f - slope * (float)dist : -INFINITY; S[nt][j] = s; mx[j] = fmaxf(mx[j], s); }
        float inv[4];
#pragma unroll
        for (int j = 0; j < 4; ++j) { float m = mx[j];
#pragma unroll
            for (int o = 8; o > 0; o >>= 1) m = fmaxf(m, __shfl_xor(m, o));
            m = fmaxf(m, sink); float sum = 0.f;
#pragma unroll
            for (int nt = 0; nt < 9; ++nt) { const float p = __expf(S[nt][j] - m); S[nt][j] = p; sum += p; }
#pragma unroll
            for (int o = 8; o > 0; o >>= 1) sum += __shfl_xor(sum, o);
            inv[j] = 1.f / (sum + __expf(sink - m)); }
#pragma unroll
        for (int nt = 0; nt < 9; ++nt)
#pragma unroll
            for (int j = 0; j < 4; ++j) Pw[(fq * 4 + j) * 168 + nt * 16 + fr] = f2bf(S[nt][j]);
        asm volatile("s_waitcnt lgkmcnt(0)" ::: "memory"); __builtin_amdgcn_wave_barrier();
        f32x4 O[4];
#pragma unroll
        for (int dt = 0; dt < 4; ++dt) O[dt] = (f32x4){0.f, 0.f, 0.f, 0.f};
#pragma unroll
        for (int ks = 0; ks < 5; ++ks) { const bf16x8 pa = *(const bf16x8*)(Pw + fr * 168 + ks * 32 + fq * 8);
#pragma unroll
            for (int dt = 0; dt < 4; ++dt) { const bf16x8 vb = *(const bf16x8*)(Vt + (dt * 16 + fr) * 280 + q0 + ks * 32 + fq * 8); O[dt] = __builtin_amdgcn_mfma_f32_16x16x32_bf16(pa, vb, O[dt], 0, 0, 0); } }
        asm volatile("s_waitcnt lgkmcnt(0)" ::: "memory"); __builtin_amdgcn_wave_barrier();
#pragma unroll
        for (int dt = 0; dt < 4; ++dt)
#pragma unroll
            for (int j = 0; j < 4; ++j) { if (!dry) proj[(qrow0 + fq * 4 + j) * LDP + C_Q + hq * 64 + dt * 16 + fr] = f2bf(O[dt][j] * inv[j]); }
        qa[0] = qn[0]; qa[1] = qn[1];
    }
    if (nb == 31) {
        for (int idx = tid; idx < 128 * 64; idx += 512) { const int t = idx >> 6, d = idx & 63; const size_t row = (size_t)b * 4096 + 3968 + t;
            const size_t o = ((size_t)((layer * 4 + b) * 128 + t)) * 256 + kvh * 64 + d;
            P.out[O_PK + o] = bf2f(proj[row * LDP + C_K + kvh * 64 + d]); P.out[O_PV + o] = bf2f(proj[row * LDP + C_V + kvh * 64 + d]); }
    }
}
__device__ void attn_sample_item(const Params& P, int layer, int item, float* L, bool dry = false) {
    const int tid = otid(), w = tid >> 6, lane = tid & 63;
    const int sb = item >> 2, kvh = item & 3, r0 = NPR + sb * 4;
    bf16_t* proj = (bf16_t*)(P.ws + WS_PROJ);
    float* Kf = L; float* Vf = Kf + 132 * 65; float* Q = Vf + 132 * 65; float* Sc = Q + 16 * 64;
    const float* ck = P.in[7] + ((size_t)(layer * 128 + sb)) * 128 * 256; const float* cv = P.in[8] + ((size_t)(layer * 128 + sb)) * 128 * 256;
    __syncthreads();
    {
        f32x4 kq[4], vq[4];
#pragma unroll
        for (int i = 0; i < 4; ++i) { const int idx = tid + i * 512, j = idx >> 4, d4 = (idx & 15) * 4; kq[i] = *(const f32x4*)(ck + (size_t)j * 256 + kvh * 64 + d4); vq[i] = *(const f32x4*)(cv + (size_t)j * 256 + kvh * 64 + d4); }
#pragma unroll
        for (int i = 0; i < 4; ++i) { const int idx = tid + i * 512, j = idx >> 4, d4 = (idx & 15) * 4;
#pragma unroll
            for (int e = 0; e < 4; ++e) { Kf[j * 65 + d4 + e] = kq[i][e]; Vf[j * 65 + d4 + e] = vq[i][e]; }
            if (j >= 4) { const size_t o = ((size_t)((layer * 128 + sb) * 128 + (j - 4))) * 256 + kvh * 64 + d4; *(f32x4*)(P.out + O_SK + o) = kq[i]; *(f32x4*)(P.out + O_SV + o) = vq[i]; } }
        if (tid < 256) { const int j = 128 + (tid >> 6), d = tid & 63; const float kv = bf2f(proj[(size_t)(r0 + j - 128) * LDP + C_K + kvh * 64 + d]), vv = bf2f(proj[(size_t)(r0 + j - 128) * LDP + C_V + kvh * 64 + d]);
            Kf[j * 65 + d] = kv; Vf[j * 65 + d] = vv; const size_t o = ((size_t)((layer * 128 + sb) * 128 + (j - 4))) * 256 + kvh * 64 + d; P.out[O_SK + o] = kv; P.out[O_SV + o] = vv; }
    }
    for (int idx = tid; idx < 1024; idx += 512) { const int qr = idx >> 6, d = idx & 63; Q[idx] = bf2f(proj[(size_t)(r0 + (qr >> 2)) * LDP + C_Q + (kvh * 4 + (qr & 3)) * 64 + d]); }
    __syncthreads();
    for (int idx = tid; idx < 16 * 132; idx += 512) { const int qr = idx / 132, j = idx - qr * 132; const int dist = 128 + (qr >> 2) - j; float s = -INFINITY;
        if (dist >= 0 && dist <= 128) { float a = 0.f;
#pragma unroll 8
            for (int d = 0; d < 64; ++d) a += Q[qr * 64 + d] * Kf[j * 65 + d];
            s = a * 0.125f - exp2f(-0.5f * (float)(kvh * 4 + (qr & 3) + 1)) * (float)dist; }
        Sc[qr * 136 + j] = s; }
    __syncthreads();
    for (int rr = 0; rr < 2; ++rr) { const int qr = w * 2 + rr; const float sink = P.in[21][layer * 16 + kvh * 4 + (qr & 3)];
        float v0 = Sc[qr * 136 + lane], v1 = Sc[qr * 136 + 64 + lane], v2 = lane < 4 ? Sc[qr * 136 + 128 + lane] : -INFINITY;
        float m = fmaxf(fmaxf(v0, v1), v2);
#pragma unroll
        for (int o = 32; o > 0; o >>= 1) m = fmaxf(m, __shfl_xor(m, o));
        m = fmaxf(m, sink);
        v0 = __expf(v0 - m); v1 = __expf(v1 - m); v2 = __expf(v2 - m);
        const float sum = wave_sum(v0 + v1 + v2); const float inv = 1.f / (sum + __expf(sink - m));
        Sc[qr * 136 + lane] = v0 * inv; Sc[qr * 136 + 64 + lane] = v1 * inv; if (lane < 4) Sc[qr * 136 + 128 + lane] = v2 * inv; }
    __syncthreads();
    for (int idx = tid; idx < 1024; idx += 512) { const int qr = idx >> 6, d = idx & 63; float o = 0.f;
        for (int j = 0; j < 132; ++j) o += Sc[qr * 136 + j] * Vf[j * 65 + d];
        if (!dry) proj[(size_t)(r0 + (qr >> 2)) * LDP + C_Q + (kvh * 4 + (qr & 3)) * 64 + d] = f2bf(o); }
}

__device__ void gmlp_prompt_item(const Params& P, int layer, int item, unsigned char* lds, bool dry = false) {
    const int tid = otid(), w = tid >> 6, lane = tid & 63, fr = lane & 15, fq = lane >> 4;
    const int b = item >> 8, chn = (item >> 3) & 31, g = item & 7;
    const size_t r0 = (size_t)b * 4096 + (size_t)chn * 128;
    bf16_t* proj = (bf16_t*)(P.ws + WS_PROJ);
    bf16_t* VT = (bf16_t*)lds; bf16_t* Wt = VT + 128 * 136; float* MU = (float*)(Wt + 128 * 136); float* RS = MU + 128;
    __syncthreads();
#pragma unroll
    for (int hb = 0; hb < 2; ++hb) { u32x4 av[8], cv8[8];
#pragma unroll
        for (int i = 0; i < 8; ++i) { const bf16_t* vp = proj + (r0 + w * 16 + hb * 8 + i) * LDP + C_UV + 1024 + lane * 16; av[i] = *(const u32x4*)vp; cv8[i] = *(const u32x4*)(vp + 8); }
#pragma unroll
        for (int i = 0; i < 8; ++i) { const int t = w * 16 + hb * 8 + i; float s = 0.f, sq = 0.f;
#pragma unroll
            for (int k = 0; k < 4; ++k) { float x0 = bflo(av[i][k]), x1 = bfhi(av[i][k]), x2 = bflo(cv8[i][k]), x3 = bfhi(cv8[i][k]); s += x0 + x1 + x2 + x3; sq += x0 * x0 + x1 * x1 + x2 * x2 + x3 * x3; }
            s = wave_sum(s); sq = wave_sum(sq);
            if (lane == 0) { const float mean = s * (1.f / 1024.f); const float var = fmaxf(sq * (1.f / 1024.f) - mean * mean, 0.f); MU[t] = mean; RS[t] = rsqrtf(var + EPSF); } } }
    const float* Wg = P.in[24] + ((size_t)(layer * 8 + g)) * 16384;
#pragma unroll
    for (int idx = tid; idx < 4096; idx += 512) { const int t = idx >> 5, s4 = (idx & 31) * 4; const f32x4 wv = *(const f32x4*)(Wg + t * 128 + s4);
        u32x2 o; o[0] = pk2(s4 <= t ? wv[0] : 0.f, s4 + 1 <= t ? wv[1] : 0.f); o[1] = pk2(s4 + 2 <= t ? wv[2] : 0.f, s4 + 3 <= t ? wv[3] : 0.f);
        *(u32x2*)(Wt + t * 136 + s4) = o; }
    __syncthreads();
    const float* lg = P.in[22] + layer * 1024 + g * 128; const float* lb = P.in[23] + layer * 1024 + g * 128;
#pragma unroll
    for (int idx = tid; idx < 2048; idx += 512) { const int s = idx & 127, fs = idx >> 7; const u32x4 v = *(const u32x4*)(proj + (r0 + s) * LDP + C_UV + 1024 + g * 128 + fs * 8);
        const float mu = MU[s], rs = RS[s];
#pragma unroll
        for (int i = 0; i < 8; ++i) { const int f = fs * 8 + i; const float x = (i & 1) ? bfhi(v[i >> 1]) : bflo(v[i >> 1]); VT[f * 136 + s] = f2bf((x - mu) * rs * lg[f] + lb[f]); } }
    __syncthreads();
    f32x4 acc[8];
#pragma unroll
    for (int ft = 0; ft < 8; ++ft) acc[ft] = (f32x4){0.f, 0.f, 0.f, 0.f};
    const int nks = (16 * w + 15) / 32 + 1;
    for (int ks = 0; ks < nks; ++ks) { const bf16x8 a = *(const bf16x8*)(Wt + (w * 16 + fr) * 136 + ks * 32 + fq * 8);
#pragma unroll
        for (int ft = 0; ft < 8; ++ft) { const bf16x8 bb = *(const bf16x8*)(VT + (ft * 16 + fr) * 136 + ks * 32 + fq * 8); acc[ft] = __builtin_amdgcn_mfma_f32_16x16x32_bf16(a, bb, acc[ft], 0, 0, 0); } }
    bf16_t uv[4][8]; float bsv[4];
#pragma unroll
    for (int j = 0; j < 4; ++j) { const int t = w * 16 + fq * 4 + j; bsv[j] = P.in[25][(layer * 8 + g) * 128 + t];
#pragma unroll
        for (int ft = 0; ft < 8; ++ft) uv[j][ft] = proj[(r0 + t) * LDP + C_UV + g * 128 + ft * 16 + fr]; }
#pragma unroll
    for (int j = 0; j < 4; ++j) { const int t = w * 16 + fq * 4 + j;
#pragma unroll
        for (int ft = 0; ft < 8; ++ft) { if (!dry) proj[(r0 + t) * LDP + C_UV + g * 128 + ft * 16 + fr] = f2bf(bf2f(uv[j][ft]) * (acc[ft][j] + bsv[j])); } }
}
__device__ void gmlp_sample_item(const Params& P, int layer, int item, float* L) {
    const int tid = otid(), w = tid >> 6, lane = tid & 63; const int sb = item >> 1, c = (item & 1) * 512 + tid, g = c >> 7; const size_t r0 = NPR + sb * 4;
    bf16_t* proj = (bf16_t*)(P.ws + WS_PROJ);
    float* MU = L; float* RS = MU + 4;
    __syncthreads();
    if (w < 4) { const bf16_t* vp = proj + (r0 + w) * LDP + C_UV + 1024 + lane * 16; const u32x4 a = *(const u32x4*)vp, cc = *(const u32x4*)(vp + 8); float s = 0.f, sq = 0.f;
#pragma unroll
        for (int k = 0; k < 4; ++k) { float x0 = bflo(a[k]), x1 = bfhi(a[k]), x2 = bflo(cc[k]), x3 = bfhi(cc[k]); s += x0 + x1 + x2 + x3; sq += x0 * x0 + x1 * x1 + x2 * x2 + x3 * x3; }
        s = wave_sum(s); sq = wave_sum(sq);
        if (lane == 0) { const float mean = s * (1.f / 1024.f); const float var = fmaxf(sq * (1.f / 1024.f) - mean * mean, 0.f); MU[w] = mean; RS[w] = rsqrtf(var + EPSF); } }
    bf16_t xv[4], uv[4]; f32x4 wv[4]; float bs[4];
#pragma unroll
    for (int t = 0; t < 4; ++t) { xv[t] = proj[(r0 + t) * LDP + C_UV + 1024 + c]; uv[t] = proj[(r0 + t) * LDP + C_UV + c];
        wv[t] = *(const f32x4*)(P.in[24] + ((size_t)(layer * 8 + g)) * 16384 + t * 128); bs[t] = P.in[25][(layer * 8 + g) * 128 + t]; }
    const float lg = P.in[22][layer * 1024 + c], lb = P.in[23][layer * 1024 + c];
    __syncthreads();
    float vn[4];
#pragma unroll
    for (int t = 0; t < 4; ++t) { vn[t] = (bf2f(xv[t]) - MU[t]) * RS[t] * lg + lb; P.out[O_SGMV + ((size_t)((layer * 128 + sb) * 4 + t)) * 1024 + c] = vn[t]; }
#pragma unroll
    for (int t = 0; t < 4; ++t) { float m = bs[t];
#pragma unroll
        for (int sx = 0; sx < 4; ++sx) if (sx <= t) m += wv[t][sx] * vn[sx];
        proj[(r0 + t) * LDP + C_UV + c] = f2bf(bf2f(uv[t]) * m); }
}

template <int R>
__device__ __forceinline__ void shortconv_rows(const Params& P, int layer, int r0, int tid) {
    bf16_t* proj = (bf16_t*)(P.ws + WS_PROJ);
    const float* cw = P.in[20] + layer * 3 * 1024;
    const int j = tid * 2; const int ss = seq_start(r0); const bool havePrev = (r0 - 2 >= ss);
    unsigned cg[R + 2], xs[R + 2], bg[R];
#pragma unroll
    for (int k = 0; k < R + 2; ++k) { cg[k] = 0u; xs[k] = 0u;
        if (k >= 2 || havePrev) { const bf16_t* rp = proj + (size_t)(r0 - 2 + k) * LDP + C_BCX + j; cg[k] = *(const unsigned*)(rp + 1024); xs[k] = *(const unsigned*)(rp + 2048); } }
#pragma unroll
    for (int k = 0; k < R; ++k) bg[k] = *(const unsigned*)(proj + (size_t)(r0 + k) * LDP + C_BCX + j);
    float pr0[R + 2], pr1[R + 2];
#pragma unroll
    for (int k = 0; k < R + 2; ++k) { pr0[k] = bflo(cg[k]) * bflo(xs[k]); pr1[k] = bfhi(cg[k]) * bfhi(xs[k]); }
    if (!havePrev && r0 >= NPR) { const float* st = P.in[6] + ((size_t)(layer * 128 + ((r0 - NPR) >> 2)) * 2) * 1024 + j; pr0[0] = st[0]; pr1[0] = st[1]; pr0[1] = st[1024]; pr1[1] = st[1025]; }
    const float w0a = cw[j], w0b = cw[j + 1], w1a = cw[1024 + j], w1b = cw[1025 + j], w2a = cw[2048 + j], w2b = cw[2049 + j];
#pragma unroll
    for (int k = 0; k < R; ++k) { const float y0 = w0a * pr0[k] + w1a * pr0[k + 1] + w2a * pr0[k + 2], y1 = w0b * pr1[k] + w1b * pr1[k + 1] + w2b * pr1[k + 2];
        *(unsigned*)(proj + (size_t)(r0 + k) * LDP + C_BCX + j) = pk2(bflo(bg[k]) * y0, bfhi(bg[k]) * y1);
        const int r = r0 + k;
        if (r < NPR) { const int l = r & 4095; if (l >= 4094) { float* o = P.out + O_PSCC + ((size_t)((layer * 4 + (r >> 12)) * 2 + (l - 4094))) * 1024 + j; o[0] = pr0[k + 2]; o[1] = pr1[k + 2]; } }
        else { const int l = (r - NPR) & 3; if (l >= 2) { float* o = P.out + O_SSCC + ((size_t)((layer * 128 + ((r - NPR) >> 2)) * 2 + (l - 2))) * 1024 + j; o[0] = pr0[k + 2]; o[1] = pr1[k + 2]; } }
    }
}
__device__ void shortconv_item(const Params& P, int layer, int item) {
    const int tid = otid();
    if (item < 1024) shortconv_rows<16>(P, layer, item * 16, tid); else shortconv_rows<4>(P, layer, NPR + (item - 1024) * 4, tid);
}
__device__ void ssdconv_state_item(const Params& P, int layer, int sq) {
    const bf16_t* proj = (const bf16_t*)(P.ws + WS_PROJ);
    const size_t rbase = sq < 4 ? (size_t)sq * 4096 + 4093 : (size_t)NPR + (size_t)(sq - 4) * 4 + 1;
    float* o = sq < 4 ? P.out + O_PSSDC + (size_t)(layer * 4 + sq) * 3 * 1536 : P.out + O_SSSDC + (size_t)(layer * 128 + (sq - 4)) * 3 * 1536;
    const int tid = otid(); bf16_t v[9];
#pragma unroll
    for (int i = 0; i < 9; ++i) { const int e = tid + i * 512, t = e / 1536, c = e - t * 1536; v[i] = proj[(rbase + t) * LDP + C_XBC + c]; }
#pragma unroll
    for (int i = 0; i < 9; ++i) o[tid + i * 512] = bf2f(v[i]);
}

template <int R>
__device__ __forceinline__ void ffn_act_unit(const Params& P, int layer, int r0, int oc) {
    const bf16_t* up = (const bf16_t*)(P.ws + WS_PROJ); bf16_t* act = (bf16_t*)(P.ws + WS_PROJ + UP_BYTES);
    const float* cw = P.in[30] + (size_t)layer * 3 * 5632; const float* cb = P.in[31] + (size_t)layer * 5632;
    const int j0 = oc * 8;
    float wa[3][8], wg[3][8], ba[8], bgv[8], pa[2][8], pg[2][8];
#pragma unroll
    for (int k = 0; k < 3; ++k) { const f32x4 a0 = *(const f32x4*)(cw + k * 5632 + j0), a1 = *(const f32x4*)(cw + k * 5632 + j0 + 4), g0 = *(const f32x4*)(cw + k * 5632 + 2816 + j0), g1 = *(const f32x4*)(cw + k * 5632 + 2816 + j0 + 4);
#pragma unroll
        for (int i = 0; i < 4; ++i) { wa[k][i] = a0[i]; wa[k][4 + i] = a1[i]; wg[k][i] = g0[i]; wg[k][4 + i] = g1[i]; } }
    { const f32x4 a0 = *(const f32x4*)(cb + j0), a1 = *(const f32x4*)(cb + j0 + 4), g0 = *(const f32x4*)(cb + 2816 + j0), g1 = *(const f32x4*)(cb + 2816 + j0 + 4);
#pragma unroll
      for (int i = 0; i < 4; ++i) { ba[i] = a0[i]; ba[4 + i] = a1[i]; bgv[i] = g0[i]; bgv[4 + i] = g1[i]; } }
    const int ss = seq_start(r0); const bool havePrev = (r0 - 2 >= ss);
#pragma unroll
    for (int k = 0; k < 2; ++k) {
        if (havePrev) { const u32x4 ua = *(const u32x4*)(up + (size_t)(r0 - 2 + k) * 5632 + j0), ug = *(const u32x4*)(up + (size_t)(r0 - 2 + k) * 5632 + 2816 + j0);
#pragma unroll
            for (int i = 0; i < 4; ++i) { pa[k][2 * i] = bflo(ua[i]); pa[k][2 * i + 1] = bfhi(ua[i]); pg[k][2 * i] = bflo(ug[i]); pg[k][2 * i + 1] = bfhi(ug[i]); } }
        else if (r0 >= NPR) { const float* pp = P.in[9] + ((size_t)(layer * 128 + ((r0 - NPR) >> 2)) * 2 + k) * 5632;
#pragma unroll
            for (int i = 0; i < 8; ++i) { pa[k][i] = pp[j0 + i]; pg[k][i] = pp[2816 + j0 + i]; } }
        else {
#pragma unroll
            for (int i = 0; i < 8; ++i) { pa[k][i] = 0.f; pg[k][i] = 0.f; } } }
#pragma unroll
    for (int kb = 0; kb < R; kb += 4) { u32x4 ua[4], ug[4];
#pragma unroll
        for (int q = 0; q < 4; ++q) { ua[q] = *(const u32x4*)(up + (size_t)(r0 + kb + q) * 5632 + j0); ug[q] = *(const u32x4*)(up + (size_t)(r0 + kb + q) * 5632 + 2816 + j0); }
#pragma unroll
        for (int q = 0; q < 4; ++q) { const int r = r0 + kb + q; float ca[8], cgv[8], o[8];
#pragma unroll
            for (int i = 0; i < 4; ++i) { ca[2 * i] = bflo(ua[q][i]); ca[2 * i + 1] = bfhi(ua[q][i]); cgv[2 * i] = bflo(ug[q][i]); cgv[2 * i + 1] = bfhi(ug[q][i]); }
#pragma unroll
            for (int i = 0; i < 8; ++i) { const float a = ba[i] + wa[0][i] * pa[0][i] + wa[1][i] * pa[1][i] + wa[2][i] * ca[i], g = bgv[i] + wg[0][i] * pg[0][i] + wg[1][i] * pg[1][i] + wg[2][i] * cgv[i];
                o[i] = silu_fast(a) * g; pa[0][i] = pa[1][i]; pa[1][i] = ca[i]; pg[0][i] = pg[1][i]; pg[1][i] = cgv[i]; }
            u32x4 ov; ov[0] = pk2(o[0], o[1]); ov[1] = pk2(o[2], o[3]); ov[2] = pk2(o[4], o[5]); ov[3] = pk2(o[6], o[7]);
            *(u32x4*)(act + (size_t)r * 2816 + j0) = ov;
            float* so = nullptr;
            if (r < NPR) { const int l = r & 4095; if (l >= 4094) so = P.out + O_PFFC + ((size_t)((layer * 4 + (r >> 12)) * 2 + (l - 4094))) * 5632; }
            else { const int l = (r - NPR) & 3; if (l >= 2) so = P.out + O_SFFC + ((size_t)((layer * 128 + ((r - NPR) >> 2)) * 2 + (l - 2))) * 5632; }
            if (so) {
#pragma unroll
                for (int i = 0; i < 8; ++i) { so[j0 + i] = ca[i]; so[2816 + j0 + i] = cgv[i]; } }
        } }
}
__device__ void phase_ffn_act(const Params& P, int layer) {
    constexpr int NU_P = 2048 * 352, NU_S = 128 * 352;
    for (int u = blockIdx.x * 512 + otid(); u < NU_P + NU_S; u += gridDim.x * 512) {
        if (u < NU_P) { const int rb = u / 352, oc = u - rb * 352; ffn_act_unit<8>(P, layer, rb * 8, oc); }
        else { const int v = u - NU_P, sq = v / 352, oc = v - sq * 352; ffn_act_unit<4>(P, layer, NPR + sq * 4, oc); }
    }
}

__device__ __forceinline__ void sgemm_partial(const bf16_t* A, int lda, const bf16_t* Bt, int ldb, int K, int row0, int col0, float* red, int tid) {
    const int w = tid >> 6, lane = tid & 63, fr = lane & 15, fq = lane >> 4;
    const int kw = K >> 3, k0 = w * kw;
    f32x4 acc[2][4];
#pragma unroll
    for (int mt = 0; mt < 2; ++mt)
#pragma unroll
        for (int nt = 0; nt < 4; ++nt) acc[mt][nt] = (f32x4){0.f, 0.f, 0.f, 0.f};
    const bf16_t* ap = A + (size_t)(row0 + fr) * lda + k0 + fq * 8;
    const bf16_t* bp = Bt + (size_t)(col0 + fr) * ldb + k0 + fq * 8;
    const int nks = kw >> 5;
#pragma unroll 4
    for (int ks = 0; ks < nks; ++ks) { bf16x8 a[2], b[4];
#pragma unroll
        for (int mt = 0; mt < 2; ++mt) a[mt] = *(const bf16x8*)(ap + (size_t)mt * 16 * lda + ks * 32);
#pragma unroll
        for (int nt = 0; nt < 4; ++nt) b[nt] = *(const bf16x8*)(bp + (size_t)nt * 16 * ldb + ks * 32);
#pragma unroll
        for (int mt = 0; mt < 2; ++mt)
#pragma unroll
            for (int nt = 0; nt < 4; ++nt) acc[mt][nt] = __builtin_amdgcn_mfma_f32_16x16x32_bf16(a[mt], b[nt], acc[mt][nt], 0, 0, 0); }
#pragma unroll
    for (int mt = 0; mt < 2; ++mt)
#pragma unroll
        for (int nt = 0; nt < 4; ++nt)
#pragma unroll
            for (int j = 0; j < 4; ++j) red[(w * 32 + mt * 16 + fq * 4 + j) * 64 + nt * 16 + fr] = acc[mt][nt][j];
}
__device__ __forceinline__ f32x4 sgemm_reduce(const float* red, int tid) {
    const int row = tid >> 4, c4 = (tid & 15) * 4; f32x4 sacc = (f32x4){0.f, 0.f, 0.f, 0.f};
#pragma unroll
    for (int w = 0; w < 8; ++w) sacc += *(const f32x4*)(red + (w * 32 + row) * 64 + c4);
    return sacc;
}
__device__ void sample_branch(const Params& P, int layer, float* red) {
    const int tid = otid(); const bf16_t* proj = (const bf16_t*)(P.ws + WS_PROJ); bf16_t* hbuf = (bf16_t*)(P.ws + WS_H);
    for (int piece = blockIdx.x; piece < 256; piece += gridDim.x) {
        const int row0 = (piece >> 4) * 32, col0 = (piece & 15) * 64; const size_t r = NPR + row0 + (tid >> 4); const int c = col0 + (tid & 15) * 4;
        f32x4 sum = (f32x4){0.f, 0.f, 0.f, 0.f};
        for (int z = 0; z < 4; ++z) {
            const int ao = z == 0 ? C_Z : (z == 1 ? C_BCX : (z == 2 ? C_Q : C_UV));
            __syncthreads();
            sgemm_partial(proj + (size_t)NPR * LDP + ao, LDP, (const bf16_t*)(P.ws + WS_WBR) + (size_t)(layer * 4 + z) * 1048576, 1024, 1024, row0, col0, red, tid);
            __syncthreads();
            const f32x4 v = sgemm_reduce(red, tid);
            const u32x2 gv = *(const u32x2*)(proj + r * LDP + C_GATE + z * 1024 + c);
            sum[0] += bflo(gv[0]) * v[0]; sum[1] += bfhi(gv[0]) * v[1]; sum[2] += bflo(gv[1]) * v[2]; sum[3] += bfhi(gv[1]) * v[3];
        }
        u32x2 o; o[0] = pk2(sum[0], sum[1]); o[1] = pk2(sum[2], sum[3]); *(u32x2*)(hbuf + r * 1024 + c) = o;
    }
}
__device__ void sample_resid(const Params& P, const bf16_t* A, int lda, const bf16_t* Bt, int K, const float* xin_s, float* xout, const float* ga, float* red) {
    const int tid = otid();
    for (int piece = blockIdx.x; piece < 256; piece += gridDim.x) {
        const int row0 = (piece >> 4) * 32, col0 = (piece & 15) * 64; const int rs = row0 + (tid >> 4), c = col0 + (tid & 15) * 4;
        __syncthreads();
        sgemm_partial(A, lda, Bt, K, K, row0, col0, red, tid);
        __syncthreads();
        const f32x4 v = sgemm_reduce(red, tid);
        const f32x4 xv = *(const f32x4*)(xin_s + (size_t)rs * 1024 + c), gv = *(const f32x4*)(ga + (size_t)(4 + (rs >> 2)) * 6144 + c);
        *(f32x4*)(xout + (size_t)(NPR + rs) * 1024 + c) = xv + gv * v;
    }
}

__device__ __forceinline__ void grid_bar(unsigned* ctr, unsigned& epoch) {
    asm volatile("s_waitcnt vmcnt(0) lgkmcnt(0)" ::: "memory");
    __syncthreads();
    epoch += 1;
    if (threadIdx.x == 0) {
        __builtin_amdgcn_fence(__ATOMIC_RELEASE, "agent");
        asm volatile("s_waitcnt vmcnt(0) lgkmcnt(0)" ::: "memory");
        __hip_atomic_fetch_add(ctr, 1u, __ATOMIC_RELAXED, __HIP_MEMORY_SCOPE_AGENT);
        const unsigned target = epoch * gridDim.x;
        while (__hip_atomic_load(ctr, __ATOMIC_RELAXED, __HIP_MEMORY_SCOPE_AGENT) < target) __builtin_amdgcn_s_sleep(1);
        __builtin_amdgcn_fence(__ATOMIC_ACQUIRE, "agent");
        asm volatile("s_waitcnt vmcnt(0) lgkmcnt(0)" ::: "memory");
    }
    __syncthreads();
}

#ifndef PHMASK
#define PHMASK 0xFFFFFFFF
#endif
#define EN(x) ((PHMASK >> (x)) & 1)
#ifndef DRYM
#define DRYM 0
#endif
#ifndef DBL
#define DBL 0
#endif
#define REP(x) (((DBL >> (x)) & 1) ? 2 : 1)
constexpr int PH_PER_LAYER = 11, N_PHASES = 2 + 4 * PH_PER_LAYER + 1;

__global__ void __launch_bounds__(512, 2) mega_fwd(Params P) {
    extern __shared__ __attribute__((aligned(16))) unsigned char lds_raw[];
    cg::grid_group grid = cg::this_grid();
    LAS unsigned char* ldsl = (LAS unsigned char*)lds_raw;
    bf16_t* proj = (bf16_t*)(P.ws + WS_PROJ);
    bf16_t* hbuf = (bf16_t*)(P.ws + WS_H);
    float* xbuf = P.out;
    float* mod = (float*)(P.ws + WS_MOD);
    unsigned* barctr = (unsigned*)(P.ws + WS_BAR); unsigned epoch = 0;
    for (int ph = P.ph_lo; ph < P.ph_hi; ++ph) {
        if (ph == 0) { for (int rp = 0; rp < REP(0); ++rp) phase_convert(P, (float*)lds_raw); }
        else if (ph == 1) {
            Gemm g{(const bf16_t*)(P.ws + WS_CACT), (const bf16_t*)(P.ws + WS_WADA), 1024, 1024, 1024, 1, 96, 0, 0, 0, 0, 0};
            EpiMod E{mod, P.in[11]};
            for (int rp = 0; rp < REP(1); ++rp) gemm_phase<EpiMod, 1>(ldsl, g, E);
        }
        else if (ph == N_PHASES - 1) { phase_final_norm(xbuf, P.in[33]); }
        else {
            const int layer = (ph - 2) / PH_PER_LAYER, sp = (ph - 2) % PH_PER_LAYER;
            const float* modL = mod + (size_t)layer * NCOND * 6144;
            const float* xin_p = layer == 0 ? P.in[0] : xbuf; const float* xin_s = layer == 0 ? P.in[1] : xbuf + (size_t)NPR * 1024;
            if (sp == 0) { for (int rp = 0; rp < REP(16); ++rp) phase_norm(xin_p, xin_s, P.in[12] + layer * 1024, modL, 0, 1024, hbuf); }
            else if (sp == 1) {
                Gemm g{hbuf, (const bf16_t*)(P.ws + WS_WIN) + (size_t)layer * 13568 * 1024, 1024, 1024, 1024, 66, 53, 0, 0, 0, 0, 0};
                EpiProj E{proj};
                for (int rp = 0; rp < REP(2); ++rp) gemm_phase<EpiProj, 1>(ldsl, g, E);
            }
            else if (sp == 2) {
                for (int it = blockIdx.x; it < 4100 + 256; it += gridDim.x) {
                    if (it < 512) { for (int rp = 0; rp < REP(3); ++rp) ssd_pass1_item(P, layer, it, lds_raw); }
                    else if (it < 1024) { for (int rp = (DRYM & 1) ? 0 : 1; rp < 2; ++rp) attn_prompt_item(P, layer, it - 512, lds_raw, rp == 0 && P.ph_lo == 0); }
                    else if (it < 1536) { for (int rp = (DRYM & 2) ? 0 : 1; rp < 2; ++rp) attn_sample_item(P, layer, it - 1024, (float*)lds_raw, rp == 0 && P.ph_lo == 0); }
                    else if (it < 2560) { for (int rp = (DRYM & 4) ? 0 : 1; rp < 2; ++rp) gmlp_prompt_item(P, layer, it - 1536, lds_raw, rp == 0 && P.ph_lo == 0); }
                    else if (it < 2816) { if (EN(8)) gmlp_sample_item(P, layer, it - 2560, (float*)lds_raw); }
                    else if (it < 3968) { if (EN(9)) shortconv_item(P, layer, it - 2816); }
                    else if (it < 4100) ssdconv_state_item(P, layer, it - 3968);
                    else ssd_item<2>(P, layer, it - 4100, (float*)lds_raw);
                }
            }
            else if (sp == 3) { phase_ssd_scan(P, layer); }
            else if (sp == 4) { for (int it = blockIdx.x; it < 512; it += gridDim.x) ssd_pass3_item(P, layer, it, lds_raw); }
            else if (sp == 5) {
                Gemm g{proj, (const bf16_t*)(P.ws + WS_WBR) + (size_t)layer * 4 * 1048576, LDP, 1024, 1024, 64, 4, C_Z, C_BCX, C_Q, C_UV, (size_t)1048576};
                EpiBranch E{proj, (float*)(P.ws + WS_MSUM), hbuf};
                for (int rp = 0; rp < REP(11); ++rp) gemm_phase<EpiBranch, 4>(ldsl, g, E);
                sample_branch(P, layer, (float*)lds_raw);
            }
            else if (sp == 6) {
                Gemm g{hbuf, (const bf16_t*)(P.ws + WS_WO) + (size_t)layer * 1048576, 1024, 1024, 1024, 64, 4, 0, 0, 0, 0, 0};
                EpiResid E{xin_p, xin_s, xbuf, modL + 2048};
                if (EN(12)) gemm_phase<EpiResid, 1>(ldsl, g, E);
                sample_resid(P, hbuf + (size_t)NPR * 1024, 1024, (const bf16_t*)(P.ws + WS_WO) + (size_t)layer * 1048576, 1024, xin_s, xbuf, modL + 2048, (float*)lds_raw);
            }
            else if (sp == 7) { for (int rp = 0; rp < REP(16); ++rp) phase_norm(xbuf, xbuf + (size_t)NPR * 1024, P.in[28] + layer * 1024, modL, 3072, 4096, hbuf); }
            else if (sp == 8) {
                Gemm g{hbuf, (const bf16_t*)(P.ws + WS_WUP) + (size_t)layer * 5632 * 1024, 1024, 1024, 1024, 66, 22, 0, 0, 0, 0, 0};
                EpiUp E{proj};
                for (int rp = 0; rp < REP(13); ++rp) gemm_phase<EpiUp, 1>(ldsl, g, E);
            }
            else if (sp == 9) { for (int rp = 0; rp < REP(14); ++rp) phase_ffn_act(P, layer); }
            else {
                Gemm g{(const bf16_t*)(P.ws + WS_PROJ + UP_BYTES), (const bf16_t*)(P.ws + WS_WDN) + (size_t)layer * 1024 * 2816, 2816, 2816, 2816, 64, 4, 0, 0, 0, 0, 0};
                EpiResid E{xbuf, xbuf + (size_t)NPR * 1024, xbuf, modL + 5120};
                if (EN(15)) gemm_phase<EpiResid, 1>(ldsl, g, E);
                sample_resid(P, (const bf16_t*)(P.ws + WS_PROJ + UP_BYTES) + (size_t)NPR * 2816, 2816, (const bf16_t*)(P.ws + WS_WDN) + (size_t)layer * 1024 * 2816, 2816, xbuf + (size_t)NPR * 1024, xbuf, modL + 5120, (float*)lds_raw);
            }
        }
        if (ph + 1 < P.ph_hi) { if (ph == 0) grid.sync(); else grid_bar(barctr, epoch); }
    }
}

extern "C" void kernel_launch(void* const* d_in, const int* in_sizes, int n_in, void* d_out, int out_size, void* d_ws, size_t ws_size, hipStream_t stream) {
    static int grid_blocks = 0;
    if (grid_blocks == 0) {
        if (n_in != 34 || (size_t)out_size != O_END || ws_size < WS_END + 256) { fprintf(stderr, "kernel_launch: unexpected sizes n_in %d out %d ws %zu (need %zu)\n", n_in, out_size, ws_size, (size_t)WS_END); grid_blocks = -1; return; }
        int dev = 0, cus = 0, per_cu = 0;
        (void)hipGetDevice(&dev); (void)hipDeviceGetAttribute(&cus, hipDeviceAttributeMultiprocessorCount, dev);
        if (hipFuncSetAttribute((const void*)mega_fwd, hipFuncAttributeMaxDynamicSharedMemorySize, LDS_BYTES) != hipSuccess) { fprintf(stderr, "hipFuncSetAttribute failed\n"); grid_blocks = -1; return; }
        if (hipOccupancyMaxActiveBlocksPerMultiprocessor(&per_cu, (const void*)mega_fwd, 512, LDS_BYTES) != hipSuccess || per_cu < 1) per_cu = 1;
        grid_blocks = cus * 1;
    }
    if (grid_blocks < 0) return;
    Params p{};
    for (int i = 0; i < 34; ++i) p.in[i] = (const float*)d_in[i];
    p.out = (float*)d_out; p.ws = (unsigned char*)d_ws; p.ph_lo = 0; p.ph_hi = N_PHASES;
    (void)hipMemsetAsync((unsigned char*)d_ws + WS_BAR, 0, 256, stream);
    void* args[] = {&p};
    hipError_t e = hipLaunchCooperativeKernel((const void*)mega_fwd, dim3(grid_blocks), dim3(512), args, LDS_BYTES, stream);
    if (e != hipSuccess) fprintf(stderr, "cooperative launch failed: %s (grid %d)\n", hipGetErrorString(e), grid_blocks);
}
```

```cpp
#include <hip/hip_runtime.h>
#include <hip/hip_cooperative_groups.h>
#include <cstdio>
namespace cg = cooperative_groups;

typedef unsigned short bf16_t;
typedef short bf16x8 __attribute__((ext_vector_type(8)));
typedef float f32x4 __attribute__((ext_vector_type(4)));
typedef unsigned u32x4 __attribute__((ext_vector_type(4)));
typedef unsigned u32x2 __attribute__((ext_vector_type(2)));
#define LAS __attribute__((address_space(3)))

constexpr int NTOK = 16896, NPR = 16384;
constexpr int LDP = 13568;
constexpr int C_Z = 0, C_XBC = 1024, C_DTR = 2560, C_BCX = 2576, C_Q = 5648, C_K = 6672, C_V = 6928, C_UV = 7184, C_GATE = 9232, C_END = 13328;
constexpr int NCOND = 132;
constexpr float EPSF = 1e-6f;

constexpr size_t WS_WIN = 0;
constexpr size_t WS_WBR = WS_WIN + (size_t)4 * 13568 * 1024 * 2;
constexpr size_t WS_WO = WS_WBR + (size_t)16 * 1024 * 1024 * 2;
constexpr size_t WS_WUP = WS_WO + (size_t)4 * 1024 * 1024 * 2;
constexpr size_t WS_WDN = WS_WUP + (size_t)4 * 5632 * 1024 * 2;
constexpr size_t WS_WADA = WS_WDN + (size_t)4 * 1024 * 2816 * 2;
constexpr size_t WS_CACT = WS_WADA + (size_t)4 * 6144 * 1024 * 2;
constexpr size_t WS_MOD = WS_CACT + (size_t)256 * 1024 * 2;
constexpr size_t WS_H = WS_MOD + (size_t)4 * NCOND * 6144 * 4;
constexpr size_t WS_MSUM = WS_H + (size_t)NTOK * 1024 * 2;
constexpr size_t WS_PROJ = WS_MSUM + (size_t)NTOK * 1024 * 4;
constexpr size_t WS_END = WS_PROJ + (size_t)NTOK * LDP * 2;
constexpr size_t WS_BAR = WS_END;
constexpr size_t WS_SSDST = WS_WADA;
constexpr size_t WS_SSDDEC = WS_WADA + (size_t)4 * 32 * 16 * 4096 * 4;
constexpr size_t UP_BYTES = (size_t)NTOK * 5632 * 2;

constexpr size_t O_YP = 0, O_YS = 16777216, O_PSSM = O_YS + 524288, O_PSSDC = O_PSSM + 1048576, O_PSCC = O_PSSDC + 73728,
                 O_PK = O_PSCC + 32768, O_PV = O_PK + 524288, O_PFFC = O_PV + 524288, O_SSSM = O_PFFC + 180224,
                 O_SSSDC = O_SSSM + 33554432, O_SSCC = O_SSSDC + 2359296, O_SK = O_SSCC + 1048576, O_SV = O_SK + 16777216,
                 O_SFFC = O_SV + 16777216, O_SGMV = O_SFFC + 5767168, O_END = O_SGMV + 2097152;

struct Params { const float* in[34]; float* out; unsigned char* ws; int ph_lo, ph_hi; };

constexpr int LDS_BYTES = 155648;

__device__ __forceinline__ float bf2f(bf16_t v) { return __uint_as_float((unsigned)v << 16); }
__device__ __forceinline__ float bflo(unsigned v) { return __uint_as_float(v << 16); }
__device__ __forceinline__ float bfhi(unsigned v) { return __uint_as_float(v & 0xffff0000u); }
__device__ __forceinline__ unsigned pk2(float lo, float hi) { unsigned r; asm("v_cvt_pk_bf16_f32 %0, %1, %2" : "=v"(r) : "v"(lo), "v"(hi)); return r; }
__device__ __forceinline__ bf16_t f2bf(float f) { return (bf16_t)(pk2(f, 0.f) & 0xffffu); }
__device__ __forceinline__ float wave_sum(float v) {
#pragma unroll
    for (int o = 32; o > 0; o >>= 1) v += __shfl_xor(v, o);
    return v;
}
__device__ __forceinline__ int otid() { int t = threadIdx.x; asm volatile("" : "+v"(t)); return t; }
__device__ __forceinline__ float sigmoidf_(float x) { return 1.f / (1.f + __expf(-x)); }
__device__ __forceinline__ float siluf_(float x) { return x / (1.f + __expf(-x)); }
__device__ __forceinline__ float geluf_(float x) { const float u = 0.7978845608f * (x + 0.044715f * x * x * x); return x / (1.f + __expf(-2.f * u)); }
__device__ __forceinline__ float softplusf_(float x) { return fmaxf(x, 0.f) + log1pf(__expf(-fabsf(x))); }
__device__ __forceinline__ float silu_fast(float x) { return x * __builtin_amdgcn_rcpf(1.f + __expf(-x)); }
__device__ __forceinline__ float sigmoid_fast(float x) { return __builtin_amdgcn_rcpf(1.f + __expf(-x)); }
__device__ __forceinline__ float gelu_fast(float x) { const float u = 0.7978845608f * (x + 0.044715f * x * x * x); return x * __builtin_amdgcn_rcpf(1.f + __expf(-2.f * u)); }
__device__ __forceinline__ int cond_row(int r) { return r < NPR ? (r >> 12) : 4 + ((r - NPR) >> 2); }
__device__ __forceinline__ int seq_start(int r) { return r < NPR ? (r & ~4095) : NPR + ((r - NPR) & ~3); }

constexpr int BM = 256, BK = 64, HALF = 128, HTB = HALF * BK * 2;
__device__ __forceinline__ int lds_byte(int r, int c) { const int st = (r >> 4) * 2 + (c >> 5), rr = r & 15, cc = c & 31, ob = rr * 64 + cc * 2; return st * 1024 + (ob ^ (((ob >> 9) & 1) << 5)); }
__device__ __forceinline__ void stage_rc(int b, int& R, int& C) { const int st = b / 1024, sb = b % 1024, swz = sb ^ (((sb >> 9) & 1) << 5); R = (st >> 1) * 16 + swz / 64; C = (st & 1) * 32 + (swz % 64) / 2; }
__device__ __forceinline__ int perm32(int rho) { const int n = rho >> 4, i = rho & 15; return 8 * (i >> 2) + 4 * n + (i & 3); }

struct Unit { int pm, pn, z; };
struct Gemm { const bf16_t* A; const bf16_t* Bt; int lda, ldb, K, nM, nN; int ao0, ao1, ao2, ao3; size_t zB; };
__device__ __forceinline__ int gemm_aofs(const Gemm& g, int z) { return z == 0 ? g.ao0 : (z == 1 ? g.ao1 : (z == 2 ? g.ao2 : g.ao3)); }

template <int ZN> __device__ __forceinline__ bool unit_next(const Gemm& g, int i, Unit& u) {
    const int tile = i / ZN; u.z = i - tile * ZN;
    const long L = (long)tile * gridDim.x + blockIdx.x; const int nwg = g.nM * g.nN; if (L >= nwg) return false;
    int wgid = (int)L; { const int q = nwg / 8, r = nwg % 8, xcd = wgid % 8, off = wgid / 8; wgid = (xcd < r ? xcd * (q + 1) : r * (q + 1) + (xcd - r) * q) + off; }
    const int nig = 8 * g.nN, gid = wgid / nig, fm = gid * 8, gsz = (g.nM - fm) < 8 ? (g.nM - fm) : 8;
    u.pm = fm + ((wgid % nig) % gsz); u.pn = (wgid % nig) / gsz; return true;
}

template <class Epi, int ZN>
__device__ __forceinline__ void gemm_phase(LAS unsigned char* lds, const Gemm g, const Epi& E) {
    const int tid = otid(), wid = __builtin_amdgcn_readfirstlane(tid >> 6), lane = tid & 63, wr = wid >> 2, wc = wid & 3, fr = lane & 15, fq = lane >> 4;
    const int K = g.K, nt = K / BK;
    unsigned voffA[2], voffB[2];
#pragma unroll
    for (int i = 0; i < 2; ++i) { int R, C; stage_rc(tid * 16 + i * 8192, R, C); const int Rb = Epi::PERM ? ((R & ~31) + perm32(R & 31)) : R;
        voffA[i] = (unsigned)(R * g.lda + C) * 2u; voffB[i] = (unsigned)(Rb * g.ldb + C) * 2u; }
    const size_t kstep = (size_t)(BK * 2);
    const size_t hstepA = (size_t)HALF * g.lda * 2, hstepB = (size_t)HALF * g.ldb * 2;
    const size_t tstepA = 2 * hstepA, tstepB = 2 * hstepB;
    const unsigned ldsw = (unsigned)wid * 1024u;
    const int aoff = lds_byte(wr * 64 + fr, fq * 8), boff = lds_byte(wc * 32 + fr, fq * 8);
#define PG8_SA(b, h) (((b) * 2 + (h)) * HTB)
#define PG8_SB(b, h) ((4 + (b) * 2 + (h)) * HTB)
#define PG8_STAGE(bufoff, gbase, voff) do { _Pragma("unroll") for (int _i = 0; _i < 2; ++_i) \
        __builtin_amdgcn_global_load_lds((const unsigned*)((const char*)(gbase) + (voff)[_i]), (LAS unsigned*)(lds + (bufoff) + ldsw + _i * 8192), 16, 0, 0); } while (0)
#define PG8_LDA(dst, b, h) do { _Pragma("unroll") for (int m = 0; m < 4; ++m) _Pragma("unroll") for (int k = 0; k < 2; ++k) dst[m][k] = *(const LAS bf16x8*)(lds + PG8_SA(b, h) + aoff + m * 2048 + k * 1024); } while (0)
#define PG8_LDB(dst, b, h) do { _Pragma("unroll") for (int n = 0; n < 2; ++n) _Pragma("unroll") for (int k = 0; k < 2; ++k) dst[n][k] = *(const LAS bf16x8*)(lds + PG8_SB(b, h) + boff + n * 2048 + k * 1024); } while (0)
#define PG8_MMA(ai, bj, At, Bt) do { __builtin_amdgcn_s_setprio(1); _Pragma("unroll") for (int m = 0; m < 4; ++m) _Pragma("unroll") for (int n = 0; n < 2; ++n) _Pragma("unroll") for (int k = 0; k < 2; ++k) \
        acc[ai][bj][m][n] = __builtin_amdgcn_mfma_f32_16x16x32_bf16(Bt[n][k], At[m][k], acc[ai][bj][m][n], 0, 0, 0); __builtin_amdgcn_s_setprio(0); } while (0)
#define PG8_WAIT_V(n) asm volatile("s_waitcnt vmcnt(" #n ")" ::: "memory")
#define PG8_WAIT_L(n) asm volatile("s_waitcnt lgkmcnt(" #n ")" ::: "memory")
#define PG8_BAR __builtin_amdgcn_s_barrier()
#define PG8_SCHED __builtin_amdgcn_sched_barrier(0)
    Unit cur, nxt; int ui = 0;
    if (!unit_next<ZN>(g, 0, cur)) return;
    f32x4 acc[2][2][4][2];
#pragma unroll
    for (int a = 0; a < 2; ++a)
#pragma unroll
        for (int b = 0; b < 2; ++b)
#pragma unroll
            for (int m = 0; m < 4; ++m)
#pragma unroll
                for (int n = 0; n < 2; ++n) acc[a][b][m][n] = (f32x4){0.f, 0.f, 0.f, 0.f};
    bf16x8 At[4][2], B0[2][2], B1[2][2];
    const char* cA = (const char*)g.A + (size_t)cur.pm * tstepA + (size_t)gemm_aofs(g, cur.z) * 2;
    const char* cB = (const char*)g.Bt + (size_t)cur.pn * tstepB + (size_t)cur.z * g.zB * 2;
    PG8_WAIT_V(0);
    PG8_STAGE(PG8_SB(0, 0), cB, voffB); PG8_STAGE(PG8_SA(0, 0), cA, voffA); PG8_STAGE(PG8_SB(0, 1), cB + hstepB, voffB); PG8_STAGE(PG8_SA(0, 1), cA + hstepA, voffA);
    if (wr == 1) PG8_BAR;
    PG8_WAIT_V(4); PG8_BAR;
    PG8_STAGE(PG8_SB(1, 0), cB + kstep, voffB); PG8_STAGE(PG8_SA(1, 0), cA + kstep, voffA); PG8_STAGE(PG8_SB(1, 1), cB + hstepB + kstep, voffB);
    PG8_WAIT_V(6); PG8_BAR;
    for (;;) {
        const bool has_next = unit_next<ZN>(g, ui + 1, nxt);
        const char* nA = has_next ? (const char*)g.A + (size_t)nxt.pm * tstepA + (size_t)gemm_aofs(g, nxt.z) * 2 : cA;
        const char* nB = has_next ? (const char*)g.Bt + (size_t)nxt.pn * tstepB + (size_t)nxt.z * g.zB * 2 : cB;
        for (int t = 0; t < nt; t += 2) {
            const bool last = (t == nt - 2);
            const char* a1 = cA + (size_t)(t + 1) * kstep;
            const char* a2 = last ? nA : cA + (size_t)(t + 2) * kstep; const char* b2 = last ? nB : cB + (size_t)(t + 2) * kstep;
            const char* a3 = a2 + kstep; const char* b3 = b2 + kstep;
            PG8_LDB(B0, 0, 0); PG8_SCHED; PG8_LDA(At, 0, 0); PG8_STAGE(PG8_SA(1, 1), a1 + hstepA, voffA);
            PG8_WAIT_L(8); PG8_BAR; PG8_WAIT_L(0); PG8_MMA(0, 0, At, B0); PG8_BAR; PG8_SCHED;
            PG8_LDB(B1, 0, 1); PG8_STAGE(PG8_SB(0, 0), b2, voffB);
            PG8_BAR; PG8_WAIT_L(0); PG8_MMA(0, 1, At, B1); PG8_BAR;
            PG8_LDA(At, 0, 1); PG8_STAGE(PG8_SA(0, 0), a2, voffA);
            PG8_BAR; PG8_WAIT_L(0); PG8_MMA(1, 0, At, B0); PG8_BAR; PG8_SCHED;
            PG8_STAGE(PG8_SB(0, 1), b2 + hstepB, voffB);
            PG8_WAIT_V(6); PG8_BAR; PG8_MMA(1, 1, At, B1); PG8_BAR;
            PG8_LDB(B0, 1, 0); PG8_SCHED; PG8_LDA(At, 1, 0); PG8_STAGE(PG8_SA(0, 1), a2 + hstepA, voffA);
            PG8_WAIT_L(8); PG8_BAR; PG8_WAIT_L(0); PG8_MMA(0, 0, At, B0); PG8_BAR; PG8_SCHED;
            PG8_LDB(B1, 1, 1); PG8_STAGE(PG8_SB(1, 0), b3, voffB);
            PG8_BAR; PG8_WAIT_L(0); PG8_MMA(0, 1, At, B1); PG8_BAR;
            PG8_LDA(At, 1, 1); PG8_STAGE(PG8_SA(1, 0), a3, voffA);
            PG8_BAR; PG8_WAIT_L(0); PG8_MMA(1, 0, At, B0); PG8_BAR; PG8_SCHED;
            PG8_STAGE(PG8_SB(1, 1), b3 + hstepB, voffB);
            PG8_WAIT_V(6); PG8_BAR; PG8_MMA(1, 1, At, B1); PG8_BAR;
        }
        E(acc, cur, wr, wc, fr, fq);
        if (!has_next) break;
#pragma unroll
        for (int a = 0; a < 2; ++a)
#pragma unroll
            for (int b = 0; b < 2; ++b)
#pragma unroll
                for (int m = 0; m < 4; ++m)
#pragma unroll
                    for (int n = 0; n < 2; ++n) acc[a][b][m][n] = (f32x4){0.f, 0.f, 0.f, 0.f};
        cur = nxt; cA = nA; cB = nB; ++ui;
    }
    PG8_WAIT_V(0);
    if (wr == 0) PG8_BAR;
    PG8_BAR;
#undef PG8_SA
#undef PG8_SB
#undef PG8_STAGE
#undef PG8_LDA
#undef PG8_LDB
#undef PG8_MMA
#undef PG8_WAIT_V
#undef PG8_WAIT_L
#undef PG8_BAR
#undef PG8_SCHED
}

struct EpiMod {
    static constexpr bool PERM = false;
    float* mod; const float* bada;
    __device__ __forceinline__ void operator()(const f32x4 (&acc)[2][2][4][2], const Unit& u, int wr, int wc, int fr, int fq) const {
#pragma unroll
        for (int ai = 0; ai < 2; ++ai)
#pragma unroll
            for (int m = 0; m < 4; ++m) { const int r = u.pm * BM + ai * HALF + wr * 64 + m * 16 + fr; if (r >= NCOND) continue;
#pragma unroll
                for (int bj = 0; bj < 2; ++bj)
#pragma unroll
                    for (int n = 0; n < 2; ++n) { const int c = u.pn * BM + bj * HALF + wc * 32 + n * 16 + fq * 4; const int layer = c / 6144, cc = c - layer * 6144;
                        const f32x4 b = *(const f32x4*)(bada + c); *(f32x4*)(mod + ((size_t)(layer * NCOND + r)) * 6144 + cc) = acc[ai][bj][m][n] + b; } }
    }
};
struct EpiProj {
    static constexpr bool PERM = true;
    bf16_t* O;
    __device__ __forceinline__ void operator()(const f32x4 (&acc)[2][2][4][2], const Unit& u, int wr, int wc, int fr, int fq) const {
#pragma unroll
        for (int bj = 0; bj < 2; ++bj) { const int c = u.pn * BM + bj * HALF + wc * 32 + fq * 8; const int mode = (c >= C_GATE) ? 2 : (c >= C_UV ? 1 : 0);
#pragma unroll
            for (int ai = 0; ai < 2; ++ai)
#pragma unroll
                for (int m = 0; m < 4; ++m) { const int r = u.pm * BM + ai * HALF + wr * 64 + m * 16 + fr;
                    float v[8];
#pragma unroll
                    for (int i = 0; i < 8; ++i) { float x = acc[ai][bj][m][i >> 2][i & 3]; v[i] = mode == 2 ? sigmoid_fast(x) : (mode == 1 ? gelu_fast(x) : x); }
                    u32x4 o; o[0] = pk2(v[0], v[1]); o[1] = pk2(v[2], v[3]); o[2] = pk2(v[4], v[5]); o[3] = pk2(v[6], v[7]);
                    *(u32x4*)(O + (size_t)r * LDP + c) = o; } }
    }
};
struct EpiUp {
    static constexpr bool PERM = true;
    bf16_t* O;
    __device__ __forceinline__ void operator()(const f32x4 (&acc)[2][2][4][2], const Unit& u, int wr, int wc, int fr, int fq) const {
#pragma unroll
        for (int bj = 0; bj < 2; ++bj) { const int c = u.pn * BM + bj * HALF + wc * 32 + fq * 8;
#pragma unroll
            for (int ai = 0; ai < 2; ++ai)
#pragma unroll
                for (int m = 0; m < 4; ++m) { const int r = u.pm * BM + ai * HALF + wr * 64 + m * 16 + fr;
                    const f32x4 a = acc[ai][bj][m][0], b = acc[ai][bj][m][1];
                    u32x4 o; o[0] = pk2(a[0], a[1]); o[1] = pk2(a[2], a[3]); o[2] = pk2(b[0], b[1]); o[3] = pk2(b[2], b[3]);
                    *(u32x4*)(O + (size_t)r * 5632 + c) = o; } }
    }
};
struct EpiBranch {
    static constexpr bool PERM = true;
    const bf16_t* proj; float* msum; bf16_t* merged;
    __device__ __forceinline__ void operator()(const f32x4 (&acc)[2][2][4][2], const Unit& u, int wr, int wc, int fr, int fq) const {
        const int z = u.z;
#pragma unroll
        for (int bj = 0; bj < 2; ++bj) { const int c = u.pn * BM + bj * HALF + wc * 32 + fq * 8;
#pragma unroll
            for (int ai = 0; ai < 2; ++ai)
#pragma unroll
                for (int m = 0; m < 4; ++m) { const int r = u.pm * BM + ai * HALF + wr * 64 + m * 16 + fr;
                    const u32x4 gv = *(const u32x4*)(proj + (size_t)r * LDP + C_GATE + z * 1024 + c);
                    float* mp = msum + (size_t)r * 1024 + c;
                    f32x4 s0 = (f32x4){0.f, 0.f, 0.f, 0.f}, s1 = s0;
                    if (z > 0) { s0 = *(const f32x4*)mp; s1 = *(const f32x4*)(mp + 4); }
                    const f32x4 a = acc[ai][bj][m][0], b = acc[ai][bj][m][1];
                    s0[0] += bflo(gv[0]) * a[0]; s0[1] += bfhi(gv[0]) * a[1]; s0[2] += bflo(gv[1]) * a[2]; s0[3] += bfhi(gv[1]) * a[3];
                    s1[0] += bflo(gv[2]) * b[0]; s1[1] += bfhi(gv[2]) * b[1]; s1[2] += bflo(gv[3]) * b[2]; s1[3] += bfhi(gv[3]) * b[3];
                    if (z < 3) { *(f32x4*)mp = s0; *(f32x4*)(mp + 4) = s1; }
                    else { u32x4 o; o[0] = pk2(s0[0], s0[1]); o[1] = pk2(s0[2], s0[3]); o[2] = pk2(s1[0], s1[1]); o[3] = pk2(s1[2], s1[3]);
                        *(u32x4*)(merged + (size_t)r * 1024 + c) = o; } } }
    }
};
struct EpiResid {
    static constexpr bool PERM = false;
    const float* xin_p; const float* xin_s; float* xout; const float* ga;
    __device__ __forceinline__ void operator()(const f32x4 (&acc)[2][2][4][2], const Unit& u, int wr, int wc, int fr, int fq) const {
#pragma unroll
        for (int ai = 0; ai < 2; ++ai)
#pragma unroll
            for (int m = 0; m < 4; ++m) { const int r = u.pm * BM + ai * HALF + wr * 64 + m * 16 + fr;
                const float* xr = r < NPR ? xin_p + (size_t)r * 1024 : xin_s + (size_t)(r - NPR) * 1024;
                const float* gr = ga + (size_t)cond_row(r) * 6144;
#pragma unroll
                for (int bj = 0; bj < 2; ++bj)
#pragma unroll
                    for (int n = 0; n < 2; ++n) { const int c = u.pn * BM + bj * HALF + wc * 32 + n * 16 + fq * 4;
                        const f32x4 xv = *(const f32x4*)(xr + c), gv = *(const f32x4*)(gr + c);
                        *(f32x4*)(xout + (size_t)r * 1024 + c) = xv + gv * acc[ai][bj][m][n]; } }
    }
};

struct CTile { const float* src; bf16_t* dst; int K, N, k0, n0; };
__device__ __forceinline__ CTile conv_decode(const Params& P, int t) {
    constexpr int T_IN = 3392, T_BR = 1024, T_O = 256, T_UP = 1408, T_DN = 704, T_ADA = 1536, T_L = T_IN + T_BR + T_O + T_UP + T_DN + T_ADA;
    const int layer = t / T_L; int r = t - layer * T_L; CTile c;
    if (r < T_IN) { c.src = P.in[13] + (size_t)layer * 1024 * 13328; c.dst = (bf16_t*)(P.ws + WS_WIN) + (size_t)layer * 13568 * 1024; c.K = 1024; c.N = 13328; c.k0 = (r / 212) * 64; c.n0 = (r % 212) * 64; return c; }
    r -= T_IN;
    if (r < T_BR) { const int br = r >> 8, q = r & 255; c.src = P.in[26] + (size_t)(layer * 4 + br) * 1048576; c.dst = (bf16_t*)(P.ws + WS_WBR) + (size_t)(layer * 4 + br) * 1048576; c.K = 1024; c.N = 1024; c.k0 = (q >> 4) * 64; c.n0 = (q & 15) * 64; return c; }
    r -= T_BR;
    if (r < T_O) { c.src = P.in[27] + (size_t)layer * 1048576; c.dst = (bf16_t*)(P.ws + WS_WO) + (size_t)layer * 1048576; c.K = 1024; c.N = 1024; c.k0 = (r >> 4) * 64; c.n0 = (r & 15) * 64; return c; }
    r -= T_O;
    if (r < T_UP) { c.src = P.in[29] + (size_t)layer * 1024 * 5632; c.dst = (bf16_t*)(P.ws + WS_WUP) + (size_t)layer * 5632 * 1024; c.K = 1024; c.N = 5632; c.k0 = (r / 88) * 64; c.n0 = (r % 88) * 64; return c; }
    r -= T_UP;
    if (r < T_DN) { c.src = P.in[32] + (size_t)layer * 2816 * 1024; c.dst = (bf16_t*)(P.ws + WS_WDN) + (size_t)layer * 1024 * 2816; c.K = 2816; c.N = 1024; c.k0 = (r >> 4) * 64; c.n0 = (r & 15) * 64; return c; }
    r -= T_DN;
    c.src = P.in[10] + (size_t)layer * 1024 * 6144; c.dst = (bf16_t*)(P.ws + WS_WADA) + (size_t)layer * 6144 * 1024; c.K = 1024; c.N = 6144; c.k0 = (r / 96) * 64; c.n0 = (r % 96) * 64; return c;
}
__device__ void phase_convert(const Params& P, float* T) {
    constexpr int NT = 4 * 8320;
    const int tid = otid();
    int t = blockIdx.x;
    CTile cur = conv_decode(P, t < NT ? t : 0);
    float v[8], nv[8];
#pragma unroll
    for (int e = 0; e < 8; ++e) { const int idx = tid + e * 512, k = idx >> 6, n = idx & 63; v[e] = (t < NT && cur.n0 + n < cur.N) ? cur.src[(size_t)(cur.k0 + k) * cur.N + cur.n0 + n] : 0.f; }
    for (; t < NT; t += gridDim.x) {
        const int tn = t + gridDim.x; const bool hn = tn < NT; const CTile nxt = conv_decode(P, hn ? tn : 0);
#pragma unroll
        for (int e = 0; e < 8; ++e) { const int idx = tid + e * 512, k = idx >> 6, n = idx & 63; nv[e] = (hn && nxt.n0 + n < nxt.N) ? nxt.src[(size_t)(nxt.k0 + k) * nxt.N + nxt.n0 + n] : 0.f; }
#pragma unroll
        for (int e = 0; e < 8; ++e) { const int idx = tid + e * 512, k = idx >> 6, n = idx & 63; T[k * 65 + n] = v[e]; }
        __syncthreads();
        { const int n = tid >> 3, kc = (tid & 7) * 8; float x[8];
#pragma unroll
          for (int j = 0; j < 8; ++j) x[j] = T[(kc + j) * 65 + n];
          u32x4 o; o[0] = pk2(x[0], x[1]); o[1] = pk2(x[2], x[3]); o[2] = pk2(x[4], x[5]); o[3] = pk2(x[6], x[7]);
          *(u32x4*)(cur.dst + (size_t)(cur.n0 + n) * cur.K + cur.k0 + kc) = o; }
        __syncthreads();
#pragma unroll
        for (int e = 0; e < 8; ++e) v[e] = nv[e];
        cur = nxt;
    }
    bf16_t* cact = (bf16_t*)(P.ws + WS_CACT);
    for (int i = blockIdx.x * 512 + otid(); i < 256 * 1024; i += gridDim.x * 512) {
        const int r = i >> 10, c = i & 1023; float v = 0.f;
        if (r < 4) v = siluf_(P.in[2][r * 1024 + c]); else if (r < NCOND) v = siluf_(P.in[3][(r - 4) * 1024 + c]);
        cact[i] = f2bf(v);
    }
}

__device__ void phase_norm(const float* xp, const float* xs, const float* g, const float* modL, int shofs, int scofs, bf16_t* hout) {
    const int tid = otid(); const int w = tid >> 6, lane = tid & 63;
    for (int r = blockIdx.x * 8 + w; r < NTOK; r += gridDim.x * 8) {
        const float* x = r < NPR ? xp + (size_t)r * 1024 : xs + (size_t)(r - NPR) * 1024;
        const float* mr = modL + (size_t)cond_row(r) * 6144;
        f32x4 v[4]; float ss = 0.f;
#pragma unroll
        for (int i = 0; i < 4; ++i) { v[i] = *(const f32x4*)(x + i * 256 + lane * 4); ss += v[i][0] * v[i][0] + v[i][1] * v[i][1] + v[i][2] * v[i][2] + v[i][3] * v[i][3]; }
        ss = wave_sum(ss); const float rs = rsqrtf(ss * (1.f / 1024.f) + EPSF);
#pragma unroll
        for (int i = 0; i < 4; ++i) { const int c = i * 256 + lane * 4;
            const f32x4 gv = *(const f32x4*)(g + c), sc = *(const f32x4*)(mr + scofs + c), sh = *(const f32x4*)(mr + shofs + c);
            f32x4 o = v[i] * rs * gv * (sc + 1.f) + sh;
            u32x2 pk; pk[0] = pk2(o[0], o[1]); pk[1] = pk2(o[2], o[3]);
            *(u32x2*)(hout + (size_t)r * 1024 + c) = pk; }
    }
}
__device__ void phase_final_norm(float* x, const float* g) {
    const int tid = otid(); const int w = tid >> 6, lane = tid & 63;
    for (int r = blockIdx.x * 8 + w; r < NTOK; r += gridDim.x * 8) {
        float* xr = x + (size_t)r * 1024; f32x4 v[4]; float ss = 0.f;
#pragma unroll
        for (int i = 0; i < 4; ++i) { v[i] = *(const f32x4*)(xr + i * 256 + lane * 4); ss += v[i][0] * v[i][0] + v[i][1] * v[i][1] + v[i][2] * v[i][2] + v[i][3] * v[i][3]; }
        ss = wave_sum(ss); const float rs = rsqrtf(ss * (1.f / 1024.f) + EPSF);
#pragma unroll
        for (int i = 0; i < 4; ++i) { const int c = i * 256 + lane * 4; const f32x4 gv = *(const f32x4*)(g + c); *(f32x4*)(xr + c) = v[i] * rs * gv; }
    }
}

template <int MODE>
__device__ void ssd_item(const Params& P, int layer, int item, float* L) {
    const int tid = otid(), w = tid >> 6, lane = tid & 63;
    bf16_t* proj = (bf16_t*)(P.ws + WS_PROJ);
    float* states = (float*)(P.ws + WS_SSDST); float* decs = (float*)(P.ws + WS_SSDDEC);
    int r0, nsteps, half, seq0, b = 0, c = 0, sb = 0;
    if (MODE == 2) { sb = item >> 1; half = item & 1; r0 = NPR + sb * 4; nsteps = 4; seq0 = r0; }
    else { b = item >> 6; c = (item >> 1) & 31; half = item & 1; r0 = b * 4096 + c * 128; nsteps = 128; seq0 = b * 4096; }
    float* XS = L; float* ZS = XS + 16 * 512; float* BS = ZS + 16 * 512; float* CS = BS + 16 * 128; float* DTS = CS + 16 * 128; float* DAS = DTS + 128; float* SSQ = DAS + 128;
    const float* cw = P.in[14] + (size_t)layer * 4 * 1536; const float* cb = P.in[15] + (size_t)layer * 1536;
    const float* prev = P.in[5] + ((size_t)(layer * 128 + sb)) * 3 * 1536;
    const int hd = half * 8 + w, gl = w >> 2;
    float h[64];
    if (MODE == 0) {
#pragma unroll
        for (int n = 0; n < 64; ++n) h[n] = 0.f;
    } else {
        const float* s0p = (MODE == 1) ? states + ((size_t)((b * 32 + c) * 16 + hd)) * 4096 + lane * 64
                                       : P.in[4] + ((size_t)((layer * 128 + sb) * 16 + hd)) * 4096 + lane * 64;
#pragma unroll
        for (int n4 = 0; n4 < 16; ++n4) { const f32x4 v = *(const f32x4*)(s0p + n4 * 4); h[n4 * 4] = v[0]; h[n4 * 4 + 1] = v[1]; h[n4 * 4 + 2] = v[2]; h[n4 * 4 + 3] = v[3]; }
    }
    const float Dh = P.in[18][layer * 16 + hd];
    float decp = 1.f;
    for (int s0 = 0; s0 < nsteps; s0 += 16) {
        const int ns = (nsteps - s0) < 16 ? (nsteps - s0) : 16;
        __syncthreads();
        for (int idx = tid; idx < ns * 768; idx += 512) {
            const int t = idx / 768, ch = idx - t * 768;
            int cx;
            if (ch < 512) cx = half * 512 + ch; else if (ch < 640) cx = 1024 + half * 128 + (ch - 512); else cx = 1280 + half * 128 + (ch - 640);
            float a = cb[cx];
#pragma unroll
            for (int k = 0; k < 4; ++k) { const int step = s0 + t - 3 + k, rr = r0 + step; float raw;
                if (rr >= seq0) raw = bf2f(proj[(size_t)rr * LDP + C_XBC + cx]);
                else raw = (MODE == 2) ? prev[(3 + step) * 1536 + cx] : 0.f;
                a += cw[k * 1536 + cx] * raw; }
            a = siluf_(a);
            if (ch < 512) { XS[t * 512 + ch] = a; if (MODE != 0) ZS[t * 512 + ch] = bf2f(proj[(size_t)(r0 + s0 + t) * LDP + C_Z + cx]); }
            else if (ch < 640) BS[t * 128 + ch - 512] = a; else CS[t * 128 + ch - 640] = a;
        }
        if (tid < ns * 8) { const int t = tid >> 3, ww = tid & 7, hh = half * 8 + ww;
            const float dt = softplusf_(bf2f(proj[(size_t)(r0 + s0 + t) * LDP + C_DTR + hh]) + P.in[16][layer * 16 + hh]);
            DTS[t * 8 + ww] = dt; DAS[t * 8 + ww] = __expf(-dt * __expf(P.in[17][layer * 16 + hh])); }
        __syncthreads();
        for (int t = 0; t < ns; ++t) {
            const float a = DAS[t * 8 + w], dt = DTS[t * 8 + w], xv = XS[t * 512 + w * 64 + lane], xd = xv * dt; decp *= a;
            const f32x4* B4 = (const f32x4*)(BS + t * 128 + gl * 64);
#pragma unroll
            for (int n4 = 0; n4 < 16; ++n4) { const f32x4 bv = B4[n4];
                h[n4 * 4] = a * h[n4 * 4] + xd * bv[0]; h[n4 * 4 + 1] = a * h[n4 * 4 + 1] + xd * bv[1]; h[n4 * 4 + 2] = a * h[n4 * 4 + 2] + xd * bv[2]; h[n4 * 4 + 3] = a * h[n4 * 4 + 3] + xd * bv[3]; }
            if (MODE != 0) {
                const f32x4* C4 = (const f32x4*)(CS + t * 128 + gl * 64); float y0 = 0.f, y1 = 0.f;
#pragma unroll
                for (int n4 = 0; n4 < 16; ++n4) { const f32x4 cv = C4[n4]; y0 += h[n4 * 4] * cv[0] + h[n4 * 4 + 2] * cv[2]; y1 += h[n4 * 4 + 1] * cv[1] + h[n4 * 4 + 3] * cv[3]; }
                float y = y0 + y1 + Dh * xv; y *= siluf_(ZS[t * 512 + w * 64 + lane]);
                const float sq = wave_sum(y * y); if (lane == 0) SSQ[(s0 + t) * 8 + w] = sq;
                proj[(size_t)(r0 + s0 + t) * LDP + C_Z + hd * 64 + lane] = f2bf(y);
            }
        }
    }
    if (MODE == 0) {
        float* sp = states + ((size_t)((b * 32 + c) * 16 + hd)) * 4096 + lane * 64;
#pragma unroll
        for (int n4 = 0; n4 < 16; ++n4) *(f32x4*)(sp + n4 * 4) = (f32x4){h[n4 * 4], h[n4 * 4 + 1], h[n4 * 4 + 2], h[n4 * 4 + 3]};
        if (lane == 0) decs[(b * 32 + c) * 16 + hd] = decp;
    }
    if (MODE == 2) {
        float* sp = P.out + O_SSSM + ((size_t)((layer * 128 + sb) * 16 + hd)) * 4096 + lane * 64;
#pragma unroll
        for (int n4 = 0; n4 < 16; ++n4) *(f32x4*)(sp + n4 * 4) = (f32x4){h[n4 * 4], h[n4 * 4 + 1], h[n4 * 4 + 2], h[n4 * 4 + 3]};
    }
    if (MODE != 0) {
        __syncthreads();
        const float ng = P.in[19][layer * 1024 + hd * 64 + lane];
        for (int t = 0; t < nsteps; ++t) {
            const float tot = SSQ[t * 8 + gl * 4] + SSQ[t * 8 + gl * 4 + 1] + SSQ[t * 8 + gl * 4 + 2] + SSQ[t * 8 + gl * 4 + 3];
            const float sc = rsqrtf(tot * (1.f / 256.f) + EPSF) * ng;
            bf16_t* ap = proj + (size_t)(r0 + t) * LDP + C_Z + hd * 64 + lane; *ap = f2bf(bf2f(*ap) * sc);
        }
    }
}

__device__ __forceinline__ int xt_idx(int row, int t) { return row * 136 + ((((t >> 3) ^ ((row >> 3) & 15)) << 3) | (t & 7)); }
__device__ __forceinline__ void ssd_stage_dt(const Params& P, int layer, const bf16_t* proj, size_t r0, int g, float* DT, float* ACS, int tid) {
    { const int hh = tid >> 7, t = tid & 127, hd = g * 4 + hh;
      const float dt = softplusf_(bf2f(proj[(r0 + t) * LDP + C_DTR + hd]) + P.in[16][layer * 16 + hd]);
      DT[hh * 128 + t] = dt; ACS[hh * 128 + t] = -dt * __expf(P.in[17][layer * 16 + hd]); }
    __syncthreads();
    if (tid < 256) { const int hh = tid >> 6, l = tid & 63; const float a0 = ACS[hh * 128 + 2 * l], a1 = ACS[hh * 128 + 2 * l + 1]; float sum = a0 + a1;
#pragma unroll
        for (int o = 1; o < 64; o <<= 1) { const float v = __shfl_up(sum, o); if (l >= o) sum += v; }
        ACS[hh * 128 + 2 * l] = sum - a1; ACS[hh * 128 + 2 * l + 1] = sum; }
    __syncthreads();
}
template <int PASS>
__device__ __forceinline__ void ssd_stage_conv(const Params& P, int layer, const bf16_t* proj, size_t r0, bool first, int g, const float* DT, const float* ACS, bf16_t* XT4, bf16_t* Bx, bf16_t* Cs, int tid) {
    const int slot = tid & 63, seg = tid >> 6;
    if (slot < (PASS ? 48 : 40)) {
        int cx; if (slot < 32) cx = g * 256 + slot * 8; else if (slot < 40) cx = 1024 + g * 64 + (slot - 32) * 8; else cx = 1280 + g * 64 + (slot - 40) * 8;
        const float* cw = P.in[14] + (size_t)layer * 4 * 1536 + cx; const float* cb = P.in[15] + (size_t)layer * 1536 + cx;
        float wt[4][8], bb[8], win[3][8];
#pragma unroll
        for (int k = 0; k < 4; ++k) { const f32x4 a = *(const f32x4*)(cw + k * 1536), c = *(const f32x4*)(cw + k * 1536 + 4);
#pragma unroll
            for (int i = 0; i < 4; ++i) { wt[k][i] = a[i]; wt[k][4 + i] = c[i]; } }
        { const f32x4 a = *(const f32x4*)cb, c = *(const f32x4*)(cb + 4);
#pragma unroll
          for (int i = 0; i < 4; ++i) { bb[i] = a[i]; bb[4 + i] = c[i]; } }
        const int t0 = seg * 16;
#pragma unroll
        for (int k = 0; k < 3; ++k) { u32x4 raw = (u32x4){0u, 0u, 0u, 0u};
            if (!(first && seg == 0)) raw = *(const u32x4*)(proj + (r0 + t0 - 3 + k) * LDP + C_XBC + cx);
#pragma unroll
            for (int i = 0; i < 4; ++i) { win[k][2 * i] = bflo(raw[i]); win[k][2 * i + 1] = bfhi(raw[i]); } }
        u32x4 cur4[4], nxt4[4];
#pragma unroll
        for (int q = 0; q < 4; ++q) { cur4[q] = *(const u32x4*)(proj + (r0 + t0 + q) * LDP + C_XBC + cx); nxt4[q] = cur4[q]; }
        for (int gq = 0; gq < 4; ++gq) {
            if (gq < 3) {
#pragma unroll
                for (int q = 0; q < 4; ++q) nxt4[q] = *(const u32x4*)(proj + (r0 + t0 + gq * 4 + 4 + q) * LDP + C_XBC + cx); }
#pragma unroll
            for (int q = 0; q < 4; ++q) {
                const int t = t0 + gq * 4 + q; const u32x4 raw = cur4[q];
                float cur[8], o[8];
#pragma unroll
                for (int i = 0; i < 4; ++i) { cur[2 * i] = bflo(raw[i]); cur[2 * i + 1] = bfhi(raw[i]); }
#pragma unroll
                for (int i = 0; i < 8; ++i) { o[i] = siluf_(bb[i] + wt[0][i] * win[0][i] + wt[1][i] * win[1][i] + wt[2][i] * win[2][i] + wt[3][i] * cur[i]); win[0][i] = win[1][i]; win[1][i] = win[2][i]; win[2][i] = cur[i]; }
                if (slot < 32) { const int hh = slot >> 3, p0 = (slot & 7) * 8; float sc = DT[hh * 128 + t]; if (PASS == 0) sc *= __expf(ACS[hh * 128 + 127] - ACS[hh * 128 + t]);
#pragma unroll
                    for (int i = 0; i < 8; ++i) XT4[xt_idx(hh * 64 + p0 + i, t)] = f2bf(o[i] * sc); }
                else if (slot < 40) { const int n0 = (slot - 32) * 8;
                    if (PASS == 0) {
#pragma unroll
                        for (int i = 0; i < 8; ++i) Bx[xt_idx(n0 + i, t)] = f2bf(o[i]); }
                    else { u32x4 pk; pk[0] = pk2(o[0], o[1]); pk[1] = pk2(o[2], o[3]); pk[2] = pk2(o[4], o[5]); pk[3] = pk2(o[6], o[7]); *(u32x4*)(Bx + t * 72 + n0) = pk; } }
                else { const int n0 = (slot - 40) * 8; u32x4 pk; pk[0] = pk2(o[0], o[1]); pk[1] = pk2(o[2], o[3]); pk[2] = pk2(o[4], o[5]); pk[3] = pk2(o[6], o[7]); *(u32x4*)(Cs + t * 72 + n0) = pk; }
            }
#pragma unroll
            for (int q = 0; q < 4; ++q) cur4[q] = nxt4[q];
        }
    }
}
__device__ void ssd_pass1_item(const Params& P, int layer, int item, unsigned char* lds) {
    const int tid = otid(), w = __builtin_amdgcn_readfirstlane(tid >> 6), lane = tid & 63, fr = lane & 15, fq = lane >> 4;
    const int b = item >> 7, c = (item >> 2) & 31, g = item & 3; const size_t r0 = (size_t)b * 4096 + (size_t)c * 128;
    const bf16_t* proj = (const bf16_t*)(P.ws + WS_PROJ);
    float* states = (float*)(P.ws + WS_SSDST); float* decs = (float*)(P.ws + WS_SSDDEC);
    bf16_t* XT4 = (bf16_t*)lds; bf16_t* BT = XT4 + 256 * 136; float* DT = (float*)(BT + 64 * 136); float* ACS = DT + 512;
    __syncthreads();
    ssd_stage_dt(P, layer, proj, r0, g, DT, ACS, tid);
    ssd_stage_conv<0>(P, layer, proj, r0, c == 0, g, DT, ACS, XT4, BT, nullptr, tid);
    __syncthreads();
    const int hh = w >> 1, pb = (w & 1) * 2;
    f32x4 acc[2][4];
#pragma unroll
    for (int pi = 0; pi < 2; ++pi)
#pragma unroll
        for (int nt = 0; nt < 4; ++nt) acc[pi][nt] = (f32x4){0.f, 0.f, 0.f, 0.f};
#pragma unroll
    for (int ks = 0; ks < 4; ++ks) { bf16x8 a[2];
#pragma unroll
        for (int pi = 0; pi < 2; ++pi) a[pi] = *(const bf16x8*)(XT4 + xt_idx(hh * 64 + (pb + pi) * 16 + fr, ks * 32 + fq * 8));
#pragma unroll
        for (int nt = 0; nt < 4; ++nt) { const bf16x8 bv = *(const bf16x8*)(BT + xt_idx(nt * 16 + fr, ks * 32 + fq * 8));
#pragma unroll
            for (int pi = 0; pi < 2; ++pi) acc[pi][nt] = __builtin_amdgcn_mfma_f32_16x16x32_bf16(a[pi], bv, acc[pi][nt], 0, 0, 0); } }
    float* sp = states + ((size_t)((b * 32 + c) * 16 + g * 4 + hh)) * 4096;
#pragma unroll
    for (int pi = 0; pi < 2; ++pi)
#pragma unroll
        for (int nt = 0; nt < 4; ++nt)
#pragma unroll
            for (int j = 0; j < 4; ++j) sp[((pb + pi) * 16 + fq * 4 + j) * 64 + nt * 16 + fr] = acc[pi][nt][j];
    if (tid < 4) decs[(b * 32 + c) * 16 + g * 4 + tid] = __expf(ACS[tid * 128 + 127]);
}
__device__ void ssd_pass3_item(const Params& P, int layer, int item, unsigned char* lds) {
    const int tid = otid(), w = __builtin_amdgcn_readfirstlane(tid >> 6), lane = tid & 63, fr = lane & 15, fq = lane >> 4;
    const int b = item >> 7, c = (item >> 2) & 31, g = item & 3; const size_t r0 = (size_t)b * 4096 + (size_t)c * 128;
    bf16_t* proj = (bf16_t*)(P.ws + WS_PROJ);
    const float* states = (const float*)(P.ws + WS_SSDST);
    bf16_t* Cs = (bf16_t*)lds; bf16_t* Bs = Cs + 128 * 72; bf16_t* Sin = Bs; bf16_t* XT4 = Bs + 128 * 72; bf16_t* Ms = XT4 + 256 * 136; float* DT = (float*)(Ms + 128 * 136); float* ACS = DT + 512;
    __syncthreads();
    ssd_stage_dt(P, layer, proj, r0, g, DT, ACS, tid);
    ssd_stage_conv<1>(P, layer, proj, r0, c == 0, g, DT, ACS, XT4, Bs, Cs, tid);
    __syncthreads();
    f32x4 CB[8];
#pragma unroll
    for (int st = 0; st < 8; ++st) { CB[st] = (f32x4){0.f, 0.f, 0.f, 0.f};
        if (st <= w) {
#pragma unroll
            for (int ks = 0; ks < 2; ++ks) { const bf16x8 a = *(const bf16x8*)(Cs + (16 * w + fr) * 72 + ks * 32 + fq * 8), bv = *(const bf16x8*)(Bs + (16 * st + fr) * 72 + ks * 32 + fq * 8);
                CB[st] = __builtin_amdgcn_mfma_f32_16x16x32_bf16(a, bv, CB[st], 0, 0, 0); } } }
    float ssq[4] = {0.f, 0.f, 0.f, 0.f};
    const int nks = (w >> 1) + 1;
    bf16_t* zrow[4];
#pragma unroll
    for (int j = 0; j < 4; ++j) zrow[j] = proj + (r0 + 16 * w + fq * 4 + j) * LDP + C_Z + g * 256 + fr;
    for (int hh = 0; hh < 4; ++hh) {
        const int hd = g * 4 + hh;
        __syncthreads();
        { const int p = tid >> 3, n0 = (tid & 7) * 8; const float* sp = states + ((size_t)((b * 32 + c) * 16 + hd)) * 4096 + p * 64 + n0;
          const f32x4 a = *(const f32x4*)sp, cc = *(const f32x4*)(sp + 4); u32x4 pk; pk[0] = pk2(a[0], a[1]); pk[1] = pk2(a[2], a[3]); pk[2] = pk2(cc[0], cc[1]); pk[3] = pk2(cc[2], cc[3]);
          *(u32x4*)(Sin + p * 72 + n0) = pk; }
        float acs_t[4];
#pragma unroll
        for (int j = 0; j < 4; ++j) acs_t[j] = ACS[hh * 128 + 16 * w + fq * 4 + j];
#pragma unroll
        for (int st = 0; st < 8; ++st) { if (st <= (w | 1)) { const float acs_s = ACS[hh * 128 + 16 * st + fr];
#pragma unroll
            for (int j = 0; j < 4; ++j) { const int t = 16 * w + fq * 4 + j, sx = 16 * st + fr; const float v = (st <= w && sx <= t) ? CB[st][j] * __expf(acs_t[j] - acs_s) : 0.f; Ms[t * 136 + sx] = f2bf(v); } } }
        __syncthreads();
        bf16_t zv[4][4];
#pragma unroll
        for (int j = 0; j < 4; ++j)
#pragma unroll
            for (int pt = 0; pt < 4; ++pt) zv[j][pt] = *(zrow[j] + hh * 64 + pt * 16);
        f32x4 yd[4], yo[4];
#pragma unroll
        for (int pt = 0; pt < 4; ++pt) { yd[pt] = (f32x4){0.f, 0.f, 0.f, 0.f}; yo[pt] = (f32x4){0.f, 0.f, 0.f, 0.f}; }
        for (int ks = 0; ks < nks; ++ks) { const bf16x8 a = *(const bf16x8*)(Ms + (16 * w + fr) * 136 + ks * 32 + fq * 8);
#pragma unroll
            for (int pt = 0; pt < 4; ++pt) { const bf16x8 bv = *(const bf16x8*)(XT4 + xt_idx(hh * 64 + pt * 16 + fr, ks * 32 + fq * 8)); yd[pt] = __builtin_amdgcn_mfma_f32_16x16x32_bf16(a, bv, yd[pt], 0, 0, 0); } }
#pragma unroll
        for (int ks = 0; ks < 2; ++ks) { const bf16x8 a = *(const bf16x8*)(Cs + (16 * w + fr) * 72 + ks * 32 + fq * 8);
#pragma unroll
            for (int pt = 0; pt < 4; ++pt) { const bf16x8 bv = *(const bf16x8*)(Sin + (pt * 16 + fr) * 72 + ks * 32 + fq * 8); yo[pt] = __builtin_amdgcn_mfma_f32_16x16x32_bf16(a, bv, yo[pt], 0, 0, 0); } }
        const float Dh = P.in[18][layer * 16 + hd];
#pragma unroll
        for (int j = 0; j < 4; ++j) { const int t = 16 * w + fq * 4 + j; const float et = __expf(acs_t[j]), idt = 1.f / DT[hh * 128 + t];
#pragma unroll
            for (int pt = 0; pt < 4; ++pt) { const int p = pt * 16 + fr; const float x = bf2f(XT4[xt_idx(hh * 64 + p, t)]) * idt;
                bf16_t* zp = zrow[j] + hh * 64 + pt * 16;
                float y = yd[pt][j] + et * yo[pt][j] + Dh * x; y *= silu_fast(bf2f(zv[j][pt])); ssq[j] += y * y; *zp = f2bf(y); } }
    }
    asm volatile("s_waitcnt vmcnt(0)" ::: "memory");
    const float* ng = P.in[19] + layer * 1024 + g * 256 + fr;
#pragma unroll
    for (int j = 0; j < 4; ++j) { float v = ssq[j];
#pragma unroll
        for (int o = 8; o > 0; o >>= 1) v += __shfl_xor(v, o);
        ssq[j] = rsqrtf(v * (1.f / 256.f) + EPSF); }
    for (int hb = 0; hb < 16; hb += 4) { bf16_t yv[4][4]; float gv[4];
#pragma unroll
        for (int q = 0; q < 4; ++q) { gv[q] = ng[(hb + q) * 16];
#pragma unroll
            for (int j = 0; j < 4; ++j) yv[q][j] = *(zrow[j] + (hb + q) * 16); }
#pragma unroll
        for (int q = 0; q < 4; ++q)
#pragma unroll
            for (int j = 0; j < 4; ++j) *(zrow[j] + (hb + q) * 16) = f2bf(bf2f(yv[q][j]) * ssq[j] * gv[q]); }
}
__device__ void phase_ssd_scan(const Params& P, int layer) {
    float* states = (float*)(P.ws + WS_SSDST); const float* decs = (const float*)(P.ws + WS_SSDDEC);
    for (int e = blockIdx.x * 512 + otid(); e < 4 * 16 * 4096; e += gridDim.x * 512) {
        const int b = e >> 16, hd = (e >> 12) & 15, pn = e & 4095; float carry = 0.f;
        float st[32], dc[32];
#pragma unroll
        for (int c = 0; c < 32; ++c) { st[c] = states[((size_t)((b * 32 + c) * 16 + hd)) * 4096 + pn]; dc[c] = decs[(b * 32 + c) * 16 + hd]; }
#pragma unroll
        for (int c = 0; c < 32; ++c) { states[((size_t)((b * 32 + c) * 16 + hd)) * 4096 + pn] = carry; carry = carry * dc[c] + st[c]; }
        P.out[O_PSSM + ((size_t)((layer * 4 + b) * 16 + hd)) * 4096 + pn] = carry;
    }
}

__device__ void attn_prompt_item(const Params& P, int layer, int item, unsigned char* lds, bool dry = false) {
    const int tid = otid(), w = tid >> 6, lane = tid & 63, fr = lane & 15, fq = lane >> 4;
    const int b = item >> 7, nb = (item >> 2) & 31, kvh = item & 3;
    bf16_t* proj = (bf16_t*)(P.ws + WS_PROJ);
    bf16_t* Ks = (bf16_t*)lds;
    bf16_t* Vt = Ks + 256 * 72;
    bf16_t* Pw = Vt + 64 * 280 + w * 16 * 168;
    const long rowK0 = (long)b * 4096 + (long)(nb - 1) * 128;
    const bf16_t* qbase = proj + ((size_t)b * 4096 + (size_t)nb * 128 + w * 16 + fr) * LDP + C_Q + kvh * 256 + fq * 8;
    bf16x8 qa[2], qn[2];
#pragma unroll
    for (int ks = 0; ks < 2; ++ks) { qa[ks] = *(const bf16x8*)(qbase + ks * 32); qn[ks] = qa[ks]; }
    __syncthreads();
#pragma unroll
    for (int idx = tid; idx < 2048; idx += 512) { const int kj = idx >> 3, seg = idx & 7; u32x4 v = (u32x4){0u, 0u, 0u, 0u};
        if (nb > 0 || kj >= 128) v = *(const u32x4*)(proj + (size_t)(rowK0 + kj) * LDP + C_K + kvh * 64 + seg * 8);
        *(u32x4*)(Ks + kj * 72 + seg * 8) = v; }
#pragma unroll
    for (int idx = tid; idx < 2048; idx += 512) { const int seg = idx >> 8, kj = idx & 255; u32x4 v = (u32x4){0u, 0u, 0u, 0u};
        if (nb > 0 || kj >= 128) v = *(const u32x4*)(proj + (size_t)(rowK0 + kj) * LDP + C_V + kvh * 64 + seg * 8);
#pragma unroll
        for (int i = 0; i < 8; ++i) Vt[(seg * 8 + i) * 280 + kj] = (bf16_t)((v[i >> 1] >> ((i & 1) * 16)) & 0xffffu); }
    for (int idx = tid; idx < 64 * 24; idx += 512) { const int d = idx / 24, cc = 256 + idx % 24; Vt[d * 280 + cc] = 0; }
    for (int i = lane; i < 384; i += 64) Pw[(i / 24) * 168 + 144 + i % 24] = 0;
    __syncthreads();
    const int q0 = w * 16;
    const size_t qrow0 = (size_t)b * 4096 + (size_t)nb * 128 + q0;
    for (int gi = 0; gi < 4; ++gi) {
        const int hq = kvh * 4 + gi;
        const float slope = exp2f(-0.5f * (float)(hq + 1));
        const float sink = P.in[21][layer * 16 + hq];
        if (gi < 3) {
#pragma unroll
            for (int ks = 0; ks < 2; ++ks) qn[ks] = *(const bf16x8*)(qbase + (gi + 1) * 64 + ks * 32); }
        f32x4 S[9];
#pragma unroll
        for (int nt = 0; nt < 9; ++nt) { f32x4 a = (f32x4){0.f, 0.f, 0.f, 0.f}; const bf16_t* kp = Ks + (q0 + nt * 16 + fr) * 72 + fq * 8;
#pragma unroll
            for (int ks = 0; ks < 2; ++ks) { const bf16x8 kb = *(const bf16x8*)(kp + ks * 32); a = __builtin_amdgcn_mfma_f32_16x16x32_bf16(qa[ks], kb, a, 0, 0, 0); }
            S[nt] = a; }
        float mx[4] = {-INFINITY, -INFINITY, -INFINITY, -INFINITY};
#pragma unroll
        for (int nt = 0; nt < 9; ++nt)
#pragma unroll
            for (int j = 0; j < 4; ++j) { const int dist = (fq * 4 + j) - (nt * 16 + fr) + 128; const bool valid = dist >= 0 && dist <= 128 && (nb > 0 || (q0 + nt * 16 + fr) >= 128);
                const float s = valid ? S[nt][j] * 0.125f - slope * (float)dist : -INFINITY; S[nt][j] = s; mx[j] = fmaxf(mx[j], s); }
        float inv[4];
#pragma unroll
        for (int j = 0; j < 4; ++j) { float m = mx[j];
#pragma unroll
            for (int o = 8; o > 0; o >>= 1) m = fmaxf(m, __shfl_xor(m, o));
            m = fmaxf(m, sink); float sum = 0.f;
#pragma unroll
            for (int nt = 0; nt < 9; ++nt) { const float p = __expf(S[nt][j] - m); S[nt][j] = p; sum += p; }
#pragma unroll
            for (int o = 8; o > 0; o >>= 1) sum += __shfl_xor(sum, o);
            inv[j] = 1.f / (sum + __expf(sink - m)); }
#pragma unroll
        for (int nt = 0; nt < 9; ++nt)
#pragma unroll
            for (int j = 0; j < 4; ++j) Pw[(fq * 4 + j) * 168 + nt * 16 + fr] = f2bf(S[nt][j]);
        asm volatile("s_waitcnt lgkmcnt(0)" ::: "memory"); __builtin_amdgcn_wave_barrier();
        f32x4 O[4];
#pragma unroll
        for (int dt = 0; dt < 4; ++dt) O[dt] = (f32x4){0.f, 0.f, 0.f, 0.f};
#pragma unroll
        for (int ks = 0; ks < 5; ++ks) { const bf16x8 pa = *(const bf16x8*)(Pw + fr * 168 + ks * 32 + fq * 8);
#pragma unroll
            for (int dt = 0; dt < 4; ++dt) { const bf16x8 vb = *(const bf16x8*)(Vt + (dt * 16 + fr) * 280 + q0 + ks * 32 + fq * 8); O[dt] = __builtin_amdgcn_mfma_f32_16x16x32_bf16(pa, vb, O[dt], 0, 0, 0); } }
        asm volatile("s_waitcnt lgkmcnt(0)" ::: "memory"); __builtin_amdgcn_wave_barrier();
#pragma unroll
        for (int dt = 0; dt < 4; ++dt)
#pragma unroll
            for (int j = 0; j < 4; ++j) { if (!dry) proj[(qrow0 + fq * 4 + j) * LDP + C_Q + hq * 64 + dt * 16 + fr] = f2bf(O[dt][j] * inv[j]); }
        qa[0] = qn[0]; qa[1] = qn[1];
    }
    if (nb == 31) {
        for (int idx = tid; idx < 128 * 64; idx += 512) { const int t = idx >> 6, d = idx & 63; const size_t row = (size_t)b * 4096 + 3968 + t;
            const size_t o = ((size_t)((layer * 4 + b) * 128 + t)) * 256 + kvh * 64 + d;
            P.out[O_PK + o] = bf2f(proj[row * LDP + C_K + kvh * 64 + d]); P.out[O_PV + o] = bf2f(proj[row * LDP + C_V + kvh * 64 + d]); }
    }
}
__device__ void attn_sample_item(const Params& P, int layer, int item, float* L, bool dry = false) {
    const int tid = otid(), w = tid >> 6, lane = tid & 63;
    const int sb = item >> 2, kvh = item & 3, r0 = NPR + sb * 4;
    bf16_t* proj = (bf16_t*)(P.ws + WS_PROJ);
    float* Kf = L; float* Vf = Kf + 132 * 65; float* Q = Vf + 132 * 65; float* Sc = Q + 16 * 64;
    const float* ck = P.in[7] + ((size_t)(layer * 128 + sb)) * 128 * 256; const float* cv = P.in[8] + ((size_t)(layer * 128 + sb)) * 128 * 256;
    __syncthreads();
    {
        f32x4 kq[4], vq[4];
#pragma unroll
        for (int i = 0; i < 4; ++i) { const int idx = tid + i * 512, j = idx >> 4, d4 = (idx & 15) * 4; kq[i] = *(const f32x4*)(ck + (size_t)j * 256 + kvh * 64 + d4); vq[i] = *(const f32x4*)(cv + (size_t)j * 256 + kvh * 64 + d4); }
#pragma unroll
        for (int i = 0; i < 4; ++i) { const int idx = tid + i * 512, j = idx >> 4, d4 = (idx & 15) * 4;
#pragma unroll
            for (int e = 0; e < 4; ++e) { Kf[j * 65 + d4 + e] = kq[i][e]; Vf[j * 65 + d4 + e] = vq[i][e]; }
            if (j >= 4) { const size_t o = ((size_t)((layer * 128 + sb) * 128 + (j - 4))) * 256 + kvh * 64 + d4; *(f32x4*)(P.out + O_SK + o) = kq[i]; *(f32x4*)(P.out + O_SV + o) = vq[i]; } }
        if (tid < 256) { const int j = 128 + (tid >> 6), d = tid & 63; const float kv = bf2f(proj[(size_t)(r0 + j - 128) * LDP + C_K + kvh * 64 + d]), vv = bf2f(proj[(size_t)(r0 + j - 128) * LDP + C_V + kvh * 64 + d]);
            Kf[j * 65 + d] = kv; Vf[j * 65 + d] = vv; const size_t o = ((size_t)((layer * 128 + sb) * 128 + (j - 4))) * 256 + kvh * 64 + d; P.out[O_SK + o] = kv; P.out[O_SV + o] = vv; }
    }
    for (int idx = tid; idx < 1024; idx += 512) { const int qr = idx >> 6, d = idx & 63; Q[idx] = bf2f(proj[(size_t)(r0 + (qr >> 2)) * LDP + C_Q + (kvh * 4 + (qr & 3)) * 64 + d]); }
    __syncthreads();
    for (int idx = tid; idx < 16 * 132; idx += 512) { const int qr = idx / 132, j = idx - qr * 132; const int dist = 128 + (qr >> 2) - j; float s = -INFINITY;
        if (dist >= 0 && dist <= 128) { float a = 0.f;
#pragma unroll 8
            for (int d = 0; d < 64; ++d) a += Q[qr * 64 + d] * Kf[j * 65 + d];
            s = a * 0.125f - exp2f(-0.5f * (float)(kvh * 4 + (qr & 3) + 1)) * (float)dist; }
        Sc[qr * 136 + j] = s; }
    __syncthreads();
    for (int rr = 0; rr < 2; ++rr) { const int qr = w * 2 + rr; const float sink = P.in[21][layer * 16 + kvh * 4 + (qr & 3)];
        float v0 = Sc[qr * 136 + lane], v1 = Sc[qr * 136 + 64 + lane], v2 = lane < 4 ? Sc[qr * 136 + 128 + lane] : -INFINITY;
        float m = fmaxf(fmaxf(v0, v1), v2);
#pragma unroll
        for (int o = 32; o > 0; o >>= 1) m = fmaxf(m, __shfl_xor(m, o));
        m = fmaxf(m, sink);
        v0 = __expf(v0 - m); v1 = __expf(v1 - m); v2 = __expf(v2 - m);
        const float sum = wave_sum(v0 + v1 + v2); const float inv = 1.f / (sum + __expf(sink - m));
        Sc[qr * 136 + lane] = v0 * inv; Sc[qr * 136 + 64 + lane] = v1 * inv; if (lane < 4) Sc[qr * 136 + 128 + lane] = v2 * inv; }
    __syncthreads();
    for (int idx = tid; idx < 1024; idx += 512) { const int qr = idx >> 6, d = idx & 63; float o = 0.f;
        for (int j = 0; j < 132; ++j) o += Sc[qr * 136 + j] * Vf[j * 65 + d];
        if (!dry) proj[(size_t)(r0 + (qr >> 2)) * LDP + C_Q + (kvh * 4 + (qr & 3)) * 64 + d] = f2bf(o); }
}

__device__ void gmlp_prompt_item(const Params& P, int layer, int item, unsigned char* lds, bool dry = false) {
    const int tid = otid(), w = tid >> 6, lane = tid & 63, fr = lane & 15, fq = lane >> 4;
    const int b = item >> 8, chn = (item >> 3) & 31, g = item & 7;
    const size_t r0 = (size_t)b * 4096 + (size_t)chn * 128;
    bf16_t* proj = (bf16_t*)(P.ws + WS_PROJ);
    bf16_t* VT = (bf16_t*)lds; bf16_t* Wt = VT + 128 * 136; float* MU = (float*)(Wt + 128 * 136); float* RS = MU + 128;
    __syncthreads();
#pragma unroll
    for (int hb = 0; hb < 2; ++hb) { u32x4 av[8], cv8[8];
#pragma unroll
        for (int i = 0; i < 8; ++i) { const bf16_t* vp = proj + (r0 + w * 16 + hb * 8 + i) * LDP + C_UV + 1024 + lane * 16; av[i] = *(const u32x4*)vp; cv8[i] = *(const u32x4*)(vp + 8); }
#pragma unroll
        for (int i = 0; i < 8; ++i) { const int t = w * 16 + hb * 8 + i; float s = 0.f, sq = 0.f;
#pragma unroll
            for (int k = 0; k < 4; ++k) { float x0 = bflo(av[i][k]), x1 = bfhi(av[i][k]), x2 = bflo(cv8[i][k]), x3 = bfhi(cv8[i][k]); s += x0 + x1 + x2 + x3; sq += x0 * x0 + x1 * x1 + x2 * x2 + x3 * x3; }
            s = wave_sum(s); sq = wave_sum(sq);
            if (lane == 0) { const float mean = s * (1.f / 1024.f); const float var = fmaxf(sq * (1.f / 1024.f) - mean * mean, 0.f); MU[t] = mean; RS[t] = rsqrtf(var + EPSF); } } }
    const float* Wg = P.in[24] + ((size_t)(layer * 8 + g)) * 16384;
#pragma unroll
    for (int idx = tid; idx < 4096; idx += 512) { const int t = idx >> 5, s4 = (idx & 31) * 4; const f32x4 wv = *(const f32x4*)(Wg + t * 128 + s4);
        u32x2 o; o[0] = pk2(s4 <= t ? wv[0] : 0.f, s4 + 1 <= t ? wv[1] : 0.f); o[1] = pk2(s4 + 2 <= t ? wv[2] : 0.f, s4 + 3 <= t ? wv[3] : 0.f);
        *(u32x2*)(Wt + t * 136 + s4) = o; }
    __syncthreads();
    const float* lg = P.in[22] + layer * 1024 + g * 128; const float* lb = P.in[23] + layer * 1024 + g * 128;
#pragma unroll
    for (int idx = tid; idx < 2048; idx += 512) { const int s = idx & 127, fs = idx >> 7; const u32x4 v = *(const u32x4*)(proj + (r0 + s) * LDP + C_UV + 1024 + g * 128 + fs * 8);
        const float mu = MU[s], rs = RS[s];
#pragma unroll
        for (int i = 0; i < 8; ++i) { const int f = fs * 8 + i; const float x = (i & 1) ? bfhi(v[i >> 1]) : bflo(v[i >> 1]); VT[f * 136 + s] = f2bf((x - mu) * rs * lg[f] + lb[f]); } }
    __syncthreads();
    f32x4 acc[8];
#pragma unroll
    for (int ft = 0; ft < 8; ++ft) acc[ft] = (f32x4){0.f, 0.f, 0.f, 0.f};
    const int nks = (16 * w + 15) / 32 + 1;
    for (int ks = 0; ks < nks; ++ks) { const bf16x8 a = *(const bf16x8*)(Wt + (w * 16 + fr) * 136 + ks * 32 + fq * 8);
#pragma unroll
        for (int ft = 0; ft < 8; ++ft) { const bf16x8 bb = *(const bf16x8*)(VT + (ft * 16 + fr) * 136 + ks * 32 + fq * 8); acc[ft] = __builtin_amdgcn_mfma_f32_16x16x32_bf16(a, bb, acc[ft], 0, 0, 0); } }
    bf16_t uv[4][8]; float bsv[4];
#pragma unroll
    for (int j = 0; j < 4; ++j) { const int t = w * 16 + fq * 4 + j; bsv[j] = P.in[25][(layer * 8 + g) * 128 + t];
#pragma unroll
        for (int ft = 0; ft < 8; ++ft) uv[j][ft] = proj[(r0 + t) * LDP + C_UV + g * 128 + ft * 16 + fr]; }
#pragma unroll
    for (int j = 0; j < 4; ++j) { const int t = w * 16 + fq * 4 + j;
#pragma unroll
        for (int ft = 0; ft < 8; ++ft) { if (!dry) proj[(r0 + t) * LDP + C_UV + g * 128 + ft * 16 + fr] = f2bf(bf2f(uv[j][ft]) * (acc[ft][j] + bsv[j])); } }
}
__device__ void gmlp_sample_item(const Params& P, int layer, int sb, float* L) {
    const int tid = otid(), w = tid >> 6, lane = tid & 63; const size_t r0 = NPR + sb * 4;
    bf16_t* proj = (bf16_t*)(P.ws + WS_PROJ);
    float* Vn = L; float* MU = Vn + 4096; float* RS = MU + 4;
    __syncthreads();
    if (w < 4) { const bf16_t* vp = proj + (r0 + w) * LDP + C_UV + 1024 + lane * 16; const u32x4 a = *(const u32x4*)vp, c = *(const u32x4*)(vp + 8); float s = 0.f, sq = 0.f;
#pragma unroll
        for (int k = 0; k < 4; ++k) { float x0 = bflo(a[k]), x1 = bfhi(a[k]), x2 = bflo(c[k]), x3 = bfhi(c[k]); s += x0 + x1 + x2 + x3; sq += x0 * x0 + x1 * x1 + x2 * x2 + x3 * x3; }
        s = wave_sum(s); sq = wave_sum(sq);
        if (lane == 0) { const float mean = s * (1.f / 1024.f); const float var = fmaxf(sq * (1.f / 1024.f) - mean * mean, 0.f); MU[w] = mean; RS[w] = rsqrtf(var + EPSF); } }
    __syncthreads();
    for (int idx = tid; idx < 4096; idx += 512) { const int t = idx >> 10, c = idx & 1023;
        const float x = bf2f(proj[(r0 + t) * LDP + C_UV + 1024 + c]); const float vn = (x - MU[t]) * RS[t] * P.in[22][layer * 1024 + c] + P.in[23][layer * 1024 + c];
        Vn[idx] = vn; P.out[O_SGMV + ((size_t)((layer * 128 + sb) * 4 + t)) * 1024 + c] = vn; }
    __syncthreads();
    for (int idx = tid; idx < 4096; idx += 512) { const int t = idx >> 10, c = idx & 1023, g = c >> 7;
        const float* Wg = P.in[24] + ((size_t)(layer * 8 + g)) * 16384 + t * 128; float m = P.in[25][(layer * 8 + g) * 128 + t];
        for (int s = 0; s <= t; ++s) m += Wg[s] * Vn[s * 1024 + c];
        bf16_t* ap = proj + (r0 + t) * LDP + C_UV + c; *ap = f2bf(bf2f(*ap) * m); }
}

template <int R>
__device__ __forceinline__ void shortconv_rows(const Params& P, int layer, int r0, int tid) {
    bf16_t* proj = (bf16_t*)(P.ws + WS_PROJ);
    const float* cw = P.in[20] + layer * 3 * 1024;
    const int j = tid * 2; const int ss = seq_start(r0); const bool havePrev = (r0 - 2 >= ss);
    unsigned cg[R + 2], xs[R + 2], bg[R];
#pragma unroll
    for (int k = 0; k < R + 2; ++k) { cg[k] = 0u; xs[k] = 0u;
        if (k >= 2 || havePrev) { const bf16_t* rp = proj + (size_t)(r0 - 2 + k) * LDP + C_BCX + j; cg[k] = *(const unsigned*)(rp + 1024); xs[k] = *(const unsigned*)(rp + 2048); } }
#pragma unroll
    for (int k = 0; k < R; ++k) bg[k] = *(const unsigned*)(proj + (size_t)(r0 + k) * LDP + C_BCX + j);
    float pr0[R + 2], pr1[R + 2];
#pragma unroll
    for (int k = 0; k < R + 2; ++k) { pr0[k] = bflo(cg[k]) * bflo(xs[k]); pr1[k] = bfhi(cg[k]) * bfhi(xs[k]); }
    if (!havePrev && r0 >= NPR) { const float* st = P.in[6] + ((size_t)(layer * 128 + ((r0 - NPR) >> 2)) * 2) * 1024 + j; pr0[0] = st[0]; pr1[0] = st[1]; pr0[1] = st[1024]; pr1[1] = st[1025]; }
    const float w0a = cw[j], w0b = cw[j + 1], w1a = cw[1024 + j], w1b = cw[1025 + j], w2a = cw[2048 + j], w2b = cw[2049 + j];
#pragma unroll
    for (int k = 0; k < R; ++k) { const float y0 = w0a * pr0[k] + w1a * pr0[k + 1] + w2a * pr0[k + 2], y1 = w0b * pr1[k] + w1b * pr1[k + 1] + w2b * pr1[k + 2];
        *(unsigned*)(proj + (size_t)(r0 + k) * LDP + C_BCX + j) = pk2(bflo(bg[k]) * y0, bfhi(bg[k]) * y1);
        const int r = r0 + k;
        if (r < NPR) { const int l = r & 4095; if (l >= 4094) { float* o = P.out + O_PSCC + ((size_t)((layer * 4 + (r >> 12)) * 2 + (l - 4094))) * 1024 + j; o[0] = pr0[k + 2]; o[1] = pr1[k + 2]; } }
        else { const int l = (r - NPR) & 3; if (l >= 2) { float* o = P.out + O_SSCC + ((size_t)((layer * 128 + ((r - NPR) >> 2)) * 2 + (l - 2))) * 1024 + j; o[0] = pr0[k + 2]; o[1] = pr1[k + 2]; } }
    }
}
__device__ void shortconv_item(const Params& P, int layer, int item) {
    const int tid = otid();
    if (item < 1024) shortconv_rows<16>(P, layer, item * 16, tid); else shortconv_rows<4>(P, layer, NPR + (item - 1024) * 4, tid);
}
__device__ void ssdconv_state_item(const Params& P, int layer, int sq) {
    const bf16_t* proj = (const bf16_t*)(P.ws + WS_PROJ);
    const size_t rbase = sq < 4 ? (size_t)sq * 4096 + 4093 : (size_t)NPR + (size_t)(sq - 4) * 4 + 1;
    float* o = sq < 4 ? P.out + O_PSSDC + (size_t)(layer * 4 + sq) * 3 * 1536 : P.out + O_SSSDC + (size_t)(layer * 128 + (sq - 4)) * 3 * 1536;
    const int tid = otid(); bf16_t v[9];
#pragma unroll
    for (int i = 0; i < 9; ++i) { const int e = tid + i * 512, t = e / 1536, c = e - t * 1536; v[i] = proj[(rbase + t) * LDP + C_XBC + c]; }
#pragma unroll
    for (int i = 0; i < 9; ++i) o[tid + i * 512] = bf2f(v[i]);
}

template <int R>
__device__ __forceinline__ void ffn_act_unit(const Params& P, int layer, int r0, int oc) {
    const bf16_t* up = (const bf16_t*)(P.ws + WS_PROJ); bf16_t* act = (bf16_t*)(P.ws + WS_PROJ + UP_BYTES);
    const float* cw = P.in[30] + (size_t)layer * 3 * 5632; const float* cb = P.in[31] + (size_t)layer * 5632;
    const int j0 = oc * 8;
    float wa[3][8], wg[3][8], ba[8], bgv[8], pa[2][8], pg[2][8];
#pragma unroll
    for (int k = 0; k < 3; ++k) { const f32x4 a0 = *(const f32x4*)(cw + k * 5632 + j0), a1 = *(const f32x4*)(cw + k * 5632 + j0 + 4), g0 = *(const f32x4*)(cw + k * 5632 + 2816 + j0), g1 = *(const f32x4*)(cw + k * 5632 + 2816 + j0 + 4);
#pragma unroll
        for (int i = 0; i < 4; ++i) { wa[k][i] = a0[i]; wa[k][4 + i] = a1[i]; wg[k][i] = g0[i]; wg[k][4 + i] = g1[i]; } }
    { const f32x4 a0 = *(const f32x4*)(cb + j0), a1 = *(const f32x4*)(cb + j0 + 4), g0 = *(const f32x4*)(cb + 2816 + j0), g1 = *(const f32x4*)(cb + 2816 + j0 + 4);
#pragma unroll
      for (int i = 0; i < 4; ++i) { ba[i] = a0[i]; ba[4 + i] = a1[i]; bgv[i] = g0[i]; bgv[4 + i] = g1[i]; } }
    const int ss = seq_start(r0); const bool havePrev = (r0 - 2 >= ss);
#pragma unroll
    for (int k = 0; k < 2; ++k) {
        if (havePrev) { const u32x4 ua = *(const u32x4*)(up + (size_t)(r0 - 2 + k) * 5632 + j0), ug = *(const u32x4*)(up + (size_t)(r0 - 2 + k) * 5632 + 2816 + j0);
#pragma unroll
            for (int i = 0; i < 4; ++i) { pa[k][2 * i] = bflo(ua[i]); pa[k][2 * i + 1] = bfhi(ua[i]); pg[k][2 * i] = bflo(ug[i]); pg[k][2 * i + 1] = bfhi(ug[i]); } }
        else if (r0 >= NPR) { const float* pp = P.in[9] + ((size_t)(layer * 128 + ((r0 - NPR) >> 2)) * 2 + k) * 5632;
#pragma unroll
            for (int i = 0; i < 8; ++i) { pa[k][i] = pp[j0 + i]; pg[k][i] = pp[2816 + j0 + i]; } }
        else {
#pragma unroll
            for (int i = 0; i < 8; ++i) { pa[k][i] = 0.f; pg[k][i] = 0.f; } } }
#pragma unroll
    for (int kb = 0; kb < R; kb += 4) { u32x4 ua[4], ug[4];
#pragma unroll
        for (int q = 0; q < 4; ++q) { ua[q] = *(const u32x4*)(up + (size_t)(r0 + kb + q) * 5632 + j0); ug[q] = *(const u32x4*)(up + (size_t)(r0 + kb + q) * 5632 + 2816 + j0); }
#pragma unroll
        for (int q = 0; q < 4; ++q) { const int r = r0 + kb + q; float ca[8], cgv[8], o[8];
#pragma unroll
            for (int i = 0; i < 4; ++i) { ca[2 * i] = bflo(ua[q][i]); ca[2 * i + 1] = bfhi(ua[q][i]); cgv[2 * i] = bflo(ug[q][i]); cgv[2 * i + 1] = bfhi(ug[q][i]); }
#pragma unroll
            for (int i = 0; i < 8; ++i) { const float a = ba[i] + wa[0][i] * pa[0][i] + wa[1][i] * pa[1][i] + wa[2][i] * ca[i], g = bgv[i] + wg[0][i] * pg[0][i] + wg[1][i] * pg[1][i] + wg[2][i] * cgv[i];
                o[i] = silu_fast(a) * g; pa[0][i] = pa[1][i]; pa[1][i] = ca[i]; pg[0][i] = pg[1][i]; pg[1][i] = cgv[i]; }
            u32x4 ov; ov[0] = pk2(o[0], o[1]); ov[1] = pk2(o[2], o[3]); ov[2] = pk2(o[4], o[5]); ov[3] = pk2(o[6], o[7]);
            *(u32x4*)(act + (size_t)r * 2816 + j0) = ov;
            float* so = nullptr;
            if (r < NPR) { const int l = r & 4095; if (l >= 4094) so = P.out + O_PFFC + ((size_t)((layer * 4 + (r >> 12)) * 2 + (l - 4094))) * 5632; }
            else { const int l = (r - NPR) & 3; if (l >= 2) so = P.out + O_SFFC + ((size_t)((layer * 128 + ((r - NPR) >> 2)) * 2 + (l - 2))) * 5632; }
            if (so) {
#pragma unroll
                for (int i = 0; i < 8; ++i) { so[j0 + i] = ca[i]; so[2816 + j0 + i] = cgv[i]; } }
        } }
}
__device__ void phase_ffn_act(const Params& P, int layer) {
    constexpr int NU_P = 2048 * 352, NU_S = 128 * 352;
    for (int u = blockIdx.x * 512 + otid(); u < NU_P + NU_S; u += gridDim.x * 512) {
        if (u < NU_P) { const int rb = u / 352, oc = u - rb * 352; ffn_act_unit<8>(P, layer, rb * 8, oc); }
        else { const int v = u - NU_P, sq = v / 352, oc = v - sq * 352; ffn_act_unit<4>(P, layer, NPR + sq * 4, oc); }
    }
}

__device__ __forceinline__ void sgemm_partial(const bf16_t* A, int lda, const bf16_t* Bt, int ldb, int K, int row0, int col0, float* red, int tid) {
    const int w = tid >> 6, lane = tid & 63, fr = lane & 15, fq = lane >> 4;
    const int kw = K >> 3, k0 = w * kw;
    f32x4 acc[2][4];
#pragma unroll
    for (int mt = 0; mt < 2; ++mt)
#pragma unroll
        for (int nt = 0; nt < 4; ++nt) acc[mt][nt] = (f32x4){0.f, 0.f, 0.f, 0.f};
    const bf16_t* ap = A + (size_t)(row0 + fr) * lda + k0 + fq * 8;
    const bf16_t* bp = Bt + (size_t)(col0 + fr) * ldb + k0 + fq * 8;
    const int nks = kw >> 5;
#pragma unroll 4
    for (int ks = 0; ks < nks; ++ks) { bf16x8 a[2], b[4];
#pragma unroll
        for (int mt = 0; mt < 2; ++mt) a[mt] = *(const bf16x8*)(ap + (size_t)mt * 16 * lda + ks * 32);
#pragma unroll
        for (int nt = 0; nt < 4; ++nt) b[nt] = *(const bf16x8*)(bp + (size_t)nt * 16 * ldb + ks * 32);
#pragma unroll
        for (int mt = 0; mt < 2; ++mt)
#pragma unroll
            for (int nt = 0; nt < 4; ++nt) acc[mt][nt] = __builtin_amdgcn_mfma_f32_16x16x32_bf16(a[mt], b[nt], acc[mt][nt], 0, 0, 0); }
#pragma unroll
    for (int mt = 0; mt < 2; ++mt)
#pragma unroll
        for (int nt = 0; nt < 4; ++nt)
#pragma unroll
            for (int j = 0; j < 4; ++j) red[(w * 32 + mt * 16 + fq * 4 + j) * 64 + nt * 16 + fr] = acc[mt][nt][j];
}
__device__ __forceinline__ f32x4 sgemm_reduce(const float* red, int tid) {
    const int row = tid >> 4, c4 = (tid & 15) * 4; f32x4 sacc = (f32x4){0.f, 0.f, 0.f, 0.f};
#pragma unroll
    for (int w = 0; w < 8; ++w) sacc += *(const f32x4*)(red + (w * 32 + row) * 64 + c4);
    return sacc;
}
__device__ void sample_branch(const Params& P, int layer, float* red) {
    const int tid = otid(); const bf16_t* proj = (const bf16_t*)(P.ws + WS_PROJ); bf16_t* hbuf = (bf16_t*)(P.ws + WS_H);
    for (int piece = blockIdx.x; piece < 256; piece += gridDim.x) {
        const int row0 = (piece >> 4) * 32, col0 = (piece & 15) * 64; const size_t r = NPR + row0 + (tid >> 4); const int c = col0 + (tid & 15) * 4;
        f32x4 sum = (f32x4){0.f, 0.f, 0.f, 0.f};
        for (int z = 0; z < 4; ++z) {
            const int ao = z == 0 ? C_Z : (z == 1 ? C_BCX : (z == 2 ? C_Q : C_UV));
            __syncthreads();
            sgemm_partial(proj + (size_t)NPR * LDP + ao, LDP, (const bf16_t*)(P.ws + WS_WBR) + (size_t)(layer * 4 + z) * 1048576, 1024, 1024, row0, col0, red, tid);
            __syncthreads();
            const f32x4 v = sgemm_reduce(red, tid);
            const u32x2 gv = *(const u32x2*)(proj + r * LDP + C_GATE + z * 1024 + c);
            sum[0] += bflo(gv[0]) * v[0]; sum[1] += bfhi(gv[0]) * v[1]; sum[2] += bflo(gv[1]) * v[2]; sum[3] += bfhi(gv[1]) * v[3];
        }
        u32x2 o; o[0] = pk2(sum[0], sum[1]); o[1] = pk2(sum[2], sum[3]); *(u32x2*)(hbuf + r * 1024 + c) = o;
    }
}
__device__ void sample_resid(const Params& P, const bf16_t* A, int lda, const bf16_t* Bt, int K, const float* xin_s, float* xout, const float* ga, float* red) {
    const int tid = otid();
    for (int piece = blockIdx.x; piece < 256; piece += gridDim.x) {
        const int row0 = (piece >> 4) * 32, col0 = (piece & 15) * 64; const int rs = row0 + (tid >> 4), c = col0 + (tid & 15) * 4;
        __syncthreads();
        sgemm_partial(A, lda, Bt, K, K, row0, col0, red, tid);
        __syncthreads();
        const f32x4 v = sgemm_reduce(red, tid);
        const f32x4 xv = *(const f32x4*)(xin_s + (size_t)rs * 1024 + c), gv = *(const f32x4*)(ga + (size_t)(4 + (rs >> 2)) * 6144 + c);
        *(f32x4*)(xout + (size_t)(NPR + rs) * 1024 + c) = xv + gv * v;
    }
}

__device__ __forceinline__ void grid_bar(unsigned* ctr, unsigned& epoch) {
    asm volatile("s_waitcnt vmcnt(0) lgkmcnt(0)" ::: "memory");
    __syncthreads();
    epoch += 1;
    if (threadIdx.x == 0) {
        __builtin_amdgcn_fence(__ATOMIC_RELEASE, "agent");
        asm volatile("s_waitcnt vmcnt(0) lgkmcnt(0)" ::: "memory");
        __hip_atomic_fetch_add(ctr, 1u, __ATOMIC_RELAXED, __HIP_MEMORY_SCOPE_AGENT);
        const unsigned target = epoch * gridDim.x;
        while (__hip_atomic_load(ctr, __ATOMIC_RELAXED, __HIP_MEMORY_SCOPE_AGENT) < target) __builtin_amdgcn_s_sleep(1);
        __builtin_amdgcn_fence(__ATOMIC_ACQUIRE, "agent");
        asm volatile("s_waitcnt vmcnt(0) lgkmcnt(0)" ::: "memory");
    }
    __syncthreads();
}

#ifndef PHMASK
#define PHMASK 0xFFFFFFFF
#endif
#define EN(x) ((PHMASK >> (x)) & 1)
#ifndef DRYM
#define DRYM 0
#endif
#ifndef DBL
#define DBL 0
#endif
#define REP(x) (((DBL >> (x)) & 1) ? 2 : 1)
constexpr int PH_PER_LAYER = 11, N_PHASES = 2 + 4 * PH_PER_LAYER + 1;

__global__ void __launch_bounds__(512, 2) mega_fwd(Params P) {
    extern __shared__ __attribute__((aligned(16))) unsigned char lds_raw[];
    cg::grid_group grid = cg::this_grid();
    LAS unsigned char* ldsl = (LAS unsigned char*)lds_raw;
    bf16_t* proj = (bf16_t*)(P.ws + WS_PROJ);
    bf16_t* hbuf = (bf16_t*)(P.ws + WS_H);
    float* xbuf = P.out;
    float* mod = (float*)(P.ws + WS_MOD);
    unsigned* barctr = (unsigned*)(P.ws + WS_BAR); unsigned epoch = 0;
    for (int ph = P.ph_lo; ph < P.ph_hi; ++ph) {
        if (ph == 0) { for (int rp = 0; rp < REP(0); ++rp) phase_convert(P, (float*)lds_raw); }
        else if (ph == 1) {
            Gemm g{(const bf16_t*)(P.ws + WS_CACT), (const bf16_t*)(P.ws + WS_WADA), 1024, 1024, 1024, 1, 96, 0, 0, 0, 0, 0};
            EpiMod E{mod, P.in[11]};
            for (int rp = 0; rp < REP(1); ++rp) gemm_phase<EpiMod, 1>(ldsl, g, E);
        }
        else if (ph == N_PHASES - 1) { phase_final_norm(xbuf, P.in[33]); }
        else {
            const int layer = (ph - 2) / PH_PER_LAYER, sp = (ph - 2) % PH_PER_LAYER;
            const float* modL = mod + (size_t)layer * NCOND * 6144;
            const float* xin_p = layer == 0 ? P.in[0] : xbuf; const float* xin_s = layer == 0 ? P.in[1] : xbuf + (size_t)NPR * 1024;
            if (sp == 0) { for (int rp = 0; rp < REP(16); ++rp) phase_norm(xin_p, xin_s, P.in[12] + layer * 1024, modL, 0, 1024, hbuf); }
            else if (sp == 1) {
                Gemm g{hbuf, (const bf16_t*)(P.ws + WS_WIN) + (size_t)layer * 13568 * 1024, 1024, 1024, 1024, 66, 53, 0, 0, 0, 0, 0};
                EpiProj E{proj};
                for (int rp = 0; rp < REP(2); ++rp) gemm_phase<EpiProj, 1>(ldsl, g, E);
            }
            else if (sp == 2) {
                for (int it = blockIdx.x; it < 3972 + 256; it += gridDim.x) {
                    if (it < 512) { for (int rp = 0; rp < REP(3); ++rp) ssd_pass1_item(P, layer, it, lds_raw); }
                    else if (it < 1024) { for (int rp = (DRYM & 1) ? 0 : 1; rp < 2; ++rp) attn_prompt_item(P, layer, it - 512, lds_raw, rp == 0 && P.ph_lo == 0); }
                    else if (it < 1536) { for (int rp = (DRYM & 2) ? 0 : 1; rp < 2; ++rp) attn_sample_item(P, layer, it - 1024, (float*)lds_raw, rp == 0 && P.ph_lo == 0); }
                    else if (it < 2560) { for (int rp = (DRYM & 4) ? 0 : 1; rp < 2; ++rp) gmlp_prompt_item(P, layer, it - 1536, lds_raw, rp == 0 && P.ph_lo == 0); }
                    else if (it < 2688) { if (EN(8)) gmlp_sample_item(P, layer, it - 2560, (float*)lds_raw); }
                    else if (it < 3840) { if (EN(9)) shortconv_item(P, layer, it - 2688); }
                    else if (it < 3972) ssdconv_state_item(P, layer, it - 3840);
                    else ssd_item<2>(P, layer, it - 3972, (float*)lds_raw);
                }
            }
            else if (sp == 3) { phase_ssd_scan(P, layer); }
            else if (sp == 4) { for (int it = blockIdx.x; it < 512; it += gridDim.x) ssd_pass3_item(P, layer, it, lds_raw); }
            else if (sp == 5) {
                Gemm g{proj, (const bf16_t*)(P.ws + WS_WBR) + (size_t)layer * 4 * 1048576, LDP, 1024, 1024, 64, 4, C_Z, C_BCX, C_Q, C_UV, (size_t)1048576};
                EpiBranch E{proj, (float*)(P.ws + WS_MSUM), hbuf};
                for (int rp = 0; rp < REP(11); ++rp) gemm_phase<EpiBranch, 4>(ldsl, g, E);
                sample_branch(P, layer, (float*)lds_raw);
            }
            else if (sp == 6) {
                Gemm g{hbuf, (const bf16_t*)(P.ws + WS_WO) + (size_t)layer * 1048576, 1024, 1024, 1024, 64, 4, 0, 0, 0, 0, 0};
                EpiResid E{xin_p, xin_s, xbuf, modL + 2048};
                if (EN(12)) gemm_phase<EpiResid, 1>(ldsl, g, E);
                sample_resid(P, hbuf + (size_t)NPR * 1024, 1024, (const bf16_t*)(P.ws + WS_WO) + (size_t)layer * 1048576, 1024, xin_s, xbuf, modL + 2048, (float*)lds_raw);
            }
            else if (sp == 7) { for (int rp = 0; rp < REP(16); ++rp) phase_norm(xbuf, xbuf + (size_t)NPR * 1024, P.in[28] + layer * 1024, modL, 3072, 4096, hbuf); }
            else if (sp == 8) {
                Gemm g{hbuf, (const bf16_t*)(P.ws + WS_WUP) + (size_t)layer * 5632 * 1024, 1024, 1024, 1024, 66, 22, 0, 0, 0, 0, 0};
                EpiUp E{proj};
                for (int rp = 0; rp < REP(13); ++rp) gemm_phase<EpiUp, 1>(ldsl, g, E);
            }
            else if (sp == 9) { for (int rp = 0; rp < REP(14); ++rp) phase_ffn_act(P, layer); }
            else {
                Gemm g{(const bf16_t*)(P.ws + WS_PROJ + UP_BYTES), (const bf16_t*)(P.ws + WS_WDN) + (size_t)layer * 1024 * 2816, 2816, 2816, 2816, 64, 4, 0, 0, 0, 0, 0};
                EpiResid E{xbuf, xbuf + (size_t)NPR * 1024, xbuf, modL + 5120};
                if (EN(15)) gemm_phase<EpiResid, 1>(ldsl, g, E);
                sample_resid(P, (const bf16_t*)(P.ws + WS_PROJ + UP_BYTES) + (size_t)NPR * 2816, 2816, (const bf16_t*)(P.ws + WS_WDN) + (size_t)layer * 1024 * 2816, 2816, xbuf + (size_t)NPR * 1024, xbuf, modL + 5120, (float*)lds_raw);
            }
        }
        if (ph + 1 < P.ph_hi) { if (ph == 0) grid.sync(); else grid_bar(barctr, epoch); }
    }
}

extern "C" void kernel_launch(void* const* d_in, const int* in_sizes, int n_in, void* d_out, int out_size, void* d_ws, size_t ws_size, hipStream_t stream) {
    static int grid_blocks = 0;
    if (grid_blocks == 0) {
        if (n_in != 34 || (size_t)out_size != O_END || ws_size < WS_END + 256) { fprintf(stderr, "kernel_launch: unexpected sizes n_in %d out %d ws %zu (need %zu)\n", n_in, out_size, ws_size, (size_t)WS_END); grid_blocks = -1; return; }
        int dev = 0, cus = 0, per_cu = 0;
        (void)hipGetDevice(&dev); (void)hipDeviceGetAttribute(&cus, hipDeviceAttributeMultiprocessorCount, dev);
        if (hipFuncSetAttribute((const void*)mega_fwd, hipFuncAttributeMaxDynamicSharedMemorySize, LDS_BYTES) != hipSuccess) { fprintf(stderr, "hipFuncSetAttribute failed\n"); grid_blocks = -1; return; }
        if (hipOccupancyMaxActiveBlocksPerMultiprocessor(&per_cu, (const void*)mega_fwd, 512, LDS_BYTES) != hipSuccess || per_cu < 1) per_cu = 1;
        grid_blocks = cus * 1;
    }
    if (grid_blocks < 0) return;
    Params p{};
    for (int i = 0; i < 34; ++i) p.in[i] = (const float*)d_in[i];
    p.out = (float*)d_out; p.ws = (unsigned char*)d_ws; p.ph_lo = 0; p.ph_hi = N_PHASES;
    (void)hipMemsetAsync((unsigned char*)d_ws + WS_BAR, 0, 256, stream);
    void* args[] = {&p};
    hipError_t e = hipLaunchCooperativeKernel((const void*)mega_fwd, dim3(grid_blocks), dim3(512), args, LDS_BYTES, stream);
    if (e != hipSuccess) fprintf(stderr, "cooperative launch failed: %s (grid %d)\n", hipGetErrorString(e), grid_blocks);
}
```

```cpp
#include <hip/hip_runtime.h>
#include <hip/hip_cooperative_groups.h>
#include <cstdio>
namespace cg = cooperative_groups;

typedef unsigned short bf16_t;
typedef short bf16x8 __attribute__((ext_vector_type(8)));
typedef float f32x4 __attribute__((ext_vector_type(4)));
typedef unsigned u32x4 __attribute__((ext_vector_type(4)));
typedef unsigned u32x2 __attribute__((ext_vector_type(2)));
#define LAS __attribute__((address_space(3)))

constexpr int NTOK = 16896, NPR = 16384;
constexpr int LDP = 13568;
constexpr int C_Z = 0, C_XBC = 1024, C_DTR = 2560, C_BCX = 2576, C_Q = 5648, C_K = 6672, C_V = 6928, C_UV = 7184, C_GATE = 9232, C_END = 13328;
constexpr int NCOND = 132;
constexpr float EPSF = 1e-6f;

constexpr size_t WS_WIN = 0;
constexpr size_t WS_WBR = WS_WIN + (size_t)4 * 13568 * 1024 * 2;
constexpr size_t WS_WO = WS_WBR + (size_t)16 * 1024 * 1024 * 2;
constexpr size_t WS_WUP = WS_WO + (size_t)4 * 1024 * 1024 * 2;
constexpr size_t WS_WDN = WS_WUP + (size_t)4 * 5632 * 1024 * 2;
constexpr size_t WS_WADA = WS_WDN + (size_t)4 * 1024 * 2816 * 2;
constexpr size_t WS_CACT = WS_WADA + (size_t)4 * 6144 * 1024 * 2;
constexpr size_t WS_MOD = WS_CACT + (size_t)256 * 1024 * 2;
constexpr size_t WS_H = WS_MOD + (size_t)4 * NCOND * 6144 * 4;
constexpr size_t WS_MSUM = WS_H + (size_t)NTOK * 1024 * 2;
constexpr size_t WS_PROJ = WS_MSUM + (size_t)NTOK * 1024 * 4;
constexpr size_t WS_END = WS_PROJ + (size_t)NTOK * LDP * 2;
constexpr size_t WS_BAR = WS_END;
constexpr size_t WS_SSDST = WS_WADA;
constexpr size_t WS_SSDDEC = WS_WADA + (size_t)4 * 32 * 16 * 4096 * 4;
constexpr size_t UP_BYTES = (size_t)NTOK * 5632 * 2;

constexpr size_t O_YP = 0, O_YS = 16777216, O_PSSM = O_YS + 524288, O_PSSDC = O_PSSM + 1048576, O_PSCC = O_PSSDC + 73728,
                 O_PK = O_PSCC + 32768, O_PV = O_PK + 524288, O_PFFC = O_PV + 524288, O_SSSM = O_PFFC + 180224,
                 O_SSSDC = O_SSSM + 33554432, O_SSCC = O_SSSDC + 2359296, O_SK = O_SSCC + 1048576, O_SV = O_SK + 16777216,
                 O_SFFC = O_SV + 16777216, O_SGMV = O_SFFC + 5767168, O_END = O_SGMV + 2097152;

struct Params { const float* in[34]; float* out; unsigned char* ws; int ph_lo, ph_hi; };

constexpr int LDS_BYTES = 155648;

__device__ __forceinline__ float bf2f(bf16_t v) { return __uint_as_float((unsigned)v << 16); }
__device__ __forceinline__ float bflo(unsigned v) { return __uint_as_float(v << 16); }
__device__ __forceinline__ float bfhi(unsigned v) { return __uint_as_float(v & 0xffff0000u); }
__device__ __forceinline__ unsigned pk2(float lo, float hi) { unsigned r; asm("v_cvt_pk_bf16_f32 %0, %1, %2" : "=v"(r) : "v"(lo), "v"(hi)); return r; }
__device__ __forceinline__ bf16_t f2bf(float f) { return (bf16_t)(pk2(f, 0.f) & 0xffffu); }
__device__ __forceinline__ float wave_sum(float v) {
#pragma unroll
    for (int o = 32; o > 0; o >>= 1) v += __shfl_xor(v, o);
    return v;
}
__device__ __forceinline__ int otid() { int t = threadIdx.x; asm volatile("" : "+v"(t)); return t; }
__device__ __forceinline__ float sigmoidf_(float x) { return 1.f / (1.f + __expf(-x)); }
__device__ __forceinline__ float siluf_(float x) { return x / (1.f + __expf(-x)); }
__device__ __forceinline__ float geluf_(float x) { const float u = 0.7978845608f * (x + 0.044715f * x * x * x); return x / (1.f + __expf(-2.f * u)); }
__device__ __forceinline__ float softplusf_(float x) { return fmaxf(x, 0.f) + log1pf(__expf(-fabsf(x))); }
__device__ __forceinline__ float silu_fast(float x) { return x * __builtin_amdgcn_rcpf(1.f + __expf(-x)); }
__device__ __forceinline__ float sigmoid_fast(float x) { return __builtin_amdgcn_rcpf(1.f + __expf(-x)); }
__device__ __forceinline__ float gelu_fast(float x) { const float u = 0.7978845608f * (x + 0.044715f * x * x * x); return x * __builtin_amdgcn_rcpf(1.f + __expf(-2.f * u)); }
__device__ __forceinline__ int cond_row(int r) { return r < NPR ? (r >> 12) : 4 + ((r - NPR) >> 2); }
__device__ __forceinline__ int seq_start(int r) { return r < NPR ? (r & ~4095) : NPR + ((r - NPR) & ~3); }

constexpr int BM = 256, BK = 64, HALF = 128, HTB = HALF * BK * 2;
__device__ __forceinline__ int lds_byte(int r, int c) { const int st = (r >> 4) * 2 + (c >> 5), rr = r & 15, cc = c & 31, ob = rr * 64 + cc * 2; return st * 1024 + (ob ^ (((ob >> 9) & 1) << 5)); }
__device__ __forceinline__ void stage_rc(int b, int& R, int& C) { const int st = b / 1024, sb = b % 1024, swz = sb ^ (((sb >> 9) & 1) << 5); R = (st >> 1) * 16 + swz / 64; C = (st & 1) * 32 + (swz % 64) / 2; }
__device__ __forceinline__ int perm32(int rho) { const int n = rho >> 4, i = rho & 15; return 8 * (i >> 2) + 4 * n + (i & 3); }

struct Unit { int pm, pn, z; };
struct Gemm { const bf16_t* A; const bf16_t* Bt; int lda, ldb, K, nM, nN; int ao0, ao1, ao2, ao3; size_t zB; };
__device__ __forceinline__ int gemm_aofs(const Gemm& g, int z) { return z == 0 ? g.ao0 : (z == 1 ? g.ao1 : (z == 2 ? g.ao2 : g.ao3)); }

template <int ZN> __device__ __forceinline__ bool unit_next(const Gemm& g, int i, Unit& u) {
    const int tile = i / ZN; u.z = i - tile * ZN;
    const long L = (long)tile * gridDim.x + blockIdx.x; const int nwg = g.nM * g.nN; if (L >= nwg) return false;
    int wgid = (int)L; { const int q = nwg / 8, r = nwg % 8, xcd = wgid % 8, off = wgid / 8; wgid = (xcd < r ? xcd * (q + 1) : r * (q + 1) + (xcd - r) * q) + off; }
    const int nig = 8 * g.nN, gid = wgid / nig, fm = gid * 8, gsz = (g.nM - fm) < 8 ? (g.nM - fm) : 8;
    u.pm = fm + ((wgid % nig) % gsz); u.pn = (wgid % nig) / gsz; return true;
}

template <class Epi, int ZN>
__device__ __forceinline__ void gemm_phase(LAS unsigned char* lds, const Gemm g, const Epi& E) {
    const int tid = otid(), wid = __builtin_amdgcn_readfirstlane(tid >> 6), lane = tid & 63, wr = wid >> 2, wc = wid & 3, fr = lane & 15, fq = lane >> 4;
    const int K = g.K, nt = K / BK;
    unsigned voffA[2], voffB[2];
#pragma unroll
    for (int i = 0; i < 2; ++i) { int R, C; stage_rc(tid * 16 + i * 8192, R, C); const int Rb = Epi::PERM ? ((R & ~31) + perm32(R & 31)) : R;
        voffA[i] = (unsigned)(R * g.lda + C) * 2u; voffB[i] = (unsigned)(Rb * g.ldb + C) * 2u; }
    const size_t kstep = (size_t)(BK * 2);
    const size_t hstepA = (size_t)HALF * g.lda * 2, hstepB = (size_t)HALF * g.ldb * 2;
    const size_t tstepA = 2 * hstepA, tstepB = 2 * hstepB;
    const unsigned ldsw = (unsigned)wid * 1024u;
    const int aoff = lds_byte(wr * 64 + fr, fq * 8), boff = lds_byte(wc * 32 + fr, fq * 8);
#define PG8_SA(b, h) (((b) * 2 + (h)) * HTB)
#define PG8_SB(b, h) ((4 + (b) * 2 + (h)) * HTB)
#define PG8_STAGE(bufoff, gbase, voff) do { _Pragma("unroll") for (int _i = 0; _i < 2; ++_i) \
        __builtin_amdgcn_global_load_lds((const unsigned*)((const char*)(gbase) + (voff)[_i]), (LAS unsigned*)(lds + (bufoff) + ldsw + _i * 8192), 16, 0, 0); } while (0)
#define PG8_LDA(dst, b, h) do { _Pragma("unroll") for (int m = 0; m < 4; ++m) _Pragma("unroll") for (int k = 0; k < 2; ++k) dst[m][k] = *(const LAS bf16x8*)(lds + PG8_SA(b, h) + aoff + m * 2048 + k * 1024); } while (0)
#define PG8_LDB(dst, b, h) do { _Pragma("unroll") for (int n = 0; n < 2; ++n) _Pragma("unroll") for (int k = 0; k < 2; ++k) dst[n][k] = *(const LAS bf16x8*)(lds + PG8_SB(b, h) + boff + n * 2048 + k * 1024); } while (0)
#define PG8_MMA(ai, bj, At, Bt) do { __builtin_amdgcn_s_setprio(1); _Pragma("unroll") for (int m = 0; m < 4; ++m) _Pragma("unroll") for (int n = 0; n < 2; ++n) _Pragma("unroll") for (int k = 0; k < 2; ++k) \
        acc[ai][bj][m][n] = __builtin_amdgcn_mfma_f32_16x16x32_bf16(Bt[n][k], At[m][k], acc[ai][bj][m][n], 0, 0, 0); __builtin_amdgcn_s_setprio(0); } while (0)
#define PG8_WAIT_V(n) asm volatile("s_waitcnt vmcnt(" #n ")" ::: "memory")
#define PG8_WAIT_L(n) asm volatile("s_waitcnt lgkmcnt(" #n ")" ::: "memory")
#define PG8_BAR __builtin_amdgcn_s_barrier()
#define PG8_SCHED __builtin_amdgcn_sched_barrier(0)
    Unit cur, nxt; int ui = 0;
    if (!unit_next<ZN>(g, 0, cur)) return;
    f32x4 acc[2][2][4][2];
#pragma unroll
    for (int a = 0; a < 2; ++a)
#pragma unroll
        for (int b = 0; b < 2; ++b)
#pragma unroll
            for (int m = 0; m < 4; ++m)
#pragma unroll
                for (int n = 0; n < 2; ++n) acc[a][b][m][n] = (f32x4){0.f, 0.f, 0.f, 0.f};
    bf16x8 At[4][2], B0[2][2], B1[2][2];
    const char* cA = (const char*)g.A + (size_t)cur.pm * tstepA + (size_t)gemm_aofs(g, cur.z) * 2;
    const char* cB = (const char*)g.Bt + (size_t)cur.pn * tstepB + (size_t)cur.z * g.zB * 2;
    PG8_WAIT_V(0);
    PG8_STAGE(PG8_SB(0, 0), cB, voffB); PG8_STAGE(PG8_SA(0, 0), cA, voffA); PG8_STAGE(PG8_SB(0, 1), cB + hstepB, voffB); PG8_STAGE(PG8_SA(0, 1), cA + hstepA, voffA);
    if (wr == 1) PG8_BAR;
    PG8_WAIT_V(4); PG8_BAR;
    PG8_STAGE(PG8_SB(1, 0), cB + kstep, voffB); PG8_STAGE(PG8_SA(1, 0), cA + kstep, voffA); PG8_STAGE(PG8_SB(1, 1), cB + hstepB + kstep, voffB);
    PG8_WAIT_V(6); PG8_BAR;
    for (;;) {
        const bool has_next = unit_next<ZN>(g, ui + 1, nxt);
        const char* nA = has_next ? (const char*)g.A + (size_t)nxt.pm * tstepA + (size_t)gemm_aofs(g, nxt.z) * 2 : cA;
        const char* nB = has_next ? (const char*)g.Bt + (size_t)nxt.pn * tstepB + (size_t)nxt.z * g.zB * 2 : cB;
        for (int t = 0; t < nt; t += 2) {
            const bool last = (t == nt - 2);
            const char* a1 = cA + (size_t)(t + 1) * kstep;
            const char* a2 = last ? nA : cA + (size_t)(t + 2) * kstep; const char* b2 = last ? nB : cB + (size_t)(t + 2) * kstep;
            const char* a3 = a2 + kstep; const char* b3 = b2 + kstep;
            PG8_LDB(B0, 0, 0); PG8_SCHED; PG8_LDA(At, 0, 0); PG8_STAGE(PG8_SA(1, 1), a1 + hstepA, voffA);
            PG8_WAIT_L(8); PG8_BAR; PG8_WAIT_L(0); PG8_MMA(0, 0, At, B0); PG8_BAR; PG8_SCHED;
            PG8_LDB(B1, 0, 1); PG8_STAGE(PG8_SB(0, 0), b2, voffB);
            PG8_BAR; PG8_WAIT_L(0); PG8_MMA(0, 1, At, B1); PG8_BAR;
            PG8_LDA(At, 0, 1); PG8_STAGE(PG8_SA(0, 0), a2, voffA);
            PG8_BAR; PG8_WAIT_L(0); PG8_MMA(1, 0, At, B0); PG8_BAR; PG8_SCHED;
            PG8_STAGE(PG8_SB(0, 1), b2 + hstepB, voffB);
            PG8_WAIT_V(6); PG8_BAR; PG8_MMA(1, 1, At, B1); PG8_BAR;
            PG8_LDB(B0, 1, 0); PG8_SCHED; PG8_LDA(At, 1, 0); PG8_STAGE(PG8_SA(0, 1), a2 + hstepA, voffA);
            PG8_WAIT_L(8); PG8_BAR; PG8_WAIT_L(0); PG8_MMA(0, 0, At, B0); PG8_BAR; PG8_SCHED;
            PG8_LDB(B1, 1, 1); PG8_STAGE(PG8_SB(1, 0), b3, voffB);
            PG8_BAR; PG8_WAIT_L(0); PG8_MMA(0, 1, At, B1); PG8_BAR;
            PG8_LDA(At, 1, 1); PG8_STAGE(PG8_SA(1, 0), a3, voffA);
            PG8_BAR; PG8_WAIT_L(0); PG8_MMA(1, 0, At, B0); PG8_BAR; PG8_SCHED;
            PG8_STAGE(PG8_SB(1, 1), b3 + hstepB, voffB);
            PG8_WAIT_V(6); PG8_BAR; PG8_MMA(1, 1, At, B1); PG8_BAR;
        }
        E(acc, cur, wr, wc, fr, fq);
        if (!has_next) break;
#pragma unroll
        for (int a = 0; a < 2; ++a)
#pragma unroll
            for (int b = 0; b < 2; ++b)
#pragma unroll
                for (int m = 0; m < 4; ++m)
#pragma unroll
                    for (int n = 0; n < 2; ++n) acc[a][b][m][n] = (f32x4){0.f, 0.f, 0.f, 0.f};
        cur = nxt; cA = nA; cB = nB; ++ui;
    }
    PG8_WAIT_V(0);
    if (wr == 0) PG8_BAR;
    PG8_BAR;
#undef PG8_SA
#undef PG8_SB
#undef PG8_STAGE
#undef PG8_LDA
#undef PG8_LDB
#undef PG8_MMA
#undef PG8_WAIT_V
#undef PG8_WAIT_L
#undef PG8_BAR
#undef PG8_SCHED
}

struct EpiMod {
    static constexpr bool PERM = false;
    float* mod; const float* bada;
    __device__ __forceinline__ void operator()(const f32x4 (&acc)[2][2][4][2], const Unit& u, int wr, int wc, int fr, int fq) const {
#pragma unroll
        for (int ai = 0; ai < 2; ++ai)
#pragma unroll
            for (int m = 0; m < 4; ++m) { const int r = u.pm * BM + ai * HALF + wr * 64 + m * 16 + fr; if (r >= NCOND) continue;
#pragma unroll
                for (int bj = 0; bj < 2; ++bj)
#pragma unroll
                    for (int n = 0; n < 2; ++n) { const int c = u.pn * BM + bj * HALF + wc * 32 + n * 16 + fq * 4; const int layer = c / 6144, cc = c - layer * 6144;
                        const f32x4 b = *(const f32x4*)(bada + c); *(f32x4*)(mod + ((size_t)(layer * NCOND + r)) * 6144 + cc) = acc[ai][bj][m][n] + b; } }
    }
};
struct EpiProj {
    static constexpr bool PERM = true;
    bf16_t* O;
    __device__ __forceinline__ void operator()(const f32x4 (&acc)[2][2][4][2], const Unit& u, int wr, int wc, int fr, int fq) const {
#pragma unroll
        for (int bj = 0; bj < 2; ++bj) { const int c = u.pn * BM + bj * HALF + wc * 32 + fq * 8; const int mode = (c >= C_GATE) ? 2 : (c >= C_UV ? 1 : 0);
#pragma unroll
            for (int ai = 0; ai < 2; ++ai)
#pragma unroll
                for (int m = 0; m < 4; ++m) { const int r = u.pm * BM + ai * HALF + wr * 64 + m * 16 + fr;
                    float v[8];
#pragma unroll
                    for (int i = 0; i < 8; ++i) { float x = acc[ai][bj][m][i >> 2][i & 3]; v[i] = mode == 2 ? sigmoid_fast(x) : (mode == 1 ? gelu_fast(x) : x); }
                    u32x4 o; o[0] = pk2(v[0], v[1]); o[1] = pk2(v[2], v[3]); o[2] = pk2(v[4], v[5]); o[3] = pk2(v[6], v[7]);
                    *(u32x4*)(O + (size_t)r * LDP + c) = o; } }
    }
};
struct EpiUp {
    static constexpr bool PERM = true;
    bf16_t* O;
    __device__ __forceinline__ void operator()(const f32x4 (&acc)[2][2][4][2], const Unit& u, int wr, int wc, int fr, int fq) const {
#pragma unroll
        for (int bj = 0; bj < 2; ++bj) { const int c = u.pn * BM + bj * HALF + wc * 32 + fq * 8;
#pragma unroll
            for (int ai = 0; ai < 2; ++ai)
#pragma unroll
                for (int m = 0; m < 4; ++m) { const int r = u.pm * BM + ai * HALF + wr * 64 + m * 16 + fr;
                    const f32x4 a = acc[ai][bj][m][0], b = acc[ai][bj][m][1];
                    u32x4 o; o[0] = pk2(a[0], a[1]); o[1] = pk2(a[2], a[3]); o[2] = pk2(b[0], b[1]); o[3] = pk2(b[2], b[3]);
                    *(u32x4*)(O + (size_t)r * 5632 + c) = o; } }
    }
};
struct EpiBranch {
    static constexpr bool PERM = true;
    const bf16_t* proj; float* msum; bf16_t* merged;
    __device__ __forceinline__ void operator()(const f32x4 (&acc)[2][2][4][2], const Unit& u, int wr, int wc, int fr, int fq) const {
        const int z = u.z;
#pragma unroll
        for (int bj = 0; bj < 2; ++bj) { const int c = u.pn * BM + bj * HALF + wc * 32 + fq * 8;
#pragma unroll
            for (int ai = 0; ai < 2; ++ai)
#pragma unroll
                for (int m = 0; m < 4; ++m) { const int r = u.pm * BM + ai * HALF + wr * 64 + m * 16 + fr;
                    const u32x4 gv = *(const u32x4*)(proj + (size_t)r * LDP + C_GATE + z * 1024 + c);
                    float* mp = msum + (size_t)r * 1024 + c;
                    f32x4 s0 = (f32x4){0.f, 0.f, 0.f, 0.f}, s1 = s0;
                    if (z > 0) { s0 = *(const f32x4*)mp; s1 = *(const f32x4*)(mp + 4); }
                    const f32x4 a = acc[ai][bj][m][0], b = acc[ai][bj][m][1];
                    s0[0] += bflo(gv[0]) * a[0]; s0[1] += bfhi(gv[0]) * a[1]; s0[2] += bflo(gv[1]) * a[2]; s0[3] += bfhi(gv[1]) * a[3];
                    s1[0] += bflo(gv[2]) * b[0]; s1[1] += bfhi(gv[2]) * b[1]; s1[2] += bflo(gv[3]) * b[2]; s1[3] += bfhi(gv[3]) * b[3];
                    if (z < 3) { *(f32x4*)mp = s0; *(f32x4*)(mp + 4) = s1; }
                    else { u32x4 o; o[0] = pk2(s0[0], s0[1]); o[1] = pk2(s0[2], s0[3]); o[2] = pk2(s1[0], s1[1]); o[3] = pk2(s1[2], s1[3]);
                        *(u32x4*)(merged + (size_t)r * 1024 + c) = o; } } }
    }
};
struct EpiResid {
    static constexpr bool PERM = false;
    const float* xin_p; const float* xin_s; float* xout; const float* ga;
    __device__ __forceinline__ void operator()(const f32x4 (&acc)[2][2][4][2], const Unit& u, int wr, int wc, int fr, int fq) const {
#pragma unroll
        for (int ai = 0; ai < 2; ++ai)
#pragma unroll
            for (int m = 0; m < 4; ++m) { const int r = u.pm * BM + ai * HALF + wr * 64 + m * 16 + fr;
                const float* xr = r < NPR ? xin_p + (size_t)r * 1024 : xin_s + (size_t)(r - NPR) * 1024;
                const float* gr = ga + (size_t)cond_row(r) * 6144;
#pragma unroll
                for (int bj = 0; bj < 2; ++bj)
#pragma unroll
                    for (int n = 0; n < 2; ++n) { const int c = u.pn * BM + bj * HALF + wc * 32 + n * 16 + fq * 4;
                        const f32x4 xv = *(const f32x4*)(xr + c), gv = *(const f32x4*)(gr + c);
                        *(f32x4*)(xout + (size_t)r * 1024 + c) = xv + gv * acc[ai][bj][m][n]; } }
    }
};

struct CTile { const float* src; bf16_t* dst; int K, N, k0, n0; };
__device__ __forceinline__ CTile conv_decode(const Params& P, int t) {
    constexpr int T_IN = 3392, T_BR = 1024, T_O = 256, T_UP = 1408, T_DN = 704, T_ADA = 1536, T_L = T_IN + T_BR + T_O + T_UP + T_DN + T_ADA;
    const int layer = t / T_L; int r = t - layer * T_L; CTile c;
    if (r < T_IN) { c.src = P.in[13] + (size_t)layer * 1024 * 13328; c.dst = (bf16_t*)(P.ws + WS_WIN) + (size_t)layer * 13568 * 1024; c.K = 1024; c.N = 13328; c.k0 = (r / 212) * 64; c.n0 = (r % 212) * 64; return c; }
    r -= T_IN;
    if (r < T_BR) { const int br = r >> 8, q = r & 255; c.src = P.in[26] + (size_t)(layer * 4 + br) * 1048576; c.dst = (bf16_t*)(P.ws + WS_WBR) + (size_t)(layer * 4 + br) * 1048576; c.K = 1024; c.N = 1024; c.k0 = (q >> 4) * 64; c.n0 = (q & 15) * 64; return c; }
    r -= T_BR;
    if (r < T_O) { c.src = P.in[27] + (size_t)layer * 1048576; c.dst = (bf16_t*)(P.ws + WS_WO) + (size_t)layer * 1048576; c.K = 1024; c.N = 1024; c.k0 = (r >> 4) * 64; c.n0 = (r & 15) * 64; return c; }
    r -= T_O;
    if (r < T_UP) { c.src = P.in[29] + (size_t)layer * 1024 * 5632; c.dst = (bf16_t*)(P.ws + WS_WUP) + (size_t)layer * 5632 * 1024; c.K = 1024; c.N = 5632; c.k0 = (r / 88) * 64; c.n0 = (r % 88) * 64; return c; }
    r -= T_UP;
    if (r < T_DN) { c.src = P.in[32] + (size_t)layer * 2816 * 1024; c.dst = (bf16_t*)(P.ws + WS_WDN) + (size_t)layer * 1024 * 2816; c.K = 2816; c.N = 1024; c.k0 = (r >> 4) * 64; c.n0 = (r & 15) * 64; return c; }
    r -= T_DN;
    c.src = P.in[10] + (size_t)layer * 1024 * 6144; c.dst = (bf16_t*)(P.ws + WS_WADA) + (size_t)layer * 6144 * 1024; c.K = 1024; c.N = 6144; c.k0 = (r / 96) * 64; c.n0 = (r % 96) * 64; return c;
}
__device__ void phase_convert(const Params& P, float* T) {
    constexpr int NT = 4 * 8320;
    const int tid = otid();
    int t = blockIdx.x;
    CTile cur = conv_decode(P, t < NT ? t : 0);
    float v[8], nv[8];
#pragma unroll
    for (int e = 0; e < 8; ++e) { const int idx = tid + e * 512, k = idx >> 6, n = idx & 63; v[e] = (t < NT && cur.n0 + n < cur.N) ? cur.src[(size_t)(cur.k0 + k) * cur.N + cur.n0 + n] : 0.f; }
    for (; t < NT; t += gridDim.x) {
        const int tn = t + gridDim.x; const bool hn = tn < NT; const CTile nxt = conv_decode(P, hn ? tn : 0);
#pragma unroll
        for (int e = 0; e < 8; ++e) { const int idx = tid + e * 512, k = idx >> 6, n = idx & 63; nv[e] = (hn && nxt.n0 + n < nxt.N) ? nxt.src[(size_t)(nxt.k0 + k) * nxt.N + nxt.n0 + n] : 0.f; }
#pragma unroll
        for (int e = 0; e < 8; ++e) { const int idx = tid + e * 512, k = idx >> 6, n = idx & 63; T[k * 65 + n] = v[e]; }
        __syncthreads();
        { const int n = tid >> 3, kc = (tid & 7) * 8; float x[8];
#pragma unroll
          for (int j = 0; j < 8; ++j) x[j] = T[(kc + j) * 65 + n];
          u32x4 o; o[0] = pk2(x[0], x[1]); o[1] = pk2(x[2], x[3]); o[2] = pk2(x[4], x[5]); o[3] = pk2(x[6], x[7]);
          *(u32x4*)(cur.dst + (size_t)(cur.n0 + n) * cur.K + cur.k0 + kc) = o; }
        __syncthreads();
#pragma unroll
        for (int e = 0; e < 8; ++e) v[e] = nv[e];
        cur = nxt;
    }
    bf16_t* cact = (bf16_t*)(P.ws + WS_CACT);
    for (int i = blockIdx.x * 512 + otid(); i < 256 * 1024; i += gridDim.x * 512) {
        const int r = i >> 10, c = i & 1023; float v = 0.f;
        if (r < 4) v = siluf_(P.in[2][r * 1024 + c]); else if (r < NCOND) v = siluf_(P.in[3][(r - 4) * 1024 + c]);
        cact[i] = f2bf(v);
    }
}

__device__ void phase_norm(const float* xp, const float* xs, const float* g, const float* modL, int shofs, int scofs, bf16_t* hout) {
    const int tid = otid(); const int w = tid >> 6, lane = tid & 63;
    for (int r = blockIdx.x * 8 + w; r < NTOK; r += gridDim.x * 8) {
        const float* x = r < NPR ? xp + (size_t)r * 1024 : xs + (size_t)(r - NPR) * 1024;
        const float* mr = modL + (size_t)cond_row(r) * 6144;
        f32x4 v[4]; float ss = 0.f;
#pragma unroll
        for (int i = 0; i < 4; ++i) { v[i] = *(const f32x4*)(x + i * 256 + lane * 4); ss += v[i][0] * v[i][0] + v[i][1] * v[i][1] + v[i][2] * v[i][2] + v[i][3] * v[i][3]; }
        ss = wave_sum(ss); const float rs = rsqrtf(ss * (1.f / 1024.f) + EPSF);
#pragma unroll
        for (int i = 0; i < 4; ++i) { const int c = i * 256 + lane * 4;
            const f32x4 gv = *(const f32x4*)(g + c), sc = *(const f32x4*)(mr + scofs + c), sh = *(const f32x4*)(mr + shofs + c);
            f32x4 o = v[i] * rs * gv * (sc + 1.f) + sh;
            u32x2 pk; pk[0] = pk2(o[0], o[1]); pk[1] = pk2(o[2], o[3]);
            *(u32x2*)(hout + (size_t)r * 1024 + c) = pk; }
    }
}
__device__ void phase_final_norm(float* x, const float* g) {
    const int tid = otid(); const int w = tid >> 6, lane = tid & 63;
    for (int r = blockIdx.x * 8 + w; r < NTOK; r += gridDim.x * 8) {
        float* xr = x + (size_t)r * 1024; f32x4 v[4]; float ss = 0.f;
#pragma unroll
        for (int i = 0; i < 4; ++i) { v[i] = *(const f32x4*)(xr + i * 256 + lane * 4); ss += v[i][0] * v[i][0] + v[i][1] * v[i][1] + v[i][2] * v[i][2] + v[i][3] * v[i][3]; }
        ss = wave_sum(ss); const float rs = rsqrtf(ss * (1.f / 1024.f) + EPSF);
#pragma unroll
        for (int i = 0; i < 4; ++i) { const int c = i * 256 + lane * 4; const f32x4 gv = *(const f32x4*)(g + c); *(f32x4*)(xr + c) = v[i] * rs * gv; }
    }
}

template <int MODE>
__device__ void ssd_item(const Params& P, int layer, int item, float* L) {
    const int tid = otid(), w = tid >> 6, lane = tid & 63;
    bf16_t* proj = (bf16_t*)(P.ws + WS_PROJ);
    float* states = (float*)(P.ws + WS_SSDST); float* decs = (float*)(P.ws + WS_SSDDEC);
    int r0, nsteps, half, seq0, b = 0, c = 0, sb = 0;
    if (MODE == 2) { sb = item >> 1; half = item & 1; r0 = NPR + sb * 4; nsteps = 4; seq0 = r0; }
    else { b = item >> 6; c = (item >> 1) & 31; half = item & 1; r0 = b * 4096 + c * 128; nsteps = 128; seq0 = b * 4096; }
    float* XS = L; float* ZS = XS + 16 * 512; float* BS = ZS + 16 * 512; float* CS = BS + 16 * 128; float* DTS = CS + 16 * 128; float* DAS = DTS + 128; float* SSQ = DAS + 128;
    const float* cw = P.in[14] + (size_t)layer * 4 * 1536; const float* cb = P.in[15] + (size_t)layer * 1536;
    const float* prev = P.in[5] + ((size_t)(layer * 128 + sb)) * 3 * 1536;
    const int hd = half * 8 + w, gl = w >> 2;
    float h[64];
    if (MODE == 0) {
#pragma unroll
        for (int n = 0; n < 64; ++n) h[n] = 0.f;
    } else {
        const float* s0p = (MODE == 1) ? states + ((size_t)((b * 32 + c) * 16 + hd)) * 4096 + lane * 64
                                       : P.in[4] + ((size_t)((layer * 128 + sb) * 16 + hd)) * 4096 + lane * 64;
#pragma unroll
        for (int n4 = 0; n4 < 16; ++n4) { const f32x4 v = *(const f32x4*)(s0p + n4 * 4); h[n4 * 4] = v[0]; h[n4 * 4 + 1] = v[1]; h[n4 * 4 + 2] = v[2]; h[n4 * 4 + 3] = v[3]; }
    }
    const float Dh = P.in[18][layer * 16 + hd];
    float decp = 1.f;
    for (int s0 = 0; s0 < nsteps; s0 += 16) {
        const int ns = (nsteps - s0) < 16 ? (nsteps - s0) : 16;
        __syncthreads();
        for (int idx = tid; idx < ns * 768; idx += 512) {
            const int t = idx / 768, ch = idx - t * 768;
            int cx;
            if (ch < 512) cx = half * 512 + ch; else if (ch < 640) cx = 1024 + half * 128 + (ch - 512); else cx = 1280 + half * 128 + (ch - 640);
            float a = cb[cx];
#pragma unroll
            for (int k = 0; k < 4; ++k) { const int step = s0 + t - 3 + k, rr = r0 + step; float raw;
                if (rr >= seq0) raw = bf2f(proj[(size_t)rr * LDP + C_XBC + cx]);
                else raw = (MODE == 2) ? prev[(3 + step) * 1536 + cx] : 0.f;
                a += cw[k * 1536 + cx] * raw; }
            a = siluf_(a);
            if (ch < 512) { XS[t * 512 + ch] = a; if (MODE != 0) ZS[t * 512 + ch] = bf2f(proj[(size_t)(r0 + s0 + t) * LDP + C_Z + cx]); }
            else if (ch < 640) BS[t * 128 + ch - 512] = a; else CS[t * 128 + ch - 640] = a;
        }
        if (tid < ns * 8) { const int t = tid >> 3, ww = tid & 7, hh = half * 8 + ww;
            const float dt = softplusf_(bf2f(proj[(size_t)(r0 + s0 + t) * LDP + C_DTR + hh]) + P.in[16][layer * 16 + hh]);
            DTS[t * 8 + ww] = dt; DAS[t * 8 + ww] = __expf(-dt * __expf(P.in[17][layer * 16 + hh])); }
        __syncthreads();
        for (int t = 0; t < ns; ++t) {
            const float a = DAS[t * 8 + w], dt = DTS[t * 8 + w], xv = XS[t * 512 + w * 64 + lane], xd = xv * dt; decp *= a;
            const f32x4* B4 = (const f32x4*)(BS + t * 128 + gl * 64);
#pragma unroll
            for (int n4 = 0; n4 < 16; ++n4) { const f32x4 bv = B4[n4];
                h[n4 * 4] = a * h[n4 * 4] + xd * bv[0]; h[n4 * 4 + 1] = a * h[n4 * 4 + 1] + xd * bv[1]; h[n4 * 4 + 2] = a * h[n4 * 4 + 2] + xd * bv[2]; h[n4 * 4 + 3] = a * h[n4 * 4 + 3] + xd * bv[3]; }
            if (MODE != 0) {
                const f32x4* C4 = (const f32x4*)(CS + t * 128 + gl * 64); float y0 = 0.f, y1 = 0.f;
#pragma unroll
                for (int n4 = 0; n4 < 16; ++n4) { const f32x4 cv = C4[n4]; y0 += h[n4 * 4] * cv[0] + h[n4 * 4 + 2] * cv[2]; y1 += h[n4 * 4 + 1] * cv[1] + h[n4 * 4 + 3] * cv[3]; }
                float y = y0 + y1 + Dh * xv; y *= siluf_(ZS[t * 512 + w * 64 + lane]);
                const float sq = wave_sum(y * y); if (lane == 0) SSQ[(s0 + t) * 8 + w] = sq;
                proj[(size_t)(r0 + s0 + t) * LDP + C_Z + hd * 64 + lane] = f2bf(y);
            }
        }
    }
    if (MODE == 0) {
        float* sp = states + ((size_t)((b * 32 + c) * 16 + hd)) * 4096 + lane * 64;
#pragma unroll
        for (int n4 = 0; n4 < 16; ++n4) *(f32x4*)(sp + n4 * 4) = (f32x4){h[n4 * 4], h[n4 * 4 + 1], h[n4 * 4 + 2], h[n4 * 4 + 3]};
        if (lane == 0) decs[(b * 32 + c) * 16 + hd] = decp;
    }
    if (MODE == 2) {
        float* sp = P.out + O_SSSM + ((size_t)((layer * 128 + sb) * 16 + hd)) * 4096 + lane * 64;
#pragma unroll
        for (int n4 = 0; n4 < 16; ++n4) *(f32x4*)(sp + n4 * 4) = (f32x4){h[n4 * 4], h[n4 * 4 + 1], h[n4 * 4 + 2], h[n4 * 4 + 3]};
    }
    if (MODE != 0) {
        __syncthreads();
        const float ng = P.in[19][layer * 1024 + hd * 64 + lane];
        for (int t = 0; t < nsteps; ++t) {
            const float tot = SSQ[t * 8 + gl * 4] + SSQ[t * 8 + gl * 4 + 1] + SSQ[t * 8 + gl * 4 + 2] + SSQ[t * 8 + gl * 4 + 3];
            const float sc = rsqrtf(tot * (1.f / 256.f) + EPSF) * ng;
            bf16_t* ap = proj + (size_t)(r0 + t) * LDP + C_Z + hd * 64 + lane; *ap = f2bf(bf2f(*ap) * sc);
        }
    }
}

__device__ __forceinline__ int xt_idx(int row, int t) { return row * 136 + ((((t >> 3) ^ ((row >> 3) & 15)) << 3) | (t & 7)); }
__device__ __forceinline__ void ssd_stage_dt(const Params& P, int layer, const bf16_t* proj, size_t r0, int g, float* DT, float* ACS, int tid) {
    { const int hh = tid >> 7, t = tid & 127, hd = g * 4 + hh;
      const float dt = softplusf_(bf2f(proj[(r0 + t) * LDP + C_DTR + hd]) + P.in[16][layer * 16 + hd]);
      DT[hh * 128 + t] = dt; ACS[hh * 128 + t] = -dt * __expf(P.in[17][layer * 16 + hd]); }
    __syncthreads();
    if (tid < 256) { const int hh = tid >> 6, l = tid & 63; const float a0 = ACS[hh * 128 + 2 * l], a1 = ACS[hh * 128 + 2 * l + 1]; float sum = a0 + a1;
#pragma unroll
        for (int o = 1; o < 64; o <<= 1) { const float v = __shfl_up(sum, o); if (l >= o) sum += v; }
        ACS[hh * 128 + 2 * l] = sum - a1; ACS[hh * 128 + 2 * l + 1] = sum; }
    __syncthreads();
}
template <int PASS>
__device__ __forceinline__ void ssd_stage_conv(const Params& P, int layer, const bf16_t* proj, size_t r0, bool first, int g, const float* DT, const float* ACS, bf16_t* XT4, bf16_t* Bx, bf16_t* Cs, int tid) {
    const int slot = tid & 63, seg = tid >> 6;
    if (slot < (PASS ? 48 : 40)) {
        int cx; if (slot < 32) cx = g * 256 + slot * 8; else if (slot < 40) cx = 1024 + g * 64 + (slot - 32) * 8; else cx = 1280 + g * 64 + (slot - 40) * 8;
        const float* cw = P.in[14] + (size_t)layer * 4 * 1536 + cx; const float* cb = P.in[15] + (size_t)layer * 1536 + cx;
        float wt[4][8], bb[8], win[3][8];
#pragma unroll
        for (int k = 0; k < 4; ++k) { const f32x4 a = *(const f32x4*)(cw + k * 1536), c = *(const f32x4*)(cw + k * 1536 + 4);
#pragma unroll
            for (int i = 0; i < 4; ++i) { wt[k][i] = a[i]; wt[k][4 + i] = c[i]; } }
        { const f32x4 a = *(const f32x4*)cb, c = *(const f32x4*)(cb + 4);
#pragma unroll
          for (int i = 0; i < 4; ++i) { bb[i] = a[i]; bb[4 + i] = c[i]; } }
        const int t0 = seg * 16;
#pragma unroll
        for (int k = 0; k < 3; ++k) { u32x4 raw = (u32x4){0u, 0u, 0u, 0u};
            if (!(first && seg == 0)) raw = *(const u32x4*)(proj + (r0 + t0 - 3 + k) * LDP + C_XBC + cx);
#pragma unroll
            for (int i = 0; i < 4; ++i) { win[k][2 * i] = bflo(raw[i]); win[k][2 * i + 1] = bfhi(raw[i]); } }
        u32x4 cur4[4], nxt4[4];
#pragma unroll
        for (int q = 0; q < 4; ++q) { cur4[q] = *(const u32x4*)(proj + (r0 + t0 + q) * LDP + C_XBC + cx); nxt4[q] = cur4[q]; }
        for (int gq = 0; gq < 4; ++gq) {
            if (gq < 3) {
#pragma unroll
                for (int q = 0; q < 4; ++q) nxt4[q] = *(const u32x4*)(proj + (r0 + t0 + gq * 4 + 4 + q) * LDP + C_XBC + cx); }
#pragma unroll
            for (int q = 0; q < 4; ++q) {
                const int t = t0 + gq * 4 + q; const u32x4 raw = cur4[q];
                float cur[8], o[8];
#pragma unroll
                for (int i = 0; i < 4; ++i) { cur[2 * i] = bflo(raw[i]); cur[2 * i + 1] = bfhi(raw[i]); }
#pragma unroll
                for (int i = 0; i < 8; ++i) { o[i] = siluf_(bb[i] + wt[0][i] * win[0][i] + wt[1][i] * win[1][i] + wt[2][i] * win[2][i] + wt[3][i] * cur[i]); win[0][i] = win[1][i]; win[1][i] = win[2][i]; win[2][i] = cur[i]; }
                if (slot < 32) { const int hh = slot >> 3, p0 = (slot & 7) * 8; float sc = DT[hh * 128 + t]; if (PASS == 0) sc *= __expf(ACS[hh * 128 + 127] - ACS[hh * 128 + t]);
#pragma unroll
                    for (int i = 0; i < 8; ++i) XT4[xt_idx(hh * 64 + p0 + i, t)] = f2bf(o[i] * sc); }
                else if (slot < 40) { const int n0 = (slot - 32) * 8;
                    if (PASS == 0) {
#pragma unroll
                        for (int i = 0; i < 8; ++i) Bx[xt_idx(n0 + i, t)] = f2bf(o[i]); }
                    else { u32x4 pk; pk[0] = pk2(o[0], o[1]); pk[1] = pk2(o[2], o[3]); pk[2] = pk2(o[4], o[5]); pk[3] = pk2(o[6], o[7]); *(u32x4*)(Bx + t * 72 + n0) = pk; } }
                else { const int n0 = (slot - 40) * 8; u32x4 pk; pk[0] = pk2(o[0], o[1]); pk[1] = pk2(o[2], o[3]); pk[2] = pk2(o[4], o[5]); pk[3] = pk2(o[6], o[7]); *(u32x4*)(Cs + t * 72 + n0) = pk; }
            }
#pragma unroll
            for (int q = 0; q < 4; ++q) cur4[q] = nxt4[q];
        }
    }
}
__device__ void ssd_pass1_item(const Params& P, int layer, int item, unsigned char* lds) {
    const int tid = otid(), w = __builtin_amdgcn_readfirstlane(tid >> 6), lane = tid & 63, fr = lane & 15, fq = lane >> 4;
    const int b = item >> 7, c = (item >> 2) & 31, g = item & 3; const size_t r0 = (size_t)b * 4096 + (size_t)c * 128;
    const bf16_t* proj = (const bf16_t*)(P.ws + WS_PROJ);
    float* states = (float*)(P.ws + WS_SSDST); float* decs = (float*)(P.ws + WS_SSDDEC);
    bf16_t* XT4 = (bf16_t*)lds; bf16_t* BT = XT4 + 256 * 136; float* DT = (float*)(BT + 64 * 136); float* ACS = DT + 512;
    __syncthreads();
    ssd_stage_dt(P, layer, proj, r0, g, DT, ACS, tid);
    ssd_stage_conv<0>(P, layer, proj, r0, c == 0, g, DT, ACS, XT4, BT, nullptr, tid);
    __syncthreads();
    const int hh = w >> 1, pb = (w & 1) * 2;
    f32x4 acc[2][4];
#pragma unroll
    for (int pi = 0; pi < 2; ++pi)
#pragma unroll
        for (int nt = 0; nt < 4; ++nt) acc[pi][nt] = (f32x4){0.f, 0.f, 0.f, 0.f};
#pragma unroll
    for (int ks = 0; ks < 4; ++ks) { bf16x8 a[2];
#pragma unroll
        for (int pi = 0; pi < 2; ++pi) a[pi] = *(const bf16x8*)(XT4 + xt_idx(hh * 64 + (pb + pi) * 16 + fr, ks * 32 + fq * 8));
#pragma unroll
        for (int nt = 0; nt < 4; ++nt) { const bf16x8 bv = *(const bf16x8*)(BT + xt_idx(nt * 16 + fr, ks * 32 + fq * 8));
#pragma unroll
            for (int pi = 0; pi < 2; ++pi) acc[pi][nt] = __builtin_amdgcn_mfma_f32_16x16x32_bf16(a[pi], bv, acc[pi][nt], 0, 0, 0); } }
    float* sp = states + ((size_t)((b * 32 + c) * 16 + g * 4 + hh)) * 4096;
#pragma unroll
    for (int pi = 0; pi < 2; ++pi)
#pragma unroll
        for (int nt = 0; nt < 4; ++nt)
#pragma unroll
            for (int j = 0; j < 4; ++j) sp[((pb + pi) * 16 + fq * 4 + j) * 64 + nt * 16 + fr] = acc[pi][nt][j];
    if (tid < 4) decs[(b * 32 + c) * 16 + g * 4 + tid] = __expf(ACS[tid * 128 + 127]);
}
__device__ void ssd_pass3_item(const Params& P, int layer, int item, unsigned char* lds) {
    const int tid = otid(), w = __builtin_amdgcn_readfirstlane(tid >> 6), lane = tid & 63, fr = lane & 15, fq = lane >> 4;
    const int b = item >> 7, c = (item >> 2) & 31, g = item & 3; const size_t r0 = (size_t)b * 4096 + (size_t)c * 128;
    bf16_t* proj = (bf16_t*)(P.ws + WS_PROJ);
    const float* states = (const float*)(P.ws + WS_SSDST);
    bf16_t* Cs = (bf16_t*)lds; bf16_t* Bs = Cs + 128 * 72; bf16_t* Sin = Bs; bf16_t* XT4 = Bs + 128 * 72; bf16_t* Ms = XT4 + 256 * 136; float* DT = (float*)(Ms + 128 * 136); float* ACS = DT + 512;
    __syncthreads();
    ssd_stage_dt(P, layer, proj, r0, g, DT, ACS, tid);
    ssd_stage_conv<1>(P, layer, proj, r0, c == 0, g, DT, ACS, XT4, Bs, Cs, tid);
    __syncthreads();
    f32x4 CB[8];
#pragma unroll
    for (int st = 0; st < 8; ++st) { CB[st] = (f32x4){0.f, 0.f, 0.f, 0.f};
        if (st <= w) {
#pragma unroll
            for (int ks = 0; ks < 2; ++ks) { const bf16x8 a = *(const bf16x8*)(Cs + (16 * w + fr) * 72 + ks * 32 + fq * 8), bv = *(const bf16x8*)(Bs + (16 * st + fr) * 72 + ks * 32 + fq * 8);
                CB[st] = __builtin_amdgcn_mfma_f32_16x16x32_bf16(a, bv, CB[st], 0, 0, 0); } } }
    float ssq[4] = {0.f, 0.f, 0.f, 0.f};
    const int nks = (w >> 1) + 1;
    bf16_t* zrow[4];
#pragma unroll
    for (int j = 0; j < 4; ++j) zrow[j] = proj + (r0 + 16 * w + fq * 4 + j) * LDP + C_Z + g * 256 + fr;
    f32x4 sna, snc;
    { const float* sp = states + ((size_t)((b * 32 + c) * 16 + g * 4)) * 4096 + (tid >> 3) * 64 + (tid & 7) * 8; sna = *(const f32x4*)sp; snc = *(const f32x4*)(sp + 4); }
    for (int hh = 0; hh < 4; ++hh) {
        const int hd = g * 4 + hh;
        __syncthreads();
        { const int p = tid >> 3, n0 = (tid & 7) * 8;
          u32x4 pk; pk[0] = pk2(sna[0], sna[1]); pk[1] = pk2(sna[2], sna[3]); pk[2] = pk2(snc[0], snc[1]); pk[3] = pk2(snc[2], snc[3]);
          *(u32x4*)(Sin + p * 72 + n0) = pk;
          if (hh < 3) { const float* sp = states + ((size_t)((b * 32 + c) * 16 + hd + 1)) * 4096 + p * 64 + n0; sna = *(const f32x4*)sp; snc = *(const f32x4*)(sp + 4); } }
        float acs_t[4];
#pragma unroll
        for (int j = 0; j < 4; ++j) acs_t[j] = ACS[hh * 128 + 16 * w + fq * 4 + j];
#pragma unroll
        for (int st = 0; st < 8; ++st) { if (st <= (w | 1)) { const float acs_s = ACS[hh * 128 + 16 * st + fr];
#pragma unroll
            for (int j = 0; j < 4; ++j) { const int t = 16 * w + fq * 4 + j, sx = 16 * st + fr; const float v = (st <= w && sx <= t) ? CB[st][j] * __expf(acs_t[j] - acs_s) : 0.f; Ms[t * 136 + sx] = f2bf(v); } } }
        __syncthreads();
        bf16_t zv[4][4];
#pragma unroll
        for (int j = 0; j < 4; ++j)
#pragma unroll
            for (int pt = 0; pt < 4; ++pt) zv[j][pt] = *(zrow[j] + hh * 64 + pt * 16);
        f32x4 yd[4], yo[4];
#pragma unroll
        for (int pt = 0; pt < 4; ++pt) { yd[pt] = (f32x4){0.f, 0.f, 0.f, 0.f}; yo[pt] = (f32x4){0.f, 0.f, 0.f, 0.f}; }
        for (int ks = 0; ks < nks; ++ks) { const bf16x8 a = *(const bf16x8*)(Ms + (16 * w + fr) * 136 + ks * 32 + fq * 8);
#pragma unroll
            for (int pt = 0; pt < 4; ++pt) { const bf16x8 bv = *(const bf16x8*)(XT4 + xt_idx(hh * 64 + pt * 16 + fr, ks * 32 + fq * 8)); yd[pt] = __builtin_amdgcn_mfma_f32_16x16x32_bf16(a, bv, yd[pt], 0, 0, 0); } }
#pragma unroll
        for (int ks = 0; ks < 2; ++ks) { const bf16x8 a = *(const bf16x8*)(Cs + (16 * w + fr) * 72 + ks * 32 + fq * 8);
#pragma unroll
            for (int pt = 0; pt < 4; ++pt) { const bf16x8 bv = *(const bf16x8*)(Sin + (pt * 16 + fr) * 72 + ks * 32 + fq * 8); yo[pt] = __builtin_amdgcn_mfma_f32_16x16x32_bf16(a, bv, yo[pt], 0, 0, 0); } }
        const float Dh = P.in[18][layer * 16 + hd];
#pragma unroll
        for (int j = 0; j < 4; ++j) { const int t = 16 * w + fq * 4 + j; const float et = __expf(acs_t[j]), idt = 1.f / DT[hh * 128 + t];
#pragma unroll
            for (int pt = 0; pt < 4; ++pt) { const int p = pt * 16 + fr; const float x = bf2f(XT4[xt_idx(hh * 64 + p, t)]) * idt;
                bf16_t* zp = zrow[j] + hh * 64 + pt * 16;
                float y = yd[pt][j] + et * yo[pt][j] + Dh * x; y *= silu_fast(bf2f(zv[j][pt])); ssq[j] += y * y; *zp = f2bf(y); } }
    }
    asm volatile("s_waitcnt vmcnt(0)" ::: "memory");
    const float* ng = P.in[19] + layer * 1024 + g * 256 + fr;
#pragma unroll
    for (int j = 0; j < 4; ++j) { float v = ssq[j];
#pragma unroll
        for (int o = 8; o > 0; o >>= 1) v += __shfl_xor(v, o);
        ssq[j] = rsqrtf(v * (1.f / 256.f) + EPSF); }
    for (int hb = 0; hb < 16; hb += 4) { bf16_t yv[4][4]; float gv[4];
#pragma unroll
        for (int q = 0; q < 4; ++q) { gv[q] = ng[(hb + q) * 16];
#pragma unroll
            for (int j = 0; j < 4; ++j) yv[q][j] = *(zrow[j] + (hb + q) * 16); }
#pragma unroll
        for (int q = 0; q < 4; ++q)
#pragma unroll
            for (int j = 0; j < 4; ++j) *(zrow[j] + (hb + q) * 16) = f2bf(bf2f(yv[q][j]) * ssq[j] * gv[q]); }
}
__device__ void phase_ssd_scan(const Params& P, int layer) {
    float* states = (float*)(P.ws + WS_SSDST); const float* decs = (const float*)(P.ws + WS_SSDDEC);
    for (int e = blockIdx.x * 512 + otid(); e < 4 * 16 * 4096; e += gridDim.x * 512) {
        const int b = e >> 16, hd = (e >> 12) & 15, pn = e & 4095; float carry = 0.f;
        float st[32], dc[32];
#pragma unroll
        for (int c = 0; c < 32; ++c) { st[c] = states[((size_t)((b * 32 + c) * 16 + hd)) * 4096 + pn]; dc[c] = decs[(b * 32 + c) * 16 + hd]; }
#pragma unroll
        for (int c = 0; c < 32; ++c) { states[((size_t)((b * 32 + c) * 16 + hd)) * 4096 + pn] = carry; carry = carry * dc[c] + st[c]; }
        P.out[O_PSSM + ((size_t)((layer * 4 + b) * 16 + hd)) * 4096 + pn] = carry;
    }
}

__device__ void attn_prompt_item(const Params& P, int layer, int item, unsigned char* lds, bool dry = false) {
    const int tid = otid(), w = tid >> 6, lane = tid & 63, fr = lane & 15, fq = lane >> 4;
    const int b = item >> 7, nb = (item >> 2) & 31, kvh = item & 3;
    bf16_t* proj = (bf16_t*)(P.ws + WS_PROJ);
    bf16_t* Ks = (bf16_t*)lds;
    bf16_t* Vt = Ks + 256 * 72;
    bf16_t* Pw = Vt + 64 * 280 + w * 16 * 168;
    const long rowK0 = (long)b * 4096 + (long)(nb - 1) * 128;
    const bf16_t* qbase = proj + ((size_t)b * 4096 + (size_t)nb * 128 + w * 16 + fr) * LDP + C_Q + kvh * 256 + fq * 8;
    bf16x8 qa[2], qn[2];
#pragma unroll
    for (int ks = 0; ks < 2; ++ks) { qa[ks] = *(const bf16x8*)(qbase + ks * 32); qn[ks] = qa[ks]; }
    __syncthreads();
#pragma unroll
    for (int idx = tid; idx < 2048; idx += 512) { const int kj = idx >> 3, seg = idx & 7; u32x4 v = (u32x4){0u, 0u, 0u, 0u};
        if (nb > 0 || kj >= 128) v = *(const u32x4*)(proj + (size_t)(rowK0 + kj) * LDP + C_K + kvh * 64 + seg * 8);
        *(u32x4*)(Ks + kj * 72 + seg * 8) = v; }
#pragma unroll
    for (int idx = tid; idx < 2048; idx += 512) { const int seg = idx >> 8, kj = idx & 255; u32x4 v = (u32x4){0u, 0u, 0u, 0u};
        if (nb > 0 || kj >= 128) v = *(const u32x4*)(proj + (size_t)(rowK0 + kj) * LDP + C_V + kvh * 64 + seg * 8);
#pragma unroll
        for (int i = 0; i < 8; ++i) Vt[(seg * 8 + i) * 280 + kj] = (bf16_t)((v[i >> 1] >> ((i & 1) * 16)) & 0xffffu); }
    for (int idx = tid; idx < 64 * 24; idx += 512) { const int d = idx / 24, cc = 256 + idx % 24; Vt[d * 280 + cc] = 0; }
    for (int i = lane; i < 384; i += 64) Pw[(i / 24) * 168 + 144 + i % 24] = 0;
    __syncthreads();
    const int q0 = w * 16;
    const size_t qrow0 = (size_t)b * 4096 + (size_t)nb * 128 + q0;
    for (int gi = 0; gi < 4; ++gi) {
        const int hq = kvh * 4 + gi;
        const float slope = exp2f(-0.5f * (float)(hq + 1));
        const float sink = P.in[21][layer * 16 + hq];
        if (gi < 3) {
#pragma unroll
            for (int ks = 0; ks < 2; ++ks) qn[ks] = *(const bf16x8*)(qbase + (gi + 1) * 64 + ks * 32); }
        f32x4 S[9];
#pragma unroll
        for (int nt = 0; nt < 9; ++nt) { f32x4 a = (f32x4){0.f, 0.f, 0.f, 0.f}; const bf16_t* kp = Ks + (q0 + nt * 16 + fr) * 72 + fq * 8;
#pragma unroll
            for (int ks = 0; ks < 2; ++ks) { const bf16x8 kb = *(const bf16x8*)(kp + ks * 32); a = __builtin_amdgcn_mfma_f32_16x16x32_bf16(qa[ks], kb, a, 0, 0, 0); }
            S[nt] = a; }
        float mx[4] = {-INFINITY, -INFINITY, -INFINITY, -INFINITY};
#pragma unroll
        for (int nt = 0; nt < 9; ++nt)
#pragma unroll
            for (int j = 0; j < 4; ++j) { const int dist = (fq * 4 + j) - (nt * 16 + fr) + 128; const bool valid = dist >= 0 && dist <= 128 && (nb > 0 || (q0 + nt * 16 + fr) >= 128);
                const float s = valid ? S[nt][j] * 0.125f - slope * (float)dist : -INFINITY; S[nt][j] = s; mx[j] = fmaxf(mx[j], s); }
        float inv[4];
#pragma unroll
        for (int j = 0; j < 4; ++j) { float m = mx[j];
#pragma unroll
            for (int o = 8; o > 0; o >>= 1) m = fmaxf(m, __shfl_xor(m, o));
            m = fmaxf(m, sink); float sum = 0.f;
#pragma unroll
            for (int nt = 0; nt < 9; ++nt) { const float p = __expf(S[nt][j] - m); S[nt][j] = p; sum += p; }
#pragma unroll
            for (int o = 8; o > 0; o >>= 1) sum += __shfl_xor(sum, o);
            inv[j] = 1.f / (sum + __expf(sink - m)); }
#pragma unroll
        for (int nt = 0; nt < 9; ++nt)
#pragma unroll
            for (int j = 0; j < 4; ++j) Pw[(fq * 4 + j) * 168 + nt * 16 + fr] = f2bf(S[nt][j]);
        asm volatile("s_waitcnt lgkmcnt(0)" ::: "memory"); __builtin_amdgcn_wave_barrier();
        f32x4 O[4];
#pragma unroll
        for (int dt = 0; dt < 4; ++dt) O[dt] = (f32x4){0.f, 0.f, 0.f, 0.f};
#pragma unroll
        for (int ks = 0; ks < 5; ++ks) { const bf16x8 pa = *(const bf16x8*)(Pw + fr * 168 + ks * 32 + fq * 8);
#pragma unroll
            for (int dt = 0; dt < 4; ++dt) { const bf16x8 vb = *(const bf16x8*)(Vt + (dt * 16 + fr) * 280 + q0 + ks * 32 + fq * 8); O[dt] = __builtin_amdgcn_mfma_f32_16x16x32_bf16(pa, vb, O[dt], 0, 0, 0); } }
        asm volatile("s_waitcnt lgkmcnt(0)" ::: "memory"); __builtin_amdgcn_wave_barrier();
#pragma unroll
        for (int dt = 0; dt < 4; ++dt)
#pragma unroll
            for (int j = 0; j < 4; ++j) { if (!dry) proj[(qrow0 + fq * 4 + j) * LDP + C_Q + hq * 64 + dt * 16 + fr] = f2bf(O[dt][j] * inv[j]); }
        qa[0] = qn[0]; qa[1] = qn[1];
    }
    if (nb == 31) {
        for (int idx = tid; idx < 128 * 64; idx += 512) { const int t = idx >> 6, d = idx & 63; const size_t row = (size_t)b * 4096 + 3968 + t;
            const size_t o = ((size_t)((layer * 4 + b) * 128 + t)) * 256 + kvh * 64 + d;
            P.out[O_PK + o] = bf2f(proj[row * LDP + C_K + kvh * 64 + d]); P.out[O_PV + o] = bf2f(proj[row * LDP + C_V + kvh * 64 + d]); }
    }
}
__device__ void attn_sample_item(const Params& P, int layer, int item, float* L, bool dry = false) {
    const int tid = otid(), w = tid >> 6, lane = tid & 63;
    const int sb = item >> 2, kvh = item & 3, r0 = NPR + sb * 4;
    bf16_t* proj = (bf16_t*)(P.ws + WS_PROJ);
    float* Kf = L; float* Vf = Kf + 132 * 65; float* Q = Vf + 132 * 65; float* Sc = Q + 16 * 64;
    const float* ck = P.in[7] + ((size_t)(layer * 128 + sb)) * 128 * 256; const float* cv = P.in[8] + ((size_t)(layer * 128 + sb)) * 128 * 256;
    __syncthreads();
    {
        f32x4 kq[4], vq[4];
#pragma unroll
        for (int i = 0; i < 4; ++i) { const int idx = tid + i * 512, j = idx >> 4, d4 = (idx & 15) * 4; kq[i] = *(const f32x4*)(ck + (size_t)j * 256 + kvh * 64 + d4); vq[i] = *(const f32x4*)(cv + (size_t)j * 256 + kvh * 64 + d4); }
#pragma unroll
        for (int i = 0; i < 4; ++i) { const int idx = tid + i * 512, j = idx >> 4, d4 = (idx & 15) * 4;
#pragma unroll
            for (int e = 0; e < 4; ++e) { Kf[j * 65 + d4 + e] = kq[i][e]; Vf[j * 65 + d4 + e] = vq[i][e]; }
            if (j >= 4) { const size_t o = ((size_t)((layer * 128 + sb) * 128 + (j - 4))) * 256 + kvh * 64 + d4; *(f32x4*)(P.out + O_SK + o) = kq[i]; *(f32x4*)(P.out + O_SV + o) = vq[i]; } }
        if (tid < 256) { const int j = 128 + (tid >> 6), d = tid & 63; const float kv = bf2f(proj[(size_t)(r0 + j - 128) * LDP + C_K + kvh * 64 + d]), vv = bf2f(proj[(size_t)(r0 + j - 128) * LDP + C_V + kvh * 64 + d]);
            Kf[j * 65 + d] = kv; Vf[j * 65 + d] = vv; const size_t o = ((size_t)((layer * 128 + sb) * 128 + (j - 4))) * 256 + kvh * 64 + d; P.out[O_SK + o] = kv; P.out[O_SV + o] = vv; }
    }
    for (int idx = tid; idx < 1024; idx += 512) { const int qr = idx >> 6, d = idx & 63; Q[idx] = bf2f(proj[(size_t)(r0 + (qr >> 2)) * LDP + C_Q + (kvh * 4 + (qr & 3)) * 64 + d]); }
    __syncthreads();
    for (int idx = tid; idx < 16 * 132; idx += 512) { const int qr = idx / 132, j = idx - qr * 132; const int dist = 128 + (qr >> 2) - j; float s = -INFINITY;
        if (dist >= 0 && dist <= 128) { float a = 0.f;
#pragma unroll 8
            for (int d = 0; d < 64; ++d) a += Q[qr * 64 + d] * Kf[j * 65 + d];
            s = a * 0.125f - exp2f(-0.5f * (float)(kvh * 4 + (qr & 3) + 1)) * (float)dist; }
        Sc[qr * 136 + j] = s; }
    __syncthreads();
    for (int rr = 0; rr < 2; ++rr) { const int qr = w * 2 + rr; const float sink = P.in[21][layer * 16 + kvh * 4 + (qr & 3)];
        float v0 = Sc[qr * 136 + lane], v1 = Sc[qr * 136 + 64 + lane], v2 = lane < 4 ? Sc[qr * 136 + 128 + lane] : -INFINITY;
        float m = fmaxf(fmaxf(v0, v1), v2);
#pragma unroll
        for (int o = 32; o > 0; o >>= 1) m = fmaxf(m, __shfl_xor(m, o));
        m = fmaxf(m, sink);
        v0 = __expf(v0 - m); v1 = __expf(v1 - m); v2 = __expf(v2 - m);
        const float sum = wave_sum(v0 + v1 + v2); const float inv = 1.f / (sum + __expf(sink - m));
        Sc[qr * 136 + lane] = v0 * inv; Sc[qr * 136 + 64 + lane] = v1 * inv; if (lane < 4) Sc[qr * 136 + 128 + lane] = v2 * inv; }
    __syncthreads();
    for (int idx = tid; idx < 1024; idx += 512) { const int qr = idx >> 6, d = idx & 63; float o = 0.f;
        for (int j = 0; j < 132; ++j) o += Sc[qr * 136 + j] * Vf[j * 65 + d];
        if (!dry) proj[(size_t)(r0 + (qr >> 2)) * LDP + C_Q + (kvh * 4 + (qr & 3)) * 64 + d] = f2bf(o); }
}

__device__ void gmlp_prompt_item(const Params& P, int layer, int item, unsigned char* lds, bool dry = false) {
    const int tid = otid(), w = tid >> 6, lane = tid & 63, fr = lane & 15, fq = lane >> 4;
    const int b = item >> 8, chn = (item >> 3) & 31, g = item & 7;
    const size_t r0 = (size_t)b * 4096 + (size_t)chn * 128;
    bf16_t* proj = (bf16_t*)(P.ws + WS_PROJ);
    bf16_t* VT = (bf16_t*)lds; bf16_t* Wt = VT + 128 * 136; float* MU = (float*)(Wt + 128 * 136); float* RS = MU + 128;
    __syncthreads();
#pragma unroll
    for (int hb = 0; hb < 2; ++hb) { u32x4 av[8], cv8[8];
#pragma unroll
        for (int i = 0; i < 8; ++i) { const bf16_t* vp = proj + (r0 + w * 16 + hb * 8 + i) * LDP + C_UV + 1024 + lane * 16; av[i] = *(const u32x4*)vp; cv8[i] = *(const u32x4*)(vp + 8); }
#pragma unroll
        for (int i = 0; i < 8; ++i) { const int t = w * 16 + hb * 8 + i; float s = 0.f, sq = 0.f;
#pragma unroll
            for (int k = 0; k < 4; ++k) { float x0 = bflo(av[i][k]), x1 = bfhi(av[i][k]), x2 = bflo(cv8[i][k]), x3 = bfhi(cv8[i][k]); s += x0 + x1 + x2 + x3; sq += x0 * x0 + x1 * x1 + x2 * x2 + x3 * x3; }
            s = wave_sum(s); sq = wave_sum(sq);
            if (lane == 0) { const float mean = s * (1.f / 1024.f); const float var = fmaxf(sq * (1.f / 1024.f) - mean * mean, 0.f); MU[t] = mean; RS[t] = rsqrtf(var + EPSF); } } }
    const float* Wg = P.in[24] + ((size_t)(layer * 8 + g)) * 16384;
#pragma unroll
    for (int idx = tid; idx < 4096; idx += 512) { const int t = idx >> 5, s4 = (idx & 31) * 4; const f32x4 wv = *(const f32x4*)(Wg + t * 128 + s4);
        u32x2 o; o[0] = pk2(s4 <= t ? wv[0] : 0.f, s4 + 1 <= t ? wv[1] : 0.f); o[1] = pk2(s4 + 2 <= t ? wv[2] : 0.f, s4 + 3 <= t ? wv[3] : 0.f);
        *(u32x2*)(Wt + t * 136 + s4) = o; }
    __syncthreads();
    const float* lg = P.in[22] + layer * 1024 + g * 128; const float* lb = P.in[23] + layer * 1024 + g * 128;
#pragma unroll
    for (int idx = tid; idx < 2048; idx += 512) { const int s = idx & 127, fs = idx >> 7; const u32x4 v = *(const u32x4*)(proj + (r0 + s) * LDP + C_UV + 1024 + g * 128 + fs * 8);
        const float mu = MU[s], rs = RS[s];
#pragma unroll
        for (int i = 0; i < 8; ++i) { const int f = fs * 8 + i; const float x = (i & 1) ? bfhi(v[i >> 1]) : bflo(v[i >> 1]); VT[f * 136 + s] = f2bf((x - mu) * rs * lg[f] + lb[f]); } }
    __syncthreads();
    f32x4 acc[8];
#pragma unroll
    for (int ft = 0; ft < 8; ++ft) acc[ft] = (f32x4){0.f, 0.f, 0.f, 0.f};
    const int nks = (16 * w + 15) / 32 + 1;
    for (int ks = 0; ks < nks; ++ks) { const bf16x8 a = *(const bf16x8*)(Wt + (w * 16 + fr) * 136 + ks * 32 + fq * 8);
#pragma unroll
        for (int ft = 0; ft < 8; ++ft) { const bf16x8 bb = *(const bf16x8*)(VT + (ft * 16 + fr) * 136 + ks * 32 + fq * 8); acc[ft] = __builtin_amdgcn_mfma_f32_16x16x32_bf16(a, bb, acc[ft], 0, 0, 0); } }
    bf16_t uv[4][8]; float bsv[4];
#pragma unroll
    for (int j = 0; j < 4; ++j) { const int t = w * 16 + fq * 4 + j; bsv[j] = P.in[25][(layer * 8 + g) * 128 + t];
#pragma unroll
        for (int ft = 0; ft < 8; ++ft) uv[j][ft] = proj[(r0 + t) * LDP + C_UV + g * 128 + ft * 16 + fr]; }
#pragma unroll
    for (int j = 0; j < 4; ++j) { const int t = w * 16 + fq * 4 + j;
#pragma unroll
        for (int ft = 0; ft < 8; ++ft) { if (!dry) proj[(r0 + t) * LDP + C_UV + g * 128 + ft * 16 + fr] = f2bf(bf2f(uv[j][ft]) * (acc[ft][j] + bsv[j])); } }
}
__device__ void gmlp_sample_item(const Params& P, int layer, int sb, float* L) {
    const int tid = otid(), w = tid >> 6, lane = tid & 63; const size_t r0 = NPR + sb * 4;
    bf16_t* proj = (bf16_t*)(P.ws + WS_PROJ);
    float* Vn = L; float* MU = Vn + 4096; float* RS = MU + 4;
    __syncthreads();
    if (w < 4) { const bf16_t* vp = proj + (r0 + w) * LDP + C_UV + 1024 + lane * 16; const u32x4 a = *(const u32x4*)vp, c = *(const u32x4*)(vp + 8); float s = 0.f, sq = 0.f;
#pragma unroll
        for (int k = 0; k < 4; ++k) { float x0 = bflo(a[k]), x1 = bfhi(a[k]), x2 = bflo(c[k]), x3 = bfhi(c[k]); s += x0 + x1 + x2 + x3; sq += x0 * x0 + x1 * x1 + x2 * x2 + x3 * x3; }
        s = wave_sum(s); sq = wave_sum(sq);
        if (lane == 0) { const float mean = s * (1.f / 1024.f); const float var = fmaxf(sq * (1.f / 1024.f) - mean * mean, 0.f); MU[w] = mean; RS[w] = rsqrtf(var + EPSF); } }
    __syncthreads();
    for (int idx = tid; idx < 4096; idx += 512) { const int t = idx >> 10, c = idx & 1023;
        const float x = bf2f(proj[(r0 + t) * LDP + C_UV + 1024 + c]); const float vn = (x - MU[t]) * RS[t] * P.in[22][layer * 1024 + c] + P.in[23][layer * 1024 + c];
        Vn[idx] = vn; P.out[O_SGMV + ((size_t)((layer * 128 + sb) * 4 + t)) * 1024 + c] = vn; }
    __syncthreads();
    for (int idx = tid; idx < 4096; idx += 512) { const int t = idx >> 10, c = idx & 1023, g = c >> 7;
        const float* Wg = P.in[24] + ((size_t)(layer * 8 + g)) * 16384 + t * 128; float m = P.in[25][(layer * 8 + g) * 128 + t];
        for (int s = 0; s <= t; ++s) m += Wg[s] * Vn[s * 1024 + c];
        bf16_t* ap = proj + (r0 + t) * LDP + C_UV + c; *ap = f2bf(bf2f(*ap) * m); }
}

template <int R>
__device__ __forceinline__ void shortconv_rows(const Params& P, int layer, int r0, int tid) {
    bf16_t* proj = (bf16_t*)(P.ws + WS_PROJ);
    const float* cw = P.in[20] + layer * 3 * 1024;
    const int j = tid * 2; const int ss = seq_start(r0); const bool havePrev = (r0 - 2 >= ss);
    unsigned cg[R + 2], xs[R + 2], bg[R];
#pragma unroll
    for (int k = 0; k < R + 2; ++k) { cg[k] = 0u; xs[k] = 0u;
        if (k >= 2 || havePrev) { const bf16_t* rp = proj + (size_t)(r0 - 2 + k) * LDP + C_BCX + j; cg[k] = *(const unsigned*)(rp + 1024); xs[k] = *(const unsigned*)(rp + 2048); } }
#pragma unroll
    for (int k = 0; k < R; ++k) bg[k] = *(const unsigned*)(proj + (size_t)(r0 + k) * LDP + C_BCX + j);
    float pr0[R + 2], pr1[R + 2];
#pragma unroll
    for (int k = 0; k < R + 2; ++k) { pr0[k] = bflo(cg[k]) * bflo(xs[k]); pr1[k] = bfhi(cg[k]) * bfhi(xs[k]); }
    if (!havePrev && r0 >= NPR) { const float* st = P.in[6] + ((size_t)(layer * 128 + ((r0 - NPR) >> 2)) * 2) * 1024 + j; pr0[0] = st[0]; pr1[0] = st[1]; pr0[1] = st[1024]; pr1[1] = st[1025]; }
    const float w0a = cw[j], w0b = cw[j + 1], w1a = cw[1024 + j], w1b = cw[1025 + j], w2a = cw[2048 + j], w2b = cw[2049 + j];
#pragma unroll
    for (int k = 0; k < R; ++k) { const float y0 = w0a * pr0[k] + w1a * pr0[k + 1] + w2a * pr0[k + 2], y1 = w0b * pr1[k] + w1b * pr1[k + 1] + w2b * pr1[k + 2];
        *(unsigned*)(proj + (size_t)(r0 + k) * LDP + C_BCX + j) = pk2(bflo(bg[k]) * y0, bfhi(bg[k]) * y1);
        const int r = r0 + k;
        if (r < NPR) { const int l = r & 4095; if (l >= 4094) { float* o = P.out + O_PSCC + ((size_t)((layer * 4 + (r >> 12)) * 2 + (l - 4094))) * 1024 + j; o[0] = pr0[k + 2]; o[1] = pr1[k + 2]; } }
        else { const int l = (r - NPR) & 3; if (l >= 2) { float* o = P.out + O_SSCC + ((size_t)((layer * 128 + ((r - NPR) >> 2)) * 2 + (l - 2))) * 1024 + j; o[0] = pr0[k + 2]; o[1] = pr1[k + 2]; } }
    }
}
__device__ void shortconv_item(const Params& P, int layer, int item) {
    const int tid = otid();
    if (item < 1024) shortconv_rows<16>(P, layer, item * 16, tid); else shortconv_rows<4>(P, layer, NPR + (item - 1024) * 4, tid);
}
__device__ void ssdconv_state_item(const Params& P, int layer, int sq) {
    const bf16_t* proj = (const bf16_t*)(P.ws + WS_PROJ);
    const size_t rbase = sq < 4 ? (size_t)sq * 4096 + 4093 : (size_t)NPR + (size_t)(sq - 4) * 4 + 1;
    float* o = sq < 4 ? P.out + O_PSSDC + (size_t)(layer * 4 + sq) * 3 * 1536 : P.out + O_SSSDC + (size_t)(layer * 128 + (sq - 4)) * 3 * 1536;
    const int tid = otid(); bf16_t v[9];
#pragma unroll
    for (int i = 0; i < 9; ++i) { const int e = tid + i * 512, t = e / 1536, c = e - t * 1536; v[i] = proj[(rbase + t) * LDP + C_XBC + c]; }
#pragma unroll
    for (int i = 0; i < 9; ++i) o[tid + i * 512] = bf2f(v[i]);
}

template <int R>
__device__ __forceinline__ void ffn_act_unit(const Params& P, int layer, int r0, int oc) {
    const bf16_t* up = (const bf16_t*)(P.ws + WS_PROJ); bf16_t* act = (bf16_t*)(P.ws + WS_PROJ + UP_BYTES);
    const float* cw = P.in[30] + (size_t)layer * 3 * 5632; const float* cb = P.in[31] + (size_t)layer * 5632;
    const int j0 = oc * 8;
    float wa[3][8], wg[3][8], ba[8], bgv[8], pa[2][8], pg[2][8];
#pragma unroll
    for (int k = 0; k < 3; ++k) { const f32x4 a0 = *(const f32x4*)(cw + k * 5632 + j0), a1 = *(const f32x4*)(cw + k * 5632 + j0 + 4), g0 = *(const f32x4*)(cw + k * 5632 + 2816 + j0), g1 = *(const f32x4*)(cw + k * 5632 + 2816 + j0 + 4);
#pragma unroll
        for (int i = 0; i < 4; ++i) { wa[k][i] = a0[i]; wa[k][4 + i] = a1[i]; wg[k][i] = g0[i]; wg[k][4 + i] = g1[i]; } }
    { const f32x4 a0 = *(const f32x4*)(cb + j0), a1 = *(const f32x4*)(cb + j0 + 4), g0 = *(const f32x4*)(cb + 2816 + j0), g1 = *(const f32x4*)(cb + 2816 + j0 + 4);
#pragma unroll
      for (int i = 0; i < 4; ++i) { ba[i] = a0[i]; ba[4 + i] = a1[i]; bgv[i] = g0[i]; bgv[4 + i] = g1[i]; } }
    const int ss = seq_start(r0); const bool havePrev = (r0 - 2 >= ss);
#pragma unroll
    for (int k = 0; k < 2; ++k) {
        if (havePrev) { const u32x4 ua = *(const u32x4*)(up + (size_t)(r0 - 2 + k) * 5632 + j0), ug = *(const u32x4*)(up + (size_t)(r0 - 2 + k) * 5632 + 2816 + j0);
#pragma unroll
            for (int i = 0; i < 4; ++i) { pa[k][2 * i] = bflo(ua[i]); pa[k][2 * i + 1] = bfhi(ua[i]); pg[k][2 * i] = bflo(ug[i]); pg[k][2 * i + 1] = bfhi(ug[i]); } }
        else if (r0 >= NPR) { const float* pp = P.in[9] + ((size_t)(layer * 128 + ((r0 - NPR) >> 2)) * 2 + k) * 5632;
#pragma unroll
            for (int i = 0; i < 8; ++i) { pa[k][i] = pp[j0 + i]; pg[k][i] = pp[2816 + j0 + i]; } }
        else {
#pragma unroll
            for (int i = 0; i < 8; ++i) { pa[k][i] = 0.f; pg[k][i] = 0.f; } } }
#pragma unroll
    for (int kb = 0; kb < R; kb += 4) { u32x4 ua[4], ug[4];
#pragma unroll
        for (int q = 0; q < 4; ++q) { ua[q] = *(const u32x4*)(up + (size_t)(r0 + kb + q) * 5632 + j0); ug[q] = *(const u32x4*)(up + (size_t)(r0 + kb + q) * 5632 + 2816 + j0); }
#pragma unroll
        for (int q = 0; q < 4; ++q) { const int r = r0 + kb + q; float ca[8], cgv[8], o[8];
#pragma unroll
            for (int i = 0; i < 4; ++i) { ca[2 * i] = bflo(ua[q][i]); ca[2 * i + 1] = bfhi(ua[q][i]); cgv[2 * i] = bflo(ug[q][i]); cgv[2 * i + 1] = bfhi(ug[q][i]); }
#pragma unroll
            for (int i = 0; i < 8; ++i) { const float a = ba[i] + wa[0][i] * pa[0][i] + wa[1][i] * pa[1][i] + wa[2][i] * ca[i], g = bgv[i] + wg[0][i] * pg[0][i] + wg[1][i] * pg[1][i] + wg[2][i] * cgv[i];
                o[i] = silu_fast(a) * g; pa[0][i] = pa[1][i]; pa[1][i] = ca[i]; pg[0][i] = pg[1][i]; pg[1][i] = cgv[i]; }
            u32x4 ov; ov[0] = pk2(o[0], o[1]); ov[1] = pk2(o[2], o[3]); ov[2] = pk2(o[4], o[5]); ov[3] = pk2(o[6], o[7]);
            *(u32x4*)(act + (size_t)r * 2816 + j0) = ov;
            float* so = nullptr;
            if (r < NPR) { const int l = r & 4095; if (l >= 4094) so = P.out + O_PFFC + ((size_t)((layer * 4 + (r >> 12)) * 2 + (l - 4094))) * 5632; }
            else { const int l = (r - NPR) & 3; if (l >= 2) so = P.out + O_SFFC + ((size_t)((layer * 128 + ((r - NPR) >> 2)) * 2 + (l - 2))) * 5632; }
            if (so) {
#pragma unroll
                for (int i = 0; i < 8; ++i) { so[j0 + i] = ca[i]; so[2816 + j0 + i] = cgv[i]; } }
        } }
}
__device__ void phase_ffn_act(const Params& P, int layer) {
    constexpr int NU_P = 2048 * 352, NU_S = 128 * 352;
    for (int u = blockIdx.x * 512 + otid(); u < NU_P + NU_S; u += gridDim.x * 512) {
        if (u < NU_P) { const int rb = u / 352, oc = u - rb * 352; ffn_act_unit<8>(P, layer, rb * 8, oc); }
        else { const int v = u - NU_P, sq = v / 352, oc = v - sq * 352; ffn_act_unit<4>(P, layer, NPR + sq * 4, oc); }
    }
}

__device__ __forceinline__ void sgemm_partial(const bf16_t* A, int lda, const bf16_t* Bt, int ldb, int K, int row0, int col0, float* red, int tid) {
    const int w = tid >> 6, lane = tid & 63, fr = lane & 15, fq = lane >> 4;
    const int kw = K >> 3, k0 = w * kw;
    f32x4 acc[2][4];
#pragma unroll
    for (int mt = 0; mt < 2; ++mt)
#pragma unroll
        for (int nt = 0; nt < 4; ++nt) acc[mt][nt] = (f32x4){0.f, 0.f, 0.f, 0.f};
    const bf16_t* ap = A + (size_t)(row0 + fr) * lda + k0 + fq * 8;
    const bf16_t* bp = Bt + (size_t)(col0 + fr) * ldb + k0 + fq * 8;
    const int nks = kw >> 5;
#pragma unroll 4
    for (int ks = 0; ks < nks; ++ks) { bf16x8 a[2], b[4];
#pragma unroll
        for (int mt = 0; mt < 2; ++mt) a[mt] = *(const bf16x8*)(ap + (size_t)mt * 16 * lda + ks * 32);
#pragma unroll
        for (int nt = 0; nt < 4; ++nt) b[nt] = *(const bf16x8*)(bp + (size_t)nt * 16 * ldb + ks * 32);
#pragma unroll
        for (int mt = 0; mt < 2; ++mt)
#pragma unroll
            for (int nt = 0; nt < 4; ++nt) acc[mt][nt] = __builtin_amdgcn_mfma_f32_16x16x32_bf16(a[mt], b[nt], acc[mt][nt], 0, 0, 0); }
#pragma unroll
    for (int mt = 0; mt < 2; ++mt)
#pragma unroll
        for (int nt = 0; nt < 4; ++nt)
#pragma unroll
            for (int j = 0; j < 4; ++j) red[(w * 32 + mt * 16 + fq * 4 + j) * 64 + nt * 16 + fr] = acc[mt][nt][j];
}
__device__ __forceinline__ f32x4 sgemm_reduce(const float* red, int tid) {
    const int row = tid >> 4, c4 = (tid & 15) * 4; f32x4 sacc = (f32x4){0.f, 0.f, 0.f, 0.f};
#pragma unroll
    for (int w = 0; w < 8; ++w) sacc += *(const f32x4*)(red + (w * 32 + row) * 64 + c4);
    return sacc;
}
__device__ void sample_branch(const Params& P, int layer, float* red) {
    const int tid = otid(); const bf16_t* proj = (const bf16_t*)(P.ws + WS_PROJ); bf16_t* hbuf = (bf16_t*)(P.ws + WS_H);
    for (int piece = blockIdx.x; piece < 256; piece += gridDim.x) {
        const int row0 = (piece >> 4) * 32, col0 = (piece & 15) * 64; const size_t r = NPR + row0 + (tid >> 4); const int c = col0 + (tid & 15) * 4;
        f32x4 sum = (f32x4){0.f, 0.f, 0.f, 0.f};
        for (int z = 0; z < 4; ++z) {
            const int ao = z == 0 ? C_Z : (z == 1 ? C_BCX : (z == 2 ? C_Q : C_UV));
            __syncthreads();
            sgemm_partial(proj + (size_t)NPR * LDP + ao, LDP, (const bf16_t*)(P.ws + WS_WBR) + (size_t)(layer * 4 + z) * 1048576, 1024, 1024, row0, col0, red, tid);
            __syncthreads();
            const f32x4 v = sgemm_reduce(red, tid);
            const u32x2 gv = *(const u32x2*)(proj + r * LDP + C_GATE + z * 1024 + c);
            sum[0] += bflo(gv[0]) * v[0]; sum[1] += bfhi(gv[0]) * v[1]; sum[2] += bflo(gv[1]) * v[2]; sum[3] += bfhi(gv[1]) * v[3];
        }
        u32x2 o; o[0] = pk2(sum[0], sum[1]); o[1] = pk2(sum[2], sum[3]); *(u32x2*)(hbuf + r * 1024 + c) = o;
    }
}
__device__ void sample_resid(const Params& P, const bf16_t* A, int lda, const bf16_t* Bt, int K, const float* xin_s, float* xout, const float* ga, float* red) {
    const int tid = otid();
    for (int piece = blockIdx.x; piece < 256; piece += gridDim.x) {
        const int row0 = (piece >> 4) * 32, col0 = (piece & 15) * 64; const int rs = row0 + (tid >> 4), c = col0 + (tid & 15) * 4;
        __syncthreads();
        sgemm_partial(A, lda, Bt, K, K, row0, col0, red, tid);
        __syncthreads();
        const f32x4 v = sgemm_reduce(red, tid);
        const f32x4 xv = *(const f32x4*)(xin_s + (size_t)rs * 1024 + c), gv = *(const f32x4*)(ga + (size_t)(4 + (rs >> 2)) * 6144 + c);
        *(f32x4*)(xout + (size_t)(NPR + rs) * 1024 + c) = xv + gv * v;
    }
}

__device__ __forceinline__ void grid_bar(unsigned* ctr, unsigned& epoch) {
    asm volatile("s_waitcnt vmcnt(0) lgkmcnt(0)" ::: "memory");
    __syncthreads();
    epoch += 1;
    if (threadIdx.x == 0) {
        __builtin_amdgcn_fence(__ATOMIC_RELEASE, "agent");
        asm volatile("s_waitcnt vmcnt(0) lgkmcnt(0)" ::: "memory");
        __hip_atomic_fetch_add(ctr, 1u, __ATOMIC_RELAXED, __HIP_MEMORY_SCOPE_AGENT);
        const unsigned target = epoch * gridDim.x;
        while (__hip_atomic_load(ctr, __ATOMIC_RELAXED, __HIP_MEMORY_SCOPE_AGENT) < target) __builtin_amdgcn_s_sleep(1);
        __builtin_amdgcn_fence(__ATOMIC_ACQUIRE, "agent");
        asm volatile("s_waitcnt vmcnt(0) lgkmcnt(0)" ::: "memory");
    }
    __syncthreads();
}

#ifndef PHMASK
#define PHMASK 0xFFFFFFFF
#endif
#define EN(x) ((PHMASK >> (x)) & 1)
#ifndef DRYM
#define DRYM 0
#endif
#ifndef DBL
#define DBL 0
#endif
#define REP(x) (((DBL >> (x)) & 1) ? 2 : 1)
constexpr int PH_PER_LAYER = 11, N_PHASES = 2 + 4 * PH_PER_LAYER + 1;

__global__ void __launch_bounds__(512, 2) mega_fwd(Params P) {
    extern __shared__ __attribute__((aligned(16))) unsigned char lds_raw[];
    cg::grid_group grid = cg::this_grid();
    LAS unsigned char* ldsl = (LAS unsigned char*)lds_raw;
    bf16_t* proj = (bf16_t*)(P.ws + WS_PROJ);
    bf16_t* hbuf = (bf16_t*)(P.ws + WS_H);
    float* xbuf = P.out;
    float* mod = (float*)(P.ws + WS_MOD);
    unsigned* barctr = (unsigned*)(P.ws + WS_BAR); unsigned epoch = 0;
    for (int ph = P.ph_lo; ph < P.ph_hi; ++ph) {
        if (ph == 0) { for (int rp = 0; rp < REP(0); ++rp) phase_convert(P, (float*)lds_raw); }
        else if (ph == 1) {
            Gemm g{(const bf16_t*)(P.ws + WS_CACT), (const bf16_t*)(P.ws + WS_WADA), 1024, 1024, 1024, 1, 96, 0, 0, 0, 0, 0};
            EpiMod E{mod, P.in[11]};
            for (int rp = 0; rp < REP(1); ++rp) gemm_phase<EpiMod, 1>(ldsl, g, E);
        }
        else if (ph == N_PHASES - 1) { phase_final_norm(xbuf, P.in[33]); }
        else {
            const int layer = (ph - 2) / PH_PER_LAYER, sp = (ph - 2) % PH_PER_LAYER;
            const float* modL = mod + (size_t)layer * NCOND * 6144;
            const float* xin_p = layer == 0 ? P.in[0] : xbuf; const float* xin_s = layer == 0 ? P.in[1] : xbuf + (size_t)NPR * 1024;
            if (sp == 0) { for (int rp = 0; rp < REP(16); ++rp) phase_norm(xin_p, xin_s, P.in[12] + layer * 1024, modL, 0, 1024, hbuf); }
            else if (sp == 1) {
                Gemm g{hbuf, (const bf16_t*)(P.ws + WS_WIN) + (size_t)layer * 13568 * 1024, 1024, 1024, 1024, 66, 53, 0, 0, 0, 0, 0};
                EpiProj E{proj};
                for (int rp = 0; rp < REP(2); ++rp) gemm_phase<EpiProj, 1>(ldsl, g, E);
            }
            else if (sp == 2) {
                for (int it = blockIdx.x; it < 3972 + 256; it += gridDim.x) {
                    if (it < 512) { for (int rp = 0; rp < REP(3); ++rp) ssd_pass1_item(P, layer, it, lds_raw); }
                    else if (it < 1024) { for (int rp = (DRYM & 1) ? 0 : 1; rp < 2; ++rp) attn_prompt_item(P, layer, it - 512, lds_raw, rp == 0 && P.ph_lo == 0); }
                    else if (it < 1536) { for (int rp = (DRYM & 2) ? 0 : 1; rp < 2; ++rp) attn_sample_item(P, layer, it - 1024, (float*)lds_raw, rp == 0 && P.ph_lo == 0); }
                    else if (it < 2560) { for (int rp = (DRYM & 4) ? 0 : 1; rp < 2; ++rp) gmlp_prompt_item(P, layer, it - 1536, lds_raw, rp == 0 && P.ph_lo == 0); }
                    else if (it < 2688) { if (EN(8)) gmlp_sample_item(P, layer, it - 2560, (float*)lds_raw); }
                    else if (it < 3840) { if (EN(9)) shortconv_item(P, layer, it - 2688); }
                    else if (it < 3972) ssdconv_state_item(P, layer, it - 3840);
                    else ssd_item<2>(P, layer, it - 3972, (float*)lds_raw);
                }
            }
            else if (sp == 3) { phase_ssd_scan(P, layer); }
            else if (sp == 4) { for (int it = blockIdx.x; it < 512; it += gridDim.x) ssd_pass3_item(P, layer, it, lds_raw); }
            else if (sp == 5) {
                Gemm g{proj, (const bf16_t*)(P.ws + WS_WBR) + (size_t)layer * 4 * 1048576, LDP, 1024, 1024, 64, 4, C_Z, C_BCX, C_Q, C_UV, (size_t)1048576};
                EpiBranch E{proj, (float*)(P.ws + WS_MSUM), hbuf};
                for (int rp = 0; rp < REP(11); ++rp) gemm_phase<EpiBranch, 4>(ldsl, g, E);
                sample_branch(P, layer, (float*)lds_raw);
            }
            else if (sp == 6) {
                Gemm g{hbuf, (const bf16_t*)(P.ws + WS_WO) + (size_t)layer * 1048576, 1024, 1024, 1024, 64, 4, 0, 0, 0, 0, 0};
                EpiResid E{xin_p, xin_s, xbuf, modL + 2048};
                if (EN(12)) gemm_phase<EpiResid, 1>(ldsl, g, E);
                sample_resid(P, hbuf + (size_t)NPR * 1024, 1024, (const bf16_t*)(P.ws + WS_WO) + (size_t)layer * 1048576, 1024, xin_s, xbuf, modL + 2048, (float*)lds_raw);
            }
            else if (sp == 7) { for (int rp = 0; rp < REP(16); ++rp) phase_norm(xbuf, xbuf + (size_t)NPR * 1024, P.in[28] + layer * 1024, modL, 3072, 4096, hbuf); }
            else if (sp == 8) {
                Gemm g{hbuf, (const bf16_t*)(P.ws + WS_WUP) + (size_t)layer * 5632 * 1024, 1024, 1024, 1024, 66, 22, 0, 0, 0, 0, 0};
                EpiUp E{proj};
                for (int rp = 0; rp < REP(13); ++rp) gemm_phase<EpiUp, 1>(ldsl, g, E);
            }
            else if (sp == 9) { for (int rp = 0; rp < REP(14); ++rp) phase_ffn_act(P, layer); }
            else {
                Gemm g{(const bf16_t*)(P.ws + WS_PROJ + UP_BYTES), (const bf16_t*)(P.ws + WS_WDN) + (size_t)layer * 1024 * 2816, 2816, 2816, 2816, 64, 4, 0, 0, 0, 0, 0};
                EpiResid E{xbuf, xbuf + (size_t)NPR * 1024, xbuf, modL + 5120};
                if (EN(15)) gemm_phase<EpiResid, 1>(ldsl, g, E);
                sample_resid(P, (const bf16_t*)(P.ws + WS_PROJ + UP_BYTES) + (size_t)NPR * 2816, 2816, (const bf16_t*)(P.ws + WS_WDN) + (size_t)layer * 1024 * 2816, 2816, xbuf + (size_t)NPR * 1024, xbuf, modL + 5120, (float*)lds_raw);
            }
        }
        if (ph + 1 < P.ph_hi) { if (ph == 0) grid.sync(); else grid_bar(barctr, epoch); }
    }
}

extern "C" void kernel_launch(void* const* d_in, const int* in_sizes, int n_in, void* d_out, int out_size, void* d_ws, size_t ws_size, hipStream_t stream) {
    static int grid_blocks = 0;
    if (grid_blocks == 0) {
        if (n_in != 34 || (size_t)out_size != O_END || ws_size < WS_END + 256) { fprintf(stderr, "kernel_launch: unexpected sizes n_in %d out %d ws %zu (need %zu)\n", n_in, out_size, ws_size, (size_t)WS_END); grid_blocks = -1; return; }
        int dev = 0, cus = 0, per_cu = 0;
        (void)hipGetDevice(&dev); (void)hipDeviceGetAttribute(&cus, hipDeviceAttributeMultiprocessorCount, dev);
        if (hipFuncSetAttribute((const void*)mega_fwd, hipFuncAttributeMaxDynamicSharedMemorySize, LDS_BYTES) != hipSuccess) { fprintf(stderr, "hipFuncSetAttribute failed\n"); grid_blocks = -1; return; }
        if (hipOccupancyMaxActiveBlocksPerMultiprocessor(&per_cu, (const void*)mega_fwd, 512, LDS_BYTES) != hipSuccess || per_cu < 1) per_cu = 1;
        grid_blocks = cus * 1;
    }
    if (grid_blocks < 0) return;
    Params p{};
    for (int i = 0; i < 34; ++i) p.in[i] = (const float*)d_in[i];
    p.out = (float*)d_out; p.ws = (unsigned char*)d_ws; p.ph_lo = 0; p.ph_hi = N_PHASES;
    (void)hipMemsetAsync((unsigned char*)d_ws + WS_BAR, 0, 256, stream);
    void* args[] = {&p};
    hipError_t e = hipLaunchCooperativeKernel((const void*)mega_fwd, dim3(grid_blocks), dim3(512), args, LDS_BYTES, stream);
    if (e != hipSuccess) fprintf(stderr, "cooperative launch failed: %s (grid %d)\n", hipGetErrorString(e), grid_blocks);
}
```

```cpp
#include <hip/hip_runtime.h>
#include <hip/hip_cooperative_groups.h>
#include <cstdio>
namespace cg = cooperative_groups;

typedef unsigned short bf16_t;
typedef short bf16x8 __attribute__((ext_vector_type(8)));
typedef float f32x4 __attribute__((ext_vector_type(4)));
typedef unsigned u32x4 __attribute__((ext_vector_type(4)));
typedef unsigned u32x2 __attribute__((ext_vector_type(2)));
#define LAS __attribute__((address_space(3)))

constexpr int NTOK = 16896, NPR = 16384;
constexpr int LDP = 13568;
constexpr int C_Z = 0, C_XBC = 1024, C_DTR = 2560, C_BCX = 2576, C_Q = 5648, C_K = 6672, C_V = 6928, C_UV = 7184, C_GATE = 9232, C_END = 13328;
constexpr int NCOND = 132;
constexpr float EPSF = 1e-6f;

constexpr size_t WS_WIN = 0;
constexpr size_t WS_WBR = WS_WIN + (size_t)4 * 13568 * 1024 * 2;
constexpr size_t WS_WO = WS_WBR + (size_t)16 * 1024 * 1024 * 2;
constexpr size_t WS_WUP = WS_WO + (size_t)4 * 1024 * 1024 * 2;
constexpr size_t WS_WDN = WS_WUP + (size_t)4 * 5632 * 1024 * 2;
constexpr size_t WS_WADA = WS_WDN + (size_t)4 * 1024 * 2816 * 2;
constexpr size_t WS_CACT = WS_WADA + (size_t)4 * 6144 * 1024 * 2;
constexpr size_t WS_MOD = WS_CACT + (size_t)256 * 1024 * 2;
constexpr size_t WS_H = WS_MOD + (size_t)4 * NCOND * 6144 * 4;
constexpr size_t WS_MSUM = WS_H + (size_t)NTOK * 1024 * 2;
constexpr size_t WS_PROJ = WS_MSUM + (size_t)NTOK * 1024 * 4;
constexpr size_t WS_END = WS_PROJ + (size_t)NTOK * LDP * 2;
constexpr size_t WS_BAR = WS_END;
constexpr size_t WS_SSDST = WS_WADA;
constexpr size_t WS_SSDDEC = WS_WADA + (size_t)4 * 32 * 16 * 4096 * 4;
constexpr size_t UP_BYTES = (size_t)NTOK * 5632 * 2;

constexpr size_t O_YP = 0, O_YS = 16777216, O_PSSM = O_YS + 524288, O_PSSDC = O_PSSM + 1048576, O_PSCC = O_PSSDC + 73728,
                 O_PK = O_PSCC + 32768, O_PV = O_PK + 524288, O_PFFC = O_PV + 524288, O_SSSM = O_PFFC + 180224,
                 O_SSSDC = O_SSSM + 33554432, O_SSCC = O_SSSDC + 2359296, O_SK = O_SSCC + 1048576, O_SV = O_SK + 16777216,
                 O_SFFC = O_SV + 16777216, O_SGMV = O_SFFC + 5767168, O_END = O_SGMV + 2097152;

struct Params { const float* in[34]; float* out; unsigned char* ws; int ph_lo, ph_hi; };

constexpr int LDS_BYTES = 155648;

__device__ __forceinline__ float bf2f(bf16_t v) { return __uint_as_float((unsigned)v << 16); }
__device__ __forceinline__ float bflo(unsigned v) { return __uint_as_float(v << 16); }
__device__ __forceinline__ float bfhi(unsigned v) { return __uint_as_float(v & 0xffff0000u); }
__device__ __forceinline__ unsigned pk2(float lo, float hi) { unsigned r; asm("v_cvt_pk_bf16_f32 %0, %1, %2" : "=v"(r) : "v"(lo), "v"(hi)); return r; }
__device__ __forceinline__ bf16_t f2bf(float f) { return (bf16_t)(pk2(f, 0.f) & 0xffffu); }
__device__ __forceinline__ float shx(float v, int o, int lane) { return __int_as_float(__builtin_amdgcn_ds_bpermute((lane ^ o) << 2, __float_as_int(v))); }
__device__ __forceinline__ float wave_sum(float v, int lane) {
#pragma unroll
    for (int o = 32; o > 0; o >>= 1) v += shx(v, o, lane);
    return v;
}
__device__ __forceinline__ int otid() { int t = threadIdx.x; asm volatile("" : "+v"(t)); return t; }
__device__ __forceinline__ float sigmoidf_(float x) { return 1.f / (1.f + __expf(-x)); }
__device__ __forceinline__ float siluf_(float x) { return x / (1.f + __expf(-x)); }
__device__ __forceinline__ float geluf_(float x) { const float u = 0.7978845608f * (x + 0.044715f * x * x * x); return x / (1.f + __expf(-2.f * u)); }
__device__ __forceinline__ float softplusf_(float x) { return fmaxf(x, 0.f) + log1pf(__expf(-fabsf(x))); }
__device__ __forceinline__ float silu_fast(float x) { return x * __builtin_amdgcn_rcpf(1.f + __expf(-x)); }
__device__ __forceinline__ float sigmoid_fast(float x) { return __builtin_amdgcn_rcpf(1.f + __expf(-x)); }
__device__ __forceinline__ float gelu_fast(float x) { const float u = 0.7978845608f * (x + 0.044715f * x * x * x); return x * __builtin_amdgcn_rcpf(1.f + __expf(-2.f * u)); }
__device__ __forceinline__ int cond_row(int r) { return r < NPR ? (r >> 12) : 4 + ((r - NPR) >> 2); }
__device__ __forceinline__ int seq_start(int r) { return r < NPR ? (r & ~4095) : NPR + ((r - NPR) & ~3); }

constexpr int BM = 256, BK = 64, HALF = 128, HTB = HALF * BK * 2;
__device__ __forceinline__ int lds_byte(int r, int c) { const int st = (r >> 4) * 2 + (c >> 5), rr = r & 15, cc = c & 31, ob = rr * 64 + cc * 2; return st * 1024 + (ob ^ (((ob >> 9) & 1) << 5)); }
__device__ __forceinline__ void stage_rc(int b, int& R, int& C) { const int st = b / 1024, sb = b % 1024, swz = sb ^ (((sb >> 9) & 1) << 5); R = (st >> 1) * 16 + swz / 64; C = (st & 1) * 32 + (swz % 64) / 2; }
__device__ __forceinline__ int perm32(int rho) { const int n = rho >> 4, i = rho & 15; return 8 * (i >> 2) + 4 * n + (i & 3); }

struct Unit { int pm, pn, z; };
struct Gemm { const bf16_t* A; const bf16_t* Bt; int lda, ldb, K, nM, nN; int ao0, ao1, ao2, ao3; size_t zB; };
__device__ __forceinline__ int gemm_aofs(const Gemm& g, int z) { return z == 0 ? g.ao0 : (z == 1 ? g.ao1 : (z == 2 ? g.ao2 : g.ao3)); }

template <int ZN> __device__ __forceinline__ bool unit_next(const Gemm& g, int i, Unit& u) {
    const int tile = i / ZN; u.z = i - tile * ZN;
    const long L = (long)tile * gridDim.x + blockIdx.x; const int nwg = g.nM * g.nN; if (L >= nwg) return false;
    int wgid = (int)L; { const int q = nwg / 8, r = nwg % 8, xcd = wgid % 8, off = wgid / 8; wgid = (xcd < r ? xcd * (q + 1) : r * (q + 1) + (xcd - r) * q) + off; }
    const int nig = 8 * g.nN, gid = wgid / nig, fm = gid * 8, gsz = (g.nM - fm) < 8 ? (g.nM - fm) : 8;
    u.pm = fm + ((wgid % nig) % gsz); u.pn = (wgid % nig) / gsz; return true;
}

template <class Epi, int ZN>
__device__ __forceinline__ void gemm_phase(LAS unsigned char* lds, const Gemm g, const Epi& E) {
    const int tid = otid(), wid = __builtin_amdgcn_readfirstlane(tid >> 6), lane = tid & 63, wr = wid >> 2, wc = wid & 3, fr = lane & 15, fq = lane >> 4;
    const int K = g.K, nt = K / BK;
    unsigned voffA[2], voffB[2];
#pragma unroll
    for (int i = 0; i < 2; ++i) { int R, C; stage_rc(tid * 16 + i * 8192, R, C); const int Rb = Epi::PERM ? ((R & ~31) + perm32(R & 31)) : R;
        voffA[i] = (unsigned)(R * g.lda + C) * 2u; voffB[i] = (unsigned)(Rb * g.ldb + C) * 2u; }
    const size_t kstep = (size_t)(BK * 2);
    const size_t hstepA = (size_t)HALF * g.lda * 2, hstepB = (size_t)HALF * g.ldb * 2;
    const size_t tstepA = 2 * hstepA, tstepB = 2 * hstepB;
    const unsigned ldsw = (unsigned)wid * 1024u;
    const int aoff = lds_byte(wr * 64 + fr, fq * 8), boff = lds_byte(wc * 32 + fr, fq * 8);
#define PG8_SA(b, h) (((b) * 2 + (h)) * HTB)
#define PG8_SB(b, h) ((4 + (b) * 2 + (h)) * HTB)
#define PG8_STAGE(bufoff, gbase, voff) do { _Pragma("unroll") for (int _i = 0; _i < 2; ++_i) \
        __builtin_amdgcn_global_load_lds((const unsigned*)((const char*)(gbase) + (voff)[_i]), (LAS unsigned*)(lds + (bufoff) + ldsw + _i * 8192), 16, 0, 0); } while (0)
#define PG8_LDA(dst, b, h) do { _Pragma("unroll") for (int m = 0; m < 4; ++m) _Pragma("unroll") for (int k = 0; k < 2; ++k) dst[m][k] = *(const LAS bf16x8*)(lds + PG8_SA(b, h) + aoff + m * 2048 + k * 1024); } while (0)
#define PG8_LDB(dst, b, h) do { _Pragma("unroll") for (int n = 0; n < 2; ++n) _Pragma("unroll") for (int k = 0; k < 2; ++k) dst[n][k] = *(const LAS bf16x8*)(lds + PG8_SB(b, h) + boff + n * 2048 + k * 1024); } while (0)
#define PG8_MMA(ai, bj, At, Bt) do { __builtin_amdgcn_s_setprio(1); _Pragma("unroll") for (int m = 0; m < 4; ++m) _Pragma("unroll") for (int n = 0; n < 2; ++n) _Pragma("unroll") for (int k = 0; k < 2; ++k) \
        acc[ai][bj][m][n] = __builtin_amdgcn_mfma_f32_16x16x32_bf16(Bt[n][k], At[m][k], acc[ai][bj][m][n], 0, 0, 0); __builtin_amdgcn_s_setprio(0); } while (0)
#define PG8_WAIT_V(n) asm volatile("s_waitcnt vmcnt(" #n ")" ::: "memory")
#define PG8_WAIT_L(n) asm volatile("s_waitcnt lgkmcnt(" #n ")" ::: "memory")
#define PG8_BAR __builtin_amdgcn_s_barrier()
#define PG8_SCHED __builtin_amdgcn_sched_barrier(0)
    Unit cur, nxt; int ui = 0;
    if (!unit_next<ZN>(g, 0, cur)) return;
    f32x4 acc[2][2][4][2];
#pragma unroll
    for (int a = 0; a < 2; ++a)
#pragma unroll
        for (int b = 0; b < 2; ++b)
#pragma unroll
            for (int m = 0; m < 4; ++m)
#pragma unroll
                for (int n = 0; n < 2; ++n) acc[a][b][m][n] = (f32x4){0.f, 0.f, 0.f, 0.f};
    bf16x8 At[4][2], B0[2][2], B1[2][2];
    const char* cA = (const char*)g.A + (size_t)cur.pm * tstepA + (size_t)gemm_aofs(g, cur.z) * 2;
    const char* cB = (const char*)g.Bt + (size_t)cur.pn * tstepB + (size_t)cur.z * g.zB * 2;
    PG8_WAIT_V(0);
    PG8_STAGE(PG8_SB(0, 0), cB, voffB); PG8_STAGE(PG8_SA(0, 0), cA, voffA); PG8_STAGE(PG8_SB(0, 1), cB + hstepB, voffB); PG8_STAGE(PG8_SA(0, 1), cA + hstepA, voffA);
    if (wr == 1) PG8_BAR;
    PG8_WAIT_V(4); PG8_BAR;
    PG8_STAGE(PG8_SB(1, 0), cB + kstep, voffB); PG8_STAGE(PG8_SA(1, 0), cA + kstep, voffA); PG8_STAGE(PG8_SB(1, 1), cB + hstepB + kstep, voffB);
    PG8_WAIT_V(6); PG8_BAR;
    for (;;) {
        const bool has_next = unit_next<ZN>(g, ui + 1, nxt);
        const char* nA = has_next ? (const char*)g.A + (size_t)nxt.pm * tstepA + (size_t)gemm_aofs(g, nxt.z) * 2 : cA;
        const char* nB = has_next ? (const char*)g.Bt + (size_t)nxt.pn * tstepB + (size_t)nxt.z * g.zB * 2 : cB;
        for (int t = 0; t < nt; t += 2) {
            const bool last = (t == nt - 2);
            const char* a1 = cA + (size_t)(t + 1) * kstep;
            const char* a2 = last ? nA : cA + (size_t)(t + 2) * kstep; const char* b2 = last ? nB : cB + (size_t)(t + 2) * kstep;
            const char* a3 = a2 + kstep; const char* b3 = b2 + kstep;
            PG8_LDB(B0, 0, 0); PG8_SCHED; PG8_LDA(At, 0, 0); PG8_STAGE(PG8_SA(1, 1), a1 + hstepA, voffA);
            PG8_WAIT_L(8); PG8_BAR; PG8_WAIT_L(0); PG8_MMA(0, 0, At, B0); PG8_BAR; PG8_SCHED;
            PG8_LDB(B1, 0, 1); PG8_STAGE(PG8_SB(0, 0), b2, voffB);
            PG8_BAR; PG8_WAIT_L(0); PG8_MMA(0, 1, At, B1); PG8_BAR;
            PG8_LDA(At, 0, 1); PG8_STAGE(PG8_SA(0, 0), a2, voffA);
            PG8_BAR; PG8_WAIT_L(0); PG8_MMA(1, 0, At, B0); PG8_BAR; PG8_SCHED;
            PG8_STAGE(PG8_SB(0, 1), b2 + hstepB, voffB);
            PG8_WAIT_V(6); PG8_BAR; PG8_MMA(1, 1, At, B1); PG8_BAR;
            PG8_LDB(B0, 1, 0); PG8_SCHED; PG8_LDA(At, 1, 0); PG8_STAGE(PG8_SA(0, 1), a2 + hstepA, voffA);
            PG8_WAIT_L(8); PG8_BAR; PG8_WAIT_L(0); PG8_MMA(0, 0, At, B0); PG8_BAR; PG8_SCHED;
            PG8_LDB(B1, 1, 1); PG8_STAGE(PG8_SB(1, 0), b3, voffB);
            PG8_BAR; PG8_WAIT_L(0); PG8_MMA(0, 1, At, B1); PG8_BAR;
            PG8_LDA(At, 1, 1); PG8_STAGE(PG8_SA(1, 0), a3, voffA);
            PG8_BAR; PG8_WAIT_L(0); PG8_MMA(1, 0, At, B0); PG8_BAR; PG8_SCHED;
            PG8_STAGE(PG8_SB(1, 1), b3 + hstepB, voffB);
            PG8_WAIT_V(6); PG8_BAR; PG8_MMA(1, 1, At, B1); PG8_BAR;
        }
        E(acc, cur, wr, wc, fr, fq);
        if (!has_next) break;
#pragma unroll
        for (int a = 0; a < 2; ++a)
#pragma unroll
            for (int b = 0; b < 2; ++b)
#pragma unroll
                for (int m = 0; m < 4; ++m)
#pragma unroll
                    for (int n = 0; n < 2; ++n) acc[a][b][m][n] = (f32x4){0.f, 0.f, 0.f, 0.f};
        cur = nxt; cA = nA; cB = nB; ++ui;
    }
    PG8_WAIT_V(0);
    if (wr == 0) PG8_BAR;
    PG8_BAR;
#undef PG8_SA
#undef PG8_SB
#undef PG8_STAGE
#undef PG8_LDA
#undef PG8_LDB
#undef PG8_MMA
#undef PG8_WAIT_V
#undef PG8_WAIT_L
#undef PG8_BAR
#undef PG8_SCHED
}

struct EpiMod {
    static constexpr bool PERM = false;
    float* mod; const float* bada;
    __device__ __forceinline__ void operator()(const f32x4 (&acc)[2][2][4][2], const Unit& u, int wr, int wc, int fr, int fq) const {
        f32x4 bv[2][2];
#pragma unroll
        for (int bj = 0; bj < 2; ++bj)
#pragma unroll
            for (int n = 0; n < 2; ++n) bv[bj][n] = *(const f32x4*)(bada + u.pn * BM + bj * HALF + wc * 32 + n * 16 + fq * 4);
#pragma unroll
        for (int ai = 0; ai < 2; ++ai)
#pragma unroll
            for (int m = 0; m < 4; ++m) { const int r = u.pm * BM + ai * HALF + wr * 64 + m * 16 + fr; if (r >= NCOND) continue;
#pragma unroll
                for (int bj = 0; bj < 2; ++bj)
#pragma unroll
                    for (int n = 0; n < 2; ++n) { const int c = u.pn * BM + bj * HALF + wc * 32 + n * 16 + fq * 4; const int layer = c / 6144, cc = c - layer * 6144;
                        *(f32x4*)(mod + ((size_t)(layer * NCOND + r)) * 6144 + cc) = acc[ai][bj][m][n] + bv[bj][n]; } }
    }
};
struct EpiProj {
    static constexpr bool PERM = true;
    bf16_t* O;
    __device__ __forceinline__ void operator()(const f32x4 (&acc)[2][2][4][2], const Unit& u, int wr, int wc, int fr, int fq) const {
#pragma unroll
        for (int bj = 0; bj < 2; ++bj) { const int c = u.pn * BM + bj * HALF + wc * 32 + fq * 8; const int mode = (c >= C_GATE) ? 2 : (c >= C_UV ? 1 : 0);
#pragma unroll
            for (int ai = 0; ai < 2; ++ai)
#pragma unroll
                for (int m = 0; m < 4; ++m) { const int r = u.pm * BM + ai * HALF + wr * 64 + m * 16 + fr;
                    float v[8];
#pragma unroll
                    for (int i = 0; i < 8; ++i) { float x = acc[ai][bj][m][i >> 2][i & 3]; v[i] = mode == 2 ? sigmoid_fast(x) : (mode == 1 ? gelu_fast(x) : x); }
                    u32x4 o; o[0] = pk2(v[0], v[1]); o[1] = pk2(v[2], v[3]); o[2] = pk2(v[4], v[5]); o[3] = pk2(v[6], v[7]);
                    *(u32x4*)(O + (size_t)r * LDP + c) = o; } }
    }
};
struct EpiUp {
    static constexpr bool PERM = true;
    bf16_t* O;
    __device__ __forceinline__ void operator()(const f32x4 (&acc)[2][2][4][2], const Unit& u, int wr, int wc, int fr, int fq) const {
#pragma unroll
        for (int bj = 0; bj < 2; ++bj) { const int c = u.pn * BM + bj * HALF + wc * 32 + fq * 8;
#pragma unroll
            for (int ai = 0; ai < 2; ++ai)
#pragma unroll
                for (int m = 0; m < 4; ++m) { const int r = u.pm * BM + ai * HALF + wr * 64 + m * 16 + fr;
                    const f32x4 a = acc[ai][bj][m][0], b = acc[ai][bj][m][1];
                    u32x4 o; o[0] = pk2(a[0], a[1]); o[1] = pk2(a[2], a[3]); o[2] = pk2(b[0], b[1]); o[3] = pk2(b[2], b[3]);
                    *(u32x4*)(O + (size_t)r * 5632 + c) = o; } }
    }
};
struct EpiBranch {
    static constexpr bool PERM = true;
    const bf16_t* proj; float* msum; bf16_t* merged;
    __device__ __forceinline__ void operator()(const f32x4 (&acc)[2][2][4][2], const Unit& u, int wr, int wc, int fr, int fq) const {
        const int z = u.z;
#pragma unroll
        for (int bj = 0; bj < 2; ++bj) { const int c = u.pn * BM + bj * HALF + wc * 32 + fq * 8;
#pragma unroll
            for (int ai = 0; ai < 2; ++ai) {
                u32x4 gt[4]; f32x4 s0[4], s1[4];
#pragma unroll
                for (int m = 0; m < 4; ++m) { const int r = u.pm * BM + ai * HALF + wr * 64 + m * 16 + fr;
                    gt[m] = *(const u32x4*)(proj + (size_t)r * LDP + C_GATE + z * 1024 + c);
                    s0[m] = (f32x4){0.f, 0.f, 0.f, 0.f}; s1[m] = s0[m];
                    if (z > 0) { const float* mp = msum + (size_t)r * 1024 + c; s0[m] = *(const f32x4*)mp; s1[m] = *(const f32x4*)(mp + 4); } }
#pragma unroll
                for (int m = 0; m < 4; ++m) { const int r = u.pm * BM + ai * HALF + wr * 64 + m * 16 + fr; float* mp = msum + (size_t)r * 1024 + c;
                    const f32x4 a = acc[ai][bj][m][0], b = acc[ai][bj][m][1]; const u32x4 gv = gt[m]; f32x4 t0 = s0[m], t1 = s1[m];
                    t0[0] += bflo(gv[0]) * a[0]; t0[1] += bfhi(gv[0]) * a[1]; t0[2] += bflo(gv[1]) * a[2]; t0[3] += bfhi(gv[1]) * a[3];
                    t1[0] += bflo(gv[2]) * b[0]; t1[1] += bfhi(gv[2]) * b[1]; t1[2] += bflo(gv[3]) * b[2]; t1[3] += bfhi(gv[3]) * b[3];
                    if (z < 3) { *(f32x4*)mp = t0; *(f32x4*)(mp + 4) = t1; }
                    else { u32x4 o; o[0] = pk2(t0[0], t0[1]); o[1] = pk2(t0[2], t0[3]); o[2] = pk2(t1[0], t1[1]); o[3] = pk2(t1[2], t1[3]);
                        *(u32x4*)(merged + (size_t)r * 1024 + c) = o; } } } }
    }
};
struct EpiResid {
    static constexpr bool PERM = false;
    const float* xin_p; const float* xin_s; float* xout; const float* ga;
    __device__ __forceinline__ void operator()(const f32x4 (&acc)[2][2][4][2], const Unit& u, int wr, int wc, int fr, int fq) const {
        const float* gr = ga + (size_t)(u.pm >> 4) * 6144;
        f32x4 gv[2][2];
#pragma unroll
        for (int bj = 0; bj < 2; ++bj)
#pragma unroll
            for (int n = 0; n < 2; ++n) gv[bj][n] = *(const f32x4*)(gr + u.pn * BM + bj * HALF + wc * 32 + n * 16 + fq * 4);
#pragma unroll
        for (int am = 0; am < 4; ++am) { const int ai = am >> 1, m0 = (am & 1) * 2;
            f32x4 xv[2][2][2];
#pragma unroll
            for (int mm = 0; mm < 2; ++mm) { const int r = u.pm * BM + ai * HALF + wr * 64 + (m0 + mm) * 16 + fr;
#pragma unroll
                for (int bj = 0; bj < 2; ++bj)
#pragma unroll
                    for (int n = 0; n < 2; ++n) xv[mm][bj][n] = *(const f32x4*)(xin_p + (size_t)r * 1024 + u.pn * BM + bj * HALF + wc * 32 + n * 16 + fq * 4); }
#pragma unroll
            for (int mm = 0; mm < 2; ++mm) { const int r = u.pm * BM + ai * HALF + wr * 64 + (m0 + mm) * 16 + fr;
#pragma unroll
                for (int bj = 0; bj < 2; ++bj)
#pragma unroll
                    for (int n = 0; n < 2; ++n) *(f32x4*)(xout + (size_t)r * 1024 + u.pn * BM + bj * HALF + wc * 32 + n * 16 + fq * 4) = xv[mm][bj][n] + gv[bj][n] * acc[ai][bj][m0 + mm][n]; } }
    }
};

struct CTile { const float* src; bf16_t* dst; int K, N, k0, n0; };
__device__ __forceinline__ CTile conv_decode(const Params& P, int t) {
    constexpr int T_IN = 3392, T_BR = 1024, T_O = 256, T_UP = 1408, T_DN = 704, T_ADA = 1536, T_L = T_IN + T_BR + T_O + T_UP + T_DN + T_ADA;
    const int layer = t / T_L; int r = t - layer * T_L; CTile c;
    if (r < T_IN) { c.src = P.in[13] + (size_t)layer * 1024 * 13328; c.dst = (bf16_t*)(P.ws + WS_WIN) + (size_t)layer * 13568 * 1024; c.K = 1024; c.N = 13328; c.k0 = (r / 212) * 64; c.n0 = (r % 212) * 64; return c; }
    r -= T_IN;
    if (r < T_BR) { const int br = r >> 8, q = r & 255; c.src = P.in[26] + (size_t)(layer * 4 + br) * 1048576; c.dst = (bf16_t*)(P.ws + WS_WBR) + (size_t)(layer * 4 + br) * 1048576; c.K = 1024; c.N = 1024; c.k0 = (q >> 4) * 64; c.n0 = (q & 15) * 64; return c; }
    r -= T_BR;
    if (r < T_O) { c.src = P.in[27] + (size_t)layer * 1048576; c.dst = (bf16_t*)(P.ws + WS_WO) + (size_t)layer * 1048576; c.K = 1024; c.N = 1024; c.k0 = (r >> 4) * 64; c.n0 = (r & 15) * 64; return c; }
    r -= T_O;
    if (r < T_UP) { c.src = P.in[29] + (size_t)layer * 1024 * 5632; c.dst = (bf16_t*)(P.ws + WS_WUP) + (size_t)layer * 5632 * 1024; c.K = 1024; c.N = 5632; c.k0 = (r / 88) * 64; c.n0 = (r % 88) * 64; return c; }
    r -= T_UP;
    if (r < T_DN) { c.src = P.in[32] + (size_t)layer * 2816 * 1024; c.dst = (bf16_t*)(P.ws + WS_WDN) + (size_t)layer * 1024 * 2816; c.K = 2816; c.N = 1024; c.k0 = (r >> 4) * 64; c.n0 = (r & 15) * 64; return c; }
    r -= T_DN;
    c.src = P.in[10] + (size_t)layer * 1024 * 6144; c.dst = (bf16_t*)(P.ws + WS_WADA) + (size_t)layer * 6144 * 1024; c.K = 1024; c.N = 6144; c.k0 = (r / 96) * 64; c.n0 = (r % 96) * 64; return c;
}
__device__ __forceinline__ void phase_convert(const Params& P, float* T) {
    constexpr int NT = 4 * 8320;
    const int tid = otid();
    int t = blockIdx.x;
    CTile cur = conv_decode(P, t < NT ? t : 0);
    float v[8], nv[8];
#pragma unroll
    for (int e = 0; e < 8; ++e) { const int idx = tid + e * 512, k = idx >> 6, n = idx & 63; v[e] = (t < NT && cur.n0 + n < cur.N) ? cur.src[(size_t)(cur.k0 + k) * cur.N + cur.n0 + n] : 0.f; }
    for (; t < NT; t += gridDim.x) {
        const int tn = t + gridDim.x; const bool hn = tn < NT; const CTile nxt = conv_decode(P, hn ? tn : 0);
#pragma unroll
        for (int e = 0; e < 8; ++e) { const int idx = tid + e * 512, k = idx >> 6, n = idx & 63; nv[e] = (hn && nxt.n0 + n < nxt.N) ? nxt.src[(size_t)(nxt.k0 + k) * nxt.N + nxt.n0 + n] : 0.f; }
#pragma unroll
        for (int e = 0; e < 8; ++e) { const int idx = tid + e * 512, k = idx >> 6, n = idx & 63; T[k * 65 + n] = v[e]; }
        __syncthreads();
        { const int n = tid >> 3, kc = (tid & 7) * 8; float x[8];
#pragma unroll
          for (int j = 0; j < 8; ++j) x[j] = T[(kc + j) * 65 + n];
          u32x4 o; o[0] = pk2(x[0], x[1]); o[1] = pk2(x[2], x[3]); o[2] = pk2(x[4], x[5]); o[3] = pk2(x[6], x[7]);
          *(u32x4*)(cur.dst + (size_t)(cur.n0 + n) * cur.K + cur.k0 + kc) = o; }
        __syncthreads();
#pragma unroll
        for (int e = 0; e < 8; ++e) v[e] = nv[e];
        cur = nxt;
    }
    bf16_t* cact = (bf16_t*)(P.ws + WS_CACT);
    for (int i = blockIdx.x * 512 + otid(); i < 256 * 1024; i += gridDim.x * 512) {
        const int r = i >> 10, c = i & 1023; float v = 0.f;
        if (r < 4) v = siluf_(P.in[2][r * 1024 + c]); else if (r < NCOND) v = siluf_(P.in[3][(r - 4) * 1024 + c]);
        cact[i] = f2bf(v);
    }
}

__device__ __forceinline__ void phase_norm(const float* xp, const float* xs, const float* g, const float* modL, int shofs, int scofs, bf16_t* hout) {
    const int tid = otid(); const int w = tid >> 6, lane = tid & 63;
    for (int r = blockIdx.x * 8 + w; r < NTOK; r += gridDim.x * 8) {
        const float* x = r < NPR ? xp + (size_t)r * 1024 : xs + (size_t)(r - NPR) * 1024;
        const float* mr = modL + (size_t)cond_row(r) * 6144;
        f32x4 v[4]; float ss = 0.f;
#pragma unroll
        for (int i = 0; i < 4; ++i) { v[i] = *(const f32x4*)(x + i * 256 + lane * 4); ss += v[i][0] * v[i][0] + v[i][1] * v[i][1] + v[i][2] * v[i][2] + v[i][3] * v[i][3]; }
        ss = wave_sum(ss, lane); const float rs = rsqrtf(ss * (1.f / 1024.f) + EPSF);
#pragma unroll
        for (int i = 0; i < 4; ++i) { const int c = i * 256 + lane * 4;
            const f32x4 gv = *(const f32x4*)(g + c), sc = *(const f32x4*)(mr + scofs + c), sh = *(const f32x4*)(mr + shofs + c);
            f32x4 o = v[i] * rs * gv * (sc + 1.f) + sh;
            u32x2 pk; pk[0] = pk2(o[0], o[1]); pk[1] = pk2(o[2], o[3]);
            *(u32x2*)(hout + (size_t)r * 1024 + c) = pk; }
    }
}
__device__ __forceinline__ void phase_final_norm(float* x, const float* g) {
    const int tid = otid(); const int w = tid >> 6, lane = tid & 63;
    for (int r = blockIdx.x * 8 + w; r < NTOK; r += gridDim.x * 8) {
        float* xr = x + (size_t)r * 1024; f32x4 v[4]; float ss = 0.f;
#pragma unroll
        for (int i = 0; i < 4; ++i) { v[i] = *(const f32x4*)(xr + i * 256 + lane * 4); ss += v[i][0] * v[i][0] + v[i][1] * v[i][1] + v[i][2] * v[i][2] + v[i][3] * v[i][3]; }
        ss = wave_sum(ss, lane); const float rs = rsqrtf(ss * (1.f / 1024.f) + EPSF);
#pragma unroll
        for (int i = 0; i < 4; ++i) { const int c = i * 256 + lane * 4; const f32x4 gv = *(const f32x4*)(g + c); *(f32x4*)(xr + c) = v[i] * rs * gv; }
    }
}

template <int MODE>
__device__ __forceinline__ void ssd_item(const Params& P, int layer, int item, float* L) {
    const int tid = otid(), w = tid >> 6, lane = tid & 63;
    bf16_t* proj = (bf16_t*)(P.ws + WS_PROJ);
    float* states = (float*)(P.ws + WS_SSDST); float* decs = (float*)(P.ws + WS_SSDDEC);
    int r0, nsteps, half, seq0, b = 0, c = 0, sb = 0;
    if (MODE == 2) { sb = item >> 1; half = item & 1; r0 = NPR + sb * 4; nsteps = 4; seq0 = r0; }
    else { b = item >> 6; c = (item >> 1) & 31; half = item & 1; r0 = b * 4096 + c * 128; nsteps = 128; seq0 = b * 4096; }
    float* XS = L; float* ZS = XS + 16 * 512; float* BS = ZS + 16 * 512; float* CS = BS + 16 * 128; float* DTS = CS + 16 * 128; float* DAS = DTS + 128; float* SSQ = DAS + 128;
    const float* cw = P.in[14] + (size_t)layer * 4 * 1536; const float* cb = P.in[15] + (size_t)layer * 1536;
    const float* prev = P.in[5] + ((size_t)(layer * 128 + sb)) * 3 * 1536;
    const int hd = half * 8 + w, gl = w >> 2;
    float h[64];
    if (MODE == 0) {
#pragma unroll
        for (int n = 0; n < 64; ++n) h[n] = 0.f;
    } else {
        const float* s0p = (MODE == 1) ? states + ((size_t)((b * 32 + c) * 16 + hd)) * 4096 + lane * 64
                                       : P.in[4] + ((size_t)((layer * 128 + sb) * 16 + hd)) * 4096 + lane * 64;
#pragma unroll
        for (int n4 = 0; n4 < 16; ++n4) { const f32x4 v = *(const f32x4*)(s0p + n4 * 4); h[n4 * 4] = v[0]; h[n4 * 4 + 1] = v[1]; h[n4 * 4 + 2] = v[2]; h[n4 * 4 + 3] = v[3]; }
    }
    const float Dh = P.in[18][layer * 16 + hd];
    float decp = 1.f;
    for (int s0 = 0; s0 < nsteps; s0 += 16) {
        const int ns = (nsteps - s0) < 16 ? (nsteps - s0) : 16;
        __syncthreads();
        for (int idx = tid; idx < ns * 768; idx += 512) {
            const int t = idx / 768, ch = idx - t * 768;
            int cx;
            if (ch < 512) cx = half * 512 + ch; else if (ch < 640) cx = 1024 + half * 128 + (ch - 512); else cx = 1280 + half * 128 + (ch - 640);
            float a = cb[cx];
#pragma unroll
            for (int k = 0; k < 4; ++k) { const int step = s0 + t - 3 + k, rr = r0 + step; float raw;
                if (rr >= seq0) raw = bf2f(proj[(size_t)rr * LDP + C_XBC + cx]);
                else raw = (MODE == 2) ? prev[(3 + step) * 1536 + cx] : 0.f;
                a += cw[k * 1536 + cx] * raw; }
            a = siluf_(a);
            if (ch < 512) { XS[t * 512 + ch] = a; if (MODE != 0) ZS[t * 512 + ch] = bf2f(proj[(size_t)(r0 + s0 + t) * LDP + C_Z + cx]); }
            else if (ch < 640) BS[t * 128 + ch - 512] = a; else CS[t * 128 + ch - 640] = a;
        }
        if (tid < ns * 8) { const int t = tid >> 3, ww = tid & 7, hh = half * 8 + ww;
            const float dt = softplusf_(bf2f(proj[(size_t)(r0 + s0 + t) * LDP + C_DTR + hh]) + P.in[16][layer * 16 + hh]);
            DTS[t * 8 + ww] = dt; DAS[t * 8 + ww] = __expf(-dt * __expf(P.in[17][layer * 16 + hh])); }
        __syncthreads();
        for (int t = 0; t < ns; ++t) {
            const float a = DAS[t * 8 + w], dt = DTS[t * 8 + w], xv = XS[t * 512 + w * 64 + lane], xd = xv * dt; decp *= a;
            const f32x4* B4 = (const f32x4*)(BS + t * 128 + gl * 64);
#pragma unroll
            for (int n4 = 0; n4 < 16; ++n4) { const f32x4 bv = B4[n4];
                h[n4 * 4] = a * h[n4 * 4] + xd * bv[0]; h[n4 * 4 + 1] = a * h[n4 * 4 + 1] + xd * bv[1]; h[n4 * 4 + 2] = a * h[n4 * 4 + 2] + xd * bv[2]; h[n4 * 4 + 3] = a * h[n4 * 4 + 3] + xd * bv[3]; }
            if (MODE != 0) {
                const f32x4* C4 = (const f32x4*)(CS + t * 128 + gl * 64); float y0 = 0.f, y1 = 0.f;
#pragma unroll
                for (int n4 = 0; n4 < 16; ++n4) { const f32x4 cv = C4[n4]; y0 += h[n4 * 4] * cv[0] + h[n4 * 4 + 2] * cv[2]; y1 += h[n4 * 4 + 1] * cv[1] + h[n4 * 4 + 3] * cv[3]; }
                float y = y0 + y1 + Dh * xv; y *= siluf_(ZS[t * 512 + w * 64 + lane]);
                const float sq = wave_sum(y * y, lane); if (lane == 0) SSQ[(s0 + t) * 8 + w] = sq;
                proj[(size_t)(r0 + s0 + t) * LDP + C_Z + hd * 64 + lane] = f2bf(y);
            }
        }
    }
    if (MODE == 0) {
        float* sp = states + ((size_t)((b * 32 + c) * 16 + hd)) * 4096 + lane * 64;
#pragma unroll
        for (int n4 = 0; n4 < 16; ++n4) *(f32x4*)(sp + n4 * 4) = (f32x4){h[n4 * 4], h[n4 * 4 + 1], h[n4 * 4 + 2], h[n4 * 4 + 3]};
        if (lane == 0) decs[(b * 32 + c) * 16 + hd] = decp;
    }
    if (MODE == 2) {
        float* sp = P.out + O_SSSM + ((size_t)((layer * 128 + sb) * 16 + hd)) * 4096 + lane * 64;
#pragma unroll
        for (int n4 = 0; n4 < 16; ++n4) *(f32x4*)(sp + n4 * 4) = (f32x4){h[n4 * 4], h[n4 * 4 + 1], h[n4 * 4 + 2], h[n4 * 4 + 3]};
    }
    if (MODE != 0) {
        __syncthreads();
        const float ng = P.in[19][layer * 1024 + hd * 64 + lane];
        for (int t = 0; t < nsteps; ++t) {
            const float tot = SSQ[t * 8 + gl * 4] + SSQ[t * 8 + gl * 4 + 1] + SSQ[t * 8 + gl * 4 + 2] + SSQ[t * 8 + gl * 4 + 3];
            const float sc = rsqrtf(tot * (1.f / 256.f) + EPSF) * ng;
            bf16_t* ap = proj + (size_t)(r0 + t) * LDP + C_Z + hd * 64 + lane; *ap = f2bf(bf2f(*ap) * sc);
        }
    }
}

__device__ __forceinline__ int xt_idx(int row, int t) { return row * 136 + ((((t >> 3) ^ ((row >> 3) & 15)) << 3) | (t & 7)); }
__device__ __forceinline__ void ssd_stage_dt(const Params& P, int layer, const bf16_t* proj, size_t r0, int g, float* DT, float* ACS, int tid) {
    { const int hh = tid >> 7, t = tid & 127, hd = g * 4 + hh;
      const float dt = softplusf_(bf2f(proj[(r0 + t) * LDP + C_DTR + hd]) + P.in[16][layer * 16 + hd]);
      DT[hh * 128 + t] = dt; ACS[hh * 128 + t] = -dt * __expf(P.in[17][layer * 16 + hd]); }
    __syncthreads();
    if (tid < 256) { const int hh = tid >> 6, l = tid & 63; const float a0 = ACS[hh * 128 + 2 * l], a1 = ACS[hh * 128 + 2 * l + 1]; float sum = a0 + a1;
#pragma unroll
        for (int o = 1; o < 64; o <<= 1) { const float v = __int_as_float(__builtin_amdgcn_ds_bpermute(((l - o) & 63) << 2, __float_as_int(sum))); if (l >= o) sum += v; }
        ACS[hh * 128 + 2 * l] = sum - a1; ACS[hh * 128 + 2 * l + 1] = sum; }
    __syncthreads();
}
template <int PASS>
__device__ __forceinline__ void ssd_stage_conv(const Params& P, int layer, const bf16_t* proj, size_t r0, bool first, int g, const float* DT, const float* ACS, bf16_t* XT4, bf16_t* Bx, bf16_t* Cs, int tid) {
    const int slot = tid & 63, seg = tid >> 6;
    if (slot < (PASS ? 48 : 40)) {
        int cx; if (slot < 32) cx = g * 256 + slot * 8; else if (slot < 40) cx = 1024 + g * 64 + (slot - 32) * 8; else cx = 1280 + g * 64 + (slot - 40) * 8;
        const float* cw = P.in[14] + (size_t)layer * 4 * 1536 + cx; const float* cb = P.in[15] + (size_t)layer * 1536 + cx;
        float wt[4][8], bb[8], win[3][8];
#pragma unroll
        for (int k = 0; k < 4; ++k) { const f32x4 a = *(const f32x4*)(cw + k * 1536), c = *(const f32x4*)(cw + k * 1536 + 4);
#pragma unroll
            for (int i = 0; i < 4; ++i) { wt[k][i] = a[i]; wt[k][4 + i] = c[i]; } }
        { const f32x4 a = *(const f32x4*)cb, c = *(const f32x4*)(cb + 4);
#pragma unroll
          for (int i = 0; i < 4; ++i) { bb[i] = a[i]; bb[4 + i] = c[i]; } }
        const int t0 = seg * 16;
#pragma unroll
        for (int k = 0; k < 3; ++k) { u32x4 raw = (u32x4){0u, 0u, 0u, 0u};
            if (!(first && seg == 0)) raw = *(const u32x4*)(proj + (r0 + t0 - 3 + k) * LDP + C_XBC + cx);
#pragma unroll
            for (int i = 0; i < 4; ++i) { win[k][2 * i] = bflo(raw[i]); win[k][2 * i + 1] = bfhi(raw[i]); } }
        u32x4 cur4[4], nxt4[4];
#pragma unroll
        for (int q = 0; q < 4; ++q) { cur4[q] = *(const u32x4*)(proj + (r0 + t0 + q) * LDP + C_XBC + cx); nxt4[q] = cur4[q]; }
        for (int gq = 0; gq < 4; ++gq) {
            if (gq < 3) {
#pragma unroll
                for (int q = 0; q < 4; ++q) nxt4[q] = *(const u32x4*)(proj + (r0 + t0 + gq * 4 + 4 + q) * LDP + C_XBC + cx); }
#pragma unroll
            for (int q = 0; q < 4; ++q) {
                const int t = t0 + gq * 4 + q; const u32x4 raw = cur4[q];
                float cur[8], o[8];
#pragma unroll
                for (int i = 0; i < 4; ++i) { cur[2 * i] = bflo(raw[i]); cur[2 * i + 1] = bfhi(raw[i]); }
#pragma unroll
                for (int i = 0; i < 8; ++i) { o[i] = siluf_(bb[i] + wt[0][i] * win[0][i] + wt[1][i] * win[1][i] + wt[2][i] * win[2][i] + wt[3][i] * cur[i]); win[0][i] = win[1][i]; win[1][i] = win[2][i]; win[2][i] = cur[i]; }
                if (slot < 32) { const int hh = slot >> 3, p0 = (slot & 7) * 8; float sc = DT[hh * 128 + t]; if (PASS == 0) sc *= __expf(ACS[hh * 128 + 127] - ACS[hh * 128 + t]);
#pragma unroll
                    for (int i = 0; i < 8; ++i) XT4[xt_idx(hh * 64 + p0 + i, t)] = f2bf(o[i] * sc); }
                else if (slot < 40) { const int n0 = (slot - 32) * 8;
                    if (PASS == 0) {
#pragma unroll
                        for (int i = 0; i < 8; ++i) Bx[xt_idx(n0 + i, t)] = f2bf(o[i]); }
                    else { u32x4 pk; pk[0] = pk2(o[0], o[1]); pk[1] = pk2(o[2], o[3]); pk[2] = pk2(o[4], o[5]); pk[3] = pk2(o[6], o[7]); *(u32x4*)(Bx + t * 72 + n0) = pk; } }
                else { const int n0 = (slot - 40) * 8; u32x4 pk; pk[0] = pk2(o[0], o[1]); pk[1] = pk2(o[2], o[3]); pk[2] = pk2(o[4], o[5]); pk[3] = pk2(o[6], o[7]); *(u32x4*)(Cs + t * 72 + n0) = pk; }
            }
#pragma unroll
            for (int q = 0; q < 4; ++q) cur4[q] = nxt4[q];
        }
    }
}
__device__ __forceinline__ void ssd_pass1_item(const Params& P, int layer, int item, unsigned char* lds) {
    const int tid = otid(), w = __builtin_amdgcn_readfirstlane(tid >> 6), lane = tid & 63, fr = lane & 15, fq = lane >> 4;
    const int b = item >> 7, c = (item >> 2) & 31, g = item & 3; const size_t r0 = (size_t)b * 4096 + (size_t)c * 128;
    const bf16_t* proj = (const bf16_t*)(P.ws + WS_PROJ);
    float* states = (float*)(P.ws + WS_SSDST); float* decs = (float*)(P.ws + WS_SSDDEC);
    bf16_t* XT4 = (bf16_t*)lds; bf16_t* BT = XT4 + 256 * 136; float* DT = (float*)(BT + 64 * 136); float* ACS = DT + 512;
    __syncthreads();
    ssd_stage_dt(P, layer, proj, r0, g, DT, ACS, tid);
    ssd_stage_conv<0>(P, layer, proj, r0, c == 0, g, DT, ACS, XT4, BT, nullptr, tid);
    __syncthreads();
    const int hh = w >> 1, pb = (w & 1) * 2;
    f32x4 acc[2][4];
#pragma unroll
    for (int pi = 0; pi < 2; ++pi)
#pragma unroll
        for (int nt = 0; nt < 4; ++nt) acc[pi][nt] = (f32x4){0.f, 0.f, 0.f, 0.f};
#pragma unroll
    for (int ks = 0; ks < 4; ++ks) { bf16x8 a[2];
#pragma unroll
        for (int pi = 0; pi < 2; ++pi) a[pi] = *(const bf16x8*)(XT4 + xt_idx(hh * 64 + (pb + pi) * 16 + fr, ks * 32 + fq * 8));
#pragma unroll
        for (int nt = 0; nt < 4; ++nt) { const bf16x8 bv = *(const bf16x8*)(BT + xt_idx(nt * 16 + fr, ks * 32 + fq * 8));
#pragma unroll
            for (int pi = 0; pi < 2; ++pi) acc[pi][nt] = __builtin_amdgcn_mfma_f32_16x16x32_bf16(a[pi], bv, acc[pi][nt], 0, 0, 0); } }
    float* sp = states + ((size_t)((b * 32 + c) * 16 + g * 4 + hh)) * 4096;
#pragma unroll
    for (int pi = 0; pi < 2; ++pi)
#pragma unroll
        for (int nt = 0; nt < 4; ++nt)
#pragma unroll
            for (int j = 0; j < 4; ++j) sp[((pb + pi) * 16 + fq * 4 + j) * 64 + nt * 16 + fr] = acc[pi][nt][j];
    if (tid < 4) decs[(b * 32 + c) * 16 + g * 4 + tid] = __expf(ACS[tid * 128 + 127]);
}
__device__ __forceinline__ void ssd_pass3_item(const Params& P, int layer, int item, unsigned char* lds, bool dry = false) {
    const int tid = otid(), w = __builtin_amdgcn_readfirstlane(tid >> 6), lane = tid & 63, fr = lane & 15, fq = lane >> 4;
    const int b = item >> 7, c = (item >> 2) & 31, g = item & 3; const size_t r0 = (size_t)b * 4096 + (size_t)c * 128;
    bf16_t* proj = (bf16_t*)(P.ws + WS_PROJ);
    const float* states = (const float*)(P.ws + WS_SSDST);
    bf16_t* Cs = (bf16_t*)lds; bf16_t* Bs = Cs + 128 * 72; bf16_t* Sin = Bs; bf16_t* XT4 = Bs + 128 * 72; bf16_t* Ms = XT4 + 256 * 136; float* DT = (float*)(Ms + 128 * 136); float* ACS = DT + 512;
    __syncthreads();
    ssd_stage_dt(P, layer, proj, r0, g, DT, ACS, tid);
    ssd_stage_conv<1>(P, layer, proj, r0, c == 0, g, DT, ACS, XT4, Bs, Cs, tid);
    __syncthreads();
    f32x4 CB[8];
#pragma unroll
    for (int st = 0; st < 8; ++st) { CB[st] = (f32x4){0.f, 0.f, 0.f, 0.f};
        if (st <= w) {
#pragma unroll
            for (int ks = 0; ks < 2; ++ks) { const bf16x8 a = *(const bf16x8*)(Cs + (16 * w + fr) * 72 + ks * 32 + fq * 8), bv = *(const bf16x8*)(Bs + (16 * st + fr) * 72 + ks * 32 + fq * 8);
                CB[st] = __builtin_amdgcn_mfma_f32_16x16x32_bf16(a, bv, CB[st], 0, 0, 0); } } }
    float ssq[4] = {0.f, 0.f, 0.f, 0.f};
    const int nks = (w >> 1) + 1;
    bf16_t* zrow[4];
#pragma unroll
    for (int j = 0; j < 4; ++j) zrow[j] = proj + (r0 + 16 * w + fq * 4 + j) * LDP + C_Z + g * 256 + fr;
    f32x4 sna, snc;
    { const float* sp = states + ((size_t)((b * 32 + c) * 16 + g * 4)) * 4096 + (tid >> 3) * 64 + (tid & 7) * 8; sna = *(const f32x4*)sp; snc = *(const f32x4*)(sp + 4); }
    for (int hh = 0; hh < 4; ++hh) {
        const int hd = g * 4 + hh;
        __syncthreads();
        { const int p = tid >> 3, n0 = (tid & 7) * 8;
          u32x4 pk; pk[0] = pk2(sna[0], sna[1]); pk[1] = pk2(sna[2], sna[3]); pk[2] = pk2(snc[0], snc[1]); pk[3] = pk2(snc[2], snc[3]);
          *(u32x4*)(Sin + p * 72 + n0) = pk;
          if (hh < 3) { const float* sp = states + ((size_t)((b * 32 + c) * 16 + hd + 1)) * 4096 + p * 64 + n0; sna = *(const f32x4*)sp; snc = *(const f32x4*)(sp + 4); } }
        float acs_t[4];
#pragma unroll
        for (int j = 0; j < 4; ++j) acs_t[j] = ACS[hh * 128 + 16 * w + fq * 4 + j];
#pragma unroll
        for (int st = 0; st < 8; ++st) { if (st <= (w | 1)) { const float acs_s = ACS[hh * 128 + 16 * st + fr];
#pragma unroll
            for (int j = 0; j < 4; ++j) { const int t = 16 * w + fq * 4 + j, sx = 16 * st + fr; const float v = (st <= w && sx <= t) ? CB[st][j] * __expf(acs_t[j] - acs_s) : 0.f; Ms[t * 136 + sx] = f2bf(v); } } }
        __syncthreads();
        bf16_t zv[4][4];
#pragma unroll
        for (int j = 0; j < 4; ++j)
#pragma unroll
            for (int pt = 0; pt < 4; ++pt) zv[j][pt] = *(zrow[j] + hh * 64 + pt * 16);
        f32x4 yd[4], yo[4];
#pragma unroll
        for (int pt = 0; pt < 4; ++pt) { yd[pt] = (f32x4){0.f, 0.f, 0.f, 0.f}; yo[pt] = (f32x4){0.f, 0.f, 0.f, 0.f}; }
        for (int ks = 0; ks < nks; ++ks) { const bf16x8 a = *(const bf16x8*)(Ms + (16 * w + fr) * 136 + ks * 32 + fq * 8);
#pragma unroll
            for (int pt = 0; pt < 4; ++pt) { const bf16x8 bv = *(const bf16x8*)(XT4 + xt_idx(hh * 64 + pt * 16 + fr, ks * 32 + fq * 8)); yd[pt] = __builtin_amdgcn_mfma_f32_16x16x32_bf16(a, bv, yd[pt], 0, 0, 0); } }
#pragma unroll
        for (int ks = 0; ks < 2; ++ks) { const bf16x8 a = *(const bf16x8*)(Cs + (16 * w + fr) * 72 + ks * 32 + fq * 8);
#pragma unroll
            for (int pt = 0; pt < 4; ++pt) { const bf16x8 bv = *(const bf16x8*)(Sin + (pt * 16 + fr) * 72 + ks * 32 + fq * 8); yo[pt] = __builtin_amdgcn_mfma_f32_16x16x32_bf16(a, bv, yo[pt], 0, 0, 0); } }
        const float Dh = P.in[18][layer * 16 + hd];
#pragma unroll
        for (int j = 0; j < 4; ++j) { const int t = 16 * w + fq * 4 + j; const float et = __expf(acs_t[j]), idt = 1.f / DT[hh * 128 + t];
#pragma unroll
            for (int pt = 0; pt < 4; ++pt) { const int p = pt * 16 + fr; const float x = bf2f(XT4[xt_idx(hh * 64 + p, t)]) * idt;
                bf16_t* zp = zrow[j] + hh * 64 + pt * 16;
                float y = yd[pt][j] + et * yo[pt][j] + Dh * x; y *= silu_fast(bf2f(zv[j][pt])); ssq[j] += y * y; if (!dry) *zp = f2bf(y); } }
    }
    asm volatile("s_waitcnt vmcnt(0)" ::: "memory");
    const float* ng = P.in[19] + layer * 1024 + g * 256 + fr;
#pragma unroll
    for (int j = 0; j < 4; ++j) { float v = ssq[j];
#pragma unroll
        for (int o = 8; o > 0; o >>= 1) v += shx(v, o, lane);
        ssq[j] = rsqrtf(v * (1.f / 256.f) + EPSF); }
    for (int hb = 0; hb < 16; hb += 4) { bf16_t yv[4][4]; float gv[4];
#pragma unroll
        for (int q = 0; q < 4; ++q) { gv[q] = ng[(hb + q) * 16];
#pragma unroll
            for (int j = 0; j < 4; ++j) yv[q][j] = *(zrow[j] + (hb + q) * 16); }
#pragma unroll
        for (int q = 0; q < 4; ++q)
#pragma unroll
            for (int j = 0; j < 4; ++j) { if (!dry) *(zrow[j] + (hb + q) * 16) = f2bf(bf2f(yv[q][j]) * ssq[j] * gv[q]); } }
}
__device__ __forceinline__ void phase_ssd_scan(const Params& P, int layer) {
    float* states = (float*)(P.ws + WS_SSDST); const float* decs = (const float*)(P.ws + WS_SSDDEC);
    for (int e = blockIdx.x * 512 + otid(); e < 4 * 16 * 4096; e += gridDim.x * 512) {
        const int b = e >> 16, hd = (e >> 12) & 15, pn = e & 4095; float carry = 0.f;
        float st[32], dc[32];
#pragma unroll
        for (int c = 0; c < 32; ++c) { st[c] = states[((size_t)((b * 32 + c) * 16 + hd)) * 4096 + pn]; dc[c] = decs[(b * 32 + c) * 16 + hd]; }
#pragma unroll
        for (int c = 0; c < 32; ++c) { states[((size_t)((b * 32 + c) * 16 + hd)) * 4096 + pn] = carry; carry = carry * dc[c] + st[c]; }
        P.out[O_PSSM + ((size_t)((layer * 4 + b) * 16 + hd)) * 4096 + pn] = carry;
    }
}

__device__ __forceinline__ void attn_prompt_item(const Params& P, int layer, int item, unsigned char* lds, bool dry = false) {
    const int tid = otid(), w = tid >> 6, lane = tid & 63, fr = lane & 15, fq = lane >> 4;
    const int b = item >> 7, nb = (item >> 2) & 31, kvh = item & 3;
    bf16_t* proj = (bf16_t*)(P.ws + WS_PROJ);
    bf16_t* Ks = (bf16_t*)lds;
    bf16_t* Vt = Ks + 256 * 72;
    bf16_t* Pw = Vt + 64 * 280 + w * 16 * 168;
    const long rowK0 = (long)b * 4096 + (long)(nb - 1) * 128;
    const bf16_t* qbase = proj + ((size_t)b * 4096 + (size_t)nb * 128 + w * 16 + fr) * LDP + C_Q + kvh * 256 + fq * 8;
    bf16x8 qa[2], qn[2];
#pragma unroll
    for (int ks = 0; ks < 2; ++ks) { qa[ks] = *(const bf16x8*)(qbase + ks * 32); qn[ks] = qa[ks]; }
    __syncthreads();
#pragma unroll
    for (int idx = tid; idx < 2048; idx += 512) { const int kj = idx >> 3, seg = idx & 7; u32x4 v = (u32x4){0u, 0u, 0u, 0u};
        if (nb > 0 || kj >= 128) v = *(const u32x4*)(proj + (size_t)(rowK0 + kj) * LDP + C_K + kvh * 64 + seg * 8);
        *(u32x4*)(Ks + kj * 72 + seg * 8) = v; }
#pragma unroll
    for (int idx = tid; idx < 2048; idx += 512) { const int seg = idx >> 8, kj = idx & 255; u32x4 v = (u32x4){0u, 0u, 0u, 0u};
        if (nb > 0 || kj >= 128) v = *(const u32x4*)(proj + (size_t)(rowK0 + kj) * LDP + C_V + kvh * 64 + seg * 8);
#pragma unroll
        for (int i = 0; i < 8; ++i) Vt[(seg * 8 + i) * 280 + kj] = (bf16_t)((v[i >> 1] >> ((i & 1) * 16)) & 0xffffu); }
    for (int idx = tid; idx < 64 * 24; idx += 512) { const int d = idx / 24, cc = 256 + idx % 24; Vt[d * 280 + cc] = 0; }
    for (int i = lane; i < 384; i += 64) Pw[(i / 24) * 168 + 144 + i % 24] = 0;
    __syncthreads();
    const int q0 = w * 16;
    const size_t qrow0 = (size_t)b * 4096 + (size_t)nb * 128 + q0;
    for (int gi = 0; gi < 4; ++gi) {
        const int hq = kvh * 4 + gi;
        const float slope = exp2f(-0.5f * (float)(hq + 1));
        const float sink = P.in[21][layer * 16 + hq];
        if (gi < 3) {
#pragma unroll
            for (int ks = 0; ks < 2; ++ks) qn[ks] = *(const bf16x8*)(qbase + (gi + 1) * 64 + ks * 32); }
        f32x4 S[9];
#pragma unroll
        for (int nt = 0; nt < 9; ++nt) { f32x4 a = (f32x4){0.f, 0.f, 0.f, 0.f}; const bf16_t* kp = Ks + (q0 + nt * 16 + fr) * 72 + fq * 8;
#pragma unroll
            for (int ks = 0; ks < 2; ++ks) { const bf16x8 kb = *(const bf16x8*)(kp + ks * 32); a = __builtin_amdgcn_mfma_f32_16x16x32_bf16(qa[ks], kb, a, 0, 0, 0); }
            S[nt] = a; }
        float mx[4] = {-INFINITY, -INFINITY, -INFINITY, -INFINITY};
#pragma unroll
        for (int nt = 0; nt < 9; ++nt)
#pragma unroll
            for (int j = 0; j < 4; ++j) { const int dist = (fq * 4 + j) - (nt * 16 + fr) + 128; const bool valid = dist >= 0 && dist <= 128 && (nb > 0 || (q0 + nt * 16 + fr) >= 128);
                const float s = valid ? S[nt][j] * 0.125f - slope * (float)dist : -INFINITY; S[nt][j] = s; mx[j] = fmaxf(mx[j], s); }
        float inv[4];
#pragma unroll
        for (int j = 0; j < 4; ++j) { float m = mx[j];
#pragma unroll
            for (int o = 8; o > 0; o >>= 1) m = fmaxf(m, shx(m, o, lane));
            m = fmaxf(m, sink); float sum = 0.f;
#pragma unroll
            for (int nt = 0; nt < 9; ++nt) { const float p = __expf(S[nt][j] - m); S[nt][j] = p; sum += p; }
#pragma unroll
            for (int o = 8; o > 0; o >>= 1) sum += shx(sum, o, lane);
            inv[j] = 1.f / (sum + __expf(sink - m)); }
#pragma unroll
        for (int nt = 0; nt < 9; ++nt)
#pragma unroll
            for (int j = 0; j < 4; ++j) Pw[(fq * 4 + j) * 168 + nt * 16 + fr] = f2bf(S[nt][j]);
        asm volatile("s_waitcnt lgkmcnt(0)" ::: "memory"); __builtin_amdgcn_wave_barrier();
        f32x4 O[4];
#pragma unroll
        for (int dt = 0; dt < 4; ++dt) O[dt] = (f32x4){0.f, 0.f, 0.f, 0.f};
#pragma unroll
        for (int ks = 0; ks < 5; ++ks) { const bf16x8 pa = *(const bf16x8*)(Pw + fr * 168 + ks * 32 + fq * 8);
#pragma unroll
            for (int dt = 0; dt < 4; ++dt) { const bf16x8 vb = *(const bf16x8*)(Vt + (dt * 16 + fr) * 280 + q0 + ks * 32 + fq * 8); O[dt] = __builtin_amdgcn_mfma_f32_16x16x32_bf16(pa, vb, O[dt], 0, 0, 0); } }
        asm volatile("s_waitcnt lgkmcnt(0)" ::: "memory"); __builtin_amdgcn_wave_barrier();
#pragma unroll
        for (int dt = 0; dt < 4; ++dt)
#pragma unroll
            for (int j = 0; j < 4; ++j) { if (!dry) proj[(qrow0 + fq * 4 + j) * LDP + C_Q + hq * 64 + dt * 16 + fr] = f2bf(O[dt][j] * inv[j]); }
        qa[0] = qn[0]; qa[1] = qn[1];
    }
    if (nb == 31) {
        for (int idx = tid; idx < 128 * 64; idx += 512) { const int t = idx >> 6, d = idx & 63; const size_t row = (size_t)b * 4096 + 3968 + t;
            const size_t o = ((size_t)((layer * 4 + b) * 128 + t)) * 256 + kvh * 64 + d;
            P.out[O_PK + o] = bf2f(proj[row * LDP + C_K + kvh * 64 + d]); P.out[O_PV + o] = bf2f(proj[row * LDP + C_V + kvh * 64 + d]); }
    }
}
__device__ __forceinline__ void attn_sample_item(const Params& P, int layer, int item, float* L, bool dry = false) {
    const int tid = otid(), w = tid >> 6, lane = tid & 63;
    const int sb = item >> 2, kvh = item & 3, r0 = NPR + sb * 4;
    bf16_t* proj = (bf16_t*)(P.ws + WS_PROJ);
    float* Kf = L; float* Vf = Kf + 132 * 65; float* Q = Vf + 132 * 65; float* Sc = Q + 16 * 64;
    const float* ck = P.in[7] + ((size_t)(layer * 128 + sb)) * 128 * 256; const float* cv = P.in[8] + ((size_t)(layer * 128 + sb)) * 128 * 256;
    __syncthreads();
    {
        f32x4 kq[4], vq[4];
#pragma unroll
        for (int i = 0; i < 4; ++i) { const int idx = tid + i * 512, j = idx >> 4, d4 = (idx & 15) * 4; kq[i] = *(const f32x4*)(ck + (size_t)j * 256 + kvh * 64 + d4); vq[i] = *(const f32x4*)(cv + (size_t)j * 256 + kvh * 64 + d4); }
#pragma unroll
        for (int i = 0; i < 4; ++i) { const int idx = tid + i * 512, j = idx >> 4, d4 = (idx & 15) * 4;
#pragma unroll
            for (int e = 0; e < 4; ++e) { Kf[j * 65 + d4 + e] = kq[i][e]; Vf[j * 65 + d4 + e] = vq[i][e]; }
            if (j >= 4) { const size_t o = ((size_t)((layer * 128 + sb) * 128 + (j - 4))) * 256 + kvh * 64 + d4; *(f32x4*)(P.out + O_SK + o) = kq[i]; *(f32x4*)(P.out + O_SV + o) = vq[i]; } }
        if (tid < 256) { const int j = 128 + (tid >> 6), d = tid & 63; const float kv = bf2f(proj[(size_t)(r0 + j - 128) * LDP + C_K + kvh * 64 + d]), vv = bf2f(proj[(size_t)(r0 + j - 128) * LDP + C_V + kvh * 64 + d]);
            Kf[j * 65 + d] = kv; Vf[j * 65 + d] = vv; const size_t o = ((size_t)((layer * 128 + sb) * 128 + (j - 4))) * 256 + kvh * 64 + d; P.out[O_SK + o] = kv; P.out[O_SV + o] = vv; }
    }
    for (int idx = tid; idx < 1024; idx += 512) { const int qr = idx >> 6, d = idx & 63; Q[idx] = bf2f(proj[(size_t)(r0 + (qr >> 2)) * LDP + C_Q + (kvh * 4 + (qr & 3)) * 64 + d]); }
    __syncthreads();
    for (int idx = tid; idx < 16 * 132; idx += 512) { const int qr = idx / 132, j = idx - qr * 132; const int dist = 128 + (qr >> 2) - j; float s = -INFINITY;
        if (dist >= 0 && dist <= 128) { float a = 0.f;
#pragma unroll 8
            for (int d = 0; d < 64; ++d) a += Q[qr * 64 + d] * Kf[j * 65 + d];
            s = a * 0.125f - exp2f(-0.5f * (float)(kvh * 4 + (qr & 3) + 1)) * (float)dist; }
        Sc[qr * 136 + j] = s; }
    __syncthreads();
    for (int rr = 0; rr < 2; ++rr) { const int qr = w * 2 + rr; const float sink = P.in[21][layer * 16 + kvh * 4 + (qr & 3)];
        float v0 = Sc[qr * 136 + lane], v1 = Sc[qr * 136 + 64 + lane], v2 = lane < 4 ? Sc[qr * 136 + 128 + lane] : -INFINITY;
        float m = fmaxf(fmaxf(v0, v1), v2);
#pragma unroll
        for (int o = 32; o > 0; o >>= 1) m = fmaxf(m, shx(m, o, lane));
        m = fmaxf(m, sink);
        v0 = __expf(v0 - m); v1 = __expf(v1 - m); v2 = __expf(v2 - m);
        const float sum = wave_sum(v0 + v1 + v2, lane); const float inv = 1.f / (sum + __expf(sink - m));
        Sc[qr * 136 + lane] = v0 * inv; Sc[qr * 136 + 64 + lane] = v1 * inv; if (lane < 4) Sc[qr * 136 + 128 + lane] = v2 * inv; }
    __syncthreads();
    for (int idx = tid; idx < 1024; idx += 512) { const int qr = idx >> 6, d = idx & 63; float o = 0.f;
        for (int j = 0; j < 132; ++j) o += Sc[qr * 136 + j] * Vf[j * 65 + d];
        if (!dry) proj[(size_t)(r0 + (qr >> 2)) * LDP + C_Q + (kvh * 4 + (qr & 3)) * 64 + d] = f2bf(o); }
}

__device__ __forceinline__ void gmlp_prompt_item(const Params& P, int layer, int item, unsigned char* lds, bool dry = false) {
    const int tid = otid(), w = tid >> 6, lane = tid & 63, fr = lane & 15, fq = lane >> 4;
    const int b = item >> 8, chn = (item >> 3) & 31, g = item & 7;
    const size_t r0 = (size_t)b * 4096 + (size_t)chn * 128;
    bf16_t* proj = (bf16_t*)(P.ws + WS_PROJ);
    bf16_t* VT = (bf16_t*)lds; bf16_t* Wt = VT + 128 * 136; float* MU = (float*)(Wt + 128 * 136); float* RS = MU + 128;
    __syncthreads();
#pragma unroll
    for (int hb = 0; hb < 2; ++hb) { u32x4 av[8], cv8[8];
#pragma unroll
        for (int i = 0; i < 8; ++i) { const bf16_t* vp = proj + (r0 + w * 16 + hb * 8 + i) * LDP + C_UV + 1024 + lane * 16; av[i] = *(const u32x4*)vp; cv8[i] = *(const u32x4*)(vp + 8); }
#pragma unroll
        for (int i = 0; i < 8; ++i) { const int t = w * 16 + hb * 8 + i; float s = 0.f, sq = 0.f;
#pragma unroll
            for (int k = 0; k < 4; ++k) { float x0 = bflo(av[i][k]), x1 = bfhi(av[i][k]), x2 = bflo(cv8[i][k]), x3 = bfhi(cv8[i][k]); s += x0 + x1 + x2 + x3; sq += x0 * x0 + x1 * x1 + x2 * x2 + x3 * x3; }
            s = wave_sum(s, lane); sq = wave_sum(sq, lane);
            if (lane == 0) { const float mean = s * (1.f / 1024.f); const float var = fmaxf(sq * (1.f / 1024.f) - mean * mean, 0.f); MU[t] = mean; RS[t] = rsqrtf(var + EPSF); } } }
    const float* Wg = P.in[24] + ((size_t)(layer * 8 + g)) * 16384;
#pragma unroll
    for (int idx = tid; idx < 4096; idx += 512) { const int t = idx >> 5, s4 = (idx & 31) * 4; const f32x4 wv = *(const f32x4*)(Wg + t * 128 + s4);
        u32x2 o; o[0] = pk2(s4 <= t ? wv[0] : 0.f, s4 + 1 <= t ? wv[1] : 0.f); o[1] = pk2(s4 + 2 <= t ? wv[2] : 0.f, s4 + 3 <= t ? wv[3] : 0.f);
        *(u32x2*)(Wt + t * 136 + s4) = o; }
    __syncthreads();
    const float* lg = P.in[22] + layer * 1024 + g * 128; const float* lb = P.in[23] + layer * 1024 + g * 128;
#pragma unroll
    for (int idx = tid; idx < 2048; idx += 512) { const int s = idx & 127, fs = idx >> 7; const u32x4 v = *(const u32x4*)(proj + (r0 + s) * LDP + C_UV + 1024 + g * 128 + fs * 8);
        const float mu = MU[s], rs = RS[s];
#pragma unroll
        for (int i = 0; i < 8; ++i) { const int f = fs * 8 + i; const float x = (i & 1) ? bfhi(v[i >> 1]) : bflo(v[i >> 1]); VT[f * 136 + s] = f2bf((x - mu) * rs * lg[f] + lb[f]); } }
    __syncthreads();
    f32x4 acc[8];
#pragma unroll
    for (int ft = 0; ft < 8; ++ft) acc[ft] = (f32x4){0.f, 0.f, 0.f, 0.f};
    const int nks = (16 * w + 15) / 32 + 1;
    for (int ks = 0; ks < nks; ++ks) { const bf16x8 a = *(const bf16x8*)(Wt + (w * 16 + fr) * 136 + ks * 32 + fq * 8);
#pragma unroll
        for (int ft = 0; ft < 8; ++ft) { const bf16x8 bb = *(const bf16x8*)(VT + (ft * 16 + fr) * 136 + ks * 32 + fq * 8); acc[ft] = __builtin_amdgcn_mfma_f32_16x16x32_bf16(a, bb, acc[ft], 0, 0, 0); } }
    bf16_t uv[4][8]; float bsv[4];
#pragma unroll
    for (int j = 0; j < 4; ++j) { const int t = w * 16 + fq * 4 + j; bsv[j] = P.in[25][(layer * 8 + g) * 128 + t];
#pragma unroll
        for (int ft = 0; ft < 8; ++ft) uv[j][ft] = proj[(r0 + t) * LDP + C_UV + g * 128 + ft * 16 + fr]; }
#pragma unroll
    for (int j = 0; j < 4; ++j) { const int t = w * 16 + fq * 4 + j;
#pragma unroll
        for (int ft = 0; ft < 8; ++ft) { if (!dry) proj[(r0 + t) * LDP + C_UV + g * 128 + ft * 16 + fr] = f2bf(bf2f(uv[j][ft]) * (acc[ft][j] + bsv[j])); } }
}
__device__ __forceinline__ void gmlp_sample_item(const Params& P, int layer, int sb, float* L) {
    const int tid = otid(), w = tid >> 6, lane = tid & 63; const size_t r0 = NPR + sb * 4;
    bf16_t* proj = (bf16_t*)(P.ws + WS_PROJ);
    float* Vn = L; float* MU = Vn + 4096; float* RS = MU + 4;
    __syncthreads();
    if (w < 4) { const bf16_t* vp = proj + (r0 + w) * LDP + C_UV + 1024 + lane * 16; const u32x4 a = *(const u32x4*)vp, c = *(const u32x4*)(vp + 8); float s = 0.f, sq = 0.f;
#pragma unroll
        for (int k = 0; k < 4; ++k) { float x0 = bflo(a[k]), x1 = bfhi(a[k]), x2 = bflo(c[k]), x3 = bfhi(c[k]); s += x0 + x1 + x2 + x3; sq += x0 * x0 + x1 * x1 + x2 * x2 + x3 * x3; }
        s = wave_sum(s, lane); sq = wave_sum(sq, lane);
        if (lane == 0) { const float mean = s * (1.f / 1024.f); const float var = fmaxf(sq * (1.f / 1024.f) - mean * mean, 0.f); MU[w] = mean; RS[w] = rsqrtf(var + EPSF); } }
    __syncthreads();
    for (int idx = tid; idx < 4096; idx += 512) { const int t = idx >> 10, c = idx & 1023;
        const float x = bf2f(proj[(r0 + t) * LDP + C_UV + 1024 + c]); const float vn = (x - MU[t]) * RS[t] * P.in[22][layer * 1024 + c] + P.in[23][layer * 1024 + c];
        Vn[idx] = vn; P.out[O_SGMV + ((size_t)((layer * 128 + sb) * 4 + t)) * 1024 + c] = vn; }
    __syncthreads();
    for (int idx = tid; idx < 4096; idx += 512) { const int t = idx >> 10, c = idx & 1023, g = c >> 7;
        const float* Wg = P.in[24] + ((size_t)(layer * 8 + g)) * 16384 + t * 128; float m = P.in[25][(layer * 8 + g) * 128 + t];
        for (int s = 0; s <= t; ++s) m += Wg[s] * Vn[s * 1024 + c];
        bf16_t* ap = proj + (r0 + t) * LDP + C_UV + c; *ap = f2bf(bf2f(*ap) * m); }
}

template <int R>
__device__ __forceinline__ void shortconv_rows(const Params& P, int layer, int r0, int tid, bool dry) {
    bf16_t* proj = (bf16_t*)(P.ws + WS_PROJ);
    const float* cw = P.in[20] + layer * 3 * 1024;
    const int j = tid * 2; const int ss = seq_start(r0); const bool havePrev = (r0 - 2 >= ss);
    unsigned cg[R + 2], xs[R + 2], bg[R];
#pragma unroll
    for (int k = 0; k < R + 2; ++k) { cg[k] = 0u; xs[k] = 0u;
        if (k >= 2 || havePrev) { const bf16_t* rp = proj + (size_t)(r0 - 2 + k) * LDP + C_BCX + j; cg[k] = *(const unsigned*)(rp + 1024); xs[k] = *(const unsigned*)(rp + 2048); } }
#pragma unroll
    for (int k = 0; k < R; ++k) bg[k] = *(const unsigned*)(proj + (size_t)(r0 + k) * LDP + C_BCX + j);
    float pr0[R + 2], pr1[R + 2];
#pragma unroll
    for (int k = 0; k < R + 2; ++k) { pr0[k] = bflo(cg[k]) * bflo(xs[k]); pr1[k] = bfhi(cg[k]) * bfhi(xs[k]); }
    if (!havePrev && r0 >= NPR) { const float* st = P.in[6] + ((size_t)(layer * 128 + ((r0 - NPR) >> 2)) * 2) * 1024 + j; pr0[0] = st[0]; pr1[0] = st[1]; pr0[1] = st[1024]; pr1[1] = st[1025]; }
    const float w0a = cw[j], w0b = cw[j + 1], w1a = cw[1024 + j], w1b = cw[1025 + j], w2a = cw[2048 + j], w2b = cw[2049 + j];
#pragma unroll
    for (int k = 0; k < R; ++k) { const float y0 = w0a * pr0[k] + w1a * pr0[k + 1] + w2a * pr0[k + 2], y1 = w0b * pr1[k] + w1b * pr1[k + 1] + w2b * pr1[k + 2];
        if (!dry) *(unsigned*)(proj + (size_t)(r0 + k) * LDP + C_BCX + j) = pk2(bflo(bg[k]) * y0, bfhi(bg[k]) * y1);
        const int r = r0 + k;
        if (r < NPR) { const int l = r & 4095; if (l >= 4094) { float* o = P.out + O_PSCC + ((size_t)((layer * 4 + (r >> 12)) * 2 + (l - 4094))) * 1024 + j; o[0] = pr0[k + 2]; o[1] = pr1[k + 2]; } }
        else { const int l = (r - NPR) & 3; if (l >= 2) { float* o = P.out + O_SSCC + ((size_t)((layer * 128 + ((r - NPR) >> 2)) * 2 + (l - 2))) * 1024 + j; o[0] = pr0[k + 2]; o[1] = pr1[k + 2]; } }
    }
}
__device__ __forceinline__ void shortconv_item(const Params& P, int layer, int item, bool dry = false) {
    const int tid = otid();
    if (item < 1024) shortconv_rows<16>(P, layer, item * 16, tid, dry); else shortconv_rows<4>(P, layer, NPR + (item - 1024) * 4, tid, dry);
}
__device__ __forceinline__ void ssdconv_state_item(const Params& P, int layer, int sq) {
    const bf16_t* proj = (const bf16_t*)(P.ws + WS_PROJ);
    const size_t rbase = sq < 4 ? (size_t)sq * 4096 + 4093 : (size_t)NPR + (size_t)(sq - 4) * 4 + 1;
    float* o = sq < 4 ? P.out + O_PSSDC + (size_t)(layer * 4 + sq) * 3 * 1536 : P.out + O_SSSDC + (size_t)(layer * 128 + (sq - 4)) * 3 * 1536;
    const int tid = otid(); bf16_t v[9];
#pragma unroll
    for (int i = 0; i < 9; ++i) { const int e = tid + i * 512, t = e / 1536, c = e - t * 1536; v[i] = proj[(rbase + t) * LDP + C_XBC + c]; }
#pragma unroll
    for (int i = 0; i < 9; ++i) o[tid + i * 512] = bf2f(v[i]);
}

template <int R>
__device__ __forceinline__ void ffn_act_unit(const Params& P, int layer, int r0, int oc) {
    const bf16_t* up = (const bf16_t*)(P.ws + WS_PROJ); bf16_t* act = (bf16_t*)(P.ws + WS_PROJ + UP_BYTES);
    const float* cw = P.in[30] + (size_t)layer * 3 * 5632; const float* cb = P.in[31] + (size_t)layer * 5632;
    const int j0 = oc * 8;
    float wa[3][8], wg[3][8], ba[8], bgv[8], pa[2][8], pg[2][8];
#pragma unroll
    for (int k = 0; k < 3; ++k) { const f32x4 a0 = *(const f32x4*)(cw + k * 5632 + j0), a1 = *(const f32x4*)(cw + k * 5632 + j0 + 4), g0 = *(const f32x4*)(cw + k * 5632 + 2816 + j0), g1 = *(const f32x4*)(cw + k * 5632 + 2816 + j0 + 4);
#pragma unroll
        for (int i = 0; i < 4; ++i) { wa[k][i] = a0[i]; wa[k][4 + i] = a1[i]; wg[k][i] = g0[i]; wg[k][4 + i] = g1[i]; } }
    { const f32x4 a0 = *(const f32x4*)(cb + j0), a1 = *(const f32x4*)(cb + j0 + 4), g0 = *(const f32x4*)(cb + 2816 + j0), g1 = *(const f32x4*)(cb + 2816 + j0 + 4);
#pragma unroll
      for (int i = 0; i < 4; ++i) { ba[i] = a0[i]; ba[4 + i] = a1[i]; bgv[i] = g0[i]; bgv[4 + i] = g1[i]; } }
    const int ss = seq_start(r0); const bool havePrev = (r0 - 2 >= ss);
#pragma unroll
    for (int k = 0; k < 2; ++k) {
        if (havePrev) { const u32x4 ua = *(const u32x4*)(up + (size_t)(r0 - 2 + k) * 5632 + j0), ug = *(const u32x4*)(up + (size_t)(r0 - 2 + k) * 5632 + 2816 + j0);
#pragma unroll
            for (int i = 0; i < 4; ++i) { pa[k][2 * i] = bflo(ua[i]); pa[k][2 * i + 1] = bfhi(ua[i]); pg[k][2 * i] = bflo(ug[i]); pg[k][2 * i + 1] = bfhi(ug[i]); } }
        else if (r0 >= NPR) { const float* pp = P.in[9] + ((size_t)(layer * 128 + ((r0 - NPR) >> 2)) * 2 + k) * 5632;
#pragma unroll
            for (int i = 0; i < 8; ++i) { pa[k][i] = pp[j0 + i]; pg[k][i] = pp[2816 + j0 + i]; } }
        else {
#pragma unroll
            for (int i = 0; i < 8; ++i) { pa[k][i] = 0.f; pg[k][i] = 0.f; } } }
#pragma unroll
    for (int kb = 0; kb < R; kb += 4) { u32x4 ua[4], ug[4];
#pragma unroll
        for (int q = 0; q < 4; ++q) { ua[q] = *(const u32x4*)(up + (size_t)(r0 + kb + q) * 5632 + j0); ug[q] = *(const u32x4*)(up + (size_t)(r0 + kb + q) * 5632 + 2816 + j0); }
#pragma unroll
        for (int q = 0; q < 4; ++q) { const int r = r0 + kb + q; float ca[8], cgv[8], o[8];
#pragma unroll
            for (int i = 0; i < 4; ++i) { ca[2 * i] = bflo(ua[q][i]); ca[2 * i + 1] = bfhi(ua[q][i]); cgv[2 * i] = bflo(ug[q][i]); cgv[2 * i + 1] = bfhi(ug[q][i]); }
#pragma unroll
            for (int i = 0; i < 8; ++i) { const float a = ba[i] + wa[0][i] * pa[0][i] + wa[1][i] * pa[1][i] + wa[2][i] * ca[i], g = bgv[i] + wg[0][i] * pg[0][i] + wg[1][i] * pg[1][i] + wg[2][i] * cgv[i];
                o[i] = silu_fast(a) * g; pa[0][i] = pa[1][i]; pa[1][i] = ca[i]; pg[0][i] = pg[1][i]; pg[1][i] = cgv[i]; }
            u32x4 ov; ov[0] = pk2(o[0], o[1]); ov[1] = pk2(o[2], o[3]); ov[2] = pk2(o[4], o[5]); ov[3] = pk2(o[6], o[7]);
            *(u32x4*)(act + (size_t)r * 2816 + j0) = ov;
            float* so = nullptr;
            if (r < NPR) { const int l = r & 4095; if (l >= 4094) so = P.out + O_PFFC + ((size_t)((layer * 4 + (r >> 12)) * 2 + (l - 4094))) * 5632; }
            else { const int l = (r - NPR) & 3; if (l >= 2) so = P.out + O_SFFC + ((size_t)((layer * 128 + ((r - NPR) >> 2)) * 2 + (l - 2))) * 5632; }
            if (so) {
#pragma unroll
                for (int i = 0; i < 8; ++i) { so[j0 + i] = ca[i]; so[2816 + j0 + i] = cgv[i]; } }
        } }
}
__device__ __forceinline__ void phase_ffn_act(const Params& P, int layer) {
    constexpr int NU_P = 2048 * 352, NU_S = 128 * 352;
    for (int u = blockIdx.x * 512 + otid(); u < NU_P + NU_S; u += gridDim.x * 512) {
        if (u < NU_P) { const int rb = u / 352, oc = u - rb * 352; ffn_act_unit<8>(P, layer, rb * 8, oc); }
        else { const int v = u - NU_P, sq = v / 352, oc = v - sq * 352; ffn_act_unit<4>(P, layer, NPR + sq * 4, oc); }
    }
}

__device__ __forceinline__ void sgemm_partial(const bf16_t* A, int lda, const bf16_t* Bt, int ldb, int K, int row0, int col0, float* red, int tid) {
    const int w = tid >> 6, lane = tid & 63, fr = lane & 15, fq = lane >> 4;
    const int kw = K >> 3, k0 = w * kw;
    f32x4 acc[2][4];
#pragma unroll
    for (int mt = 0; mt < 2; ++mt)
#pragma unroll
        for (int nt = 0; nt < 4; ++nt) acc[mt][nt] = (f32x4){0.f, 0.f, 0.f, 0.f};
    const bf16_t* ap = A + (size_t)(row0 + fr) * lda + k0 + fq * 8;
    const bf16_t* bp = Bt + (size_t)(col0 + fr) * ldb + k0 + fq * 8;
    const int nks = kw >> 5;
#pragma unroll 4
    for (int ks = 0; ks < nks; ++ks) { bf16x8 a[2], b[4];
#pragma unroll
        for (int mt = 0; mt < 2; ++mt) a[mt] = *(const bf16x8*)(ap + (size_t)mt * 16 * lda + ks * 32);
#pragma unroll
        for (int nt = 0; nt < 4; ++nt) b[nt] = *(const bf16x8*)(bp + (size_t)nt * 16 * ldb + ks * 32);
#pragma unroll
        for (int mt = 0; mt < 2; ++mt)
#pragma unroll
            for (int nt = 0; nt < 4; ++nt) acc[mt][nt] = __builtin_amdgcn_mfma_f32_16x16x32_bf16(a[mt], b[nt], acc[mt][nt], 0, 0, 0); }
#pragma unroll
    for (int mt = 0; mt < 2; ++mt)
#pragma unroll
        for (int nt = 0; nt < 4; ++nt)
#pragma unroll
            for (int j = 0; j < 4; ++j) red[(w * 32 + mt * 16 + fq * 4 + j) * 64 + nt * 16 + fr] = acc[mt][nt][j];
}
__device__ __forceinline__ f32x4 sgemm_reduce(const float* red, int tid) {
    const int row = tid >> 4, c4 = (tid & 15) * 4; f32x4 sacc = (f32x4){0.f, 0.f, 0.f, 0.f};
#pragma unroll
    for (int w = 0; w < 8; ++w) sacc += *(const f32x4*)(red + (w * 32 + row) * 64 + c4);
    return sacc;
}
__device__ __forceinline__ void sample_branch(const Params& P, int layer, float* red) {
    const int tid = otid(); const bf16_t* proj = (const bf16_t*)(P.ws + WS_PROJ); bf16_t* hbuf = (bf16_t*)(P.ws + WS_H);
    for (int piece = blockIdx.x; piece < 256; piece += gridDim.x) {
        const int row0 = (piece >> 4) * 32, col0 = (piece & 15) * 64; const size_t r = NPR + row0 + (tid >> 4); const int c = col0 + (tid & 15) * 4;
        f32x4 sum = (f32x4){0.f, 0.f, 0.f, 0.f};
        for (int z = 0; z < 4; ++z) {
            const int ao = z == 0 ? C_Z : (z == 1 ? C_BCX : (z == 2 ? C_Q : C_UV));
            __syncthreads();
            sgemm_partial(proj + (size_t)NPR * LDP + ao, LDP, (const bf16_t*)(P.ws + WS_WBR) + (size_t)(layer * 4 + z) * 1048576, 1024, 1024, row0, col0, red, tid);
            __syncthreads();
            const f32x4 v = sgemm_reduce(red, tid);
            const u32x2 gv = *(const u32x2*)(proj + r * LDP + C_GATE + z * 1024 + c);
            sum[0] += bflo(gv[0]) * v[0]; sum[1] += bfhi(gv[0]) * v[1]; sum[2] += bflo(gv[1]) * v[2]; sum[3] += bfhi(gv[1]) * v[3];
        }
        u32x2 o; o[0] = pk2(sum[0], sum[1]); o[1] = pk2(sum[2], sum[3]); *(u32x2*)(hbuf + r * 1024 + c) = o;
    }
}
__device__ __forceinline__ void sample_resid(const Params& P, const bf16_t* A, int lda, const bf16_t* Bt, int K, const float* xin_s, float* xout, const float* ga, float* red) {
    const int tid = otid();
    for (int piece = blockIdx.x; piece < 256; piece += gridDim.x) {
        const int row0 = (piece >> 4) * 32, col0 = (piece & 15) * 64; const int rs = row0 + (tid >> 4), c = col0 + (tid & 15) * 4;
        __syncthreads();
        sgemm_partial(A, lda, Bt, K, K, row0, col0, red, tid);
        __syncthreads();
        const f32x4 v = sgemm_reduce(red, tid);
        const f32x4 xv = *(const f32x4*)(xin_s + (size_t)rs * 1024 + c), gv = *(const f32x4*)(ga + (size_t)(4 + (rs >> 2)) * 6144 + c);
        *(f32x4*)(xout + (size_t)(NPR + rs) * 1024 + c) = xv + gv * v;
    }
}

__device__ __forceinline__ void grid_bar(unsigned* ctr, unsigned& epoch) {
    asm volatile("s_waitcnt vmcnt(0) lgkmcnt(0)" ::: "memory");
    __syncthreads();
    epoch += 1;
    if (otid() == 0) {
        __builtin_amdgcn_fence(__ATOMIC_RELEASE, "agent");
        asm volatile("s_waitcnt vmcnt(0) lgkmcnt(0)" ::: "memory");
        __hip_atomic_fetch_add(ctr, 1u, __ATOMIC_RELAXED, __HIP_MEMORY_SCOPE_AGENT);
        const unsigned target = epoch * gridDim.x;
        while (__hip_atomic_load(ctr, __ATOMIC_RELAXED, __HIP_MEMORY_SCOPE_AGENT) < target) __builtin_amdgcn_s_sleep(1);
        __builtin_amdgcn_fence(__ATOMIC_ACQUIRE, "agent");
        asm volatile("s_waitcnt vmcnt(0) lgkmcnt(0)" ::: "memory");
    }
    __syncthreads();
}

#ifndef PHMASK
#define PHMASK 0xFFFFFFFF
#endif
#define EN(x) ((PHMASK >> (x)) & 1)
#ifndef DRYM
#define DRYM 0
#endif
#ifndef DBL
#define DBL 0
#endif
#define REP(x) (((DBL >> (x)) & 1) ? 2 : 1)
constexpr int PH_PER_LAYER = 11, N_PHASES = 2 + 4 * PH_PER_LAYER + 1;

__global__ void __launch_bounds__(512, 2) mega_fwd(Params PK) {
    extern __shared__ __attribute__((aligned(16))) unsigned char lds_raw[];
    cg::grid_group grid = cg::this_grid();
    LAS unsigned char* ldsl = (LAS unsigned char*)lds_raw;
    unsigned epoch = 0;
    for (int ph = PK.ph_lo; ph < PK.ph_hi; ++ph) {
        Params P = PK;
        { unsigned char* w_ = P.ws; asm volatile("" : "+s"(w_)); P.ws = w_; float* o_ = P.out; asm volatile("" : "+s"(o_)); P.out = o_; }
        unsigned* barctr = (unsigned*)(P.ws + WS_BAR);
        bf16_t* proj = (bf16_t*)(P.ws + WS_PROJ);
        bf16_t* hbuf = (bf16_t*)(P.ws + WS_H);
        float* xbuf = P.out;
        float* mod = (float*)(P.ws + WS_MOD);
        if (ph == 0) { for (int rp = 0; rp < REP(0); ++rp) phase_convert(P, (float*)lds_raw); }
        else if (ph == 1) {
            Gemm g{(const bf16_t*)(P.ws + WS_CACT), (const bf16_t*)(P.ws + WS_WADA), 1024, 1024, 1024, 1, 96, 0, 0, 0, 0, 0};
            EpiMod E{mod, P.in[11]};
            for (int rp = 0; rp < REP(1); ++rp) gemm_phase<EpiMod, 1>(ldsl, g, E);
        }
        else if (ph == N_PHASES - 1) { phase_final_norm(xbuf, P.in[33]); }
        else {
            const int layer = (ph - 2) / PH_PER_LAYER, sp = (ph - 2) % PH_PER_LAYER;
            const float* modL = mod + (size_t)layer * NCOND * 6144;
            const float* xin_p = layer == 0 ? P.in[0] : xbuf; const float* xin_s = layer == 0 ? P.in[1] : xbuf + (size_t)NPR * 1024;
            if (sp == 0) { for (int rp = 0; rp < REP(16); ++rp) phase_norm(xin_p, xin_s, P.in[12] + layer * 1024, modL, 0, 1024, hbuf); }
            else if (sp == 1) {
                Gemm g{hbuf, (const bf16_t*)(P.ws + WS_WIN) + (size_t)layer * 13568 * 1024, 1024, 1024, 1024, 66, 53, 0, 0, 0, 0, 0};
                EpiProj E{proj};
                for (int rp = 0; rp < REP(2); ++rp) gemm_phase<EpiProj, 1>(ldsl, g, E);
            }
            else if (sp == 2) {
                for (int it = blockIdx.x; it < 3972 + 256; it += gridDim.x) {
                    if (it < 512) { for (int rp = 0; rp < REP(3); ++rp) ssd_pass1_item(P, layer, it, lds_raw); }
                    else if (it < 1024) { for (int rp = (DRYM & 1) ? 0 : 1; rp < 2; ++rp) attn_prompt_item(P, layer, it - 512, lds_raw, rp == 0 && P.ph_lo == 0); }
                    else if (it < 1536) { for (int rp = (DRYM & 2) ? 0 : 1; rp < 2; ++rp) attn_sample_item(P, layer, it - 1024, (float*)lds_raw, rp == 0 && P.ph_lo == 0); }
                    else if (it < 2560) { for (int rp = (DRYM & 4) ? 0 : 1; rp < 2; ++rp) gmlp_prompt_item(P, layer, it - 1536, lds_raw, rp == 0 && P.ph_lo == 0); }
                    else if (it < 2688) { if (EN(8)) gmlp_sample_item(P, layer, it - 2560, (float*)lds_raw); }
                    else if (it < 3840) { for (int rp = (DRYM & 8) ? 0 : 1; rp < 2; ++rp) shortconv_item(P, layer, it - 2688, rp == 0 && P.ph_lo == 0); }
                    else if (it < 3972) ssdconv_state_item(P, layer, it - 3840);
                    else ssd_item<2>(P, layer, it - 3972, (float*)lds_raw);
                }
            }
            else if (sp == 3) { phase_ssd_scan(P, layer); }
            else if (sp == 4) { for (int it = blockIdx.x; it < 512; it += gridDim.x) for (int rp = (DRYM & 16) ? 0 : 1; rp < 2; ++rp) ssd_pass3_item(P, layer, it, lds_raw, rp == 0 && P.ph_lo == 0); }
            else if (sp == 5) {
                Gemm g{proj, (const bf16_t*)(P.ws + WS_WBR) + (size_t)layer * 4 * 1048576, LDP, 1024, 1024, 64, 4, C_Z, C_BCX, C_Q, C_UV, (size_t)1048576};
                EpiBranch E{proj, (float*)(P.ws + WS_MSUM), hbuf};
                for (int rp = 0; rp < REP(11); ++rp) gemm_phase<EpiBranch, 4>(ldsl, g, E);
                for (int rp = 0; rp < REP(17); ++rp) sample_branch(P, layer, (float*)lds_raw);
            }
            else if (sp == 6) {
                Gemm g{hbuf, (const bf16_t*)(P.ws + WS_WO) + (size_t)layer * 1048576, 1024, 1024, 1024, 64, 4, 0, 0, 0, 0, 0};
                EpiResid E{xin_p, xin_s, xbuf, modL + 2048};
                if (EN(12)) gemm_phase<EpiResid, 1>(ldsl, g, E);
                sample_resid(P, hbuf + (size_t)NPR * 1024, 1024, (const bf16_t*)(P.ws + WS_WO) + (size_t)layer * 1048576, 1024, xin_s, xbuf, modL + 2048, (float*)lds_raw);
            }
            else if (sp == 7) { for (int rp = 0; rp < REP(16); ++rp) phase_norm(xbuf, xbuf + (size_t)NPR * 1024, P.in[28] + layer * 1024, modL, 3072, 4096, hbuf); }
            else if (sp == 8) {
                Gemm g{hbuf, (const bf16_t*)(P.ws + WS_WUP) + (size_t)layer * 5632 * 1024, 1024, 1024, 1024, 66, 22, 0, 0, 0, 0, 0};
                EpiUp E{proj};
                for (int rp = 0; rp < REP(13); ++rp) gemm_phase<EpiUp, 1>(ldsl, g, E);
            }
            else if (sp == 9) { for (int rp = 0; rp < REP(14); ++rp) phase_ffn_act(P, layer); }
            else {
                Gemm g{(const bf16_t*)(P.ws + WS_PROJ + UP_BYTES), (const bf16_t*)(P.ws + WS_WDN) + (size_t)layer * 1024 * 2816, 2816, 2816, 2816, 64, 4, 0, 0, 0, 0, 0};
                EpiResid E{xbuf, xbuf + (size_t)NPR * 1024, xbuf, modL + 5120};
                if (EN(15)) gemm_phase<EpiResid, 1>(ldsl, g, E);
                sample_resid(P, (const bf16_t*)(P.ws + WS_PROJ + UP_BYTES) + (size_t)NPR * 2816, 2816, (const bf16_t*)(P.ws + WS_WDN) + (size_t)layer * 1024 * 2816, 2816, xbuf + (size_t)NPR * 1024, xbuf, modL + 5120, (float*)lds_raw);
            }
        }
        if (ph + 1 < P.ph_hi) { if (ph == 0) grid.sync(); else grid_bar(barctr, epoch); }
    }
}

extern "C" void kernel_launch(void* const* d_in, const int* in_sizes, int n_in, void* d_out, int out_size, void* d_ws, size_t ws_size, hipStream_t stream) {
    static int grid_blocks = 0;
    if (grid_blocks == 0) {
        if (n_in != 34 || (size_t)out_size != O_END || ws_size < WS_END + 256) { fprintf(stderr, "kernel_launch: unexpected sizes n_in %d out %d ws %zu (need %zu)\n", n_in, out_size, ws_size, (size_t)WS_END); grid_blocks = -1; return; }
        int dev = 0, cus = 0, per_cu = 0;
        (void)hipGetDevice(&dev); (void)hipDeviceGetAttribute(&cus, hipDeviceAttributeMultiprocessorCount, dev);
        if (hipFuncSetAttribute((const void*)mega_fwd, hipFuncAttributeMaxDynamicSharedMemorySize, LDS_BYTES) != hipSuccess) { fprintf(stderr, "hipFuncSetAttribute failed\n"); grid_blocks = -1; return; }
        if (hipOccupancyMaxActiveBlocksPerMultiprocessor(&per_cu, (const void*)mega_fwd, 512, LDS_BYTES) != hipSuccess || per_cu < 1) per_cu = 1;
        grid_blocks = cus * 1;
    }
    if (grid_blocks < 0) return;
    Params p{};
    for (int i = 0; i < 34; ++i) p.in[i] = (const float*)d_in[i];
    p.out = (float*)d_out; p.ws = (unsigned char*)d_ws; p.ph_lo = 0; p.ph_hi = N_PHASES;
    (void)hipMemsetAsync((unsigned char*)d_ws + WS_BAR, 0, 256, stream);
    void* args[] = {&p};
    hipError_t e = hipLaunchCooperativeKernel((const void*)mega_fwd, dim3(grid_blocks), dim3(512), args, LDS_BYTES, stream);
    if (e != hipSuccess) fprintf(stderr, "cooperative launch failed: %s (grid %d)\n", hipGetErrorString(e), grid_blocks);
}
```

```cpp
#include <hip/hip_runtime.h>
#include <hip/hip_cooperative_groups.h>
#include <cstdio>
namespace cg = cooperative_groups;

typedef unsigned short bf16_t;
typedef short bf16x8 __attribute__((ext_vector_type(8)));
typedef float f32x4 __attribute__((ext_vector_type(4)));
typedef unsigned u32x4 __attribute__((ext_vector_type(4)));
typedef unsigned u32x2 __attribute__((ext_vector_type(2)));
#define LAS __attribute__((address_space(3)))

constexpr int NTOK = 16896, NPR = 16384;
constexpr int LDP = 13568;
constexpr int C_Z = 0, C_XBC = 1024, C_DTR = 2560, C_BCX = 2576, C_Q = 5648, C_K = 6672, C_V = 6928, C_UV = 7184, C_GATE = 9232, C_END = 13328;
constexpr int NCOND = 132;
constexpr float EPSF = 1e-6f;

constexpr size_t WS_WIN = 0;
constexpr size_t WS_WBR = WS_WIN + (size_t)4 * 13568 * 1024 * 2;
constexpr size_t WS_WO = WS_WBR + (size_t)16 * 1024 * 1024 * 2;
constexpr size_t WS_WUP = WS_WO + (size_t)4 * 1024 * 1024 * 2;
constexpr size_t WS_WDN = WS_WUP + (size_t)4 * 5632 * 1024 * 2;
constexpr size_t WS_WADA = WS_WDN + (size_t)4 * 1024 * 2816 * 2;
constexpr size_t WS_CACT = WS_WADA + (size_t)4 * 6144 * 1024 * 2;
constexpr size_t WS_MOD = WS_CACT + (size_t)256 * 1024 * 2;
constexpr size_t WS_H = WS_MOD + (size_t)4 * NCOND * 6144 * 4;
constexpr size_t WS_MSUM = WS_H + (size_t)NTOK * 1024 * 2;
constexpr size_t WS_PROJ = WS_MSUM + (size_t)NTOK * 1024 * 4;
constexpr size_t WS_END = WS_PROJ + (size_t)NTOK * LDP * 2;
constexpr size_t WS_BAR = WS_END;
constexpr size_t WS_SSDST = WS_WADA;
constexpr size_t WS_SSDDEC = WS_WADA + (size_t)4 * 32 * 16 * 4096 * 4;
constexpr size_t UP_BYTES = (size_t)NTOK * 5632 * 2;

constexpr size_t O_YP = 0, O_YS = 16777216, O_PSSM = O_YS + 524288, O_PSSDC = O_PSSM + 1048576, O_PSCC = O_PSSDC + 73728,
                 O_PK = O_PSCC + 32768, O_PV = O_PK + 524288, O_PFFC = O_PV + 524288, O_SSSM = O_PFFC + 180224,
                 O_SSSDC = O_SSSM + 33554432, O_SSCC = O_SSSDC + 2359296, O_SK = O_SSCC + 1048576, O_SV = O_SK + 16777216,
                 O_SFFC = O_SV + 16777216, O_SGMV = O_SFFC + 5767168, O_END = O_SGMV + 2097152;

struct Params { const float* in[34]; float* out; unsigned char* ws; int ph_lo, ph_hi; };

constexpr int LDS_BYTES = 155648;

__device__ __forceinline__ float bf2f(bf16_t v) { return __uint_as_float((unsigned)v << 16); }
__device__ __forceinline__ float bflo(unsigned v) { return __uint_as_float(v << 16); }
__device__ __forceinline__ float bfhi(unsigned v) { return __uint_as_float(v & 0xffff0000u); }
__device__ __forceinline__ unsigned pk2(float lo, float hi) { unsigned r; asm("v_cvt_pk_bf16_f32 %0, %1, %2" : "=v"(r) : "v"(lo), "v"(hi)); return r; }
__device__ __forceinline__ bf16_t f2bf(float f) { return (bf16_t)(pk2(f, 0.f) & 0xffffu); }
__device__ __forceinline__ float shx(float v, int o, int lane) { return __int_as_float(__builtin_amdgcn_ds_bpermute((lane ^ o) << 2, __float_as_int(v))); }
__device__ __forceinline__ float wave_sum(float v, int lane) {
#pragma unroll
    for (int o = 32; o > 0; o >>= 1) v += shx(v, o, lane);
    return v;
}
__device__ __forceinline__ int otid() { int t = threadIdx.x; asm volatile("" : "+v"(t)); return t; }
__device__ __forceinline__ float sigmoidf_(float x) { return __builtin_amdgcn_rcpf(1.f + __expf(-x)); }
__device__ __forceinline__ float siluf_(float x) { return x * __builtin_amdgcn_rcpf(1.f + __expf(-x)); }
__device__ __forceinline__ float geluf_(float x) { const float u = 0.7978845608f * (x + 0.044715f * x * x * x); return x / (1.f + __expf(-2.f * u)); }
__device__ __forceinline__ float softplusf_(float x) { return fmaxf(x, 0.f) + log1pf(__expf(-fabsf(x))); }
__device__ __forceinline__ float silu_fast(float x) { return x * __builtin_amdgcn_rcpf(1.f + __expf(-x)); }
__device__ __forceinline__ float sigmoid_fast(float x) { return __builtin_amdgcn_rcpf(1.f + __expf(-x)); }
__device__ __forceinline__ float gelu_fast(float x) { const float u = 0.7978845608f * (x + 0.044715f * x * x * x); return x * __builtin_amdgcn_rcpf(1.f + __expf(-2.f * u)); }
__device__ __forceinline__ int cond_row(int r) { return r < NPR ? (r >> 12) : 4 + ((r - NPR) >> 2); }
__device__ __forceinline__ int seq_start(int r) { return r < NPR ? (r & ~4095) : NPR + ((r - NPR) & ~3); }

constexpr int BM = 256, BK = 64, HALF = 128, HTB = HALF * BK * 2;
__device__ __forceinline__ int lds_byte(int r, int c) { const int st = (r >> 4) * 2 + (c >> 5), rr = r & 15, cc = c & 31, ob = rr * 64 + cc * 2; return st * 1024 + (ob ^ (((ob >> 9) & 1) << 5)); }
__device__ __forceinline__ void stage_rc(int b, int& R, int& C) { const int st = b / 1024, sb = b % 1024, swz = sb ^ (((sb >> 9) & 1) << 5); R = (st >> 1) * 16 + swz / 64; C = (st & 1) * 32 + (swz % 64) / 2; }
__device__ __forceinline__ int perm32(int rho) { const int n = rho >> 4, i = rho & 15; return 8 * (i >> 2) + 4 * n + (i & 3); }

struct Unit { int pm, pn, z; };
struct Gemm { const bf16_t* A; const bf16_t* Bt; int lda, ldb, K, nM, nN; int ao0, ao1, ao2, ao3; size_t zB; };
__device__ __forceinline__ int gemm_aofs(const Gemm& g, int z) { return z == 0 ? g.ao0 : (z == 1 ? g.ao1 : (z == 2 ? g.ao2 : g.ao3)); }

template <int ZN> __device__ __forceinline__ bool unit_next(const Gemm& g, int i, Unit& u) {
    const int tile = i / ZN; u.z = i - tile * ZN;
    const long L = (long)tile * gridDim.x + blockIdx.x; const int nwg = g.nM * g.nN; if (L >= nwg) return false;
    int wgid = (int)L; { const int q = nwg / 8, r = nwg % 8, xcd = wgid % 8, off = wgid / 8; wgid = (xcd < r ? xcd * (q + 1) : r * (q + 1) + (xcd - r) * q) + off; }
    const int nig = 8 * g.nN, gid = wgid / nig, fm = gid * 8, gsz = (g.nM - fm) < 8 ? (g.nM - fm) : 8;
    u.pm = fm + ((wgid % nig) % gsz); u.pn = (wgid % nig) / gsz; return true;
}

template <class Epi, int ZN>
__device__ __forceinline__ void gemm_phase(LAS unsigned char* lds, const Gemm g, const Epi& E) {
    const int tid = otid(), wid = __builtin_amdgcn_readfirstlane(tid >> 6), lane = tid & 63, wr = wid >> 2, wc = wid & 3, fr = lane & 15, fq = lane >> 4;
    const int K = g.K, nt = K / BK;
    unsigned voffA[2], voffB[2];
#pragma unroll
    for (int i = 0; i < 2; ++i) { int R, C; stage_rc(tid * 16 + i * 8192, R, C); const int Rb = Epi::PERM ? ((R & ~31) + perm32(R & 31)) : R;
        voffA[i] = (unsigned)(R * g.lda + C) * 2u; voffB[i] = (unsigned)(Rb * g.ldb + C) * 2u; }
    const size_t kstep = (size_t)(BK * 2);
    const size_t hstepA = (size_t)HALF * g.lda * 2, hstepB = (size_t)HALF * g.ldb * 2;
    const size_t tstepA = 2 * hstepA, tstepB = 2 * hstepB;
    const unsigned ldsw = (unsigned)wid * 1024u;
    const int aoff = lds_byte(wr * 64 + fr, fq * 8), boff = lds_byte(wc * 32 + fr, fq * 8);
#define PG8_SA(b, h) (((b) * 2 + (h)) * HTB)
#define PG8_SB(b, h) ((4 + (b) * 2 + (h)) * HTB)
#define PG8_STAGE(bufoff, gbase, voff) do { _Pragma("unroll") for (int _i = 0; _i < 2; ++_i) \
        __builtin_amdgcn_global_load_lds((const unsigned*)((const char*)(gbase) + (voff)[_i]), (LAS unsigned*)(lds + (bufoff) + ldsw + _i * 8192), 16, 0, 0); } while (0)
#define PG8_LDA(dst, b, h) do { _Pragma("unroll") for (int m = 0; m < 4; ++m) _Pragma("unroll") for (int k = 0; k < 2; ++k) dst[m][k] = *(const LAS bf16x8*)(lds + PG8_SA(b, h) + aoff + m * 2048 + k * 1024); } while (0)
#define PG8_LDB(dst, b, h) do { _Pragma("unroll") for (int n = 0; n < 2; ++n) _Pragma("unroll") for (int k = 0; k < 2; ++k) dst[n][k] = *(const LAS bf16x8*)(lds + PG8_SB(b, h) + boff + n * 2048 + k * 1024); } while (0)
#define PG8_MMA(ai, bj, At, Bt) do { __builtin_amdgcn_s_setprio(1); _Pragma("unroll") for (int m = 0; m < 4; ++m) _Pragma("unroll") for (int n = 0; n < 2; ++n) _Pragma("unroll") for (int k = 0; k < 2; ++k) \
        acc[ai][bj][m][n] = __builtin_amdgcn_mfma_f32_16x16x32_bf16(Bt[n][k], At[m][k], acc[ai][bj][m][n], 0, 0, 0); __builtin_amdgcn_s_setprio(0); } while (0)
#define PG8_WAIT_V(n) asm volatile("s_waitcnt vmcnt(" #n ")" ::: "memory")
#define PG8_WAIT_L(n) asm volatile("s_waitcnt lgkmcnt(" #n ")" ::: "memory")
#define PG8_BAR __builtin_amdgcn_s_barrier()
#define PG8_SCHED __builtin_amdgcn_sched_barrier(0)
    Unit cur, nxt; int ui = 0;
    if (!unit_next<ZN>(g, 0, cur)) return;
    f32x4 acc[2][2][4][2];
#pragma unroll
    for (int a = 0; a < 2; ++a)
#pragma unroll
        for (int b = 0; b < 2; ++b)
#pragma unroll
            for (int m = 0; m < 4; ++m)
#pragma unroll
                for (int n = 0; n < 2; ++n) acc[a][b][m][n] = (f32x4){0.f, 0.f, 0.f, 0.f};
    bf16x8 At[4][2], B0[2][2], B1[2][2];
    const char* cA = (const char*)g.A + (size_t)cur.pm * tstepA + (size_t)gemm_aofs(g, cur.z) * 2;
    const char* cB = (const char*)g.Bt + (size_t)cur.pn * tstepB + (size_t)cur.z * g.zB * 2;
    PG8_WAIT_V(0);
    PG8_STAGE(PG8_SB(0, 0), cB, voffB); PG8_STAGE(PG8_SA(0, 0), cA, voffA); PG8_STAGE(PG8_SB(0, 1), cB + hstepB, voffB); PG8_STAGE(PG8_SA(0, 1), cA + hstepA, voffA);
    if (wr == 1) PG8_BAR;
    PG8_WAIT_V(4); PG8_BAR;
    PG8_STAGE(PG8_SB(1, 0), cB + kstep, voffB); PG8_STAGE(PG8_SA(1, 0), cA + kstep, voffA); PG8_STAGE(PG8_SB(1, 1), cB + hstepB + kstep, voffB);
    PG8_WAIT_V(6); PG8_BAR;
    for (;;) {
        const bool has_next = unit_next<ZN>(g, ui + 1, nxt);
        const char* nA = has_next ? (const char*)g.A + (size_t)nxt.pm * tstepA + (size_t)gemm_aofs(g, nxt.z) * 2 : cA;
        const char* nB = has_next ? (const char*)g.Bt + (size_t)nxt.pn * tstepB + (size_t)nxt.z * g.zB * 2 : cB;
        for (int t = 0; t < nt; t += 2) {
            const bool last = (t == nt - 2);
            const char* a1 = cA + (size_t)(t + 1) * kstep;
            const char* a2 = last ? nA : cA + (size_t)(t + 2) * kstep; const char* b2 = last ? nB : cB + (size_t)(t + 2) * kstep;
            const char* a3 = a2 + kstep; const char* b3 = b2 + kstep;
            PG8_LDB(B0, 0, 0); PG8_SCHED; PG8_LDA(At, 0, 0); PG8_STAGE(PG8_SA(1, 1), a1 + hstepA, voffA);
            PG8_WAIT_L(8); PG8_BAR; PG8_WAIT_L(0); PG8_MMA(0, 0, At, B0); PG8_BAR; PG8_SCHED;
            PG8_LDB(B1, 0, 1); PG8_STAGE(PG8_SB(0, 0), b2, voffB);
            PG8_BAR; PG8_WAIT_L(0); PG8_MMA(0, 1, At, B1); PG8_BAR;
            PG8_LDA(At, 0, 1); PG8_STAGE(PG8_SA(0, 0), a2, voffA);
            PG8_BAR; PG8_WAIT_L(0); PG8_MMA(1, 0, At, B0); PG8_BAR; PG8_SCHED;
            PG8_STAGE(PG8_SB(0, 1), b2 + hstepB, voffB);
            PG8_WAIT_V(6); PG8_BAR; PG8_MMA(1, 1, At, B1); PG8_BAR;
            PG8_LDB(B0, 1, 0); PG8_SCHED; PG8_LDA(At, 1, 0); PG8_STAGE(PG8_SA(0, 1), a2 + hstepA, voffA);
            PG8_WAIT_L(8); PG8_BAR; PG8_WAIT_L(0); PG8_MMA(0, 0, At, B0); PG8_BAR; PG8_SCHED;
            PG8_LDB(B1, 1, 1); PG8_STAGE(PG8_SB(1, 0), b3, voffB);
            PG8_BAR; PG8_WAIT_L(0); PG8_MMA(0, 1, At, B1); PG8_BAR;
            PG8_LDA(At, 1, 1); PG8_STAGE(PG8_SA(1, 0), a3, voffA);
            PG8_BAR; PG8_WAIT_L(0); PG8_MMA(1, 0, At, B0); PG8_BAR; PG8_SCHED;
            PG8_STAGE(PG8_SB(1, 1), b3 + hstepB, voffB);
            PG8_WAIT_V(6); PG8_BAR; PG8_MMA(1, 1, At, B1); PG8_BAR;
        }
        E(acc, cur, wr, wc, fr, fq);
        if (!has_next) break;
#pragma unroll
        for (int a = 0; a < 2; ++a)
#pragma unroll
            for (int b = 0; b < 2; ++b)
#pragma unroll
                for (int m = 0; m < 4; ++m)
#pragma unroll
                    for (int n = 0; n < 2; ++n) acc[a][b][m][n] = (f32x4){0.f, 0.f, 0.f, 0.f};
        cur = nxt; cA = nA; cB = nB; ++ui;
    }
    PG8_WAIT_V(0);
    if (wr == 0) PG8_BAR;
    PG8_BAR;
#undef PG8_SA
#undef PG8_SB
#undef PG8_STAGE
#undef PG8_LDA
#undef PG8_LDB
#undef PG8_MMA
#undef PG8_WAIT_V
#undef PG8_WAIT_L
#undef PG8_BAR
#undef PG8_SCHED
}

struct EpiMod {
    static constexpr bool PERM = false;
    float* mod; const float* bada;
    __device__ __forceinline__ void operator()(const f32x4 (&acc)[2][2][4][2], const Unit& u, int wr, int wc, int fr, int fq) const {
        f32x4 bv[2][2];
#pragma unroll
        for (int bj = 0; bj < 2; ++bj)
#pragma unroll
            for (int n = 0; n < 2; ++n) bv[bj][n] = *(const f32x4*)(bada + u.pn * BM + bj * HALF + wc * 32 + n * 16 + fq * 4);
#pragma unroll
        for (int ai = 0; ai < 2; ++ai)
#pragma unroll
            for (int m = 0; m < 4; ++m) { const int r = u.pm * BM + ai * HALF + wr * 64 + m * 16 + fr; if (r >= NCOND) continue;
#pragma unroll
                for (int bj = 0; bj < 2; ++bj)
#pragma unroll
                    for (int n = 0; n < 2; ++n) { const int c = u.pn * BM + bj * HALF + wc * 32 + n * 16 + fq * 4; const int layer = c / 6144, cc = c - layer * 6144;
                        *(f32x4*)(mod + ((size_t)(layer * NCOND + r)) * 6144 + cc) = acc[ai][bj][m][n] + bv[bj][n]; } }
    }
};
struct EpiProj {
    static constexpr bool PERM = true;
    bf16_t* O;
    __device__ __forceinline__ void operator()(const f32x4 (&acc)[2][2][4][2], const Unit& u, int wr, int wc, int fr, int fq) const {
#pragma unroll
        for (int bj = 0; bj < 2; ++bj) { const int c = u.pn * BM + bj * HALF + wc * 32 + fq * 8; const int mode = (c >= C_GATE) ? 2 : (c >= C_UV ? 1 : 0);
#pragma unroll
            for (int ai = 0; ai < 2; ++ai)
#pragma unroll
                for (int m = 0; m < 4; ++m) { const int r = u.pm * BM + ai * HALF + wr * 64 + m * 16 + fr;
                    float v[8];
#pragma unroll
                    for (int i = 0; i < 8; ++i) { float x = acc[ai][bj][m][i >> 2][i & 3]; v[i] = mode == 2 ? sigmoid_fast(x) : (mode == 1 ? gelu_fast(x) : x); }
                    u32x4 o; o[0] = pk2(v[0], v[1]); o[1] = pk2(v[2], v[3]); o[2] = pk2(v[4], v[5]); o[3] = pk2(v[6], v[7]);
                    *(u32x4*)(O + (size_t)r * LDP + c) = o; } }
    }
};
struct EpiUp {
    static constexpr bool PERM = true;
    bf16_t* O;
    __device__ __forceinline__ void operator()(const f32x4 (&acc)[2][2][4][2], const Unit& u, int wr, int wc, int fr, int fq) const {
#pragma unroll
        for (int bj = 0; bj < 2; ++bj) { const int c = u.pn * BM + bj * HALF + wc * 32 + fq * 8;
#pragma unroll
            for (int ai = 0; ai < 2; ++ai)
#pragma unroll
                for (int m = 0; m < 4; ++m) { const int r = u.pm * BM + ai * HALF + wr * 64 + m * 16 + fr;
                    const f32x4 a = acc[ai][bj][m][0], b = acc[ai][bj][m][1];
                    u32x4 o; o[0] = pk2(a[0], a[1]); o[1] = pk2(a[2], a[3]); o[2] = pk2(b[0], b[1]); o[3] = pk2(b[2], b[3]);
                    *(u32x4*)(O + (size_t)r * 5632 + c) = o; } }
    }
};
struct EpiBranch {
    static constexpr bool PERM = true;
    const bf16_t* proj; float* msum; bf16_t* merged;
    __device__ __forceinline__ void operator()(const f32x4 (&acc)[2][2][4][2], const Unit& u, int wr, int wc, int fr, int fq) const {
        const int z = u.z;
#pragma unroll
        for (int bj = 0; bj < 2; ++bj) { const int c = u.pn * BM + bj * HALF + wc * 32 + fq * 8;
#pragma unroll
            for (int ai = 0; ai < 2; ++ai) {
                u32x4 gt[4], pv[4];
#pragma unroll
                for (int m = 0; m < 4; ++m) { const int r = u.pm * BM + ai * HALF + wr * 64 + m * 16 + fr;
                    gt[m] = *(const u32x4*)(proj + (size_t)r * LDP + C_GATE + z * 1024 + c);
                    pv[m] = (u32x4){0u, 0u, 0u, 0u};
                    if (z > 0) pv[m] = *(const u32x4*)(merged + (size_t)r * 1024 + c); }
#pragma unroll
                for (int m = 0; m < 4; ++m) { const int r = u.pm * BM + ai * HALF + wr * 64 + m * 16 + fr;
                    const f32x4 a = acc[ai][bj][m][0], b = acc[ai][bj][m][1]; const u32x4 gv = gt[m], p = pv[m];
                    u32x4 o;
                    o[0] = pk2(bflo(p[0]) + bflo(gv[0]) * a[0], bfhi(p[0]) + bfhi(gv[0]) * a[1]); o[1] = pk2(bflo(p[1]) + bflo(gv[1]) * a[2], bfhi(p[1]) + bfhi(gv[1]) * a[3]);
                    o[2] = pk2(bflo(p[2]) + bflo(gv[2]) * b[0], bfhi(p[2]) + bfhi(gv[2]) * b[1]); o[3] = pk2(bflo(p[3]) + bflo(gv[3]) * b[2], bfhi(p[3]) + bfhi(gv[3]) * b[3]);
                    *(u32x4*)(merged + (size_t)r * 1024 + c) = o; } } }
    }
};
struct EpiResid {
    static constexpr bool PERM = false;
    const float* xin_p; const float* xin_s; float* xout; const float* ga;
    __device__ __forceinline__ void operator()(const f32x4 (&acc)[2][2][4][2], const Unit& u, int wr, int wc, int fr, int fq) const {
        const float* gr = ga + (size_t)(u.pm >> 4) * 6144;
        f32x4 gv[2][2];
#pragma unroll
        for (int bj = 0; bj < 2; ++bj)
#pragma unroll
            for (int n = 0; n < 2; ++n) gv[bj][n] = *(const f32x4*)(gr + u.pn * BM + bj * HALF + wc * 32 + n * 16 + fq * 4);
#pragma unroll
        for (int am = 0; am < 4; ++am) { const int ai = am >> 1, m0 = (am & 1) * 2;
            f32x4 xv[2][2][2];
#pragma unroll
            for (int mm = 0; mm < 2; ++mm) { const int r = u.pm * BM + ai * HALF + wr * 64 + (m0 + mm) * 16 + fr;
#pragma unroll
                for (int bj = 0; bj < 2; ++bj)
#pragma unroll
                    for (int n = 0; n < 2; ++n) xv[mm][bj][n] = *(const f32x4*)(xin_p + (size_t)r * 1024 + u.pn * BM + bj * HALF + wc * 32 + n * 16 + fq * 4); }
#pragma unroll
            for (int mm = 0; mm < 2; ++mm) { const int r = u.pm * BM + ai * HALF + wr * 64 + (m0 + mm) * 16 + fr;
#pragma unroll
                for (int bj = 0; bj < 2; ++bj)
#pragma unroll
                    for (int n = 0; n < 2; ++n) *(f32x4*)(xout + (size_t)r * 1024 + u.pn * BM + bj * HALF + wc * 32 + n * 16 + fq * 4) = xv[mm][bj][n] + gv[bj][n] * acc[ai][bj][m0 + mm][n]; } }
    }
};

struct CTile { const float* src; bf16_t* dst; int K, N, k0, n0; };
__device__ __forceinline__ CTile conv_decode(const Params& P, int t) {
    constexpr int T_IN = 3392, T_BR = 1024, T_O = 256, T_UP = 1408, T_DN = 704, T_ADA = 1536, T_L = T_IN + T_BR + T_O + T_UP + T_DN + T_ADA;
    const int layer = t / T_L; int r = t - layer * T_L; CTile c;
    if (r < T_IN) { c.src = P.in[13] + (size_t)layer * 1024 * 13328; c.dst = (bf16_t*)(P.ws + WS_WIN) + (size_t)layer * 13568 * 1024; c.K = 1024; c.N = 13328; c.k0 = (r / 212) * 64; c.n0 = (r % 212) * 64; return c; }
    r -= T_IN;
    if (r < T_BR) { const int br = r >> 8, q = r & 255; c.src = P.in[26] + (size_t)(layer * 4 + br) * 1048576; c.dst = (bf16_t*)(P.ws + WS_WBR) + (size_t)(layer * 4 + br) * 1048576; c.K = 1024; c.N = 1024; c.k0 = (q >> 4) * 64; c.n0 = (q & 15) * 64; return c; }
    r -= T_BR;
    if (r < T_O) { c.src = P.in[27] + (size_t)layer * 1048576; c.dst = (bf16_t*)(P.ws + WS_WO) + (size_t)layer * 1048576; c.K = 1024; c.N = 1024; c.k0 = (r >> 4) * 64; c.n0 = (r & 15) * 64; return c; }
    r -= T_O;
    if (r < T_UP) { c.src = P.in[29] + (size_t)layer * 1024 * 5632; c.dst = (bf16_t*)(P.ws + WS_WUP) + (size_t)layer * 5632 * 1024; c.K = 1024; c.N = 5632; c.k0 = (r / 88) * 64; c.n0 = (r % 88) * 64; return c; }
    r -= T_UP;
    if (r < T_DN) { c.src = P.in[32] + (size_t)layer * 2816 * 1024; c.dst = (bf16_t*)(P.ws + WS_WDN) + (size_t)layer * 1024 * 2816; c.K = 2816; c.N = 1024; c.k0 = (r >> 4) * 64; c.n0 = (r & 15) * 64; return c; }
    r -= T_DN;
    c.src = P.in[10] + (size_t)layer * 1024 * 6144; c.dst = (bf16_t*)(P.ws + WS_WADA) + (size_t)layer * 6144 * 1024; c.K = 1024; c.N = 6144; c.k0 = (r / 96) * 64; c.n0 = (r % 96) * 64; return c;
}
__device__ __forceinline__ void phase_convert(const Params& P, float* T) {
    constexpr int NT = 4 * 8320;
    const int tid = otid();
    int t = blockIdx.x;
    CTile cur = conv_decode(P, t < NT ? t : 0);
    float v[8], nv[8];
#pragma unroll
    for (int e = 0; e < 8; ++e) { const int idx = tid + e * 512, k = idx >> 6, n = idx & 63; v[e] = (t < NT && cur.n0 + n < cur.N) ? cur.src[(size_t)(cur.k0 + k) * cur.N + cur.n0 + n] : 0.f; }
    for (; t < NT; t += gridDim.x) {
        const int tn = t + gridDim.x; const bool hn = tn < NT; const CTile nxt = conv_decode(P, hn ? tn : 0);
#pragma unroll
        for (int e = 0; e < 8; ++e) { const int idx = tid + e * 512, k = idx >> 6, n = idx & 63; nv[e] = (hn && nxt.n0 + n < nxt.N) ? nxt.src[(size_t)(nxt.k0 + k) * nxt.N + nxt.n0 + n] : 0.f; }
#pragma unroll
        for (int e = 0; e < 8; ++e) { const int idx = tid + e * 512, k = idx >> 6, n = idx & 63; T[k * 65 + n] = v[e]; }
        __syncthreads();
        { const int n = tid >> 3, kc = (tid & 7) * 8; float x[8];
#pragma unroll
          for (int j = 0; j < 8; ++j) x[j] = T[(kc + j) * 65 + n];
          u32x4 o; o[0] = pk2(x[0], x[1]); o[1] = pk2(x[2], x[3]); o[2] = pk2(x[4], x[5]); o[3] = pk2(x[6], x[7]);
          *(u32x4*)(cur.dst + (size_t)(cur.n0 + n) * cur.K + cur.k0 + kc) = o; }
        __syncthreads();
#pragma unroll
        for (int e = 0; e < 8; ++e) v[e] = nv[e];
        cur = nxt;
    }
    bf16_t* cact = (bf16_t*)(P.ws + WS_CACT);
    for (int i = blockIdx.x * 512 + otid(); i < 256 * 1024; i += gridDim.x * 512) {
        const int r = i >> 10, c = i & 1023; float v = 0.f;
        if (r < 4) v = siluf_(P.in[2][r * 1024 + c]); else if (r < NCOND) v = siluf_(P.in[3][(r - 4) * 1024 + c]);
        cact[i] = f2bf(v);
    }
}

__device__ __forceinline__ void phase_norm(const float* xp, const float* xs, const float* g, const float* modL, int shofs, int scofs, bf16_t* hout) {
    const int tid = otid(); const int w = tid >> 6, lane = tid & 63;
    for (int r = blockIdx.x * 8 + w; r < NTOK; r += gridDim.x * 8) {
        const float* x = r < NPR ? xp + (size_t)r * 1024 : xs + (size_t)(r - NPR) * 1024;
        const float* mr = modL + (size_t)cond_row(r) * 6144;
        f32x4 v[4]; float ss = 0.f;
#pragma unroll
        for (int i = 0; i < 4; ++i) { v[i] = *(const f32x4*)(x + i * 256 + lane * 4); ss += v[i][0] * v[i][0] + v[i][1] * v[i][1] + v[i][2] * v[i][2] + v[i][3] * v[i][3]; }
        ss = wave_sum(ss, lane); const float rs = rsqrtf(ss * (1.f / 1024.f) + EPSF);
#pragma unroll
        for (int i = 0; i < 4; ++i) { const int c = i * 256 + lane * 4;
            const f32x4 gv = *(const f32x4*)(g + c), sc = *(const f32x4*)(mr + scofs + c), sh = *(const f32x4*)(mr + shofs + c);
            f32x4 o = v[i] * rs * gv * (sc + 1.f) + sh;
            u32x2 pk; pk[0] = pk2(o[0], o[1]); pk[1] = pk2(o[2], o[3]);
            *(u32x2*)(hout + (size_t)r * 1024 + c) = pk; }
    }
}
__device__ __forceinline__ void phase_final_norm(float* x, const float* g) {
    const int tid = otid(); const int w = tid >> 6, lane = tid & 63;
    for (int r = blockIdx.x * 8 + w; r < NTOK; r += gridDim.x * 8) {
        float* xr = x + (size_t)r * 1024; f32x4 v[4]; float ss = 0.f;
#pragma unroll
        for (int i = 0; i < 4; ++i) { v[i] = *(const f32x4*)(xr + i * 256 + lane * 4); ss += v[i][0] * v[i][0] + v[i][1] * v[i][1] + v[i][2] * v[i][2] + v[i][3] * v[i][3]; }
        ss = wave_sum(ss, lane); const float rs = rsqrtf(ss * (1.f / 1024.f) + EPSF);
#pragma unroll
        for (int i = 0; i < 4; ++i) { const int c = i * 256 + lane * 4; const f32x4 gv = *(const f32x4*)(g + c); *(f32x4*)(xr + c) = v[i] * rs * gv; }
    }
}

template <int MODE>
__device__ __forceinline__ void ssd_item(const Params& P, int layer, int item, float* L) {
    const int tid = otid(), w = tid >> 6, lane = tid & 63;
    bf16_t* proj = (bf16_t*)(P.ws + WS_PROJ);
    float* states = (float*)(P.ws + WS_SSDST); float* decs = (float*)(P.ws + WS_SSDDEC);
    int r0, nsteps, half, seq0, b = 0, c = 0, sb = 0;
    if (MODE == 2) { sb = item >> 1; half = item & 1; r0 = NPR + sb * 4; nsteps = 4; seq0 = r0; }
    else { b = item >> 6; c = (item >> 1) & 31; half = item & 1; r0 = b * 4096 + c * 128; nsteps = 128; seq0 = b * 4096; }
    float* XS = L; float* ZS = XS + 16 * 512; float* BS = ZS + 16 * 512; float* CS = BS + 16 * 128; float* DTS = CS + 16 * 128; float* DAS = DTS + 128; float* SSQ = DAS + 128;
    const float* cw = P.in[14] + (size_t)layer * 4 * 1536; const float* cb = P.in[15] + (size_t)layer * 1536;
    const float* prev = P.in[5] + ((size_t)(layer * 128 + sb)) * 3 * 1536;
    const int hd = half * 8 + w, gl = w >> 2;
    float h[64];
    if (MODE == 0) {
#pragma unroll
        for (int n = 0; n < 64; ++n) h[n] = 0.f;
    } else {
        const float* s0p = (MODE == 1) ? states + ((size_t)((b * 32 + c) * 16 + hd)) * 4096 + lane * 64
                                       : P.in[4] + ((size_t)((layer * 128 + sb) * 16 + hd)) * 4096 + lane * 64;
#pragma unroll
        for (int n4 = 0; n4 < 16; ++n4) { const f32x4 v = *(const f32x4*)(s0p + n4 * 4); h[n4 * 4] = v[0]; h[n4 * 4 + 1] = v[1]; h[n4 * 4 + 2] = v[2]; h[n4 * 4 + 3] = v[3]; }
    }
    const float Dh = P.in[18][layer * 16 + hd];
    float decp = 1.f;
    for (int s0 = 0; s0 < nsteps; s0 += 16) {
        const int ns = (nsteps - s0) < 16 ? (nsteps - s0) : 16;
        __syncthreads();
        for (int idx = tid; idx < ns * 768; idx += 512) {
            const int t = idx / 768, ch = idx - t * 768;
            int cx;
            if (ch < 512) cx = half * 512 + ch; else if (ch < 640) cx = 1024 + half * 128 + (ch - 512); else cx = 1280 + half * 128 + (ch - 640);
            float a = cb[cx];
#pragma unroll
            for (int k = 0; k < 4; ++k) { const int step = s0 + t - 3 + k, rr = r0 + step; float raw;
                if (rr >= seq0) raw = bf2f(proj[(size_t)rr * LDP + C_XBC + cx]);
                else raw = (MODE == 2) ? prev[(3 + step) * 1536 + cx] : 0.f;
                a += cw[k * 1536 + cx] * raw; }
            a = siluf_(a);
            if (ch < 512) { XS[t * 512 + ch] = a; if (MODE != 0) ZS[t * 512 + ch] = bf2f(proj[(size_t)(r0 + s0 + t) * LDP + C_Z + cx]); }
            else if (ch < 640) BS[t * 128 + ch - 512] = a; else CS[t * 128 + ch - 640] = a;
        }
        if (tid < ns * 8) { const int t = tid >> 3, ww = tid & 7, hh = half * 8 + ww;
            const float dt = softplusf_(bf2f(proj[(size_t)(r0 + s0 + t) * LDP + C_DTR + hh]) + P.in[16][layer * 16 + hh]);
            DTS[t * 8 + ww] = dt; DAS[t * 8 + ww] = __expf(-dt * __expf(P.in[17][layer * 16 + hh])); }
        __syncthreads();
        for (int t = 0; t < ns; ++t) {
            const float a = DAS[t * 8 + w], dt = DTS[t * 8 + w], xv = XS[t * 512 + w * 64 + lane], xd = xv * dt; decp *= a;
            const f32x4* B4 = (const f32x4*)(BS + t * 128 + gl * 64);
#pragma unroll
            for (int n4 = 0; n4 < 16; ++n4) { const f32x4 bv = B4[n4];
                h[n4 * 4] = a * h[n4 * 4] + xd * bv[0]; h[n4 * 4 + 1] = a * h[n4 * 4 + 1] + xd * bv[1]; h[n4 * 4 + 2] = a * h[n4 * 4 + 2] + xd * bv[2]; h[n4 * 4 + 3] = a * h[n4 * 4 + 3] + xd * bv[3]; }
            if (MODE != 0) {
                const f32x4* C4 = (const f32x4*)(CS + t * 128 + gl * 64); float y0 = 0.f, y1 = 0.f;
#pragma unroll
                for (int n4 = 0; n4 < 16; ++n4) { const f32x4 cv = C4[n4]; y0 += h[n4 * 4] * cv[0] + h[n4 * 4 + 2] * cv[2]; y1 += h[n4 * 4 + 1] * cv[1] + h[n4 * 4 + 3] * cv[3]; }
                float y = y0 + y1 + Dh * xv; y *= siluf_(ZS[t * 512 + w * 64 + lane]);
                const float sq = wave_sum(y * y, lane); if (lane == 0) SSQ[(s0 + t) * 8 + w] = sq;
                proj[(size_t)(r0 + s0 + t) * LDP + C_Z + hd * 64 + lane] = f2bf(y);
            }
        }
    }
    if (MODE == 0) {
        float* sp = states + ((size_t)((b * 32 + c) * 16 + hd)) * 4096 + lane * 64;
#pragma unroll
        for (int n4 = 0; n4 < 16; ++n4) *(f32x4*)(sp + n4 * 4) = (f32x4){h[n4 * 4], h[n4 * 4 + 1], h[n4 * 4 + 2], h[n4 * 4 + 3]};
        if (lane == 0) decs[(b * 32 + c) * 16 + hd] = decp;
    }
    if (MODE == 2) {
        float* sp = P.out + O_SSSM + ((size_t)((layer * 128 + sb) * 16 + hd)) * 4096 + lane * 64;
#pragma unroll
        for (int n4 = 0; n4 < 16; ++n4) *(f32x4*)(sp + n4 * 4) = (f32x4){h[n4 * 4], h[n4 * 4 + 1], h[n4 * 4 + 2], h[n4 * 4 + 3]};
    }
    if (MODE != 0) {
        __syncthreads();
        const float ng = P.in[19][layer * 1024 + hd * 64 + lane];
        for (int t = 0; t < nsteps; ++t) {
            const float tot = SSQ[t * 8 + gl * 4] + SSQ[t * 8 + gl * 4 + 1] + SSQ[t * 8 + gl * 4 + 2] + SSQ[t * 8 + gl * 4 + 3];
            const float sc = rsqrtf(tot * (1.f / 256.f) + EPSF) * ng;
            bf16_t* ap = proj + (size_t)(r0 + t) * LDP + C_Z + hd * 64 + lane; *ap = f2bf(bf2f(*ap) * sc);
        }
    }
}

__device__ __forceinline__ int xt_idx(int row, int t) { return row * 136 + ((((t >> 3) ^ ((row >> 3) & 15)) << 3) | (t & 7)); }
__device__ __forceinline__ void ssd_stage_dt(const Params& P, int layer, const bf16_t* proj, size_t r0, int g, float* DT, float* ACS, int tid) {
    { const int hh = tid >> 7, t = tid & 127, hd = g * 4 + hh;
      const float dt = softplusf_(bf2f(proj[(r0 + t) * LDP + C_DTR + hd]) + P.in[16][layer * 16 + hd]);
      DT[hh * 128 + t] = dt; ACS[hh * 128 + t] = -dt * __expf(P.in[17][layer * 16 + hd]); }
    __syncthreads();
    if (tid < 256) { const int hh = tid >> 6, l = tid & 63; const float a0 = ACS[hh * 128 + 2 * l], a1 = ACS[hh * 128 + 2 * l + 1]; float sum = a0 + a1;
#pragma unroll
        for (int o = 1; o < 64; o <<= 1) { const float v = __int_as_float(__builtin_amdgcn_ds_bpermute(((l - o) & 63) << 2, __float_as_int(sum))); if (l >= o) sum += v; }
        ACS[hh * 128 + 2 * l] = sum - a1; ACS[hh * 128 + 2 * l + 1] = sum; }
    __syncthreads();
}
template <int PASS>
__device__ __forceinline__ void ssd_stage_conv(const Params& P, int layer, const bf16_t* proj, size_t r0, bool first, int g, const float* DT, const float* ACS, bf16_t* XT4, bf16_t* Bx, bf16_t* Cs, int tid) {
    const int slot = tid & 63, seg = tid >> 6;
    if (slot < (PASS ? 48 : 40)) {
        int cx; if (slot < 32) cx = g * 256 + slot * 8; else if (slot < 40) cx = 1024 + g * 64 + (slot - 32) * 8; else cx = 1280 + g * 64 + (slot - 40) * 8;
        const float* cw = P.in[14] + (size_t)layer * 4 * 1536 + cx; const float* cb = P.in[15] + (size_t)layer * 1536 + cx;
        float wt[4][8], bb[8], win[3][8];
#pragma unroll
        for (int k = 0; k < 4; ++k) { const f32x4 a = *(const f32x4*)(cw + k * 1536), c = *(const f32x4*)(cw + k * 1536 + 4);
#pragma unroll
            for (int i = 0; i < 4; ++i) { wt[k][i] = a[i]; wt[k][4 + i] = c[i]; } }
        { const f32x4 a = *(const f32x4*)cb, c = *(const f32x4*)(cb + 4);
#pragma unroll
          for (int i = 0; i < 4; ++i) { bb[i] = a[i]; bb[4 + i] = c[i]; } }
        const int t0 = seg * 16;
#pragma unroll
        for (int k = 0; k < 3; ++k) { u32x4 raw = (u32x4){0u, 0u, 0u, 0u};
            if (!(first && seg == 0)) raw = *(const u32x4*)(proj + (r0 + t0 - 3 + k) * LDP + C_XBC + cx);
#pragma unroll
            for (int i = 0; i < 4; ++i) { win[k][2 * i] = bflo(raw[i]); win[k][2 * i + 1] = bfhi(raw[i]); } }
        u32x4 cur4[4], nxt4[4];
#pragma unroll
        for (int q = 0; q < 4; ++q) { cur4[q] = *(const u32x4*)(proj + (r0 + t0 + q) * LDP + C_XBC + cx); nxt4[q] = cur4[q]; }
        for (int gq = 0; gq < 4; ++gq) {
            if (gq < 3) {
#pragma unroll
                for (int q = 0; q < 4; ++q) nxt4[q] = *(const u32x4*)(proj + (r0 + t0 + gq * 4 + 4 + q) * LDP + C_XBC + cx); }
#pragma unroll
            for (int q = 0; q < 4; ++q) {
                const int t = t0 + gq * 4 + q; const u32x4 raw = cur4[q];
                float cur[8], o[8];
#pragma unroll
                for (int i = 0; i < 4; ++i) { cur[2 * i] = bflo(raw[i]); cur[2 * i + 1] = bfhi(raw[i]); }
#pragma unroll
                for (int i = 0; i < 8; ++i) { o[i] = siluf_(bb[i] + wt[0][i] * win[0][i] + wt[1][i] * win[1][i] + wt[2][i] * win[2][i] + wt[3][i] * cur[i]); win[0][i] = win[1][i]; win[1][i] = win[2][i]; win[2][i] = cur[i]; }
                if (slot < 32) { const int hh = slot >> 3, p0 = (slot & 7) * 8; float sc = DT[hh * 128 + t]; if (PASS == 0) sc *= __expf(ACS[hh * 128 + 127] - ACS[hh * 128 + t]);
#pragma unroll
                    for (int i = 0; i < 8; ++i) XT4[xt_idx(hh * 64 + p0 + i, t)] = f2bf(o[i] * sc); }
                else if (slot < 40) { const int n0 = (slot - 32) * 8;
                    if (PASS == 0) {
#pragma unroll
                        for (int i = 0; i < 8; ++i) Bx[xt_idx(n0 + i, t)] = f2bf(o[i]); }
                    else { u32x4 pk; pk[0] = pk2(o[0], o[1]); pk[1] = pk2(o[2], o[3]); pk[2] = pk2(o[4], o[5]); pk[3] = pk2(o[6], o[7]); *(u32x4*)(Bx + t * 72 + n0) = pk; } }
                else { const int n0 = (slot - 40) * 8; u32x4 pk; pk[0] = pk2(o[0], o[1]); pk[1] = pk2(o[2], o[3]); pk[2] = pk2(o[4], o[5]); pk[3] = pk2(o[6], o[7]); *(u32x4*)(Cs + t * 72 + n0) = pk; }
            }
#pragma unroll
            for (int q = 0; q < 4; ++q) cur4[q] = nxt4[q];
        }
    }
}
__device__ __forceinline__ void ssd_pass1_item(const Params& P, int layer, int item, unsigned char* lds) {
    const int tid = otid(), w = __builtin_amdgcn_readfirstlane(tid >> 6), lane = tid & 63, fr = lane & 15, fq = lane >> 4;
    const int b = item >> 7, c = (item >> 2) & 31, g = item & 3; const size_t r0 = (size_t)b * 4096 + (size_t)c * 128;
    const bf16_t* proj = (const bf16_t*)(P.ws + WS_PROJ);
    float* states = (float*)(P.ws + WS_SSDST); float* decs = (float*)(P.ws + WS_SSDDEC);
    bf16_t* XT4 = (bf16_t*)lds; bf16_t* BT = XT4 + 256 * 136; float* DT = (float*)(BT + 64 * 136); float* ACS = DT + 512;
    __syncthreads();
    ssd_stage_dt(P, layer, proj, r0, g, DT, ACS, tid);
    ssd_stage_conv<0>(P, layer, proj, r0, c == 0, g, DT, ACS, XT4, BT, nullptr, tid);
    __syncthreads();
    const int hh = w >> 1, pb = (w & 1) * 2;
    f32x4 acc[2][4];
#pragma unroll
    for (int pi = 0; pi < 2; ++pi)
#pragma unroll
        for (int nt = 0; nt < 4; ++nt) acc[pi][nt] = (f32x4){0.f, 0.f, 0.f, 0.f};
#pragma unroll
    for (int ks = 0; ks < 4; ++ks) { bf16x8 a[2];
#pragma unroll
        for (int pi = 0; pi < 2; ++pi) a[pi] = *(const bf16x8*)(XT4 + xt_idx(hh * 64 + (pb + pi) * 16 + fr, ks * 32 + fq * 8));
#pragma unroll
        for (int nt = 0; nt < 4; ++nt) { const bf16x8 bv = *(const bf16x8*)(BT + xt_idx(nt * 16 + fr, ks * 32 + fq * 8));
#pragma unroll
            for (int pi = 0; pi < 2; ++pi) acc[pi][nt] = __builtin_amdgcn_mfma_f32_16x16x32_bf16(a[pi], bv, acc[pi][nt], 0, 0, 0); } }
    float* sp = states + ((size_t)((b * 32 + c) * 16 + g * 4 + hh)) * 4096;
#pragma unroll
    for (int pi = 0; pi < 2; ++pi)
#pragma unroll
        for (int nt = 0; nt < 4; ++nt)
#pragma unroll
            for (int j = 0; j < 4; ++j) sp[((pb + pi) * 16 + fq * 4 + j) * 64 + nt * 16 + fr] = acc[pi][nt][j];
    if (tid < 4) decs[(b * 32 + c) * 16 + g * 4 + tid] = __expf(ACS[tid * 128 + 127]);
}
__device__ __forceinline__ void ssd_pass3_item(const Params& P, int layer, int item, unsigned char* lds, bool dry = false) {
    const int tid = otid(), w = __builtin_amdgcn_readfirstlane(tid >> 6), lane = tid & 63, fr = lane & 15, fq = lane >> 4;
    const int b = item >> 7, c = (item >> 2) & 31, g = item & 3; const size_t r0 = (size_t)b * 4096 + (size_t)c * 128;
    bf16_t* proj = (bf16_t*)(P.ws + WS_PROJ);
    const float* states = (const float*)(P.ws + WS_SSDST);
    bf16_t* Cs = (bf16_t*)lds; bf16_t* Bs = Cs + 128 * 72; bf16_t* Sin = Bs; bf16_t* XT4 = Bs + 128 * 72; bf16_t* Ms = XT4 + 256 * 136; float* DT = (float*)(Ms + 128 * 136); float* ACS = DT + 512;
    __syncthreads();
    ssd_stage_dt(P, layer, proj, r0, g, DT, ACS, tid);
    ssd_stage_conv<1>(P, layer, proj, r0, c == 0, g, DT, ACS, XT4, Bs, Cs, tid);
    __syncthreads();
    f32x4 CB[8];
#pragma unroll
    for (int st = 0; st < 8; ++st) { CB[st] = (f32x4){0.f, 0.f, 0.f, 0.f};
        if (st <= w) {
#pragma unroll
            for (int ks = 0; ks < 2; ++ks) { const bf16x8 a = *(const bf16x8*)(Cs + (16 * w + fr) * 72 + ks * 32 + fq * 8), bv = *(const bf16x8*)(Bs + (16 * st + fr) * 72 + ks * 32 + fq * 8);
                CB[st] = __builtin_amdgcn_mfma_f32_16x16x32_bf16(a, bv, CB[st], 0, 0, 0); } } }
    float ssq[4] = {0.f, 0.f, 0.f, 0.f};
    const int nks = (w >> 1) + 1;
    bf16_t* zrow[4];
#pragma unroll
    for (int j = 0; j < 4; ++j) zrow[j] = proj + (r0 + 16 * w + fq * 4 + j) * LDP + C_Z + g * 256 + fr;
    f32x4 sna, snc;
    { const float* sp = states + ((size_t)((b * 32 + c) * 16 + g * 4)) * 4096 + (tid >> 3) * 64 + (tid & 7) * 8; sna = *(const f32x4*)sp; snc = *(const f32x4*)(sp + 4); }
    for (int hh = 0; hh < 4; ++hh) {
        const int hd = g * 4 + hh;
        __syncthreads();
        { const int p = tid >> 3, n0 = (tid & 7) * 8;
          u32x4 pk; pk[0] = pk2(sna[0], sna[1]); pk[1] = pk2(sna[2], sna[3]); pk[2] = pk2(snc[0], snc[1]); pk[3] = pk2(snc[2], snc[3]);
          *(u32x4*)(Sin + p * 72 + n0) = pk;
          if (hh < 3) { const float* sp = states + ((size_t)((b * 32 + c) * 16 + hd + 1)) * 4096 + p * 64 + n0; sna = *(const f32x4*)sp; snc = *(const f32x4*)(sp + 4); } }
        float acs_t[4];
#pragma unroll
        for (int j = 0; j < 4; ++j) acs_t[j] = ACS[hh * 128 + 16 * w + fq * 4 + j];
#pragma unroll
        for (int st = 0; st < 8; ++st) { if (st <= (w | 1)) { const float acs_s = ACS[hh * 128 + 16 * st + fr];
#pragma unroll
            for (int j = 0; j < 4; ++j) { const int t = 16 * w + fq * 4 + j, sx = 16 * st + fr; const float v = (st <= w && sx <= t) ? CB[st][j] * __expf(acs_t[j] - acs_s) : 0.f; Ms[t * 136 + sx] = f2bf(v); } } }
        __syncthreads();
        bf16_t zv[4][4];
#pragma unroll
        for (int j = 0; j < 4; ++j)
#pragma unroll
            for (int pt = 0; pt < 4; ++pt) zv[j][pt] = *(zrow[j] + hh * 64 + pt * 16);
        f32x4 yd[4], yo[4];
#pragma unroll
        for (int pt = 0; pt < 4; ++pt) { yd[pt] = (f32x4){0.f, 0.f, 0.f, 0.f}; yo[pt] = (f32x4){0.f, 0.f, 0.f, 0.f}; }
        for (int ks = 0; ks < nks; ++ks) { const bf16x8 a = *(const bf16x8*)(Ms + (16 * w + fr) * 136 + ks * 32 + fq * 8);
#pragma unroll
            for (int pt = 0; pt < 4; ++pt) { const bf16x8 bv = *(const bf16x8*)(XT4 + xt_idx(hh * 64 + pt * 16 + fr, ks * 32 + fq * 8)); yd[pt] = __builtin_amdgcn_mfma_f32_16x16x32_bf16(a, bv, yd[pt], 0, 0, 0); } }
#pragma unroll
        for (int ks = 0; ks < 2; ++ks) { const bf16x8 a = *(const bf16x8*)(Cs + (16 * w + fr) * 72 + ks * 32 + fq * 8);
#pragma unroll
            for (int pt = 0; pt < 4; ++pt) { const bf16x8 bv = *(const bf16x8*)(Sin + (pt * 16 + fr) * 72 + ks * 32 + fq * 8); yo[pt] = __builtin_amdgcn_mfma_f32_16x16x32_bf16(a, bv, yo[pt], 0, 0, 0); } }
        const float Dh = P.in[18][layer * 16 + hd];
#pragma unroll
        for (int j = 0; j < 4; ++j) { const int t = 16 * w + fq * 4 + j; const float et = __expf(acs_t[j]), idt = 1.f / DT[hh * 128 + t];
#pragma unroll
            for (int pt = 0; pt < 4; ++pt) { const int p = pt * 16 + fr; const float x = bf2f(XT4[xt_idx(hh * 64 + p, t)]) * idt;
                bf16_t* zp = zrow[j] + hh * 64 + pt * 16;
                float y = yd[pt][j] + et * yo[pt][j] + Dh * x; y *= silu_fast(bf2f(zv[j][pt])); ssq[j] += y * y; if (!dry) *zp = f2bf(y); } }
    }
    asm volatile("s_waitcnt vmcnt(0)" ::: "memory");
    const float* ng = P.in[19] + layer * 1024 + g * 256 + fr;
#pragma unroll
    for (int j = 0; j < 4; ++j) { float v = ssq[j];
#pragma unroll
        for (int o = 8; o > 0; o >>= 1) v += shx(v, o, lane);
        ssq[j] = rsqrtf(v * (1.f / 256.f) + EPSF); }
    for (int hb = 0; hb < 16; hb += 4) { bf16_t yv[4][4]; float gv[4];
#pragma unroll
        for (int q = 0; q < 4; ++q) { gv[q] = ng[(hb + q) * 16];
#pragma unroll
            for (int j = 0; j < 4; ++j) yv[q][j] = *(zrow[j] + (hb + q) * 16); }
#pragma unroll
        for (int q = 0; q < 4; ++q)
#pragma unroll
            for (int j = 0; j < 4; ++j) { if (!dry) *(zrow[j] + (hb + q) * 16) = f2bf(bf2f(yv[q][j]) * ssq[j] * gv[q]); } }
}
__device__ __forceinline__ void phase_ssd_scan(const Params& P, int layer) {
    float* states = (float*)(P.ws + WS_SSDST); const float* decs = (const float*)(P.ws + WS_SSDDEC);
    for (int e = blockIdx.x * 512 + otid(); e < 4 * 16 * 4096; e += gridDim.x * 512) {
        const int b = e >> 16, hd = (e >> 12) & 15, pn = e & 4095; float carry = 0.f;
        float st[32], dc[32];
#pragma unroll
        for (int c = 0; c < 32; ++c) { st[c] = states[((size_t)((b * 32 + c) * 16 + hd)) * 4096 + pn]; dc[c] = decs[(b * 32 + c) * 16 + hd]; }
#pragma unroll
        for (int c = 0; c < 32; ++c) { states[((size_t)((b * 32 + c) * 16 + hd)) * 4096 + pn] = carry; carry = carry * dc[c] + st[c]; }
        P.out[O_PSSM + ((size_t)((layer * 4 + b) * 16 + hd)) * 4096 + pn] = carry;
    }
}

__device__ __forceinline__ void attn_prompt_item(const Params& P, int layer, int item, unsigned char* lds, bool dry = false) {
    const int tid = otid(), w = tid >> 6, lane = tid & 63, fr = lane & 15, fq = lane >> 4;
    const int b = item >> 7, nb = (item >> 2) & 31, kvh = item & 3;
    bf16_t* proj = (bf16_t*)(P.ws + WS_PROJ);
    bf16_t* Ks = (bf16_t*)lds;
    bf16_t* Vt = Ks + 256 * 72;
    bf16_t* Pw = Vt + 64 * 280 + w * 16 * 168;
    const long rowK0 = (long)b * 4096 + (long)(nb - 1) * 128;
    const bf16_t* qbase = proj + ((size_t)b * 4096 + (size_t)nb * 128 + w * 16 + fr) * LDP + C_Q + kvh * 256 + fq * 8;
    bf16x8 qa[2], qn[2];
#pragma unroll
    for (int ks = 0; ks < 2; ++ks) { qa[ks] = *(const bf16x8*)(qbase + ks * 32); qn[ks] = qa[ks]; }
    __syncthreads();
#pragma unroll
    for (int idx = tid; idx < 2048; idx += 512) { const int kj = idx >> 3, seg = idx & 7; u32x4 v = (u32x4){0u, 0u, 0u, 0u};
        if (nb > 0 || kj >= 128) v = *(const u32x4*)(proj + (size_t)(rowK0 + kj) * LDP + C_K + kvh * 64 + seg * 8);
        *(u32x4*)(Ks + kj * 72 + seg * 8) = v; }
#pragma unroll
    for (int idx = tid; idx < 2048; idx += 512) { const int seg = idx >> 8, kj = idx & 255; u32x4 v = (u32x4){0u, 0u, 0u, 0u};
        if (nb > 0 || kj >= 128) v = *(const u32x4*)(proj + (size_t)(rowK0 + kj) * LDP + C_V + kvh * 64 + seg * 8);
#pragma unroll
        for (int i = 0; i < 8; ++i) Vt[(seg * 8 + i) * 280 + kj] = (bf16_t)((v[i >> 1] >> ((i & 1) * 16)) & 0xffffu); }
    for (int idx = tid; idx < 64 * 24; idx += 512) { const int d = idx / 24, cc = 256 + idx % 24; Vt[d * 280 + cc] = 0; }
    for (int i = lane; i < 384; i += 64) Pw[(i / 24) * 168 + 144 + i % 24] = 0;
    __syncthreads();
    const int q0 = w * 16;
    const size_t qrow0 = (size_t)b * 4096 + (size_t)nb * 128 + q0;
    for (int gi = 0; gi < 4; ++gi) {
        const int hq = kvh * 4 + gi;
        const float slope = exp2f(-0.5f * (float)(hq + 1));
        const float sink = P.in[21][layer * 16 + hq];
        if (gi < 3) {
#pragma unroll
            for (int ks = 0; ks < 2; ++ks) qn[ks] = *(const bf16x8*)(qbase + (gi + 1) * 64 + ks * 32); }
        f32x4 S[9];
#pragma unroll
        for (int nt = 0; nt < 9; ++nt) { f32x4 a = (f32x4){0.f, 0.f, 0.f, 0.f}; const bf16_t* kp = Ks + (q0 + nt * 16 + fr) * 72 + fq * 8;
#pragma unroll
            for (int ks = 0; ks < 2; ++ks) { const bf16x8 kb = *(const bf16x8*)(kp + ks * 32); a = __builtin_amdgcn_mfma_f32_16x16x32_bf16(qa[ks], kb, a, 0, 0, 0); }
            S[nt] = a; }
        float mx[4] = {-INFINITY, -INFINITY, -INFINITY, -INFINITY};
#pragma unroll
        for (int nt = 0; nt < 9; ++nt)
#pragma unroll
            for (int j = 0; j < 4; ++j) { const int dist = (fq * 4 + j) - (nt * 16 + fr) + 128; const bool valid = dist >= 0 && dist <= 128 && (nb > 0 || (q0 + nt * 16 + fr) >= 128);
                const float s = valid ? S[nt][j] * 0.125f - slope * (float)dist : -INFINITY; S[nt][j] = s; mx[j] = fmaxf(mx[j], s); }
        float inv[4];
#pragma unroll
        for (int j = 0; j < 4; ++j) { float m = mx[j];
#pragma unroll
            for (int o = 8; o > 0; o >>= 1) m = fmaxf(m, shx(m, o, lane));
            m = fmaxf(m, sink); float sum = 0.f;
#pragma unroll
            for (int nt = 0; nt < 9; ++nt) { const float p = __expf(S[nt][j] - m); S[nt][j] = p; sum += p; }
#pragma unroll
            for (int o = 8; o > 0; o >>= 1) sum += shx(sum, o, lane);
            inv[j] = 1.f / (sum + __expf(sink - m)); }
#pragma unroll
        for (int nt = 0; nt < 9; ++nt)
#pragma unroll
            for (int j = 0; j < 4; ++j) Pw[(fq * 4 + j) * 168 + nt * 16 + fr] = f2bf(S[nt][j]);
        asm volatile("s_waitcnt lgkmcnt(0)" ::: "memory"); __builtin_amdgcn_wave_barrier();
        f32x4 O[4];
#pragma unroll
        for (int dt = 0; dt < 4; ++dt) O[dt] = (f32x4){0.f, 0.f, 0.f, 0.f};
#pragma unroll
        for (int ks = 0; ks < 5; ++ks) { const bf16x8 pa = *(const bf16x8*)(Pw + fr * 168 + ks * 32 + fq * 8);
#pragma unroll
            for (int dt = 0; dt < 4; ++dt) { const bf16x8 vb = *(const bf16x8*)(Vt + (dt * 16 + fr) * 280 + q0 + ks * 32 + fq * 8); O[dt] = __builtin_amdgcn_mfma_f32_16x16x32_bf16(pa, vb, O[dt], 0, 0, 0); } }
        asm volatile("s_waitcnt lgkmcnt(0)" ::: "memory"); __builtin_amdgcn_wave_barrier();
#pragma unroll
        for (int dt = 0; dt < 4; ++dt)
#pragma unroll
            for (int j = 0; j < 4; ++j) { if (!dry) proj[(qrow0 + fq * 4 + j) * LDP + C_Q + hq * 64 + dt * 16 + fr] = f2bf(O[dt][j] * inv[j]); }
        qa[0] = qn[0]; qa[1] = qn[1];
    }
    if (nb == 31) {
        for (int idx = tid; idx < 128 * 64; idx += 512) { const int t = idx >> 6, d = idx & 63; const size_t row = (size_t)b * 4096 + 3968 + t;
            const size_t o = ((size_t)((layer * 4 + b) * 128 + t)) * 256 + kvh * 64 + d;
            P.out[O_PK + o] = bf2f(proj[row * LDP + C_K + kvh * 64 + d]); P.out[O_PV + o] = bf2f(proj[row * LDP + C_V + kvh * 64 + d]); }
    }
}
__device__ __forceinline__ void attn_sample_item(const Params& P, int layer, int item, float* L, bool dry = false) {
    const int tid = otid(), w = tid >> 6, lane = tid & 63;
    const int sb = item >> 2, kvh = item & 3, r0 = NPR + sb * 4;
    bf16_t* proj = (bf16_t*)(P.ws + WS_PROJ);
    float* Kf = L; float* Vf = Kf + 132 * 65; float* Q = Vf + 132 * 65; float* Sc = Q + 16 * 64;
    const float* ck = P.in[7] + ((size_t)(layer * 128 + sb)) * 128 * 256; const float* cv = P.in[8] + ((size_t)(layer * 128 + sb)) * 128 * 256;
    __syncthreads();
    {
        f32x4 kq[4], vq[4];
#pragma unroll
        for (int i = 0; i < 4; ++i) { const int idx = tid + i * 512, j = idx >> 4, d4 = (idx & 15) * 4; kq[i] = *(const f32x4*)(ck + (size_t)j * 256 + kvh * 64 + d4); vq[i] = *(const f32x4*)(cv + (size_t)j * 256 + kvh * 64 + d4); }
#pragma unroll
        for (int i = 0; i < 4; ++i) { const int idx = tid + i * 512, j = idx >> 4, d4 = (idx & 15) * 4;
#pragma unroll
            for (int e = 0; e < 4; ++e) { Kf[j * 65 + d4 + e] = kq[i][e]; Vf[j * 65 + d4 + e] = vq[i][e]; }
            if (j >= 4) { const size_t o = ((size_t)((layer * 128 + sb) * 128 + (j - 4))) * 256 + kvh * 64 + d4; *(f32x4*)(P.out + O_SK + o) = kq[i]; *(f32x4*)(P.out + O_SV + o) = vq[i]; } }
        if (tid < 256) { const int j = 128 + (tid >> 6), d = tid & 63; const float kv = bf2f(proj[(size_t)(r0 + j - 128) * LDP + C_K + kvh * 64 + d]), vv = bf2f(proj[(size_t)(r0 + j - 128) * LDP + C_V + kvh * 64 + d]);
            Kf[j * 65 + d] = kv; Vf[j * 65 + d] = vv; const size_t o = ((size_t)((layer * 128 + sb) * 128 + (j - 4))) * 256 + kvh * 64 + d; P.out[O_SK + o] = kv; P.out[O_SV + o] = vv; }
    }
    for (int idx = tid; idx < 1024; idx += 512) { const int qr = idx >> 6, d = idx & 63; Q[idx] = bf2f(proj[(size_t)(r0 + (qr >> 2)) * LDP + C_Q + (kvh * 4 + (qr & 3)) * 64 + d]); }
    __syncthreads();
    for (int idx = tid; idx < 16 * 132; idx += 512) { const int qr = idx / 132, j = idx - qr * 132; const int dist = 128 + (qr >> 2) - j; float s = -INFINITY;
        if (dist >= 0 && dist <= 128) { float a = 0.f;
#pragma unroll 8
            for (int d = 0; d < 64; ++d) a += Q[qr * 64 + d] * Kf[j * 65 + d];
            s = a * 0.125f - exp2f(-0.5f * (float)(kvh * 4 + (qr & 3) + 1)) * (float)dist; }
        Sc[qr * 136 + j] = s; }
    __syncthreads();
    for (int rr = 0; rr < 2; ++rr) { const int qr = w * 2 + rr; const float sink = P.in[21][layer * 16 + kvh * 4 + (qr & 3)];
        float v0 = Sc[qr * 136 + lane], v1 = Sc[qr * 136 + 64 + lane], v2 = lane < 4 ? Sc[qr * 136 + 128 + lane] : -INFINITY;
        float m = fmaxf(fmaxf(v0, v1), v2);
#pragma unroll
        for (int o = 32; o > 0; o >>= 1) m = fmaxf(m, shx(m, o, lane));
        m = fmaxf(m, sink);
        v0 = __expf(v0 - m); v1 = __expf(v1 - m); v2 = __expf(v2 - m);
        const float sum = wave_sum(v0 + v1 + v2, lane); const float inv = 1.f / (sum + __expf(sink - m));
        Sc[qr * 136 + lane] = v0 * inv; Sc[qr * 136 + 64 + lane] = v1 * inv; if (lane < 4) Sc[qr * 136 + 128 + lane] = v2 * inv; }
    __syncthreads();
    for (int idx = tid; idx < 1024; idx += 512) { const int qr = idx >> 6, d = idx & 63; float o = 0.f;
        for (int j = 0; j < 132; ++j) o += Sc[qr * 136 + j] * Vf[j * 65 + d];
        if (!dry) proj[(size_t)(r0 + (qr >> 2)) * LDP + C_Q + (kvh * 4 + (qr & 3)) * 64 + d] = f2bf(o); }
}

__device__ __forceinline__ void gmlp_prompt_item(const Params& P, int layer, int item, unsigned char* lds, bool dry = false) {
    const int tid = otid(), w = tid >> 6, lane = tid & 63, fr = lane & 15, fq = lane >> 4;
    const int b = item >> 8, chn = (item >> 3) & 31, g = item & 7;
    const size_t r0 = (size_t)b * 4096 + (size_t)chn * 128;
    bf16_t* proj = (bf16_t*)(P.ws + WS_PROJ);
    bf16_t* VT = (bf16_t*)lds; bf16_t* Wt = VT + 128 * 136; float* MU = (float*)(Wt + 128 * 136); float* RS = MU + 128;
    __syncthreads();
#pragma unroll
    for (int hb = 0; hb < 2; ++hb) { u32x4 av[8], cv8[8];
#pragma unroll
        for (int i = 0; i < 8; ++i) { const bf16_t* vp = proj + (r0 + w * 16 + hb * 8 + i) * LDP + C_UV + 1024 + lane * 16; av[i] = *(const u32x4*)vp; cv8[i] = *(const u32x4*)(vp + 8); }
#pragma unroll
        for (int i = 0; i < 8; ++i) { const int t = w * 16 + hb * 8 + i; float s = 0.f, sq = 0.f;
#pragma unroll
            for (int k = 0; k < 4; ++k) { float x0 = bflo(av[i][k]), x1 = bfhi(av[i][k]), x2 = bflo(cv8[i][k]), x3 = bfhi(cv8[i][k]); s += x0 + x1 + x2 + x3; sq += x0 * x0 + x1 * x1 + x2 * x2 + x3 * x3; }
            s = wave_sum(s, lane); sq = wave_sum(sq, lane);
            if (lane == 0) { const float mean = s * (1.f / 1024.f); const float var = fmaxf(sq * (1.f / 1024.f) - mean * mean, 0.f); MU[t] = mean; RS[t] = rsqrtf(var + EPSF); } } }
    const float* Wg = P.in[24] + ((size_t)(layer * 8 + g)) * 16384;
#pragma unroll
    for (int idx = tid; idx < 4096; idx += 512) { const int t = idx >> 5, s4 = (idx & 31) * 4; const f32x4 wv = *(const f32x4*)(Wg + t * 128 + s4);
        u32x2 o; o[0] = pk2(s4 <= t ? wv[0] : 0.f, s4 + 1 <= t ? wv[1] : 0.f); o[1] = pk2(s4 + 2 <= t ? wv[2] : 0.f, s4 + 3 <= t ? wv[3] : 0.f);
        *(u32x2*)(Wt + t * 136 + s4) = o; }
    __syncthreads();
    const float* lg = P.in[22] + layer * 1024 + g * 128; const float* lb = P.in[23] + layer * 1024 + g * 128;
#pragma unroll
    for (int idx = tid; idx < 2048; idx += 512) { const int s = idx & 127, fs = idx >> 7; const u32x4 v = *(const u32x4*)(proj + (r0 + s) * LDP + C_UV + 1024 + g * 128 + fs * 8);
        const float mu = MU[s], rs = RS[s];
#pragma unroll
        for (int i = 0; i < 8; ++i) { const int f = fs * 8 + i; const float x = (i & 1) ? bfhi(v[i >> 1]) : bflo(v[i >> 1]); VT[f * 136 + s] = f2bf((x - mu) * rs * lg[f] + lb[f]); } }
    __syncthreads();
    f32x4 acc[8];
#pragma unroll
    for (int ft = 0; ft < 8; ++ft) acc[ft] = (f32x4){0.f, 0.f, 0.f, 0.f};
    const int nks = (16 * w + 15) / 32 + 1;
    for (int ks = 0; ks < nks; ++ks) { const bf16x8 a = *(const bf16x8*)(Wt + (w * 16 + fr) * 136 + ks * 32 + fq * 8);
#pragma unroll
        for (int ft = 0; ft < 8; ++ft) { const bf16x8 bb = *(const bf16x8*)(VT + (ft * 16 + fr) * 136 + ks * 32 + fq * 8); acc[ft] = __builtin_amdgcn_mfma_f32_16x16x32_bf16(a, bb, acc[ft], 0, 0, 0); } }
    bf16_t uv[4][8]; float bsv[4];
#pragma unroll
    for (int j = 0; j < 4; ++j) { const int t = w * 16 + fq * 4 + j; bsv[j] = P.in[25][(layer * 8 + g) * 128 + t];
#pragma unroll
        for (int ft = 0; ft < 8; ++ft) uv[j][ft] = proj[(r0 + t) * LDP + C_UV + g * 128 + ft * 16 + fr]; }
#pragma unroll
    for (int j = 0; j < 4; ++j) { const int t = w * 16 + fq * 4 + j;
#pragma unroll
        for (int ft = 0; ft < 8; ++ft) { if (!dry) proj[(r0 + t) * LDP + C_UV + g * 128 + ft * 16 + fr] = f2bf(bf2f(uv[j][ft]) * (acc[ft][j] + bsv[j])); } }
}
__device__ __forceinline__ void gmlp_sample_item(const Params& P, int layer, int sb, float* L) {
    const int tid = otid(), w = tid >> 6, lane = tid & 63; const size_t r0 = NPR + sb * 4;
    bf16_t* proj = (bf16_t*)(P.ws + WS_PROJ);
    float* Vn = L; float* MU = Vn + 4096; float* RS = MU + 4;
    __syncthreads();
    if (w < 4) { const bf16_t* vp = proj + (r0 + w) * LDP + C_UV + 1024 + lane * 16; const u32x4 a = *(const u32x4*)vp, c = *(const u32x4*)(vp + 8); float s = 0.f, sq = 0.f;
#pragma unroll
        for (int k = 0; k < 4; ++k) { float x0 = bflo(a[k]), x1 = bfhi(a[k]), x2 = bflo(c[k]), x3 = bfhi(c[k]); s += x0 + x1 + x2 + x3; sq += x0 * x0 + x1 * x1 + x2 * x2 + x3 * x3; }
        s = wave_sum(s, lane); sq = wave_sum(sq, lane);
        if (lane == 0) { const float mean = s * (1.f / 1024.f); const float var = fmaxf(sq * (1.f / 1024.f) - mean * mean, 0.f); MU[w] = mean; RS[w] = rsqrtf(var + EPSF); } }
    __syncthreads();
    for (int idx = tid; idx < 4096; idx += 512) { const int t = idx >> 10, c = idx & 1023;
        const float x = bf2f(proj[(r0 + t) * LDP + C_UV + 1024 + c]); const float vn = (x - MU[t]) * RS[t] * P.in[22][layer * 1024 + c] + P.in[23][layer * 1024 + c];
        Vn[idx] = vn; P.out[O_SGMV + ((size_t)((layer * 128 + sb) * 4 + t)) * 1024 + c] = vn; }
    __syncthreads();
    for (int idx = tid; idx < 4096; idx += 512) { const int t = idx >> 10, c = idx & 1023, g = c >> 7;
        const float* Wg = P.in[24] + ((size_t)(layer * 8 + g)) * 16384 + t * 128; float m = P.in[25][(layer * 8 + g) * 128 + t];
        for (int s = 0; s <= t; ++s) m += Wg[s] * Vn[s * 1024 + c];
        bf16_t* ap = proj + (r0 + t) * LDP + C_UV + c; *ap = f2bf(bf2f(*ap) * m); }
}

template <int R>
__device__ __forceinline__ void shortconv_rows(const Params& P, int layer, int r0, int tid, bool dry) {
    bf16_t* proj = (bf16_t*)(P.ws + WS_PROJ);
    const float* cw = P.in[20] + layer * 3 * 1024;
    const int j = tid * 2; const int ss = seq_start(r0); const bool havePrev = (r0 - 2 >= ss);
    unsigned cg[R + 2], xs[R + 2], bg[R];
#pragma unroll
    for (int k = 0; k < R + 2; ++k) { cg[k] = 0u; xs[k] = 0u;
        if (k >= 2 || havePrev) { const bf16_t* rp = proj + (size_t)(r0 - 2 + k) * LDP + C_BCX + j; cg[k] = *(const unsigned*)(rp + 1024); xs[k] = *(const unsigned*)(rp + 2048); } }
#pragma unroll
    for (int k = 0; k < R; ++k) bg[k] = *(const unsigned*)(proj + (size_t)(r0 + k) * LDP + C_BCX + j);
    float pr0[R + 2], pr1[R + 2];
#pragma unroll
    for (int k = 0; k < R + 2; ++k) { pr0[k] = bflo(cg[k]) * bflo(xs[k]); pr1[k] = bfhi(cg[k]) * bfhi(xs[k]); }
    if (!havePrev && r0 >= NPR) { const float* st = P.in[6] + ((size_t)(layer * 128 + ((r0 - NPR) >> 2)) * 2) * 1024 + j; pr0[0] = st[0]; pr1[0] = st[1]; pr0[1] = st[1024]; pr1[1] = st[1025]; }
    const float w0a = cw[j], w0b = cw[j + 1], w1a = cw[1024 + j], w1b = cw[1025 + j], w2a = cw[2048 + j], w2b = cw[2049 + j];
#pragma unroll
    for (int k = 0; k < R; ++k) { const float y0 = w0a * pr0[k] + w1a * pr0[k + 1] + w2a * pr0[k + 2], y1 = w0b * pr1[k] + w1b * pr1[k + 1] + w2b * pr1[k + 2];
        if (!dry) *(unsigned*)(proj + (size_t)(r0 + k) * LDP + C_BCX + j) = pk2(bflo(bg[k]) * y0, bfhi(bg[k]) * y1);
        const int r = r0 + k;
        if (r < NPR) { const int l = r & 4095; if (l >= 4094) { float* o = P.out + O_PSCC + ((size_t)((layer * 4 + (r >> 12)) * 2 + (l - 4094))) * 1024 + j; o[0] = pr0[k + 2]; o[1] = pr1[k + 2]; } }
        else { const int l = (r - NPR) & 3; if (l >= 2) { float* o = P.out + O_SSCC + ((size_t)((layer * 128 + ((r - NPR) >> 2)) * 2 + (l - 2))) * 1024 + j; o[0] = pr0[k + 2]; o[1] = pr1[k + 2]; } }
    }
}
__device__ __forceinline__ void shortconv_item(const Params& P, int layer, int item, bool dry = false) {
    const int tid = otid();
    if (item < 1024) shortconv_rows<16>(P, layer, item * 16, tid, dry); else shortconv_rows<4>(P, layer, NPR + (item - 1024) * 4, tid, dry);
}
__device__ __forceinline__ void ssdconv_state_item(const Params& P, int layer, int sq) {
    const bf16_t* proj = (const bf16_t*)(P.ws + WS_PROJ);
    const size_t rbase = sq < 4 ? (size_t)sq * 4096 + 4093 : (size_t)NPR + (size_t)(sq - 4) * 4 + 1;
    float* o = sq < 4 ? P.out + O_PSSDC + (size_t)(layer * 4 + sq) * 3 * 1536 : P.out + O_SSSDC + (size_t)(layer * 128 + (sq - 4)) * 3 * 1536;
    const int tid = otid(); bf16_t v[9];
#pragma unroll
    for (int i = 0; i < 9; ++i) { const int e = tid + i * 512, t = e / 1536, c = e - t * 1536; v[i] = proj[(rbase + t) * LDP + C_XBC + c]; }
#pragma unroll
    for (int i = 0; i < 9; ++i) o[tid + i * 512] = bf2f(v[i]);
}

template <int R>
__device__ __forceinline__ void ffn_act_unit(const Params& P, int layer, int r0, int oc) {
    const bf16_t* up = (const bf16_t*)(P.ws + WS_PROJ); bf16_t* act = (bf16_t*)(P.ws + WS_PROJ + UP_BYTES);
    const float* cw = P.in[30] + (size_t)layer * 3 * 5632; const float* cb = P.in[31] + (size_t)layer * 5632;
    const int j0 = oc * 8;
    float wa[3][8], wg[3][8], ba[8], bgv[8], pa[2][8], pg[2][8];
#pragma unroll
    for (int k = 0; k < 3; ++k) { const f32x4 a0 = *(const f32x4*)(cw + k * 5632 + j0), a1 = *(const f32x4*)(cw + k * 5632 + j0 + 4), g0 = *(const f32x4*)(cw + k * 5632 + 2816 + j0), g1 = *(const f32x4*)(cw + k * 5632 + 2816 + j0 + 4);
#pragma unroll
        for (int i = 0; i < 4; ++i) { wa[k][i] = a0[i]; wa[k][4 + i] = a1[i]; wg[k][i] = g0[i]; wg[k][4 + i] = g1[i]; } }
    { const f32x4 a0 = *(const f32x4*)(cb + j0), a1 = *(const f32x4*)(cb + j0 + 4), g0 = *(const f32x4*)(cb + 2816 + j0), g1 = *(const f32x4*)(cb + 2816 + j0 + 4);
#pragma unroll
      for (int i = 0; i < 4; ++i) { ba[i] = a0[i]; ba[4 + i] = a1[i]; bgv[i] = g0[i]; bgv[4 + i] = g1[i]; } }
    const int ss = seq_start(r0); const bool havePrev = (r0 - 2 >= ss);
#pragma unroll
    for (int k = 0; k < 2; ++k) {
        if (havePrev) { const u32x4 ua = *(const u32x4*)(up + (size_t)(r0 - 2 + k) * 5632 + j0), ug = *(const u32x4*)(up + (size_t)(r0 - 2 + k) * 5632 + 2816 + j0);
#pragma unroll
            for (int i = 0; i < 4; ++i) { pa[k][2 * i] = bflo(ua[i]); pa[k][2 * i + 1] = bfhi(ua[i]); pg[k][2 * i] = bflo(ug[i]); pg[k][2 * i + 1] = bfhi(ug[i]); } }
        else if (r0 >= NPR) { const float* pp = P.in[9] + ((size_t)(layer * 128 + ((r0 - NPR) >> 2)) * 2 + k) * 5632;
#pragma unroll
            for (int i = 0; i < 8; ++i) { pa[k][i] = pp[j0 + i]; pg[k][i] = pp[2816 + j0 + i]; } }
        else {
#pragma unroll
            for (int i = 0; i < 8; ++i) { pa[k][i] = 0.f; pg[k][i] = 0.f; } } }
#pragma unroll
    for (int kb = 0; kb < R; kb += 4) { u32x4 ua[4], ug[4];
#pragma unroll
        for (int q = 0; q < 4; ++q) { ua[q] = *(const u32x4*)(up + (size_t)(r0 + kb + q) * 5632 + j0); ug[q] = *(const u32x4*)(up + (size_t)(r0 + kb + q) * 5632 + 2816 + j0); }
#pragma unroll
        for (int q = 0; q < 4; ++q) { const int r = r0 + kb + q; float ca[8], cgv[8], o[8];
#pragma unroll
            for (int i = 0; i < 4; ++i) { ca[2 * i] = bflo(ua[q][i]); ca[2 * i + 1] = bfhi(ua[q][i]); cgv[2 * i] = bflo(ug[q][i]); cgv[2 * i + 1] = bfhi(ug[q][i]); }
#pragma unroll
            for (int i = 0; i < 8; ++i) { const float a = ba[i] + wa[0][i] * pa[0][i] + wa[1][i] * pa[1][i] + wa[2][i] * ca[i], g = bgv[i] + wg[0][i] * pg[0][i] + wg[1][i] * pg[1][i] + wg[2][i] * cgv[i];
                o[i] = silu_fast(a) * g; pa[0][i] = pa[1][i]; pa[1][i] = ca[i]; pg[0][i] = pg[1][i]; pg[1][i] = cgv[i]; }
            u32x4 ov; ov[0] = pk2(o[0], o[1]); ov[1] = pk2(o[2], o[3]); ov[2] = pk2(o[4], o[5]); ov[3] = pk2(o[6], o[7]);
            *(u32x4*)(act + (size_t)r * 2816 + j0) = ov;
            float* so = nullptr;
            if (r < NPR) { const int l = r & 4095; if (l >= 4094) so = P.out + O_PFFC + ((size_t)((layer * 4 + (r >> 12)) * 2 + (l - 4094))) * 5632; }
            else { const int l = (r - NPR) & 3; if (l >= 2) so = P.out + O_SFFC + ((size_t)((layer * 128 + ((r - NPR) >> 2)) * 2 + (l - 2))) * 5632; }
            if (so) {
#pragma unroll
                for (int i = 0; i < 8; ++i) { so[j0 + i] = ca[i]; so[2816 + j0 + i] = cgv[i]; } }
        } }
}
__device__ __forceinline__ void phase_ffn_act(const Params& P, int layer) {
    constexpr int NU_P = 2048 * 352, NU_S = 128 * 352;
    for (int u = blockIdx.x * 512 + otid(); u < NU_P + NU_S; u += gridDim.x * 512) {
        if (u < NU_P) { const int rb = u / 352, oc = u - rb * 352; ffn_act_unit<8>(P, layer, rb * 8, oc); }
        else { const int v = u - NU_P, sq = v / 352, oc = v - sq * 352; ffn_act_unit<4>(P, layer, NPR + sq * 4, oc); }
    }
}

__device__ __forceinline__ void sgemm_partial(const bf16_t* A, int lda, const bf16_t* Bt, int ldb, int K, int row0, int col0, float* red, int tid) {
    const int w = tid >> 6, lane = tid & 63, fr = lane & 15, fq = lane >> 4;
    const int kw = K >> 3, k0 = w * kw;
    f32x4 acc[2][4];
#pragma unroll
    for (int mt = 0; mt < 2; ++mt)
#pragma unroll
        for (int nt = 0; nt < 4; ++nt) acc[mt][nt] = (f32x4){0.f, 0.f, 0.f, 0.f};
    const bf16_t* ap = A + (size_t)(row0 + fr) * lda + k0 + fq * 8;
    const bf16_t* bp = Bt + (size_t)(col0 + fr) * ldb + k0 + fq * 8;
    const int nks = kw >> 5;
#pragma unroll 4
    for (int ks = 0; ks < nks; ++ks) { bf16x8 a[2], b[4];
#pragma unroll
        for (int mt = 0; mt < 2; ++mt) a[mt] = *(const bf16x8*)(ap + (size_t)mt * 16 * lda + ks * 32);
#pragma unroll
        for (int nt = 0; nt < 4; ++nt) b[nt] = *(const bf16x8*)(bp + (size_t)nt * 16 * ldb + ks * 32);
#pragma unroll
        for (int mt = 0; mt < 2; ++mt)
#pragma unroll
            for (int nt = 0; nt < 4; ++nt) acc[mt][nt] = __builtin_amdgcn_mfma_f32_16x16x32_bf16(a[mt], b[nt], acc[mt][nt], 0, 0, 0); }
#pragma unroll
    for (int mt = 0; mt < 2; ++mt)
#pragma unroll
        for (int nt = 0; nt < 4; ++nt)
#pragma unroll
            for (int j = 0; j < 4; ++j) red[(w * 32 + mt * 16 + fq * 4 + j) * 64 + nt * 16 + fr] = acc[mt][nt][j];
}
__device__ __forceinline__ f32x4 sgemm_reduce(const float* red, int tid) {
    const int row = tid >> 4, c4 = (tid & 15) * 4; f32x4 sacc = (f32x4){0.f, 0.f, 0.f, 0.f};
#pragma unroll
    for (int w = 0; w < 8; ++w) sacc += *(const f32x4*)(red + (w * 32 + row) * 64 + c4);
    return sacc;
}
__device__ __forceinline__ void sg_load4(const bf16_t* ap, int lda, const bf16_t* bp, int ldb, bf16x8 (&a)[4][2], bf16x8 (&b)[4][4]) {
#pragma unroll
    for (int ks = 0; ks < 4; ++ks) {
#pragma unroll
        for (int mt = 0; mt < 2; ++mt) a[ks][mt] = *(const bf16x8*)(ap + (size_t)mt * 16 * lda + ks * 32);
#pragma unroll
        for (int nt = 0; nt < 4; ++nt) b[ks][nt] = *(const bf16x8*)(bp + (size_t)nt * 16 * ldb + ks * 32); }
}
__device__ __forceinline__ void sample_branch(const Params& P, int layer, float* red) {
    const int tid = otid(), w = tid >> 6, lane = tid & 63, fr = lane & 15, fq = lane >> 4;
    const bf16_t* proj = (const bf16_t*)(P.ws + WS_PROJ); bf16_t* hbuf = (bf16_t*)(P.ws + WS_H);
    for (int piece = blockIdx.x; piece < 256; piece += gridDim.x) {
        const int row0 = (piece >> 4) * 32, col0 = (piece & 15) * 64; const size_t r = NPR + row0 + (tid >> 4); const int c = col0 + (tid & 15) * 4;
        const bf16_t* abase = proj + (size_t)(NPR + row0 + fr) * LDP + w * 128 + fq * 8;
        const bf16_t* bbase = (const bf16_t*)(P.ws + WS_WBR) + (size_t)layer * 4 * 1048576 + (size_t)(col0 + fr) * 1024 + w * 128 + fq * 8;
        bf16x8 a[4][2], b[4][4];
        sg_load4(abase + C_Z, LDP, bbase, 1024, a, b);
        f32x4 sum = (f32x4){0.f, 0.f, 0.f, 0.f};
        for (int z = 0; z < 4; ++z) {
            f32x4 acc[2][4];
#pragma unroll
            for (int mt = 0; mt < 2; ++mt)
#pragma unroll
                for (int nt = 0; nt < 4; ++nt) acc[mt][nt] = (f32x4){0.f, 0.f, 0.f, 0.f};
#pragma unroll
            for (int ks = 0; ks < 4; ++ks)
#pragma unroll
                for (int mt = 0; mt < 2; ++mt)
#pragma unroll
                    for (int nt = 0; nt < 4; ++nt) acc[mt][nt] = __builtin_amdgcn_mfma_f32_16x16x32_bf16(a[ks][mt], b[ks][nt], acc[mt][nt], 0, 0, 0);
            if (z < 3) { const int ao = z == 0 ? C_BCX : (z == 1 ? C_Q : C_UV); sg_load4(abase + ao, LDP, bbase + (size_t)(z + 1) * 1048576, 1024, a, b); }
            const u32x2 gv = *(const u32x2*)(proj + r * LDP + C_GATE + z * 1024 + c);
            __syncthreads();
#pragma unroll
            for (int mt = 0; mt < 2; ++mt)
#pragma unroll
                for (int nt = 0; nt < 4; ++nt)
#pragma unroll
                    for (int j = 0; j < 4; ++j) red[(w * 32 + mt * 16 + fq * 4 + j) * 64 + nt * 16 + fr] = acc[mt][nt][j];
            __syncthreads();
            const f32x4 v = sgemm_reduce(red, tid);
            sum[0] += bflo(gv[0]) * v[0]; sum[1] += bfhi(gv[0]) * v[1]; sum[2] += bflo(gv[1]) * v[2]; sum[3] += bfhi(gv[1]) * v[3];
        }
        u32x2 o; o[0] = pk2(sum[0], sum[1]); o[1] = pk2(sum[2], sum[3]); *(u32x2*)(hbuf + r * 1024 + c) = o;
        __syncthreads();
    }
}
__device__ __forceinline__ void sample_resid(const Params& P, const bf16_t* A, int lda, const bf16_t* Bt, int K, const float* xin_s, float* xout, const float* ga, float* red) {
    const int tid = otid();
    for (int piece = blockIdx.x; piece < 256; piece += gridDim.x) {
        const int row0 = (piece >> 4) * 32, col0 = (piece & 15) * 64; const int rs = row0 + (tid >> 4), c = col0 + (tid & 15) * 4;
        __syncthreads();
        sgemm_partial(A, lda, Bt, K, K, row0, col0, red, tid);
        __syncthreads();
        const f32x4 v = sgemm_reduce(red, tid);
        const f32x4 xv = *(const f32x4*)(xin_s + (size_t)rs * 1024 + c), gv = *(const f32x4*)(ga + (size_t)(4 + (rs >> 2)) * 6144 + c);
        *(f32x4*)(xout + (size_t)(NPR + rs) * 1024 + c) = xv + gv * v;
    }
}

__device__ __forceinline__ void grid_bar(unsigned* ctr, unsigned& epoch) {
    asm volatile("s_waitcnt vmcnt(0) lgkmcnt(0)" ::: "memory");
    __syncthreads();
    epoch += 1;
    if (otid() == 0) {
        __builtin_amdgcn_fence(__ATOMIC_RELEASE, "agent");
        asm volatile("s_waitcnt vmcnt(0) lgkmcnt(0)" ::: "memory");
        __hip_atomic_fetch_add(ctr, 1u, __ATOMIC_RELAXED, __HIP_MEMORY_SCOPE_AGENT);
        const unsigned target = epoch * gridDim.x;
        while (__hip_atomic_load(ctr, __ATOMIC_RELAXED, __HIP_MEMORY_SCOPE_AGENT) < target) __builtin_amdgcn_s_sleep(1);
        __builtin_amdgcn_fence(__ATOMIC_ACQUIRE, "agent");
        asm volatile("s_waitcnt vmcnt(0) lgkmcnt(0)" ::: "memory");
    }
    __syncthreads();
}

#ifndef PHMASK
#define PHMASK 0xFFFFFFFF
#endif
#define EN(x) ((PHMASK >> (x)) & 1)
#ifndef DRYM
#define DRYM 0
#endif
#ifndef DBL
#define DBL 0
#endif
#define REP(x) (((DBL >> (x)) & 1) ? 2 : 1)
constexpr int PH_PER_LAYER = 11, N_PHASES = 2 + 4 * PH_PER_LAYER + 1;

__global__ void __launch_bounds__(512, 2) mega_fwd(Params PK) {
    extern __shared__ __attribute__((aligned(16))) unsigned char lds_raw[];
    cg::grid_group grid = cg::this_grid();
    LAS unsigned char* ldsl = (LAS unsigned char*)lds_raw;
    unsigned epoch = 0;
    for (int ph = PK.ph_lo; ph < PK.ph_hi; ++ph) {
        Params P = PK;
        { unsigned char* w_ = P.ws; asm volatile("" : "+s"(w_)); P.ws = w_; float* o_ = P.out; asm volatile("" : "+s"(o_)); P.out = o_; }
        unsigned* barctr = (unsigned*)(P.ws + WS_BAR);
        bf16_t* proj = (bf16_t*)(P.ws + WS_PROJ);
        bf16_t* hbuf = (bf16_t*)(P.ws + WS_H);
        float* xbuf = P.out;
        float* mod = (float*)(P.ws + WS_MOD);
        if (ph == 0) { for (int rp = 0; rp < REP(0); ++rp) phase_convert(P, (float*)lds_raw); }
        else if (ph == 1) {
            Gemm g{(const bf16_t*)(P.ws + WS_CACT), (const bf16_t*)(P.ws + WS_WADA), 1024, 1024, 1024, 1, 96, 0, 0, 0, 0, 0};
            EpiMod E{mod, P.in[11]};
            for (int rp = 0; rp < REP(1); ++rp) gemm_phase<EpiMod, 1>(ldsl, g, E);
        }
        else if (ph == N_PHASES - 1) { phase_final_norm(xbuf, P.in[33]); }
        else {
            const int layer = (ph - 2) / PH_PER_LAYER, sp = (ph - 2) % PH_PER_LAYER;
            const float* modL = mod + (size_t)layer * NCOND * 6144;
            const float* xin_p = layer == 0 ? P.in[0] : xbuf; const float* xin_s = layer == 0 ? P.in[1] : xbuf + (size_t)NPR * 1024;
            if (sp == 0) { for (int rp = 0; rp < REP(16); ++rp) phase_norm(xin_p, xin_s, P.in[12] + layer * 1024, modL, 0, 1024, hbuf); }
            else if (sp == 1) {
                Gemm g{hbuf, (const bf16_t*)(P.ws + WS_WIN) + (size_t)layer * 13568 * 1024, 1024, 1024, 1024, 66, 53, 0, 0, 0, 0, 0};
                EpiProj E{proj};
                for (int rp = 0; rp < REP(2); ++rp) gemm_phase<EpiProj, 1>(ldsl, g, E);
            }
            else if (sp == 2) {
                for (int it = blockIdx.x; it < 3972 + 256; it += gridDim.x) {
                    if (it < 512) { for (int rp = 0; rp < REP(3); ++rp) ssd_pass1_item(P, layer, it, lds_raw); }
                    else if (it < 1024) { for (int rp = (DRYM & 1) ? 0 : 1; rp < 2; ++rp) attn_prompt_item(P, layer, it - 512, lds_raw, rp == 0 && P.ph_lo == 0); }
                    else if (it < 1536) { for (int rp = (DRYM & 2) ? 0 : 1; rp < 2; ++rp) attn_sample_item(P, layer, it - 1024, (float*)lds_raw, rp == 0 && P.ph_lo == 0); }
                    else if (it < 2560) { for (int rp = (DRYM & 4) ? 0 : 1; rp < 2; ++rp) gmlp_prompt_item(P, layer, it - 1536, lds_raw, rp == 0 && P.ph_lo == 0); }
                    else if (it < 2688) { if (EN(8)) gmlp_sample_item(P, layer, it - 2560, (float*)lds_raw); }
                    else if (it < 3840) { for (int rp = (DRYM & 8) ? 0 : 1; rp < 2; ++rp) shortconv_item(P, layer, it - 2688, rp == 0 && P.ph_lo == 0); }
                    else if (it < 3972) ssdconv_state_item(P, layer, it - 3840);
                    else ssd_item<2>(P, layer, it - 3972, (float*)lds_raw);
                }
            }
            else if (sp == 3) { phase_ssd_scan(P, layer); }
            else if (sp == 4) { for (int it = blockIdx.x; it < 512; it += gridDim.x) for (int rp = (DRYM & 16) ? 0 : 1; rp < 2; ++rp) ssd_pass3_item(P, layer, it, lds_raw, rp == 0 && P.ph_lo == 0); }
            else if (sp == 5) {
                Gemm g{proj, (const bf16_t*)(P.ws + WS_WBR) + (size_t)layer * 4 * 1048576, LDP, 1024, 1024, 64, 4, C_Z, C_BCX, C_Q, C_UV, (size_t)1048576};
                EpiBranch E{proj, (float*)(P.ws + WS_MSUM), hbuf};
                for (int rp = 0; rp < REP(11); ++rp) gemm_phase<EpiBranch, 4>(ldsl, g, E);
                for (int rp = 0; rp < REP(17); ++rp) sample_branch(P, layer, (float*)lds_raw);
            }
            else if (sp == 6) {
                Gemm g{hbuf, (const bf16_t*)(P.ws + WS_WO) + (size_t)layer * 1048576, 1024, 1024, 1024, 64, 4, 0, 0, 0, 0, 0};
                EpiResid E{xin_p, xin_s, xbuf, modL + 2048};
                if (EN(12)) gemm_phase<EpiResid, 1>(ldsl, g, E);
                sample_resid(P, hbuf + (size_t)NPR * 1024, 1024, (const bf16_t*)(P.ws + WS_WO) + (size_t)layer * 1048576, 1024, xin_s, xbuf, modL + 2048, (float*)lds_raw);
            }
            else if (sp == 7) { for (int rp = 0; rp < REP(16); ++rp) phase_norm(xbuf, xbuf + (size_t)NPR * 1024, P.in[28] + layer * 1024, modL, 3072, 4096, hbuf); }
            else if (sp == 8) {
                Gemm g{hbuf, (const bf16_t*)(P.ws + WS_WUP) + (size_t)layer * 5632 * 1024, 1024, 1024, 1024, 66, 22, 0, 0, 0, 0, 0};
                EpiUp E{proj};
                for (int rp = 0; rp < REP(13); ++rp) gemm_phase<EpiUp, 1>(ldsl, g, E);
            }
            else if (sp == 9) { for (int rp = 0; rp < REP(14); ++rp) phase_ffn_act(P, layer); }
            else {
                Gemm g{(const bf16_t*)(P.ws + WS_PROJ + UP_BYTES), (const bf16_t*)(P.ws + WS_WDN) + (size_t)layer * 1024 * 2816, 2816, 2816, 2816, 64, 4, 0, 0, 0, 0, 0};
                EpiResid E{xbuf, xbuf + (size_t)NPR * 1024, xbuf, modL + 5120};
                if (EN(15)) gemm_phase<EpiResid, 1>(ldsl, g, E);
                sample_resid(P, (const bf16_t*)(P.ws + WS_PROJ + UP_BYTES) + (size_t)NPR * 2816, 2816, (const bf16_t*)(P.ws + WS_WDN) + (size_t)layer * 1024 * 2816, 2816, xbuf + (size_t)NPR * 1024, xbuf, modL + 5120, (float*)lds_raw);
            }
        }
        if (ph + 1 < P.ph_hi) { if (ph == 0) grid.sync(); else grid_bar(barctr, epoch); }
    }
}

extern "C" void kernel_launch(void* const* d_in, const int* in_sizes, int n_in, void* d_out, int out_size, void* d_ws, size_t ws_size, hipStream_t stream) {
    static int grid_blocks = 0;
    if (grid_blocks == 0) {
        if (n_in != 34 || (size_t)out_size != O_END || ws_size < WS_END + 256) { fprintf(stderr, "kernel_launch: unexpected sizes n_in %d out %d ws %zu (need %zu)\n", n_in, out_size, ws_size, (size_t)WS_END); grid_blocks = -1; return; }
        int dev = 0, cus = 0, per_cu = 0;
        (void)hipGetDevice(&dev); (void)hipDeviceGetAttribute(&cus, hipDeviceAttributeMultiprocessorCount, dev);
        if (hipFuncSetAttribute((const void*)mega_fwd, hipFuncAttributeMaxDynamicSharedMemorySize, LDS_BYTES) != hipSuccess) { fprintf(stderr, "hipFuncSetAttribute failed\n"); grid_blocks = -1; return; }
        if (hipOccupancyMaxActiveBlocksPerMultiprocessor(&per_cu, (const void*)mega_fwd, 512, LDS_BYTES) != hipSuccess || per_cu < 1) per_cu = 1;
        grid_blocks = cus * 1;
    }
    if (grid_blocks < 0) return;
    Params p{};
    for (int i = 0; i < 34; ++i) p.in[i] = (const float*)d_in[i];
    p.out = (float*)d_out; p.ws = (unsigned char*)d_ws; p.ph_lo = 0; p.ph_hi = N_PHASES;
    (void)hipMemsetAsync((unsigned char*)d_ws + WS_BAR, 0, 256, stream);
    void* args[] = {&p};
    hipError_t e = hipLaunchCooperativeKernel((const void*)mega_fwd, dim3(grid_blocks), dim3(512), args, LDS_BYTES, stream);
    if (e != hipSuccess) fprintf(stderr, "cooperative launch failed: %s (grid %d)\n", hipGetErrorString(e), grid_blocks);
}
```

```cpp
#include <hip/hip_runtime.h>
#include <hip/hip_cooperative_groups.h>
#include <cstdio>
namespace cg = cooperative_groups;

typedef unsigned short bf16_t;
typedef short bf16x8 __attribute__((ext_vector_type(8)));
typedef float f32x4 __attribute__((ext_vector_type(4)));
typedef unsigned u32x4 __attribute__((ext_vector_type(4)));
typedef unsigned u32x2 __attribute__((ext_vector_type(2)));
#define LAS __attribute__((address_space(3)))

constexpr int NTOK = 16896, NPR = 16384;
constexpr int LDP = 13568;
constexpr int C_Z = 0, C_XBC = 1024, C_DTR = 2560, C_BCX = 2576, C_Q = 5648, C_K = 6672, C_V = 6928, C_UV = 7184, C_GATE = 9232, C_END = 13328;
constexpr int NCOND = 132;
constexpr float EPSF = 1e-6f;

constexpr size_t WS_WIN = 0;
constexpr size_t WS_WBR = WS_WIN + (size_t)4 * 13568 * 1024 * 2;
constexpr size_t WS_WO = WS_WBR + (size_t)16 * 1024 * 1024 * 2;
constexpr size_t WS_WUP = WS_WO + (size_t)4 * 1024 * 1024 * 2;
constexpr size_t WS_WDN = WS_WUP + (size_t)4 * 5632 * 1024 * 2;
constexpr size_t WS_WADA = WS_WDN + (size_t)4 * 1024 * 2816 * 2;
constexpr size_t WS_CACT = WS_WADA + (size_t)4 * 6144 * 1024 * 2;
constexpr size_t WS_MOD = WS_CACT + (size_t)256 * 1024 * 2;
constexpr size_t WS_H = WS_MOD + (size_t)4 * NCOND * 6144 * 4;
constexpr size_t WS_MSUM = WS_H + (size_t)NTOK * 1024 * 2;
constexpr size_t WS_PROJ = WS_MSUM + (size_t)NTOK * 1024 * 4;
constexpr size_t WS_END = WS_PROJ + (size_t)NTOK * LDP * 2;
constexpr size_t WS_BAR = WS_END;
constexpr size_t WS_SSDST = WS_WADA;
constexpr size_t WS_SSDDEC = WS_WADA + (size_t)4 * 32 * 16 * 4096 * 4;
constexpr size_t UP_BYTES = (size_t)NTOK * 5632 * 2;

constexpr size_t O_YP = 0, O_YS = 16777216, O_PSSM = O_YS + 524288, O_PSSDC = O_PSSM + 1048576, O_PSCC = O_PSSDC + 73728,
                 O_PK = O_PSCC + 32768, O_PV = O_PK + 524288, O_PFFC = O_PV + 524288, O_SSSM = O_PFFC + 180224,
                 O_SSSDC = O_SSSM + 33554432, O_SSCC = O_SSSDC + 2359296, O_SK = O_SSCC + 1048576, O_SV = O_SK + 16777216,
                 O_SFFC = O_SV + 16777216, O_SGMV = O_SFFC + 5767168, O_END = O_SGMV + 2097152;

struct Params { const float* in[34]; float* out; unsigned char* ws; int ph_lo, ph_hi; };

constexpr int LDS_BYTES = 155648;

__device__ __forceinline__ float bf2f(bf16_t v) { return __uint_as_float((unsigned)v << 16); }
__device__ __forceinline__ float bflo(unsigned v) { return __uint_as_float(v << 16); }
__device__ __forceinline__ float bfhi(unsigned v) { return __uint_as_float(v & 0xffff0000u); }
__device__ __forceinline__ unsigned pk2(float lo, float hi) { unsigned r; asm("v_cvt_pk_bf16_f32 %0, %1, %2" : "=v"(r) : "v"(lo), "v"(hi)); return r; }
__device__ __forceinline__ bf16_t f2bf(float f) { return (bf16_t)(pk2(f, 0.f) & 0xffffu); }
__device__ __forceinline__ float shx(float v, int o, int lane) { return __int_as_float(__builtin_amdgcn_ds_bpermute((lane ^ o) << 2, __float_as_int(v))); }
__device__ __forceinline__ float wave_sum(float v, int lane) {
#pragma unroll
    for (int o = 32; o > 0; o >>= 1) v += shx(v, o, lane);
    return v;
}
__device__ __forceinline__ int otid() { int t = threadIdx.x; asm volatile("" : "+v"(t)); return t; }
__device__ __forceinline__ float sigmoidf_(float x) { return __builtin_amdgcn_rcpf(1.f + __expf(-x)); }
__device__ __forceinline__ float siluf_(float x) { return x * __builtin_amdgcn_rcpf(1.f + __expf(-x)); }
__device__ __forceinline__ float geluf_(float x) { const float u = 0.7978845608f * (x + 0.044715f * x * x * x); return x / (1.f + __expf(-2.f * u)); }
__device__ __forceinline__ float softplusf_(float x) { return fmaxf(x, 0.f) + log1pf(__expf(-fabsf(x))); }
__device__ __forceinline__ float silu_fast(float x) { return x * __builtin_amdgcn_rcpf(1.f + __expf(-x)); }
__device__ __forceinline__ float sigmoid_fast(float x) { return __builtin_amdgcn_rcpf(1.f + __expf(-x)); }
__device__ __forceinline__ float gelu_fast(float x) { const float u = 0.7978845608f * (x + 0.044715f * x * x * x); return x * __builtin_amdgcn_rcpf(1.f + __expf(-2.f * u)); }
__device__ __forceinline__ int cond_row(int r) { return r < NPR ? (r >> 12) : 4 + ((r - NPR) >> 2); }
__device__ __forceinline__ int seq_start(int r) { return r < NPR ? (r & ~4095) : NPR + ((r - NPR) & ~3); }

constexpr int BM = 256, BK = 64, HALF = 128, HTB = HALF * BK * 2;
__device__ __forceinline__ int lds_byte(int r, int c) { const int st = (r >> 4) * 2 + (c >> 5), rr = r & 15, cc = c & 31, ob = rr * 64 + cc * 2; return st * 1024 + (ob ^ (((ob >> 9) & 1) << 5)); }
__device__ __forceinline__ void stage_rc(int b, int& R, int& C) { const int st = b / 1024, sb = b % 1024, swz = sb ^ (((sb >> 9) & 1) << 5); R = (st >> 1) * 16 + swz / 64; C = (st & 1) * 32 + (swz % 64) / 2; }
__device__ __forceinline__ int perm32(int rho) { const int n = rho >> 4, i = rho & 15; return 8 * (i >> 2) + 4 * n + (i & 3); }

struct Unit { int pm, pn, z; };
struct Gemm { const bf16_t* A; const bf16_t* Bt; int lda, ldb, K, nM, nN; int ao0, ao1, ao2, ao3; size_t zB; };
__device__ __forceinline__ int gemm_aofs(const Gemm& g, int z) { return z == 0 ? g.ao0 : (z == 1 ? g.ao1 : (z == 2 ? g.ao2 : g.ao3)); }

template <int ZN> __device__ __forceinline__ bool unit_next(const Gemm& g, int i, Unit& u) {
    const int tile = i / ZN; u.z = i - tile * ZN;
    const long L = (long)tile * gridDim.x + blockIdx.x; const int nwg = g.nM * g.nN; if (L >= nwg) return false;
    int wgid = (int)L; { const int q = nwg / 8, r = nwg % 8, xcd = wgid % 8, off = wgid / 8; wgid = (xcd < r ? xcd * (q + 1) : r * (q + 1) + (xcd - r) * q) + off; }
    const int nig = 8 * g.nN, gid = wgid / nig, fm = gid * 8, gsz = (g.nM - fm) < 8 ? (g.nM - fm) : 8;
    u.pm = fm + ((wgid % nig) % gsz); u.pn = (wgid % nig) / gsz; return true;
}

template <class Epi, int ZN>
__device__ __forceinline__ void gemm_phase(LAS unsigned char* lds, const Gemm g, const Epi& E) {
    const int tid = otid(), wid = __builtin_amdgcn_readfirstlane(tid >> 6), lane = tid & 63, wr = wid >> 2, wc = wid & 3, fr = lane & 15, fq = lane >> 4;
    const int K = g.K, nt = K / BK;
    unsigned voffA[2], voffB[2];
#pragma unroll
    for (int i = 0; i < 2; ++i) { int R, C; stage_rc(tid * 16 + i * 8192, R, C); const int Rb = Epi::PERM ? ((R & ~31) + perm32(R & 31)) : R;
        voffA[i] = (unsigned)(R * g.lda + C) * 2u; voffB[i] = (unsigned)(Rb * g.ldb + C) * 2u; }
    const size_t kstep = (size_t)(BK * 2);
    const size_t hstepA = (size_t)HALF * g.lda * 2, hstepB = (size_t)HALF * g.ldb * 2;
    const size_t tstepA = 2 * hstepA, tstepB = 2 * hstepB;
    const unsigned ldsw = (unsigned)wid * 1024u;
    const int aoff = lds_byte(wr * 64 + fr, fq * 8), boff = lds_byte(wc * 32 + fr, fq * 8);
#define PG8_SA(b, h) (((b) * 2 + (h)) * HTB)
#define PG8_SB(b, h) ((4 + (b) * 2 + (h)) * HTB)
#define PG8_STAGE(bufoff, gbase, voff) do { _Pragma("unroll") for (int _i = 0; _i < 2; ++_i) \
        __builtin_amdgcn_global_load_lds((const unsigned*)((const char*)(gbase) + (voff)[_i]), (LAS unsigned*)(lds + (bufoff) + ldsw + _i * 8192), 16, 0, 0); } while (0)
#define PG8_LDA(dst, b, h) do { _Pragma("unroll") for (int m = 0; m < 4; ++m) _Pragma("unroll") for (int k = 0; k < 2; ++k) dst[m][k] = *(const LAS bf16x8*)(lds + PG8_SA(b, h) + aoff + m * 2048 + k * 1024); } while (0)
#define PG8_LDB(dst, b, h) do { _Pragma("unroll") for (int n = 0; n < 2; ++n) _Pragma("unroll") for (int k = 0; k < 2; ++k) dst[n][k] = *(const LAS bf16x8*)(lds + PG8_SB(b, h) + boff + n * 2048 + k * 1024); } while (0)
#define PG8_MMA(ai, bj, At, Bt) do { __builtin_amdgcn_s_setprio(1); _Pragma("unroll") for (int m = 0; m < 4; ++m) _Pragma("unroll") for (int n = 0; n < 2; ++n) _Pragma("unroll") for (int k = 0; k < 2; ++k) \
        acc[ai][bj][m][n] = __builtin_amdgcn_mfma_f32_16x16x32_bf16(Bt[n][k], At[m][k], acc[ai][bj][m][n], 0, 0, 0); __builtin_amdgcn_s_setprio(0); } while (0)
#define PG8_WAIT_V(n) asm volatile("s_waitcnt vmcnt(" #n ")" ::: "memory")
#define PG8_WAIT_L(n) asm volatile("s_waitcnt lgkmcnt(" #n ")" ::: "memory")
#define PG8_BAR __builtin_amdgcn_s_barrier()
#define PG8_SCHED __builtin_amdgcn_sched_barrier(0)
    Unit cur, nxt; int ui = 0;
    if (!unit_next<ZN>(g, 0, cur)) return;
    f32x4 acc[2][2][4][2];
#pragma unroll
    for (int a = 0; a < 2; ++a)
#pragma unroll
        for (int b = 0; b < 2; ++b)
#pragma unroll
            for (int m = 0; m < 4; ++m)
#pragma unroll
                for (int n = 0; n < 2; ++n) acc[a][b][m][n] = (f32x4){0.f, 0.f, 0.f, 0.f};
    bf16x8 At[4][2], B0[2][2], B1[2][2];
    const char* cA = (const char*)g.A + (size_t)cur.pm * tstepA + (size_t)gemm_aofs(g, cur.z) * 2;
    const char* cB = (const char*)g.Bt + (size_t)cur.pn * tstepB + (size_t)cur.z * g.zB * 2;
    PG8_WAIT_V(0);
    PG8_STAGE(PG8_SB(0, 0), cB, voffB); PG8_STAGE(PG8_SA(0, 0), cA, voffA); PG8_STAGE(PG8_SB(0, 1), cB + hstepB, voffB); PG8_STAGE(PG8_SA(0, 1), cA + hstepA, voffA);
    if (wr == 1) PG8_BAR;
    PG8_WAIT_V(4); PG8_BAR;
    PG8_STAGE(PG8_SB(1, 0), cB + kstep, voffB); PG8_STAGE(PG8_SA(1, 0), cA + kstep, voffA); PG8_STAGE(PG8_SB(1, 1), cB + hstepB + kstep, voffB);
    PG8_WAIT_V(6); PG8_BAR;
    for (;;) {
        const bool has_next = unit_next<ZN>(g, ui + 1, nxt);
        const char* nA = has_next ? (const char*)g.A + (size_t)nxt.pm * tstepA + (size_t)gemm_aofs(g, nxt.z) * 2 : cA;
        const char* nB = has_next ? (const char*)g.Bt + (size_t)nxt.pn * tstepB + (size_t)nxt.z * g.zB * 2 : cB;
        for (int t = 0; t < nt; t += 2) {
            const bool last = (t == nt - 2);
            const char* a1 = cA + (size_t)(t + 1) * kstep;
            const char* a2 = last ? nA : cA + (size_t)(t + 2) * kstep; const char* b2 = last ? nB : cB + (size_t)(t + 2) * kstep;
            const char* a3 = a2 + kstep; const char* b3 = b2 + kstep;
            PG8_LDB(B0, 0, 0); PG8_SCHED; PG8_LDA(At, 0, 0); PG8_STAGE(PG8_SA(1, 1), a1 + hstepA, voffA);
            PG8_WAIT_L(8); PG8_BAR; PG8_WAIT_L(0); PG8_MMA(0, 0, At, B0); PG8_BAR; PG8_SCHED;
            PG8_LDB(B1, 0, 1); PG8_STAGE(PG8_SB(0, 0), b2, voffB);
            PG8_BAR; PG8_WAIT_L(0); PG8_MMA(0, 1, At, B1); PG8_BAR;
            PG8_LDA(At, 0, 1); PG8_STAGE(PG8_SA(0, 0), a2, voffA);
            PG8_BAR; PG8_WAIT_L(0); PG8_MMA(1, 0, At, B0); PG8_BAR; PG8_SCHED;
            PG8_STAGE(PG8_SB(0, 1), b2 + hstepB, voffB);
            PG8_WAIT_V(6); PG8_BAR; PG8_MMA(1, 1, At, B1); PG8_BAR;
            PG8_LDB(B0, 1, 0); PG8_SCHED; PG8_LDA(At, 1, 0); PG8_STAGE(PG8_SA(0, 1), a2 + hstepA, voffA);
            PG8_WAIT_L(8); PG8_BAR; PG8_WAIT_L(0); PG8_MMA(0, 0, At, B0); PG8_BAR; PG8_SCHED;
            PG8_LDB(B1, 1, 1); PG8_STAGE(PG8_SB(1, 0), b3, voffB);
            PG8_BAR; PG8_WAIT_L(0); PG8_MMA(0, 1, At, B1); PG8_BAR;
            PG8_LDA(At, 1, 1); PG8_STAGE(PG8_SA(1, 0), a3, voffA);
            PG8_BAR; PG8_WAIT_L(0); PG8_MMA(1, 0, At, B0); PG8_BAR; PG8_SCHED;
            PG8_STAGE(PG8_SB(1, 1), b3 + hstepB, voffB);
            PG8_WAIT_V(6); PG8_BAR; PG8_MMA(1, 1, At, B1); PG8_BAR;
        }
        E(acc, cur, wr, wc, fr, fq);
        if (!has_next) break;
#pragma unroll
        for (int a = 0; a < 2; ++a)
#pragma unroll
            for (int b = 0; b < 2; ++b)
#pragma unroll
                for (int m = 0; m < 4; ++m)
#pragma unroll
                    for (int n = 0; n < 2; ++n) acc[a][b][m][n] = (f32x4){0.f, 0.f, 0.f, 0.f};
        cur = nxt; cA = nA; cB = nB; ++ui;
    }
    PG8_WAIT_V(0);
    if (wr == 0) PG8_BAR;
    PG8_BAR;
#undef PG8_SA
#undef PG8_SB
#undef PG8_STAGE
#undef PG8_LDA
#undef PG8_LDB
#undef PG8_MMA
#undef PG8_WAIT_V
#undef PG8_WAIT_L
#undef PG8_BAR
#undef PG8_SCHED
}

struct EpiMod {
    static constexpr bool PERM = false;
    float* mod; const float* bada;
    __device__ __forceinline__ void operator()(const f32x4 (&acc)[2][2][4][2], const Unit& u, int wr, int wc, int fr, int fq) const {
        f32x4 bv[2][2];
#pragma unroll
        for (int bj = 0; bj < 2; ++bj)
#pragma unroll
            for (int n = 0; n < 2; ++n) bv[bj][n] = *(const f32x4*)(bada + u.pn * BM + bj * HALF + wc * 32 + n * 16 + fq * 4);
#pragma unroll
        for (int ai = 0; ai < 2; ++ai)
#pragma unroll
            for (int m = 0; m < 4; ++m) { const int r = u.pm * BM + ai * HALF + wr * 64 + m * 16 + fr; if (r >= NCOND) continue;
#pragma unroll
                for (int bj = 0; bj < 2; ++bj)
#pragma unroll
                    for (int n = 0; n < 2; ++n) { const int c = u.pn * BM + bj * HALF + wc * 32 + n * 16 + fq * 4; const int layer = c / 6144, cc = c - layer * 6144;
                        *(f32x4*)(mod + ((size_t)(layer * NCOND + r)) * 6144 + cc) = acc[ai][bj][m][n] + bv[bj][n]; } }
    }
};
struct EpiProj {
    static constexpr bool PERM = true;
    bf16_t* O;
    __device__ __forceinline__ void operator()(const f32x4 (&acc)[2][2][4][2], const Unit& u, int wr, int wc, int fr, int fq) const {
#pragma unroll
        for (int bj = 0; bj < 2; ++bj) { const int c = u.pn * BM + bj * HALF + wc * 32 + fq * 8; const int mode = (c >= C_UV + 1024 && c < C_GATE) ? 1 : 0;
#pragma unroll
            for (int ai = 0; ai < 2; ++ai)
#pragma unroll
                for (int m = 0; m < 4; ++m) { const int r = u.pm * BM + ai * HALF + wr * 64 + m * 16 + fr;
                    float v[8];
#pragma unroll
                    for (int i = 0; i < 8; ++i) { float x = acc[ai][bj][m][i >> 2][i & 3]; v[i] = (mode == 1 ? gelu_fast(x) : x); }
                    u32x4 o; o[0] = pk2(v[0], v[1]); o[1] = pk2(v[2], v[3]); o[2] = pk2(v[4], v[5]); o[3] = pk2(v[6], v[7]);
                    *(u32x4*)(O + (size_t)r * LDP + c) = o; } }
    }
};
struct EpiUp {
    static constexpr bool PERM = true;
    bf16_t* O;
    __device__ __forceinline__ void operator()(const f32x4 (&acc)[2][2][4][2], const Unit& u, int wr, int wc, int fr, int fq) const {
#pragma unroll
        for (int bj = 0; bj < 2; ++bj) { const int c = u.pn * BM + bj * HALF + wc * 32 + fq * 8;
#pragma unroll
            for (int ai = 0; ai < 2; ++ai)
#pragma unroll
                for (int m = 0; m < 4; ++m) { const int r = u.pm * BM + ai * HALF + wr * 64 + m * 16 + fr;
                    const f32x4 a = acc[ai][bj][m][0], b = acc[ai][bj][m][1];
                    u32x4 o; o[0] = pk2(a[0], a[1]); o[1] = pk2(a[2], a[3]); o[2] = pk2(b[0], b[1]); o[3] = pk2(b[2], b[3]);
                    *(u32x4*)(O + (size_t)r * 5632 + c) = o; } }
    }
};
struct EpiBranch {
    static constexpr bool PERM = true;
    const bf16_t* proj; float* msum; bf16_t* merged;
    __device__ __forceinline__ void operator()(const f32x4 (&acc)[2][2][4][2], const Unit& u, int wr, int wc, int fr, int fq) const {
        const int z = u.z;
#pragma unroll
        for (int bj = 0; bj < 2; ++bj) { const int c = u.pn * BM + bj * HALF + wc * 32 + fq * 8;
#pragma unroll
            for (int ai = 0; ai < 2; ++ai) {
                u32x4 gt[4], pv[4];
#pragma unroll
                for (int m = 0; m < 4; ++m) { const int r = u.pm * BM + ai * HALF + wr * 64 + m * 16 + fr;
                    gt[m] = *(const u32x4*)(proj + (size_t)r * LDP + C_GATE + z * 1024 + c);
                    pv[m] = (u32x4){0u, 0u, 0u, 0u};
                    if (z > 0) pv[m] = *(const u32x4*)(merged + (size_t)r * 1024 + c); }
#pragma unroll
                for (int m = 0; m < 4; ++m) { const int r = u.pm * BM + ai * HALF + wr * 64 + m * 16 + fr;
                    const f32x4 a = acc[ai][bj][m][0], b = acc[ai][bj][m][1]; const u32x4 gv = gt[m], p = pv[m];
                    u32x4 o;
                    o[0] = pk2(bflo(p[0]) + sigmoid_fast(bflo(gv[0])) * a[0], bfhi(p[0]) + sigmoid_fast(bfhi(gv[0])) * a[1]); o[1] = pk2(bflo(p[1]) + sigmoid_fast(bflo(gv[1])) * a[2], bfhi(p[1]) + sigmoid_fast(bfhi(gv[1])) * a[3]);
                    o[2] = pk2(bflo(p[2]) + sigmoid_fast(bflo(gv[2])) * b[0], bfhi(p[2]) + sigmoid_fast(bfhi(gv[2])) * b[1]); o[3] = pk2(bflo(p[3]) + sigmoid_fast(bflo(gv[3])) * b[2], bfhi(p[3]) + sigmoid_fast(bfhi(gv[3])) * b[3]);
                    *(u32x4*)(merged + (size_t)r * 1024 + c) = o; } } }
    }
};
struct EpiResid {
    static constexpr bool PERM = false;
    const float* xin_p; const float* xin_s; float* xout; const float* ga;
    __device__ __forceinline__ void operator()(const f32x4 (&acc)[2][2][4][2], const Unit& u, int wr, int wc, int fr, int fq) const {
        const float* gr = ga + (size_t)(u.pm >> 4) * 6144;
        f32x4 gv[2][2];
#pragma unroll
        for (int bj = 0; bj < 2; ++bj)
#pragma unroll
            for (int n = 0; n < 2; ++n) gv[bj][n] = *(const f32x4*)(gr + u.pn * BM + bj * HALF + wc * 32 + n * 16 + fq * 4);
#pragma unroll
        for (int am = 0; am < 4; ++am) { const int ai = am >> 1, m0 = (am & 1) * 2;
            f32x4 xv[2][2][2];
#pragma unroll
            for (int mm = 0; mm < 2; ++mm) { const int r = u.pm * BM + ai * HALF + wr * 64 + (m0 + mm) * 16 + fr;
#pragma unroll
                for (int bj = 0; bj < 2; ++bj)
#pragma unroll
                    for (int n = 0; n < 2; ++n) xv[mm][bj][n] = *(const f32x4*)(xin_p + (size_t)r * 1024 + u.pn * BM + bj * HALF + wc * 32 + n * 16 + fq * 4); }
#pragma unroll
            for (int mm = 0; mm < 2; ++mm) { const int r = u.pm * BM + ai * HALF + wr * 64 + (m0 + mm) * 16 + fr;
#pragma unroll
                for (int bj = 0; bj < 2; ++bj)
#pragma unroll
                    for (int n = 0; n < 2; ++n) *(f32x4*)(xout + (size_t)r * 1024 + u.pn * BM + bj * HALF + wc * 32 + n * 16 + fq * 4) = xv[mm][bj][n] + gv[bj][n] * acc[ai][bj][m0 + mm][n]; } }
    }
};

struct CTile { const float* src; bf16_t* dst; int K, N, k0, n0; };
__device__ __forceinline__ CTile conv_decode(const Params& P, int t) {
    constexpr int T_IN = 3392, T_BR = 1024, T_O = 256, T_UP = 1408, T_DN = 704, T_ADA = 1536, T_L = T_IN + T_BR + T_O + T_UP + T_DN + T_ADA;
    const int layer = t / T_L; int r = t - layer * T_L; CTile c;
    if (r < T_IN) { c.src = P.in[13] + (size_t)layer * 1024 * 13328; c.dst = (bf16_t*)(P.ws + WS_WIN) + (size_t)layer * 13568 * 1024; c.K = 1024; c.N = 13328; c.k0 = (r / 212) * 64; c.n0 = (r % 212) * 64; return c; }
    r -= T_IN;
    if (r < T_BR) { const int br = r >> 8, q = r & 255; c.src = P.in[26] + (size_t)(layer * 4 + br) * 1048576; c.dst = (bf16_t*)(P.ws + WS_WBR) + (size_t)(layer * 4 + br) * 1048576; c.K = 1024; c.N = 1024; c.k0 = (q >> 4) * 64; c.n0 = (q & 15) * 64; return c; }
    r -= T_BR;
    if (r < T_O) { c.src = P.in[27] + (size_t)layer * 1048576; c.dst = (bf16_t*)(P.ws + WS_WO) + (size_t)layer * 1048576; c.K = 1024; c.N = 1024; c.k0 = (r >> 4) * 64; c.n0 = (r & 15) * 64; return c; }
    r -= T_O;
    if (r < T_UP) { c.src = P.in[29] + (size_t)layer * 1024 * 5632; c.dst = (bf16_t*)(P.ws + WS_WUP) + (size_t)layer * 5632 * 1024; c.K = 1024; c.N = 5632; c.k0 = (r / 88) * 64; c.n0 = (r % 88) * 64; return c; }
    r -= T_UP;
    if (r < T_DN) { c.src = P.in[32] + (size_t)layer * 2816 * 1024; c.dst = (bf16_t*)(P.ws + WS_WDN) + (size_t)layer * 1024 * 2816; c.K = 2816; c.N = 1024; c.k0 = (r >> 4) * 64; c.n0 = (r & 15) * 64; return c; }
    r -= T_DN;
    c.src = P.in[10] + (size_t)layer * 1024 * 6144; c.dst = (bf16_t*)(P.ws + WS_WADA) + (size_t)layer * 6144 * 1024; c.K = 1024; c.N = 6144; c.k0 = (r / 96) * 64; c.n0 = (r % 96) * 64; return c;
}
__device__ __forceinline__ void phase_convert(const Params& P, float* T) {
    constexpr int NT = 4 * 8320;
    const int tid = otid();
    int t = blockIdx.x;
    CTile cur = conv_decode(P, t < NT ? t : 0);
    float v[8], nv[8];
#pragma unroll
    for (int e = 0; e < 8; ++e) { const int idx = tid + e * 512, k = idx >> 6, n = idx & 63; v[e] = (t < NT && cur.n0 + n < cur.N) ? cur.src[(size_t)(cur.k0 + k) * cur.N + cur.n0 + n] : 0.f; }
    for (; t < NT; t += gridDim.x) {
        const int tn = t + gridDim.x; const bool hn = tn < NT; const CTile nxt = conv_decode(P, hn ? tn : 0);
#pragma unroll
        for (int e = 0; e < 8; ++e) { const int idx = tid + e * 512, k = idx >> 6, n = idx & 63; nv[e] = (hn && nxt.n0 + n < nxt.N) ? nxt.src[(size_t)(nxt.k0 + k) * nxt.N + nxt.n0 + n] : 0.f; }
#pragma unroll
        for (int e = 0; e < 8; ++e) { const int idx = tid + e * 512, k = idx >> 6, n = idx & 63; T[k * 65 + n] = v[e]; }
        __syncthreads();
        { const int n = tid >> 3, kc = (tid & 7) * 8; float x[8];
#pragma unroll
          for (int j = 0; j < 8; ++j) x[j] = T[(kc + j) * 65 + n];
          u32x4 o; o[0] = pk2(x[0], x[1]); o[1] = pk2(x[2], x[3]); o[2] = pk2(x[4], x[5]); o[3] = pk2(x[6], x[7]);
          *(u32x4*)(cur.dst + (size_t)(cur.n0 + n) * cur.K + cur.k0 + kc) = o; }
        __syncthreads();
#pragma unroll
        for (int e = 0; e < 8; ++e) v[e] = nv[e];
        cur = nxt;
    }
    bf16_t* cact = (bf16_t*)(P.ws + WS_CACT);
    for (int i = blockIdx.x * 512 + otid(); i < 256 * 1024; i += gridDim.x * 512) {
        const int r = i >> 10, c = i & 1023; float v = 0.f;
        if (r < 4) v = siluf_(P.in[2][r * 1024 + c]); else if (r < NCOND) v = siluf_(P.in[3][(r - 4) * 1024 + c]);
        cact[i] = f2bf(v);
    }
}

__device__ __forceinline__ void phase_norm(const float* xp, const float* xs, const float* g, const float* modL, int shofs, int scofs, bf16_t* hout) {
    const int tid = otid(); const int w = tid >> 6, lane = tid & 63;
    for (int r = blockIdx.x * 8 + w; r < NTOK; r += gridDim.x * 8) {
        const float* x = r < NPR ? xp + (size_t)r * 1024 : xs + (size_t)(r - NPR) * 1024;
        const float* mr = modL + (size_t)cond_row(r) * 6144;
        f32x4 v[4]; float ss = 0.f;
#pragma unroll
        for (int i = 0; i < 4; ++i) { v[i] = *(const f32x4*)(x + i * 256 + lane * 4); ss += v[i][0] * v[i][0] + v[i][1] * v[i][1] + v[i][2] * v[i][2] + v[i][3] * v[i][3]; }
        ss = wave_sum(ss, lane); const float rs = rsqrtf(ss * (1.f / 1024.f) + EPSF);
#pragma unroll
        for (int i = 0; i < 4; ++i) { const int c = i * 256 + lane * 4;
            const f32x4 gv = *(const f32x4*)(g + c), sc = *(const f32x4*)(mr + scofs + c), sh = *(const f32x4*)(mr + shofs + c);
            f32x4 o = v[i] * rs * gv * (sc + 1.f) + sh;
            u32x2 pk; pk[0] = pk2(o[0], o[1]); pk[1] = pk2(o[2], o[3]);
            *(u32x2*)(hout + (size_t)r * 1024 + c) = pk; }
    }
}
__device__ __forceinline__ void phase_final_norm(float* x, const float* g) {
    const int tid = otid(); const int w = tid >> 6, lane = tid & 63;
    for (int r = blockIdx.x * 8 + w; r < NTOK; r += gridDim.x * 8) {
        float* xr = x + (size_t)r * 1024; f32x4 v[4]; float ss = 0.f;
#pragma unroll
        for (int i = 0; i < 4; ++i) { v[i] = *(const f32x4*)(xr + i * 256 + lane * 4); ss += v[i][0] * v[i][0] + v[i][1] * v[i][1] + v[i][2] * v[i][2] + v[i][3] * v[i][3]; }
        ss = wave_sum(ss, lane); const float rs = rsqrtf(ss * (1.f / 1024.f) + EPSF);
#pragma unroll
        for (int i = 0; i < 4; ++i) { const int c = i * 256 + lane * 4; const f32x4 gv = *(const f32x4*)(g + c); *(f32x4*)(xr + c) = v[i] * rs * gv; }
    }
}

template <int MODE>
__device__ __forceinline__ void ssd_item(const Params& P, int layer, int item, float* L) {
    const int tid = otid(), w = tid >> 6, lane = tid & 63;
    bf16_t* proj = (bf16_t*)(P.ws + WS_PROJ);
    float* states = (float*)(P.ws + WS_SSDST); float* decs = (float*)(P.ws + WS_SSDDEC);
    int r0, nsteps, half, seq0, b = 0, c = 0, sb = 0;
    if (MODE == 2) { sb = item >> 1; half = item & 1; r0 = NPR + sb * 4; nsteps = 4; seq0 = r0; }
    else { b = item >> 6; c = (item >> 1) & 31; half = item & 1; r0 = b * 4096 + c * 128; nsteps = 128; seq0 = b * 4096; }
    float* XS = L; float* ZS = XS + 16 * 512; float* BS = ZS + 16 * 512; float* CS = BS + 16 * 128; float* DTS = CS + 16 * 128; float* DAS = DTS + 128; float* SSQ = DAS + 128;
    const float* cw = P.in[14] + (size_t)layer * 4 * 1536; const float* cb = P.in[15] + (size_t)layer * 1536;
    const float* prev = P.in[5] + ((size_t)(layer * 128 + sb)) * 3 * 1536;
    const int hd = half * 8 + w, gl = w >> 2;
    float h[64];
    if (MODE == 0) {
#pragma unroll
        for (int n = 0; n < 64; ++n) h[n] = 0.f;
    } else {
        const float* s0p = (MODE == 1) ? states + ((size_t)((b * 32 + c) * 16 + hd)) * 4096 + lane * 64
                                       : P.in[4] + ((size_t)((layer * 128 + sb) * 16 + hd)) * 4096 + lane * 64;
#pragma unroll
        for (int n4 = 0; n4 < 16; ++n4) { const f32x4 v = *(const f32x4*)(s0p + n4 * 4); h[n4 * 4] = v[0]; h[n4 * 4 + 1] = v[1]; h[n4 * 4 + 2] = v[2]; h[n4 * 4 + 3] = v[3]; }
    }
    const float Dh = P.in[18][layer * 16 + hd];
    float decp = 1.f;
    for (int s0 = 0; s0 < nsteps; s0 += 16) {
        const int ns = (nsteps - s0) < 16 ? (nsteps - s0) : 16;
        __syncthreads();
        for (int idx = tid; idx < ns * 768; idx += 512) {
            const int t = idx / 768, ch = idx - t * 768;
            int cx;
            if (ch < 512) cx = half * 512 + ch; else if (ch < 640) cx = 1024 + half * 128 + (ch - 512); else cx = 1280 + half * 128 + (ch - 640);
            float a = cb[cx];
#pragma unroll
            for (int k = 0; k < 4; ++k) { const int step = s0 + t - 3 + k, rr = r0 + step; float raw;
                if (rr >= seq0) raw = bf2f(proj[(size_t)rr * LDP + C_XBC + cx]);
                else raw = (MODE == 2) ? prev[(3 + step) * 1536 + cx] : 0.f;
                a += cw[k * 1536 + cx] * raw; }
            a = siluf_(a);
            if (ch < 512) { XS[t * 512 + ch] = a; if (MODE != 0) ZS[t * 512 + ch] = bf2f(proj[(size_t)(r0 + s0 + t) * LDP + C_Z + cx]); }
            else if (ch < 640) BS[t * 128 + ch - 512] = a; else CS[t * 128 + ch - 640] = a;
        }
        if (tid < ns * 8) { const int t = tid >> 3, ww = tid & 7, hh = half * 8 + ww;
            const float dt = softplusf_(bf2f(proj[(size_t)(r0 + s0 + t) * LDP + C_DTR + hh]) + P.in[16][layer * 16 + hh]);
            DTS[t * 8 + ww] = dt; DAS[t * 8 + ww] = __expf(-dt * __expf(P.in[17][layer * 16 + hh])); }
        __syncthreads();
        for (int t = 0; t < ns; ++t) {
            const float a = DAS[t * 8 + w], dt = DTS[t * 8 + w], xv = XS[t * 512 + w * 64 + lane], xd = xv * dt; decp *= a;
            const f32x4* B4 = (const f32x4*)(BS + t * 128 + gl * 64);
#pragma unroll
            for (int n4 = 0; n4 < 16; ++n4) { const f32x4 bv = B4[n4];
                h[n4 * 4] = a * h[n4 * 4] + xd * bv[0]; h[n4 * 4 + 1] = a * h[n4 * 4 + 1] + xd * bv[1]; h[n4 * 4 + 2] = a * h[n4 * 4 + 2] + xd * bv[2]; h[n4 * 4 + 3] = a * h[n4 * 4 + 3] + xd * bv[3]; }
            if (MODE != 0) {
                const f32x4* C4 = (const f32x4*)(CS + t * 128 + gl * 64); float y0 = 0.f, y1 = 0.f;
#pragma unroll
                for (int n4 = 0; n4 < 16; ++n4) { const f32x4 cv = C4[n4]; y0 += h[n4 * 4] * cv[0] + h[n4 * 4 + 2] * cv[2]; y1 += h[n4 * 4 + 1] * cv[1] + h[n4 * 4 + 3] * cv[3]; }
                float y = y0 + y1 + Dh * xv; y *= siluf_(ZS[t * 512 + w * 64 + lane]);
                const float sq = wave_sum(y * y, lane); if (lane == 0) SSQ[(s0 + t) * 8 + w] = sq;
                proj[(size_t)(r0 + s0 + t) * LDP + C_Z + hd * 64 + lane] = f2bf(y);
            }
        }
    }
    if (MODE == 0) {
        float* sp = states + ((size_t)((b * 32 + c) * 16 + hd)) * 4096 + lane * 64;
#pragma unroll
        for (int n4 = 0; n4 < 16; ++n4) *(f32x4*)(sp + n4 * 4) = (f32x4){h[n4 * 4], h[n4 * 4 + 1], h[n4 * 4 + 2], h[n4 * 4 + 3]};
        if (lane == 0) decs[(b * 32 + c) * 16 + hd] = decp;
    }
    if (MODE == 2) {
        float* sp = P.out + O_SSSM + ((size_t)((layer * 128 + sb) * 16 + hd)) * 4096 + lane * 64;
#pragma unroll
        for (int n4 = 0; n4 < 16; ++n4) *(f32x4*)(sp + n4 * 4) = (f32x4){h[n4 * 4], h[n4 * 4 + 1], h[n4 * 4 + 2], h[n4 * 4 + 3]};
    }
    if (MODE != 0) {
        __syncthreads();
        const float ng = P.in[19][layer * 1024 + hd * 64 + lane];
        for (int t = 0; t < nsteps; ++t) {
            const float tot = SSQ[t * 8 + gl * 4] + SSQ[t * 8 + gl * 4 + 1] + SSQ[t * 8 + gl * 4 + 2] + SSQ[t * 8 + gl * 4 + 3];
            const float sc = rsqrtf(tot * (1.f / 256.f) + EPSF) * ng;
            bf16_t* ap = proj + (size_t)(r0 + t) * LDP + C_Z + hd * 64 + lane; *ap = f2bf(bf2f(*ap) * sc);
        }
    }
}

__device__ __forceinline__ int xt_idx(int row, int t) { return row * 136 + ((((t >> 3) ^ ((row >> 3) & 15)) << 3) | (t & 7)); }
__device__ __forceinline__ void ssd_stage_dt(const Params& P, int layer, const bf16_t* proj, size_t r0, int g, float* DT, float* ACS, int tid) {
    { const int hh = tid >> 7, t = tid & 127, hd = g * 4 + hh;
      const float dt = softplusf_(bf2f(proj[(r0 + t) * LDP + C_DTR + hd]) + P.in[16][layer * 16 + hd]);
      DT[hh * 128 + t] = dt; ACS[hh * 128 + t] = -dt * __expf(P.in[17][layer * 16 + hd]); }
    __syncthreads();
    if (tid < 256) { const int hh = tid >> 6, l = tid & 63; const float a0 = ACS[hh * 128 + 2 * l], a1 = ACS[hh * 128 + 2 * l + 1]; float sum = a0 + a1;
#pragma unroll
        for (int o = 1; o < 64; o <<= 1) { const float v = __int_as_float(__builtin_amdgcn_ds_bpermute(((l - o) & 63) << 2, __float_as_int(sum))); if (l >= o) sum += v; }
        ACS[hh * 128 + 2 * l] = sum - a1; ACS[hh * 128 + 2 * l + 1] = sum; }
    __syncthreads();
}
template <int PASS>
__device__ __forceinline__ void ssd_stage_conv(const Params& P, int layer, const bf16_t* proj, size_t r0, bool first, int g, const float* DT, const float* ACS, bf16_t* XT4, bf16_t* Bx, bf16_t* Cs, int tid) {
    const int slot = tid & 63, seg = tid >> 6;
    if (slot < (PASS ? 48 : 40)) {
        int cx; if (slot < 32) cx = g * 256 + slot * 8; else if (slot < 40) cx = 1024 + g * 64 + (slot - 32) * 8; else cx = 1280 + g * 64 + (slot - 40) * 8;
        const float* cw = P.in[14] + (size_t)layer * 4 * 1536 + cx; const float* cb = P.in[15] + (size_t)layer * 1536 + cx;
        float wt[4][8], bb[8], win[3][8];
#pragma unroll
        for (int k = 0; k < 4; ++k) { const f32x4 a = *(const f32x4*)(cw + k * 1536), c = *(const f32x4*)(cw + k * 1536 + 4);
#pragma unroll
            for (int i = 0; i < 4; ++i) { wt[k][i] = a[i]; wt[k][4 + i] = c[i]; } }
        { const f32x4 a = *(const f32x4*)cb, c = *(const f32x4*)(cb + 4);
#pragma unroll
          for (int i = 0; i < 4; ++i) { bb[i] = a[i]; bb[4 + i] = c[i]; } }
        const int t0 = seg * 16;
#pragma unroll
        for (int k = 0; k < 3; ++k) { u32x4 raw = (u32x4){0u, 0u, 0u, 0u};
            if (!(first && seg == 0)) raw = *(const u32x4*)(proj + (r0 + t0 - 3 + k) * LDP + C_XBC + cx);
#pragma unroll
            for (int i = 0; i < 4; ++i) { win[k][2 * i] = bflo(raw[i]); win[k][2 * i + 1] = bfhi(raw[i]); } }
        u32x4 cur4[4], nxt4[4];
#pragma unroll
        for (int q = 0; q < 4; ++q) { cur4[q] = *(const u32x4*)(proj + (r0 + t0 + q) * LDP + C_XBC + cx); nxt4[q] = cur4[q]; }
        for (int gq = 0; gq < 4; ++gq) {
            if (gq < 3) {
#pragma unroll
                for (int q = 0; q < 4; ++q) nxt4[q] = *(const u32x4*)(proj + (r0 + t0 + gq * 4 + 4 + q) * LDP + C_XBC + cx); }
#pragma unroll
            for (int q = 0; q < 4; ++q) {
                const int t = t0 + gq * 4 + q; const u32x4 raw = cur4[q];
                float cur[8], o[8];
#pragma unroll
                for (int i = 0; i < 4; ++i) { cur[2 * i] = bflo(raw[i]); cur[2 * i + 1] = bfhi(raw[i]); }
#pragma unroll
                for (int i = 0; i < 8; ++i) { o[i] = siluf_(bb[i] + wt[0][i] * win[0][i] + wt[1][i] * win[1][i] + wt[2][i] * win[2][i] + wt[3][i] * cur[i]); win[0][i] = win[1][i]; win[1][i] = win[2][i]; win[2][i] = cur[i]; }
                if (slot < 32) { const int hh = slot >> 3, p0 = (slot & 7) * 8; float sc = DT[hh * 128 + t]; if (PASS == 0) sc *= __expf(ACS[hh * 128 + 127] - ACS[hh * 128 + t]);
#pragma unroll
                    for (int i = 0; i < 8; ++i) XT4[xt_idx(hh * 64 + p0 + i, t)] = f2bf(o[i] * sc); }
                else if (slot < 40) { const int n0 = (slot - 32) * 8;
                    if (PASS == 0) {
#pragma unroll
                        for (int i = 0; i < 8; ++i) Bx[xt_idx(n0 + i, t)] = f2bf(o[i]); }
                    else { u32x4 pk; pk[0] = pk2(o[0], o[1]); pk[1] = pk2(o[2], o[3]); pk[2] = pk2(o[4], o[5]); pk[3] = pk2(o[6], o[7]); *(u32x4*)(Bx + t * 72 + n0) = pk; } }
                else { const int n0 = (slot - 40) * 8; u32x4 pk; pk[0] = pk2(o[0], o[1]); pk[1] = pk2(o[2], o[3]); pk[2] = pk2(o[4], o[5]); pk[3] = pk2(o[6], o[7]); *(u32x4*)(Cs + t * 72 + n0) = pk; }
            }
#pragma unroll
            for (int q = 0; q < 4; ++q) cur4[q] = nxt4[q];
        }
    }
}
__device__ __forceinline__ void ssd_pass1_item(const Params& P, int layer, int item, unsigned char* lds) {
    const int tid = otid(), w = __builtin_amdgcn_readfirstlane(tid >> 6), lane = tid & 63, fr = lane & 15, fq = lane >> 4;
    const int b = item >> 7, c = (item >> 2) & 31, g = item & 3; const size_t r0 = (size_t)b * 4096 + (size_t)c * 128;
    const bf16_t* proj = (const bf16_t*)(P.ws + WS_PROJ);
    float* states = (float*)(P.ws + WS_SSDST); float* decs = (float*)(P.ws + WS_SSDDEC);
    bf16_t* XT4 = (bf16_t*)lds; bf16_t* BT = XT4 + 256 * 136; float* DT = (float*)(BT + 64 * 136); float* ACS = DT + 512;
    __syncthreads();
    ssd_stage_dt(P, layer, proj, r0, g, DT, ACS, tid);
    ssd_stage_conv<0>(P, layer, proj, r0, c == 0, g, DT, ACS, XT4, BT, nullptr, tid);
    __syncthreads();
    const int hh = w >> 1, pb = (w & 1) * 2;
    f32x4 acc[2][4];
#pragma unroll
    for (int pi = 0; pi < 2; ++pi)
#pragma unroll
        for (int nt = 0; nt < 4; ++nt) acc[pi][nt] = (f32x4){0.f, 0.f, 0.f, 0.f};
#pragma unroll
    for (int ks = 0; ks < 4; ++ks) { bf16x8 a[2];
#pragma unroll
        for (int pi = 0; pi < 2; ++pi) a[pi] = *(const bf16x8*)(XT4 + xt_idx(hh * 64 + (pb + pi) * 16 + fr, ks * 32 + fq * 8));
#pragma unroll
        for (int nt = 0; nt < 4; ++nt) { const bf16x8 bv = *(const bf16x8*)(BT + xt_idx(nt * 16 + fr, ks * 32 + fq * 8));
#pragma unroll
            for (int pi = 0; pi < 2; ++pi) acc[pi][nt] = __builtin_amdgcn_mfma_f32_16x16x32_bf16(a[pi], bv, acc[pi][nt], 0, 0, 0); } }
    float* sp = states + ((size_t)((b * 32 + c) * 16 + g * 4 + hh)) * 4096;
#pragma unroll
    for (int pi = 0; pi < 2; ++pi)
#pragma unroll
        for (int nt = 0; nt < 4; ++nt)
#pragma unroll
            for (int j = 0; j < 4; ++j) sp[((pb + pi) * 16 + fq * 4 + j) * 64 + nt * 16 + fr] = acc[pi][nt][j];
    if (tid < 4) decs[(b * 32 + c) * 16 + g * 4 + tid] = __expf(ACS[tid * 128 + 127]);
}
__device__ __forceinline__ void ssd_pass3_item(const Params& P, int layer, int item, unsigned char* lds, bool dry = false) {
    const int tid = otid(), w = __builtin_amdgcn_readfirstlane(tid >> 6), lane = tid & 63, fr = lane & 15, fq = lane >> 4;
    const int b = item >> 7, c = (item >> 2) & 31, g = item & 3; const size_t r0 = (size_t)b * 4096 + (size_t)c * 128;
    bf16_t* proj = (bf16_t*)(P.ws + WS_PROJ);
    const float* states = (const float*)(P.ws + WS_SSDST);
    bf16_t* Cs = (bf16_t*)lds; bf16_t* Bs = Cs + 128 * 72; bf16_t* Sin = Bs; bf16_t* XT4 = Bs + 128 * 72; bf16_t* Ms = XT4 + 256 * 136; float* DT = (float*)(Ms + 128 * 136); float* ACS = DT + 512;
    __syncthreads();
    ssd_stage_dt(P, layer, proj, r0, g, DT, ACS, tid);
    ssd_stage_conv<1>(P, layer, proj, r0, c == 0, g, DT, ACS, XT4, Bs, Cs, tid);
    __syncthreads();
    f32x4 CB[8];
#pragma unroll
    for (int st = 0; st < 8; ++st) { CB[st] = (f32x4){0.f, 0.f, 0.f, 0.f};
        if (st <= w) {
#pragma unroll
            for (int ks = 0; ks < 2; ++ks) { const bf16x8 a = *(const bf16x8*)(Cs + (16 * w + fr) * 72 + ks * 32 + fq * 8), bv = *(const bf16x8*)(Bs + (16 * st + fr) * 72 + ks * 32 + fq * 8);
                CB[st] = __builtin_amdgcn_mfma_f32_16x16x32_bf16(a, bv, CB[st], 0, 0, 0); } } }
    float ssq[4] = {0.f, 0.f, 0.f, 0.f};
    const int nks = (w >> 1) + 1;
    bf16_t* zrow[4];
#pragma unroll
    for (int j = 0; j < 4; ++j) zrow[j] = proj + (r0 + 16 * w + fq * 4 + j) * LDP + C_Z + g * 256 + fr;
    f32x4 sna, snc;
    { const float* sp = states + ((size_t)((b * 32 + c) * 16 + g * 4)) * 4096 + (tid >> 3) * 64 + (tid & 7) * 8; sna = *(const f32x4*)sp; snc = *(const f32x4*)(sp + 4); }
    for (int hh = 0; hh < 4; ++hh) {
        const int hd = g * 4 + hh;
        __syncthreads();
        { const int p = tid >> 3, n0 = (tid & 7) * 8;
          u32x4 pk; pk[0] = pk2(sna[0], sna[1]); pk[1] = pk2(sna[2], sna[3]); pk[2] = pk2(snc[0], snc[1]); pk[3] = pk2(snc[2], snc[3]);
          *(u32x4*)(Sin + p * 72 + n0) = pk;
          if (hh < 3) { const float* sp = states + ((size_t)((b * 32 + c) * 16 + hd + 1)) * 4096 + p * 64 + n0; sna = *(const f32x4*)sp; snc = *(const f32x4*)(sp + 4); } }
        float acs_t[4];
#pragma unroll
        for (int j = 0; j < 4; ++j) acs_t[j] = ACS[hh * 128 + 16 * w + fq * 4 + j];
#pragma unroll
        for (int st = 0; st < 8; ++st) { if (st <= (w | 1)) { const float acs_s = ACS[hh * 128 + 16 * st + fr];
#pragma unroll
            for (int j = 0; j < 4; ++j) { const int t = 16 * w + fq * 4 + j, sx = 16 * st + fr; const float v = (st <= w && sx <= t) ? CB[st][j] * __expf(acs_t[j] - acs_s) : 0.f; Ms[t * 136 + sx] = f2bf(v); } } }
        __syncthreads();
        bf16_t zv[4][4];
#pragma unroll
        for (int j = 0; j < 4; ++j)
#pragma unroll
            for (int pt = 0; pt < 4; ++pt) zv[j][pt] = *(zrow[j] + hh * 64 + pt * 16);
        f32x4 yd[4], yo[4];
#pragma unroll
        for (int pt = 0; pt < 4; ++pt) { yd[pt] = (f32x4){0.f, 0.f, 0.f, 0.f}; yo[pt] = (f32x4){0.f, 0.f, 0.f, 0.f}; }
        for (int ks = 0; ks < nks; ++ks) { const bf16x8 a = *(const bf16x8*)(Ms + (16 * w + fr) * 136 + ks * 32 + fq * 8);
#pragma unroll
            for (int pt = 0; pt < 4; ++pt) { const bf16x8 bv = *(const bf16x8*)(XT4 + xt_idx(hh * 64 + pt * 16 + fr, ks * 32 + fq * 8)); yd[pt] = __builtin_amdgcn_mfma_f32_16x16x32_bf16(a, bv, yd[pt], 0, 0, 0); } }
#pragma unroll
        for (int ks = 0; ks < 2; ++ks) { const bf16x8 a = *(const bf16x8*)(Cs + (16 * w + fr) * 72 + ks * 32 + fq * 8);
#pragma unroll
            for (int pt = 0; pt < 4; ++pt) { const bf16x8 bv = *(const bf16x8*)(Sin + (pt * 16 + fr) * 72 + ks * 32 + fq * 8); yo[pt] = __builtin_amdgcn_mfma_f32_16x16x32_bf16(a, bv, yo[pt], 0, 0, 0); } }
        const float Dh = P.in[18][layer * 16 + hd];
#pragma unroll
        for (int j = 0; j < 4; ++j) { const int t = 16 * w + fq * 4 + j; const float et = __expf(acs_t[j]), idt = 1.f / DT[hh * 128 + t];
#pragma unroll
            for (int pt = 0; pt < 4; ++pt) { const int p = pt * 16 + fr; const float x = bf2f(XT4[xt_idx(hh * 64 + p, t)]) * idt;
                bf16_t* zp = zrow[j] + hh * 64 + pt * 16;
                float y = yd[pt][j] + et * yo[pt][j] + Dh * x; y *= silu_fast(bf2f(zv[j][pt])); ssq[j] += y * y; if (!dry) *zp = f2bf(y); } }
    }
    asm volatile("s_waitcnt vmcnt(0)" ::: "memory");
    const float* ng = P.in[19] + layer * 1024 + g * 256 + fr;
#pragma unroll
    for (int j = 0; j < 4; ++j) { float v = ssq[j];
#pragma unroll
        for (int o = 8; o > 0; o >>= 1) v += shx(v, o, lane);
        ssq[j] = rsqrtf(v * (1.f / 256.f) + EPSF); }
    for (int hb = 0; hb < 16; hb += 4) { bf16_t yv[4][4]; float gv[4];
#pragma unroll
        for (int q = 0; q < 4; ++q) { gv[q] = ng[(hb + q) * 16];
#pragma unroll
            for (int j = 0; j < 4; ++j) yv[q][j] = *(zrow[j] + (hb + q) * 16); }
#pragma unroll
        for (int q = 0; q < 4; ++q)
#pragma unroll
            for (int j = 0; j < 4; ++j) { if (!dry) *(zrow[j] + (hb + q) * 16) = f2bf(bf2f(yv[q][j]) * ssq[j] * gv[q]); } }
}
__device__ __forceinline__ void phase_ssd_scan(const Params& P, int layer) {
    float* states = (float*)(P.ws + WS_SSDST); const float* decs = (const float*)(P.ws + WS_SSDDEC);
    for (int e = blockIdx.x * 512 + otid(); e < 4 * 16 * 4096; e += gridDim.x * 512) {
        const int b = e >> 16, hd = (e >> 12) & 15, pn = e & 4095; float carry = 0.f;
        float st[32], dc[32];
#pragma unroll
        for (int c = 0; c < 32; ++c) { st[c] = states[((size_t)((b * 32 + c) * 16 + hd)) * 4096 + pn]; dc[c] = decs[(b * 32 + c) * 16 + hd]; }
#pragma unroll
        for (int c = 0; c < 32; ++c) { states[((size_t)((b * 32 + c) * 16 + hd)) * 4096 + pn] = carry; carry = carry * dc[c] + st[c]; }
        P.out[O_PSSM + ((size_t)((layer * 4 + b) * 16 + hd)) * 4096 + pn] = carry;
    }
}

__device__ __forceinline__ void attn_prompt_item(const Params& P, int layer, int item, unsigned char* lds, bool dry = false) {
    const int tid = otid(), w = tid >> 6, lane = tid & 63, fr = lane & 15, fq = lane >> 4;
    const int b = item >> 7, nb = (item >> 2) & 31, kvh = item & 3;
    bf16_t* proj = (bf16_t*)(P.ws + WS_PROJ);
    bf16_t* Ks = (bf16_t*)lds;
    bf16_t* Vt = Ks + 256 * 72;
    bf16_t* Pw = Vt + 64 * 280 + w * 16 * 168;
    const long rowK0 = (long)b * 4096 + (long)(nb - 1) * 128;
    const bf16_t* qbase = proj + ((size_t)b * 4096 + (size_t)nb * 128 + w * 16 + fr) * LDP + C_Q + kvh * 256 + fq * 8;
    bf16x8 qa[2], qn[2];
#pragma unroll
    for (int ks = 0; ks < 2; ++ks) { qa[ks] = *(const bf16x8*)(qbase + ks * 32); qn[ks] = qa[ks]; }
    __syncthreads();
#pragma unroll
    for (int idx = tid; idx < 2048; idx += 512) { const int kj = idx >> 3, seg = idx & 7; u32x4 v = (u32x4){0u, 0u, 0u, 0u};
        if (nb > 0 || kj >= 128) v = *(const u32x4*)(proj + (size_t)(rowK0 + kj) * LDP + C_K + kvh * 64 + seg * 8);
        *(u32x4*)(Ks + kj * 72 + seg * 8) = v; }
#pragma unroll
    for (int idx = tid; idx < 2048; idx += 512) { const int seg = idx >> 8, kj = idx & 255; u32x4 v = (u32x4){0u, 0u, 0u, 0u};
        if (nb > 0 || kj >= 128) v = *(const u32x4*)(proj + (size_t)(rowK0 + kj) * LDP + C_V + kvh * 64 + seg * 8);
#pragma unroll
        for (int i = 0; i < 8; ++i) Vt[(seg * 8 + i) * 280 + kj] = (bf16_t)((v[i >> 1] >> ((i & 1) * 16)) & 0xffffu); }
    for (int idx = tid; idx < 64 * 24; idx += 512) { const int d = idx / 24, cc = 256 + idx % 24; Vt[d * 280 + cc] = 0; }
    for (int i = lane; i < 384; i += 64) Pw[(i / 24) * 168 + 144 + i % 24] = 0;
    __syncthreads();
    const int q0 = w * 16;
    const size_t qrow0 = (size_t)b * 4096 + (size_t)nb * 128 + q0;
    for (int gi = 0; gi < 4; ++gi) {
        const int hq = kvh * 4 + gi;
        const float slope = exp2f(-0.5f * (float)(hq + 1));
        const float sink = P.in[21][layer * 16 + hq];
        if (gi < 3) {
#pragma unroll
            for (int ks = 0; ks < 2; ++ks) qn[ks] = *(const bf16x8*)(qbase + (gi + 1) * 64 + ks * 32); }
        f32x4 S[9];
#pragma unroll
        for (int nt = 0; nt < 9; ++nt) { f32x4 a = (f32x4){0.f, 0.f, 0.f, 0.f}; const bf16_t* kp = Ks + (q0 + nt * 16 + fr) * 72 + fq * 8;
#pragma unroll
            for (int ks = 0; ks < 2; ++ks) { const bf16x8 kb = *(const bf16x8*)(kp + ks * 32); a = __builtin_amdgcn_mfma_f32_16x16x32_bf16(qa[ks], kb, a, 0, 0, 0); }
            S[nt] = a; }
        float mx[4] = {-INFINITY, -INFINITY, -INFINITY, -INFINITY};
#pragma unroll
        for (int nt = 0; nt < 9; ++nt)
#pragma unroll
            for (int j = 0; j < 4; ++j) { const int dist = (fq * 4 + j) - (nt * 16 + fr) + 128; const bool valid = dist >= 0 && dist <= 128 && (nb > 0 || (q0 + nt * 16 + fr) >= 128);
                const float s = valid ? S[nt][j] * 0.125f - slope * (float)dist : -INFINITY; S[nt][j] = s; mx[j] = fmaxf(mx[j], s); }
        float inv[4];
#pragma unroll
        for (int j = 0; j < 4; ++j) { float m = mx[j];
#pragma unroll
            for (int o = 8; o > 0; o >>= 1) m = fmaxf(m, shx(m, o, lane));
            m = fmaxf(m, sink); float sum = 0.f;
#pragma unroll
            for (int nt = 0; nt < 9; ++nt) { const float p = __expf(S[nt][j] - m); S[nt][j] = p; sum += p; }
#pragma unroll
            for (int o = 8; o > 0; o >>= 1) sum += shx(sum, o, lane);
            inv[j] = 1.f / (sum + __expf(sink - m)); }
#pragma unroll
        for (int nt = 0; nt < 9; ++nt)
#pragma unroll
            for (int j = 0; j < 4; ++j) Pw[(fq * 4 + j) * 168 + nt * 16 + fr] = f2bf(S[nt][j]);
        asm volatile("s_waitcnt lgkmcnt(0)" ::: "memory"); __builtin_amdgcn_wave_barrier();
        f32x4 O[4];
#pragma unroll
        for (int dt = 0; dt < 4; ++dt) O[dt] = (f32x4){0.f, 0.f, 0.f, 0.f};
#pragma unroll
        for (int ks = 0; ks < 5; ++ks) { const bf16x8 pa = *(const bf16x8*)(Pw + fr * 168 + ks * 32 + fq * 8);
#pragma unroll
            for (int dt = 0; dt < 4; ++dt) { const bf16x8 vb = *(const bf16x8*)(Vt + (dt * 16 + fr) * 280 + q0 + ks * 32 + fq * 8); O[dt] = __builtin_amdgcn_mfma_f32_16x16x32_bf16(pa, vb, O[dt], 0, 0, 0); } }
        asm volatile("s_waitcnt lgkmcnt(0)" ::: "memory"); __builtin_amdgcn_wave_barrier();
#pragma unroll
        for (int dt = 0; dt < 4; ++dt)
#pragma unroll
            for (int j = 0; j < 4; ++j) { if (!dry) proj[(qrow0 + fq * 4 + j) * LDP + C_Q + hq * 64 + dt * 16 + fr] = f2bf(O[dt][j] * inv[j]); }
        qa[0] = qn[0]; qa[1] = qn[1];
    }
    if (nb == 31) {
        for (int idx = tid; idx < 128 * 64; idx += 512) { const int t = idx >> 6, d = idx & 63; const size_t row = (size_t)b * 4096 + 3968 + t;
            const size_t o = ((size_t)((layer * 4 + b) * 128 + t)) * 256 + kvh * 64 + d;
            P.out[O_PK + o] = bf2f(proj[row * LDP + C_K + kvh * 64 + d]); P.out[O_PV + o] = bf2f(proj[row * LDP + C_V + kvh * 64 + d]); }
    }
}
__device__ __forceinline__ void attn_sample_item(const Params& P, int layer, int item, float* L, bool dry = false) {
    const int tid = otid(), w = tid >> 6, lane = tid & 63;
    const int sb = item >> 2, kvh = item & 3, r0 = NPR + sb * 4;
    bf16_t* proj = (bf16_t*)(P.ws + WS_PROJ);
    float* Kf = L; float* Vf = Kf + 132 * 65; float* Q = Vf + 132 * 65; float* Sc = Q + 16 * 64;
    const float* ck = P.in[7] + ((size_t)(layer * 128 + sb)) * 128 * 256; const float* cv = P.in[8] + ((size_t)(layer * 128 + sb)) * 128 * 256;
    __syncthreads();
    {
        f32x4 kq[4], vq[4];
#pragma unroll
        for (int i = 0; i < 4; ++i) { const int idx = tid + i * 512, j = idx >> 4, d4 = (idx & 15) * 4; kq[i] = *(const f32x4*)(ck + (size_t)j * 256 + kvh * 64 + d4); vq[i] = *(const f32x4*)(cv + (size_t)j * 256 + kvh * 64 + d4); }
#pragma unroll
        for (int i = 0; i < 4; ++i) { const int idx = tid + i * 512, j = idx >> 4, d4 = (idx & 15) * 4;
#pragma unroll
            for (int e = 0; e < 4; ++e) { Kf[j * 65 + d4 + e] = kq[i][e]; Vf[j * 65 + d4 + e] = vq[i][e]; }
            if (j >= 4) { const size_t o = ((size_t)((layer * 128 + sb) * 128 + (j - 4))) * 256 + kvh * 64 + d4; *(f32x4*)(P.out + O_SK + o) = kq[i]; *(f32x4*)(P.out + O_SV + o) = vq[i]; } }
        if (tid < 256) { const int j = 128 + (tid >> 6), d = tid & 63; const float kv = bf2f(proj[(size_t)(r0 + j - 128) * LDP + C_K + kvh * 64 + d]), vv = bf2f(proj[(size_t)(r0 + j - 128) * LDP + C_V + kvh * 64 + d]);
            Kf[j * 65 + d] = kv; Vf[j * 65 + d] = vv; const size_t o = ((size_t)((layer * 128 + sb) * 128 + (j - 4))) * 256 + kvh * 64 + d; P.out[O_SK + o] = kv; P.out[O_SV + o] = vv; }
    }
    for (int idx = tid; idx < 1024; idx += 512) { const int qr = idx >> 6, d = idx & 63; Q[idx] = bf2f(proj[(size_t)(r0 + (qr >> 2)) * LDP + C_Q + (kvh * 4 + (qr & 3)) * 64 + d]); }
    __syncthreads();
    for (int idx = tid; idx < 16 * 132; idx += 512) { const int qr = idx / 132, j = idx - qr * 132; const int dist = 128 + (qr >> 2) - j; float s = -INFINITY;
        if (dist >= 0 && dist <= 128) { float a = 0.f;
#pragma unroll 8
            for (int d = 0; d < 64; ++d) a += Q[qr * 64 + d] * Kf[j * 65 + d];
            s = a * 0.125f - exp2f(-0.5f * (float)(kvh * 4 + (qr & 3) + 1)) * (float)dist; }
        Sc[qr * 136 + j] = s; }
    __syncthreads();
    for (int rr = 0; rr < 2; ++rr) { const int qr = w * 2 + rr; const float sink = P.in[21][layer * 16 + kvh * 4 + (qr & 3)];
        float v0 = Sc[qr * 136 + lane], v1 = Sc[qr * 136 + 64 + lane], v2 = lane < 4 ? Sc[qr * 136 + 128 + lane] : -INFINITY;
        float m = fmaxf(fmaxf(v0, v1), v2);
#pragma unroll
        for (int o = 32; o > 0; o >>= 1) m = fmaxf(m, shx(m, o, lane));
        m = fmaxf(m, sink);
        v0 = __expf(v0 - m); v1 = __expf(v1 - m); v2 = __expf(v2 - m);
        const float sum = wave_sum(v0 + v1 + v2, lane); const float inv = 1.f / (sum + __expf(sink - m));
        Sc[qr * 136 + lane] = v0 * inv; Sc[qr * 136 + 64 + lane] = v1 * inv; if (lane < 4) Sc[qr * 136 + 128 + lane] = v2 * inv; }
    __syncthreads();
    for (int idx = tid; idx < 1024; idx += 512) { const int qr = idx >> 6, d = idx & 63; float o = 0.f;
        for (int j = 0; j < 132; ++j) o += Sc[qr * 136 + j] * Vf[j * 65 + d];
        if (!dry) proj[(size_t)(r0 + (qr >> 2)) * LDP + C_Q + (kvh * 4 + (qr & 3)) * 64 + d] = f2bf(o); }
}

__device__ __forceinline__ void gmlp_prompt_item(const Params& P, int layer, int item, unsigned char* lds, bool dry = false) {
    const int tid = otid(), w = tid >> 6, lane = tid & 63, fr = lane & 15, fq = lane >> 4;
    const int b = item >> 8, chn = (item >> 3) & 31, g = item & 7;
    const size_t r0 = (size_t)b * 4096 + (size_t)chn * 128;
    bf16_t* proj = (bf16_t*)(P.ws + WS_PROJ);
    bf16_t* VT = (bf16_t*)lds; bf16_t* Wt = VT + 128 * 136; float* MU = (float*)(Wt + 128 * 136); float* RS = MU + 128;
    __syncthreads();
#pragma unroll
    for (int hb = 0; hb < 2; ++hb) { u32x4 av[8], cv8[8];
#pragma unroll
        for (int i = 0; i < 8; ++i) { const bf16_t* vp = proj + (r0 + w * 16 + hb * 8 + i) * LDP + C_UV + 1024 + lane * 16; av[i] = *(const u32x4*)vp; cv8[i] = *(const u32x4*)(vp + 8); }
#pragma unroll
        for (int i = 0; i < 8; ++i) { const int t = w * 16 + hb * 8 + i; float s = 0.f, sq = 0.f;
#pragma unroll
            for (int k = 0; k < 4; ++k) { float x0 = bflo(av[i][k]), x1 = bfhi(av[i][k]), x2 = bflo(cv8[i][k]), x3 = bfhi(cv8[i][k]); s += x0 + x1 + x2 + x3; sq += x0 * x0 + x1 * x1 + x2 * x2 + x3 * x3; }
            s = wave_sum(s, lane); sq = wave_sum(sq, lane);
            if (lane == 0) { const float mean = s * (1.f / 1024.f); const float var = fmaxf(sq * (1.f / 1024.f) - mean * mean, 0.f); MU[t] = mean; RS[t] = rsqrtf(var + EPSF); } } }
    const float* Wg = P.in[24] + ((size_t)(layer * 8 + g)) * 16384;
#pragma unroll
    for (int idx = tid; idx < 4096; idx += 512) { const int t = idx >> 5, s4 = (idx & 31) * 4; const f32x4 wv = *(const f32x4*)(Wg + t * 128 + s4);
        u32x2 o; o[0] = pk2(s4 <= t ? wv[0] : 0.f, s4 + 1 <= t ? wv[1] : 0.f); o[1] = pk2(s4 + 2 <= t ? wv[2] : 0.f, s4 + 3 <= t ? wv[3] : 0.f);
        *(u32x2*)(Wt + t * 136 + s4) = o; }
    __syncthreads();
    const float* lg = P.in[22] + layer * 1024 + g * 128; const float* lb = P.in[23] + layer * 1024 + g * 128;
#pragma unroll
    for (int idx = tid; idx < 2048; idx += 512) { const int s = idx & 127, fs = idx >> 7; const u32x4 v = *(const u32x4*)(proj + (r0 + s) * LDP + C_UV + 1024 + g * 128 + fs * 8);
        const float mu = MU[s], rs = RS[s];
#pragma unroll
        for (int i = 0; i < 8; ++i) { const int f = fs * 8 + i; const float x = (i & 1) ? bfhi(v[i >> 1]) : bflo(v[i >> 1]); VT[f * 136 + s] = f2bf((x - mu) * rs * lg[f] + lb[f]); } }
    __syncthreads();
    f32x4 acc[8];
#pragma unroll
    for (int ft = 0; ft < 8; ++ft) acc[ft] = (f32x4){0.f, 0.f, 0.f, 0.f};
    const int nks = (16 * w + 15) / 32 + 1;
    for (int ks = 0; ks < nks; ++ks) { const bf16x8 a = *(const bf16x8*)(Wt + (w * 16 + fr) * 136 + ks * 32 + fq * 8);
#pragma unroll
        for (int ft = 0; ft < 8; ++ft) { const bf16x8 bb = *(const bf16x8*)(VT + (ft * 16 + fr) * 136 + ks * 32 + fq * 8); acc[ft] = __builtin_amdgcn_mfma_f32_16x16x32_bf16(a, bb, acc[ft], 0, 0, 0); } }
    bf16_t uv[4][8]; float bsv[4];
#pragma unroll
    for (int j = 0; j < 4; ++j) { const int t = w * 16 + fq * 4 + j; bsv[j] = P.in[25][(layer * 8 + g) * 128 + t];
#pragma unroll
        for (int ft = 0; ft < 8; ++ft) uv[j][ft] = proj[(r0 + t) * LDP + C_UV + g * 128 + ft * 16 + fr]; }
#pragma unroll
    for (int j = 0; j < 4; ++j) { const int t = w * 16 + fq * 4 + j;
#pragma unroll
        for (int ft = 0; ft < 8; ++ft) { if (!dry) proj[(r0 + t) * LDP + C_UV + g * 128 + ft * 16 + fr] = f2bf(gelu_fast(bf2f(uv[j][ft])) * (acc[ft][j] + bsv[j])); } }
}
__device__ __forceinline__ void gmlp_sample_item(const Params& P, int layer, int sb, float* L) {
    const int tid = otid(), w = tid >> 6, lane = tid & 63; const size_t r0 = NPR + sb * 4;
    bf16_t* proj = (bf16_t*)(P.ws + WS_PROJ);
    float* Vn = L; float* MU = Vn + 4096; float* RS = MU + 4;
    __syncthreads();
    if (w < 4) { const bf16_t* vp = proj + (r0 + w) * LDP + C_UV + 1024 + lane * 16; const u32x4 a = *(const u32x4*)vp, c = *(const u32x4*)(vp + 8); float s = 0.f, sq = 0.f;
#pragma unroll
        for (int k = 0; k < 4; ++k) { float x0 = bflo(a[k]), x1 = bfhi(a[k]), x2 = bflo(c[k]), x3 = bfhi(c[k]); s += x0 + x1 + x2 + x3; sq += x0 * x0 + x1 * x1 + x2 * x2 + x3 * x3; }
        s = wave_sum(s, lane); sq = wave_sum(sq, lane);
        if (lane == 0) { const float mean = s * (1.f / 1024.f); const float var = fmaxf(sq * (1.f / 1024.f) - mean * mean, 0.f); MU[w] = mean; RS[w] = rsqrtf(var + EPSF); } }
    __syncthreads();
    for (int idx = tid; idx < 4096; idx += 512) { const int t = idx >> 10, c = idx & 1023;
        const float x = bf2f(proj[(r0 + t) * LDP + C_UV + 1024 + c]); const float vn = (x - MU[t]) * RS[t] * P.in[22][layer * 1024 + c] + P.in[23][layer * 1024 + c];
        Vn[idx] = vn; P.out[O_SGMV + ((size_t)((layer * 128 + sb) * 4 + t)) * 1024 + c] = vn; }
    __syncthreads();
    for (int idx = tid; idx < 4096; idx += 512) { const int t = idx >> 10, c = idx & 1023, g = c >> 7;
        const float* Wg = P.in[24] + ((size_t)(layer * 8 + g)) * 16384 + t * 128; float m = P.in[25][(layer * 8 + g) * 128 + t];
        for (int s = 0; s <= t; ++s) m += Wg[s] * Vn[s * 1024 + c];
        bf16_t* ap = proj + (r0 + t) * LDP + C_UV + c; *ap = f2bf(gelu_fast(bf2f(*ap)) * m); }
}

template <int R>
__device__ __forceinline__ void shortconv_rows(const Params& P, int layer, int r0, int tid, bool dry) {
    bf16_t* proj = (bf16_t*)(P.ws + WS_PROJ);
    const float* cw = P.in[20] + layer * 3 * 1024;
    const int j = tid * 2; const int ss = seq_start(r0); const bool havePrev = (r0 - 2 >= ss);
    unsigned cg[R + 2], xs[R + 2], bg[R];
#pragma unroll
    for (int k = 0; k < R + 2; ++k) { cg[k] = 0u; xs[k] = 0u;
        if (k >= 2 || havePrev) { const bf16_t* rp = proj + (size_t)(r0 - 2 + k) * LDP + C_BCX + j; cg[k] = *(const unsigned*)(rp + 1024); xs[k] = *(const unsigned*)(rp + 2048); } }
#pragma unroll
    for (int k = 0; k < R; ++k) bg[k] = *(const unsigned*)(proj + (size_t)(r0 + k) * LDP + C_BCX + j);
    float pr0[R + 2], pr1[R + 2];
#pragma unroll
    for (int k = 0; k < R + 2; ++k) { pr0[k] = bflo(cg[k]) * bflo(xs[k]); pr1[k] = bfhi(cg[k]) * bfhi(xs[k]); }
    if (!havePrev && r0 >= NPR) { const float* st = P.in[6] + ((size_t)(layer * 128 + ((r0 - NPR) >> 2)) * 2) * 1024 + j; pr0[0] = st[0]; pr1[0] = st[1]; pr0[1] = st[1024]; pr1[1] = st[1025]; }
    const float w0a = cw[j], w0b = cw[j + 1], w1a = cw[1024 + j], w1b = cw[1025 + j], w2a = cw[2048 + j], w2b = cw[2049 + j];
#pragma unroll
    for (int k = 0; k < R; ++k) { const float y0 = w0a * pr0[k] + w1a * pr0[k + 1] + w2a * pr0[k + 2], y1 = w0b * pr1[k] + w1b * pr1[k + 1] + w2b * pr1[k + 2];
        if (!dry) *(unsigned*)(proj + (size_t)(r0 + k) * LDP + C_BCX + j) = pk2(bflo(bg[k]) * y0, bfhi(bg[k]) * y1);
        const int r = r0 + k;
        if (r < NPR) { const int l = r & 4095; if (l >= 4094) { float* o = P.out + O_PSCC + ((size_t)((layer * 4 + (r >> 12)) * 2 + (l - 4094))) * 1024 + j; o[0] = pr0[k + 2]; o[1] = pr1[k + 2]; } }
        else { const int l = (r - NPR) & 3; if (l >= 2) { float* o = P.out + O_SSCC + ((size_t)((layer * 128 + ((r - NPR) >> 2)) * 2 + (l - 2))) * 1024 + j; o[0] = pr0[k + 2]; o[1] = pr1[k + 2]; } }
    }
}
__device__ __forceinline__ void shortconv_item(const Params& P, int layer, int item, bool dry = false) {
    const int tid = otid();
    if (item < 1024) shortconv_rows<16>(P, layer, item * 16, tid, dry); else shortconv_rows<4>(P, layer, NPR + (item - 1024) * 4, tid, dry);
}
__device__ __forceinline__ void ssdconv_state_item(const Params& P, int layer, int sq) {
    const bf16_t* proj = (const bf16_t*)(P.ws + WS_PROJ);
    const size_t rbase = sq < 4 ? (size_t)sq * 4096 + 4093 : (size_t)NPR + (size_t)(sq - 4) * 4 + 1;
    float* o = sq < 4 ? P.out + O_PSSDC + (size_t)(layer * 4 + sq) * 3 * 1536 : P.out + O_SSSDC + (size_t)(layer * 128 + (sq - 4)) * 3 * 1536;
    const int tid = otid(); bf16_t v[9];
#pragma unroll
    for (int i = 0; i < 9; ++i) { const int e = tid + i * 512, t = e / 1536, c = e - t * 1536; v[i] = proj[(rbase + t) * LDP + C_XBC + c]; }
#pragma unroll
    for (int i = 0; i < 9; ++i) o[tid + i * 512] = bf2f(v[i]);
}

template <int R>
__device__ __forceinline__ void ffn_act_unit(const Params& P, int layer, int r0, int oc) {
    const bf16_t* up = (const bf16_t*)(P.ws + WS_PROJ); bf16_t* act = (bf16_t*)(P.ws + WS_PROJ + UP_BYTES);
    const float* cw = P.in[30] + (size_t)layer * 3 * 5632; const float* cb = P.in[31] + (size_t)layer * 5632;
    const int j0 = oc * 8;
    float wa[3][8], wg[3][8], ba[8], bgv[8], pa[2][8], pg[2][8];
#pragma unroll
    for (int k = 0; k < 3; ++k) { const f32x4 a0 = *(const f32x4*)(cw + k * 5632 + j0), a1 = *(const f32x4*)(cw + k * 5632 + j0 + 4), g0 = *(const f32x4*)(cw + k * 5632 + 2816 + j0), g1 = *(const f32x4*)(cw + k * 5632 + 2816 + j0 + 4);
#pragma unroll
        for (int i = 0; i < 4; ++i) { wa[k][i] = a0[i]; wa[k][4 + i] = a1[i]; wg[k][i] = g0[i]; wg[k][4 + i] = g1[i]; } }
    { const f32x4 a0 = *(const f32x4*)(cb + j0), a1 = *(const f32x4*)(cb + j0 + 4), g0 = *(const f32x4*)(cb + 2816 + j0), g1 = *(const f32x4*)(cb + 2816 + j0 + 4);
#pragma unroll
      for (int i = 0; i < 4; ++i) { ba[i] = a0[i]; ba[4 + i] = a1[i]; bgv[i] = g0[i]; bgv[4 + i] = g1[i]; } }
    const int ss = seq_start(r0); const bool havePrev = (r0 - 2 >= ss);
#pragma unroll
    for (int k = 0; k < 2; ++k) {
        if (havePrev) { const u32x4 ua = *(const u32x4*)(up + (size_t)(r0 - 2 + k) * 5632 + j0), ug = *(const u32x4*)(up + (size_t)(r0 - 2 + k) * 5632 + 2816 + j0);
#pragma unroll
            for (int i = 0; i < 4; ++i) { pa[k][2 * i] = bflo(ua[i]); pa[k][2 * i + 1] = bfhi(ua[i]); pg[k][2 * i] = bflo(ug[i]); pg[k][2 * i + 1] = bfhi(ug[i]); } }
        else if (r0 >= NPR) { const float* pp = P.in[9] + ((size_t)(layer * 128 + ((r0 - NPR) >> 2)) * 2 + k) * 5632;
#pragma unroll
            for (int i = 0; i < 8; ++i) { pa[k][i] = pp[j0 + i]; pg[k][i] = pp[2816 + j0 + i]; } }
        else {
#pragma unroll
            for (int i = 0; i < 8; ++i) { pa[k][i] = 0.f; pg[k][i] = 0.f; } } }
#pragma unroll
    for (int kb = 0; kb < R; kb += 4) { u32x4 ua[4], ug[4];
#pragma unroll
        for (int q = 0; q < 4; ++q) { ua[q] = *(const u32x4*)(up + (size_t)(r0 + kb + q) * 5632 + j0); ug[q] = *(const u32x4*)(up + (size_t)(r0 + kb + q) * 5632 + 2816 + j0); }
#pragma unroll
        for (int q = 0; q < 4; ++q) { const int r = r0 + kb + q; float ca[8], cgv[8], o[8];
#pragma unroll
            for (int i = 0; i < 4; ++i) { ca[2 * i] = bflo(ua[q][i]); ca[2 * i + 1] = bfhi(ua[q][i]); cgv[2 * i] = bflo(ug[q][i]); cgv[2 * i + 1] = bfhi(ug[q][i]); }
#pragma unroll
            for (int i = 0; i < 8; ++i) { const float a = ba[i] + wa[0][i] * pa[0][i] + wa[1][i] * pa[1][i] + wa[2][i] * ca[i], g = bgv[i] + wg[0][i] * pg[0][i] + wg[1][i] * pg[1][i] + wg[2][i] * cgv[i];
                o[i] = silu_fast(a) * g; pa[0][i] = pa[1][i]; pa[1][i] = ca[i]; pg[0][i] = pg[1][i]; pg[1][i] = cgv[i]; }
            u32x4 ov; ov[0] = pk2(o[0], o[1]); ov[1] = pk2(o[2], o[3]); ov[2] = pk2(o[4], o[5]); ov[3] = pk2(o[6], o[7]);
            *(u32x4*)(act + (size_t)r * 2816 + j0) = ov;
            float* so = nullptr;
            if (r < NPR) { const int l = r & 4095; if (l >= 4094) so = P.out + O_PFFC + ((size_t)((layer * 4 + (r >> 12)) * 2 + (l - 4094))) * 5632; }
            else { const int l = (r - NPR) & 3; if (l >= 2) so = P.out + O_SFFC + ((size_t)((layer * 128 + ((r - NPR) >> 2)) * 2 + (l - 2))) * 5632; }
            if (so) {
#pragma unroll
                for (int i = 0; i < 8; ++i) { so[j0 + i] = ca[i]; so[2816 + j0 + i] = cgv[i]; } }
        } }
}
__device__ __forceinline__ void phase_ffn_act(const Params& P, int layer) {
    constexpr int NU_P = 2048 * 352, NU_S = 128 * 352;
    for (int u = blockIdx.x * 512 + otid(); u < NU_P + NU_S; u += gridDim.x * 512) {
        if (u < NU_P) { const int rb = u / 352, oc = u - rb * 352; ffn_act_unit<8>(P, layer, rb * 8, oc); }
        else { const int v = u - NU_P, sq = v / 352, oc = v - sq * 352; ffn_act_unit<4>(P, layer, NPR + sq * 4, oc); }
    }
}

__device__ __forceinline__ void sgemm_partial(const bf16_t* A, int lda, const bf16_t* Bt, int ldb, int K, int row0, int col0, float* red, int tid) {
    const int w = tid >> 6, lane = tid & 63, fr = lane & 15, fq = lane >> 4;
    const int kw = K >> 3, k0 = w * kw;
    f32x4 acc[2][4];
#pragma unroll
    for (int mt = 0; mt < 2; ++mt)
#pragma unroll
        for (int nt = 0; nt < 4; ++nt) acc[mt][nt] = (f32x4){0.f, 0.f, 0.f, 0.f};
    const bf16_t* ap = A + (size_t)(row0 + fr) * lda + k0 + fq * 8;
    const bf16_t* bp = Bt + (size_t)(col0 + fr) * ldb + k0 + fq * 8;
    const int nks = kw >> 5;
#pragma unroll 4
    for (int ks = 0; ks < nks; ++ks) { bf16x8 a[2], b[4];
#pragma unroll
        for (int mt = 0; mt < 2; ++mt) a[mt] = *(const bf16x8*)(ap + (size_t)mt * 16 * lda + ks * 32);
#pragma unroll
        for (int nt = 0; nt < 4; ++nt) b[nt] = *(const bf16x8*)(bp + (size_t)nt * 16 * ldb + ks * 32);
#pragma unroll
        for (int mt = 0; mt < 2; ++mt)
#pragma unroll
            for (int nt = 0; nt < 4; ++nt) acc[mt][nt] = __builtin_amdgcn_mfma_f32_16x16x32_bf16(a[mt], b[nt], acc[mt][nt], 0, 0, 0); }
#pragma unroll
    for (int mt = 0; mt < 2; ++mt)
#pragma unroll
        for (int nt = 0; nt < 4; ++nt)
#pragma unroll
            for (int j = 0; j < 4; ++j) red[(w * 32 + mt * 16 + fq * 4 + j) * 64 + nt * 16 + fr] = acc[mt][nt][j];
}
__device__ __forceinline__ f32x4 sgemm_reduce(const float* red, int tid) {
    const int row = tid >> 4, c4 = (tid & 15) * 4; f32x4 sacc = (f32x4){0.f, 0.f, 0.f, 0.f};
#pragma unroll
    for (int w = 0; w < 8; ++w) sacc += *(const f32x4*)(red + (w * 32 + row) * 64 + c4);
    return sacc;
}
__device__ __forceinline__ void sg_load4(const bf16_t* ap, int lda, const bf16_t* bp, int ldb, bf16x8 (&a)[4][2], bf16x8 (&b)[4][4]) {
#pragma unroll
    for (int ks = 0; ks < 4; ++ks) {
#pragma unroll
        for (int mt = 0; mt < 2; ++mt) a[ks][mt] = *(const bf16x8*)(ap + (size_t)mt * 16 * lda + ks * 32);
#pragma unroll
        for (int nt = 0; nt < 4; ++nt) b[ks][nt] = *(const bf16x8*)(bp + (size_t)nt * 16 * ldb + ks * 32); }
}
__device__ __forceinline__ void sample_branch(const Params& P, int layer, float* red) {
    const int tid = otid(), w = tid >> 6, lane = tid & 63, fr = lane & 15, fq = lane >> 4;
    const bf16_t* proj = (const bf16_t*)(P.ws + WS_PROJ); bf16_t* hbuf = (bf16_t*)(P.ws + WS_H);
    for (int piece = blockIdx.x; piece < 256; piece += gridDim.x) {
        const int row0 = (piece >> 4) * 32, col0 = (piece & 15) * 64; const size_t r = NPR + row0 + (tid >> 4); const int c = col0 + (tid & 15) * 4;
        const bf16_t* abase = proj + (size_t)(NPR + row0 + fr) * LDP + w * 128 + fq * 8;
        const bf16_t* bbase = (const bf16_t*)(P.ws + WS_WBR) + (size_t)layer * 4 * 1048576 + (size_t)(col0 + fr) * 1024 + w * 128 + fq * 8;
        bf16x8 a[4][2], b[4][4];
        sg_load4(abase + C_Z, LDP, bbase, 1024, a, b);
        f32x4 sum = (f32x4){0.f, 0.f, 0.f, 0.f};
        for (int z = 0; z < 4; ++z) {
            f32x4 acc[2][4];
#pragma unroll
            for (int mt = 0; mt < 2; ++mt)
#pragma unroll
                for (int nt = 0; nt < 4; ++nt) acc[mt][nt] = (f32x4){0.f, 0.f, 0.f, 0.f};
#pragma unroll
            for (int ks = 0; ks < 4; ++ks)
#pragma unroll
                for (int mt = 0; mt < 2; ++mt)
#pragma unroll
                    for (int nt = 0; nt < 4; ++nt) acc[mt][nt] = __builtin_amdgcn_mfma_f32_16x16x32_bf16(a[ks][mt], b[ks][nt], acc[mt][nt], 0, 0, 0);
            if (z < 3) { const int ao = z == 0 ? C_BCX : (z == 1 ? C_Q : C_UV); sg_load4(abase + ao, LDP, bbase + (size_t)(z + 1) * 1048576, 1024, a, b); }
            const u32x2 gv = *(const u32x2*)(proj + r * LDP + C_GATE + z * 1024 + c);
            __syncthreads();
#pragma unroll
            for (int mt = 0; mt < 2; ++mt)
#pragma unroll
                for (int nt = 0; nt < 4; ++nt)
#pragma unroll
                    for (int j = 0; j < 4; ++j) red[(w * 32 + mt * 16 + fq * 4 + j) * 64 + nt * 16 + fr] = acc[mt][nt][j];
            __syncthreads();
            const f32x4 v = sgemm_reduce(red, tid);
            sum[0] += sigmoid_fast(bflo(gv[0])) * v[0]; sum[1] += sigmoid_fast(bfhi(gv[0])) * v[1]; sum[2] += sigmoid_fast(bflo(gv[1])) * v[2]; sum[3] += sigmoid_fast(bfhi(gv[1])) * v[3];
        }
        u32x2 o; o[0] = pk2(sum[0], sum[1]); o[1] = pk2(sum[2], sum[3]); *(u32x2*)(hbuf + r * 1024 + c) = o;
        __syncthreads();
    }
}
__device__ __forceinline__ void sample_resid(const Params& P, const bf16_t* A, int lda, const bf16_t* Bt, int K, const float* xin_s, float* xout, const float* ga, float* red) {
    const int tid = otid();
    for (int piece = blockIdx.x; piece < 256; piece += gridDim.x) {
        const int row0 = (piece >> 4) * 32, col0 = (piece & 15) * 64; const int rs = row0 + (tid >> 4), c = col0 + (tid & 15) * 4;
        __syncthreads();
        sgemm_partial(A, lda, Bt, K, K, row0, col0, red, tid);
        __syncthreads();
        const f32x4 v = sgemm_reduce(red, tid);
        const f32x4 xv = *(const f32x4*)(xin_s + (size_t)rs * 1024 + c), gv = *(const f32x4*)(ga + (size_t)(4 + (rs >> 2)) * 6144 + c);
        *(f32x4*)(xout + (size_t)(NPR + rs) * 1024 + c) = xv + gv * v;
    }
}

__device__ __forceinline__ void grid_bar(unsigned* ctr, unsigned& epoch) {
    asm volatile("s_waitcnt vmcnt(0) lgkmcnt(0)" ::: "memory");
    __syncthreads();
    epoch += 1;
    if (otid() == 0) {
        __builtin_amdgcn_fence(__ATOMIC_RELEASE, "agent");
        asm volatile("s_waitcnt vmcnt(0) lgkmcnt(0)" ::: "memory");
        __hip_atomic_fetch_add(ctr, 1u, __ATOMIC_RELAXED, __HIP_MEMORY_SCOPE_AGENT);
        const unsigned target = epoch * gridDim.x;
        while (__hip_atomic_load(ctr, __ATOMIC_RELAXED, __HIP_MEMORY_SCOPE_AGENT) < target) __builtin_amdgcn_s_sleep(1);
        __builtin_amdgcn_fence(__ATOMIC_ACQUIRE, "agent");
        asm volatile("s_waitcnt vmcnt(0) lgkmcnt(0)" ::: "memory");
    }
    __syncthreads();
}

#ifndef PHMASK
#define PHMASK 0xFFFFFFFF
#endif
#define EN(x) ((PHMASK >> (x)) & 1)
#ifndef DRYM
#define DRYM 0
#endif
#ifndef DBL
#define DBL 0
#endif
#define REP(x) (((DBL >> (x)) & 1) ? 2 : 1)
constexpr int PH_PER_LAYER = 11, N_PHASES = 2 + 4 * PH_PER_LAYER + 1;

__global__ void __launch_bounds__(512, 2) mega_fwd(Params PK) {
    extern __shared__ __attribute__((aligned(16))) unsigned char lds_raw[];
    cg::grid_group grid = cg::this_grid();
    LAS unsigned char* ldsl = (LAS unsigned char*)lds_raw;
    unsigned epoch = 0;
    for (int ph = PK.ph_lo; ph < PK.ph_hi; ++ph) {
        Params P = PK;
        { unsigned char* w_ = P.ws; asm volatile("" : "+s"(w_)); P.ws = w_; float* o_ = P.out; asm volatile("" : "+s"(o_)); P.out = o_; }
        unsigned* barctr = (unsigned*)(P.ws + WS_BAR);
        bf16_t* proj = (bf16_t*)(P.ws + WS_PROJ);
        bf16_t* hbuf = (bf16_t*)(P.ws + WS_H);
        float* xbuf = P.out;
        float* mod = (float*)(P.ws + WS_MOD);
        if (ph == 0) { for (int rp = 0; rp < REP(0); ++rp) phase_convert(P, (float*)lds_raw); }
        else if (ph == 1) {
            Gemm g{(const bf16_t*)(P.ws + WS_CACT), (const bf16_t*)(P.ws + WS_WADA), 1024, 1024, 1024, 1, 96, 0, 0, 0, 0, 0};
            EpiMod E{mod, P.in[11]};
            for (int rp = 0; rp < REP(1); ++rp) gemm_phase<EpiMod, 1>(ldsl, g, E);
        }
        else if (ph == N_PHASES - 1) { phase_final_norm(xbuf, P.in[33]); }
        else {
            const int layer = (ph - 2) / PH_PER_LAYER, sp = (ph - 2) % PH_PER_LAYER;
            const float* modL = mod + (size_t)layer * NCOND * 6144;
            const float* xin_p = layer == 0 ? P.in[0] : xbuf; const float* xin_s = layer == 0 ? P.in[1] : xbuf + (size_t)NPR * 1024;
            if (sp == 0) { for (int rp = 0; rp < REP(16); ++rp) phase_norm(xin_p, xin_s, P.in[12] + layer * 1024, modL, 0, 1024, hbuf); }
            else if (sp == 1) {
                Gemm g{hbuf, (const bf16_t*)(P.ws + WS_WIN) + (size_t)layer * 13568 * 1024, 1024, 1024, 1024, 66, 53, 0, 0, 0, 0, 0};
                EpiProj E{proj};
                for (int rp = 0; rp < REP(2); ++rp) gemm_phase<EpiProj, 1>(ldsl, g, E);
            }
            else if (sp == 2) {
                for (int it = blockIdx.x; it < 3972 + 256; it += gridDim.x) {
                    if (it < 512) { for (int rp = 0; rp < REP(3); ++rp) ssd_pass1_item(P, layer, it, lds_raw); }
                    else if (it < 1024) { for (int rp = (DRYM & 1) ? 0 : 1; rp < 2; ++rp) attn_prompt_item(P, layer, it - 512, lds_raw, rp == 0 && P.ph_lo == 0); }
                    else if (it < 1536) { for (int rp = (DRYM & 2) ? 0 : 1; rp < 2; ++rp) attn_sample_item(P, layer, it - 1024, (float*)lds_raw, rp == 0 && P.ph_lo == 0); }
                    else if (it < 2560) { for (int rp = (DRYM & 4) ? 0 : 1; rp < 2; ++rp) gmlp_prompt_item(P, layer, it - 1536, lds_raw, rp == 0 && P.ph_lo == 0); }
                    else if (it < 2688) { if (EN(8)) gmlp_sample_item(P, layer, it - 2560, (float*)lds_raw); }
                    else if (it < 3840) { for (int rp = (DRYM & 8) ? 0 : 1; rp < 2; ++rp) shortconv_item(P, layer, it - 2688, rp == 0 && P.ph_lo == 0); }
                    else if (it < 3972) ssdconv_state_item(P, layer, it - 3840);
                    else ssd_item<2>(P, layer, it - 3972, (float*)lds_raw);
                }
            }
            else if (sp == 3) { phase_ssd_scan(P, layer); }
            else if (sp == 4) { for (int it = blockIdx.x; it < 512; it += gridDim.x) for (int rp = (DRYM & 16) ? 0 : 1; rp < 2; ++rp) ssd_pass3_item(P, layer, it, lds_raw, rp == 0 && P.ph_lo == 0); }
            else if (sp == 5) {
                Gemm g{proj, (const bf16_t*)(P.ws + WS_WBR) + (size_t)layer * 4 * 1048576, LDP, 1024, 1024, 64, 4, C_Z, C_BCX, C_Q, C_UV, (size_t)1048576};
                EpiBranch E{proj, (float*)(P.ws + WS_MSUM), hbuf};
                for (int rp = 0; rp < REP(11); ++rp) gemm_phase<EpiBranch, 4>(ldsl, g, E);
                for (int rp = 0; rp < REP(17); ++rp) sample_branch(P, layer, (float*)lds_raw);
            }
            else if (sp == 6) {
                Gemm g{hbuf, (const bf16_t*)(P.ws + WS_WO) + (size_t)layer * 1048576, 1024, 1024, 1024, 64, 4, 0, 0, 0, 0, 0};
                EpiResid E{xin_p, xin_s, xbuf, modL + 2048};
                if (EN(12)) gemm_phase<EpiResid, 1>(ldsl, g, E);
                sample_resid(P, hbuf + (size_t)NPR * 1024, 1024, (const bf16_t*)(P.ws + WS_WO) + (size_t)layer * 1048576, 1024, xin_s, xbuf, modL + 2048, (float*)lds_raw);
            }
            else if (sp == 7) { for (int rp = 0; rp < REP(16); ++rp) phase_norm(xbuf, xbuf + (size_t)NPR * 1024, P.in[28] + layer * 1024, modL, 3072, 4096, hbuf); }
            else if (sp == 8) {
                Gemm g{hbuf, (const bf16_t*)(P.ws + WS_WUP) + (size_t)layer * 5632 * 1024, 1024, 1024, 1024, 66, 22, 0, 0, 0, 0, 0};
                EpiUp E{proj};
                for (int rp = 0; rp < REP(13); ++rp) gemm_phase<EpiUp, 1>(ldsl, g, E);
            }
            else if (sp == 9) { for (int rp = 0; rp < REP(14); ++rp) phase_ffn_act(P, layer); }
            else {
                Gemm g{(const bf16_t*)(P.ws + WS_PROJ + UP_BYTES), (const bf16_t*)(P.ws + WS_WDN) + (size_t)layer * 1024 * 2816, 2816, 2816, 2816, 64, 4, 0, 0, 0, 0, 0};
                EpiResid E{xbuf, xbuf + (size_t)NPR * 1024, xbuf, modL + 5120};
                if (EN(15)) gemm_phase<EpiResid, 1>(ldsl, g, E);
                sample_resid(P, (const bf16_t*)(P.ws + WS_PROJ + UP_BYTES) + (size_t)NPR * 2816, 2816, (const bf16_t*)(P.ws + WS_WDN) + (size_t)layer * 1024 * 2816, 2816, xbuf + (size_t)NPR * 1024, xbuf, modL + 5120, (float*)lds_raw);
            }
        }
        if (ph + 1 < P.ph_hi) { if (ph == 0) grid.sync(); else grid_bar(barctr, epoch); }
    }
}

extern "C" void kernel_launch(void* const* d_in, const int* in_sizes, int n_in, void* d_out, int out_size, void* d_ws, size_t ws_size, hipStream_t stream) {
    static int grid_blocks = 0;
    if (grid_blocks == 0) {
        if (n_in != 34 || (size_t)out_size != O_END || ws_size < WS_END + 256) { fprintf(stderr, "kernel_launch: unexpected sizes n_in %d out %d ws %zu (need %zu)\n", n_in, out_size, ws_size, (size_t)WS_END); grid_blocks = -1; return; }
        int dev = 0, cus = 0, per_cu = 0;
        (void)hipGetDevice(&dev); (void)hipDeviceGetAttribute(&cus, hipDeviceAttributeMultiprocessorCount, dev);
        if (hipFuncSetAttribute((const void*)mega_fwd, hipFuncAttributeMaxDynamicSharedMemorySize, LDS_BYTES) != hipSuccess) { fprintf(stderr, "hipFuncSetAttribute failed\n"); grid_blocks = -1; return; }
        if (hipOccupancyMaxActiveBlocksPerMultiprocessor(&per_cu, (const void*)mega_fwd, 512, LDS_BYTES) != hipSuccess || per_cu < 1) per_cu = 1;
        grid_blocks = cus * 1;
    }
    if (grid_blocks < 0) return;
    Params p{};
    for (int i = 0; i < 34; ++i) p.in[i] = (const float*)d_in[i];
    p.out = (float*)d_out; p.ws = (unsigned char*)d_ws; p.ph_lo = 0; p.ph_hi = N_PHASES;
    (void)hipMemsetAsync((unsigned char*)d_ws + WS_BAR, 0, 256, stream);
    void* args[] = {&p};
    hipError_t e = hipLaunchCooperativeKernel((const void*)mega_fwd, dim3(grid_blocks), dim3(512), args, LDS_BYTES, stream);
    if (e != hipSuccess) fprintf(stderr, "cooperative launch failed: %s (grid %d)\n", hipGetErrorString(e), grid_blocks);
}
```

```cpp
#include <hip/hip_runtime.h>
#include <hip/hip_cooperative_groups.h>
#include <cstdio>
namespace cg = cooperative_groups;

typedef unsigned short bf16_t;
typedef short bf16x8 __attribute__((ext_vector_type(8)));
typedef float f32x4 __attribute__((ext_vector_type(4)));
typedef unsigned u32x4 __attribute__((ext_vector_type(4)));
typedef unsigned u32x2 __attribute__((ext_vector_type(2)));
#define LAS __attribute__((address_space(3)))

constexpr int NTOK = 16896, NPR = 16384;
constexpr int LDP = 13568;
constexpr int C_Z = 0, C_XBC = 1024, C_DTR = 2560, C_BCX = 2576, C_Q = 5648, C_K = 6672, C_V = 6928, C_UV = 7184, C_GATE = 9232, C_END = 13328;
constexpr int NCOND = 132;
constexpr float EPSF = 1e-6f;

constexpr size_t WS_WIN = 0;
constexpr size_t WS_WBR = WS_WIN + (size_t)4 * 13568 * 1024 * 2;
constexpr size_t WS_WO = WS_WBR + (size_t)16 * 1024 * 1024 * 2;
constexpr size_t WS_WUP = WS_WO + (size_t)4 * 1024 * 1024 * 2;
constexpr size_t WS_WDN = WS_WUP + (size_t)4 * 5632 * 1024 * 2;
constexpr size_t WS_WADA = WS_WDN + (size_t)4 * 1024 * 2816 * 2;
constexpr size_t WS_CACT = WS_WADA + (size_t)4 * 6144 * 1024 * 2;
constexpr size_t WS_MOD = WS_CACT + (size_t)256 * 1024 * 2;
constexpr size_t WS_H = WS_MOD + (size_t)4 * NCOND * 6144 * 4;
constexpr size_t WS_MSUM = WS_H + (size_t)NTOK * 1024 * 2;
constexpr size_t WS_PROJ = WS_MSUM + (size_t)NTOK * 1024 * 4;
constexpr size_t WS_END = WS_PROJ + (size_t)NTOK * LDP * 2;
constexpr size_t WS_BAR = WS_END;
constexpr size_t WS_SSDST = WS_WADA;
constexpr size_t WS_SSDDEC = WS_WADA + (size_t)4 * 32 * 16 * 4096 * 4;
constexpr size_t UP_BYTES = (size_t)NTOK * 5632 * 2;

constexpr size_t O_YP = 0, O_YS = 16777216, O_PSSM = O_YS + 524288, O_PSSDC = O_PSSM + 1048576, O_PSCC = O_PSSDC + 73728,
                 O_PK = O_PSCC + 32768, O_PV = O_PK + 524288, O_PFFC = O_PV + 524288, O_SSSM = O_PFFC + 180224,
                 O_SSSDC = O_SSSM + 33554432, O_SSCC = O_SSSDC + 2359296, O_SK = O_SSCC + 1048576, O_SV = O_SK + 16777216,
                 O_SFFC = O_SV + 16777216, O_SGMV = O_SFFC + 5767168, O_END = O_SGMV + 2097152;

struct Params { const float* in[34]; float* out; unsigned char* ws; int ph_lo, ph_hi; };

constexpr int LDS_BYTES = 155648;

__device__ __forceinline__ float bf2f(bf16_t v) { return __uint_as_float((unsigned)v << 16); }
__device__ __forceinline__ float bflo(unsigned v) { return __uint_as_float(v << 16); }
__device__ __forceinline__ float bfhi(unsigned v) { return __uint_as_float(v & 0xffff0000u); }
__device__ __forceinline__ unsigned pk2(float lo, float hi) { unsigned r; asm("v_cvt_pk_bf16_f32 %0, %1, %2" : "=v"(r) : "v"(lo), "v"(hi)); return r; }
__device__ __forceinline__ bf16_t f2bf(float f) { return (bf16_t)(pk2(f, 0.f) & 0xffffu); }
__device__ __forceinline__ float shx(float v, int o, int lane) { return __int_as_float(__builtin_amdgcn_ds_bpermute((lane ^ o) << 2, __float_as_int(v))); }
__device__ __forceinline__ float wave_sum(float v, int lane) {
#pragma unroll
    for (int o = 32; o > 0; o >>= 1) v += shx(v, o, lane);
    return v;
}
__device__ __forceinline__ int otid() { int t = threadIdx.x; asm volatile("" : "+v"(t)); return t; }
__device__ __forceinline__ float sigmoidf_(float x) { return __builtin_amdgcn_rcpf(1.f + __expf(-x)); }
__device__ __forceinline__ float siluf_(float x) { return x * __builtin_amdgcn_rcpf(1.f + __expf(-x)); }
__device__ __forceinline__ float geluf_(float x) { const float u = 0.7978845608f * (x + 0.044715f * x * x * x); return x / (1.f + __expf(-2.f * u)); }
__device__ __forceinline__ float softplusf_(float x) { return fmaxf(x, 0.f) + log1pf(__expf(-fabsf(x))); }
__device__ __forceinline__ float silu_fast(float x) { return x * __builtin_amdgcn_rcpf(1.f + __expf(-x)); }
__device__ __forceinline__ float sigmoid_fast(float x) { return __builtin_amdgcn_rcpf(1.f + __expf(-x)); }
__device__ __forceinline__ float gelu_fast(float x) { const float u = 0.7978845608f * (x + 0.044715f * x * x * x); return x * __builtin_amdgcn_rcpf(1.f + __expf(-2.f * u)); }
__device__ __forceinline__ int cond_row(int r) { return r < NPR ? (r >> 12) : 4 + ((r - NPR) >> 2); }
__device__ __forceinline__ int seq_start(int r) { return r < NPR ? (r & ~4095) : NPR + ((r - NPR) & ~3); }

constexpr int BM = 256, BK = 64, HALF = 128, HTB = HALF * BK * 2;
__device__ __forceinline__ int lds_byte(int r, int c) { const int st = (r >> 4) * 2 + (c >> 5), rr = r & 15, cc = c & 31, ob = rr * 64 + cc * 2; return st * 1024 + (ob ^ (((ob >> 9) & 1) << 5)); }
__device__ __forceinline__ void stage_rc(int b, int& R, int& C) { const int st = b / 1024, sb = b % 1024, swz = sb ^ (((sb >> 9) & 1) << 5); R = (st >> 1) * 16 + swz / 64; C = (st & 1) * 32 + (swz % 64) / 2; }
__device__ __forceinline__ int perm32(int rho) { const int n = rho >> 4, i = rho & 15; return 8 * (i >> 2) + 4 * n + (i & 3); }

struct Unit { int pm, pn, z; };
struct Gemm { const bf16_t* A; const bf16_t* Bt; int lda, ldb, K, nM, nN; int ao0, ao1, ao2, ao3; size_t zB; };
__device__ __forceinline__ int gemm_aofs(const Gemm& g, int z) { return z == 0 ? g.ao0 : (z == 1 ? g.ao1 : (z == 2 ? g.ao2 : g.ao3)); }

template <int ZN> __device__ __forceinline__ bool unit_next(const Gemm& g, int i, Unit& u) {
    const int tile = i / ZN; u.z = i - tile * ZN;
    const long L = (long)tile * gridDim.x + blockIdx.x; const int nwg = g.nM * g.nN; if (L >= nwg) return false;
    int wgid = (int)L; { const int q = nwg / 8, r = nwg % 8, xcd = wgid % 8, off = wgid / 8; wgid = (xcd < r ? xcd * (q + 1) : r * (q + 1) + (xcd - r) * q) + off; }
    const int nig = 8 * g.nN, gid = wgid / nig, fm = gid * 8, gsz = (g.nM - fm) < 8 ? (g.nM - fm) : 8;
    u.pm = fm + ((wgid % nig) % gsz); u.pn = (wgid % nig) / gsz; return true;
}

template <class Epi, int ZN>
__device__ __forceinline__ void gemm_phase(LAS unsigned char* lds, const Gemm g, const Epi& E) {
    const int tid = otid(), wid = __builtin_amdgcn_readfirstlane(tid >> 6), lane = tid & 63, wr = wid >> 2, wc = wid & 3, fr = lane & 15, fq = lane >> 4;
    const int K = g.K, nt = K / BK;
    unsigned voffA[2], voffB[2];
#pragma unroll
    for (int i = 0; i < 2; ++i) { int R, C; stage_rc(tid * 16 + i * 8192, R, C); const int Rb = Epi::PERM ? ((R & ~31) + perm32(R & 31)) : R;
        voffA[i] = (unsigned)(R * g.lda + C) * 2u; voffB[i] = (unsigned)(Rb * g.ldb + C) * 2u; }
    const size_t kstep = (size_t)(BK * 2);
    const size_t hstepA = (size_t)HALF * g.lda * 2, hstepB = (size_t)HALF * g.ldb * 2;
    const size_t tstepA = 2 * hstepA, tstepB = 2 * hstepB;
    const unsigned ldsw = (unsigned)wid * 1024u;
    const int aoff = lds_byte(wr * 64 + fr, fq * 8), boff = lds_byte(wc * 32 + fr, fq * 8);
#define PG8_SA(b, h) (((b) * 2 + (h)) * HTB)
#define PG8_SB(b, h) ((4 + (b) * 2 + (h)) * HTB)
#define PG8_STAGE(bufoff, gbase, voff) do { _Pragma("unroll") for (int _i = 0; _i < 2; ++_i) \
        __builtin_amdgcn_global_load_lds((const unsigned*)((const char*)(gbase) + (voff)[_i]), (LAS unsigned*)(lds + (bufoff) + ldsw + _i * 8192), 16, 0, 0); } while (0)
#define PG8_LDA(dst, b, h) do { _Pragma("unroll") for (int m = 0; m < 4; ++m) _Pragma("unroll") for (int k = 0; k < 2; ++k) dst[m][k] = *(const LAS bf16x8*)(lds + PG8_SA(b, h) + aoff + m * 2048 + k * 1024); } while (0)
#define PG8_LDB(dst, b, h) do { _Pragma("unroll") for (int n = 0; n < 2; ++n) _Pragma("unroll") for (int k = 0; k < 2; ++k) dst[n][k] = *(const LAS bf16x8*)(lds + PG8_SB(b, h) + boff + n * 2048 + k * 1024); } while (0)
#define PG8_MMA(ai, bj, At, Bt) do { __builtin_amdgcn_s_setprio(1); _Pragma("unroll") for (int m = 0; m < 4; ++m) _Pragma("unroll") for (int n = 0; n < 2; ++n) _Pragma("unroll") for (int k = 0; k < 2; ++k) \
        acc[ai][bj][m][n] = __builtin_amdgcn_mfma_f32_16x16x32_bf16(Bt[n][k], At[m][k], acc[ai][bj][m][n], 0, 0, 0); __builtin_amdgcn_s_setprio(0); } while (0)
#define PG8_WAIT_V(n) asm volatile("s_waitcnt vmcnt(" #n ")" ::: "memory")
#define PG8_WAIT_L(n) asm volatile("s_waitcnt lgkmcnt(" #n ")" ::: "memory")
#define PG8_BAR __builtin_amdgcn_s_barrier()
#define PG8_SCHED __builtin_amdgcn_sched_barrier(0)
    Unit cur, nxt; int ui = 0;
    if (!unit_next<ZN>(g, 0, cur)) return;
    f32x4 acc[2][2][4][2];
#pragma unroll
    for (int a = 0; a < 2; ++a)
#pragma unroll
        for (int b = 0; b < 2; ++b)
#pragma unroll
            for (int m = 0; m < 4; ++m)
#pragma unroll
                for (int n = 0; n < 2; ++n) acc[a][b][m][n] = (f32x4){0.f, 0.f, 0.f, 0.f};
    bf16x8 At[4][2], B0[2][2], B1[2][2];
    const char* cA = (const char*)g.A + (size_t)cur.pm * tstepA + (size_t)gemm_aofs(g, cur.z) * 2;
    const char* cB = (const char*)g.Bt + (size_t)cur.pn * tstepB + (size_t)cur.z * g.zB * 2;
    PG8_WAIT_V(0);
    PG8_STAGE(PG8_SB(0, 0), cB, voffB); PG8_STAGE(PG8_SA(0, 0), cA, voffA); PG8_STAGE(PG8_SB(0, 1), cB + hstepB, voffB); PG8_STAGE(PG8_SA(0, 1), cA + hstepA, voffA);
    if (wr == 1) PG8_BAR;
    PG8_WAIT_V(4); PG8_BAR;
    PG8_STAGE(PG8_SB(1, 0), cB + kstep, voffB); PG8_STAGE(PG8_SA(1, 0), cA + kstep, voffA); PG8_STAGE(PG8_SB(1, 1), cB + hstepB + kstep, voffB);
    PG8_WAIT_V(6); PG8_BAR;
    for (;;) {
        const bool has_next = unit_next<ZN>(g, ui + 1, nxt);
        const char* nA = has_next ? (const char*)g.A + (size_t)nxt.pm * tstepA + (size_t)gemm_aofs(g, nxt.z) * 2 : cA;
        const char* nB = has_next ? (const char*)g.Bt + (size_t)nxt.pn * tstepB + (size_t)nxt.z * g.zB * 2 : cB;
        for (int t = 0; t < nt; t += 2) {
            const bool last = (t == nt - 2);
            const char* a1 = cA + (size_t)(t + 1) * kstep;
            const char* a2 = last ? nA : cA + (size_t)(t + 2) * kstep; const char* b2 = last ? nB : cB + (size_t)(t + 2) * kstep;
            const char* a3 = a2 + kstep; const char* b3 = b2 + kstep;
            PG8_LDB(B0, 0, 0); PG8_SCHED; PG8_LDA(At, 0, 0); PG8_STAGE(PG8_SA(1, 1), a1 + hstepA, voffA);
            PG8_WAIT_L(8); PG8_BAR; PG8_WAIT_L(0); PG8_MMA(0, 0, At, B0); PG8_BAR; PG8_SCHED;
            PG8_LDB(B1, 0, 1); PG8_STAGE(PG8_SB(0, 0), b2, voffB);
            PG8_BAR; PG8_WAIT_L(0); PG8_MMA(0, 1, At, B1); PG8_BAR;
            PG8_LDA(At, 0, 1); PG8_STAGE(PG8_SA(0, 0), a2, voffA);
            PG8_BAR; PG8_WAIT_L(0); PG8_MMA(1, 0, At, B0); PG8_BAR; PG8_SCHED;
            PG8_STAGE(PG8_SB(0, 1), b2 + hstepB, voffB);
            PG8_WAIT_V(6); PG8_BAR; PG8_MMA(1, 1, At, B1); PG8_BAR;
            PG8_LDB(B0, 1, 0); PG8_SCHED; PG8_LDA(At, 1, 0); PG8_STAGE(PG8_SA(0, 1), a2 + hstepA, voffA);
            PG8_WAIT_L(8); PG8_BAR; PG8_WAIT_L(0); PG8_MMA(0, 0, At, B0); PG8_BAR; PG8_SCHED;
            PG8_LDB(B1, 1, 1); PG8_STAGE(PG8_SB(1, 0), b3, voffB);
            PG8_BAR; PG8_WAIT_L(0); PG8_MMA(0, 1, At, B1); PG8_BAR;
            PG8_LDA(At, 1, 1); PG8_STAGE(PG8_SA(1, 0), a3, voffA);
            PG8_BAR; PG8_WAIT_L(0); PG8_MMA(1, 0, At, B0); PG8_BAR; PG8_SCHED;
            PG8_STAGE(PG8_SB(1, 1), b3 + hstepB, voffB);
            PG8_WAIT_V(6); PG8_BAR; PG8_MMA(1, 1, At, B1); PG8_BAR;
        }
        E(acc, cur, wr, wc, fr, fq);
        if (!has_next) break;
#pragma unroll
        for (int a = 0; a < 2; ++a)
#pragma unroll
            for (int b = 0; b < 2; ++b)
#pragma unroll
                for (int m = 0; m < 4; ++m)
#pragma unroll
                    for (int n = 0; n < 2; ++n) acc[a][b][m][n] = (f32x4){0.f, 0.f, 0.f, 0.f};
        cur = nxt; cA = nA; cB = nB; ++ui;
    }
    PG8_WAIT_V(0);
    if (wr == 0) PG8_BAR;
    PG8_BAR;
#undef PG8_SA
#undef PG8_SB
#undef PG8_STAGE
#undef PG8_LDA
#undef PG8_LDB
#undef PG8_MMA
#undef PG8_WAIT_V
#undef PG8_WAIT_L
#undef PG8_BAR
#undef PG8_SCHED
}

struct EpiMod {
    static constexpr bool PERM = false;
    float* mod; const float* bada;
    __device__ __forceinline__ void operator()(const f32x4 (&acc)[2][2][4][2], const Unit& u, int wr, int wc, int fr, int fq) const {
        f32x4 bv[2][2];
#pragma unroll
        for (int bj = 0; bj < 2; ++bj)
#pragma unroll
            for (int n = 0; n < 2; ++n) bv[bj][n] = *(const f32x4*)(bada + u.pn * BM + bj * HALF + wc * 32 + n * 16 + fq * 4);
#pragma unroll
        for (int ai = 0; ai < 2; ++ai)
#pragma unroll
            for (int m = 0; m < 4; ++m) { const int r = u.pm * BM + ai * HALF + wr * 64 + m * 16 + fr; if (r >= NCOND) continue;
#pragma unroll
                for (int bj = 0; bj < 2; ++bj)
#pragma unroll
                    for (int n = 0; n < 2; ++n) { const int c = u.pn * BM + bj * HALF + wc * 32 + n * 16 + fq * 4; const int layer = c / 6144, cc = c - layer * 6144;
                        *(f32x4*)(mod + ((size_t)(layer * NCOND + r)) * 6144 + cc) = acc[ai][bj][m][n] + bv[bj][n]; } }
    }
};
struct EpiProj {
    static constexpr bool PERM = true;
    bf16_t* O;
    __device__ __forceinline__ void operator()(const f32x4 (&acc)[2][2][4][2], const Unit& u, int wr, int wc, int fr, int fq) const {
#pragma unroll
        for (int bj = 0; bj < 2; ++bj) { const int c = u.pn * BM + bj * HALF + wc * 32 + fq * 8; const int mode = (c >= C_UV + 1024 && c < C_GATE) ? 1 : 0;
#pragma unroll
            for (int ai = 0; ai < 2; ++ai)
#pragma unroll
                for (int m = 0; m < 4; ++m) { const int r = u.pm * BM + ai * HALF + wr * 64 + m * 16 + fr;
                    float v[8];
#pragma unroll
                    for (int i = 0; i < 8; ++i) { float x = acc[ai][bj][m][i >> 2][i & 3]; v[i] = (mode == 1 ? gelu_fast(x) : x); }
                    u32x4 o; o[0] = pk2(v[0], v[1]); o[1] = pk2(v[2], v[3]); o[2] = pk2(v[4], v[5]); o[3] = pk2(v[6], v[7]);
                    *(u32x4*)(O + (size_t)r * LDP + c) = o; } }
    }
};
struct EpiUp {
    static constexpr bool PERM = true;
    bf16_t* O;
    __device__ __forceinline__ void operator()(const f32x4 (&acc)[2][2][4][2], const Unit& u, int wr, int wc, int fr, int fq) const {
#pragma unroll
        for (int bj = 0; bj < 2; ++bj) { const int c = u.pn * BM + bj * HALF + wc * 32 + fq * 8;
#pragma unroll
            for (int ai = 0; ai < 2; ++ai)
#pragma unroll
                for (int m = 0; m < 4; ++m) { const int r = u.pm * BM + ai * HALF + wr * 64 + m * 16 + fr;
                    const f32x4 a = acc[ai][bj][m][0], b = acc[ai][bj][m][1];
                    u32x4 o; o[0] = pk2(a[0], a[1]); o[1] = pk2(a[2], a[3]); o[2] = pk2(b[0], b[1]); o[3] = pk2(b[2], b[3]);
                    *(u32x4*)(O + (size_t)r * 5632 + c) = o; } }
    }
};
struct EpiBranch {
    static constexpr bool PERM = true;
    const bf16_t* proj; float* msum; bf16_t* merged;
    __device__ __forceinline__ void operator()(const f32x4 (&acc)[2][2][4][2], const Unit& u, int wr, int wc, int fr, int fq) const {
        const int z = u.z;
        u32x4 gt[2][2], pv[2][2];
        const int c0 = u.pn * BM + wc * 32 + fq * 8, r0 = u.pm * BM + wr * 64 + fr;
#define EB_LOAD(k, buf) do { const int bj_ = (k) >> 2, ai_ = ((k) >> 1) & 1, m0_ = ((k) & 1) * 2; _Pragma("unroll") for (int mm = 0; mm < 2; ++mm) { const int r = r0 + ai_ * HALF + (m0_ + mm) * 16, c = c0 + bj_ * HALF; \
            gt[buf][mm] = *(const u32x4*)(proj + (size_t)r * LDP + C_GATE + z * 1024 + c); pv[buf][mm] = (u32x4){0u, 0u, 0u, 0u}; \
            if (z > 0) pv[buf][mm] = *(const u32x4*)(merged + (size_t)r * 1024 + c); } } while (0)
        EB_LOAD(0, 0);
#pragma unroll
        for (int k = 0; k < 8; ++k) { const int bj = k >> 2, ai = (k >> 1) & 1, m0 = (k & 1) * 2, buf = k & 1;
            if (k < 7) { if (buf == 0) EB_LOAD(k + 1, 1); else EB_LOAD(k + 1, 0); }
#pragma unroll
            for (int mm = 0; mm < 2; ++mm) { const int m = m0 + mm; const int r = r0 + ai * HALF + m * 16, c = c0 + bj * HALF;
                const f32x4 a = acc[ai][bj][m][0], b = acc[ai][bj][m][1]; const u32x4 gv = gt[buf][mm], p = pv[buf][mm];
                u32x4 o;
                o[0] = pk2(bflo(p[0]) + sigmoid_fast(bflo(gv[0])) * a[0], bfhi(p[0]) + sigmoid_fast(bfhi(gv[0])) * a[1]); o[1] = pk2(bflo(p[1]) + sigmoid_fast(bflo(gv[1])) * a[2], bfhi(p[1]) + sigmoid_fast(bfhi(gv[1])) * a[3]);
                o[2] = pk2(bflo(p[2]) + sigmoid_fast(bflo(gv[2])) * b[0], bfhi(p[2]) + sigmoid_fast(bfhi(gv[2])) * b[1]); o[3] = pk2(bflo(p[3]) + sigmoid_fast(bflo(gv[3])) * b[2], bfhi(p[3]) + sigmoid_fast(bfhi(gv[3])) * b[3]);
                *(u32x4*)(merged + (size_t)r * 1024 + c) = o; } }
#undef EB_LOAD
    }
};
struct EpiResid {
    static constexpr bool PERM = false;
    const float* xin_p; const float* xin_s; float* xout; const float* ga;
    __device__ __forceinline__ void operator()(const f32x4 (&acc)[2][2][4][2], const Unit& u, int wr, int wc, int fr, int fq) const {
        const float* gr = ga + (size_t)(u.pm >> 4) * 6144;
        f32x4 gv[2][2];
#pragma unroll
        for (int bj = 0; bj < 2; ++bj)
#pragma unroll
            for (int n = 0; n < 2; ++n) gv[bj][n] = *(const f32x4*)(gr + u.pn * BM + bj * HALF + wc * 32 + n * 16 + fq * 4);
#pragma unroll
        for (int am = 0; am < 4; ++am) { const int ai = am >> 1, m0 = (am & 1) * 2;
            f32x4 xv[2][2][2];
#pragma unroll
            for (int mm = 0; mm < 2; ++mm) { const int r = u.pm * BM + ai * HALF + wr * 64 + (m0 + mm) * 16 + fr;
#pragma unroll
                for (int bj = 0; bj < 2; ++bj)
#pragma unroll
                    for (int n = 0; n < 2; ++n) xv[mm][bj][n] = *(const f32x4*)(xin_p + (size_t)r * 1024 + u.pn * BM + bj * HALF + wc * 32 + n * 16 + fq * 4); }
#pragma unroll
            for (int mm = 0; mm < 2; ++mm) { const int r = u.pm * BM + ai * HALF + wr * 64 + (m0 + mm) * 16 + fr;
#pragma unroll
                for (int bj = 0; bj < 2; ++bj)
#pragma unroll
                    for (int n = 0; n < 2; ++n) *(f32x4*)(xout + (size_t)r * 1024 + u.pn * BM + bj * HALF + wc * 32 + n * 16 + fq * 4) = xv[mm][bj][n] + gv[bj][n] * acc[ai][bj][m0 + mm][n]; } }
    }
};

struct CTile { const float* src; bf16_t* dst; int K, N, k0, n0; };
__device__ __forceinline__ CTile conv_decode(const Params& P, int t) {
    constexpr int T_IN = 3392, T_BR = 1024, T_O = 256, T_UP = 1408, T_DN = 704, T_ADA = 1536, T_L = T_IN + T_BR + T_O + T_UP + T_DN + T_ADA;
    const int layer = t / T_L; int r = t - layer * T_L; CTile c;
    if (r < T_IN) { c.src = P.in[13] + (size_t)layer * 1024 * 13328; c.dst = (bf16_t*)(P.ws + WS_WIN) + (size_t)layer * 13568 * 1024; c.K = 1024; c.N = 13328; c.k0 = (r / 212) * 64; c.n0 = (r % 212) * 64; return c; }
    r -= T_IN;
    if (r < T_BR) { const int br = r >> 8, q = r & 255; c.src = P.in[26] + (size_t)(layer * 4 + br) * 1048576; c.dst = (bf16_t*)(P.ws + WS_WBR) + (size_t)(layer * 4 + br) * 1048576; c.K = 1024; c.N = 1024; c.k0 = (q >> 4) * 64; c.n0 = (q & 15) * 64; return c; }
    r -= T_BR;
    if (r < T_O) { c.src = P.in[27] + (size_t)layer * 1048576; c.dst = (bf16_t*)(P.ws + WS_WO) + (size_t)layer * 1048576; c.K = 1024; c.N = 1024; c.k0 = (r >> 4) * 64; c.n0 = (r & 15) * 64; return c; }
    r -= T_O;
    if (r < T_UP) { c.src = P.in[29] + (size_t)layer * 1024 * 5632; c.dst = (bf16_t*)(P.ws + WS_WUP) + (size_t)layer * 5632 * 1024; c.K = 1024; c.N = 5632; c.k0 = (r / 88) * 64; c.n0 = (r % 88) * 64; return c; }
    r -= T_UP;
    if (r < T_DN) { c.src = P.in[32] + (size_t)layer * 2816 * 1024; c.dst = (bf16_t*)(P.ws + WS_WDN) + (size_t)layer * 1024 * 2816; c.K = 2816; c.N = 1024; c.k0 = (r >> 4) * 64; c.n0 = (r & 15) * 64; return c; }
    r -= T_DN;
    c.src = P.in[10] + (size_t)layer * 1024 * 6144; c.dst = (bf16_t*)(P.ws + WS_WADA) + (size_t)layer * 6144 * 1024; c.K = 1024; c.N = 6144; c.k0 = (r / 96) * 64; c.n0 = (r % 96) * 64; return c;
}
__device__ __forceinline__ void phase_convert(const Params& P, float* T) {
    constexpr int NT = 4 * 8320;
    const int tid = otid();
    int t = blockIdx.x;
    CTile cur = conv_decode(P, t < NT ? t : 0);
    float v[8], nv[8];
#pragma unroll
    for (int e = 0; e < 8; ++e) { const int idx = tid + e * 512, k = idx >> 6, n = idx & 63; v[e] = (t < NT && cur.n0 + n < cur.N) ? cur.src[(size_t)(cur.k0 + k) * cur.N + cur.n0 + n] : 0.f; }
    for (; t < NT; t += gridDim.x) {
        const int tn = t + gridDim.x; const bool hn = tn < NT; const CTile nxt = conv_decode(P, hn ? tn : 0);
#pragma unroll
        for (int e = 0; e < 8; ++e) { const int idx = tid + e * 512, k = idx >> 6, n = idx & 63; nv[e] = (hn && nxt.n0 + n < nxt.N) ? nxt.src[(size_t)(nxt.k0 + k) * nxt.N + nxt.n0 + n] : 0.f; }
#pragma unroll
        for (int e = 0; e < 8; ++e) { const int idx = tid + e * 512, k = idx >> 6, n = idx & 63; T[k * 65 + n] = v[e]; }
        __syncthreads();
        { const int n = tid >> 3, kc = (tid & 7) * 8; float x[8];
#pragma unroll
          for (int j = 0; j < 8; ++j) x[j] = T[(kc + j) * 65 + n];
          u32x4 o; o[0] = pk2(x[0], x[1]); o[1] = pk2(x[2], x[3]); o[2] = pk2(x[4], x[5]); o[3] = pk2(x[6], x[7]);
          *(u32x4*)(cur.dst + (size_t)(cur.n0 + n) * cur.K + cur.k0 + kc) = o; }
        __syncthreads();
#pragma unroll
        for (int e = 0; e < 8; ++e) v[e] = nv[e];
        cur = nxt;
    }
    bf16_t* cact = (bf16_t*)(P.ws + WS_CACT);
    for (int i = blockIdx.x * 512 + otid(); i < 256 * 1024; i += gridDim.x * 512) {
        const int r = i >> 10, c = i & 1023; float v = 0.f;
        if (r < 4) v = siluf_(P.in[2][r * 1024 + c]); else if (r < NCOND) v = siluf_(P.in[3][(r - 4) * 1024 + c]);
        cact[i] = f2bf(v);
    }
}

__device__ __forceinline__ void phase_norm(const float* xp, const float* xs, const float* g, const float* modL, int shofs, int scofs, bf16_t* hout) {
    const int tid = otid(); const int w = tid >> 6, lane = tid & 63;
    for (int r = blockIdx.x * 8 + w; r < NTOK; r += gridDim.x * 8) {
        const float* x = r < NPR ? xp + (size_t)r * 1024 : xs + (size_t)(r - NPR) * 1024;
        const float* mr = modL + (size_t)cond_row(r) * 6144;
        f32x4 v[4]; float ss = 0.f;
#pragma unroll
        for (int i = 0; i < 4; ++i) { v[i] = *(const f32x4*)(x + i * 256 + lane * 4); ss += v[i][0] * v[i][0] + v[i][1] * v[i][1] + v[i][2] * v[i][2] + v[i][3] * v[i][3]; }
        ss = wave_sum(ss, lane); const float rs = rsqrtf(ss * (1.f / 1024.f) + EPSF);
#pragma unroll
        for (int i = 0; i < 4; ++i) { const int c = i * 256 + lane * 4;
            const f32x4 gv = *(const f32x4*)(g + c), sc = *(const f32x4*)(mr + scofs + c), sh = *(const f32x4*)(mr + shofs + c);
            f32x4 o = v[i] * rs * gv * (sc + 1.f) + sh;
            u32x2 pk; pk[0] = pk2(o[0], o[1]); pk[1] = pk2(o[2], o[3]);
            *(u32x2*)(hout + (size_t)r * 1024 + c) = pk; }
    }
}
__device__ __forceinline__ void phase_final_norm(float* x, const float* g) {
    const int tid = otid(); const int w = tid >> 6, lane = tid & 63;
    for (int r = blockIdx.x * 8 + w; r < NTOK; r += gridDim.x * 8) {
        float* xr = x + (size_t)r * 1024; f32x4 v[4]; float ss = 0.f;
#pragma unroll
        for (int i = 0; i < 4; ++i) { v[i] = *(const f32x4*)(xr + i * 256 + lane * 4); ss += v[i][0] * v[i][0] + v[i][1] * v[i][1] + v[i][2] * v[i][2] + v[i][3] * v[i][3]; }
        ss = wave_sum(ss, lane); const float rs = rsqrtf(ss * (1.f / 1024.f) + EPSF);
#pragma unroll
        for (int i = 0; i < 4; ++i) { const int c = i * 256 + lane * 4; const f32x4 gv = *(const f32x4*)(g + c); *(f32x4*)(xr + c) = v[i] * rs * gv; }
    }
}

template <int MODE>
__device__ __forceinline__ void ssd_item(const Params& P, int layer, int item, float* L) {
    const int tid = otid(), w = tid >> 6, lane = tid & 63;
    bf16_t* proj = (bf16_t*)(P.ws + WS_PROJ);
    float* states = (float*)(P.ws + WS_SSDST); float* decs = (float*)(P.ws + WS_SSDDEC);
    int r0, nsteps, half, seq0, b = 0, c = 0, sb = 0;
    if (MODE == 2) { sb = item >> 1; half = item & 1; r0 = NPR + sb * 4; nsteps = 4; seq0 = r0; }
    else { b = item >> 6; c = (item >> 1) & 31; half = item & 1; r0 = b * 4096 + c * 128; nsteps = 128; seq0 = b * 4096; }
    float* XS = L; float* ZS = XS + 16 * 512; float* BS = ZS + 16 * 512; float* CS = BS + 16 * 128; float* DTS = CS + 16 * 128; float* DAS = DTS + 128; float* SSQ = DAS + 128;
    const float* cw = P.in[14] + (size_t)layer * 4 * 1536; const float* cb = P.in[15] + (size_t)layer * 1536;
    const float* prev = P.in[5] + ((size_t)(layer * 128 + sb)) * 3 * 1536;
    const int hd = half * 8 + w, gl = w >> 2;
    float h[64];
    if (MODE == 0) {
#pragma unroll
        for (int n = 0; n < 64; ++n) h[n] = 0.f;
    } else {
        const float* s0p = (MODE == 1) ? states + ((size_t)((b * 32 + c) * 16 + hd)) * 4096 + lane * 64
                                       : P.in[4] + ((size_t)((layer * 128 + sb) * 16 + hd)) * 4096 + lane * 64;
#pragma unroll
        for (int n4 = 0; n4 < 16; ++n4) { const f32x4 v = *(const f32x4*)(s0p + n4 * 4); h[n4 * 4] = v[0]; h[n4 * 4 + 1] = v[1]; h[n4 * 4 + 2] = v[2]; h[n4 * 4 + 3] = v[3]; }
    }
    const float Dh = P.in[18][layer * 16 + hd];
    float decp = 1.f;
    for (int s0 = 0; s0 < nsteps; s0 += 16) {
        const int ns = (nsteps - s0) < 16 ? (nsteps - s0) : 16;
        __syncthreads();
        for (int idx = tid; idx < ns * 768; idx += 512) {
            const int t = idx / 768, ch = idx - t * 768;
            int cx;
            if (ch < 512) cx = half * 512 + ch; else if (ch < 640) cx = 1024 + half * 128 + (ch - 512); else cx = 1280 + half * 128 + (ch - 640);
            float a = cb[cx];
#pragma unroll
            for (int k = 0; k < 4; ++k) { const int step = s0 + t - 3 + k, rr = r0 + step; float raw;
                if (rr >= seq0) raw = bf2f(proj[(size_t)rr * LDP + C_XBC + cx]);
                else raw = (MODE == 2) ? prev[(3 + step) * 1536 + cx] : 0.f;
                a += cw[k * 1536 + cx] * raw; }
            a = siluf_(a);
            if (ch < 512) { XS[t * 512 + ch] = a; if (MODE != 0) ZS[t * 512 + ch] = bf2f(proj[(size_t)(r0 + s0 + t) * LDP + C_Z + cx]); }
            else if (ch < 640) BS[t * 128 + ch - 512] = a; else CS[t * 128 + ch - 640] = a;
        }
        if (tid < ns * 8) { const int t = tid >> 3, ww = tid & 7, hh = half * 8 + ww;
            const float dt = softplusf_(bf2f(proj[(size_t)(r0 + s0 + t) * LDP + C_DTR + hh]) + P.in[16][layer * 16 + hh]);
            DTS[t * 8 + ww] = dt; DAS[t * 8 + ww] = __expf(-dt * __expf(P.in[17][layer * 16 + hh])); }
        __syncthreads();
        for (int t = 0; t < ns; ++t) {
            const float a = DAS[t * 8 + w], dt = DTS[t * 8 + w], xv = XS[t * 512 + w * 64 + lane], xd = xv * dt; decp *= a;
            const f32x4* B4 = (const f32x4*)(BS + t * 128 + gl * 64);
#pragma unroll
            for (int n4 = 0; n4 < 16; ++n4) { const f32x4 bv = B4[n4];
                h[n4 * 4] = a * h[n4 * 4] + xd * bv[0]; h[n4 * 4 + 1] = a * h[n4 * 4 + 1] + xd * bv[1]; h[n4 * 4 + 2] = a * h[n4 * 4 + 2] + xd * bv[2]; h[n4 * 4 + 3] = a * h[n4 * 4 + 3] + xd * bv[3]; }
            if (MODE != 0) {
                const f32x4* C4 = (const f32x4*)(CS + t * 128 + gl * 64); float y0 = 0.f, y1 = 0.f;
#pragma unroll
                for (int n4 = 0; n4 < 16; ++n4) { const f32x4 cv = C4[n4]; y0 += h[n4 * 4] * cv[0] + h[n4 * 4 + 2] * cv[2]; y1 += h[n4 * 4 + 1] * cv[1] + h[n4 * 4 + 3] * cv[3]; }
                float y = y0 + y1 + Dh * xv; y *= siluf_(ZS[t * 512 + w * 64 + lane]);
                const float sq = wave_sum(y * y, lane); if (lane == 0) SSQ[(s0 + t) * 8 + w] = sq;
                proj[(size_t)(r0 + s0 + t) * LDP + C_Z + hd * 64 + lane] = f2bf(y);
            }
        }
    }
    if (MODE == 0) {
        float* sp = states + ((size_t)((b * 32 + c) * 16 + hd)) * 4096 + lane * 64;
#pragma unroll
        for (int n4 = 0; n4 < 16; ++n4) *(f32x4*)(sp + n4 * 4) = (f32x4){h[n4 * 4], h[n4 * 4 + 1], h[n4 * 4 + 2], h[n4 * 4 + 3]};
        if (lane == 0) decs[(b * 32 + c) * 16 + hd] = decp;
    }
    if (MODE == 2) {
        float* sp = P.out + O_SSSM + ((size_t)((layer * 128 + sb) * 16 + hd)) * 4096 + lane * 64;
#pragma unroll
        for (int n4 = 0; n4 < 16; ++n4) *(f32x4*)(sp + n4 * 4) = (f32x4){h[n4 * 4], h[n4 * 4 + 1], h[n4 * 4 + 2], h[n4 * 4 + 3]};
    }
    if (MODE != 0) {
        __syncthreads();
        const float ng = P.in[19][layer * 1024 + hd * 64 + lane];
        for (int t = 0; t < nsteps; ++t) {
            const float tot = SSQ[t * 8 + gl * 4] + SSQ[t * 8 + gl * 4 + 1] + SSQ[t * 8 + gl * 4 + 2] + SSQ[t * 8 + gl * 4 + 3];
            const float sc = rsqrtf(tot * (1.f / 256.f) + EPSF) * ng;
            bf16_t* ap = proj + (size_t)(r0 + t) * LDP + C_Z + hd * 64 + lane; *ap = f2bf(bf2f(*ap) * sc);
        }
    }
}

__device__ __forceinline__ int xt_idx(int row, int t) { return row * 136 + ((((t >> 3) ^ ((row >> 3) & 15)) << 3) | (t & 7)); }
__device__ __forceinline__ void ssd_stage_dt(const Params& P, int layer, const bf16_t* proj, size_t r0, int g, float* DT, float* ACS, int tid) {
    { const int hh = tid >> 7, t = tid & 127, hd = g * 4 + hh;
      const float dt = softplusf_(bf2f(proj[(r0 + t) * LDP + C_DTR + hd]) + P.in[16][layer * 16 + hd]);
      DT[hh * 128 + t] = dt; ACS[hh * 128 + t] = -dt * __expf(P.in[17][layer * 16 + hd]); }
    __syncthreads();
    if (tid < 256) { const int hh = tid >> 6, l = tid & 63; const float a0 = ACS[hh * 128 + 2 * l], a1 = ACS[hh * 128 + 2 * l + 1]; float sum = a0 + a1;
#pragma unroll
        for (int o = 1; o < 64; o <<= 1) { const float v = __int_as_float(__builtin_amdgcn_ds_bpermute(((l - o) & 63) << 2, __float_as_int(sum))); if (l >= o) sum += v; }
        ACS[hh * 128 + 2 * l] = sum - a1; ACS[hh * 128 + 2 * l + 1] = sum; }
    __syncthreads();
}
template <int PASS>
__device__ __forceinline__ void ssd_stage_conv(const Params& P, int layer, const bf16_t* proj, size_t r0, bool first, int g, const float* DT, const float* ACS, bf16_t* XT4, bf16_t* Bx, bf16_t* Cs, int tid) {
    const int slot = tid & 63, seg = tid >> 6;
    if (slot < (PASS ? 48 : 40)) {
        int cx; if (slot < 32) cx = g * 256 + slot * 8; else if (slot < 40) cx = 1024 + g * 64 + (slot - 32) * 8; else cx = 1280 + g * 64 + (slot - 40) * 8;
        const float* cw = P.in[14] + (size_t)layer * 4 * 1536 + cx; const float* cb = P.in[15] + (size_t)layer * 1536 + cx;
        float wt[4][8], bb[8], win[3][8];
#pragma unroll
        for (int k = 0; k < 4; ++k) { const f32x4 a = *(const f32x4*)(cw + k * 1536), c = *(const f32x4*)(cw + k * 1536 + 4);
#pragma unroll
            for (int i = 0; i < 4; ++i) { wt[k][i] = a[i]; wt[k][4 + i] = c[i]; } }
        { const f32x4 a = *(const f32x4*)cb, c = *(const f32x4*)(cb + 4);
#pragma unroll
          for (int i = 0; i < 4; ++i) { bb[i] = a[i]; bb[4 + i] = c[i]; } }
        const int t0 = seg * 16;
#pragma unroll
        for (int k = 0; k < 3; ++k) { u32x4 raw = (u32x4){0u, 0u, 0u, 0u};
            if (!(first && seg == 0)) raw = *(const u32x4*)(proj + (r0 + t0 - 3 + k) * LDP + C_XBC + cx);
#pragma unroll
            for (int i = 0; i < 4; ++i) { win[k][2 * i] = bflo(raw[i]); win[k][2 * i + 1] = bfhi(raw[i]); } }
        u32x4 cur4[4], nxt4[4];
#pragma unroll
        for (int q = 0; q < 4; ++q) { cur4[q] = *(const u32x4*)(proj + (r0 + t0 + q) * LDP + C_XBC + cx); nxt4[q] = cur4[q]; }
        for (int gq = 0; gq < 4; ++gq) {
            if (gq < 3) {
#pragma unroll
                for (int q = 0; q < 4; ++q) nxt4[q] = *(const u32x4*)(proj + (r0 + t0 + gq * 4 + 4 + q) * LDP + C_XBC + cx); }
#pragma unroll
            for (int q = 0; q < 4; ++q) {
                const int t = t0 + gq * 4 + q; const u32x4 raw = cur4[q];
                float cur[8], o[8];
#pragma unroll
                for (int i = 0; i < 4; ++i) { cur[2 * i] = bflo(raw[i]); cur[2 * i + 1] = bfhi(raw[i]); }
#pragma unroll
                for (int i = 0; i < 8; ++i) { o[i] = siluf_(bb[i] + wt[0][i] * win[0][i] + wt[1][i] * win[1][i] + wt[2][i] * win[2][i] + wt[3][i] * cur[i]); win[0][i] = win[1][i]; win[1][i] = win[2][i]; win[2][i] = cur[i]; }
                if (slot < 32) { const int hh = slot >> 3, p0 = (slot & 7) * 8; float sc = DT[hh * 128 + t]; if (PASS == 0) sc *= __expf(ACS[hh * 128 + 127] - ACS[hh * 128 + t]);
#pragma unroll
                    for (int i = 0; i < 8; ++i) XT4[xt_idx(hh * 64 + p0 + i, t)] = f2bf(o[i] * sc); }
                else if (slot < 40) { const int n0 = (slot - 32) * 8;
                    if (PASS == 0) {
#pragma unroll
                        for (int i = 0; i < 8; ++i) Bx[xt_idx(n0 + i, t)] = f2bf(o[i]); }
                    else { u32x4 pk; pk[0] = pk2(o[0], o[1]); pk[1] = pk2(o[2], o[3]); pk[2] = pk2(o[4], o[5]); pk[3] = pk2(o[6], o[7]); *(u32x4*)(Bx + t * 72 + n0) = pk; } }
                else { const int n0 = (slot - 40) * 8; u32x4 pk; pk[0] = pk2(o[0], o[1]); pk[1] = pk2(o[2], o[3]); pk[2] = pk2(o[4], o[5]); pk[3] = pk2(o[6], o[7]); *(u32x4*)(Cs + t * 72 + n0) = pk; }
            }
#pragma unroll
            for (int q = 0; q < 4; ++q) cur4[q] = nxt4[q];
        }
    }
}
__device__ __forceinline__ void ssd_pass1_item(const Params& P, int layer, int item, unsigned char* lds) {
    const int tid = otid(), w = __builtin_amdgcn_readfirstlane(tid >> 6), lane = tid & 63, fr = lane & 15, fq = lane >> 4;
    const int b = item >> 7, c = (item >> 2) & 31, g = item & 3; const size_t r0 = (size_t)b * 4096 + (size_t)c * 128;
    const bf16_t* proj = (const bf16_t*)(P.ws + WS_PROJ);
    float* states = (float*)(P.ws + WS_SSDST); float* decs = (float*)(P.ws + WS_SSDDEC);
    bf16_t* XT4 = (bf16_t*)lds; bf16_t* BT = XT4 + 256 * 136; float* DT = (float*)(BT + 64 * 136); float* ACS = DT + 512;
    __syncthreads();
    ssd_stage_dt(P, layer, proj, r0, g, DT, ACS, tid);
    ssd_stage_conv<0>(P, layer, proj, r0, c == 0, g, DT, ACS, XT4, BT, nullptr, tid);
    __syncthreads();
    const int hh = w >> 1, pb = (w & 1) * 2;
    f32x4 acc[2][4];
#pragma unroll
    for (int pi = 0; pi < 2; ++pi)
#pragma unroll
        for (int nt = 0; nt < 4; ++nt) acc[pi][nt] = (f32x4){0.f, 0.f, 0.f, 0.f};
#pragma unroll
    for (int ks = 0; ks < 4; ++ks) { bf16x8 a[2];
#pragma unroll
        for (int pi = 0; pi < 2; ++pi) a[pi] = *(const bf16x8*)(XT4 + xt_idx(hh * 64 + (pb + pi) * 16 + fr, ks * 32 + fq * 8));
#pragma unroll
        for (int nt = 0; nt < 4; ++nt) { const bf16x8 bv = *(const bf16x8*)(BT + xt_idx(nt * 16 + fr, ks * 32 + fq * 8));
#pragma unroll
            for (int pi = 0; pi < 2; ++pi) acc[pi][nt] = __builtin_amdgcn_mfma_f32_16x16x32_bf16(a[pi], bv, acc[pi][nt], 0, 0, 0); } }
    float* sp = states + ((size_t)((b * 32 + c) * 16 + g * 4 + hh)) * 4096;
#pragma unroll
    for (int pi = 0; pi < 2; ++pi)
#pragma unroll
        for (int nt = 0; nt < 4; ++nt)
#pragma unroll
            for (int j = 0; j < 4; ++j) sp[((pb + pi) * 16 + fq * 4 + j) * 64 + nt * 16 + fr] = acc[pi][nt][j];
    if (tid < 4) decs[(b * 32 + c) * 16 + g * 4 + tid] = __expf(ACS[tid * 128 + 127]);
}
__device__ __forceinline__ void ssd_pass3_item(const Params& P, int layer, int item, unsigned char* lds, bool dry = false) {
    const int tid = otid(), w = __builtin_amdgcn_readfirstlane(tid >> 6), lane = tid & 63, fr = lane & 15, fq = lane >> 4;
    const int b = item >> 7, c = (item >> 2) & 31, g = item & 3; const size_t r0 = (size_t)b * 4096 + (size_t)c * 128;
    bf16_t* proj = (bf16_t*)(P.ws + WS_PROJ);
    const float* states = (const float*)(P.ws + WS_SSDST);
    bf16_t* Cs = (bf16_t*)lds; bf16_t* Bs = Cs + 128 * 72; bf16_t* Sin = Bs; bf16_t* XT4 = Bs + 128 * 72; bf16_t* Ms = XT4 + 256 * 136; float* DT = (float*)(Ms + 128 * 136); float* ACS = DT + 512;
    __syncthreads();
    ssd_stage_dt(P, layer, proj, r0, g, DT, ACS, tid);
    ssd_stage_conv<1>(P, layer, proj, r0, c == 0, g, DT, ACS, XT4, Bs, Cs, tid);
    __syncthreads();
    f32x4 CB[8];
#pragma unroll
    for (int st = 0; st < 8; ++st) { CB[st] = (f32x4){0.f, 0.f, 0.f, 0.f};
        if (st <= w) {
#pragma unroll
            for (int ks = 0; ks < 2; ++ks) { const bf16x8 a = *(const bf16x8*)(Cs + (16 * w + fr) * 72 + ks * 32 + fq * 8), bv = *(const bf16x8*)(Bs + (16 * st + fr) * 72 + ks * 32 + fq * 8);
                CB[st] = __builtin_amdgcn_mfma_f32_16x16x32_bf16(a, bv, CB[st], 0, 0, 0); } } }
    float ssq[4] = {0.f, 0.f, 0.f, 0.f};
    const int nks = (w >> 1) + 1;
    bf16_t* zrow[4];
#pragma unroll
    for (int j = 0; j < 4; ++j) zrow[j] = proj + (r0 + 16 * w + fq * 4 + j) * LDP + C_Z + g * 256 + fr;
    f32x4 sna, snc;
    { const float* sp = states + ((size_t)((b * 32 + c) * 16 + g * 4)) * 4096 + (tid >> 3) * 64 + (tid & 7) * 8; sna = *(const f32x4*)sp; snc = *(const f32x4*)(sp + 4); }
    for (int hh = 0; hh < 4; ++hh) {
        const int hd = g * 4 + hh;
        __syncthreads();
        { const int p = tid >> 3, n0 = (tid & 7) * 8;
          u32x4 pk; pk[0] = pk2(sna[0], sna[1]); pk[1] = pk2(sna[2], sna[3]); pk[2] = pk2(snc[0], snc[1]); pk[3] = pk2(snc[2], snc[3]);
          *(u32x4*)(Sin + p * 72 + n0) = pk;
          if (hh < 3) { const float* sp = states + ((size_t)((b * 32 + c) * 16 + hd + 1)) * 4096 + p * 64 + n0; sna = *(const f32x4*)sp; snc = *(const f32x4*)(sp + 4); } }
        float acs_t[4];
#pragma unroll
        for (int j = 0; j < 4; ++j) acs_t[j] = ACS[hh * 128 + 16 * w + fq * 4 + j];
#pragma unroll
        for (int st = 0; st < 8; ++st) { if (st <= (w | 1)) { const float acs_s = ACS[hh * 128 + 16 * st + fr];
#pragma unroll
            for (int j = 0; j < 4; ++j) { const int t = 16 * w + fq * 4 + j, sx = 16 * st + fr; const float v = (st <= w && sx <= t) ? CB[st][j] * __expf(acs_t[j] - acs_s) : 0.f; Ms[t * 136 + sx] = f2bf(v); } } }
        __syncthreads();
        bf16_t zv[4][4];
#pragma unroll
        for (int j = 0; j < 4; ++j)
#pragma unroll
            for (int pt = 0; pt < 4; ++pt) zv[j][pt] = *(zrow[j] + hh * 64 + pt * 16);
        f32x4 yd[4], yo[4];
#pragma unroll
        for (int pt = 0; pt < 4; ++pt) { yd[pt] = (f32x4){0.f, 0.f, 0.f, 0.f}; yo[pt] = (f32x4){0.f, 0.f, 0.f, 0.f}; }
        for (int ks = 0; ks < nks; ++ks) { const bf16x8 a = *(const bf16x8*)(Ms + (16 * w + fr) * 136 + ks * 32 + fq * 8);
#pragma unroll
            for (int pt = 0; pt < 4; ++pt) { const bf16x8 bv = *(const bf16x8*)(XT4 + xt_idx(hh * 64 + pt * 16 + fr, ks * 32 + fq * 8)); yd[pt] = __builtin_amdgcn_mfma_f32_16x16x32_bf16(a, bv, yd[pt], 0, 0, 0); } }
#pragma unroll
        for (int ks = 0; ks < 2; ++ks) { const bf16x8 a = *(const bf16x8*)(Cs + (16 * w + fr) * 72 + ks * 32 + fq * 8);
#pragma unroll
            for (int pt = 0; pt < 4; ++pt) { const bf16x8 bv = *(const bf16x8*)(Sin + (pt * 16 + fr) * 72 + ks * 32 + fq * 8); yo[pt] = __builtin_amdgcn_mfma_f32_16x16x32_bf16(a, bv, yo[pt], 0, 0, 0); } }
        const float Dh = P.in[18][layer * 16 + hd];
#pragma unroll
        for (int j = 0; j < 4; ++j) { const int t = 16 * w + fq * 4 + j; const float et = __expf(acs_t[j]), idt = 1.f / DT[hh * 128 + t];
#pragma unroll
            for (int pt = 0; pt < 4; ++pt) { const int p = pt * 16 + fr; const float x = bf2f(XT4[xt_idx(hh * 64 + p, t)]) * idt;
                bf16_t* zp = zrow[j] + hh * 64 + pt * 16;
                float y = yd[pt][j] + et * yo[pt][j] + Dh * x; y *= silu_fast(bf2f(zv[j][pt])); ssq[j] += y * y; if (!dry) *zp = f2bf(y); } }
    }
    asm volatile("s_waitcnt vmcnt(0)" ::: "memory");
    const float* ng = P.in[19] + layer * 1024 + g * 256 + fr;
#pragma unroll
    for (int j = 0; j < 4; ++j) { float v = ssq[j];
#pragma unroll
        for (int o = 8; o > 0; o >>= 1) v += shx(v, o, lane);
        ssq[j] = rsqrtf(v * (1.f / 256.f) + EPSF); }
    for (int hb = 0; hb < 16; hb += 4) { bf16_t yv[4][4]; float gv[4];
#pragma unroll
        for (int q = 0; q < 4; ++q) { gv[q] = ng[(hb + q) * 16];
#pragma unroll
            for (int j = 0; j < 4; ++j) yv[q][j] = *(zrow[j] + (hb + q) * 16); }
#pragma unroll
        for (int q = 0; q < 4; ++q)
#pragma unroll
            for (int j = 0; j < 4; ++j) { if (!dry) *(zrow[j] + (hb + q) * 16) = f2bf(bf2f(yv[q][j]) * ssq[j] * gv[q]); } }
}
__device__ __forceinline__ void phase_ssd_scan(const Params& P, int layer) {
    float* states = (float*)(P.ws + WS_SSDST); const float* decs = (const float*)(P.ws + WS_SSDDEC);
    for (int e = blockIdx.x * 512 + otid(); e < 4 * 16 * 4096; e += gridDim.x * 512) {
        const int b = e >> 16, hd = (e >> 12) & 15, pn = e & 4095; float carry = 0.f;
        float st[32], dc[32];
#pragma unroll
        for (int c = 0; c < 32; ++c) { st[c] = states[((size_t)((b * 32 + c) * 16 + hd)) * 4096 + pn]; dc[c] = decs[(b * 32 + c) * 16 + hd]; }
#pragma unroll
        for (int c = 0; c < 32; ++c) { states[((size_t)((b * 32 + c) * 16 + hd)) * 4096 + pn] = carry; carry = carry * dc[c] + st[c]; }
        P.out[O_PSSM + ((size_t)((layer * 4 + b) * 16 + hd)) * 4096 + pn] = carry;
    }
}

__device__ __forceinline__ void attn_prompt_item(const Params& P, int layer, int item, unsigned char* lds, bool dry = false) {
    const int tid = otid(), w = tid >> 6, lane = tid & 63, fr = lane & 15, fq = lane >> 4;
    const int b = item >> 7, nb = (item >> 2) & 31, kvh = item & 3;
    bf16_t* proj = (bf16_t*)(P.ws + WS_PROJ);
    bf16_t* Ks = (bf16_t*)lds;
    bf16_t* Vt = Ks + 256 * 72;
    bf16_t* Pw = Vt + 64 * 280 + w * 16 * 168;
    const long rowK0 = (long)b * 4096 + (long)(nb - 1) * 128;
    const bf16_t* qbase = proj + ((size_t)b * 4096 + (size_t)nb * 128 + w * 16 + fr) * LDP + C_Q + kvh * 256 + fq * 8;
    bf16x8 qa[2], qn[2];
#pragma unroll
    for (int ks = 0; ks < 2; ++ks) { qa[ks] = *(const bf16x8*)(qbase + ks * 32); qn[ks] = qa[ks]; }
    __syncthreads();
#pragma unroll
    for (int idx = tid; idx < 2048; idx += 512) { const int kj = idx >> 3, seg = idx & 7; u32x4 v = (u32x4){0u, 0u, 0u, 0u};
        if (nb > 0 || kj >= 128) v = *(const u32x4*)(proj + (size_t)(rowK0 + kj) * LDP + C_K + kvh * 64 + seg * 8);
        *(u32x4*)(Ks + kj * 72 + seg * 8) = v; }
#pragma unroll
    for (int idx = tid; idx < 2048; idx += 512) { const int seg = idx >> 8, kj = idx & 255; u32x4 v = (u32x4){0u, 0u, 0u, 0u};
        if (nb > 0 || kj >= 128) v = *(const u32x4*)(proj + (size_t)(rowK0 + kj) * LDP + C_V + kvh * 64 + seg * 8);
#pragma unroll
        for (int i = 0; i < 8; ++i) Vt[(seg * 8 + i) * 280 + kj] = (bf16_t)((v[i >> 1] >> ((i & 1) * 16)) & 0xffffu); }
    for (int idx = tid; idx < 64 * 24; idx += 512) { const int d = idx / 24, cc = 256 + idx % 24; Vt[d * 280 + cc] = 0; }
    for (int i = lane; i < 384; i += 64) Pw[(i / 24) * 168 + 144 + i % 24] = 0;
    __syncthreads();
    const int q0 = w * 16;
    const size_t qrow0 = (size_t)b * 4096 + (size_t)nb * 128 + q0;
    for (int gi = 0; gi < 4; ++gi) {
        const int hq = kvh * 4 + gi;
        const float slope = exp2f(-0.5f * (float)(hq + 1));
        const float sink = P.in[21][layer * 16 + hq];
        if (gi < 3) {
#pragma unroll
            for (int ks = 0; ks < 2; ++ks) qn[ks] = *(const bf16x8*)(qbase + (gi + 1) * 64 + ks * 32); }
        f32x4 S[9];
#pragma unroll
        for (int nt = 0; nt < 9; ++nt) { f32x4 a = (f32x4){0.f, 0.f, 0.f, 0.f}; const bf16_t* kp = Ks + (q0 + nt * 16 + fr) * 72 + fq * 8;
#pragma unroll
            for (int ks = 0; ks < 2; ++ks) { const bf16x8 kb = *(const bf16x8*)(kp + ks * 32); a = __builtin_amdgcn_mfma_f32_16x16x32_bf16(qa[ks], kb, a, 0, 0, 0); }
            S[nt] = a; }
        float mx[4] = {-INFINITY, -INFINITY, -INFINITY, -INFINITY};
#pragma unroll
        for (int nt = 0; nt < 9; ++nt)
#pragma unroll
            for (int j = 0; j < 4; ++j) { const int dist = (fq * 4 + j) - (nt * 16 + fr) + 128; const bool valid = dist >= 0 && dist <= 128 && (nb > 0 || (q0 + nt * 16 + fr) >= 128);
                const float s = valid ? S[nt][j] * 0.125f - slope * (float)dist : -INFINITY; S[nt][j] = s; mx[j] = fmaxf(mx[j], s); }
        float inv[4];
#pragma unroll
        for (int j = 0; j < 4; ++j) { float m = mx[j];
#pragma unroll
            for (int o = 8; o > 0; o >>= 1) m = fmaxf(m, shx(m, o, lane));
            m = fmaxf(m, sink); float sum = 0.f;
#pragma unroll
            for (int nt = 0; nt < 9; ++nt) { const float p = __expf(S[nt][j] - m); S[nt][j] = p; sum += p; }
#pragma unroll
            for (int o = 8; o > 0; o >>= 1) sum += shx(sum, o, lane);
            inv[j] = 1.f / (sum + __expf(sink - m)); }
#pragma unroll
        for (int nt = 0; nt < 9; ++nt)
#pragma unroll
            for (int j = 0; j < 4; ++j) Pw[(fq * 4 + j) * 168 + nt * 16 + fr] = f2bf(S[nt][j]);
        asm volatile("s_waitcnt lgkmcnt(0)" ::: "memory"); __builtin_amdgcn_wave_barrier();
        f32x4 O[4];
#pragma unroll
        for (int dt = 0; dt < 4; ++dt) O[dt] = (f32x4){0.f, 0.f, 0.f, 0.f};
#pragma unroll
        for (int ks = 0; ks < 5; ++ks) { const bf16x8 pa = *(const bf16x8*)(Pw + fr * 168 + ks * 32 + fq * 8);
#pragma unroll
            for (int dt = 0; dt < 4; ++dt) { const bf16x8 vb = *(const bf16x8*)(Vt + (dt * 16 + fr) * 280 + q0 + ks * 32 + fq * 8); O[dt] = __builtin_amdgcn_mfma_f32_16x16x32_bf16(pa, vb, O[dt], 0, 0, 0); } }
        asm volatile("s_waitcnt lgkmcnt(0)" ::: "memory"); __builtin_amdgcn_wave_barrier();
#pragma unroll
        for (int dt = 0; dt < 4; ++dt)
#pragma unroll
            for (int j = 0; j < 4; ++j) { if (!dry) proj[(qrow0 + fq * 4 + j) * LDP + C_Q + hq * 64 + dt * 16 + fr] = f2bf(O[dt][j] * inv[j]); }
        qa[0] = qn[0]; qa[1] = qn[1];
    }
    if (nb == 31) {
        for (int idx = tid; idx < 128 * 64; idx += 512) { const int t = idx >> 6, d = idx & 63; const size_t row = (size_t)b * 4096 + 3968 + t;
            const size_t o = ((size_t)((layer * 4 + b) * 128 + t)) * 256 + kvh * 64 + d;
            P.out[O_PK + o] = bf2f(proj[row * LDP + C_K + kvh * 64 + d]); P.out[O_PV + o] = bf2f(proj[row * LDP + C_V + kvh * 64 + d]); }
    }
}
__device__ __forceinline__ void attn_sample_item(const Params& P, int layer, int item, float* L, bool dry = false) {
    const int tid = otid(), w = tid >> 6, lane = tid & 63;
    const int sb = item >> 2, kvh = item & 3, r0 = NPR + sb * 4;
    bf16_t* proj = (bf16_t*)(P.ws + WS_PROJ);
    float* Kf = L; float* Vf = Kf + 132 * 65; float* Q = Vf + 132 * 65; float* Sc = Q + 16 * 64;
    const float* ck = P.in[7] + ((size_t)(layer * 128 + sb)) * 128 * 256; const float* cv = P.in[8] + ((size_t)(layer * 128 + sb)) * 128 * 256;
    __syncthreads();
    {
        f32x4 kq[4], vq[4];
#pragma unroll
        for (int i = 0; i < 4; ++i) { const int idx = tid + i * 512, j = idx >> 4, d4 = (idx & 15) * 4; kq[i] = *(const f32x4*)(ck + (size_t)j * 256 + kvh * 64 + d4); vq[i] = *(const f32x4*)(cv + (size_t)j * 256 + kvh * 64 + d4); }
#pragma unroll
        for (int i = 0; i < 4; ++i) { const int idx = tid + i * 512, j = idx >> 4, d4 = (idx & 15) * 4;
#pragma unroll
            for (int e = 0; e < 4; ++e) { Kf[j * 65 + d4 + e] = kq[i][e]; Vf[j * 65 + d4 + e] = vq[i][e]; }
            if (j >= 4) { const size_t o = ((size_t)((layer * 128 + sb) * 128 + (j - 4))) * 256 + kvh * 64 + d4; *(f32x4*)(P.out + O_SK + o) = kq[i]; *(f32x4*)(P.out + O_SV + o) = vq[i]; } }
        if (tid < 256) { const int j = 128 + (tid >> 6), d = tid & 63; const float kv = bf2f(proj[(size_t)(r0 + j - 128) * LDP + C_K + kvh * 64 + d]), vv = bf2f(proj[(size_t)(r0 + j - 128) * LDP + C_V + kvh * 64 + d]);
            Kf[j * 65 + d] = kv; Vf[j * 65 + d] = vv; const size_t o = ((size_t)((layer * 128 + sb) * 128 + (j - 4))) * 256 + kvh * 64 + d; P.out[O_SK + o] = kv; P.out[O_SV + o] = vv; }
    }
    for (int idx = tid; idx < 1024; idx += 512) { const int qr = idx >> 6, d = idx & 63; Q[idx] = bf2f(proj[(size_t)(r0 + (qr >> 2)) * LDP + C_Q + (kvh * 4 + (qr & 3)) * 64 + d]); }
    __syncthreads();
    for (int idx = tid; idx < 16 * 132; idx += 512) { const int qr = idx / 132, j = idx - qr * 132; const int dist = 128 + (qr >> 2) - j; float s = -INFINITY;
        if (dist >= 0 && dist <= 128) { float a = 0.f;
#pragma unroll 8
            for (int d = 0; d < 64; ++d) a += Q[qr * 64 + d] * Kf[j * 65 + d];
            s = a * 0.125f - exp2f(-0.5f * (float)(kvh * 4 + (qr & 3) + 1)) * (float)dist; }
        Sc[qr * 136 + j] = s; }
    __syncthreads();
    for (int rr = 0; rr < 2; ++rr) { const int qr = w * 2 + rr; const float sink = P.in[21][layer * 16 + kvh * 4 + (qr & 3)];
        float v0 = Sc[qr * 136 + lane], v1 = Sc[qr * 136 + 64 + lane], v2 = lane < 4 ? Sc[qr * 136 + 128 + lane] : -INFINITY;
        float m = fmaxf(fmaxf(v0, v1), v2);
#pragma unroll
        for (int o = 32; o > 0; o >>= 1) m = fmaxf(m, shx(m, o, lane));
        m = fmaxf(m, sink);
        v0 = __expf(v0 - m); v1 = __expf(v1 - m); v2 = __expf(v2 - m);
        const float sum = wave_sum(v0 + v1 + v2, lane); const float inv = 1.f / (sum + __expf(sink - m));
        Sc[qr * 136 + lane] = v0 * inv; Sc[qr * 136 + 64 + lane] = v1 * inv; if (lane < 4) Sc[qr * 136 + 128 + lane] = v2 * inv; }
    __syncthreads();
    for (int idx = tid; idx < 1024; idx += 512) { const int qr = idx >> 6, d = idx & 63; float o = 0.f;
        for (int j = 0; j < 132; ++j) o += Sc[qr * 136 + j] * Vf[j * 65 + d];
        if (!dry) proj[(size_t)(r0 + (qr >> 2)) * LDP + C_Q + (kvh * 4 + (qr & 3)) * 64 + d] = f2bf(o); }
}

__device__ __forceinline__ void gmlp_prompt_item(const Params& P, int layer, int item, unsigned char* lds, bool dry = false) {
    const int tid = otid(), w = tid >> 6, lane = tid & 63, fr = lane & 15, fq = lane >> 4;
    const int b = item >> 8, chn = (item >> 3) & 31, g = item & 7;
    const size_t r0 = (size_t)b * 4096 + (size_t)chn * 128;
    bf16_t* proj = (bf16_t*)(P.ws + WS_PROJ);
    bf16_t* VT = (bf16_t*)lds; bf16_t* Wt = VT + 128 * 136; float* MU = (float*)(Wt + 128 * 136); float* RS = MU + 128;
    __syncthreads();
#pragma unroll
    for (int hb = 0; hb < 2; ++hb) { u32x4 av[8], cv8[8];
#pragma unroll
        for (int i = 0; i < 8; ++i) { const bf16_t* vp = proj + (r0 + w * 16 + hb * 8 + i) * LDP + C_UV + 1024 + lane * 16; av[i] = *(const u32x4*)vp; cv8[i] = *(const u32x4*)(vp + 8); }
#pragma unroll
        for (int i = 0; i < 8; ++i) { const int t = w * 16 + hb * 8 + i; float s = 0.f, sq = 0.f;
#pragma unroll
            for (int k = 0; k < 4; ++k) { float x0 = bflo(av[i][k]), x1 = bfhi(av[i][k]), x2 = bflo(cv8[i][k]), x3 = bfhi(cv8[i][k]); s += x0 + x1 + x2 + x3; sq += x0 * x0 + x1 * x1 + x2 * x2 + x3 * x3; }
            s = wave_sum(s, lane); sq = wave_sum(sq, lane);
            if (lane == 0) { const float mean = s * (1.f / 1024.f); const float var = fmaxf(sq * (1.f / 1024.f) - mean * mean, 0.f); MU[t] = mean; RS[t] = rsqrtf(var + EPSF); } } }
    const float* Wg = P.in[24] + ((size_t)(layer * 8 + g)) * 16384;
#pragma unroll
    for (int idx = tid; idx < 4096; idx += 512) { const int t = idx >> 5, s4 = (idx & 31) * 4; const f32x4 wv = *(const f32x4*)(Wg + t * 128 + s4);
        u32x2 o; o[0] = pk2(s4 <= t ? wv[0] : 0.f, s4 + 1 <= t ? wv[1] : 0.f); o[1] = pk2(s4 + 2 <= t ? wv[2] : 0.f, s4 + 3 <= t ? wv[3] : 0.f);
        *(u32x2*)(Wt + t * 136 + s4) = o; }
    __syncthreads();
    const float* lg = P.in[22] + layer * 1024 + g * 128; const float* lb = P.in[23] + layer * 1024 + g * 128;
#pragma unroll
    for (int idx = tid; idx < 2048; idx += 512) { const int s = idx & 127, fs = idx >> 7; const u32x4 v = *(const u32x4*)(proj + (r0 + s) * LDP + C_UV + 1024 + g * 128 + fs * 8);
        const float mu = MU[s], rs = RS[s];
#pragma unroll
        for (int i = 0; i < 8; ++i) { const int f = fs * 8 + i; const float x = (i & 1) ? bfhi(v[i >> 1]) : bflo(v[i >> 1]); VT[f * 136 + s] = f2bf((x - mu) * rs * lg[f] + lb[f]); } }
    __syncthreads();
    f32x4 acc[8];
#pragma unroll
    for (int ft = 0; ft < 8; ++ft) acc[ft] = (f32x4){0.f, 0.f, 0.f, 0.f};
    const int nks = (16 * w + 15) / 32 + 1;
    for (int ks = 0; ks < nks; ++ks) { const bf16x8 a = *(const bf16x8*)(Wt + (w * 16 + fr) * 136 + ks * 32 + fq * 8);
#pragma unroll
        for (int ft = 0; ft < 8; ++ft) { const bf16x8 bb = *(const bf16x8*)(VT + (ft * 16 + fr) * 136 + ks * 32 + fq * 8); acc[ft] = __builtin_amdgcn_mfma_f32_16x16x32_bf16(a, bb, acc[ft], 0, 0, 0); } }
    bf16_t uv[4][8]; float bsv[4];
#pragma unroll
    for (int j = 0; j < 4; ++j) { const int t = w * 16 + fq * 4 + j; bsv[j] = P.in[25][(layer * 8 + g) * 128 + t];
#pragma unroll
        for (int ft = 0; ft < 8; ++ft) uv[j][ft] = proj[(r0 + t) * LDP + C_UV + g * 128 + ft * 16 + fr]; }
#pragma unroll
    for (int j = 0; j < 4; ++j) { const int t = w * 16 + fq * 4 + j;
#pragma unroll
        for (int ft = 0; ft < 8; ++ft) { if (!dry) proj[(r0 + t) * LDP + C_UV + g * 128 + ft * 16 + fr] = f2bf(gelu_fast(bf2f(uv[j][ft])) * (acc[ft][j] + bsv[j])); } }
}
__device__ __forceinline__ void gmlp_sample_item(const Params& P, int layer, int sb, float* L) {
    const int tid = otid(), w = tid >> 6, lane = tid & 63; const size_t r0 = NPR + sb * 4;
    bf16_t* proj = (bf16_t*)(P.ws + WS_PROJ);
    float* Vn = L; float* MU = Vn + 4096; float* RS = MU + 4;
    __syncthreads();
    if (w < 4) { const bf16_t* vp = proj + (r0 + w) * LDP + C_UV + 1024 + lane * 16; const u32x4 a = *(const u32x4*)vp, c = *(const u32x4*)(vp + 8); float s = 0.f, sq = 0.f;
#pragma unroll
        for (int k = 0; k < 4; ++k) { float x0 = bflo(a[k]), x1 = bfhi(a[k]), x2 = bflo(c[k]), x3 = bfhi(c[k]); s += x0 + x1 + x2 + x3; sq += x0 * x0 + x1 * x1 + x2 * x2 + x3 * x3; }
        s = wave_sum(s, lane); sq = wave_sum(sq, lane);
        if (lane == 0) { const float mean = s * (1.f / 1024.f); const float var = fmaxf(sq * (1.f / 1024.f) - mean * mean, 0.f); MU[w] = mean; RS[w] = rsqrtf(var + EPSF); } }
    __syncthreads();
    for (int idx = tid; idx < 4096; idx += 512) { const int t = idx >> 10, c = idx & 1023;
        const float x = bf2f(proj[(r0 + t) * LDP + C_UV + 1024 + c]); const float vn = (x - MU[t]) * RS[t] * P.in[22][layer * 1024 + c] + P.in[23][layer * 1024 + c];
        Vn[idx] = vn; P.out[O_SGMV + ((size_t)((layer * 128 + sb) * 4 + t)) * 1024 + c] = vn; }
    __syncthreads();
    for (int idx = tid; idx < 4096; idx += 512) { const int t = idx >> 10, c = idx & 1023, g = c >> 7;
        const float* Wg = P.in[24] + ((size_t)(layer * 8 + g)) * 16384 + t * 128; float m = P.in[25][(layer * 8 + g) * 128 + t];
        for (int s = 0; s <= t; ++s) m += Wg[s] * Vn[s * 1024 + c];
        bf16_t* ap = proj + (r0 + t) * LDP + C_UV + c; *ap = f2bf(gelu_fast(bf2f(*ap)) * m); }
}

template <int R>
__device__ __forceinline__ void shortconv_rows(const Params& P, int layer, int r0, int tid, bool dry) {
    bf16_t* proj = (bf16_t*)(P.ws + WS_PROJ);
    const float* cw = P.in[20] + layer * 3 * 1024;
    const int j = tid * 2; const int ss = seq_start(r0); const bool havePrev = (r0 - 2 >= ss);
    unsigned cg[R + 2], xs[R + 2], bg[R];
#pragma unroll
    for (int k = 0; k < R + 2; ++k) { cg[k] = 0u; xs[k] = 0u;
        if (k >= 2 || havePrev) { const bf16_t* rp = proj + (size_t)(r0 - 2 + k) * LDP + C_BCX + j; cg[k] = *(const unsigned*)(rp + 1024); xs[k] = *(const unsigned*)(rp + 2048); } }
#pragma unroll
    for (int k = 0; k < R; ++k) bg[k] = *(const unsigned*)(proj + (size_t)(r0 + k) * LDP + C_BCX + j);
    float pr0[R + 2], pr1[R + 2];
#pragma unroll
    for (int k = 0; k < R + 2; ++k) { pr0[k] = bflo(cg[k]) * bflo(xs[k]); pr1[k] = bfhi(cg[k]) * bfhi(xs[k]); }
    if (!havePrev && r0 >= NPR) { const float* st = P.in[6] + ((size_t)(layer * 128 + ((r0 - NPR) >> 2)) * 2) * 1024 + j; pr0[0] = st[0]; pr1[0] = st[1]; pr0[1] = st[1024]; pr1[1] = st[1025]; }
    const float w0a = cw[j], w0b = cw[j + 1], w1a = cw[1024 + j], w1b = cw[1025 + j], w2a = cw[2048 + j], w2b = cw[2049 + j];
#pragma unroll
    for (int k = 0; k < R; ++k) { const float y0 = w0a * pr0[k] + w1a * pr0[k + 1] + w2a * pr0[k + 2], y1 = w0b * pr1[k] + w1b * pr1[k + 1] + w2b * pr1[k + 2];
        if (!dry) *(unsigned*)(proj + (size_t)(r0 + k) * LDP + C_BCX + j) = pk2(bflo(bg[k]) * y0, bfhi(bg[k]) * y1);
        const int r = r0 + k;
        if (r < NPR) { const int l = r & 4095; if (l >= 4094) { float* o = P.out + O_PSCC + ((size_t)((layer * 4 + (r >> 12)) * 2 + (l - 4094))) * 1024 + j; o[0] = pr0[k + 2]; o[1] = pr1[k + 2]; } }
        else { const int l = (r - NPR) & 3; if (l >= 2) { float* o = P.out + O_SSCC + ((size_t)((layer * 128 + ((r - NPR) >> 2)) * 2 + (l - 2))) * 1024 + j; o[0] = pr0[k + 2]; o[1] = pr1[k + 2]; } }
    }
}
__device__ __forceinline__ void shortconv_item(const Params& P, int layer, int item, bool dry = false) {
    const int tid = otid();
    if (item < 1024) shortconv_rows<16>(P, layer, item * 16, tid, dry); else shortconv_rows<4>(P, layer, NPR + (item - 1024) * 4, tid, dry);
}
__device__ __forceinline__ void ssdconv_state_item(const Params& P, int layer, int sq) {
    const bf16_t* proj = (const bf16_t*)(P.ws + WS_PROJ);
    const size_t rbase = sq < 4 ? (size_t)sq * 4096 + 4093 : (size_t)NPR + (size_t)(sq - 4) * 4 + 1;
    float* o = sq < 4 ? P.out + O_PSSDC + (size_t)(layer * 4 + sq) * 3 * 1536 : P.out + O_SSSDC + (size_t)(layer * 128 + (sq - 4)) * 3 * 1536;
    const int tid = otid(); bf16_t v[9];
#pragma unroll
    for (int i = 0; i < 9; ++i) { const int e = tid + i * 512, t = e / 1536, c = e - t * 1536; v[i] = proj[(rbase + t) * LDP + C_XBC + c]; }
#pragma unroll
    for (int i = 0; i < 9; ++i) o[tid + i * 512] = bf2f(v[i]);
}

template <int R>
__device__ __forceinline__ void ffn_act_unit(const Params& P, int layer, int r0, int oc) {
    const bf16_t* up = (const bf16_t*)(P.ws + WS_PROJ); bf16_t* act = (bf16_t*)(P.ws + WS_PROJ + UP_BYTES);
    const float* cw = P.in[30] + (size_t)layer * 3 * 5632; const float* cb = P.in[31] + (size_t)layer * 5632;
    const int j0 = oc * 8;
    float wa[3][8], wg[3][8], ba[8], bgv[8], pa[2][8], pg[2][8];
#pragma unroll
    for (int k = 0; k < 3; ++k) { const f32x4 a0 = *(const f32x4*)(cw + k * 5632 + j0), a1 = *(const f32x4*)(cw + k * 5632 + j0 + 4), g0 = *(const f32x4*)(cw + k * 5632 + 2816 + j0), g1 = *(const f32x4*)(cw + k * 5632 + 2816 + j0 + 4);
#pragma unroll
        for (int i = 0; i < 4; ++i) { wa[k][i] = a0[i]; wa[k][4 + i] = a1[i]; wg[k][i] = g0[i]; wg[k][4 + i] = g1[i]; } }
    { const f32x4 a0 = *(const f32x4*)(cb + j0), a1 = *(const f32x4*)(cb + j0 + 4), g0 = *(const f32x4*)(cb + 2816 + j0), g1 = *(const f32x4*)(cb + 2816 + j0 + 4);
#pragma unroll
      for (int i = 0; i < 4; ++i) { ba[i] = a0[i]; ba[4 + i] = a1[i]; bgv[i] = g0[i]; bgv[4 + i] = g1[i]; } }
    const int ss = seq_start(r0); const bool havePrev = (r0 - 2 >= ss);
#pragma unroll
    for (int k = 0; k < 2; ++k) {
        if (havePrev) { const u32x4 ua = *(const u32x4*)(up + (size_t)(r0 - 2 + k) * 5632 + j0), ug = *(const u32x4*)(up + (size_t)(r0 - 2 + k) * 5632 + 2816 + j0);
#pragma unroll
            for (int i = 0; i < 4; ++i) { pa[k][2 * i] = bflo(ua[i]); pa[k][2 * i + 1] = bfhi(ua[i]); pg[k][2 * i] = bflo(ug[i]); pg[k][2 * i + 1] = bfhi(ug[i]); } }
        else if (r0 >= NPR) { const float* pp = P.in[9] + ((size_t)(layer * 128 + ((r0 - NPR) >> 2)) * 2 + k) * 5632;
#pragma unroll
            for (int i = 0; i < 8; ++i) { pa[k][i] = pp[j0 + i]; pg[k][i] = pp[2816 + j0 + i]; } }
        else {
#pragma unroll
            for (int i = 0; i < 8; ++i) { pa[k][i] = 0.f; pg[k][i] = 0.f; } } }
#pragma unroll
    for (int kb = 0; kb < R; kb += 4) { u32x4 ua[4], ug[4];
#pragma unroll
        for (int q = 0; q < 4; ++q) { ua[q] = *(const u32x4*)(up + (size_t)(r0 + kb + q) * 5632 + j0); ug[q] = *(const u32x4*)(up + (size_t)(r0 + kb + q) * 5632 + 2816 + j0); }
#pragma unroll
        for (int q = 0; q < 4; ++q) { const int r = r0 + kb + q; float ca[8], cgv[8], o[8];
#pragma unroll
            for (int i = 0; i < 4; ++i) { ca[2 * i] = bflo(ua[q][i]); ca[2 * i + 1] = bfhi(ua[q][i]); cgv[2 * i] = bflo(ug[q][i]); cgv[2 * i + 1] = bfhi(ug[q][i]); }
#pragma unroll
            for (int i = 0; i < 8; ++i) { const float a = ba[i] + wa[0][i] * pa[0][i] + wa[1][i] * pa[1][i] + wa[2][i] * ca[i], g = bgv[i] + wg[0][i] * pg[0][i] + wg[1][i] * pg[1][i] + wg[2][i] * cgv[i];
                o[i] = silu_fast(a) * g; pa[0][i] = pa[1][i]; pa[1][i] = ca[i]; pg[0][i] = pg[1][i]; pg[1][i] = cgv[i]; }
            u32x4 ov; ov[0] = pk2(o[0], o[1]); ov[1] = pk2(o[2], o[3]); ov[2] = pk2(o[4], o[5]); ov[3] = pk2(o[6], o[7]);
            *(u32x4*)(act + (size_t)r * 2816 + j0) = ov;
            float* so = nullptr;
            if (r < NPR) { const int l = r & 4095; if (l >= 4094) so = P.out + O_PFFC + ((size_t)((layer * 4 + (r >> 12)) * 2 + (l - 4094))) * 5632; }
            else { const int l = (r - NPR) & 3; if (l >= 2) so = P.out + O_SFFC + ((size_t)((layer * 128 + ((r - NPR) >> 2)) * 2 + (l - 2))) * 5632; }
            if (so) {
#pragma unroll
                for (int i = 0; i < 8; ++i) { so[j0 + i] = ca[i]; so[2816 + j0 + i] = cgv[i]; } }
        } }
}
__device__ __forceinline__ void phase_ffn_act(const Params& P, int layer) {
    constexpr int NU_P = 2048 * 352, NU_S = 128 * 352;
    for (int u = blockIdx.x * 512 + otid(); u < NU_P + NU_S; u += gridDim.x * 512) {
        if (u < NU_P) { const int rb = u / 352, oc = u - rb * 352; ffn_act_unit<8>(P, layer, rb * 8, oc); }
        else { const int v = u - NU_P, sq = v / 352, oc = v - sq * 352; ffn_act_unit<4>(P, layer, NPR + sq * 4, oc); }
    }
}

__device__ __forceinline__ void sgemm_partial(const bf16_t* A, int lda, const bf16_t* Bt, int ldb, int K, int row0, int col0, float* red, int tid) {
    const int w = tid >> 6, lane = tid & 63, fr = lane & 15, fq = lane >> 4;
    const int kw = K >> 3, k0 = w * kw;
    f32x4 acc[2][4];
#pragma unroll
    for (int mt = 0; mt < 2; ++mt)
#pragma unroll
        for (int nt = 0; nt < 4; ++nt) acc[mt][nt] = (f32x4){0.f, 0.f, 0.f, 0.f};
    const bf16_t* ap = A + (size_t)(row0 + fr) * lda + k0 + fq * 8;
    const bf16_t* bp = Bt + (size_t)(col0 + fr) * ldb + k0 + fq * 8;
    const int nks = kw >> 5;
#pragma unroll 4
    for (int ks = 0; ks < nks; ++ks) { bf16x8 a[2], b[4];
#pragma unroll
        for (int mt = 0; mt < 2; ++mt) a[mt] = *(const bf16x8*)(ap + (size_t)mt * 16 * lda + ks * 32);
#pragma unroll
        for (int nt = 0; nt < 4; ++nt) b[nt] = *(const bf16x8*)(bp + (size_t)nt * 16 * ldb + ks * 32);
#pragma unroll
        for (int mt = 0; mt < 2; ++mt)
#pragma unroll
            for (int nt = 0; nt < 4; ++nt) acc[mt][nt] = __builtin_amdgcn_mfma_f32_16x16x32_bf16(a[mt], b[nt], acc[mt][nt], 0, 0, 0); }
#pragma unroll
    for (int mt = 0; mt < 2; ++mt)
#pragma unroll
        for (int nt = 0; nt < 4; ++nt)
#pragma unroll
            for (int j = 0; j < 4; ++j) red[(w * 32 + mt * 16 + fq * 4 + j) * 64 + nt * 16 + fr] = acc[mt][nt][j];
}
__device__ __forceinline__ f32x4 sgemm_reduce(const float* red, int tid) {
    const int row = tid >> 4, c4 = (tid & 15) * 4; f32x4 sacc = (f32x4){0.f, 0.f, 0.f, 0.f};
#pragma unroll
    for (int w = 0; w < 8; ++w) sacc += *(const f32x4*)(red + (w * 32 + row) * 64 + c4);
    return sacc;
}
__device__ __forceinline__ void sg_load4(const bf16_t* ap, int lda, const bf16_t* bp, int ldb, bf16x8 (&a)[4][2], bf16x8 (&b)[4][4]) {
#pragma unroll
    for (int ks = 0; ks < 4; ++ks) {
#pragma unroll
        for (int mt = 0; mt < 2; ++mt) a[ks][mt] = *(const bf16x8*)(ap + (size_t)mt * 16 * lda + ks * 32);
#pragma unroll
        for (int nt = 0; nt < 4; ++nt) b[ks][nt] = *(const bf16x8*)(bp + (size_t)nt * 16 * ldb + ks * 32); }
}
__device__ __forceinline__ void sample_branch(const Params& P, int layer, float* red) {
    const int tid = otid(), w = tid >> 6, lane = tid & 63, fr = lane & 15, fq = lane >> 4;
    const bf16_t* proj = (const bf16_t*)(P.ws + WS_PROJ); bf16_t* hbuf = (bf16_t*)(P.ws + WS_H);
    for (int piece = blockIdx.x; piece < 256; piece += gridDim.x) {
        const int row0 = (piece >> 4) * 32, col0 = (piece & 15) * 64; const size_t r = NPR + row0 + (tid >> 4); const int c = col0 + (tid & 15) * 4;
        const bf16_t* abase = proj + (size_t)(NPR + row0 + fr) * LDP + w * 128 + fq * 8;
        const bf16_t* bbase = (const bf16_t*)(P.ws + WS_WBR) + (size_t)layer * 4 * 1048576 + (size_t)(col0 + fr) * 1024 + w * 128 + fq * 8;
        bf16x8 a[4][2], b[4][4];
        sg_load4(abase + C_Z, LDP, bbase, 1024, a, b);
        f32x4 sum = (f32x4){0.f, 0.f, 0.f, 0.f};
        for (int z = 0; z < 4; ++z) {
            f32x4 acc[2][4];
#pragma unroll
            for (int mt = 0; mt < 2; ++mt)
#pragma unroll
                for (int nt = 0; nt < 4; ++nt) acc[mt][nt] = (f32x4){0.f, 0.f, 0.f, 0.f};
#pragma unroll
            for (int ks = 0; ks < 4; ++ks)
#pragma unroll
                for (int mt = 0; mt < 2; ++mt)
#pragma unroll
                    for (int nt = 0; nt < 4; ++nt) acc[mt][nt] = __builtin_amdgcn_mfma_f32_16x16x32_bf16(a[ks][mt], b[ks][nt], acc[mt][nt], 0, 0, 0);
            if (z < 3) { const int ao = z == 0 ? C_BCX : (z == 1 ? C_Q : C_UV); sg_load4(abase + ao, LDP, bbase + (size_t)(z + 1) * 1048576, 1024, a, b); }
            const u32x2 gv = *(const u32x2*)(proj + r * LDP + C_GATE + z * 1024 + c);
            __syncthreads();
#pragma unroll
            for (int mt = 0; mt < 2; ++mt)
#pragma unroll
                for (int nt = 0; nt < 4; ++nt)
#pragma unroll
                    for (int j = 0; j < 4; ++j) red[(w * 32 + mt * 16 + fq * 4 + j) * 64 + nt * 16 + fr] = acc[mt][nt][j];
            __syncthreads();
            const f32x4 v = sgemm_reduce(red, tid);
            sum[0] += sigmoid_fast(bflo(gv[0])) * v[0]; sum[1] += sigmoid_fast(bfhi(gv[0])) * v[1]; sum[2] += sigmoid_fast(bflo(gv[1])) * v[2]; sum[3] += sigmoid_fast(bfhi(gv[1])) * v[3];
        }
        u32x2 o; o[0] = pk2(sum[0], sum[1]); o[1] = pk2(sum[2], sum[3]); *(u32x2*)(hbuf + r * 1024 + c) = o;
        __syncthreads();
    }
}
__device__ __forceinline__ void sample_resid(const Params& P, const bf16_t* A, int lda, const bf16_t* Bt, int K, const float* xin_s, float* xout, const float* ga, float* red) {
    const int tid = otid();
    for (int piece = blockIdx.x; piece < 256; piece += gridDim.x) {
        const int row0 = (piece >> 4) * 32, col0 = (piece & 15) * 64; const int rs = row0 + (tid >> 4), c = col0 + (tid & 15) * 4;
        __syncthreads();
        sgemm_partial(A, lda, Bt, K, K, row0, col0, red, tid);
        __syncthreads();
        const f32x4 v = sgemm_reduce(red, tid);
        const f32x4 xv = *(const f32x4*)(xin_s + (size_t)rs * 1024 + c), gv = *(const f32x4*)(ga + (size_t)(4 + (rs >> 2)) * 6144 + c);
        *(f32x4*)(xout + (size_t)(NPR + rs) * 1024 + c) = xv + gv * v;
    }
}

__device__ __forceinline__ void grid_bar(unsigned* ctr, unsigned& epoch) {
    asm volatile("s_waitcnt vmcnt(0) lgkmcnt(0)" ::: "memory");
    __syncthreads();
    epoch += 1;
    if (otid() == 0) {
        __builtin_amdgcn_fence(__ATOMIC_RELEASE, "agent");
        asm volatile("s_waitcnt vmcnt(0) lgkmcnt(0)" ::: "memory");
        __hip_atomic_fetch_add(ctr, 1u, __ATOMIC_RELAXED, __HIP_MEMORY_SCOPE_AGENT);
        const unsigned target = epoch * gridDim.x;
        while (__hip_atomic_load(ctr, __ATOMIC_RELAXED, __HIP_MEMORY_SCOPE_AGENT) < target) __builtin_amdgcn_s_sleep(1);
        __builtin_amdgcn_fence(__ATOMIC_ACQUIRE, "agent");
        asm volatile("s_waitcnt vmcnt(0) lgkmcnt(0)" ::: "memory");
    }
    __syncthreads();
}

#ifndef PHMASK
#define PHMASK 0xFFFFFFFF
#endif
#define EN(x) ((PHMASK >> (x)) & 1)
#ifndef DRYM
#define DRYM 0
#endif
#ifndef DBL
#define DBL 0
#endif
#define REP(x) (((DBL >> (x)) & 1) ? 2 : 1)
constexpr int PH_PER_LAYER = 11, N_PHASES = 2 + 4 * PH_PER_LAYER + 1;

__global__ void __launch_bounds__(512, 2) mega_fwd(Params PK) {
    extern __shared__ __attribute__((aligned(16))) unsigned char lds_raw[];
    cg::grid_group grid = cg::this_grid();
    LAS unsigned char* ldsl = (LAS unsigned char*)lds_raw;
    unsigned epoch = 0;
    for (int ph = PK.ph_lo; ph < PK.ph_hi; ++ph) {
        Params P = PK;
        { unsigned char* w_ = P.ws; asm volatile("" : "+s"(w_)); P.ws = w_; float* o_ = P.out; asm volatile("" : "+s"(o_)); P.out = o_; }
        unsigned* barctr = (unsigned*)(P.ws + WS_BAR);
        bf16_t* proj = (bf16_t*)(P.ws + WS_PROJ);
        bf16_t* hbuf = (bf16_t*)(P.ws + WS_H);
        float* xbuf = P.out;
        float* mod = (float*)(P.ws + WS_MOD);
        if (ph == 0) { for (int rp = 0; rp < REP(0); ++rp) phase_convert(P, (float*)lds_raw); }
        else if (ph == 1) {
            Gemm g{(const bf16_t*)(P.ws + WS_CACT), (const bf16_t*)(P.ws + WS_WADA), 1024, 1024, 1024, 1, 96, 0, 0, 0, 0, 0};
            EpiMod E{mod, P.in[11]};
            for (int rp = 0; rp < REP(1); ++rp) gemm_phase<EpiMod, 1>(ldsl, g, E);
        }
        else if (ph == N_PHASES - 1) { phase_final_norm(xbuf, P.in[33]); }
        else {
            const int layer = (ph - 2) / PH_PER_LAYER, sp = (ph - 2) % PH_PER_LAYER;
            const float* modL = mod + (size_t)layer * NCOND * 6144;
            const float* xin_p = layer == 0 ? P.in[0] : xbuf; const float* xin_s = layer == 0 ? P.in[1] : xbuf + (size_t)NPR * 1024;
            if (sp == 0) { for (int rp = 0; rp < REP(16); ++rp) phase_norm(xin_p, xin_s, P.in[12] + layer * 1024, modL, 0, 1024, hbuf); }
            else if (sp == 1) {
                Gemm g{hbuf, (const bf16_t*)(P.ws + WS_WIN) + (size_t)layer * 13568 * 1024, 1024, 1024, 1024, 66, 53, 0, 0, 0, 0, 0};
                EpiProj E{proj};
                for (int rp = 0; rp < REP(2); ++rp) gemm_phase<EpiProj, 1>(ldsl, g, E);
            }
            else if (sp == 2) {
                for (int it = blockIdx.x; it < 3972 + 256; it += gridDim.x) {
                    if (it < 512) { for (int rp = 0; rp < REP(3); ++rp) ssd_pass1_item(P, layer, it, lds_raw); }
                    else if (it < 1024) { for (int rp = (DRYM & 1) ? 0 : 1; rp < 2; ++rp) attn_prompt_item(P, layer, it - 512, lds_raw, rp == 0 && P.ph_lo == 0); }
                    else if (it < 1536) { for (int rp = (DRYM & 2) ? 0 : 1; rp < 2; ++rp) attn_sample_item(P, layer, it - 1024, (float*)lds_raw, rp == 0 && P.ph_lo == 0); }
                    else if (it < 2560) { for (int rp = (DRYM & 4) ? 0 : 1; rp < 2; ++rp) gmlp_prompt_item(P, layer, it - 1536, lds_raw, rp == 0 && P.ph_lo == 0); }
                    else if (it < 2688) { if (EN(8)) gmlp_sample_item(P, layer, it - 2560, (float*)lds_raw); }
                    else if (it < 3840) { for (int rp = (DRYM & 8) ? 0 : 1; rp < 2; ++rp) shortconv_item(P, layer, it - 2688, rp == 0 && P.ph_lo == 0); }
                    else if (it < 3972) ssdconv_state_item(P, layer, it - 3840);
                    else ssd_item<2>(P, layer, it - 3972, (float*)lds_raw);
                }
            }
            else if (sp == 3) { phase_ssd_scan(P, layer); }
            else if (sp == 4) { for (int it = blockIdx.x; it < 512; it += gridDim.x) for (int rp = (DRYM & 16) ? 0 : 1; rp < 2; ++rp) ssd_pass3_item(P, layer, it, lds_raw, rp == 0 && P.ph_lo == 0); }
            else if (sp == 5) {
                Gemm g{proj, (const bf16_t*)(P.ws + WS_WBR) + (size_t)layer * 4 * 1048576, LDP, 1024, 1024, 64, 4, C_Z, C_BCX, C_Q, C_UV, (size_t)1048576};
                EpiBranch E{proj, (float*)(P.ws + WS_MSUM), hbuf};
                for (int rp = 0; rp < REP(11); ++rp) gemm_phase<EpiBranch, 4>(ldsl, g, E);
                for (int rp = 0; rp < REP(17); ++rp) sample_branch(P, layer, (float*)lds_raw);
            }
            else if (sp == 6) {
                Gemm g{hbuf, (const bf16_t*)(P.ws + WS_WO) + (size_t)layer * 1048576, 1024, 1024, 1024, 64, 4, 0, 0, 0, 0, 0};
                EpiResid E{xin_p, xin_s, xbuf, modL + 2048};
                if (EN(12)) gemm_phase<EpiResid, 1>(ldsl, g, E);
                sample_resid(P, hbuf + (size_t)NPR * 1024, 1024, (const bf16_t*)(P.ws + WS_WO) + (size_t)layer * 1048576, 1024, xin_s, xbuf, modL + 2048, (float*)lds_raw);
            }
            else if (sp == 7) { for (int rp = 0; rp < REP(16); ++rp) phase_norm(xbuf, xbuf + (size_t)NPR * 1024, P.in[28] + layer * 1024, modL, 3072, 4096, hbuf); }
            else if (sp == 8) {
                Gemm g{hbuf, (const bf16_t*)(P.ws + WS_WUP) + (size_t)layer * 5632 * 1024, 1024, 1024, 1024, 66, 22, 0, 0, 0, 0, 0};
                EpiUp E{proj};
                for (int rp = 0; rp < REP(13); ++rp) gemm_phase<EpiUp, 1>(ldsl, g, E);
            }
            else if (sp == 9) { for (int rp = 0; rp < REP(14); ++rp) phase_ffn_act(P, layer); }
            else {
                Gemm g{(const bf16_t*)(P.ws + WS_PROJ + UP_BYTES), (const bf16_t*)(P.ws + WS_WDN) + (size_t)layer * 1024 * 2816, 2816, 2816, 2816, 64, 4, 0, 0, 0, 0, 0};
                EpiResid E{xbuf, xbuf + (size_t)NPR * 1024, xbuf, modL + 5120};
                if (EN(15)) gemm_phase<EpiResid, 1>(ldsl, g, E);
                sample_resid(P, (const bf16_t*)(P.ws + WS_PROJ + UP_BYTES) + (size_t)NPR * 2816, 2816, (const bf16_t*)(P.ws + WS_WDN) + (size_t)layer * 1024 * 2816, 2816, xbuf + (size_t)NPR * 1024, xbuf, modL + 5120, (float*)lds_raw);
            }
        }
        if (ph + 1 < P.ph_hi) { if (ph == 0) grid.sync(); else grid_bar(barctr, epoch); }
    }
}

extern "C" void kernel_launch(void* const* d_in, const int* in_sizes, int n_in, void* d_out, int out_size, void* d_ws, size_t ws_size, hipStream_t stream) {
    static int grid_blocks = 0;
    if (grid_blocks == 0) {
        if (n_in != 34 || (size_t)out_size != O_END || ws_size < WS_END + 256) { fprintf(stderr, "kernel_launch: unexpected sizes n_in %d out %d ws %zu (need %zu)\n", n_in, out_size, ws_size, (size_t)WS_END); grid_blocks = -1; return; }
        int dev = 0, cus = 0, per_cu = 0;
        (void)hipGetDevice(&dev); (void)hipDeviceGetAttribute(&cus, hipDeviceAttributeMultiprocessorCount, dev);
        if (hipFuncSetAttribute((const void*)mega_fwd, hipFuncAttributeMaxDynamicSharedMemorySize, LDS_BYTES) != hipSuccess) { fprintf(stderr, "hipFuncSetAttribute failed\n"); grid_blocks = -1; return; }
        if (hipOccupancyMaxActiveBlocksPerMultiprocessor(&per_cu, (const void*)mega_fwd, 512, LDS_BYTES) != hipSuccess || per_cu < 1) per_cu = 1;
        grid_blocks = cus * 1;
    }
    if (grid_blocks < 0) return;
    Params p{};
    for (int i = 0; i < 34; ++i) p.in[i] = (const float*)d_in[i];
    p.out = (float*)d_out; p.ws = (unsigned char*)d_ws; p.ph_lo = 0; p.ph_hi = N_PHASES;
    (void)hipMemsetAsync((unsigned char*)d_ws + WS_BAR, 0, 256, stream);
    void* args[] = {&p};
    hipError_t e = hipLaunchCooperativeKernel((const void*)mega_fwd, dim3(grid_blocks), dim3(512), args, LDS_BYTES, stream);
    if (e != hipSuccess) fprintf(stderr, "cooperative launch failed: %s (grid %d)\n", hipGetErrorString(e), grid_blocks);
}
```

```cpp
#include <hip/hip_runtime.h>
#include <hip/hip_cooperative_groups.h>
#include <cstdio>
namespace cg = cooperative_groups;

typedef unsigned short bf16_t;
typedef short bf16x8 __attribute__((ext_vector_type(8)));
typedef float f32x4 __attribute__((ext_vector_type(4)));
typedef unsigned u32x4 __attribute__((ext_vector_type(4)));
typedef unsigned u32x2 __attribute__((ext_vector_type(2)));
#define LAS __attribute__((address_space(3)))

constexpr int NTOK = 16896, NPR = 16384;
constexpr int LDP = 13568;
constexpr int C_Z = 0, C_XBC = 1024, C_DTR = 2560, C_BCX = 2576, C_Q = 5648, C_K = 6672, C_V = 6928, C_UV = 7184, C_GATE = 9232, C_END = 13328;
constexpr int NCOND = 132;
constexpr float EPSF = 1e-6f;

constexpr size_t WS_WIN = 0;
constexpr size_t WS_WBR = WS_WIN + (size_t)4 * 13568 * 1024 * 2;
constexpr size_t WS_WO = WS_WBR + (size_t)16 * 1024 * 1024 * 2;
constexpr size_t WS_WUP = WS_WO + (size_t)4 * 1024 * 1024 * 2;
constexpr size_t WS_WDN = WS_WUP + (size_t)4 * 5632 * 1024 * 2;
constexpr size_t WS_WADA = WS_WDN + (size_t)4 * 1024 * 2816 * 2;
constexpr size_t WS_CACT = WS_WADA + (size_t)4 * 6144 * 1024 * 2;
constexpr size_t WS_MOD = WS_CACT + (size_t)256 * 1024 * 2;
constexpr size_t WS_H = WS_MOD + (size_t)4 * NCOND * 6144 * 4;
constexpr size_t WS_MSUM = WS_H + (size_t)NTOK * 1024 * 2;
constexpr size_t WS_PROJ = WS_MSUM + (size_t)NTOK * 1024 * 4;
constexpr size_t WS_END = WS_PROJ + (size_t)NTOK * LDP * 2;
constexpr size_t WS_BAR = WS_END;
constexpr size_t WS_SSDST = WS_WADA;
constexpr size_t WS_SSDDEC = WS_WADA + (size_t)4 * 32 * 16 * 4096 * 4;
constexpr size_t UP_BYTES = (size_t)NTOK * 5632 * 2;

constexpr size_t O_YP = 0, O_YS = 16777216, O_PSSM = O_YS + 524288, O_PSSDC = O_PSSM + 1048576, O_PSCC = O_PSSDC + 73728,
                 O_PK = O_PSCC + 32768, O_PV = O_PK + 524288, O_PFFC = O_PV + 524288, O_SSSM = O_PFFC + 180224,
                 O_SSSDC = O_SSSM + 33554432, O_SSCC = O_SSSDC + 2359296, O_SK = O_SSCC + 1048576, O_SV = O_SK + 16777216,
                 O_SFFC = O_SV + 16777216, O_SGMV = O_SFFC + 5767168, O_END = O_SGMV + 2097152;

struct Params { const float* in[34]; float* out; unsigned char* ws; int ph_lo, ph_hi; };

constexpr int LDS_BYTES = 155648;

__device__ __forceinline__ float bf2f(bf16_t v) { return __uint_as_float((unsigned)v << 16); }
__device__ __forceinline__ float bflo(unsigned v) { return __uint_as_float(v << 16); }
__device__ __forceinline__ float bfhi(unsigned v) { return __uint_as_float(v & 0xffff0000u); }
__device__ __forceinline__ unsigned pk2(float lo, float hi) { unsigned r; asm("v_cvt_pk_bf16_f32 %0, %1, %2" : "=v"(r) : "v"(lo), "v"(hi)); return r; }
__device__ __forceinline__ bf16_t f2bf(float f) { return (bf16_t)(pk2(f, 0.f) & 0xffffu); }
__device__ __forceinline__ float shx(float v, int o, int lane) { return __int_as_float(__builtin_amdgcn_ds_bpermute((lane ^ o) << 2, __float_as_int(v))); }
__device__ __forceinline__ float wave_sum(float v, int lane) {
#pragma unroll
    for (int o = 32; o > 0; o >>= 1) v += shx(v, o, lane);
    return v;
}
__device__ __forceinline__ int otid() { int t = threadIdx.x; asm volatile("" : "+v"(t)); return t; }
__device__ __forceinline__ float sigmoidf_(float x) { return __builtin_amdgcn_rcpf(1.f + __expf(-x)); }
__device__ __forceinline__ float siluf_(float x) { return x * __builtin_amdgcn_rcpf(1.f + __expf(-x)); }
__device__ __forceinline__ float geluf_(float x) { const float u = 0.7978845608f * (x + 0.044715f * x * x * x); return x / (1.f + __expf(-2.f * u)); }
__device__ __forceinline__ float softplusf_(float x) { return fmaxf(x, 0.f) + log1pf(__expf(-fabsf(x))); }
__device__ __forceinline__ float silu_fast(float x) { return x * __builtin_amdgcn_rcpf(1.f + __expf(-x)); }
__device__ __forceinline__ float sigmoid_fast(float x) { return __builtin_amdgcn_rcpf(1.f + __expf(-x)); }
__device__ __forceinline__ float gelu_fast(float x) { const float u = 0.7978845608f * (x + 0.044715f * x * x * x); return x * __builtin_amdgcn_rcpf(1.f + __expf(-2.f * u)); }
__device__ __forceinline__ int cond_row(int r) { return r < NPR ? (r >> 12) : 4 + ((r - NPR) >> 2); }
__device__ __forceinline__ int seq_start(int r) { return r < NPR ? (r & ~4095) : NPR + ((r - NPR) & ~3); }

constexpr int BM = 256, BK = 64, HALF = 128, HTB = HALF * BK * 2;
__device__ __forceinline__ int lds_byte(int r, int c) { const int st = (r >> 4) * 2 + (c >> 5), rr = r & 15, cc = c & 31, ob = rr * 64 + cc * 2; return st * 1024 + (ob ^ (((ob >> 9) & 1) << 5)); }
__device__ __forceinline__ void stage_rc(int b, int& R, int& C) { const int st = b / 1024, sb = b % 1024, swz = sb ^ (((sb >> 9) & 1) << 5); R = (st >> 1) * 16 + swz / 64; C = (st & 1) * 32 + (swz % 64) / 2; }
__device__ __forceinline__ int perm32(int rho) { const int n = rho >> 4, i = rho & 15; return 8 * (i >> 2) + 4 * n + (i & 3); }

struct Unit { int pm, pn, z; };
struct Gemm { const bf16_t* A; const bf16_t* Bt; int lda, ldb, K, nM, nN; int ao0, ao1, ao2, ao3; size_t zB; };
__device__ __forceinline__ int gemm_aofs(const Gemm& g, int z) { return z == 0 ? g.ao0 : (z == 1 ? g.ao1 : (z == 2 ? g.ao2 : g.ao3)); }

template <int ZN> __device__ __forceinline__ bool unit_next(const Gemm& g, int i, Unit& u) {
    const int tile = i / ZN; u.z = i - tile * ZN;
    const long L = (long)tile * gridDim.x + blockIdx.x; const int nwg = g.nM * g.nN; if (L >= nwg) return false;
    int wgid = (int)L; { const int q = nwg / 8, r = nwg % 8, xcd = wgid % 8, off = wgid / 8; wgid = (xcd < r ? xcd * (q + 1) : r * (q + 1) + (xcd - r) * q) + off; }
    const int nig = 4 * g.nN, gid = wgid / nig, fm = gid * 4, gsz = (g.nM - fm) < 4 ? (g.nM - fm) : 4;
    u.pm = fm + ((wgid % nig) % gsz); u.pn = (wgid % nig) / gsz; return true;
}

template <class Epi, int ZN>
__device__ __forceinline__ void gemm_phase(LAS unsigned char* lds, const Gemm g, const Epi& E) {
    const int tid = otid(), wid = __builtin_amdgcn_readfirstlane(tid >> 6), lane = tid & 63, wr = wid >> 2, wc = wid & 3, fr = lane & 15, fq = lane >> 4;
    const int K = g.K, nt = K / BK;
    unsigned voffA[2], voffB[2];
#pragma unroll
    for (int i = 0; i < 2; ++i) { int R, C; stage_rc(tid * 16 + i * 8192, R, C); const int Rb = Epi::PERM ? ((R & ~31) + perm32(R & 31)) : R;
        voffA[i] = (unsigned)(R * g.lda + C) * 2u; voffB[i] = (unsigned)(Rb * g.ldb + C) * 2u; }
    const size_t kstep = (size_t)(BK * 2);
    const size_t hstepA = (size_t)HALF * g.lda * 2, hstepB = (size_t)HALF * g.ldb * 2;
    const size_t tstepA = 2 * hstepA, tstepB = 2 * hstepB;
    const unsigned ldsw = (unsigned)wid * 1024u;
    const int aoff = lds_byte(wr * 64 + fr, fq * 8), boff = lds_byte(wc * 32 + fr, fq * 8);
#define PG8_SA(b, h) (((b) * 2 + (h)) * HTB)
#define PG8_SB(b, h) ((4 + (b) * 2 + (h)) * HTB)
#define PG8_STAGE(bufoff, gbase, voff) do { _Pragma("unroll") for (int _i = 0; _i < 2; ++_i) \
        __builtin_amdgcn_global_load_lds((const unsigned*)((const char*)(gbase) + (voff)[_i]), (LAS unsigned*)(lds + (bufoff) + ldsw + _i * 8192), 16, 0, 0); } while (0)
#define PG8_LDA(dst, b, h) do { _Pragma("unroll") for (int m = 0; m < 4; ++m) _Pragma("unroll") for (int k = 0; k < 2; ++k) dst[m][k] = *(const LAS bf16x8*)(lds + PG8_SA(b, h) + aoff + m * 2048 + k * 1024); } while (0)
#define PG8_LDB(dst, b, h) do { _Pragma("unroll") for (int n = 0; n < 2; ++n) _Pragma("unroll") for (int k = 0; k < 2; ++k) dst[n][k] = *(const LAS bf16x8*)(lds + PG8_SB(b, h) + boff + n * 2048 + k * 1024); } while (0)
#define PG8_MMA(ai, bj, At, Bt) do { __builtin_amdgcn_s_setprio(1); _Pragma("unroll") for (int m = 0; m < 4; ++m) _Pragma("unroll") for (int n = 0; n < 2; ++n) _Pragma("unroll") for (int k = 0; k < 2; ++k) \
        acc[ai][bj][m][n] = __builtin_amdgcn_mfma_f32_16x16x32_bf16(Bt[n][k], At[m][k], acc[ai][bj][m][n], 0, 0, 0); __builtin_amdgcn_s_setprio(0); } while (0)
#define PG8_WAIT_V(n) asm volatile("s_waitcnt vmcnt(" #n ")" ::: "memory")
#define PG8_WAIT_L(n) asm volatile("s_waitcnt lgkmcnt(" #n ")" ::: "memory")
#define PG8_BAR __builtin_amdgcn_s_barrier()
#define PG8_SCHED __builtin_amdgcn_sched_barrier(0)
    Unit cur, nxt; int ui = 0;
    if (!unit_next<ZN>(g, 0, cur)) return;
    f32x4 acc[2][2][4][2];
#pragma unroll
    for (int a = 0; a < 2; ++a)
#pragma unroll
        for (int b = 0; b < 2; ++b)
#pragma unroll
            for (int m = 0; m < 4; ++m)
#pragma unroll
                for (int n = 0; n < 2; ++n) acc[a][b][m][n] = (f32x4){0.f, 0.f, 0.f, 0.f};
    bf16x8 At[4][2], B0[2][2], B1[2][2];
    const char* cA = (const char*)g.A + (size_t)cur.pm * tstepA + (size_t)gemm_aofs(g, cur.z) * 2;
    const char* cB = (const char*)g.Bt + (size_t)cur.pn * tstepB + (size_t)cur.z * g.zB * 2;
    PG8_WAIT_V(0);
    PG8_STAGE(PG8_SB(0, 0), cB, voffB); PG8_STAGE(PG8_SA(0, 0), cA, voffA); PG8_STAGE(PG8_SB(0, 1), cB + hstepB, voffB); PG8_STAGE(PG8_SA(0, 1), cA + hstepA, voffA);
    if (wr == 1) PG8_BAR;
    PG8_WAIT_V(4); PG8_BAR;
    PG8_STAGE(PG8_SB(1, 0), cB + kstep, voffB); PG8_STAGE(PG8_SA(1, 0), cA + kstep, voffA); PG8_STAGE(PG8_SB(1, 1), cB + hstepB + kstep, voffB);
    PG8_WAIT_V(6); PG8_BAR;
    for (;;) {
        const bool has_next = unit_next<ZN>(g, ui + 1, nxt);
        const char* nA = has_next ? (const char*)g.A + (size_t)nxt.pm * tstepA + (size_t)gemm_aofs(g, nxt.z) * 2 : cA;
        const char* nB = has_next ? (const char*)g.Bt + (size_t)nxt.pn * tstepB + (size_t)nxt.z * g.zB * 2 : cB;
        for (int t = 0; t < nt; t += 2) {
            const bool last = (t == nt - 2);
            const char* a1 = cA + (size_t)(t + 1) * kstep;
            const char* a2 = last ? nA : cA + (size_t)(t + 2) * kstep; const char* b2 = last ? nB : cB + (size_t)(t + 2) * kstep;
            const char* a3 = a2 + kstep; const char* b3 = b2 + kstep;
            PG8_LDB(B0, 0, 0); PG8_SCHED; PG8_LDA(At, 0, 0); PG8_STAGE(PG8_SA(1, 1), a1 + hstepA, voffA);
            PG8_WAIT_L(8); PG8_BAR; PG8_WAIT_L(0); PG8_MMA(0, 0, At, B0); PG8_BAR; PG8_SCHED;
            PG8_LDB(B1, 0, 1); PG8_STAGE(PG8_SB(0, 0), b2, voffB);
            PG8_BAR; PG8_WAIT_L(0); PG8_MMA(0, 1, At, B1); PG8_BAR;
            PG8_LDA(At, 0, 1); PG8_STAGE(PG8_SA(0, 0), a2, voffA);
            PG8_BAR; PG8_WAIT_L(0); PG8_MMA(1, 0, At, B0); PG8_BAR; PG8_SCHED;
            PG8_STAGE(PG8_SB(0, 1), b2 + hstepB, voffB);
            PG8_WAIT_V(6); PG8_BAR; PG8_MMA(1, 1, At, B1); PG8_BAR;
            PG8_LDB(B0, 1, 0); PG8_SCHED; PG8_LDA(At, 1, 0); PG8_STAGE(PG8_SA(0, 1), a2 + hstepA, voffA);
            PG8_WAIT_L(8); PG8_BAR; PG8_WAIT_L(0); PG8_MMA(0, 0, At, B0); PG8_BAR; PG8_SCHED;
            PG8_LDB(B1, 1, 1); PG8_STAGE(PG8_SB(1, 0), b3, voffB);
            PG8_BAR; PG8_WAIT_L(0); PG8_MMA(0, 1, At, B1); PG8_BAR;
            PG8_LDA(At, 1, 1); PG8_STAGE(PG8_SA(1, 0), a3, voffA);
            PG8_BAR; PG8_WAIT_L(0); PG8_MMA(1, 0, At, B0); PG8_BAR; PG8_SCHED;
            PG8_STAGE(PG8_SB(1, 1), b3 + hstepB, voffB);
            PG8_WAIT_V(6); PG8_BAR; PG8_MMA(1, 1, At, B1); PG8_BAR;
        }
        E(acc, cur, wr, wc, fr, fq);
        if (!has_next) break;
#pragma unroll
        for (int a = 0; a < 2; ++a)
#pragma unroll
            for (int b = 0; b < 2; ++b)
#pragma unroll
                for (int m = 0; m < 4; ++m)
#pragma unroll
                    for (int n = 0; n < 2; ++n) acc[a][b][m][n] = (f32x4){0.f, 0.f, 0.f, 0.f};
        cur = nxt; cA = nA; cB = nB; ++ui;
    }
    PG8_WAIT_V(0);
    if (wr == 0) PG8_BAR;
    PG8_BAR;
#undef PG8_SA
#undef PG8_SB
#undef PG8_STAGE
#undef PG8_LDA
#undef PG8_LDB
#undef PG8_MMA
#undef PG8_WAIT_V
#undef PG8_WAIT_L
#undef PG8_BAR
#undef PG8_SCHED
}

struct EpiMod {
    static constexpr bool PERM = false;
    float* mod; const float* bada;
    __device__ __forceinline__ void operator()(const f32x4 (&acc)[2][2][4][2], const Unit& u, int wr, int wc, int fr, int fq) const {
        f32x4 bv[2][2];
#pragma unroll
        for (int bj = 0; bj < 2; ++bj)
#pragma unroll
            for (int n = 0; n < 2; ++n) bv[bj][n] = *(const f32x4*)(bada + u.pn * BM + bj * HALF + wc * 32 + n * 16 + fq * 4);
#pragma unroll
        for (int ai = 0; ai < 2; ++ai)
#pragma unroll
            for (int m = 0; m < 4; ++m) { const int r = u.pm * BM + ai * HALF + wr * 64 + m * 16 + fr; if (r >= NCOND) continue;
#pragma unroll
                for (int bj = 0; bj < 2; ++bj)
#pragma unroll
                    for (int n = 0; n < 2; ++n) { const int c = u.pn * BM + bj * HALF + wc * 32 + n * 16 + fq * 4; const int layer = c / 6144, cc = c - layer * 6144;
                        *(f32x4*)(mod + ((size_t)(layer * NCOND + r)) * 6144 + cc) = acc[ai][bj][m][n] + bv[bj][n]; } }
    }
};
struct EpiProj {
    static constexpr bool PERM = true;
    bf16_t* O;
    __device__ __forceinline__ void operator()(const f32x4 (&acc)[2][2][4][2], const Unit& u, int wr, int wc, int fr, int fq) const {
#pragma unroll
        for (int bj = 0; bj < 2; ++bj) { const int c = u.pn * BM + bj * HALF + wc * 32 + fq * 8; const int mode = (c >= C_UV + 1024 && c < C_GATE) ? 1 : 0;
#pragma unroll
            for (int ai = 0; ai < 2; ++ai)
#pragma unroll
                for (int m = 0; m < 4; ++m) { const int r = u.pm * BM + ai * HALF + wr * 64 + m * 16 + fr;
                    float v[8];
#pragma unroll
                    for (int i = 0; i < 8; ++i) { float x = acc[ai][bj][m][i >> 2][i & 3]; v[i] = (mode == 1 ? gelu_fast(x) : x); }
                    u32x4 o; o[0] = pk2(v[0], v[1]); o[1] = pk2(v[2], v[3]); o[2] = pk2(v[4], v[5]); o[3] = pk2(v[6], v[7]);
                    *(u32x4*)(O + (size_t)r * LDP + c) = o; } }
    }
};
struct EpiUp {
    static constexpr bool PERM = true;
    bf16_t* O;
    __device__ __forceinline__ void operator()(const f32x4 (&acc)[2][2][4][2], const Unit& u, int wr, int wc, int fr, int fq) const {
#pragma unroll
        for (int bj = 0; bj < 2; ++bj) { const int c = u.pn * BM + bj * HALF + wc * 32 + fq * 8;
#pragma unroll
            for (int ai = 0; ai < 2; ++ai)
#pragma unroll
                for (int m = 0; m < 4; ++m) { const int r = u.pm * BM + ai * HALF + wr * 64 + m * 16 + fr;
                    const f32x4 a = acc[ai][bj][m][0], b = acc[ai][bj][m][1];
                    u32x4 o; o[0] = pk2(a[0], a[1]); o[1] = pk2(a[2], a[3]); o[2] = pk2(b[0], b[1]); o[3] = pk2(b[2], b[3]);
                    *(u32x4*)(O + (size_t)r * 5632 + c) = o; } }
    }
};
struct EpiBranch {
    static constexpr bool PERM = true;
    const bf16_t* proj; float* msum; bf16_t* merged;
    __device__ __forceinline__ void operator()(const f32x4 (&acc)[2][2][4][2], const Unit& u, int wr, int wc, int fr, int fq) const {
        const int z = u.z;
        u32x4 gt[2][2], pv[2][2];
        const int c0 = u.pn * BM + wc * 32 + fq * 8, r0 = u.pm * BM + wr * 64 + fr;
#define EB_LOAD(k, buf) do { const int bj_ = (k) >> 2, ai_ = ((k) >> 1) & 1, m0_ = ((k) & 1) * 2; _Pragma("unroll") for (int mm = 0; mm < 2; ++mm) { const int r = r0 + ai_ * HALF + (m0_ + mm) * 16, c = c0 + bj_ * HALF; \
            gt[buf][mm] = *(const u32x4*)(proj + (size_t)r * LDP + C_GATE + z * 1024 + c); pv[buf][mm] = (u32x4){0u, 0u, 0u, 0u}; \
            if (z > 0) pv[buf][mm] = *(const u32x4*)(merged + (size_t)r * 1024 + c); } } while (0)
        EB_LOAD(0, 0);
#pragma unroll
        for (int k = 0; k < 8; ++k) { const int bj = k >> 2, ai = (k >> 1) & 1, m0 = (k & 1) * 2, buf = k & 1;
            if (k < 7) { if (buf == 0) EB_LOAD(k + 1, 1); else EB_LOAD(k + 1, 0); }
#pragma unroll
            for (int mm = 0; mm < 2; ++mm) { const int m = m0 + mm; const int r = r0 + ai * HALF + m * 16, c = c0 + bj * HALF;
                const f32x4 a = acc[ai][bj][m][0], b = acc[ai][bj][m][1]; const u32x4 gv = gt[buf][mm], p = pv[buf][mm];
                u32x4 o;
                o[0] = pk2(bflo(p[0]) + sigmoid_fast(bflo(gv[0])) * a[0], bfhi(p[0]) + sigmoid_fast(bfhi(gv[0])) * a[1]); o[1] = pk2(bflo(p[1]) + sigmoid_fast(bflo(gv[1])) * a[2], bfhi(p[1]) + sigmoid_fast(bfhi(gv[1])) * a[3]);
                o[2] = pk2(bflo(p[2]) + sigmoid_fast(bflo(gv[2])) * b[0], bfhi(p[2]) + sigmoid_fast(bfhi(gv[2])) * b[1]); o[3] = pk2(bflo(p[3]) + sigmoid_fast(bflo(gv[3])) * b[2], bfhi(p[3]) + sigmoid_fast(bfhi(gv[3])) * b[3]);
                *(u32x4*)(merged + (size_t)r * 1024 + c) = o; } }
#undef EB_LOAD
    }
};
struct EpiResid {
    static constexpr bool PERM = false;
    const float* xin_p; const float* xin_s; float* xout; const float* ga;
    __device__ __forceinline__ void operator()(const f32x4 (&acc)[2][2][4][2], const Unit& u, int wr, int wc, int fr, int fq) const {
        const float* gr = ga + (size_t)(u.pm >> 4) * 6144;
        f32x4 gv[2][2];
#pragma unroll
        for (int bj = 0; bj < 2; ++bj)
#pragma unroll
            for (int n = 0; n < 2; ++n) gv[bj][n] = *(const f32x4*)(gr + u.pn * BM + bj * HALF + wc * 32 + n * 16 + fq * 4);
#pragma unroll
        for (int am = 0; am < 4; ++am) { const int ai = am >> 1, m0 = (am & 1) * 2;
            f32x4 xv[2][2][2];
#pragma unroll
            for (int mm = 0; mm < 2; ++mm) { const int r = u.pm * BM + ai * HALF + wr * 64 + (m0 + mm) * 16 + fr;
#pragma unroll
                for (int bj = 0; bj < 2; ++bj)
#pragma unroll
                    for (int n = 0; n < 2; ++n) xv[mm][bj][n] = *(const f32x4*)(xin_p + (size_t)r * 1024 + u.pn * BM + bj * HALF + wc * 32 + n * 16 + fq * 4); }
#pragma unroll
            for (int mm = 0; mm < 2; ++mm) { const int r = u.pm * BM + ai * HALF + wr * 64 + (m0 + mm) * 16 + fr;
#pragma unroll
                for (int bj = 0; bj < 2; ++bj)
#pragma unroll
                    for (int n = 0; n < 2; ++n) *(f32x4*)(xout + (size_t)r * 1024 + u.pn * BM + bj * HALF + wc * 32 + n * 16 + fq * 4) = xv[mm][bj][n] + gv[bj][n] * acc[ai][bj][m0 + mm][n]; } }
    }
};

struct CTile { const float* src; bf16_t* dst; int K, N, k0, n0; };
__device__ __forceinline__ CTile conv_decode(const Params& P, int t) {
    constexpr int T_IN = 3392, T_BR = 1024, T_O = 256, T_UP = 1408, T_DN = 704, T_ADA = 1536, T_L = T_IN + T_BR + T_O + T_UP + T_DN + T_ADA;
    const int layer = t / T_L; int r = t - layer * T_L; CTile c;
    if (r < T_IN) { c.src = P.in[13] + (size_t)layer * 1024 * 13328; c.dst = (bf16_t*)(P.ws + WS_WIN) + (size_t)layer * 13568 * 1024; c.K = 1024; c.N = 13328; c.k0 = (r / 212) * 64; c.n0 = (r % 212) * 64; return c; }
    r -= T_IN;
    if (r < T_BR) { const int br = r >> 8, q = r & 255; c.src = P.in[26] + (size_t)(layer * 4 + br) * 1048576; c.dst = (bf16_t*)(P.ws + WS_WBR) + (size_t)(layer * 4 + br) * 1048576; c.K = 1024; c.N = 1024; c.k0 = (q >> 4) * 64; c.n0 = (q & 15) * 64; return c; }
    r -= T_BR;
    if (r < T_O) { c.src = P.in[27] + (size_t)layer * 1048576; c.dst = (bf16_t*)(P.ws + WS_WO) + (size_t)layer * 1048576; c.K = 1024; c.N = 1024; c.k0 = (r >> 4) * 64; c.n0 = (r & 15) * 64; return c; }
    r -= T_O;
    if (r < T_UP) { c.src = P.in[29] + (size_t)layer * 1024 * 5632; c.dst = (bf16_t*)(P.ws + WS_WUP) + (size_t)layer * 5632 * 1024; c.K = 1024; c.N = 5632; c.k0 = (r / 88) * 64; c.n0 = (r % 88) * 64; return c; }
    r -= T_UP;
    if (r < T_DN) { c.src = P.in[32] + (size_t)layer * 2816 * 1024; c.dst = (bf16_t*)(P.ws + WS_WDN) + (size_t)layer * 1024 * 2816; c.K = 2816; c.N = 1024; c.k0 = (r >> 4) * 64; c.n0 = (r & 15) * 64; return c; }
    r -= T_DN;
    c.src = P.in[10] + (size_t)layer * 1024 * 6144; c.dst = (bf16_t*)(P.ws + WS_WADA) + (size_t)layer * 6144 * 1024; c.K = 1024; c.N = 6144; c.k0 = (r / 96) * 64; c.n0 = (r % 96) * 64; return c;
}
__device__ __forceinline__ void phase_convert(const Params& P, float* T) {
    constexpr int NT = 4 * 8320;
    const int tid = otid();
    int t = blockIdx.x;
    CTile cur = conv_decode(P, t < NT ? t : 0);
    float v[8], nv[8];
#pragma unroll
    for (int e = 0; e < 8; ++e) { const int idx = tid + e * 512, k = idx >> 6, n = idx & 63; v[e] = (t < NT && cur.n0 + n < cur.N) ? cur.src[(size_t)(cur.k0 + k) * cur.N + cur.n0 + n] : 0.f; }
    for (; t < NT; t += gridDim.x) {
        const int tn = t + gridDim.x; const bool hn = tn < NT; const CTile nxt = conv_decode(P, hn ? tn : 0);
#pragma unroll
        for (int e = 0; e < 8; ++e) { const int idx = tid + e * 512, k = idx >> 6, n = idx & 63; nv[e] = (hn && nxt.n0 + n < nxt.N) ? nxt.src[(size_t)(nxt.k0 + k) * nxt.N + nxt.n0 + n] : 0.f; }
#pragma unroll
        for (int e = 0; e < 8; ++e) { const int idx = tid + e * 512, k = idx >> 6, n = idx & 63; T[k * 65 + n] = v[e]; }
        __syncthreads();
        { const int n = tid >> 3, kc = (tid & 7) * 8; float x[8];
#pragma unroll
          for (int j = 0; j < 8; ++j) x[j] = T[(kc + j) * 65 + n];
          u32x4 o; o[0] = pk2(x[0], x[1]); o[1] = pk2(x[2], x[3]); o[2] = pk2(x[4], x[5]); o[3] = pk2(x[6], x[7]);
          *(u32x4*)(cur.dst + (size_t)(cur.n0 + n) * cur.K + cur.k0 + kc) = o; }
        __syncthreads();
#pragma unroll
        for (int e = 0; e < 8; ++e) v[e] = nv[e];
        cur = nxt;
    }
    bf16_t* cact = (bf16_t*)(P.ws + WS_CACT);
    for (int i = blockIdx.x * 512 + otid(); i < 256 * 1024; i += gridDim.x * 512) {
        const int r = i >> 10, c = i & 1023; float v = 0.f;
        if (r < 4) v = siluf_(P.in[2][r * 1024 + c]); else if (r < NCOND) v = siluf_(P.in[3][(r - 4) * 1024 + c]);
        cact[i] = f2bf(v);
    }
}

__device__ __forceinline__ void phase_norm(const float* xp, const float* xs, const float* g, const float* modL, int shofs, int scofs, bf16_t* hout) {
    const int tid = otid(); const int w = tid >> 6, lane = tid & 63;
    for (int r = blockIdx.x * 8 + w; r < NTOK; r += gridDim.x * 8) {
        const float* x = r < NPR ? xp + (size_t)r * 1024 : xs + (size_t)(r - NPR) * 1024;
        const float* mr = modL + (size_t)cond_row(r) * 6144;
        f32x4 v[4]; float ss = 0.f;
#pragma unroll
        for (int i = 0; i < 4; ++i) { v[i] = *(const f32x4*)(x + i * 256 + lane * 4); ss += v[i][0] * v[i][0] + v[i][1] * v[i][1] + v[i][2] * v[i][2] + v[i][3] * v[i][3]; }
        ss = wave_sum(ss, lane); const float rs = rsqrtf(ss * (1.f / 1024.f) + EPSF);
#pragma unroll
        for (int i = 0; i < 4; ++i) { const int c = i * 256 + lane * 4;
            const f32x4 gv = *(const f32x4*)(g + c), sc = *(const f32x4*)(mr + scofs + c), sh = *(const f32x4*)(mr + shofs + c);
            f32x4 o = v[i] * rs * gv * (sc + 1.f) + sh;
            u32x2 pk; pk[0] = pk2(o[0], o[1]); pk[1] = pk2(o[2], o[3]);
            *(u32x2*)(hout + (size_t)r * 1024 + c) = pk; }
    }
}
__device__ __forceinline__ void phase_final_norm(float* x, const float* g) {
    const int tid = otid(); const int w = tid >> 6, lane = tid & 63;
    for (int r = blockIdx.x * 8 + w; r < NTOK; r += gridDim.x * 8) {
        float* xr = x + (size_t)r * 1024; f32x4 v[4]; float ss = 0.f;
#pragma unroll
        for (int i = 0; i < 4; ++i) { v[i] = *(const f32x4*)(xr + i * 256 + lane * 4); ss += v[i][0] * v[i][0] + v[i][1] * v[i][1] + v[i][2] * v[i][2] + v[i][3] * v[i][3]; }
        ss = wave_sum(ss, lane); const float rs = rsqrtf(ss * (1.f / 1024.f) + EPSF);
#pragma unroll
        for (int i = 0; i < 4; ++i) { const int c = i * 256 + lane * 4; const f32x4 gv = *(const f32x4*)(g + c); *(f32x4*)(xr + c) = v[i] * rs * gv; }
    }
}

template <int MODE>
__device__ __forceinline__ void ssd_item(const Params& P, int layer, int item, float* L) {
    const int tid = otid(), w = tid >> 6, lane = tid & 63;
    bf16_t* proj = (bf16_t*)(P.ws + WS_PROJ);
    float* states = (float*)(P.ws + WS_SSDST); float* decs = (float*)(P.ws + WS_SSDDEC);
    int r0, nsteps, half, seq0, b = 0, c = 0, sb = 0;
    if (MODE == 2) { sb = item >> 1; half = item & 1; r0 = NPR + sb * 4; nsteps = 4; seq0 = r0; }
    else { b = item >> 6; c = (item >> 1) & 31; half = item & 1; r0 = b * 4096 + c * 128; nsteps = 128; seq0 = b * 4096; }
    float* XS = L; float* ZS = XS + 16 * 512; float* BS = ZS + 16 * 512; float* CS = BS + 16 * 128; float* DTS = CS + 16 * 128; float* DAS = DTS + 128; float* SSQ = DAS + 128;
    const float* cw = P.in[14] + (size_t)layer * 4 * 1536; const float* cb = P.in[15] + (size_t)layer * 1536;
    const float* prev = P.in[5] + ((size_t)(layer * 128 + sb)) * 3 * 1536;
    const int hd = half * 8 + w, gl = w >> 2;
    float h[64];
    if (MODE == 0) {
#pragma unroll
        for (int n = 0; n < 64; ++n) h[n] = 0.f;
    } else {
        const float* s0p = (MODE == 1) ? states + ((size_t)((b * 32 + c) * 16 + hd)) * 4096 + lane * 64
                                       : P.in[4] + ((size_t)((layer * 128 + sb) * 16 + hd)) * 4096 + lane * 64;
#pragma unroll
        for (int n4 = 0; n4 < 16; ++n4) { const f32x4 v = *(const f32x4*)(s0p + n4 * 4); h[n4 * 4] = v[0]; h[n4 * 4 + 1] = v[1]; h[n4 * 4 + 2] = v[2]; h[n4 * 4 + 3] = v[3]; }
    }
    const float Dh = P.in[18][layer * 16 + hd];
    float decp = 1.f;
    for (int s0 = 0; s0 < nsteps; s0 += 16) {
        const int ns = (nsteps - s0) < 16 ? (nsteps - s0) : 16;
        __syncthreads();
        for (int idx = tid; idx < ns * 768; idx += 512) {
            const int t = idx / 768, ch = idx - t * 768;
            int cx;
            if (ch < 512) cx = half * 512 + ch; else if (ch < 640) cx = 1024 + half * 128 + (ch - 512); else cx = 1280 + half * 128 + (ch - 640);
            float a = cb[cx];
#pragma unroll
            for (int k = 0; k < 4; ++k) { const int step = s0 + t - 3 + k, rr = r0 + step; float raw;
                if (rr >= seq0) raw = bf2f(proj[(size_t)rr * LDP + C_XBC + cx]);
                else raw = (MODE == 2) ? prev[(3 + step) * 1536 + cx] : 0.f;
                a += cw[k * 1536 + cx] * raw; }
            a = siluf_(a);
            if (ch < 512) { XS[t * 512 + ch] = a; if (MODE != 0) ZS[t * 512 + ch] = bf2f(proj[(size_t)(r0 + s0 + t) * LDP + C_Z + cx]); }
            else if (ch < 640) BS[t * 128 + ch - 512] = a; else CS[t * 128 + ch - 640] = a;
        }
        if (tid < ns * 8) { const int t = tid >> 3, ww = tid & 7, hh = half * 8 + ww;
            const float dt = softplusf_(bf2f(proj[(size_t)(r0 + s0 + t) * LDP + C_DTR + hh]) + P.in[16][layer * 16 + hh]);
            DTS[t * 8 + ww] = dt; DAS[t * 8 + ww] = __expf(-dt * __expf(P.in[17][layer * 16 + hh])); }
        __syncthreads();
        for (int t = 0; t < ns; ++t) {
            const float a = DAS[t * 8 + w], dt = DTS[t * 8 + w], xv = XS[t * 512 + w * 64 + lane], xd = xv * dt; decp *= a;
            const f32x4* B4 = (const f32x4*)(BS + t * 128 + gl * 64);
#pragma unroll
            for (int n4 = 0; n4 < 16; ++n4) { const f32x4 bv = B4[n4];
                h[n4 * 4] = a * h[n4 * 4] + xd * bv[0]; h[n4 * 4 + 1] = a * h[n4 * 4 + 1] + xd * bv[1]; h[n4 * 4 + 2] = a * h[n4 * 4 + 2] + xd * bv[2]; h[n4 * 4 + 3] = a * h[n4 * 4 + 3] + xd * bv[3]; }
            if (MODE != 0) {
                const f32x4* C4 = (const f32x4*)(CS + t * 128 + gl * 64); float y0 = 0.f, y1 = 0.f;
#pragma unroll
                for (int n4 = 0; n4 < 16; ++n4) { const f32x4 cv = C4[n4]; y0 += h[n4 * 4] * cv[0] + h[n4 * 4 + 2] * cv[2]; y1 += h[n4 * 4 + 1] * cv[1] + h[n4 * 4 + 3] * cv[3]; }
                float y = y0 + y1 + Dh * xv; y *= siluf_(ZS[t * 512 + w * 64 + lane]);
                const float sq = wave_sum(y * y, lane); if (lane == 0) SSQ[(s0 + t) * 8 + w] = sq;
                proj[(size_t)(r0 + s0 + t) * LDP + C_Z + hd * 64 + lane] = f2bf(y);
            }
        }
    }
    if (MODE == 0) {
        float* sp = states + ((size_t)((b * 32 + c) * 16 + hd)) * 4096 + lane * 64;
#pragma unroll
        for (int n4 = 0; n4 < 16; ++n4) *(f32x4*)(sp + n4 * 4) = (f32x4){h[n4 * 4], h[n4 * 4 + 1], h[n4 * 4 + 2], h[n4 * 4 + 3]};
        if (lane == 0) decs[(b * 32 + c) * 16 + hd] = decp;
    }
    if (MODE == 2) {
        float* sp = P.out + O_SSSM + ((size_t)((layer * 128 + sb) * 16 + hd)) * 4096 + lane * 64;
#pragma unroll
        for (int n4 = 0; n4 < 16; ++n4) *(f32x4*)(sp + n4 * 4) = (f32x4){h[n4 * 4], h[n4 * 4 + 1], h[n4 * 4 + 2], h[n4 * 4 + 3]};
    }
    if (MODE != 0) {
        __syncthreads();
        const float ng = P.in[19][layer * 1024 + hd * 64 + lane];
        for (int t = 0; t < nsteps; ++t) {
            const float tot = SSQ[t * 8 + gl * 4] + SSQ[t * 8 + gl * 4 + 1] + SSQ[t * 8 + gl * 4 + 2] + SSQ[t * 8 + gl * 4 + 3];
            const float sc = rsqrtf(tot * (1.f / 256.f) + EPSF) * ng;
            bf16_t* ap = proj + (size_t)(r0 + t) * LDP + C_Z + hd * 64 + lane; *ap = f2bf(bf2f(*ap) * sc);
        }
    }
}

__device__ __forceinline__ int xt_idx(int row, int t) { return row * 136 + ((((t >> 3) ^ ((row >> 3) & 15)) << 3) | (t & 7)); }
__device__ __forceinline__ void ssd_stage_dt(const Params& P, int layer, const bf16_t* proj, size_t r0, int g, float* DT, float* ACS, int tid) {
    { const int hh = tid >> 7, t = tid & 127, hd = g * 4 + hh;
      const float dt = softplusf_(bf2f(proj[(r0 + t) * LDP + C_DTR + hd]) + P.in[16][layer * 16 + hd]);
      DT[hh * 128 + t] = dt; ACS[hh * 128 + t] = -dt * __expf(P.in[17][layer * 16 + hd]); }
    __syncthreads();
    if (tid < 256) { const int hh = tid >> 6, l = tid & 63; const float a0 = ACS[hh * 128 + 2 * l], a1 = ACS[hh * 128 + 2 * l + 1]; float sum = a0 + a1;
#pragma unroll
        for (int o = 1; o < 64; o <<= 1) { const float v = __int_as_float(__builtin_amdgcn_ds_bpermute(((l - o) & 63) << 2, __float_as_int(sum))); if (l >= o) sum += v; }
        ACS[hh * 128 + 2 * l] = sum - a1; ACS[hh * 128 + 2 * l + 1] = sum; }
    __syncthreads();
}
template <int PASS>
__device__ __forceinline__ void ssd_stage_conv(const Params& P, int layer, const bf16_t* proj, size_t r0, bool first, int g, const float* DT, const float* ACS, bf16_t* XT4, bf16_t* Bx, bf16_t* Cs, int tid) {
    const int slot = tid & 63, seg = tid >> 6;
    if (slot < (PASS ? 48 : 40)) {
        int cx; if (slot < 32) cx = g * 256 + slot * 8; else if (slot < 40) cx = 1024 + g * 64 + (slot - 32) * 8; else cx = 1280 + g * 64 + (slot - 40) * 8;
        const float* cw = P.in[14] + (size_t)layer * 4 * 1536 + cx; const float* cb = P.in[15] + (size_t)layer * 1536 + cx;
        float wt[4][8], bb[8], win[3][8];
#pragma unroll
        for (int k = 0; k < 4; ++k) { const f32x4 a = *(const f32x4*)(cw + k * 1536), c = *(const f32x4*)(cw + k * 1536 + 4);
#pragma unroll
            for (int i = 0; i < 4; ++i) { wt[k][i] = a[i]; wt[k][4 + i] = c[i]; } }
        { const f32x4 a = *(const f32x4*)cb, c = *(const f32x4*)(cb + 4);
#pragma unroll
          for (int i = 0; i < 4; ++i) { bb[i] = a[i]; bb[4 + i] = c[i]; } }
        const int t0 = seg * 16;
#pragma unroll
        for (int k = 0; k < 3; ++k) { u32x4 raw = (u32x4){0u, 0u, 0u, 0u};
            if (!(first && seg == 0)) raw = *(const u32x4*)(proj + (r0 + t0 - 3 + k) * LDP + C_XBC + cx);
#pragma unroll
            for (int i = 0; i < 4; ++i) { win[k][2 * i] = bflo(raw[i]); win[k][2 * i + 1] = bfhi(raw[i]); } }
        u32x4 cur4[4], nxt4[4];
#pragma unroll
        for (int q = 0; q < 4; ++q) { cur4[q] = *(const u32x4*)(proj + (r0 + t0 + q) * LDP + C_XBC + cx); nxt4[q] = cur4[q]; }
        for (int gq = 0; gq < 4; ++gq) {
            if (gq < 3) {
#pragma unroll
                for (int q = 0; q < 4; ++q) nxt4[q] = *(const u32x4*)(proj + (r0 + t0 + gq * 4 + 4 + q) * LDP + C_XBC + cx); }
#pragma unroll
            for (int q = 0; q < 4; ++q) {
                const int t = t0 + gq * 4 + q; const u32x4 raw = cur4[q];
                float cur[8], o[8];
#pragma unroll
                for (int i = 0; i < 4; ++i) { cur[2 * i] = bflo(raw[i]); cur[2 * i + 1] = bfhi(raw[i]); }
#pragma unroll
                for (int i = 0; i < 8; ++i) { o[i] = siluf_(bb[i] + wt[0][i] * win[0][i] + wt[1][i] * win[1][i] + wt[2][i] * win[2][i] + wt[3][i] * cur[i]); win[0][i] = win[1][i]; win[1][i] = win[2][i]; win[2][i] = cur[i]; }
                if (slot < 32) { const int hh = slot >> 3, p0 = (slot & 7) * 8; float sc = DT[hh * 128 + t]; if (PASS == 0) sc *= __expf(ACS[hh * 128 + 127] - ACS[hh * 128 + t]);
#pragma unroll
                    for (int i = 0; i < 8; ++i) XT4[xt_idx(hh * 64 + p0 + i, t)] = f2bf(o[i] * sc); }
                else if (slot < 40) { const int n0 = (slot - 32) * 8;
                    if (PASS == 0) {
#pragma unroll
                        for (int i = 0; i < 8; ++i) Bx[xt_idx(n0 + i, t)] = f2bf(o[i]); }
                    else { u32x4 pk; pk[0] = pk2(o[0], o[1]); pk[1] = pk2(o[2], o[3]); pk[2] = pk2(o[4], o[5]); pk[3] = pk2(o[6], o[7]); *(u32x4*)(Bx + t * 72 + n0) = pk; } }
                else { const int n0 = (slot - 40) * 8; u32x4 pk; pk[0] = pk2(o[0], o[1]); pk[1] = pk2(o[2], o[3]); pk[2] = pk2(o[4], o[5]); pk[3] = pk2(o[6], o[7]); *(u32x4*)(Cs + t * 72 + n0) = pk; }
            }
#pragma unroll
            for (int q = 0; q < 4; ++q) cur4[q] = nxt4[q];
        }
    }
}
__device__ __forceinline__ void ssd_pass1_item(const Params& P, int layer, int item, unsigned char* lds) {
    const int tid = otid(), w = __builtin_amdgcn_readfirstlane(tid >> 6), lane = tid & 63, fr = lane & 15, fq = lane >> 4;
    const int b = item >> 7, c = (item >> 2) & 31, g = item & 3; const size_t r0 = (size_t)b * 4096 + (size_t)c * 128;
    const bf16_t* proj = (const bf16_t*)(P.ws + WS_PROJ);
    float* states = (float*)(P.ws + WS_SSDST); float* decs = (float*)(P.ws + WS_SSDDEC);
    bf16_t* XT4 = (bf16_t*)lds; bf16_t* BT = XT4 + 256 * 136; float* DT = (float*)(BT + 64 * 136); float* ACS = DT + 512;
    __syncthreads();
    ssd_stage_dt(P, layer, proj, r0, g, DT, ACS, tid);
    ssd_stage_conv<0>(P, layer, proj, r0, c == 0, g, DT, ACS, XT4, BT, nullptr, tid);
    __syncthreads();
    const int hh = w >> 1, pb = (w & 1) * 2;
    f32x4 acc[2][4];
#pragma unroll
    for (int pi = 0; pi < 2; ++pi)
#pragma unroll
        for (int nt = 0; nt < 4; ++nt) acc[pi][nt] = (f32x4){0.f, 0.f, 0.f, 0.f};
#pragma unroll
    for (int ks = 0; ks < 4; ++ks) { bf16x8 a[2];
#pragma unroll
        for (int pi = 0; pi < 2; ++pi) a[pi] = *(const bf16x8*)(XT4 + xt_idx(hh * 64 + (pb + pi) * 16 + fr, ks * 32 + fq * 8));
#pragma unroll
        for (int nt = 0; nt < 4; ++nt) { const bf16x8 bv = *(const bf16x8*)(BT + xt_idx(nt * 16 + fr, ks * 32 + fq * 8));
#pragma unroll
            for (int pi = 0; pi < 2; ++pi) acc[pi][nt] = __builtin_amdgcn_mfma_f32_16x16x32_bf16(a[pi], bv, acc[pi][nt], 0, 0, 0); } }
    float* sp = states + ((size_t)((b * 32 + c) * 16 + g * 4 + hh)) * 4096;
#pragma unroll
    for (int pi = 0; pi < 2; ++pi)
#pragma unroll
        for (int nt = 0; nt < 4; ++nt)
#pragma unroll
            for (int j = 0; j < 4; ++j) sp[((pb + pi) * 16 + fq * 4 + j) * 64 + nt * 16 + fr] = acc[pi][nt][j];
    if (tid < 4) decs[(b * 32 + c) * 16 + g * 4 + tid] = __expf(ACS[tid * 128 + 127]);
}
__device__ __forceinline__ void ssd_pass3_item(const Params& P, int layer, int item, unsigned char* lds, bool dry = false) {
    const int tid = otid(), w = __builtin_amdgcn_readfirstlane(tid >> 6), lane = tid & 63, fr = lane & 15, fq = lane >> 4;
    const int b = item >> 7, c = (item >> 2) & 31, g = item & 3; const size_t r0 = (size_t)b * 4096 + (size_t)c * 128;
    bf16_t* proj = (bf16_t*)(P.ws + WS_PROJ);
    const float* states = (const float*)(P.ws + WS_SSDST);
    bf16_t* Cs = (bf16_t*)lds; bf16_t* Bs = Cs + 128 * 72; bf16_t* Sin = Bs; bf16_t* XT4 = Bs + 128 * 72; bf16_t* Ms = XT4 + 256 * 136; float* DT = (float*)(Ms + 128 * 136); float* ACS = DT + 512;
    __syncthreads();
    ssd_stage_dt(P, layer, proj, r0, g, DT, ACS, tid);
    ssd_stage_conv<1>(P, layer, proj, r0, c == 0, g, DT, ACS, XT4, Bs, Cs, tid);
    __syncthreads();
    f32x4 CB[8];
#pragma unroll
    for (int st = 0; st < 8; ++st) { CB[st] = (f32x4){0.f, 0.f, 0.f, 0.f};
        if (st <= w) {
#pragma unroll
            for (int ks = 0; ks < 2; ++ks) { const bf16x8 a = *(const bf16x8*)(Cs + (16 * w + fr) * 72 + ks * 32 + fq * 8), bv = *(const bf16x8*)(Bs + (16 * st + fr) * 72 + ks * 32 + fq * 8);
                CB[st] = __builtin_amdgcn_mfma_f32_16x16x32_bf16(a, bv, CB[st], 0, 0, 0); } } }
    float ssq[4] = {0.f, 0.f, 0.f, 0.f};
    const int nks = (w >> 1) + 1;
    bf16_t* zrow[4];
#pragma unroll
    for (int j = 0; j < 4; ++j) zrow[j] = proj + (r0 + 16 * w + fq * 4 + j) * LDP + C_Z + g * 256 + fr;
    f32x4 sna, snc;
    { const float* sp = states + ((size_t)((b * 32 + c) * 16 + g * 4)) * 4096 + (tid >> 3) * 64 + (tid & 7) * 8; sna = *(const f32x4*)sp; snc = *(const f32x4*)(sp + 4); }
    for (int hh = 0; hh < 4; ++hh) {
        const int hd = g * 4 + hh;
        __syncthreads();
        { const int p = tid >> 3, n0 = (tid & 7) * 8;
          u32x4 pk; pk[0] = pk2(sna[0], sna[1]); pk[1] = pk2(sna[2], sna[3]); pk[2] = pk2(snc[0], snc[1]); pk[3] = pk2(snc[2], snc[3]);
          *(u32x4*)(Sin + p * 72 + n0) = pk;
          if (hh < 3) { const float* sp = states + ((size_t)((b * 32 + c) * 16 + hd + 1)) * 4096 + p * 64 + n0; sna = *(const f32x4*)sp; snc = *(const f32x4*)(sp + 4); } }
        float acs_t[4];
#pragma unroll
        for (int j = 0; j < 4; ++j) acs_t[j] = ACS[hh * 128 + 16 * w + fq * 4 + j];
#pragma unroll
        for (int st = 0; st < 8; ++st) { if (st <= (w | 1)) { const float acs_s = ACS[hh * 128 + 16 * st + fr];
#pragma unroll
            for (int j = 0; j < 4; ++j) { const int t = 16 * w + fq * 4 + j, sx = 16 * st + fr; const float v = (st <= w && sx <= t) ? CB[st][j] * __expf(acs_t[j] - acs_s) : 0.f; Ms[t * 136 + sx] = f2bf(v); } } }
        __syncthreads();
        bf16_t zv[4][4];
#pragma unroll
        for (int j = 0; j < 4; ++j)
#pragma unroll
            for (int pt = 0; pt < 4; ++pt) zv[j][pt] = *(zrow[j] + hh * 64 + pt * 16);
        f32x4 yd[4], yo[4];
#pragma unroll
        for (int pt = 0; pt < 4; ++pt) { yd[pt] = (f32x4){0.f, 0.f, 0.f, 0.f}; yo[pt] = (f32x4){0.f, 0.f, 0.f, 0.f}; }
        for (int ks = 0; ks < nks; ++ks) { const bf16x8 a = *(const bf16x8*)(Ms + (16 * w + fr) * 136 + ks * 32 + fq * 8);
#pragma unroll
            for (int pt = 0; pt < 4; ++pt) { const bf16x8 bv = *(const bf16x8*)(XT4 + xt_idx(hh * 64 + pt * 16 + fr, ks * 32 + fq * 8)); yd[pt] = __builtin_amdgcn_mfma_f32_16x16x32_bf16(a, bv, yd[pt], 0, 0, 0); } }
#pragma unroll
        for (int ks = 0; ks < 2; ++ks) { const bf16x8 a = *(const bf16x8*)(Cs + (16 * w + fr) * 72 + ks * 32 + fq * 8);
#pragma unroll
            for (int pt = 0; pt < 4; ++pt) { const bf16x8 bv = *(const bf16x8*)(Sin + (pt * 16 + fr) * 72 + ks * 32 + fq * 8); yo[pt] = __builtin_amdgcn_mfma_f32_16x16x32_bf16(a, bv, yo[pt], 0, 0, 0); } }
        const float Dh = P.in[18][layer * 16 + hd];
#pragma unroll
        for (int j = 0; j < 4; ++j) { const int t = 16 * w + fq * 4 + j; const float et = __expf(acs_t[j]), idt = 1.f / DT[hh * 128 + t];
#pragma unroll
            for (int pt = 0; pt < 4; ++pt) { const int p = pt * 16 + fr; const float x = bf2f(XT4[xt_idx(hh * 64 + p, t)]) * idt;
                bf16_t* zp = zrow[j] + hh * 64 + pt * 16;
                float y = yd[pt][j] + et * yo[pt][j] + Dh * x; y *= silu_fast(bf2f(zv[j][pt])); ssq[j] += y * y; if (!dry) *zp = f2bf(y); } }
    }
    asm volatile("s_waitcnt vmcnt(0)" ::: "memory");
    const float* ng = P.in[19] + layer * 1024 + g * 256 + fr;
#pragma unroll
    for (int j = 0; j < 4; ++j) { float v = ssq[j];
#pragma unroll
        for (int o = 8; o > 0; o >>= 1) v += shx(v, o, lane);
        ssq[j] = rsqrtf(v * (1.f / 256.f) + EPSF); }
    for (int hb = 0; hb < 16; hb += 4) { bf16_t yv[4][4]; float gv[4];
#pragma unroll
        for (int q = 0; q < 4; ++q) { gv[q] = ng[(hb + q) * 16];
#pragma unroll
            for (int j = 0; j < 4; ++j) yv[q][j] = *(zrow[j] + (hb + q) * 16); }
#pragma unroll
        for (int q = 0; q < 4; ++q)
#pragma unroll
            for (int j = 0; j < 4; ++j) { if (!dry) *(zrow[j] + (hb + q) * 16) = f2bf(bf2f(yv[q][j]) * ssq[j] * gv[q]); } }
}
__device__ __forceinline__ void phase_ssd_scan(const Params& P, int layer) {
    float* states = (float*)(P.ws + WS_SSDST); const float* decs = (const float*)(P.ws + WS_SSDDEC);
    for (int e = blockIdx.x * 512 + otid(); e < 4 * 16 * 4096; e += gridDim.x * 512) {
        const int b = e >> 16, hd = (e >> 12) & 15, pn = e & 4095; float carry = 0.f;
        float st[32], dc[32];
#pragma unroll
        for (int c = 0; c < 32; ++c) { st[c] = states[((size_t)((b * 32 + c) * 16 + hd)) * 4096 + pn]; dc[c] = decs[(b * 32 + c) * 16 + hd]; }
#pragma unroll
        for (int c = 0; c < 32; ++c) { states[((size_t)((b * 32 + c) * 16 + hd)) * 4096 + pn] = carry; carry = carry * dc[c] + st[c]; }
        P.out[O_PSSM + ((size_t)((layer * 4 + b) * 16 + hd)) * 4096 + pn] = carry;
    }
}

__device__ __forceinline__ void attn_prompt_item(const Params& P, int layer, int item, unsigned char* lds, bool dry = false) {
    const int tid = otid(), w = tid >> 6, lane = tid & 63, fr = lane & 15, fq = lane >> 4;
    const int b = item >> 7, nb = (item >> 2) & 31, kvh = item & 3;
    bf16_t* proj = (bf16_t*)(P.ws + WS_PROJ);
    bf16_t* Ks = (bf16_t*)lds;
    bf16_t* Vt = Ks + 256 * 72;
    bf16_t* Pw = Vt + 64 * 280 + w * 16 * 168;
    const long rowK0 = (long)b * 4096 + (long)(nb - 1) * 128;
    const bf16_t* qbase = proj + ((size_t)b * 4096 + (size_t)nb * 128 + w * 16 + fr) * LDP + C_Q + kvh * 256 + fq * 8;
    bf16x8 qa[2], qn[2];
#pragma unroll
    for (int ks = 0; ks < 2; ++ks) { qa[ks] = *(const bf16x8*)(qbase + ks * 32); qn[ks] = qa[ks]; }
    __syncthreads();
#pragma unroll
    for (int idx = tid; idx < 2048; idx += 512) { const int kj = idx >> 3, seg = idx & 7; u32x4 v = (u32x4){0u, 0u, 0u, 0u};
        if (nb > 0 || kj >= 128) v = *(const u32x4*)(proj + (size_t)(rowK0 + kj) * LDP + C_K + kvh * 64 + seg * 8);
        *(u32x4*)(Ks + kj * 72 + seg * 8) = v; }
#pragma unroll
    for (int idx = tid; idx < 2048; idx += 512) { const int seg = idx >> 8, kj = idx & 255; u32x4 v = (u32x4){0u, 0u, 0u, 0u};
        if (nb > 0 || kj >= 128) v = *(const u32x4*)(proj + (size_t)(rowK0 + kj) * LDP + C_V + kvh * 64 + seg * 8);
#pragma unroll
        for (int i = 0; i < 8; ++i) Vt[(seg * 8 + i) * 280 + kj] = (bf16_t)((v[i >> 1] >> ((i & 1) * 16)) & 0xffffu); }
    for (int idx = tid; idx < 64 * 24; idx += 512) { const int d = idx / 24, cc = 256 + idx % 24; Vt[d * 280 + cc] = 0; }
    for (int i = lane; i < 384; i += 64) Pw[(i / 24) * 168 + 144 + i % 24] = 0;
    __syncthreads();
    const int q0 = w * 16;
    const size_t qrow0 = (size_t)b * 4096 + (size_t)nb * 128 + q0;
    for (int gi = 0; gi < 4; ++gi) {
        const int hq = kvh * 4 + gi;
        const float slope = exp2f(-0.5f * (float)(hq + 1));
        const float sink = P.in[21][layer * 16 + hq];
        if (gi < 3) {
#pragma unroll
            for (int ks = 0; ks < 2; ++ks) qn[ks] = *(const bf16x8*)(qbase + (gi + 1) * 64 + ks * 32); }
        f32x4 S[9];
#pragma unroll
        for (int nt = 0; nt < 9; ++nt) { f32x4 a = (f32x4){0.f, 0.f, 0.f, 0.f}; const bf16_t* kp = Ks + (q0 + nt * 16 + fr) * 72 + fq * 8;
#pragma unroll
            for (int ks = 0; ks < 2; ++ks) { const bf16x8 kb = *(const bf16x8*)(kp + ks * 32); a = __builtin_amdgcn_mfma_f32_16x16x32_bf16(qa[ks], kb, a, 0, 0, 0); }
            S[nt] = a; }
        float mx[4] = {-INFINITY, -INFINITY, -INFINITY, -INFINITY};
#pragma unroll
        for (int nt = 0; nt < 9; ++nt)
#pragma unroll
            for (int j = 0; j < 4; ++j) { const int dist = (fq * 4 + j) - (nt * 16 + fr) + 128; const bool valid = dist >= 0 && dist <= 128 && (nb > 0 || (q0 + nt * 16 + fr) >= 128);
                const float s = valid ? S[nt][j] * 0.125f - slope * (float)dist : -INFINITY; S[nt][j] = s; mx[j] = fmaxf(mx[j], s); }
        float inv[4];
#pragma unroll
        for (int j = 0; j < 4; ++j) { float m = mx[j];
#pragma unroll
            for (int o = 8; o > 0; o >>= 1) m = fmaxf(m, shx(m, o, lane));
            m = fmaxf(m, sink); float sum = 0.f;
#pragma unroll
            for (int nt = 0; nt < 9; ++nt) { const float p = __expf(S[nt][j] - m); S[nt][j] = p; sum += p; }
#pragma unroll
            for (int o = 8; o > 0; o >>= 1) sum += shx(sum, o, lane);
            inv[j] = 1.f / (sum + __expf(sink - m)); }
#pragma unroll
        for (int nt = 0; nt < 9; ++nt)
#pragma unroll
            for (int j = 0; j < 4; ++j) Pw[(fq * 4 + j) * 168 + nt * 16 + fr] = f2bf(S[nt][j]);
        asm volatile("s_waitcnt lgkmcnt(0)" ::: "memory"); __builtin_amdgcn_wave_barrier();
        f32x4 O[4];
#pragma unroll
        for (int dt = 0; dt < 4; ++dt) O[dt] = (f32x4){0.f, 0.f, 0.f, 0.f};
#pragma unroll
        for (int ks = 0; ks < 5; ++ks) { const bf16x8 pa = *(const bf16x8*)(Pw + fr * 168 + ks * 32 + fq * 8);
#pragma unroll
            for (int dt = 0; dt < 4; ++dt) { const bf16x8 vb = *(const bf16x8*)(Vt + (dt * 16 + fr) * 280 + q0 + ks * 32 + fq * 8); O[dt] = __builtin_amdgcn_mfma_f32_16x16x32_bf16(pa, vb, O[dt], 0, 0, 0); } }
        asm volatile("s_waitcnt lgkmcnt(0)" ::: "memory"); __builtin_amdgcn_wave_barrier();
#pragma unroll
        for (int dt = 0; dt < 4; ++dt)
#pragma unroll
            for (int j = 0; j < 4; ++j) { if (!dry) proj[(qrow0 + fq * 4 + j) * LDP + C_Q + hq * 64 + dt * 16 + fr] = f2bf(O[dt][j] * inv[j]); }
        qa[0] = qn[0]; qa[1] = qn[1];
    }
    if (nb == 31) {
        for (int idx = tid; idx < 128 * 64; idx += 512) { const int t = idx >> 6, d = idx & 63; const size_t row = (size_t)b * 4096 + 3968 + t;
            const size_t o = ((size_t)((layer * 4 + b) * 128 + t)) * 256 + kvh * 64 + d;
            P.out[O_PK + o] = bf2f(proj[row * LDP + C_K + kvh * 64 + d]); P.out[O_PV + o] = bf2f(proj[row * LDP + C_V + kvh * 64 + d]); }
    }
}
__device__ __forceinline__ void attn_sample_item(const Params& P, int layer, int item, float* L, bool dry = false) {
    const int tid = otid(), w = tid >> 6, lane = tid & 63;
    const int sb = item >> 2, kvh = item & 3, r0 = NPR + sb * 4;
    bf16_t* proj = (bf16_t*)(P.ws + WS_PROJ);
    float* Kf = L; float* Vf = Kf + 132 * 65; float* Q = Vf + 132 * 65; float* Sc = Q + 16 * 64;
    const float* ck = P.in[7] + ((size_t)(layer * 128 + sb)) * 128 * 256; const float* cv = P.in[8] + ((size_t)(layer * 128 + sb)) * 128 * 256;
    __syncthreads();
    {
        f32x4 kq[4], vq[4];
#pragma unroll
        for (int i = 0; i < 4; ++i) { const int idx = tid + i * 512, j = idx >> 4, d4 = (idx & 15) * 4; kq[i] = *(const f32x4*)(ck + (size_t)j * 256 + kvh * 64 + d4); vq[i] = *(const f32x4*)(cv + (size_t)j * 256 + kvh * 64 + d4); }
#pragma unroll
        for (int i = 0; i < 4; ++i) { const int idx = tid + i * 512, j = idx >> 4, d4 = (idx & 15) * 4;
#pragma unroll
            for (int e = 0; e < 4; ++e) { Kf[j * 65 + d4 + e] = kq[i][e]; Vf[j * 65 + d4 + e] = vq[i][e]; }
            if (j >= 4) { const size_t o = ((size_t)((layer * 128 + sb) * 128 + (j - 4))) * 256 + kvh * 64 + d4; *(f32x4*)(P.out + O_SK + o) = kq[i]; *(f32x4*)(P.out + O_SV + o) = vq[i]; } }
        if (tid < 256) { const int j = 128 + (tid >> 6), d = tid & 63; const float kv = bf2f(proj[(size_t)(r0 + j - 128) * LDP + C_K + kvh * 64 + d]), vv = bf2f(proj[(size_t)(r0 + j - 128) * LDP + C_V + kvh * 64 + d]);
            Kf[j * 65 + d] = kv; Vf[j * 65 + d] = vv; const size_t o = ((size_t)((layer * 128 + sb) * 128 + (j - 4))) * 256 + kvh * 64 + d; P.out[O_SK + o] = kv; P.out[O_SV + o] = vv; }
    }
    for (int idx = tid; idx < 1024; idx += 512) { const int qr = idx >> 6, d = idx & 63; Q[idx] = bf2f(proj[(size_t)(r0 + (qr >> 2)) * LDP + C_Q + (kvh * 4 + (qr & 3)) * 64 + d]); }
    __syncthreads();
    for (int idx = tid; idx < 16 * 132; idx += 512) { const int qr = idx / 132, j = idx - qr * 132; const int dist = 128 + (qr >> 2) - j; float s = -INFINITY;
        if (dist >= 0 && dist <= 128) { float a = 0.f;
#pragma unroll 8
            for (int d = 0; d < 64; ++d) a += Q[qr * 64 + d] * Kf[j * 65 + d];
            s = a * 0.125f - exp2f(-0.5f * (float)(kvh * 4 + (qr & 3) + 1)) * (float)dist; }
        Sc[qr * 136 + j] = s; }
    __syncthreads();
    for (int rr = 0; rr < 2; ++rr) { const int qr = w * 2 + rr; const float sink = P.in[21][layer * 16 + kvh * 4 + (qr & 3)];
        float v0 = Sc[qr * 136 + lane], v1 = Sc[qr * 136 + 64 + lane], v2 = lane < 4 ? Sc[qr * 136 + 128 + lane] : -INFINITY;
        float m = fmaxf(fmaxf(v0, v1), v2);
#pragma unroll
        for (int o = 32; o > 0; o >>= 1) m = fmaxf(m, shx(m, o, lane));
        m = fmaxf(m, sink);
        v0 = __expf(v0 - m); v1 = __expf(v1 - m); v2 = __expf(v2 - m);
        const float sum = wave_sum(v0 + v1 + v2, lane); const float inv = 1.f / (sum + __expf(sink - m));
        Sc[qr * 136 + lane] = v0 * inv; Sc[qr * 136 + 64 + lane] = v1 * inv; if (lane < 4) Sc[qr * 136 + 128 + lane] = v2 * inv; }
    __syncthreads();
    for (int idx = tid; idx < 1024; idx += 512) { const int qr = idx >> 6, d = idx & 63; float o = 0.f;
        for (int j = 0; j < 132; ++j) o += Sc[qr * 136 + j] * Vf[j * 65 + d];
        if (!dry) proj[(size_t)(r0 + (qr >> 2)) * LDP + C_Q + (kvh * 4 + (qr & 3)) * 64 + d] = f2bf(o); }
}

__device__ __forceinline__ void gmlp_prompt_item(const Params& P, int layer, int item, unsigned char* lds, bool dry = false) {
    const int tid = otid(), w = tid >> 6, lane = tid & 63, fr = lane & 15, fq = lane >> 4;
    const int b = item >> 8, chn = (item >> 3) & 31, g = item & 7;
    const size_t r0 = (size_t)b * 4096 + (size_t)chn * 128;
    bf16_t* proj = (bf16_t*)(P.ws + WS_PROJ);
    bf16_t* VT = (bf16_t*)lds; bf16_t* Wt = VT + 128 * 136; float* MU = (float*)(Wt + 128 * 136); float* RS = MU + 128;
    __syncthreads();
#pragma unroll
    for (int hb = 0; hb < 2; ++hb) { u32x4 av[8], cv8[8];
#pragma unroll
        for (int i = 0; i < 8; ++i) { const bf16_t* vp = proj + (r0 + w * 16 + hb * 8 + i) * LDP + C_UV + 1024 + lane * 16; av[i] = *(const u32x4*)vp; cv8[i] = *(const u32x4*)(vp + 8); }
#pragma unroll
        for (int i = 0; i < 8; ++i) { const int t = w * 16 + hb * 8 + i; float s = 0.f, sq = 0.f;
#pragma unroll
            for (int k = 0; k < 4; ++k) { float x0 = bflo(av[i][k]), x1 = bfhi(av[i][k]), x2 = bflo(cv8[i][k]), x3 = bfhi(cv8[i][k]); s += x0 + x1 + x2 + x3; sq += x0 * x0 + x1 * x1 + x2 * x2 + x3 * x3; }
            s = wave_sum(s, lane); sq = wave_sum(sq, lane);
            if (lane == 0) { const float mean = s * (1.f / 1024.f); const float var = fmaxf(sq * (1.f / 1024.f) - mean * mean, 0.f); MU[t] = mean; RS[t] = rsqrtf(var + EPSF); } } }
    const float* Wg = P.in[24] + ((size_t)(layer * 8 + g)) * 16384;
#pragma unroll
    for (int idx = tid; idx < 4096; idx += 512) { const int t = idx >> 5, s4 = (idx & 31) * 4; const f32x4 wv = *(const f32x4*)(Wg + t * 128 + s4);
        u32x2 o; o[0] = pk2(s4 <= t ? wv[0] : 0.f, s4 + 1 <= t ? wv[1] : 0.f); o[1] = pk2(s4 + 2 <= t ? wv[2] : 0.f, s4 + 3 <= t ? wv[3] : 0.f);
        *(u32x2*)(Wt + t * 136 + s4) = o; }
    __syncthreads();
    const float* lg = P.in[22] + layer * 1024 + g * 128; const float* lb = P.in[23] + layer * 1024 + g * 128;
#pragma unroll
    for (int idx = tid; idx < 2048; idx += 512) { const int s = idx & 127, fs = idx >> 7; const u32x4 v = *(const u32x4*)(proj + (r0 + s) * LDP + C_UV + 1024 + g * 128 + fs * 8);
        const float mu = MU[s], rs = RS[s];
#pragma unroll
        for (int i = 0; i < 8; ++i) { const int f = fs * 8 + i; const float x = (i & 1) ? bfhi(v[i >> 1]) : bflo(v[i >> 1]); VT[f * 136 + s] = f2bf((x - mu) * rs * lg[f] + lb[f]); } }
    __syncthreads();
    f32x4 acc[8];
#pragma unroll
    for (int ft = 0; ft < 8; ++ft) acc[ft] = (f32x4){0.f, 0.f, 0.f, 0.f};
    const int nks = (16 * w + 15) / 32 + 1;
    for (int ks = 0; ks < nks; ++ks) { const bf16x8 a = *(const bf16x8*)(Wt + (w * 16 + fr) * 136 + ks * 32 + fq * 8);
#pragma unroll
        for (int ft = 0; ft < 8; ++ft) { const bf16x8 bb = *(const bf16x8*)(VT + (ft * 16 + fr) * 136 + ks * 32 + fq * 8); acc[ft] = __builtin_amdgcn_mfma_f32_16x16x32_bf16(a, bb, acc[ft], 0, 0, 0); } }
    bf16_t uv[4][8]; float bsv[4];
#pragma unroll
    for (int j = 0; j < 4; ++j) { const int t = w * 16 + fq * 4 + j; bsv[j] = P.in[25][(layer * 8 + g) * 128 + t];
#pragma unroll
        for (int ft = 0; ft < 8; ++ft) uv[j][ft] = proj[(r0 + t) * LDP + C_UV + g * 128 + ft * 16 + fr]; }
#pragma unroll
    for (int j = 0; j < 4; ++j) { const int t = w * 16 + fq * 4 + j;
#pragma unroll
        for (int ft = 0; ft < 8; ++ft) { if (!dry) proj[(r0 + t) * LDP + C_UV + g * 128 + ft * 16 + fr] = f2bf(gelu_fast(bf2f(uv[j][ft])) * (acc[ft][j] + bsv[j])); } }
}
__device__ __forceinline__ void gmlp_sample_item(const Params& P, int layer, int sb, float* L) {
    const int tid = otid(), w = tid >> 6, lane = tid & 63; const size_t r0 = NPR + sb * 4;
    bf16_t* proj = (bf16_t*)(P.ws + WS_PROJ);
    float* Vn = L; float* MU = Vn + 4096; float* RS = MU + 4;
    __syncthreads();
    if (w < 4) { const bf16_t* vp = proj + (r0 + w) * LDP + C_UV + 1024 + lane * 16; const u32x4 a = *(const u32x4*)vp, c = *(const u32x4*)(vp + 8); float s = 0.f, sq = 0.f;
#pragma unroll
        for (int k = 0; k < 4; ++k) { float x0 = bflo(a[k]), x1 = bfhi(a[k]), x2 = bflo(c[k]), x3 = bfhi(c[k]); s += x0 + x1 + x2 + x3; sq += x0 * x0 + x1 * x1 + x2 * x2 + x3 * x3; }
        s = wave_sum(s, lane); sq = wave_sum(sq, lane);
        if (lane == 0) { const float mean = s * (1.f / 1024.f); const float var = fmaxf(sq * (1.f / 1024.f) - mean * mean, 0.f); MU[w] = mean; RS[w] = rsqrtf(var + EPSF); } }
    __syncthreads();
    for (int idx = tid; idx < 4096; idx += 512) { const int t = idx >> 10, c = idx & 1023;
        const float x = bf2f(proj[(r0 + t) * LDP + C_UV + 1024 + c]); const float vn = (x - MU[t]) * RS[t] * P.in[22][layer * 1024 + c] + P.in[23][layer * 1024 + c];
        Vn[idx] = vn; P.out[O_SGMV + ((size_t)((layer * 128 + sb) * 4 + t)) * 1024 + c] = vn; }
    __syncthreads();
    for (int idx = tid; idx < 4096; idx += 512) { const int t = idx >> 10, c = idx & 1023, g = c >> 7;
        const float* Wg = P.in[24] + ((size_t)(layer * 8 + g)) * 16384 + t * 128; float m = P.in[25][(layer * 8 + g) * 128 + t];
        for (int s = 0; s <= t; ++s) m += Wg[s] * Vn[s * 1024 + c];
        bf16_t* ap = proj + (r0 + t) * LDP + C_UV + c; *ap = f2bf(gelu_fast(bf2f(*ap)) * m); }
}

template <int R>
__device__ __forceinline__ void shortconv_rows(const Params& P, int layer, int r0, int tid, bool dry) {
    bf16_t* proj = (bf16_t*)(P.ws + WS_PROJ);
    const float* cw = P.in[20] + layer * 3 * 1024;
    const int j = tid * 2; const int ss = seq_start(r0); const bool havePrev = (r0 - 2 >= ss);
    unsigned cg[R + 2], xs[R + 2], bg[R];
#pragma unroll
    for (int k = 0; k < R + 2; ++k) { cg[k] = 0u; xs[k] = 0u;
        if (k >= 2 || havePrev) { const bf16_t* rp = proj + (size_t)(r0 - 2 + k) * LDP + C_BCX + j; cg[k] = *(const unsigned*)(rp + 1024); xs[k] = *(const unsigned*)(rp + 2048); } }
#pragma unroll
    for (int k = 0; k < R; ++k) bg[k] = *(const unsigned*)(proj + (size_t)(r0 + k) * LDP + C_BCX + j);
    float pr0[R + 2], pr1[R + 2];
#pragma unroll
    for (int k = 0; k < R + 2; ++k) { pr0[k] = bflo(cg[k]) * bflo(xs[k]); pr1[k] = bfhi(cg[k]) * bfhi(xs[k]); }
    if (!havePrev && r0 >= NPR) { const float* st = P.in[6] + ((size_t)(layer * 128 + ((r0 - NPR) >> 2)) * 2) * 1024 + j; pr0[0] = st[0]; pr1[0] = st[1]; pr0[1] = st[1024]; pr1[1] = st[1025]; }
    const float w0a = cw[j], w0b = cw[j + 1], w1a = cw[1024 + j], w1b = cw[1025 + j], w2a = cw[2048 + j], w2b = cw[2049 + j];
#pragma unroll
    for (int k = 0; k < R; ++k) { const float y0 = w0a * pr0[k] + w1a * pr0[k + 1] + w2a * pr0[k + 2], y1 = w0b * pr1[k] + w1b * pr1[k + 1] + w2b * pr1[k + 2];
        if (!dry) *(unsigned*)(proj + (size_t)(r0 + k) * LDP + C_BCX + j) = pk2(bflo(bg[k]) * y0, bfhi(bg[k]) * y1);
        const int r = r0 + k;
        if (r < NPR) { const int l = r & 4095; if (l >= 4094) { float* o = P.out + O_PSCC + ((size_t)((layer * 4 + (r >> 12)) * 2 + (l - 4094))) * 1024 + j; o[0] = pr0[k + 2]; o[1] = pr1[k + 2]; } }
        else { const int l = (r - NPR) & 3; if (l >= 2) { float* o = P.out + O_SSCC + ((size_t)((layer * 128 + ((r - NPR) >> 2)) * 2 + (l - 2))) * 1024 + j; o[0] = pr0[k + 2]; o[1] = pr1[k + 2]; } }
    }
}
__device__ __forceinline__ void shortconv_item(const Params& P, int layer, int item, bool dry = false) {
    const int tid = otid();
    if (item < 1024) shortconv_rows<16>(P, layer, item * 16, tid, dry); else shortconv_rows<4>(P, layer, NPR + (item - 1024) * 4, tid, dry);
}
__device__ __forceinline__ void ssdconv_state_item(const Params& P, int layer, int sq) {
    const bf16_t* proj = (const bf16_t*)(P.ws + WS_PROJ);
    const size_t rbase = sq < 4 ? (size_t)sq * 4096 + 4093 : (size_t)NPR + (size_t)(sq - 4) * 4 + 1;
    float* o = sq < 4 ? P.out + O_PSSDC + (size_t)(layer * 4 + sq) * 3 * 1536 : P.out + O_SSSDC + (size_t)(layer * 128 + (sq - 4)) * 3 * 1536;
    const int tid = otid(); bf16_t v[9];
#pragma unroll
    for (int i = 0; i < 9; ++i) { const int e = tid + i * 512, t = e / 1536, c = e - t * 1536; v[i] = proj[(rbase + t) * LDP + C_XBC + c]; }
#pragma unroll
    for (int i = 0; i < 9; ++i) o[tid + i * 512] = bf2f(v[i]);
}

template <int R>
__device__ __forceinline__ void ffn_act_unit(const Params& P, int layer, int r0, int oc) {
    const bf16_t* up = (const bf16_t*)(P.ws + WS_PROJ); bf16_t* act = (bf16_t*)(P.ws + WS_PROJ + UP_BYTES);
    const float* cw = P.in[30] + (size_t)layer * 3 * 5632; const float* cb = P.in[31] + (size_t)layer * 5632;
    const int j0 = oc * 8;
    float wa[3][8], wg[3][8], ba[8], bgv[8], pa[2][8], pg[2][8];
#pragma unroll
    for (int k = 0; k < 3; ++k) { const f32x4 a0 = *(const f32x4*)(cw + k * 5632 + j0), a1 = *(const f32x4*)(cw + k * 5632 + j0 + 4), g0 = *(const f32x4*)(cw + k * 5632 + 2816 + j0), g1 = *(const f32x4*)(cw + k * 5632 + 2816 + j0 + 4);
#pragma unroll
        for (int i = 0; i < 4; ++i) { wa[k][i] = a0[i]; wa[k][4 + i] = a1[i]; wg[k][i] = g0[i]; wg[k][4 + i] = g1[i]; } }
    { const f32x4 a0 = *(const f32x4*)(cb + j0), a1 = *(const f32x4*)(cb + j0 + 4), g0 = *(const f32x4*)(cb + 2816 + j0), g1 = *(const f32x4*)(cb + 2816 + j0 + 4);
#pragma unroll
      for (int i = 0; i < 4; ++i) { ba[i] = a0[i]; ba[4 + i] = a1[i]; bgv[i] = g0[i]; bgv[4 + i] = g1[i]; } }
    const int ss = seq_start(r0); const bool havePrev = (r0 - 2 >= ss);
#pragma unroll
    for (int k = 0; k < 2; ++k) {
        if (havePrev) { const u32x4 ua = *(const u32x4*)(up + (size_t)(r0 - 2 + k) * 5632 + j0), ug = *(const u32x4*)(up + (size_t)(r0 - 2 + k) * 5632 + 2816 + j0);
#pragma unroll
            for (int i = 0; i < 4; ++i) { pa[k][2 * i] = bflo(ua[i]); pa[k][2 * i + 1] = bfhi(ua[i]); pg[k][2 * i] = bflo(ug[i]); pg[k][2 * i + 1] = bfhi(ug[i]); } }
        else if (r0 >= NPR) { const float* pp = P.in[9] + ((size_t)(layer * 128 + ((r0 - NPR) >> 2)) * 2 + k) * 5632;
#pragma unroll
            for (int i = 0; i < 8; ++i) { pa[k][i] = pp[j0 + i]; pg[k][i] = pp[2816 + j0 + i]; } }
        else {
#pragma unroll
            for (int i = 0; i < 8; ++i) { pa[k][i] = 0.f; pg[k][i] = 0.f; } } }
#pragma unroll
    for (int kb = 0; kb < R; kb += 4) { u32x4 ua[4], ug[4];
#pragma unroll
        for (int q = 0; q < 4; ++q) { ua[q] = *(const u32x4*)(up + (size_t)(r0 + kb + q) * 5632 + j0); ug[q] = *(const u32x4*)(up + (size_t)(r0 + kb + q) * 5632 + 2816 + j0); }
#pragma unroll
        for (int q = 0; q < 4; ++q) { const int r = r0 + kb + q; float ca[8], cgv[8], o[8];
#pragma unroll
            for (int i = 0; i < 4; ++i) { ca[2 * i] = bflo(ua[q][i]); ca[2 * i + 1] = bfhi(ua[q][i]); cgv[2 * i] = bflo(ug[q][i]); cgv[2 * i + 1] = bfhi(ug[q][i]); }
#pragma unroll
            for (int i = 0; i < 8; ++i) { const float a = ba[i] + wa[0][i] * pa[0][i] + wa[1][i] * pa[1][i] + wa[2][i] * ca[i], g = bgv[i] + wg[0][i] * pg[0][i] + wg[1][i] * pg[1][i] + wg[2][i] * cgv[i];
                o[i] = silu_fast(a) * g; pa[0][i] = pa[1][i]; pa[1][i] = ca[i]; pg[0][i] = pg[1][i]; pg[1][i] = cgv[i]; }
            u32x4 ov; ov[0] = pk2(o[0], o[1]); ov[1] = pk2(o[2], o[3]); ov[2] = pk2(o[4], o[5]); ov[3] = pk2(o[6], o[7]);
            *(u32x4*)(act + (size_t)r * 2816 + j0) = ov;
            float* so = nullptr;
            if (r < NPR) { const int l = r & 4095; if (l >= 4094) so = P.out + O_PFFC + ((size_t)((layer * 4 + (r >> 12)) * 2 + (l - 4094))) * 5632; }
            else { const int l = (r - NPR) & 3; if (l >= 2) so = P.out + O_SFFC + ((size_t)((layer * 128 + ((r - NPR) >> 2)) * 2 + (l - 2))) * 5632; }
            if (so) {
#pragma unroll
                for (int i = 0; i < 8; ++i) { so[j0 + i] = ca[i]; so[2816 + j0 + i] = cgv[i]; } }
        } }
}
__device__ __forceinline__ void phase_ffn_act(const Params& P, int layer) {
    constexpr int NU_P = 2048 * 352, NU_S = 128 * 352;
    for (int u = blockIdx.x * 512 + otid(); u < NU_P + NU_S; u += gridDim.x * 512) {
        if (u < NU_P) { const int rb = u / 352, oc = u - rb * 352; ffn_act_unit<8>(P, layer, rb * 8, oc); }
        else { const int v = u - NU_P, sq = v / 352, oc = v - sq * 352; ffn_act_unit<4>(P, layer, NPR + sq * 4, oc); }
    }
}

__device__ __forceinline__ void sgemm_partial(const bf16_t* A, int lda, const bf16_t* Bt, int ldb, int K, int row0, int col0, float* red, int tid) {
    const int w = tid >> 6, lane = tid & 63, fr = lane & 15, fq = lane >> 4;
    const int kw = K >> 3, k0 = w * kw;
    f32x4 acc[2][4];
#pragma unroll
    for (int mt = 0; mt < 2; ++mt)
#pragma unroll
        for (int nt = 0; nt < 4; ++nt) acc[mt][nt] = (f32x4){0.f, 0.f, 0.f, 0.f};
    const bf16_t* ap = A + (size_t)(row0 + fr) * lda + k0 + fq * 8;
    const bf16_t* bp = Bt + (size_t)(col0 + fr) * ldb + k0 + fq * 8;
    const int nks = kw >> 5;
#pragma unroll 4
    for (int ks = 0; ks < nks; ++ks) { bf16x8 a[2], b[4];
#pragma unroll
        for (int mt = 0; mt < 2; ++mt) a[mt] = *(const bf16x8*)(ap + (size_t)mt * 16 * lda + ks * 32);
#pragma unroll
        for (int nt = 0; nt < 4; ++nt) b[nt] = *(const bf16x8*)(bp + (size_t)nt * 16 * ldb + ks * 32);
#pragma unroll
        for (int mt = 0; mt < 2; ++mt)
#pragma unroll
            for (int nt = 0; nt < 4; ++nt) acc[mt][nt] = __builtin_amdgcn_mfma_f32_16x16x32_bf16(a[mt], b[nt], acc[mt][nt], 0, 0, 0); }
#pragma unroll
    for (int mt = 0; mt < 2; ++mt)
#pragma unroll
        for (int nt = 0; nt < 4; ++nt)
#pragma unroll
            for (int j = 0; j < 4; ++j) red[(w * 32 + mt * 16 + fq * 4 + j) * 64 + nt * 16 + fr] = acc[mt][nt][j];
}
__device__ __forceinline__ f32x4 sgemm_reduce(const float* red, int tid) {
    const int row = tid >> 4, c4 = (tid & 15) * 4; f32x4 sacc = (f32x4){0.f, 0.f, 0.f, 0.f};
#pragma unroll
    for (int w = 0; w < 8; ++w) sacc += *(const f32x4*)(red + (w * 32 + row) * 64 + c4);
    return sacc;
}
__device__ __forceinline__ void sg_load4(const bf16_t* ap, int lda, const bf16_t* bp, int ldb, bf16x8 (&a)[4][2], bf16x8 (&b)[4][4]) {
#pragma unroll
    for (int ks = 0; ks < 4; ++ks) {
#pragma unroll
        for (int mt = 0; mt < 2; ++mt) a[ks][mt] = *(const bf16x8*)(ap + (size_t)mt * 16 * lda + ks * 32);
#pragma unroll
        for (int nt = 0; nt < 4; ++nt) b[ks][nt] = *(const bf16x8*)(bp + (size_t)nt * 16 * ldb + ks * 32); }
}
__device__ __forceinline__ void sample_branch(const Params& P, int layer, float* red) {
    const int tid = otid(), w = tid >> 6, lane = tid & 63, fr = lane & 15, fq = lane >> 4;
    const bf16_t* proj = (const bf16_t*)(P.ws + WS_PROJ); bf16_t* hbuf = (bf16_t*)(P.ws + WS_H);
    for (int piece = blockIdx.x; piece < 256; piece += gridDim.x) {
        const int row0 = (piece >> 4) * 32, col0 = (piece & 15) * 64; const size_t r = NPR + row0 + (tid >> 4); const int c = col0 + (tid & 15) * 4;
        const bf16_t* abase = proj + (size_t)(NPR + row0 + fr) * LDP + w * 128 + fq * 8;
        const bf16_t* bbase = (const bf16_t*)(P.ws + WS_WBR) + (size_t)layer * 4 * 1048576 + (size_t)(col0 + fr) * 1024 + w * 128 + fq * 8;
        bf16x8 a[4][2], b[4][4];
        sg_load4(abase + C_Z, LDP, bbase, 1024, a, b);
        f32x4 sum = (f32x4){0.f, 0.f, 0.f, 0.f};
        for (int z = 0; z < 4; ++z) {
            f32x4 acc[2][4];
#pragma unroll
            for (int mt = 0; mt < 2; ++mt)
#pragma unroll
                for (int nt = 0; nt < 4; ++nt) acc[mt][nt] = (f32x4){0.f, 0.f, 0.f, 0.f};
#pragma unroll
            for (int ks = 0; ks < 4; ++ks)
#pragma unroll
                for (int mt = 0; mt < 2; ++mt)
#pragma unroll
                    for (int nt = 0; nt < 4; ++nt) acc[mt][nt] = __builtin_amdgcn_mfma_f32_16x16x32_bf16(a[ks][mt], b[ks][nt], acc[mt][nt], 0, 0, 0);
            if (z < 3) { const int ao = z == 0 ? C_BCX : (z == 1 ? C_Q : C_UV); sg_load4(abase + ao, LDP, bbase + (size_t)(z + 1) * 1048576, 1024, a, b); }
            const u32x2 gv = *(const u32x2*)(proj + r * LDP + C_GATE + z * 1024 + c);
            __syncthreads();
#pragma unroll
            for (int mt = 0; mt < 2; ++mt)
#pragma unroll
                for (int nt = 0; nt < 4; ++nt)
#pragma unroll
                    for (int j = 0; j < 4; ++j) red[(w * 32 + mt * 16 + fq * 4 + j) * 64 + nt * 16 + fr] = acc[mt][nt][j];
            __syncthreads();
            const f32x4 v = sgemm_reduce(red, tid);
            sum[0] += sigmoid_fast(bflo(gv[0])) * v[0]; sum[1] += sigmoid_fast(bfhi(gv[0])) * v[1]; sum[2] += sigmoid_fast(bflo(gv[1])) * v[2]; sum[3] += sigmoid_fast(bfhi(gv[1])) * v[3];
        }
        u32x2 o; o[0] = pk2(sum[0], sum[1]); o[1] = pk2(sum[2], sum[3]); *(u32x2*)(hbuf + r * 1024 + c) = o;
        __syncthreads();
    }
}
__device__ __forceinline__ void sample_resid(const Params& P, const bf16_t* A, int lda, const bf16_t* Bt, int K, const float* xin_s, float* xout, const float* ga, float* red) {
    const int tid = otid();
    for (int piece = blockIdx.x; piece < 256; piece += gridDim.x) {
        const int row0 = (piece >> 4) * 32, col0 = (piece & 15) * 64; const int rs = row0 + (tid >> 4), c = col0 + (tid & 15) * 4;
        __syncthreads();
        sgemm_partial(A, lda, Bt, K, K, row0, col0, red, tid);
        __syncthreads();
        const f32x4 v = sgemm_reduce(red, tid);
        const f32x4 xv = *(const f32x4*)(xin_s + (size_t)rs * 1024 + c), gv = *(const f32x4*)(ga + (size_t)(4 + (rs >> 2)) * 6144 + c);
        *(f32x4*)(xout + (size_t)(NPR + rs) * 1024 + c) = xv + gv * v;
    }
}

__device__ __forceinline__ void grid_bar(unsigned* ctr, unsigned& epoch) {
    asm volatile("s_waitcnt vmcnt(0) lgkmcnt(0)" ::: "memory");
    __syncthreads();
    epoch += 1;
    if (otid() == 0) {
        __builtin_amdgcn_fence(__ATOMIC_RELEASE, "agent");
        asm volatile("s_waitcnt vmcnt(0) lgkmcnt(0)" ::: "memory");
        __hip_atomic_fetch_add(ctr, 1u, __ATOMIC_RELAXED, __HIP_MEMORY_SCOPE_AGENT);
        const unsigned target = epoch * gridDim.x;
        while (__hip_atomic_load(ctr, __ATOMIC_RELAXED, __HIP_MEMORY_SCOPE_AGENT) < target) __builtin_amdgcn_s_sleep(1);
        __builtin_amdgcn_fence(__ATOMIC_ACQUIRE, "agent");
        asm volatile("s_waitcnt vmcnt(0) lgkmcnt(0)" ::: "memory");
    }
    __syncthreads();
}

#ifndef PHMASK
#define PHMASK 0xFFFFFFFF
#endif
#define EN(x) ((PHMASK >> (x)) & 1)
#ifndef DRYM
#define DRYM 0
#endif
#ifndef DBL
#define DBL 0
#endif
#define REP(x) (((DBL >> (x)) & 1) ? 2 : 1)
constexpr int PH_PER_LAYER = 11, N_PHASES = 2 + 4 * PH_PER_LAYER + 1;

__global__ void __launch_bounds__(512, 2) mega_fwd(Params PK) {
    extern __shared__ __attribute__((aligned(16))) unsigned char lds_raw[];
    cg::grid_group grid = cg::this_grid();
    LAS unsigned char* ldsl = (LAS unsigned char*)lds_raw;
    unsigned epoch = 0;
    for (int ph = PK.ph_lo; ph < PK.ph_hi; ++ph) {
        Params P = PK;
        { unsigned char* w_ = P.ws; asm volatile("" : "+s"(w_)); P.ws = w_; float* o_ = P.out; asm volatile("" : "+s"(o_)); P.out = o_; }
        unsigned* barctr = (unsigned*)(P.ws + WS_BAR);
        bf16_t* proj = (bf16_t*)(P.ws + WS_PROJ);
        bf16_t* hbuf = (bf16_t*)(P.ws + WS_H);
        float* xbuf = P.out;
        float* mod = (float*)(P.ws + WS_MOD);
        if (ph == 0) { for (int rp = 0; rp < REP(0); ++rp) phase_convert(P, (float*)lds_raw); }
        else if (ph == 1) {
            Gemm g{(const bf16_t*)(P.ws + WS_CACT), (const bf16_t*)(P.ws + WS_WADA), 1024, 1024, 1024, 1, 96, 0, 0, 0, 0, 0};
            EpiMod E{mod, P.in[11]};
            for (int rp = 0; rp < REP(1); ++rp) gemm_phase<EpiMod, 1>(ldsl, g, E);
        }
        else if (ph == N_PHASES - 1) { phase_final_norm(xbuf, P.in[33]); }
        else {
            const int layer = (ph - 2) / PH_PER_LAYER, sp = (ph - 2) % PH_PER_LAYER;
            const float* modL = mod + (size_t)layer * NCOND * 6144;
            const float* xin_p = layer == 0 ? P.in[0] : xbuf; const float* xin_s = layer == 0 ? P.in[1] : xbuf + (size_t)NPR * 1024;
            if (sp == 0) { for (int rp = 0; rp < REP(16); ++rp) phase_norm(xin_p, xin_s, P.in[12] + layer * 1024, modL, 0, 1024, hbuf); }
            else if (sp == 1) {
                Gemm g{hbuf, (const bf16_t*)(P.ws + WS_WIN) + (size_t)layer * 13568 * 1024, 1024, 1024, 1024, 66, 53, 0, 0, 0, 0, 0};
                EpiProj E{proj};
                for (int rp = 0; rp < REP(2); ++rp) gemm_phase<EpiProj, 1>(ldsl, g, E);
            }
            else if (sp == 2) {
                for (int it = blockIdx.x; it < 3972 + 256; it += gridDim.x) {
                    if (it < 512) { for (int rp = 0; rp < REP(3); ++rp) ssd_pass1_item(P, layer, it, lds_raw); }
                    else if (it < 1024) { for (int rp = (DRYM & 1) ? 0 : 1; rp < 2; ++rp) attn_prompt_item(P, layer, it - 512, lds_raw, rp == 0 && P.ph_lo == 0); }
                    else if (it < 1536) { for (int rp = (DRYM & 2) ? 0 : 1; rp < 2; ++rp) attn_sample_item(P, layer, it - 1024, (float*)lds_raw, rp == 0 && P.ph_lo == 0); }
                    else if (it < 2560) { for (int rp = (DRYM & 4) ? 0 : 1; rp < 2; ++rp) gmlp_prompt_item(P, layer, it - 1536, lds_raw, rp == 0 && P.ph_lo == 0); }
                    else if (it < 2688) { if (EN(8)) gmlp_sample_item(P, layer, it - 2560, (float*)lds_raw); }
                    else if (it < 3840) { for (int rp = (DRYM & 8) ? 0 : 1; rp < 2; ++rp) shortconv_item(P, layer, it - 2688, rp == 0 && P.ph_lo == 0); }
                    else if (it < 3972) ssdconv_state_item(P, layer, it - 3840);
                    else ssd_item<2>(P, layer, it - 3972, (float*)lds_raw);
                }
            }
            else if (sp == 3) { phase_ssd_scan(P, layer); }
            else if (sp == 4) { for (int it = blockIdx.x; it < 512; it += gridDim.x) for (int rp = (DRYM & 16) ? 0 : 1; rp < 2; ++rp) ssd_pass3_item(P, layer, it, lds_raw, rp == 0 && P.ph_lo == 0); }
            else if (sp == 5) {
                Gemm g{proj, (const bf16_t*)(P.ws + WS_WBR) + (size_t)layer * 4 * 1048576, LDP, 1024, 1024, 64, 4, C_Z, C_BCX, C_Q, C_UV, (size_t)1048576};
                EpiBranch E{proj, (float*)(P.ws + WS_MSUM), hbuf};
                for (int rp = 0; rp < REP(11); ++rp) gemm_phase<EpiBranch, 4>(ldsl, g, E);
                for (int rp = 0; rp < REP(17); ++rp) sample_branch(P, layer, (float*)lds_raw);
            }
            else if (sp == 6) {
                Gemm g{hbuf, (const bf16_t*)(P.ws + WS_WO) + (size_t)layer * 1048576, 1024, 1024, 1024, 64, 4, 0, 0, 0, 0, 0};
                EpiResid E{xin_p, xin_s, xbuf, modL + 2048};
                if (EN(12)) gemm_phase<EpiResid, 1>(ldsl, g, E);
                sample_resid(P, hbuf + (size_t)NPR * 1024, 1024, (const bf16_t*)(P.ws + WS_WO) + (size_t)layer * 1048576, 1024, xin_s, xbuf, modL + 2048, (float*)lds_raw);
            }
            else if (sp == 7) { for (int rp = 0; rp < REP(16); ++rp) phase_norm(xbuf, xbuf + (size_t)NPR * 1024, P.in[28] + layer * 1024, modL, 3072, 4096, hbuf); }
            else if (sp == 8) {
                Gemm g{hbuf, (const bf16_t*)(P.ws + WS_WUP) + (size_t)layer * 5632 * 1024, 1024, 1024, 1024, 66, 22, 0, 0, 0, 0, 0};
                EpiUp E{proj};
                for (int rp = 0; rp < REP(13); ++rp) gemm_phase<EpiUp, 1>(ldsl, g, E);
            }
            else if (sp == 9) { for (int rp = 0; rp < REP(14); ++rp) phase_ffn_act(P, layer); }
            else {
                Gemm g{(const bf16_t*)(P.ws + WS_PROJ + UP_BYTES), (const bf16_t*)(P.ws + WS_WDN) + (size_t)layer * 1024 * 2816, 2816, 2816, 2816, 64, 4, 0, 0, 0, 0, 0};
                EpiResid E{xbuf, xbuf + (size_t)NPR * 1024, xbuf, modL + 5120};
                if (EN(15)) gemm_phase<EpiResid, 1>(ldsl, g, E);
                sample_resid(P, (const bf16_t*)(P.ws + WS_PROJ + UP_BYTES) + (size_t)NPR * 2816, 2816, (const bf16_t*)(P.ws + WS_WDN) + (size_t)layer * 1024 * 2816, 2816, xbuf + (size_t)NPR * 1024, xbuf, modL + 5120, (float*)lds_raw);
            }
        }
        if (ph + 1 < P.ph_hi) { if (ph == 0) grid.sync(); else grid_bar(barctr, epoch); }
    }
}

extern "C" void kernel_launch(void* const* d_in, const int* in_sizes, int n_in, void* d_out, int out_size, void* d_ws, size_t ws_size, hipStream_t stream) {
    static int grid_blocks = 0;
    if (grid_blocks == 0) {
        if (n_in != 34 || (size_t)out_size != O_END || ws_size < WS_END + 256) { fprintf(stderr, "kernel_launch: unexpected sizes n_in %d out %d ws %zu (need %zu)\n", n_in, out_size, ws_size, (size_t)WS_END); grid_blocks = -1; return; }
        int dev = 0, cus = 0, per_cu = 0;
        (void)hipGetDevice(&dev); (void)hipDeviceGetAttribute(&cus, hipDeviceAttributeMultiprocessorCount, dev);
        if (hipFuncSetAttribute((const void*)mega_fwd, hipFuncAttributeMaxDynamicSharedMemorySize, LDS_BYTES) != hipSuccess) { fprintf(stderr, "hipFuncSetAttribute failed\n"); grid_blocks = -1; return; }
        if (hipOccupancyMaxActiveBlocksPerMultiprocessor(&per_cu, (const void*)mega_fwd, 512, LDS_BYTES) != hipSuccess || per_cu < 1) per_cu = 1;
        grid_blocks = cus * 1;
    }
    if (grid_blocks < 0) return;
    Params p{};
    for (int i = 0; i < 34; ++i) p.in[i] = (const float*)d_in[i];
    p.out = (float*)d_out; p.ws = (unsigned char*)d_ws; p.ph_lo = 0; p.ph_hi = N_PHASES;
    (void)hipMemsetAsync((unsigned char*)d_ws + WS_BAR, 0, 256, stream);
    void* args[] = {&p};
    hipError_t e = hipLaunchCooperativeKernel((const void*)mega_fwd, dim3(grid_blocks), dim3(512), args, LDS_BYTES, stream);
    if (e != hipSuccess) fprintf(stderr, "cooperative launch failed: %s (grid %d)\n", hipGetErrorString(e), grid_blocks);
}
```

```cpp
#include <hip/hip_runtime.h>
#include <hip/hip_cooperative_groups.h>
#include <cstdio>
namespace cg = cooperative_groups;

typedef unsigned short bf16_t;
typedef short bf16x8 __attribute__((ext_vector_type(8)));
typedef float f32x4 __attribute__((ext_vector_type(4)));
typedef unsigned u32x4 __attribute__((ext_vector_type(4)));
typedef unsigned u32x2 __attribute__((ext_vector_type(2)));
#define LAS __attribute__((address_space(3)))

constexpr int NTOK = 16896, NPR = 16384;
constexpr int LDP = 13568;
constexpr int C_Z = 0, C_XBC = 1024, C_DTR = 2560, C_BCX = 2576, C_Q = 5648, C_K = 6672, C_V = 6928, C_UV = 7184, C_GATE = 9232, C_END = 13328;
constexpr int NCOND = 132;
constexpr float EPSF = 1e-6f;

constexpr size_t WS_WIN = 0;
constexpr size_t WS_WBR = WS_WIN + (size_t)4 * 13568 * 1024 * 2;
constexpr size_t WS_WO = WS_WBR + (size_t)16 * 1024 * 1024 * 2;
constexpr size_t WS_WUP = WS_WO + (size_t)4 * 1024 * 1024 * 2;
constexpr size_t WS_WDN = WS_WUP + (size_t)4 * 5632 * 1024 * 2;
constexpr size_t WS_WADA = WS_WDN + (size_t)4 * 1024 * 2816 * 2;
constexpr size_t WS_CACT = WS_WADA + (size_t)4 * 6144 * 1024 * 2;
constexpr size_t WS_MOD = WS_CACT + (size_t)256 * 1024 * 2;
constexpr size_t WS_H = WS_MOD + (size_t)4 * NCOND * 6144 * 4;
constexpr size_t WS_MSUM = WS_H + (size_t)NTOK * 1024 * 2;
constexpr size_t WS_PROJ = WS_MSUM + (size_t)NTOK * 1024 * 4;
constexpr size_t WS_END = WS_PROJ + (size_t)NTOK * LDP * 2;
constexpr size_t WS_BAR = WS_END;
constexpr size_t WS_SSDST = WS_WADA;
constexpr size_t WS_SSDDEC = WS_WADA + (size_t)4 * 32 * 16 * 4096 * 4;
constexpr size_t UP_BYTES = (size_t)NTOK * 5632 * 2;

constexpr size_t O_YP = 0, O_YS = 16777216, O_PSSM = O_YS + 524288, O_PSSDC = O_PSSM + 1048576, O_PSCC = O_PSSDC + 73728,
                 O_PK = O_PSCC + 32768, O_PV = O_PK + 524288, O_PFFC = O_PV + 524288, O_SSSM = O_PFFC + 180224,
                 O_SSSDC = O_SSSM + 33554432, O_SSCC = O_SSSDC + 2359296, O_SK = O_SSCC + 1048576, O_SV = O_SK + 16777216,
                 O_SFFC = O_SV + 16777216, O_SGMV = O_SFFC + 5767168, O_END = O_SGMV + 2097152;

struct Params { const float* in[34]; float* out; unsigned char* ws; int ph_lo, ph_hi; };

constexpr int LDS_BYTES = 155648;

__device__ __forceinline__ float bf2f(bf16_t v) { return __uint_as_float((unsigned)v << 16); }
__device__ __forceinline__ float bflo(unsigned v) { return __uint_as_float(v << 16); }
__device__ __forceinline__ float bfhi(unsigned v) { return __uint_as_float(v & 0xffff0000u); }
__device__ __forceinline__ unsigned pk2(float lo, float hi) { unsigned r; asm("v_cvt_pk_bf16_f32 %0, %1, %2" : "=v"(r) : "v"(lo), "v"(hi)); return r; }
__device__ __forceinline__ bf16_t f2bf(float f) { return (bf16_t)(pk2(f, 0.f) & 0xffffu); }
__device__ __forceinline__ float shx(float v, int o, int lane) { return __int_as_float(__builtin_amdgcn_ds_bpermute((lane ^ o) << 2, __float_as_int(v))); }
__device__ __forceinline__ float wave_sum(float v, int lane) {
#pragma unroll
    for (int o = 32; o > 0; o >>= 1) v += shx(v, o, lane);
    return v;
}
__device__ __forceinline__ int otid() { int t = threadIdx.x; asm volatile("" : "+v"(t)); return t; }
__device__ __forceinline__ float sigmoidf_(float x) { return __builtin_amdgcn_rcpf(1.f + __expf(-x)); }
__device__ __forceinline__ float siluf_(float x) { return x * __builtin_amdgcn_rcpf(1.f + __expf(-x)); }
__device__ __forceinline__ float geluf_(float x) { const float u = 0.7978845608f * (x + 0.044715f * x * x * x); return x / (1.f + __expf(-2.f * u)); }
__device__ __forceinline__ float softplusf_(float x) { return fmaxf(x, 0.f) + log1pf(__expf(-fabsf(x))); }
__device__ __forceinline__ float silu_fast(float x) { return x * __builtin_amdgcn_rcpf(1.f + __expf(-x)); }
__device__ __forceinline__ float sigmoid_fast(float x) { return __builtin_amdgcn_rcpf(1.f + __expf(-x)); }
__device__ __forceinline__ float gelu_fast(float x) { const float u = 0.7978845608f * (x + 0.044715f * x * x * x); return x * __builtin_amdgcn_rcpf(1.f + __expf(-2.f * u)); }
__device__ __forceinline__ int cond_row(int r) { return r < NPR ? (r >> 12) : 4 + ((r - NPR) >> 2); }
__device__ __forceinline__ int seq_start(int r) { return r < NPR ? (r & ~4095) : NPR + ((r - NPR) & ~3); }

constexpr int BM = 256, BK = 64, HALF = 128, HTB = HALF * BK * 2;
__device__ __forceinline__ int lds_byte(int r, int c) { const int st = (r >> 4) * 2 + (c >> 5), rr = r & 15, cc = c & 31, ob = rr * 64 + cc * 2; return st * 1024 + (ob ^ (((ob >> 9) & 1) << 5)); }
__device__ __forceinline__ void stage_rc(int b, int& R, int& C) { const int st = b / 1024, sb = b % 1024, swz = sb ^ (((sb >> 9) & 1) << 5); R = (st >> 1) * 16 + swz / 64; C = (st & 1) * 32 + (swz % 64) / 2; }
__device__ __forceinline__ int perm32(int rho) { const int n = rho >> 4, i = rho & 15; return 8 * (i >> 2) + 4 * n + (i & 3); }

struct Unit { int pm, pn, z; };
struct Gemm { const bf16_t* A; const bf16_t* Bt; int lda, ldb, K, nM, nN; int ao0, ao1, ao2, ao3; size_t zB; };
__device__ __forceinline__ int gemm_aofs(const Gemm& g, int z) { return z == 0 ? g.ao0 : (z == 1 ? g.ao1 : (z == 2 ? g.ao2 : g.ao3)); }

template <int ZN> __device__ __forceinline__ bool unit_next(const Gemm& g, int i, Unit& u) {
    const int tile = i / ZN; u.z = i - tile * ZN;
    const long L = (long)tile * gridDim.x + blockIdx.x; const int nwg = g.nM * g.nN; if (L >= nwg) return false;
    int wgid = (int)L; { const int q = nwg / 8, r = nwg % 8, xcd = wgid % 8, off = wgid / 8; wgid = (xcd < r ? xcd * (q + 1) : r * (q + 1) + (xcd - r) * q) + off; }
    const int nig = 4 * g.nN, gid = wgid / nig, fm = gid * 4, gsz = (g.nM - fm) < 4 ? (g.nM - fm) : 4;
    u.pm = fm + ((wgid % nig) % gsz); u.pn = (wgid % nig) / gsz; return true;
}

template <class Epi, int ZN>
__device__ __forceinline__ void gemm_phase(LAS unsigned char* lds, const Gemm g, const Epi& E) {
    const int tid = otid(), wid = __builtin_amdgcn_readfirstlane(tid >> 6), lane = tid & 63, wr = wid >> 2, wc = wid & 3, fr = lane & 15, fq = lane >> 4;
    const int K = g.K, nt = K / BK;
    unsigned voffA[2], voffB[2];
#pragma unroll
    for (int i = 0; i < 2; ++i) { int R, C; stage_rc(tid * 16 + i * 8192, R, C); const int Rb = Epi::PERM ? ((R & ~31) + perm32(R & 31)) : R;
        voffA[i] = (unsigned)(R * g.lda + C) * 2u; voffB[i] = (unsigned)(Rb * g.ldb + C) * 2u; }
    const size_t kstep = (size_t)(BK * 2);
    const size_t hstepA = (size_t)HALF * g.lda * 2, hstepB = (size_t)HALF * g.ldb * 2;
    const size_t tstepA = 2 * hstepA, tstepB = 2 * hstepB;
    const unsigned ldsw = (unsigned)wid * 1024u;
    const int aoff = lds_byte(wr * 64 + fr, fq * 8), boff = lds_byte(wc * 32 + fr, fq * 8);
#define PG8_SA(b, h) (((b) * 2 + (h)) * HTB)
#define PG8_SB(b, h) ((4 + (b) * 2 + (h)) * HTB)
#define PG8_STAGE(bufoff, gbase, voff) do { _Pragma("unroll") for (int _i = 0; _i < 2; ++_i) \
        __builtin_amdgcn_global_load_lds((const unsigned*)((const char*)(gbase) + (voff)[_i]), (LAS unsigned*)(lds + (bufoff) + ldsw + _i * 8192), 16, 0, 0); } while (0)
#define PG8_LDA(dst, b, h) do { _Pragma("unroll") for (int m = 0; m < 4; ++m) _Pragma("unroll") for (int k = 0; k < 2; ++k) dst[m][k] = *(const LAS bf16x8*)(lds + PG8_SA(b, h) + aoff + m * 2048 + k * 1024); } while (0)
#define PG8_LDB(dst, b, h) do { _Pragma("unroll") for (int n = 0; n < 2; ++n) _Pragma("unroll") for (int k = 0; k < 2; ++k) dst[n][k] = *(const LAS bf16x8*)(lds + PG8_SB(b, h) + boff + n * 2048 + k * 1024); } while (0)
#define PG8_MMA(ai, bj, At, Bt) do { __builtin_amdgcn_s_setprio(1); _Pragma("unroll") for (int m = 0; m < 4; ++m) _Pragma("unroll") for (int n = 0; n < 2; ++n) _Pragma("unroll") for (int k = 0; k < 2; ++k) \
        acc[ai][bj][m][n] = __builtin_amdgcn_mfma_f32_16x16x32_bf16(Bt[n][k], At[m][k], acc[ai][bj][m][n], 0, 0, 0); __builtin_amdgcn_s_setprio(0); } while (0)
#define PG8_WAIT_V(n) asm volatile("s_waitcnt vmcnt(" #n ")" ::: "memory")
#define PG8_WAIT_L(n) asm volatile("s_waitcnt lgkmcnt(" #n ")" ::: "memory")
#define PG8_BAR __builtin_amdgcn_s_barrier()
#define PG8_SCHED __builtin_amdgcn_sched_barrier(0)
    Unit cur, nxt; int ui = 0;
    if (!unit_next<ZN>(g, 0, cur)) return;
    f32x4 acc[2][2][4][2];
#pragma unroll
    for (int a = 0; a < 2; ++a)
#pragma unroll
        for (int b = 0; b < 2; ++b)
#pragma unroll
            for (int m = 0; m < 4; ++m)
#pragma unroll
                for (int n = 0; n < 2; ++n) acc[a][b][m][n] = (f32x4){0.f, 0.f, 0.f, 0.f};
    bf16x8 At[4][2], B0[2][2], B1[2][2];
    const char* cA = (const char*)g.A + (size_t)cur.pm * tstepA + (size_t)gemm_aofs(g, cur.z) * 2;
    const char* cB = (const char*)g.Bt + (size_t)cur.pn * tstepB + (size_t)cur.z * g.zB * 2;
    PG8_WAIT_V(0);
    PG8_STAGE(PG8_SB(0, 0), cB, voffB); PG8_STAGE(PG8_SA(0, 0), cA, voffA); PG8_STAGE(PG8_SB(0, 1), cB + hstepB, voffB); PG8_STAGE(PG8_SA(0, 1), cA + hstepA, voffA);
    if (wr == 1) PG8_BAR;
    PG8_WAIT_V(4); PG8_BAR;
    PG8_STAGE(PG8_SB(1, 0), cB + kstep, voffB); PG8_STAGE(PG8_SA(1, 0), cA + kstep, voffA); PG8_STAGE(PG8_SB(1, 1), cB + hstepB + kstep, voffB);
    PG8_WAIT_V(6); PG8_BAR;
    for (;;) {
        const bool has_next = unit_next<ZN>(g, ui + 1, nxt);
        const char* nA = has_next ? (const char*)g.A + (size_t)nxt.pm * tstepA + (size_t)gemm_aofs(g, nxt.z) * 2 : cA;
        const char* nB = has_next ? (const char*)g.Bt + (size_t)nxt.pn * tstepB + (size_t)nxt.z * g.zB * 2 : cB;
        for (int t = 0; t < nt; t += 2) {
            const bool last = (t == nt - 2);
            const char* a1 = cA + (size_t)(t + 1) * kstep;
            const char* a2 = last ? nA : cA + (size_t)(t + 2) * kstep; const char* b2 = last ? nB : cB + (size_t)(t + 2) * kstep;
            const char* a3 = a2 + kstep; const char* b3 = b2 + kstep;
            PG8_LDB(B0, 0, 0); PG8_SCHED; PG8_LDA(At, 0, 0); PG8_STAGE(PG8_SA(1, 1), a1 + hstepA, voffA);
            PG8_WAIT_L(8); PG8_BAR; PG8_WAIT_L(0); PG8_MMA(0, 0, At, B0); PG8_BAR; PG8_SCHED;
            PG8_LDB(B1, 0, 1); PG8_STAGE(PG8_SB(0, 0), b2, voffB);
            PG8_BAR; PG8_WAIT_L(0); PG8_MMA(0, 1, At, B1); PG8_BAR;
            PG8_LDA(At, 0, 1); PG8_STAGE(PG8_SA(0, 0), a2, voffA);
            PG8_BAR; PG8_WAIT_L(0); PG8_MMA(1, 0, At, B0); PG8_BAR; PG8_SCHED;
            PG8_STAGE(PG8_SB(0, 1), b2 + hstepB, voffB);
            PG8_WAIT_V(6); PG8_BAR; PG8_MMA(1, 1, At, B1); PG8_BAR;
            PG8_LDB(B0, 1, 0); PG8_SCHED; PG8_LDA(At, 1, 0); PG8_STAGE(PG8_SA(0, 1), a2 + hstepA, voffA);
            PG8_WAIT_L(8); PG8_BAR; PG8_WAIT_L(0); PG8_MMA(0, 0, At, B0); PG8_BAR; PG8_SCHED;
            PG8_LDB(B1, 1, 1); PG8_STAGE(PG8_SB(1, 0), b3, voffB);
            PG8_BAR; PG8_WAIT_L(0); PG8_MMA(0, 1, At, B1); PG8_BAR;
            PG8_LDA(At, 1, 1); PG8_STAGE(PG8_SA(1, 0), a3, voffA);
            PG8_BAR; PG8_WAIT_L(0); PG8_MMA(1, 0, At, B0); PG8_BAR; PG8_SCHED;
            PG8_STAGE(PG8_SB(1, 1), b3 + hstepB, voffB);
            PG8_WAIT_V(6); PG8_BAR; PG8_MMA(1, 1, At, B1); PG8_BAR;
        }
        E(acc, cur, wr, wc, fr, fq);
        if (!has_next) break;
#pragma unroll
        for (int a = 0; a < 2; ++a)
#pragma unroll
            for (int b = 0; b < 2; ++b)
#pragma unroll
                for (int m = 0; m < 4; ++m)
#pragma unroll
                    for (int n = 0; n < 2; ++n) acc[a][b][m][n] = (f32x4){0.f, 0.f, 0.f, 0.f};
        cur = nxt; cA = nA; cB = nB; ++ui;
    }
    PG8_WAIT_V(0);
    if (wr == 0) PG8_BAR;
    PG8_BAR;
#undef PG8_SA
#undef PG8_SB
#undef PG8_STAGE
#undef PG8_LDA
#undef PG8_LDB
#undef PG8_MMA
#undef PG8_WAIT_V
#undef PG8_WAIT_L
#undef PG8_BAR
#undef PG8_SCHED
}

struct EpiMod {
    static constexpr bool PERM = false;
    float* mod; const float* bada;
    __device__ __forceinline__ void operator()(const f32x4 (&acc)[2][2][4][2], const Unit& u, int wr, int wc, int fr, int fq) const {
        f32x4 bv[2][2];
#pragma unroll
        for (int bj = 0; bj < 2; ++bj)
#pragma unroll
            for (int n = 0; n < 2; ++n) bv[bj][n] = *(const f32x4*)(bada + u.pn * BM + bj * HALF + wc * 32 + n * 16 + fq * 4);
#pragma unroll
        for (int ai = 0; ai < 2; ++ai)
#pragma unroll
            for (int m = 0; m < 4; ++m) { const int r = u.pm * BM + ai * HALF + wr * 64 + m * 16 + fr; if (r >= NCOND) continue;
#pragma unroll
                for (int bj = 0; bj < 2; ++bj)
#pragma unroll
                    for (int n = 0; n < 2; ++n) { const int c = u.pn * BM + bj * HALF + wc * 32 + n * 16 + fq * 4; const int layer = c / 6144, cc = c - layer * 6144;
                        *(f32x4*)(mod + ((size_t)(layer * NCOND + r)) * 6144 + cc) = acc[ai][bj][m][n] + bv[bj][n]; } }
    }
};
struct EpiProj {
    static constexpr bool PERM = true;
    bf16_t* O;
    __device__ __forceinline__ void operator()(const f32x4 (&acc)[2][2][4][2], const Unit& u, int wr, int wc, int fr, int fq) const {
#pragma unroll
        for (int bj = 0; bj < 2; ++bj) { const int c = u.pn * BM + bj * HALF + wc * 32 + fq * 8; const int mode = (c >= C_UV + 1024 && c < C_GATE) ? 1 : 0;
#pragma unroll
            for (int ai = 0; ai < 2; ++ai)
#pragma unroll
                for (int m = 0; m < 4; ++m) { const int r = u.pm * BM + ai * HALF + wr * 64 + m * 16 + fr;
                    float v[8];
#pragma unroll
                    for (int i = 0; i < 8; ++i) { float x = acc[ai][bj][m][i >> 2][i & 3]; v[i] = (mode == 1 ? gelu_fast(x) : x); }
                    u32x4 o; o[0] = pk2(v[0], v[1]); o[1] = pk2(v[2], v[3]); o[2] = pk2(v[4], v[5]); o[3] = pk2(v[6], v[7]);
                    *(u32x4*)(O + (size_t)r * LDP + c) = o; } }
    }
};
struct EpiUp {
    static constexpr bool PERM = true;
    bf16_t* O;
    __device__ __forceinline__ void operator()(const f32x4 (&acc)[2][2][4][2], const Unit& u, int wr, int wc, int fr, int fq) const {
#pragma unroll
        for (int bj = 0; bj < 2; ++bj) { const int c = u.pn * BM + bj * HALF + wc * 32 + fq * 8;
#pragma unroll
            for (int ai = 0; ai < 2; ++ai)
#pragma unroll
                for (int m = 0; m < 4; ++m) { const int r = u.pm * BM + ai * HALF + wr * 64 + m * 16 + fr;
                    const f32x4 a = acc[ai][bj][m][0], b = acc[ai][bj][m][1];
                    u32x4 o; o[0] = pk2(a[0], a[1]); o[1] = pk2(a[2], a[3]); o[2] = pk2(b[0], b[1]); o[3] = pk2(b[2], b[3]);
                    *(u32x4*)(O + (size_t)r * 5632 + c) = o; } }
    }
};
struct EpiBranch {
    static constexpr bool PERM = true;
    const bf16_t* proj; float* msum; bf16_t* merged;
    __device__ __forceinline__ void operator()(const f32x4 (&acc)[2][2][4][2], const Unit& u, int wr, int wc, int fr, int fq) const {
        const int z = u.z;
        u32x4 gt[2][2], pv[2][2];
        const int c0 = u.pn * BM + wc * 32 + fq * 8, r0 = u.pm * BM + wr * 64 + fr;
#define EB_LOAD(k, buf) do { const int bj_ = (k) >> 2, ai_ = ((k) >> 1) & 1, m0_ = ((k) & 1) * 2; _Pragma("unroll") for (int mm = 0; mm < 2; ++mm) { const int r = r0 + ai_ * HALF + (m0_ + mm) * 16, c = c0 + bj_ * HALF; \
            gt[buf][mm] = *(const u32x4*)(proj + (size_t)r * LDP + C_GATE + z * 1024 + c); pv[buf][mm] = (u32x4){0u, 0u, 0u, 0u}; \
            if (z > 0) pv[buf][mm] = *(const u32x4*)(merged + (size_t)r * 1024 + c); } } while (0)
        EB_LOAD(0, 0);
#pragma unroll
        for (int k = 0; k < 8; ++k) { const int bj = k >> 2, ai = (k >> 1) & 1, m0 = (k & 1) * 2, buf = k & 1;
            if (k < 7) { if (buf == 0) EB_LOAD(k + 1, 1); else EB_LOAD(k + 1, 0); }
#pragma unroll
            for (int mm = 0; mm < 2; ++mm) { const int m = m0 + mm; const int r = r0 + ai * HALF + m * 16, c = c0 + bj * HALF;
                const f32x4 a = acc[ai][bj][m][0], b = acc[ai][bj][m][1]; const u32x4 gv = gt[buf][mm], p = pv[buf][mm];
                u32x4 o;
                o[0] = pk2(bflo(p[0]) + sigmoid_fast(bflo(gv[0])) * a[0], bfhi(p[0]) + sigmoid_fast(bfhi(gv[0])) * a[1]); o[1] = pk2(bflo(p[1]) + sigmoid_fast(bflo(gv[1])) * a[2], bfhi(p[1]) + sigmoid_fast(bfhi(gv[1])) * a[3]);
                o[2] = pk2(bflo(p[2]) + sigmoid_fast(bflo(gv[2])) * b[0], bfhi(p[2]) + sigmoid_fast(bfhi(gv[2])) * b[1]); o[3] = pk2(bflo(p[3]) + sigmoid_fast(bflo(gv[3])) * b[2], bfhi(p[3]) + sigmoid_fast(bfhi(gv[3])) * b[3]);
                *(u32x4*)(merged + (size_t)r * 1024 + c) = o; } }
#undef EB_LOAD
    }
};
struct EpiResid {
    static constexpr bool PERM = false;
    const float* xin_p; const float* xin_s; float* xout; const float* ga;
    __device__ __forceinline__ void operator()(const f32x4 (&acc)[2][2][4][2], const Unit& u, int wr, int wc, int fr, int fq) const {
        const float* gr = ga + (size_t)(u.pm >> 4) * 6144;
        f32x4 gv[2][2];
#pragma unroll
        for (int bj = 0; bj < 2; ++bj)
#pragma unroll
            for (int n = 0; n < 2; ++n) gv[bj][n] = *(const f32x4*)(gr + u.pn * BM + bj * HALF + wc * 32 + n * 16 + fq * 4);
#pragma unroll
        for (int am = 0; am < 4; ++am) { const int ai = am >> 1, m0 = (am & 1) * 2;
            f32x4 xv[2][2][2];
#pragma unroll
            for (int mm = 0; mm < 2; ++mm) { const int r = u.pm * BM + ai * HALF + wr * 64 + (m0 + mm) * 16 + fr;
#pragma unroll
                for (int bj = 0; bj < 2; ++bj)
#pragma unroll
                    for (int n = 0; n < 2; ++n) xv[mm][bj][n] = *(const f32x4*)(xin_p + (size_t)r * 1024 + u.pn * BM + bj * HALF + wc * 32 + n * 16 + fq * 4); }
#pragma unroll
            for (int mm = 0; mm < 2; ++mm) { const int r = u.pm * BM + ai * HALF + wr * 64 + (m0 + mm) * 16 + fr;
#pragma unroll
                for (int bj = 0; bj < 2; ++bj)
#pragma unroll
                    for (int n = 0; n < 2; ++n) *(f32x4*)(xout + (size_t)r * 1024 + u.pn * BM + bj * HALF + wc * 32 + n * 16 + fq * 4) = xv[mm][bj][n] + gv[bj][n] * acc[ai][bj][m0 + mm][n]; } }
    }
};

struct CTile { const float* src; bf16_t* dst; int K, N, k0, n0; };
__device__ __forceinline__ CTile conv_decode(const Params& P, int t) {
    constexpr int T_IN = 3392, T_BR = 1024, T_O = 256, T_UP = 1408, T_DN = 704, T_ADA = 1536, T_L = T_IN + T_BR + T_O + T_UP + T_DN + T_ADA;
    const int layer = t / T_L; int r = t - layer * T_L; CTile c;
    if (r < T_IN) { c.src = P.in[13] + (size_t)layer * 1024 * 13328; c.dst = (bf16_t*)(P.ws + WS_WIN) + (size_t)layer * 13568 * 1024; c.K = 1024; c.N = 13328; c.k0 = (r / 212) * 64; c.n0 = (r % 212) * 64; return c; }
    r -= T_IN;
    if (r < T_BR) { const int br = r >> 8, q = r & 255; c.src = P.in[26] + (size_t)(layer * 4 + br) * 1048576; c.dst = (bf16_t*)(P.ws + WS_WBR) + (size_t)(layer * 4 + br) * 1048576; c.K = 1024; c.N = 1024; c.k0 = (q >> 4) * 64; c.n0 = (q & 15) * 64; return c; }
    r -= T_BR;
    if (r < T_O) { c.src = P.in[27] + (size_t)layer * 1048576; c.dst = (bf16_t*)(P.ws + WS_WO) + (size_t)layer * 1048576; c.K = 1024; c.N = 1024; c.k0 = (r >> 4) * 64; c.n0 = (r & 15) * 64; return c; }
    r -= T_O;
    if (r < T_UP) { c.src = P.in[29] + (size_t)layer * 1024 * 5632; c.dst = (bf16_t*)(P.ws + WS_WUP) + (size_t)layer * 5632 * 1024; c.K = 1024; c.N = 5632; c.k0 = (r / 88) * 64; c.n0 = (r % 88) * 64; return c; }
    r -= T_UP;
    if (r < T_DN) { c.src = P.in[32] + (size_t)layer * 2816 * 1024; c.dst = (bf16_t*)(P.ws + WS_WDN) + (size_t)layer * 1024 * 2816; c.K = 2816; c.N = 1024; c.k0 = (r >> 4) * 64; c.n0 = (r & 15) * 64; return c; }
    r -= T_DN;
    c.src = P.in[10] + (size_t)layer * 1024 * 6144; c.dst = (bf16_t*)(P.ws + WS_WADA) + (size_t)layer * 6144 * 1024; c.K = 1024; c.N = 6144; c.k0 = (r / 96) * 64; c.n0 = (r % 96) * 64; return c;
}
__device__ __forceinline__ void phase_convert(const Params& P, float* T) {
    constexpr int NT = 4 * 8320;
    const int tid = otid();
    int t = blockIdx.x;
    CTile cur = conv_decode(P, t < NT ? t : 0);
    float v[8], nv[8];
#pragma unroll
    for (int e = 0; e < 8; ++e) { const int idx = tid + e * 512, k = idx >> 6, n = idx & 63; v[e] = (t < NT && cur.n0 + n < cur.N) ? cur.src[(size_t)(cur.k0 + k) * cur.N + cur.n0 + n] : 0.f; }
    for (; t < NT; t += gridDim.x) {
        const int tn = t + gridDim.x; const bool hn = tn < NT; const CTile nxt = conv_decode(P, hn ? tn : 0);
#pragma unroll
        for (int e = 0; e < 8; ++e) { const int idx = tid + e * 512, k = idx >> 6, n = idx & 63; nv[e] = (hn && nxt.n0 + n < nxt.N) ? nxt.src[(size_t)(nxt.k0 + k) * nxt.N + nxt.n0 + n] : 0.f; }
#pragma unroll
        for (int e = 0; e < 8; ++e) { const int idx = tid + e * 512, k = idx >> 6, n = idx & 63; T[k * 65 + n] = v[e]; }
        __syncthreads();
        { const int n = tid >> 3, kc = (tid & 7) * 8; float x[8];
#pragma unroll
          for (int j = 0; j < 8; ++j) x[j] = T[(kc + j) * 65 + n];
          u32x4 o; o[0] = pk2(x[0], x[1]); o[1] = pk2(x[2], x[3]); o[2] = pk2(x[4], x[5]); o[3] = pk2(x[6], x[7]);
          *(u32x4*)(cur.dst + (size_t)(cur.n0 + n) * cur.K + cur.k0 + kc) = o; }
        __syncthreads();
#pragma unroll
        for (int e = 0; e < 8; ++e) v[e] = nv[e];
        cur = nxt;
    }
    bf16_t* cact = (bf16_t*)(P.ws + WS_CACT);
    for (int i = blockIdx.x * 512 + otid(); i < 256 * 1024; i += gridDim.x * 512) {
        const int r = i >> 10, c = i & 1023; float v = 0.f;
        if (r < 4) v = siluf_(P.in[2][r * 1024 + c]); else if (r < NCOND) v = siluf_(P.in[3][(r - 4) * 1024 + c]);
        cact[i] = f2bf(v);
    }
}

__device__ __forceinline__ void phase_norm(const float* xp, const float* xs, const float* g, const float* modL, int shofs, int scofs, bf16_t* hout) {
    const int tid = otid(); const int w = tid >> 6, lane = tid & 63;
    for (int r = blockIdx.x * 8 + w; r < NTOK; r += gridDim.x * 8) {
        const float* x = r < NPR ? xp + (size_t)r * 1024 : xs + (size_t)(r - NPR) * 1024;
        const float* mr = modL + (size_t)cond_row(r) * 6144;
        f32x4 v[4]; float ss = 0.f;
#pragma unroll
        for (int i = 0; i < 4; ++i) { v[i] = *(const f32x4*)(x + i * 256 + lane * 4); ss += v[i][0] * v[i][0] + v[i][1] * v[i][1] + v[i][2] * v[i][2] + v[i][3] * v[i][3]; }
        ss = wave_sum(ss, lane); const float rs = rsqrtf(ss * (1.f / 1024.f) + EPSF);
#pragma unroll
        for (int i = 0; i < 4; ++i) { const int c = i * 256 + lane * 4;
            const f32x4 gv = *(const f32x4*)(g + c), sc = *(const f32x4*)(mr + scofs + c), sh = *(const f32x4*)(mr + shofs + c);
            f32x4 o = v[i] * rs * gv * (sc + 1.f) + sh;
            u32x2 pk; pk[0] = pk2(o[0], o[1]); pk[1] = pk2(o[2], o[3]);
            *(u32x2*)(hout + (size_t)r * 1024 + c) = pk; }
    }
}
__device__ __forceinline__ void phase_final_norm(float* x, const float* g) {
    const int tid = otid(); const int w = tid >> 6, lane = tid & 63;
    for (int r = blockIdx.x * 8 + w; r < NTOK; r += gridDim.x * 8) {
        float* xr = x + (size_t)r * 1024; f32x4 v[4]; float ss = 0.f;
#pragma unroll
        for (int i = 0; i < 4; ++i) { v[i] = *(const f32x4*)(xr + i * 256 + lane * 4); ss += v[i][0] * v[i][0] + v[i][1] * v[i][1] + v[i][2] * v[i][2] + v[i][3] * v[i][3]; }
        ss = wave_sum(ss, lane); const float rs = rsqrtf(ss * (1.f / 1024.f) + EPSF);
#pragma unroll
        for (int i = 0; i < 4; ++i) { const int c = i * 256 + lane * 4; const f32x4 gv = *(const f32x4*)(g + c); *(f32x4*)(xr + c) = v[i] * rs * gv; }
    }
}

template <int MODE>
__device__ __forceinline__ void ssd_item(const Params& P, int layer, int item, float* L) {
    const int tid = otid(), w = tid >> 6, lane = tid & 63;
    bf16_t* proj = (bf16_t*)(P.ws + WS_PROJ);
    float* states = (float*)(P.ws + WS_SSDST); float* decs = (float*)(P.ws + WS_SSDDEC);
    int r0, nsteps, half, seq0, b = 0, c = 0, sb = 0;
    if (MODE == 2) { sb = item >> 1; half = item & 1; r0 = NPR + sb * 4; nsteps = 4; seq0 = r0; }
    else { b = item >> 6; c = (item >> 1) & 31; half = item & 1; r0 = b * 4096 + c * 128; nsteps = 128; seq0 = b * 4096; }
    float* XS = L; float* ZS = XS + 16 * 512; float* BS = ZS + 16 * 512; float* CS = BS + 16 * 128; float* DTS = CS + 16 * 128; float* DAS = DTS + 128; float* SSQ = DAS + 128;
    const float* cw = P.in[14] + (size_t)layer * 4 * 1536; const float* cb = P.in[15] + (size_t)layer * 1536;
    const float* prev = P.in[5] + ((size_t)(layer * 128 + sb)) * 3 * 1536;
    const int hd = half * 8 + w, gl = w >> 2;
    float h[64];
    if (MODE == 0) {
#pragma unroll
        for (int n = 0; n < 64; ++n) h[n] = 0.f;
    } else {
        const float* s0p = (MODE == 1) ? states + ((size_t)((b * 32 + c) * 16 + hd)) * 4096 + lane * 64
                                       : P.in[4] + ((size_t)((layer * 128 + sb) * 16 + hd)) * 4096 + lane * 64;
#pragma unroll
        for (int n4 = 0; n4 < 16; ++n4) { const f32x4 v = *(const f32x4*)(s0p + n4 * 4); h[n4 * 4] = v[0]; h[n4 * 4 + 1] = v[1]; h[n4 * 4 + 2] = v[2]; h[n4 * 4 + 3] = v[3]; }
    }
    const float Dh = P.in[18][layer * 16 + hd];
    float decp = 1.f;
    for (int s0 = 0; s0 < nsteps; s0 += 16) {
        const int ns = (nsteps - s0) < 16 ? (nsteps - s0) : 16;
        __syncthreads();
        for (int idx = tid; idx < ns * 768; idx += 512) {
            const int t = idx / 768, ch = idx - t * 768;
            int cx;
            if (ch < 512) cx = half * 512 + ch; else if (ch < 640) cx = 1024 + half * 128 + (ch - 512); else cx = 1280 + half * 128 + (ch - 640);
            float a = cb[cx];
#pragma unroll
            for (int k = 0; k < 4; ++k) { const int step = s0 + t - 3 + k, rr = r0 + step; float raw;
                if (rr >= seq0) raw = bf2f(proj[(size_t)rr * LDP + C_XBC + cx]);
                else raw = (MODE == 2) ? prev[(3 + step) * 1536 + cx] : 0.f;
                a += cw[k * 1536 + cx] * raw; }
            a = siluf_(a);
            if (ch < 512) { XS[t * 512 + ch] = a; if (MODE != 0) ZS[t * 512 + ch] = bf2f(proj[(size_t)(r0 + s0 + t) * LDP + C_Z + cx]); }
            else if (ch < 640) BS[t * 128 + ch - 512] = a; else CS[t * 128 + ch - 640] = a;
        }
        if (tid < ns * 8) { const int t = tid >> 3, ww = tid & 7, hh = half * 8 + ww;
            const float dt = softplusf_(bf2f(proj[(size_t)(r0 + s0 + t) * LDP + C_DTR + hh]) + P.in[16][layer * 16 + hh]);
            DTS[t * 8 + ww] = dt; DAS[t * 8 + ww] = __expf(-dt * __expf(P.in[17][layer * 16 + hh])); }
        __syncthreads();
        for (int t = 0; t < ns; ++t) {
            const float a = DAS[t * 8 + w], dt = DTS[t * 8 + w], xv = XS[t * 512 + w * 64 + lane], xd = xv * dt; decp *= a;
            const f32x4* B4 = (const f32x4*)(BS + t * 128 + gl * 64);
#pragma unroll
            for (int n4 = 0; n4 < 16; ++n4) { const f32x4 bv = B4[n4];
                h[n4 * 4] = a * h[n4 * 4] + xd * bv[0]; h[n4 * 4 + 1] = a * h[n4 * 4 + 1] + xd * bv[1]; h[n4 * 4 + 2] = a * h[n4 * 4 + 2] + xd * bv[2]; h[n4 * 4 + 3] = a * h[n4 * 4 + 3] + xd * bv[3]; }
            if (MODE != 0) {
                const f32x4* C4 = (const f32x4*)(CS + t * 128 + gl * 64); float y0 = 0.f, y1 = 0.f;
#pragma unroll
                for (int n4 = 0; n4 < 16; ++n4) { const f32x4 cv = C4[n4]; y0 += h[n4 * 4] * cv[0] + h[n4 * 4 + 2] * cv[2]; y1 += h[n4 * 4 + 1] * cv[1] + h[n4 * 4 + 3] * cv[3]; }
                float y = y0 + y1 + Dh * xv; y *= siluf_(ZS[t * 512 + w * 64 + lane]);
                const float sq = wave_sum(y * y, lane); if (lane == 0) SSQ[(s0 + t) * 8 + w] = sq;
                proj[(size_t)(r0 + s0 + t) * LDP + C_Z + hd * 64 + lane] = f2bf(y);
            }
        }
    }
    if (MODE == 0) {
        float* sp = states + ((size_t)((b * 32 + c) * 16 + hd)) * 4096 + lane * 64;
#pragma unroll
        for (int n4 = 0; n4 < 16; ++n4) *(f32x4*)(sp + n4 * 4) = (f32x4){h[n4 * 4], h[n4 * 4 + 1], h[n4 * 4 + 2], h[n4 * 4 + 3]};
        if (lane == 0) decs[(b * 32 + c) * 16 + hd] = decp;
    }
    if (MODE == 2) {
        float* sp = P.out + O_SSSM + ((size_t)((layer * 128 + sb) * 16 + hd)) * 4096 + lane * 64;
#pragma unroll
        for (int n4 = 0; n4 < 16; ++n4) *(f32x4*)(sp + n4 * 4) = (f32x4){h[n4 * 4], h[n4 * 4 + 1], h[n4 * 4 + 2], h[n4 * 4 + 3]};
    }
    if (MODE != 0) {
        __syncthreads();
        const float ng = P.in[19][layer * 1024 + hd * 64 + lane];
        for (int t = 0; t < nsteps; ++t) {
            const float tot = SSQ[t * 8 + gl * 4] + SSQ[t * 8 + gl * 4 + 1] + SSQ[t * 8 + gl * 4 + 2] + SSQ[t * 8 + gl * 4 + 3];
            const float sc = rsqrtf(tot * (1.f / 256.f) + EPSF) * ng;
            bf16_t* ap = proj + (size_t)(r0 + t) * LDP + C_Z + hd * 64 + lane; *ap = f2bf(bf2f(*ap) * sc);
        }
    }
}

__device__ __forceinline__ int xt_idx(int row, int t) { return row * 136 + ((((t >> 3) ^ ((row >> 3) & 15)) << 3) | (t & 7)); }
__device__ __forceinline__ void ssd_stage_dt(const Params& P, int layer, const bf16_t* proj, size_t r0, int g, float* DT, float* ACS, int tid) {
    { const int hh = tid >> 7, t = tid & 127, hd = g * 4 + hh;
      const float dt = softplusf_(bf2f(proj[(r0 + t) * LDP + C_DTR + hd]) + P.in[16][layer * 16 + hd]);
      DT[hh * 128 + t] = dt; ACS[hh * 128 + t] = -dt * __expf(P.in[17][layer * 16 + hd]); }
    __syncthreads();
    if (tid < 256) { const int hh = tid >> 6, l = tid & 63; const float a0 = ACS[hh * 128 + 2 * l], a1 = ACS[hh * 128 + 2 * l + 1]; float sum = a0 + a1;
#pragma unroll
        for (int o = 1; o < 64; o <<= 1) { const float v = __int_as_float(__builtin_amdgcn_ds_bpermute(((l - o) & 63) << 2, __float_as_int(sum))); if (l >= o) sum += v; }
        ACS[hh * 128 + 2 * l] = sum - a1; ACS[hh * 128 + 2 * l + 1] = sum; }
    __syncthreads();
}
template <int PASS>
__device__ __forceinline__ void ssd_stage_conv(const Params& P, int layer, const bf16_t* proj, size_t r0, bool first, int g, const float* DT, const float* ACS, bf16_t* XT4, bf16_t* Bx, bf16_t* Cs, int tid) {
    const int slot = tid & 63, seg = tid >> 6;
    if (slot < (PASS ? 48 : 40)) {
        int cx; if (slot < 32) cx = g * 256 + slot * 8; else if (slot < 40) cx = 1024 + g * 64 + (slot - 32) * 8; else cx = 1280 + g * 64 + (slot - 40) * 8;
        const float* cw = P.in[14] + (size_t)layer * 4 * 1536 + cx; const float* cb = P.in[15] + (size_t)layer * 1536 + cx;
        float wt[4][8], bb[8], win[3][8];
#pragma unroll
        for (int k = 0; k < 4; ++k) { const f32x4 a = *(const f32x4*)(cw + k * 1536), c = *(const f32x4*)(cw + k * 1536 + 4);
#pragma unroll
            for (int i = 0; i < 4; ++i) { wt[k][i] = a[i]; wt[k][4 + i] = c[i]; } }
        { const f32x4 a = *(const f32x4*)cb, c = *(const f32x4*)(cb + 4);
#pragma unroll
          for (int i = 0; i < 4; ++i) { bb[i] = a[i]; bb[4 + i] = c[i]; } }
        const int t0 = seg * 16;
#pragma unroll
        for (int k = 0; k < 3; ++k) { u32x4 raw = (u32x4){0u, 0u, 0u, 0u};
            if (!(first && seg == 0)) raw = *(const u32x4*)(proj + (r0 + t0 - 3 + k) * LDP + C_XBC + cx);
#pragma unroll
            for (int i = 0; i < 4; ++i) { win[k][2 * i] = bflo(raw[i]); win[k][2 * i + 1] = bfhi(raw[i]); } }
        u32x4 cur4[4], nxt4[4];
#pragma unroll
        for (int q = 0; q < 4; ++q) { cur4[q] = *(const u32x4*)(proj + (r0 + t0 + q) * LDP + C_XBC + cx); nxt4[q] = cur4[q]; }
        for (int gq = 0; gq < 4; ++gq) {
            if (gq < 3) {
#pragma unroll
                for (int q = 0; q < 4; ++q) nxt4[q] = *(const u32x4*)(proj + (r0 + t0 + gq * 4 + 4 + q) * LDP + C_XBC + cx); }
#pragma unroll
            for (int q = 0; q < 4; ++q) {
                const int t = t0 + gq * 4 + q; const u32x4 raw = cur4[q];
                float cur[8], o[8];
#pragma unroll
                for (int i = 0; i < 4; ++i) { cur[2 * i] = bflo(raw[i]); cur[2 * i + 1] = bfhi(raw[i]); }
#pragma unroll
                for (int i = 0; i < 8; ++i) { o[i] = siluf_(bb[i] + wt[0][i] * win[0][i] + wt[1][i] * win[1][i] + wt[2][i] * win[2][i] + wt[3][i] * cur[i]); win[0][i] = win[1][i]; win[1][i] = win[2][i]; win[2][i] = cur[i]; }
                if (slot < 32) { const int hh = slot >> 3, p0 = (slot & 7) * 8; float sc = DT[hh * 128 + t]; if (PASS == 0) sc *= __expf(ACS[hh * 128 + 127] - ACS[hh * 128 + t]);
#pragma unroll
                    for (int i = 0; i < 8; ++i) XT4[xt_idx(hh * 64 + p0 + i, t)] = f2bf(o[i] * sc); }
                else if (slot < 40) { const int n0 = (slot - 32) * 8;
                    if (PASS == 0) {
#pragma unroll
                        for (int i = 0; i < 8; ++i) Bx[xt_idx(n0 + i, t)] = f2bf(o[i]); }
                    else { u32x4 pk; pk[0] = pk2(o[0], o[1]); pk[1] = pk2(o[2], o[3]); pk[2] = pk2(o[4], o[5]); pk[3] = pk2(o[6], o[7]); *(u32x4*)(Bx + t * 72 + n0) = pk; } }
                else { const int n0 = (slot - 40) * 8; u32x4 pk; pk[0] = pk2(o[0], o[1]); pk[1] = pk2(o[2], o[3]); pk[2] = pk2(o[4], o[5]); pk[3] = pk2(o[6], o[7]); *(u32x4*)(Cs + t * 72 + n0) = pk; }
            }
#pragma unroll
            for (int q = 0; q < 4; ++q) cur4[q] = nxt4[q];
        }
    }
}
__device__ __forceinline__ void ssd_pass1_item(const Params& P, int layer, int item, unsigned char* lds) {
    const int tid = otid(), w = __builtin_amdgcn_readfirstlane(tid >> 6), lane = tid & 63, fr = lane & 15, fq = lane >> 4;
    const int b = item >> 7, c = (item >> 2) & 31, g = item & 3; const size_t r0 = (size_t)b * 4096 + (size_t)c * 128;
    const bf16_t* proj = (const bf16_t*)(P.ws + WS_PROJ);
    float* states = (float*)(P.ws + WS_SSDST); float* decs = (float*)(P.ws + WS_SSDDEC);
    bf16_t* XT4 = (bf16_t*)lds; bf16_t* BT = XT4 + 256 * 136; float* DT = (float*)(BT + 64 * 136); float* ACS = DT + 512;
    __syncthreads();
    ssd_stage_dt(P, layer, proj, r0, g, DT, ACS, tid);
    ssd_stage_conv<0>(P, layer, proj, r0, c == 0, g, DT, ACS, XT4, BT, nullptr, tid);
    __syncthreads();
    const int hh = w >> 1, pb = (w & 1) * 2;
    f32x4 acc[2][4];
#pragma unroll
    for (int pi = 0; pi < 2; ++pi)
#pragma unroll
        for (int nt = 0; nt < 4; ++nt) acc[pi][nt] = (f32x4){0.f, 0.f, 0.f, 0.f};
#pragma unroll
    for (int ks = 0; ks < 4; ++ks) { bf16x8 a[2];
#pragma unroll
        for (int pi = 0; pi < 2; ++pi) a[pi] = *(const bf16x8*)(XT4 + xt_idx(hh * 64 + (pb + pi) * 16 + fr, ks * 32 + fq * 8));
#pragma unroll
        for (int nt = 0; nt < 4; ++nt) { const bf16x8 bv = *(const bf16x8*)(BT + xt_idx(nt * 16 + fr, ks * 32 + fq * 8));
#pragma unroll
            for (int pi = 0; pi < 2; ++pi) acc[pi][nt] = __builtin_amdgcn_mfma_f32_16x16x32_bf16(a[pi], bv, acc[pi][nt], 0, 0, 0); } }
    float* sp = states + ((size_t)((b * 32 + c) * 16 + g * 4 + hh)) * 4096;
#pragma unroll
    for (int pi = 0; pi < 2; ++pi)
#pragma unroll
        for (int nt = 0; nt < 4; ++nt)
#pragma unroll
            for (int j = 0; j < 4; ++j) sp[((pb + pi) * 16 + fq * 4 + j) * 64 + nt * 16 + fr] = acc[pi][nt][j];
    if (tid < 4) decs[(b * 32 + c) * 16 + g * 4 + tid] = __expf(ACS[tid * 128 + 127]);
}
__device__ __forceinline__ void ssd_pass3_item(const Params& P, int layer, int item, unsigned char* lds, bool dry = false) {
    const int tid = otid(), w = __builtin_amdgcn_readfirstlane(tid >> 6), lane = tid & 63, fr = lane & 15, fq = lane >> 4;
    const int b = item >> 7, c = (item >> 2) & 31, g = item & 3; const size_t r0 = (size_t)b * 4096 + (size_t)c * 128;
    bf16_t* proj = (bf16_t*)(P.ws + WS_PROJ);
    const float* states = (const float*)(P.ws + WS_SSDST);
    bf16_t* Cs = (bf16_t*)lds; bf16_t* Bs = Cs + 128 * 72; bf16_t* Sin = Bs; bf16_t* XT4 = Bs + 128 * 72; bf16_t* Ms = XT4 + 256 * 136; float* DT = (float*)(Ms + 128 * 136); float* ACS = DT + 512;
    __syncthreads();
    ssd_stage_dt(P, layer, proj, r0, g, DT, ACS, tid);
    ssd_stage_conv<1>(P, layer, proj, r0, c == 0, g, DT, ACS, XT4, Bs, Cs, tid);
    __syncthreads();
    f32x4 CB[8];
#pragma unroll
    for (int st = 0; st < 8; ++st) { CB[st] = (f32x4){0.f, 0.f, 0.f, 0.f};
        if (st <= w) {
#pragma unroll
            for (int ks = 0; ks < 2; ++ks) { const bf16x8 a = *(const bf16x8*)(Cs + (16 * w + fr) * 72 + ks * 32 + fq * 8), bv = *(const bf16x8*)(Bs + (16 * st + fr) * 72 + ks * 32 + fq * 8);
                CB[st] = __builtin_amdgcn_mfma_f32_16x16x32_bf16(a, bv, CB[st], 0, 0, 0); } } }
    float ssq[4] = {0.f, 0.f, 0.f, 0.f};
    const int nks = (w >> 1) + 1;
    bf16_t* zrow[4];
#pragma unroll
    for (int j = 0; j < 4; ++j) zrow[j] = proj + (r0 + 16 * w + fq * 4 + j) * LDP + C_Z + g * 256 + fr;
    f32x4 sna, snc;
    { const float* sp = states + ((size_t)((b * 32 + c) * 16 + g * 4)) * 4096 + (tid >> 3) * 64 + (tid & 7) * 8; sna = *(const f32x4*)sp; snc = *(const f32x4*)(sp + 4); }
    unsigned yg[4][4][2];
#pragma unroll
    for (int hh = 0; hh < 4; ++hh) {
        const int hd = g * 4 + hh;
        __syncthreads();
        { const int p = tid >> 3, n0 = (tid & 7) * 8;
          u32x4 pk; pk[0] = pk2(sna[0], sna[1]); pk[1] = pk2(sna[2], sna[3]); pk[2] = pk2(snc[0], snc[1]); pk[3] = pk2(snc[2], snc[3]);
          *(u32x4*)(Sin + p * 72 + n0) = pk;
          if (hh < 3) { const float* sp = states + ((size_t)((b * 32 + c) * 16 + hd + 1)) * 4096 + p * 64 + n0; sna = *(const f32x4*)sp; snc = *(const f32x4*)(sp + 4); } }
        float acs_t[4];
#pragma unroll
        for (int j = 0; j < 4; ++j) acs_t[j] = ACS[hh * 128 + 16 * w + fq * 4 + j];
#pragma unroll
        for (int st = 0; st < 8; ++st) { if (st <= (w | 1)) { const float acs_s = ACS[hh * 128 + 16 * st + fr];
#pragma unroll
            for (int j = 0; j < 4; ++j) { const int t = 16 * w + fq * 4 + j, sx = 16 * st + fr; const float v = (st <= w && sx <= t) ? CB[st][j] * __expf(acs_t[j] - acs_s) : 0.f; Ms[t * 136 + sx] = f2bf(v); } } }
        __syncthreads();
        bf16_t zv[4][4];
#pragma unroll
        for (int j = 0; j < 4; ++j)
#pragma unroll
            for (int pt = 0; pt < 4; ++pt) zv[j][pt] = *(zrow[j] + hh * 64 + pt * 16);
        f32x4 yd[4], yo[4];
#pragma unroll
        for (int pt = 0; pt < 4; ++pt) { yd[pt] = (f32x4){0.f, 0.f, 0.f, 0.f}; yo[pt] = (f32x4){0.f, 0.f, 0.f, 0.f}; }
        for (int ks = 0; ks < nks; ++ks) { const bf16x8 a = *(const bf16x8*)(Ms + (16 * w + fr) * 136 + ks * 32 + fq * 8);
#pragma unroll
            for (int pt = 0; pt < 4; ++pt) { const bf16x8 bv = *(const bf16x8*)(XT4 + xt_idx(hh * 64 + pt * 16 + fr, ks * 32 + fq * 8)); yd[pt] = __builtin_amdgcn_mfma_f32_16x16x32_bf16(a, bv, yd[pt], 0, 0, 0); } }
#pragma unroll
        for (int ks = 0; ks < 2; ++ks) { const bf16x8 a = *(const bf16x8*)(Cs + (16 * w + fr) * 72 + ks * 32 + fq * 8);
#pragma unroll
            for (int pt = 0; pt < 4; ++pt) { const bf16x8 bv = *(const bf16x8*)(Sin + (pt * 16 + fr) * 72 + ks * 32 + fq * 8); yo[pt] = __builtin_amdgcn_mfma_f32_16x16x32_bf16(a, bv, yo[pt], 0, 0, 0); } }
        const float Dh = P.in[18][layer * 16 + hd];
#pragma unroll
        for (int pt = 0; pt < 4; ++pt) { const int p = pt * 16 + fr; float yy[4];
#pragma unroll
            for (int j = 0; j < 4; ++j) { const int t = 16 * w + fq * 4 + j; const float et = __expf(acs_t[j]), idt = 1.f / DT[hh * 128 + t];
                const float x = bf2f(XT4[xt_idx(hh * 64 + p, t)]) * idt;
                float y = yd[pt][j] + et * yo[pt][j] + Dh * x; y *= silu_fast(bf2f(zv[j][pt])); ssq[j] += y * y; yy[j] = y; }
            yg[hh][pt][0] = pk2(yy[0], yy[1]); yg[hh][pt][1] = pk2(yy[2], yy[3]); }
    }
    const float* ng = P.in[19] + layer * 1024 + g * 256 + fr;
#pragma unroll
    for (int j = 0; j < 4; ++j) { float v = ssq[j];
#pragma unroll
        for (int o = 8; o > 0; o >>= 1) v += shx(v, o, lane);
        ssq[j] = rsqrtf(v * (1.f / 256.f) + EPSF); }
#pragma unroll
    for (int hh = 0; hh < 4; ++hh)
#pragma unroll
        for (int pt = 0; pt < 4; ++pt) { const float gv = ng[(hh * 4 + pt) * 16];
#pragma unroll
            for (int j = 0; j < 4; ++j) { const float yv = (j & 1) ? bfhi(yg[hh][pt][j >> 1]) : bflo(yg[hh][pt][j >> 1]); if (!dry) *(zrow[j] + (hh * 4 + pt) * 16) = f2bf(yv * ssq[j] * gv); } }
}
__device__ __forceinline__ void phase_ssd_scan(const Params& P, int layer) {
    float* states = (float*)(P.ws + WS_SSDST); const float* decs = (const float*)(P.ws + WS_SSDDEC);
    for (int e = blockIdx.x * 512 + otid(); e < 4 * 16 * 4096; e += gridDim.x * 512) {
        const int b = e >> 16, hd = (e >> 12) & 15, pn = e & 4095; float carry = 0.f;
        float st[32], dc[32];
#pragma unroll
        for (int c = 0; c < 32; ++c) { st[c] = states[((size_t)((b * 32 + c) * 16 + hd)) * 4096 + pn]; dc[c] = decs[(b * 32 + c) * 16 + hd]; }
#pragma unroll
        for (int c = 0; c < 32; ++c) { states[((size_t)((b * 32 + c) * 16 + hd)) * 4096 + pn] = carry; carry = carry * dc[c] + st[c]; }
        P.out[O_PSSM + ((size_t)((layer * 4 + b) * 16 + hd)) * 4096 + pn] = carry;
    }
}

__device__ __forceinline__ void attn_prompt_item(const Params& P, int layer, int item, unsigned char* lds, bool dry = false) {
    const int tid = otid(), w = tid >> 6, lane = tid & 63, fr = lane & 15, fq = lane >> 4;
    const int b = item >> 7, nb = (item >> 2) & 31, kvh = item & 3;
    bf16_t* proj = (bf16_t*)(P.ws + WS_PROJ);
    bf16_t* Ks = (bf16_t*)lds;
    bf16_t* Vt = Ks + 256 * 72;
    bf16_t* Pw = Vt + 64 * 280 + w * 16 * 168;
    const long rowK0 = (long)b * 4096 + (long)(nb - 1) * 128;
    const bf16_t* qbase = proj + ((size_t)b * 4096 + (size_t)nb * 128 + w * 16 + fr) * LDP + C_Q + kvh * 256 + fq * 8;
    bf16x8 qa[2], qn[2];
#pragma unroll
    for (int ks = 0; ks < 2; ++ks) { qa[ks] = *(const bf16x8*)(qbase + ks * 32); qn[ks] = qa[ks]; }
    __syncthreads();
#pragma unroll
    for (int idx = tid; idx < 2048; idx += 512) { const int kj = idx >> 3, seg = idx & 7; u32x4 v = (u32x4){0u, 0u, 0u, 0u};
        if (nb > 0 || kj >= 128) v = *(const u32x4*)(proj + (size_t)(rowK0 + kj) * LDP + C_K + kvh * 64 + seg * 8);
        *(u32x4*)(Ks + kj * 72 + seg * 8) = v; }
#pragma unroll
    for (int idx = tid; idx < 2048; idx += 512) { const int seg = idx >> 8, kj = idx & 255; u32x4 v = (u32x4){0u, 0u, 0u, 0u};
        if (nb > 0 || kj >= 128) v = *(const u32x4*)(proj + (size_t)(rowK0 + kj) * LDP + C_V + kvh * 64 + seg * 8);
#pragma unroll
        for (int i = 0; i < 8; ++i) Vt[(seg * 8 + i) * 280 + kj] = (bf16_t)((v[i >> 1] >> ((i & 1) * 16)) & 0xffffu); }
    for (int idx = tid; idx < 64 * 24; idx += 512) { const int d = idx / 24, cc = 256 + idx % 24; Vt[d * 280 + cc] = 0; }
    for (int i = lane; i < 384; i += 64) Pw[(i / 24) * 168 + 144 + i % 24] = 0;
    __syncthreads();
    const int q0 = w * 16;
    const size_t qrow0 = (size_t)b * 4096 + (size_t)nb * 128 + q0;
    for (int gi = 0; gi < 4; ++gi) {
        const int hq = kvh * 4 + gi;
        const float slope = exp2f(-0.5f * (float)(hq + 1));
        const float sink = P.in[21][layer * 16 + hq];
        if (gi < 3) {
#pragma unroll
            for (int ks = 0; ks < 2; ++ks) qn[ks] = *(const bf16x8*)(qbase + (gi + 1) * 64 + ks * 32); }
        f32x4 S[9];
#pragma unroll
        for (int nt = 0; nt < 9; ++nt) { f32x4 a = (f32x4){0.f, 0.f, 0.f, 0.f}; const bf16_t* kp = Ks + (q0 + nt * 16 + fr) * 72 + fq * 8;
#pragma unroll
            for (int ks = 0; ks < 2; ++ks) { const bf16x8 kb = *(const bf16x8*)(kp + ks * 32); a = __builtin_amdgcn_mfma_f32_16x16x32_bf16(qa[ks], kb, a, 0, 0, 0); }
            S[nt] = a; }
        float mx[4] = {-INFINITY, -INFINITY, -INFINITY, -INFINITY};
#pragma unroll
        for (int nt = 0; nt < 9; ++nt)
#pragma unroll
            for (int j = 0; j < 4; ++j) { const int dist = (fq * 4 + j) - (nt * 16 + fr) + 128; const bool valid = dist >= 0 && dist <= 128 && (nb > 0 || (q0 + nt * 16 + fr) >= 128);
                const float s = valid ? S[nt][j] * 0.125f - slope * (float)dist : -INFINITY; S[nt][j] = s; mx[j] = fmaxf(mx[j], s); }
        float inv[4];
#pragma unroll
        for (int j = 0; j < 4; ++j) { float m = mx[j];
#pragma unroll
            for (int o = 8; o > 0; o >>= 1) m = fmaxf(m, shx(m, o, lane));
            m = fmaxf(m, sink); float sum = 0.f;
#pragma unroll
            for (int nt = 0; nt < 9; ++nt) { const float p = __expf(S[nt][j] - m); S[nt][j] = p; sum += p; }
#pragma unroll
            for (int o = 8; o > 0; o >>= 1) sum += shx(sum, o, lane);
            inv[j] = 1.f / (sum + __expf(sink - m)); }
#pragma unroll
        for (int nt = 0; nt < 9; ++nt)
#pragma unroll
            for (int j = 0; j < 4; ++j) Pw[(fq * 4 + j) * 168 + nt * 16 + fr] = f2bf(S[nt][j]);
        asm volatile("s_waitcnt lgkmcnt(0)" ::: "memory"); __builtin_amdgcn_wave_barrier();
        f32x4 O[4];
#pragma unroll
        for (int dt = 0; dt < 4; ++dt) O[dt] = (f32x4){0.f, 0.f, 0.f, 0.f};
#pragma unroll
        for (int ks = 0; ks < 5; ++ks) { const bf16x8 pa = *(const bf16x8*)(Pw + fr * 168 + ks * 32 + fq * 8);
#pragma unroll
            for (int dt = 0; dt < 4; ++dt) { const bf16x8 vb = *(const bf16x8*)(Vt + (dt * 16 + fr) * 280 + q0 + ks * 32 + fq * 8); O[dt] = __builtin_amdgcn_mfma_f32_16x16x32_bf16(pa, vb, O[dt], 0, 0, 0); } }
        asm volatile("s_waitcnt lgkmcnt(0)" ::: "memory"); __builtin_amdgcn_wave_barrier();
#pragma unroll
        for (int dt = 0; dt < 4; ++dt)
#pragma unroll
            for (int j = 0; j < 4; ++j) { if (!dry) proj[(qrow0 + fq * 4 + j) * LDP + C_Q + hq * 64 + dt * 16 + fr] = f2bf(O[dt][j] * inv[j]); }
        qa[0] = qn[0]; qa[1] = qn[1];
    }
    if (nb == 31) {
        for (int idx = tid; idx < 128 * 64; idx += 512) { const int t = idx >> 6, d = idx & 63; const size_t row = (size_t)b * 4096 + 3968 + t;
            const size_t o = ((size_t)((layer * 4 + b) * 128 + t)) * 256 + kvh * 64 + d;
            P.out[O_PK + o] = bf2f(proj[row * LDP + C_K + kvh * 64 + d]); P.out[O_PV + o] = bf2f(proj[row * LDP + C_V + kvh * 64 + d]); }
    }
}
__device__ __forceinline__ void attn_sample_item(const Params& P, int layer, int item, float* L, bool dry = false) {
    const int tid = otid(), w = tid >> 6, lane = tid & 63;
    const int sb = item >> 2, kvh = item & 3, r0 = NPR + sb * 4;
    bf16_t* proj = (bf16_t*)(P.ws + WS_PROJ);
    float* Kf = L; float* Vf = Kf + 132 * 65; float* Q = Vf + 132 * 65; float* Sc = Q + 16 * 64;
    const float* ck = P.in[7] + ((size_t)(layer * 128 + sb)) * 128 * 256; const float* cv = P.in[8] + ((size_t)(layer * 128 + sb)) * 128 * 256;
    __syncthreads();
    {
        f32x4 kq[4], vq[4];
#pragma unroll
        for (int i = 0; i < 4; ++i) { const int idx = tid + i * 512, j = idx >> 4, d4 = (idx & 15) * 4; kq[i] = *(const f32x4*)(ck + (size_t)j * 256 + kvh * 64 + d4); vq[i] = *(const f32x4*)(cv + (size_t)j * 256 + kvh * 64 + d4); }
#pragma unroll
        for (int i = 0; i < 4; ++i) { const int idx = tid + i * 512, j = idx >> 4, d4 = (idx & 15) * 4;
#pragma unroll
            for (int e = 0; e < 4; ++e) { Kf[j * 65 + d4 + e] = kq[i][e]; Vf[j * 65 + d4 + e] = vq[i][e]; }
            if (j >= 4) { const size_t o = ((size_t)((layer * 128 + sb) * 128 + (j - 4))) * 256 + kvh * 64 + d4; *(f32x4*)(P.out + O_SK + o) = kq[i]; *(f32x4*)(P.out + O_SV + o) = vq[i]; } }
        if (tid < 256) { const int j = 128 + (tid >> 6), d = tid & 63; const float kv = bf2f(proj[(size_t)(r0 + j - 128) * LDP + C_K + kvh * 64 + d]), vv = bf2f(proj[(size_t)(r0 + j - 128) * LDP + C_V + kvh * 64 + d]);
            Kf[j * 65 + d] = kv; Vf[j * 65 + d] = vv; const size_t o = ((size_t)((layer * 128 + sb) * 128 + (j - 4))) * 256 + kvh * 64 + d; P.out[O_SK + o] = kv; P.out[O_SV + o] = vv; }
    }
    for (int idx = tid; idx < 1024; idx += 512) { const int qr = idx >> 6, d = idx & 63; Q[idx] = bf2f(proj[(size_t)(r0 + (qr >> 2)) * LDP + C_Q + (kvh * 4 + (qr & 3)) * 64 + d]); }
    __syncthreads();
    for (int idx = tid; idx < 16 * 132; idx += 512) { const int qr = idx / 132, j = idx - qr * 132; const int dist = 128 + (qr >> 2) - j; float s = -INFINITY;
        if (dist >= 0 && dist <= 128) { float a = 0.f;
#pragma unroll 8
            for (int d = 0; d < 64; ++d) a += Q[qr * 64 + d] * Kf[j * 65 + d];
            s = a * 0.125f - exp2f(-0.5f * (float)(kvh * 4 + (qr & 3) + 1)) * (float)dist; }
        Sc[qr * 136 + j] = s; }
    __syncthreads();
    for (int rr = 0; rr < 2; ++rr) { const int qr = w * 2 + rr; const float sink = P.in[21][layer * 16 + kvh * 4 + (qr & 3)];
        float v0 = Sc[qr * 136 + lane], v1 = Sc[qr * 136 + 64 + lane], v2 = lane < 4 ? Sc[qr * 136 + 128 + lane] : -INFINITY;
        float m = fmaxf(fmaxf(v0, v1), v2);
#pragma unroll
        for (int o = 32; o > 0; o >>= 1) m = fmaxf(m, shx(m, o, lane));
        m = fmaxf(m, sink);
        v0 = __expf(v0 - m); v1 = __expf(v1 - m); v2 = __expf(v2 - m);
        const float sum = wave_sum(v0 + v1 + v2, lane); const float inv = 1.f / (sum + __expf(sink - m));
        Sc[qr * 136 + lane] = v0 * inv; Sc[qr * 136 + 64 + lane] = v1 * inv; if (lane < 4) Sc[qr * 136 + 128 + lane] = v2 * inv; }
    __syncthreads();
    for (int idx = tid; idx < 1024; idx += 512) { const int qr = idx >> 6, d = idx & 63; float o = 0.f;
        for (int j = 0; j < 132; ++j) o += Sc[qr * 136 + j] * Vf[j * 65 + d];
        if (!dry) proj[(size_t)(r0 + (qr >> 2)) * LDP + C_Q + (kvh * 4 + (qr & 3)) * 64 + d] = f2bf(o); }
}

__device__ __forceinline__ void gmlp_prompt_item(const Params& P, int layer, int item, unsigned char* lds, bool dry = false) {
    const int tid = otid(), w = tid >> 6, lane = tid & 63, fr = lane & 15, fq = lane >> 4;
    const int b = item >> 8, chn = (item >> 3) & 31, g = item & 7;
    const size_t r0 = (size_t)b * 4096 + (size_t)chn * 128;
    bf16_t* proj = (bf16_t*)(P.ws + WS_PROJ);
    bf16_t* VT = (bf16_t*)lds; bf16_t* Wt = VT + 128 * 136; float* MU = (float*)(Wt + 128 * 136); float* RS = MU + 128;
    __syncthreads();
#pragma unroll
    for (int hb = 0; hb < 2; ++hb) { u32x4 av[8], cv8[8];
#pragma unroll
        for (int i = 0; i < 8; ++i) { const bf16_t* vp = proj + (r0 + w * 16 + hb * 8 + i) * LDP + C_UV + 1024 + lane * 16; av[i] = *(const u32x4*)vp; cv8[i] = *(const u32x4*)(vp + 8); }
#pragma unroll
        for (int i = 0; i < 8; ++i) { const int t = w * 16 + hb * 8 + i; float s = 0.f, sq = 0.f;
#pragma unroll
            for (int k = 0; k < 4; ++k) { float x0 = bflo(av[i][k]), x1 = bfhi(av[i][k]), x2 = bflo(cv8[i][k]), x3 = bfhi(cv8[i][k]); s += x0 + x1 + x2 + x3; sq += x0 * x0 + x1 * x1 + x2 * x2 + x3 * x3; }
            s = wave_sum(s, lane); sq = wave_sum(sq, lane);
            if (lane == 0) { const float mean = s * (1.f / 1024.f); const float var = fmaxf(sq * (1.f / 1024.f) - mean * mean, 0.f); MU[t] = mean; RS[t] = rsqrtf(var + EPSF); } } }
    const float* Wg = P.in[24] + ((size_t)(layer * 8 + g)) * 16384;
#pragma unroll
    for (int idx = tid; idx < 4096; idx += 512) { const int t = idx >> 5, s4 = (idx & 31) * 4; const f32x4 wv = *(const f32x4*)(Wg + t * 128 + s4);
        u32x2 o; o[0] = pk2(s4 <= t ? wv[0] : 0.f, s4 + 1 <= t ? wv[1] : 0.f); o[1] = pk2(s4 + 2 <= t ? wv[2] : 0.f, s4 + 3 <= t ? wv[3] : 0.f);
        *(u32x2*)(Wt + t * 136 + s4) = o; }
    __syncthreads();
    const float* lg = P.in[22] + layer * 1024 + g * 128; const float* lb = P.in[23] + layer * 1024 + g * 128;
#pragma unroll
    for (int idx = tid; idx < 2048; idx += 512) { const int s = idx & 127, fs = idx >> 7; const u32x4 v = *(const u32x4*)(proj + (r0 + s) * LDP + C_UV + 1024 + g * 128 + fs * 8);
        const float mu = MU[s], rs = RS[s];
#pragma unroll
        for (int i = 0; i < 8; ++i) { const int f = fs * 8 + i; const float x = (i & 1) ? bfhi(v[i >> 1]) : bflo(v[i >> 1]); VT[f * 136 + s] = f2bf((x - mu) * rs * lg[f] + lb[f]); } }
    __syncthreads();
    f32x4 acc[8];
#pragma unroll
    for (int ft = 0; ft < 8; ++ft) acc[ft] = (f32x4){0.f, 0.f, 0.f, 0.f};
    const int nks = (16 * w + 15) / 32 + 1;
    for (int ks = 0; ks < nks; ++ks) { const bf16x8 a = *(const bf16x8*)(Wt + (w * 16 + fr) * 136 + ks * 32 + fq * 8);
#pragma unroll
        for (int ft = 0; ft < 8; ++ft) { const bf16x8 bb = *(const bf16x8*)(VT + (ft * 16 + fr) * 136 + ks * 32 + fq * 8); acc[ft] = __builtin_amdgcn_mfma_f32_16x16x32_bf16(a, bb, acc[ft], 0, 0, 0); } }
    bf16_t uv[4][8]; float bsv[4];
#pragma unroll
    for (int j = 0; j < 4; ++j) { const int t = w * 16 + fq * 4 + j; bsv[j] = P.in[25][(layer * 8 + g) * 128 + t];
#pragma unroll
        for (int ft = 0; ft < 8; ++ft) uv[j][ft] = proj[(r0 + t) * LDP + C_UV + g * 128 + ft * 16 + fr]; }
#pragma unroll
    for (int j = 0; j < 4; ++j) { const int t = w * 16 + fq * 4 + j;
#pragma unroll
        for (int ft = 0; ft < 8; ++ft) { if (!dry) proj[(r0 + t) * LDP + C_UV + g * 128 + ft * 16 + fr] = f2bf(gelu_fast(bf2f(uv[j][ft])) * (acc[ft][j] + bsv[j])); } }
}
__device__ __forceinline__ void gmlp_sample_item(const Params& P, int layer, int sb, float* L) {
    const int tid = otid(), w = tid >> 6, lane = tid & 63; const size_t r0 = NPR + sb * 4;
    bf16_t* proj = (bf16_t*)(P.ws + WS_PROJ);
    float* Vn = L; float* MU = Vn + 4096; float* RS = MU + 4;
    __syncthreads();
    if (w < 4) { const bf16_t* vp = proj + (r0 + w) * LDP + C_UV + 1024 + lane * 16; const u32x4 a = *(const u32x4*)vp, c = *(const u32x4*)(vp + 8); float s = 0.f, sq = 0.f;
#pragma unroll
        for (int k = 0; k < 4; ++k) { float x0 = bflo(a[k]), x1 = bfhi(a[k]), x2 = bflo(c[k]), x3 = bfhi(c[k]); s += x0 + x1 + x2 + x3; sq += x0 * x0 + x1 * x1 + x2 * x2 + x3 * x3; }
        s = wave_sum(s, lane); sq = wave_sum(sq, lane);
        if (lane == 0) { const float mean = s * (1.f / 1024.f); const float var = fmaxf(sq * (1.f / 1024.f) - mean * mean, 0.f); MU[w] = mean; RS[w] = rsqrtf(var + EPSF); } }
    __syncthreads();
    for (int idx = tid; idx < 4096; idx += 512) { const int t = idx >> 10, c = idx & 1023;
        const float x = bf2f(proj[(r0 + t) * LDP + C_UV + 1024 + c]); const float vn = (x - MU[t]) * RS[t] * P.in[22][layer * 1024 + c] + P.in[23][layer * 1024 + c];
        Vn[idx] = vn; P.out[O_SGMV + ((size_t)((layer * 128 + sb) * 4 + t)) * 1024 + c] = vn; }
    __syncthreads();
    for (int idx = tid; idx < 4096; idx += 512) { const int t = idx >> 10, c = idx & 1023, g = c >> 7;
        const float* Wg = P.in[24] + ((size_t)(layer * 8 + g)) * 16384 + t * 128; float m = P.in[25][(layer * 8 + g) * 128 + t];
        for (int s = 0; s <= t; ++s) m += Wg[s] * Vn[s * 1024 + c];
        bf16_t* ap = proj + (r0 + t) * LDP + C_UV + c; *ap = f2bf(gelu_fast(bf2f(*ap)) * m); }
}

template <int R>
__device__ __forceinline__ void shortconv_rows(const Params& P, int layer, int r0, int tid, bool dry) {
    bf16_t* proj = (bf16_t*)(P.ws + WS_PROJ);
    const float* cw = P.in[20] + layer * 3 * 1024;
    const int j = tid * 2; const int ss = seq_start(r0); const bool havePrev = (r0 - 2 >= ss);
    unsigned cg[R + 2], xs[R + 2], bg[R];
#pragma unroll
    for (int k = 0; k < R + 2; ++k) { cg[k] = 0u; xs[k] = 0u;
        if (k >= 2 || havePrev) { const bf16_t* rp = proj + (size_t)(r0 - 2 + k) * LDP + C_BCX + j; cg[k] = *(const unsigned*)(rp + 1024); xs[k] = *(const unsigned*)(rp + 2048); } }
#pragma unroll
    for (int k = 0; k < R; ++k) bg[k] = *(const unsigned*)(proj + (size_t)(r0 + k) * LDP + C_BCX + j);
    float pr0[R + 2], pr1[R + 2];
#pragma unroll
    for (int k = 0; k < R + 2; ++k) { pr0[k] = bflo(cg[k]) * bflo(xs[k]); pr1[k] = bfhi(cg[k]) * bfhi(xs[k]); }
    if (!havePrev && r0 >= NPR) { const float* st = P.in[6] + ((size_t)(layer * 128 + ((r0 - NPR) >> 2)) * 2) * 1024 + j; pr0[0] = st[0]; pr1[0] = st[1]; pr0[1] = st[1024]; pr1[1] = st[1025]; }
    const float w0a = cw[j], w0b = cw[j + 1], w1a = cw[1024 + j], w1b = cw[1025 + j], w2a = cw[2048 + j], w2b = cw[2049 + j];
#pragma unroll
    for (int k = 0; k < R; ++k) { const float y0 = w0a * pr0[k] + w1a * pr0[k + 1] + w2a * pr0[k + 2], y1 = w0b * pr1[k] + w1b * pr1[k + 1] + w2b * pr1[k + 2];
        if (!dry) *(unsigned*)(proj + (size_t)(r0 + k) * LDP + C_BCX + j) = pk2(bflo(bg[k]) * y0, bfhi(bg[k]) * y1);
        const int r = r0 + k;
        if (r < NPR) { const int l = r & 4095; if (l >= 4094) { float* o = P.out + O_PSCC + ((size_t)((layer * 4 + (r >> 12)) * 2 + (l - 4094))) * 1024 + j; o[0] = pr0[k + 2]; o[1] = pr1[k + 2]; } }
        else { const int l = (r - NPR) & 3; if (l >= 2) { float* o = P.out + O_SSCC + ((size_t)((layer * 128 + ((r - NPR) >> 2)) * 2 + (l - 2))) * 1024 + j; o[0] = pr0[k + 2]; o[1] = pr1[k + 2]; } }
    }
}
__device__ __forceinline__ void shortconv_item(const Params& P, int layer, int item, bool dry = false) {
    const int tid = otid();
    if (item < 1024) shortconv_rows<16>(P, layer, item * 16, tid, dry); else shortconv_rows<4>(P, layer, NPR + (item - 1024) * 4, tid, dry);
}
__device__ __forceinline__ void ssdconv_state_item(const Params& P, int layer, int sq) {
    const bf16_t* proj = (const bf16_t*)(P.ws + WS_PROJ);
    const size_t rbase = sq < 4 ? (size_t)sq * 4096 + 4093 : (size_t)NPR + (size_t)(sq - 4) * 4 + 1;
    float* o = sq < 4 ? P.out + O_PSSDC + (size_t)(layer * 4 + sq) * 3 * 1536 : P.out + O_SSSDC + (size_t)(layer * 128 + (sq - 4)) * 3 * 1536;
    const int tid = otid(); bf16_t v[9];
#pragma unroll
    for (int i = 0; i < 9; ++i) { const int e = tid + i * 512, t = e / 1536, c = e - t * 1536; v[i] = proj[(rbase + t) * LDP + C_XBC + c]; }
#pragma unroll
    for (int i = 0; i < 9; ++i) o[tid + i * 512] = bf2f(v[i]);
}

template <int R>
__device__ __forceinline__ void ffn_act_unit(const Params& P, int layer, int r0, int oc) {
    const bf16_t* up = (const bf16_t*)(P.ws + WS_PROJ); bf16_t* act = (bf16_t*)(P.ws + WS_PROJ + UP_BYTES);
    const float* cw = P.in[30] + (size_t)layer * 3 * 5632; const float* cb = P.in[31] + (size_t)layer * 5632;
    const int j0 = oc * 8;
    float wa[3][8], wg[3][8], ba[8], bgv[8], pa[2][8], pg[2][8];
#pragma unroll
    for (int k = 0; k < 3; ++k) { const f32x4 a0 = *(const f32x4*)(cw + k * 5632 + j0), a1 = *(const f32x4*)(cw + k * 5632 + j0 + 4), g0 = *(const f32x4*)(cw + k * 5632 + 2816 + j0), g1 = *(const f32x4*)(cw + k * 5632 + 2816 + j0 + 4);
#pragma unroll
        for (int i = 0; i < 4; ++i) { wa[k][i] = a0[i]; wa[k][4 + i] = a1[i]; wg[k][i] = g0[i]; wg[k][4 + i] = g1[i]; } }
    { const f32x4 a0 = *(const f32x4*)(cb + j0), a1 = *(const f32x4*)(cb + j0 + 4), g0 = *(const f32x4*)(cb + 2816 + j0), g1 = *(const f32x4*)(cb + 2816 + j0 + 4);
#pragma unroll
      for (int i = 0; i < 4; ++i) { ba[i] = a0[i]; ba[4 + i] = a1[i]; bgv[i] = g0[i]; bgv[4 + i] = g1[i]; } }
    const int ss = seq_start(r0); const bool havePrev = (r0 - 2 >= ss);
#pragma unroll
    for (int k = 0; k < 2; ++k) {
        if (havePrev) { const u32x4 ua = *(const u32x4*)(up + (size_t)(r0 - 2 + k) * 5632 + j0), ug = *(const u32x4*)(up + (size_t)(r0 - 2 + k) * 5632 + 2816 + j0);
#pragma unroll
            for (int i = 0; i < 4; ++i) { pa[k][2 * i] = bflo(ua[i]); pa[k][2 * i + 1] = bfhi(ua[i]); pg[k][2 * i] = bflo(ug[i]); pg[k][2 * i + 1] = bfhi(ug[i]); } }
        else if (r0 >= NPR) { const float* pp = P.in[9] + ((size_t)(layer * 128 + ((r0 - NPR) >> 2)) * 2 + k) * 5632;
#pragma unroll
            for (int i = 0; i < 8; ++i) { pa[k][i] = pp[j0 + i]; pg[k][i] = pp[2816 + j0 + i]; } }
        else {
#pragma unroll
            for (int i = 0; i < 8; ++i) { pa[k][i] = 0.f; pg[k][i] = 0.f; } } }
#pragma unroll
    for (int kb = 0; kb < R; kb += 4) { u32x4 ua[4], ug[4];
#pragma unroll
        for (int q = 0; q < 4; ++q) { ua[q] = *(const u32x4*)(up + (size_t)(r0 + kb + q) * 5632 + j0); ug[q] = *(const u32x4*)(up + (size_t)(r0 + kb + q) * 5632 + 2816 + j0); }
#pragma unroll
        for (int q = 0; q < 4; ++q) { const int r = r0 + kb + q; float ca[8], cgv[8], o[8];
#pragma unroll
            for (int i = 0; i < 4; ++i) { ca[2 * i] = bflo(ua[q][i]); ca[2 * i + 1] = bfhi(ua[q][i]); cgv[2 * i] = bflo(ug[q][i]); cgv[2 * i + 1] = bfhi(ug[q][i]); }
#pragma unroll
            for (int i = 0; i < 8; ++i) { const float a = ba[i] + wa[0][i] * pa[0][i] + wa[1][i] * pa[1][i] + wa[2][i] * ca[i], g = bgv[i] + wg[0][i] * pg[0][i] + wg[1][i] * pg[1][i] + wg[2][i] * cgv[i];
                o[i] = silu_fast(a) * g; pa[0][i] = pa[1][i]; pa[1][i] = ca[i]; pg[0][i] = pg[1][i]; pg[1][i] = cgv[i]; }
            u32x4 ov; ov[0] = pk2(o[0], o[1]); ov[1] = pk2(o[2], o[3]); ov[2] = pk2(o[4], o[5]); ov[3] = pk2(o[6], o[7]);
            *(u32x4*)(act + (size_t)r * 2816 + j0) = ov;
            float* so = nullptr;
            if (r < NPR) { const int l = r & 4095; if (l >= 4094) so = P.out + O_PFFC + ((size_t)((layer * 4 + (r >> 12)) * 2 + (l - 4094))) * 5632; }
            else { const int l = (r - NPR) & 3; if (l >= 2) so = P.out + O_SFFC + ((size_t)((layer * 128 + ((r - NPR) >> 2)) * 2 + (l - 2))) * 5632; }
            if (so) {
#pragma unroll
                for (int i = 0; i < 8; ++i) { so[j0 + i] = ca[i]; so[2816 + j0 + i] = cgv[i]; } }
        } }
}
__device__ __forceinline__ void phase_ffn_act(const Params& P, int layer) {
    constexpr int NU_P = 2048 * 352, NU_S = 128 * 352;
    for (int u = blockIdx.x * 512 + otid(); u < NU_P + NU_S; u += gridDim.x * 512) {
        if (u < NU_P) { const int rb = u / 352, oc = u - rb * 352; ffn_act_unit<8>(P, layer, rb * 8, oc); }
        else { const int v = u - NU_P, sq = v / 352, oc = v - sq * 352; ffn_act_unit<4>(P, layer, NPR + sq * 4, oc); }
    }
}

__device__ __forceinline__ void sgemm_partial(const bf16_t* A, int lda, const bf16_t* Bt, int ldb, int K, int row0, int col0, float* red, int tid) {
    const int w = tid >> 6, lane = tid & 63, fr = lane & 15, fq = lane >> 4;
    const int kw = K >> 3, k0 = w * kw;
    f32x4 acc[2][4];
#pragma unroll
    for (int mt = 0; mt < 2; ++mt)
#pragma unroll
        for (int nt = 0; nt < 4; ++nt) acc[mt][nt] = (f32x4){0.f, 0.f, 0.f, 0.f};
    const bf16_t* ap = A + (size_t)(row0 + fr) * lda + k0 + fq * 8;
    const bf16_t* bp = Bt + (size_t)(col0 + fr) * ldb + k0 + fq * 8;
    const int nks = kw >> 5;
#pragma unroll 4
    for (int ks = 0; ks < nks; ++ks) { bf16x8 a[2], b[4];
#pragma unroll
        for (int mt = 0; mt < 2; ++mt) a[mt] = *(const bf16x8*)(ap + (size_t)mt * 16 * lda + ks * 32);
#pragma unroll
        for (int nt = 0; nt < 4; ++nt) b[nt] = *(const bf16x8*)(bp + (size_t)nt * 16 * ldb + ks * 32);
#pragma unroll
        for (int mt = 0; mt < 2; ++mt)
#pragma unroll
            for (int nt = 0; nt < 4; ++nt) acc[mt][nt] = __builtin_amdgcn_mfma_f32_16x16x32_bf16(a[mt], b[nt], acc[mt][nt], 0, 0, 0); }
#pragma unroll
    for (int mt = 0; mt < 2; ++mt)
#pragma unroll
        for (int nt = 0; nt < 4; ++nt)
#pragma unroll
            for (int j = 0; j < 4; ++j) red[(w * 32 + mt * 16 + fq * 4 + j) * 64 + nt * 16 + fr] = acc[mt][nt][j];
}
__device__ __forceinline__ f32x4 sgemm_reduce(const float* red, int tid) {
    const int row = tid >> 4, c4 = (tid & 15) * 4; f32x4 sacc = (f32x4){0.f, 0.f, 0.f, 0.f};
#pragma unroll
    for (int w = 0; w < 8; ++w) sacc += *(const f32x4*)(red + (w * 32 + row) * 64 + c4);
    return sacc;
}
__device__ __forceinline__ void sg_load4(const bf16_t* ap, int lda, const bf16_t* bp, int ldb, bf16x8 (&a)[4][2], bf16x8 (&b)[4][4]) {
#pragma unroll
    for (int ks = 0; ks < 4; ++ks) {
#pragma unroll
        for (int mt = 0; mt < 2; ++mt) a[ks][mt] = *(const bf16x8*)(ap + (size_t)mt * 16 * lda + ks * 32);
#pragma unroll
        for (int nt = 0; nt < 4; ++nt) b[ks][nt] = *(const bf16x8*)(bp + (size_t)nt * 16 * ldb + ks * 32); }
}
__device__ __forceinline__ void sample_branch(const Params& P, int layer, float* red) {
    const int tid = otid(), w = tid >> 6, lane = tid & 63, fr = lane & 15, fq = lane >> 4;
    const bf16_t* proj = (const bf16_t*)(P.ws + WS_PROJ); bf16_t* hbuf = (bf16_t*)(P.ws + WS_H);
    for (int piece = blockIdx.x; piece < 256; piece += gridDim.x) {
        const int row0 = (piece >> 4) * 32, col0 = (piece & 15) * 64; const size_t r = NPR + row0 + (tid >> 4); const int c = col0 + (tid & 15) * 4;
        const bf16_t* abase = proj + (size_t)(NPR + row0 + fr) * LDP + w * 128 + fq * 8;
        const bf16_t* bbase = (const bf16_t*)(P.ws + WS_WBR) + (size_t)layer * 4 * 1048576 + (size_t)(col0 + fr) * 1024 + w * 128 + fq * 8;
        bf16x8 a[4][2], b[4][4];
        sg_load4(abase + C_Z, LDP, bbase, 1024, a, b);
        f32x4 sum = (f32x4){0.f, 0.f, 0.f, 0.f};
        for (int z = 0; z < 4; ++z) {
            f32x4 acc[2][4];
#pragma unroll
            for (int mt = 0; mt < 2; ++mt)
#pragma unroll
                for (int nt = 0; nt < 4; ++nt) acc[mt][nt] = (f32x4){0.f, 0.f, 0.f, 0.f};
#pragma unroll
            for (int ks = 0; ks < 4; ++ks)
#pragma unroll
                for (int mt = 0; mt < 2; ++mt)
#pragma unroll
                    for (int nt = 0; nt < 4; ++nt) acc[mt][nt] = __builtin_amdgcn_mfma_f32_16x16x32_bf16(a[ks][mt], b[ks][nt], acc[mt][nt], 0, 0, 0);
            if (z < 3) { const int ao = z == 0 ? C_BCX : (z == 1 ? C_Q : C_UV); sg_load4(abase + ao, LDP, bbase + (size_t)(z + 1) * 1048576, 1024, a, b); }
            const u32x2 gv = *(const u32x2*)(proj + r * LDP + C_GATE + z * 1024 + c);
            __syncthreads();
#pragma unroll
            for (int mt = 0; mt < 2; ++mt)
#pragma unroll
                for (int nt = 0; nt < 4; ++nt)
#pragma unroll
                    for (int j = 0; j < 4; ++j) red[(w * 32 + mt * 16 + fq * 4 + j) * 64 + nt * 16 + fr] = acc[mt][nt][j];
            __syncthreads();
            const f32x4 v = sgemm_reduce(red, tid);
            sum[0] += sigmoid_fast(bflo(gv[0])) * v[0]; sum[1] += sigmoid_fast(bfhi(gv[0])) * v[1]; sum[2] += sigmoid_fast(bflo(gv[1])) * v[2]; sum[3] += sigmoid_fast(bfhi(gv[1])) * v[3];
        }
        u32x2 o; o[0] = pk2(sum[0], sum[1]); o[1] = pk2(sum[2], sum[3]); *(u32x2*)(hbuf + r * 1024 + c) = o;
        __syncthreads();
    }
}
__device__ __forceinline__ void sample_resid(const Params& P, const bf16_t* A, int lda, const bf16_t* Bt, int K, const float* xin_s, float* xout, const float* ga, float* red) {
    const int tid = otid();
    for (int piece = blockIdx.x; piece < 256; piece += gridDim.x) {
        const int row0 = (piece >> 4) * 32, col0 = (piece & 15) * 64; const int rs = row0 + (tid >> 4), c = col0 + (tid & 15) * 4;
        __syncthreads();
        sgemm_partial(A, lda, Bt, K, K, row0, col0, red, tid);
        __syncthreads();
        const f32x4 v = sgemm_reduce(red, tid);
        const f32x4 xv = *(const f32x4*)(xin_s + (size_t)rs * 1024 + c), gv = *(const f32x4*)(ga + (size_t)(4 + (rs >> 2)) * 6144 + c);
        *(f32x4*)(xout + (size_t)(NPR + rs) * 1024 + c) = xv + gv * v;
    }
}

__device__ __forceinline__ void grid_bar(unsigned* ctr, unsigned& epoch) {
    asm volatile("s_waitcnt vmcnt(0) lgkmcnt(0)" ::: "memory");
    __syncthreads();
    epoch += 1;
    if (otid() == 0) {
        __builtin_amdgcn_fence(__ATOMIC_RELEASE, "agent");
        asm volatile("s_waitcnt vmcnt(0) lgkmcnt(0)" ::: "memory");
        __hip_atomic_fetch_add(ctr, 1u, __ATOMIC_RELAXED, __HIP_MEMORY_SCOPE_AGENT);
        const unsigned target = epoch * gridDim.x;
        while (__hip_atomic_load(ctr, __ATOMIC_RELAXED, __HIP_MEMORY_SCOPE_AGENT) < target) __builtin_amdgcn_s_sleep(1);
        __builtin_amdgcn_fence(__ATOMIC_ACQUIRE, "agent");
        asm volatile("s_waitcnt vmcnt(0) lgkmcnt(0)" ::: "memory");
    }
    __syncthreads();
}

#ifndef PHMASK
#define PHMASK 0xFFFFFFFF
#endif
#define EN(x) ((PHMASK >> (x)) & 1)
#ifndef DRYM
#define DRYM 0
#endif
#ifndef DBL
#define DBL 0
#endif
#define REP(x) (((DBL >> (x)) & 1) ? 2 : 1)
constexpr int PH_PER_LAYER = 11, N_PHASES = 2 + 4 * PH_PER_LAYER + 1;

__global__ void __launch_bounds__(512, 2) mega_fwd(Params PK) {
    extern __shared__ __attribute__((aligned(16))) unsigned char lds_raw[];
    cg::grid_group grid = cg::this_grid();
    LAS unsigned char* ldsl = (LAS unsigned char*)lds_raw;
    unsigned epoch = 0;
    for (int ph = PK.ph_lo; ph < PK.ph_hi; ++ph) {
        Params P = PK;
        { unsigned char* w_ = P.ws; asm volatile("" : "+s"(w_)); P.ws = w_; float* o_ = P.out; asm volatile("" : "+s"(o_)); P.out = o_; }
        unsigned* barctr = (unsigned*)(P.ws + WS_BAR);
        bf16_t* proj = (bf16_t*)(P.ws + WS_PROJ);
        bf16_t* hbuf = (bf16_t*)(P.ws + WS_H);
        float* xbuf = P.out;
        float* mod = (float*)(P.ws + WS_MOD);
        if (ph == 0) { for (int rp = 0; rp < REP(0); ++rp) phase_convert(P, (float*)lds_raw); }
        else if (ph == 1) {
            Gemm g{(const bf16_t*)(P.ws + WS_CACT), (const bf16_t*)(P.ws + WS_WADA), 1024, 1024, 1024, 1, 96, 0, 0, 0, 0, 0};
            EpiMod E{mod, P.in[11]};
            for (int rp = 0; rp < REP(1); ++rp) gemm_phase<EpiMod, 1>(ldsl, g, E);
        }
        else if (ph == N_PHASES - 1) { phase_final_norm(xbuf, P.in[33]); }
        else {
            const int layer = (ph - 2) / PH_PER_LAYER, sp = (ph - 2) % PH_PER_LAYER;
            const float* modL = mod + (size_t)layer * NCOND * 6144;
            const float* xin_p = layer == 0 ? P.in[0] : xbuf; const float* xin_s = layer == 0 ? P.in[1] : xbuf + (size_t)NPR * 1024;
            if (sp == 0) { for (int rp = 0; rp < REP(16); ++rp) phase_norm(xin_p, xin_s, P.in[12] + layer * 1024, modL, 0, 1024, hbuf); }
            else if (sp == 1) {
                Gemm g{hbuf, (const bf16_t*)(P.ws + WS_WIN) + (size_t)layer * 13568 * 1024, 1024, 1024, 1024, 66, 53, 0, 0, 0, 0, 0};
                EpiProj E{proj};
                for (int rp = 0; rp < REP(2); ++rp) gemm_phase<EpiProj, 1>(ldsl, g, E);
            }
            else if (sp == 2) {
                for (int it = blockIdx.x; it < 3972 + 256; it += gridDim.x) {
                    if (it < 512) { for (int rp = 0; rp < REP(3); ++rp) ssd_pass1_item(P, layer, it, lds_raw); }
                    else if (it < 1024) { for (int rp = (DRYM & 1) ? 0 : 1; rp < 2; ++rp) attn_prompt_item(P, layer, it - 512, lds_raw, rp == 0 && P.ph_lo == 0); }
                    else if (it < 1536) { for (int rp = (DRYM & 2) ? 0 : 1; rp < 2; ++rp) attn_sample_item(P, layer, it - 1024, (float*)lds_raw, rp == 0 && P.ph_lo == 0); }
                    else if (it < 2560) { for (int rp = (DRYM & 4) ? 0 : 1; rp < 2; ++rp) gmlp_prompt_item(P, layer, it - 1536, lds_raw, rp == 0 && P.ph_lo == 0); }
                    else if (it < 2688) { if (EN(8)) gmlp_sample_item(P, layer, it - 2560, (float*)lds_raw); }
                    else if (it < 3840) { for (int rp = (DRYM & 8) ? 0 : 1; rp < 2; ++rp) shortconv_item(P, layer, it - 2688, rp == 0 && P.ph_lo == 0); }
                    else if (it < 3972) ssdconv_state_item(P, layer, it - 3840);
                    else ssd_item<2>(P, layer, it - 3972, (float*)lds_raw);
                }
            }
            else if (sp == 3) { phase_ssd_scan(P, layer); }
            else if (sp == 4) { for (int it = blockIdx.x; it < 512; it += gridDim.x) for (int rp = (DRYM & 16) ? 0 : 1; rp < 2; ++rp) ssd_pass3_item(P, layer, it, lds_raw, rp == 0 && P.ph_lo == 0); }
            else if (sp == 5) {
                Gemm g{proj, (const bf16_t*)(P.ws + WS_WBR) + (size_t)layer * 4 * 1048576, LDP, 1024, 1024, 64, 4, C_Z, C_BCX, C_Q, C_UV, (size_t)1048576};
                EpiBranch E{proj, (float*)(P.ws + WS_MSUM), hbuf};
                for (int rp = 0; rp < REP(11); ++rp) gemm_phase<EpiBranch, 4>(ldsl, g, E);
                for (int rp = 0; rp < REP(17); ++rp) sample_branch(P, layer, (float*)lds_raw);
            }
            else if (sp == 6) {
                Gemm g{hbuf, (const bf16_t*)(P.ws + WS_WO) + (size_t)layer * 1048576, 1024, 1024, 1024, 64, 4, 0, 0, 0, 0, 0};
                EpiResid E{xin_p, xin_s, xbuf, modL + 2048};
                if (EN(12)) gemm_phase<EpiResid, 1>(ldsl, g, E);
                sample_resid(P, hbuf + (size_t)NPR * 1024, 1024, (const bf16_t*)(P.ws + WS_WO) + (size_t)layer * 1048576, 1024, xin_s, xbuf, modL + 2048, (float*)lds_raw);
            }
            else if (sp == 7) { for (int rp = 0; rp < REP(16); ++rp) phase_norm(xbuf, xbuf + (size_t)NPR * 1024, P.in[28] + layer * 1024, modL, 3072, 4096, hbuf); }
            else if (sp == 8) {
                Gemm g{hbuf, (const bf16_t*)(P.ws + WS_WUP) + (size_t)layer * 5632 * 1024, 1024, 1024, 1024, 66, 22, 0, 0, 0, 0, 0};
                EpiUp E{proj};
                for (int rp = 0; rp < REP(13); ++rp) gemm_phase<EpiUp, 1>(ldsl, g, E);
            }
            else if (sp == 9) { for (int rp = 0; rp < REP(14); ++rp) phase_ffn_act(P, layer); }
            else {
                Gemm g{(const bf16_t*)(P.ws + WS_PROJ + UP_BYTES), (const bf16_t*)(P.ws + WS_WDN) + (size_t)layer * 1024 * 2816, 2816, 2816, 2816, 64, 4, 0, 0, 0, 0, 0};
                EpiResid E{xbuf, xbuf + (size_t)NPR * 1024, xbuf, modL + 5120};
                if (EN(15)) gemm_phase<EpiResid, 1>(ldsl, g, E);
                sample_resid(P, (const bf16_t*)(P.ws + WS_PROJ + UP_BYTES) + (size_t)NPR * 2816, 2816, (const bf16_t*)(P.ws + WS_WDN) + (size_t)layer * 1024 * 2816, 2816, xbuf + (size_t)NPR * 1024, xbuf, modL + 5120, (float*)lds_raw);
            }
        }
        if (ph + 1 < P.ph_hi) { if (ph == 0) grid.sync(); else grid_bar(barctr, epoch); }
    }
}

extern "C" void kernel_launch(void* const* d_in, const int* in_sizes, int n_in, void* d_out, int out_size, void* d_ws, size_t ws_size, hipStream_t stream) {
    static int grid_blocks = 0;
    if (grid_blocks == 0) {
        if (n_in != 34 || (size_t)out_size != O_END || ws_size < WS_END + 256) { fprintf(stderr, "kernel_launch: unexpected sizes n_in %d out %d ws %zu (need %zu)\n", n_in, out_size, ws_size, (size_t)WS_END); grid_blocks = -1; return; }
        int dev = 0, cus = 0, per_cu = 0;
        (void)hipGetDevice(&dev); (void)hipDeviceGetAttribute(&cus, hipDeviceAttributeMultiprocessorCount, dev);
        if (hipFuncSetAttribute((const void*)mega_fwd, hipFuncAttributeMaxDynamicSharedMemorySize, LDS_BYTES) != hipSuccess) { fprintf(stderr, "hipFuncSetAttribute failed\n"); grid_blocks = -1; return; }
        if (hipOccupancyMaxActiveBlocksPerMultiprocessor(&per_cu, (const void*)mega_fwd, 512, LDS_BYTES) != hipSuccess || per_cu < 1) per_cu = 1;
        grid_blocks = cus * 1;
    }
    if (grid_blocks < 0) return;
    Params p{};
    for (int i = 0; i < 34; ++i) p.in[i] = (const float*)d_in[i];
    p.out = (float*)d_out; p.ws = (unsigned char*)d_ws; p.ph_lo = 0; p.ph_hi = N_PHASES;
    (void)hipMemsetAsync((unsigned char*)d_ws + WS_BAR, 0, 256, stream);
    void* args[] = {&p};
    hipError_t e = hipLaunchCooperativeKernel((const void*)mega_fwd, dim3(grid_blocks), dim3(512), args, LDS_BYTES, stream);
    if (e != hipSuccess) fprintf(stderr, "cooperative launch failed: %s (grid %d)\n", hipGetErrorString(e), grid_blocks);
}
```

```cpp
#include <hip/hip_runtime.h>
#include <hip/hip_cooperative_groups.h>
#include <cstdio>
namespace cg = cooperative_groups;

typedef unsigned short bf16_t;
typedef short bf16x8 __attribute__((ext_vector_type(8)));
typedef float f32x4 __attribute__((ext_vector_type(4)));
typedef unsigned u32x4 __attribute__((ext_vector_type(4)));
typedef unsigned u32x2 __attribute__((ext_vector_type(2)));
#define LAS __attribute__((address_space(3)))

constexpr int NTOK = 16896, NPR = 16384;
constexpr int LDP = 13568;
constexpr int C_Z = 0, C_XBC = 1024, C_DTR = 2560, C_BCX = 2576, C_Q = 5648, C_K = 6672, C_V = 6928, C_UV = 7184, C_GATE = 9232, C_END = 13328;
constexpr int NCOND = 132;
constexpr float EPSF = 1e-6f;

constexpr size_t WS_WIN = 0;
constexpr size_t WS_WBR = WS_WIN + (size_t)4 * 13568 * 1024 * 2;
constexpr size_t WS_WO = WS_WBR + (size_t)16 * 1024 * 1024 * 2;
constexpr size_t WS_WUP = WS_WO + (size_t)4 * 1024 * 1024 * 2;
constexpr size_t WS_WDN = WS_WUP + (size_t)4 * 5632 * 1024 * 2;
constexpr size_t WS_WADA = WS_WDN + (size_t)4 * 1024 * 2816 * 2;
constexpr size_t WS_CACT = WS_WADA + (size_t)4 * 6144 * 1024 * 2;
constexpr size_t WS_MOD = WS_CACT + (size_t)256 * 1024 * 2;
constexpr size_t WS_H = WS_MOD + (size_t)4 * NCOND * 6144 * 4;
constexpr size_t WS_MSUM = WS_H + (size_t)NTOK * 1024 * 2;
constexpr size_t WS_PROJ = WS_MSUM + (size_t)NTOK * 1024 * 4;
constexpr size_t WS_END = WS_PROJ + (size_t)NTOK * LDP * 2;
constexpr size_t WS_BAR = WS_END;
constexpr size_t WS_SSDST = WS_WADA;
constexpr size_t WS_SSDDEC = WS_WADA + (size_t)4 * 32 * 16 * 4096 * 4;
constexpr size_t UP_BYTES = (size_t)NTOK * 5632 * 2;

constexpr size_t O_YP = 0, O_YS = 16777216, O_PSSM = O_YS + 524288, O_PSSDC = O_PSSM + 1048576, O_PSCC = O_PSSDC + 73728,
                 O_PK = O_PSCC + 32768, O_PV = O_PK + 524288, O_PFFC = O_PV + 524288, O_SSSM = O_PFFC + 180224,
                 O_SSSDC = O_SSSM + 33554432, O_SSCC = O_SSSDC + 2359296, O_SK = O_SSCC + 1048576, O_SV = O_SK + 16777216,
                 O_SFFC = O_SV + 16777216, O_SGMV = O_SFFC + 5767168, O_END = O_SGMV + 2097152;

struct Params { const float* in[34]; float* out; unsigned char* ws; int ph_lo, ph_hi; };

constexpr int LDS_BYTES = 155648;

__device__ __forceinline__ float bf2f(bf16_t v) { return __uint_as_float((unsigned)v << 16); }
__device__ __forceinline__ float bflo(unsigned v) { return __uint_as_float(v << 16); }
__device__ __forceinline__ float bfhi(unsigned v) { return __uint_as_float(v & 0xffff0000u); }
__device__ __forceinline__ unsigned pk2(float lo, float hi) { unsigned r; asm("v_cvt_pk_bf16_f32 %0, %1, %2" : "=v"(r) : "v"(lo), "v"(hi)); return r; }
__device__ __forceinline__ bf16_t f2bf(float f) { return (bf16_t)(pk2(f, 0.f) & 0xffffu); }
__device__ __forceinline__ float shx(float v, int o, int lane) { return __int_as_float(__builtin_amdgcn_ds_bpermute((lane ^ o) << 2, __float_as_int(v))); }
__device__ __forceinline__ float wave_sum(float v, int lane) {
#pragma unroll
    for (int o = 32; o > 0; o >>= 1) v += shx(v, o, lane);
    return v;
}
__device__ __forceinline__ int otid() { int t = threadIdx.x; asm volatile("" : "+v"(t)); return t; }
__device__ __forceinline__ float sigmoidf_(float x) { return __builtin_amdgcn_rcpf(1.f + __expf(-x)); }
__device__ __forceinline__ float siluf_(float x) { return x * __builtin_amdgcn_rcpf(1.f + __expf(-x)); }
__device__ __forceinline__ float geluf_(float x) { const float u = 0.7978845608f * (x + 0.044715f * x * x * x); return x / (1.f + __expf(-2.f * u)); }
__device__ __forceinline__ float softplusf_(float x) { return fmaxf(x, 0.f) + log1pf(__expf(-fabsf(x))); }
__device__ __forceinline__ float silu_fast(float x) { return x * __builtin_amdgcn_rcpf(1.f + __expf(-x)); }
__device__ __forceinline__ float sigmoid_fast(float x) { return __builtin_amdgcn_rcpf(1.f + __expf(-x)); }
__device__ __forceinline__ float gelu_fast(float x) { const float u = 0.7978845608f * (x + 0.044715f * x * x * x); return x * __builtin_amdgcn_rcpf(1.f + __expf(-2.f * u)); }
__device__ __forceinline__ int cond_row(int r) { return r < NPR ? (r >> 12) : 4 + ((r - NPR) >> 2); }
__device__ __forceinline__ int seq_start(int r) { return r < NPR ? (r & ~4095) : NPR + ((r - NPR) & ~3); }

constexpr int BM = 256, BK = 64, HALF = 128, HTB = HALF * BK * 2;
__device__ __forceinline__ int lds_byte(int r, int c) { const int st = (r >> 4) * 2 + (c >> 5), rr = r & 15, cc = c & 31, ob = rr * 64 + cc * 2; return st * 1024 + (ob ^ (((ob >> 9) & 1) << 5)); }
__device__ __forceinline__ void stage_rc(int b, int& R, int& C) { const int st = b / 1024, sb = b % 1024, swz = sb ^ (((sb >> 9) & 1) << 5); R = (st >> 1) * 16 + swz / 64; C = (st & 1) * 32 + (swz % 64) / 2; }
__device__ __forceinline__ int perm32(int rho) { const int n = rho >> 4, i = rho & 15; return 8 * (i >> 2) + 4 * n + (i & 3); }

struct Unit { int pm, pn, z; };
struct Gemm { const bf16_t* A; const bf16_t* Bt; int lda, ldb, K, nM, nN; int ao0, ao1, ao2, ao3; size_t zB; };
__device__ __forceinline__ int gemm_aofs(const Gemm& g, int z) { return z == 0 ? g.ao0 : (z == 1 ? g.ao1 : (z == 2 ? g.ao2 : g.ao3)); }

template <int ZN> __device__ __forceinline__ bool unit_next(const Gemm& g, int i, Unit& u) {
    const int tile = i / ZN; u.z = i - tile * ZN;
    const long L = (long)tile * gridDim.x + blockIdx.x; const int nwg = g.nM * g.nN; if (L >= nwg) return false;
    int wgid = (int)L; { const int q = nwg / 8, r = nwg % 8, xcd = wgid % 8, off = wgid / 8; wgid = (xcd < r ? xcd * (q + 1) : r * (q + 1) + (xcd - r) * q) + off; }
    const int nig = 4 * g.nN, gid = wgid / nig, fm = gid * 4, gsz = (g.nM - fm) < 4 ? (g.nM - fm) : 4;
    u.pm = fm + ((wgid % nig) % gsz); u.pn = (wgid % nig) / gsz; return true;
}

template <class Epi, int ZN>
__device__ __forceinline__ void gemm_phase(LAS unsigned char* lds, const Gemm g, const Epi& E) {
    const int tid = otid(), wid = __builtin_amdgcn_readfirstlane(tid >> 6), lane = tid & 63, wr = wid >> 2, wc = wid & 3, fr = lane & 15, fq = lane >> 4;
    const int K = g.K, nt = K / BK;
    unsigned voffA[2], voffB[2];
#pragma unroll
    for (int i = 0; i < 2; ++i) { int R, C; stage_rc(tid * 16 + i * 8192, R, C); const int Rb = Epi::PERM ? ((R & ~31) + perm32(R & 31)) : R;
        voffA[i] = (unsigned)(R * g.lda + C) * 2u; voffB[i] = (unsigned)(Rb * g.ldb + C) * 2u; }
    const size_t kstep = (size_t)(BK * 2);
    const size_t hstepA = (size_t)HALF * g.lda * 2, hstepB = (size_t)HALF * g.ldb * 2;
    const size_t tstepA = 2 * hstepA, tstepB = 2 * hstepB;
    const unsigned ldsw = (unsigned)wid * 1024u;
    const int aoff = lds_byte(wr * 64 + fr, fq * 8), boff = lds_byte(wc * 32 + fr, fq * 8);
#define PG8_SA(b, h) (((b) * 2 + (h)) * HTB)
#define PG8_SB(b, h) ((4 + (b) * 2 + (h)) * HTB)
#define PG8_STAGE(bufoff, gbase, voff) do { _Pragma("unroll") for (int _i = 0; _i < 2; ++_i) \
        __builtin_amdgcn_global_load_lds((const unsigned*)((const char*)(gbase) + (voff)[_i]), (LAS unsigned*)(lds + (bufoff) + ldsw + _i * 8192), 16, 0, 0); } while (0)
#define PG8_LDA(dst, b, h) do { _Pragma("unroll") for (int m = 0; m < 4; ++m) _Pragma("unroll") for (int k = 0; k < 2; ++k) dst[m][k] = *(const LAS bf16x8*)(lds + PG8_SA(b, h) + aoff + m * 2048 + k * 1024); } while (0)
#define PG8_LDB(dst, b, h) do { _Pragma("unroll") for (int n = 0; n < 2; ++n) _Pragma("unroll") for (int k = 0; k < 2; ++k) dst[n][k] = *(const LAS bf16x8*)(lds + PG8_SB(b, h) + boff + n * 2048 + k * 1024); } while (0)
#define PG8_MMA(ai, bj, At, Bt) do { __builtin_amdgcn_s_setprio(1); _Pragma("unroll") for (int m = 0; m < 4; ++m) _Pragma("unroll") for (int n = 0; n < 2; ++n) _Pragma("unroll") for (int k = 0; k < 2; ++k) \
        acc[ai][bj][m][n] = __builtin_amdgcn_mfma_f32_16x16x32_bf16(Bt[n][k], At[m][k], acc[ai][bj][m][n], 0, 0, 0); __builtin_amdgcn_s_setprio(0); } while (0)
#define PG8_WAIT_V(n) asm volatile("s_waitcnt vmcnt(" #n ")" ::: "memory")
#define PG8_WAIT_L(n) asm volatile("s_waitcnt lgkmcnt(" #n ")" ::: "memory")
#define PG8_BAR __builtin_amdgcn_s_barrier()
#define PG8_SCHED __builtin_amdgcn_sched_barrier(0)
    Unit cur, nxt; int ui = 0;
    if (!unit_next<ZN>(g, 0, cur)) return;
    f32x4 acc[2][2][4][2];
#pragma unroll
    for (int a = 0; a < 2; ++a)
#pragma unroll
        for (int b = 0; b < 2; ++b)
#pragma unroll
            for (int m = 0; m < 4; ++m)
#pragma unroll
                for (int n = 0; n < 2; ++n) acc[a][b][m][n] = (f32x4){0.f, 0.f, 0.f, 0.f};
    bf16x8 At[4][2], B0[2][2], B1[2][2];
    const char* cA = (const char*)g.A + (size_t)cur.pm * tstepA + (size_t)gemm_aofs(g, cur.z) * 2;
    const char* cB = (const char*)g.Bt + (size_t)cur.pn * tstepB + (size_t)cur.z * g.zB * 2;
    PG8_WAIT_V(0);
    PG8_STAGE(PG8_SB(0, 0), cB, voffB); PG8_STAGE(PG8_SA(0, 0), cA, voffA); PG8_STAGE(PG8_SB(0, 1), cB + hstepB, voffB); PG8_STAGE(PG8_SA(0, 1), cA + hstepA, voffA);
    if (wr == 1) PG8_BAR;
    PG8_WAIT_V(4); PG8_BAR;
    PG8_STAGE(PG8_SB(1, 0), cB + kstep, voffB); PG8_STAGE(PG8_SA(1, 0), cA + kstep, voffA); PG8_STAGE(PG8_SB(1, 1), cB + hstepB + kstep, voffB);
    PG8_WAIT_V(6); PG8_BAR;
    for (;;) {
        const bool has_next = unit_next<ZN>(g, ui + 1, nxt);
        const char* nA = has_next ? (const char*)g.A + (size_t)nxt.pm * tstepA + (size_t)gemm_aofs(g, nxt.z) * 2 : cA;
        const char* nB = has_next ? (const char*)g.Bt + (size_t)nxt.pn * tstepB + (size_t)nxt.z * g.zB * 2 : cB;
        for (int t = 0; t < nt; t += 2) {
            const bool last = (t == nt - 2);
            const char* a1 = cA + (size_t)(t + 1) * kstep;
            const char* a2 = last ? nA : cA + (size_t)(t + 2) * kstep; const char* b2 = last ? nB : cB + (size_t)(t + 2) * kstep;
            const char* a3 = a2 + kstep; const char* b3 = b2 + kstep;
            PG8_LDB(B0, 0, 0); PG8_SCHED; PG8_LDA(At, 0, 0); PG8_STAGE(PG8_SA(1, 1), a1 + hstepA, voffA);
            PG8_WAIT_L(8); PG8_BAR; PG8_WAIT_L(0); PG8_MMA(0, 0, At, B0); PG8_BAR; PG8_SCHED;
            PG8_LDB(B1, 0, 1); PG8_STAGE(PG8_SB(0, 0), b2, voffB);
            PG8_BAR; PG8_WAIT_L(0); PG8_MMA(0, 1, At, B1); PG8_BAR;
            PG8_LDA(At, 0, 1); PG8_STAGE(PG8_SA(0, 0), a2, voffA);
            PG8_BAR; PG8_WAIT_L(0); PG8_MMA(1, 0, At, B0); PG8_BAR; PG8_SCHED;
            PG8_STAGE(PG8_SB(0, 1), b2 + hstepB, voffB);
            PG8_WAIT_V(6); PG8_BAR; PG8_MMA(1, 1, At, B1); PG8_BAR;
            PG8_LDB(B0, 1, 0); PG8_SCHED; PG8_LDA(At, 1, 0); PG8_STAGE(PG8_SA(0, 1), a2 + hstepA, voffA);
            PG8_WAIT_L(8); PG8_BAR; PG8_WAIT_L(0); PG8_MMA(0, 0, At, B0); PG8_BAR; PG8_SCHED;
            PG8_LDB(B1, 1, 1); PG8_STAGE(PG8_SB(1, 0), b3, voffB);
            PG8_BAR; PG8_WAIT_L(0); PG8_MMA(0, 1, At, B1); PG8_BAR;
            PG8_LDA(At, 1, 1); PG8_STAGE(PG8_SA(1, 0), a3, voffA);
            PG8_BAR; PG8_WAIT_L(0); PG8_MMA(1, 0, At, B0); PG8_BAR; PG8_SCHED;
            PG8_STAGE(PG8_SB(1, 1), b3 + hstepB, voffB);
            PG8_WAIT_V(6); PG8_BAR; PG8_MMA(1, 1, At, B1); PG8_BAR;
        }
        E(acc, cur, wr, wc, fr, fq);
        if (!has_next) break;
#pragma unroll
        for (int a = 0; a < 2; ++a)
#pragma unroll
            for (int b = 0; b < 2; ++b)
#pragma unroll
                for (int m = 0; m < 4; ++m)
#pragma unroll
                    for (int n = 0; n < 2; ++n) acc[a][b][m][n] = (f32x4){0.f, 0.f, 0.f, 0.f};
        cur = nxt; cA = nA; cB = nB; ++ui;
    }
    PG8_WAIT_V(0);
    if (wr == 0) PG8_BAR;
    PG8_BAR;
#undef PG8_SA
#undef PG8_SB
#undef PG8_STAGE
#undef PG8_LDA
#undef PG8_LDB
#undef PG8_MMA
#undef PG8_WAIT_V
#undef PG8_WAIT_L
#undef PG8_BAR
#undef PG8_SCHED
}

struct EpiMod {
    static constexpr bool PERM = false;
    float* mod; const float* bada;
    __device__ __forceinline__ void operator()(const f32x4 (&acc)[2][2][4][2], const Unit& u, int wr, int wc, int fr, int fq) const {
        f32x4 bv[2][2];
#pragma unroll
        for (int bj = 0; bj < 2; ++bj)
#pragma unroll
            for (int n = 0; n < 2; ++n) bv[bj][n] = *(const f32x4*)(bada + u.pn * BM + bj * HALF + wc * 32 + n * 16 + fq * 4);
#pragma unroll
        for (int ai = 0; ai < 2; ++ai)
#pragma unroll
            for (int m = 0; m < 4; ++m) { const int r = u.pm * BM + ai * HALF + wr * 64 + m * 16 + fr; if (r >= NCOND) continue;
#pragma unroll
                for (int bj = 0; bj < 2; ++bj)
#pragma unroll
                    for (int n = 0; n < 2; ++n) { const int c = u.pn * BM + bj * HALF + wc * 32 + n * 16 + fq * 4; const int layer = c / 6144, cc = c - layer * 6144;
                        *(f32x4*)(mod + ((size_t)(layer * NCOND + r)) * 6144 + cc) = acc[ai][bj][m][n] + bv[bj][n]; } }
    }
};
struct EpiProj {
    static constexpr bool PERM = true;
    bf16_t* O;
    __device__ __forceinline__ void operator()(const f32x4 (&acc)[2][2][4][2], const Unit& u, int wr, int wc, int fr, int fq) const {
#pragma unroll
        for (int bj = 0; bj < 2; ++bj) { const int c = u.pn * BM + bj * HALF + wc * 32 + fq * 8; const int mode = (c >= C_UV + 1024 && c < C_GATE) ? 1 : 0;
#pragma unroll
            for (int ai = 0; ai < 2; ++ai)
#pragma unroll
                for (int m = 0; m < 4; ++m) { const int r = u.pm * BM + ai * HALF + wr * 64 + m * 16 + fr;
                    float v[8];
#pragma unroll
                    for (int i = 0; i < 8; ++i) { float x = acc[ai][bj][m][i >> 2][i & 3]; v[i] = (mode == 1 ? gelu_fast(x) : x); }
                    u32x4 o; o[0] = pk2(v[0], v[1]); o[1] = pk2(v[2], v[3]); o[2] = pk2(v[4], v[5]); o[3] = pk2(v[6], v[7]);
                    *(u32x4*)(O + (size_t)r * LDP + c) = o; } }
    }
};
struct EpiUp {
    static constexpr bool PERM = true;
    bf16_t* O;
    __device__ __forceinline__ void operator()(const f32x4 (&acc)[2][2][4][2], const Unit& u, int wr, int wc, int fr, int fq) const {
#pragma unroll
        for (int bj = 0; bj < 2; ++bj) { const int c = u.pn * BM + bj * HALF + wc * 32 + fq * 8;
#pragma unroll
            for (int ai = 0; ai < 2; ++ai)
#pragma unroll
                for (int m = 0; m < 4; ++m) { const int r = u.pm * BM + ai * HALF + wr * 64 + m * 16 + fr;
                    const f32x4 a = acc[ai][bj][m][0], b = acc[ai][bj][m][1];
                    u32x4 o; o[0] = pk2(a[0], a[1]); o[1] = pk2(a[2], a[3]); o[2] = pk2(b[0], b[1]); o[3] = pk2(b[2], b[3]);
                    *(u32x4*)(O + (size_t)r * 5632 + c) = o; } }
    }
};
struct EpiBranch {
    static constexpr bool PERM = true;
    const bf16_t* proj; float* msum; bf16_t* merged;
    __device__ __forceinline__ void operator()(const f32x4 (&acc)[2][2][4][2], const Unit& u, int wr, int wc, int fr, int fq) const {
        const int z = u.z;
        u32x4 gt[2][2], pv[2][2];
        const int c0 = u.pn * BM + wc * 32 + fq * 8, r0 = u.pm * BM + wr * 64 + fr;
#define EB_LOAD(k, buf) do { const int bj_ = (k) >> 2, ai_ = ((k) >> 1) & 1, m0_ = ((k) & 1) * 2; _Pragma("unroll") for (int mm = 0; mm < 2; ++mm) { const int r = r0 + ai_ * HALF + (m0_ + mm) * 16, c = c0 + bj_ * HALF; \
            gt[buf][mm] = *(const u32x4*)(proj + (size_t)r * LDP + C_GATE + z * 1024 + c); pv[buf][mm] = (u32x4){0u, 0u, 0u, 0u}; \
            if (z > 0) pv[buf][mm] = *(const u32x4*)(merged + (size_t)r * 1024 + c); } } while (0)
        EB_LOAD(0, 0);
#pragma unroll
        for (int k = 0; k < 8; ++k) { const int bj = k >> 2, ai = (k >> 1) & 1, m0 = (k & 1) * 2, buf = k & 1;
            if (k < 7) { if (buf == 0) EB_LOAD(k + 1, 1); else EB_LOAD(k + 1, 0); }
#pragma unroll
            for (int mm = 0; mm < 2; ++mm) { const int m = m0 + mm; const int r = r0 + ai * HALF + m * 16, c = c0 + bj * HALF;
                const f32x4 a = acc[ai][bj][m][0], b = acc[ai][bj][m][1]; const u32x4 gv = gt[buf][mm], p = pv[buf][mm];
                u32x4 o;
                o[0] = pk2(bflo(p[0]) + sigmoid_fast(bflo(gv[0])) * a[0], bfhi(p[0]) + sigmoid_fast(bfhi(gv[0])) * a[1]); o[1] = pk2(bflo(p[1]) + sigmoid_fast(bflo(gv[1])) * a[2], bfhi(p[1]) + sigmoid_fast(bfhi(gv[1])) * a[3]);
                o[2] = pk2(bflo(p[2]) + sigmoid_fast(bflo(gv[2])) * b[0], bfhi(p[2]) + sigmoid_fast(bfhi(gv[2])) * b[1]); o[3] = pk2(bflo(p[3]) + sigmoid_fast(bflo(gv[3])) * b[2], bfhi(p[3]) + sigmoid_fast(bfhi(gv[3])) * b[3]);
                *(u32x4*)(merged + (size_t)r * 1024 + c) = o; } }
#undef EB_LOAD
    }
};
struct EpiResid {
    static constexpr bool PERM = false;
    const float* xin_p; const float* xin_s; float* xout; const float* ga;
    __device__ __forceinline__ void operator()(const f32x4 (&acc)[2][2][4][2], const Unit& u, int wr, int wc, int fr, int fq) const {
        const float* gr = ga + (size_t)(u.pm >> 4) * 6144;
        const int c0 = u.pn * BM + wc * 32 + fq * 4, r0 = u.pm * BM + wr * 64 + fr;
        f32x4 gv[2][2];
#pragma unroll
        for (int bj = 0; bj < 2; ++bj)
#pragma unroll
            for (int n = 0; n < 2; ++n) gv[bj][n] = *(const f32x4*)(gr + c0 + bj * HALF + n * 16);
        f32x4 xv[2][2][2];
#define ER_LOAD(k, buf) do { const int r_ = r0 + ((k) >> 2) * HALF + ((k) & 3) * 16; _Pragma("unroll") for (int bj = 0; bj < 2; ++bj) _Pragma("unroll") for (int n = 0; n < 2; ++n) \
            xv[buf][bj][n] = *(const f32x4*)(xin_p + (size_t)r_ * 1024 + c0 + bj * HALF + n * 16); } while (0)
        ER_LOAD(0, 0);
#pragma unroll
        for (int k = 0; k < 8; ++k) { const int ai = k >> 2, m = k & 3, buf = k & 1; const int r = r0 + ai * HALF + m * 16;
            if (k < 7) { if (buf == 0) ER_LOAD(k + 1, 1); else ER_LOAD(k + 1, 0); }
#pragma unroll
            for (int bj = 0; bj < 2; ++bj)
#pragma unroll
                for (int n = 0; n < 2; ++n) *(f32x4*)(xout + (size_t)r * 1024 + c0 + bj * HALF + n * 16) = xv[buf][bj][n] + gv[bj][n] * acc[ai][bj][m][n]; }
#undef ER_LOAD
    }
};

struct CTile { const float* src; bf16_t* dst; int K, N, k0, n0; };
__device__ __forceinline__ CTile conv_decode(const Params& P, int t) {
    constexpr int T_IN = 3392, T_BR = 1024, T_O = 256, T_UP = 1408, T_DN = 704, T_ADA = 1536, T_L = T_IN + T_BR + T_O + T_UP + T_DN + T_ADA;
    const int layer = t / T_L; int r = t - layer * T_L; CTile c;
    if (r < T_IN) { c.src = P.in[13] + (size_t)layer * 1024 * 13328; c.dst = (bf16_t*)(P.ws + WS_WIN) + (size_t)layer * 13568 * 1024; c.K = 1024; c.N = 13328; c.k0 = (r / 212) * 64; c.n0 = (r % 212) * 64; return c; }
    r -= T_IN;
    if (r < T_BR) { const int br = r >> 8, q = r & 255; c.src = P.in[26] + (size_t)(layer * 4 + br) * 1048576; c.dst = (bf16_t*)(P.ws + WS_WBR) + (size_t)(layer * 4 + br) * 1048576; c.K = 1024; c.N = 1024; c.k0 = (q >> 4) * 64; c.n0 = (q & 15) * 64; return c; }
    r -= T_BR;
    if (r < T_O) { c.src = P.in[27] + (size_t)layer * 1048576; c.dst = (bf16_t*)(P.ws + WS_WO) + (size_t)layer * 1048576; c.K = 1024; c.N = 1024; c.k0 = (r >> 4) * 64; c.n0 = (r & 15) * 64; return c; }
    r -= T_O;
    if (r < T_UP) { c.src = P.in[29] + (size_t)layer * 1024 * 5632; c.dst = (bf16_t*)(P.ws + WS_WUP) + (size_t)layer * 5632 * 1024; c.K = 1024; c.N = 5632; c.k0 = (r / 88) * 64; c.n0 = (r % 88) * 64; return c; }
    r -= T_UP;
    if (r < T_DN) { c.src = P.in[32] + (size_t)layer * 2816 * 1024; c.dst = (bf16_t*)(P.ws + WS_WDN) + (size_t)layer * 1024 * 2816; c.K = 2816; c.N = 1024; c.k0 = (r >> 4) * 64; c.n0 = (r & 15) * 64; return c; }
    r -= T_DN;
    c.src = P.in[10] + (size_t)layer * 1024 * 6144; c.dst = (bf16_t*)(P.ws + WS_WADA) + (size_t)layer * 6144 * 1024; c.K = 1024; c.N = 6144; c.k0 = (r / 96) * 64; c.n0 = (r % 96) * 64; return c;
}
__device__ __forceinline__ void phase_convert(const Params& P, float* T) {
    constexpr int NT = 4 * 8320;
    const int tid = otid();
    int t = blockIdx.x;
    CTile cur = conv_decode(P, t < NT ? t : 0);
    float v[8], nv[8];
#pragma unroll
    for (int e = 0; e < 8; ++e) { const int idx = tid + e * 512, k = idx >> 6, n = idx & 63; v[e] = (t < NT && cur.n0 + n < cur.N) ? cur.src[(size_t)(cur.k0 + k) * cur.N + cur.n0 + n] : 0.f; }
    for (; t < NT; t += gridDim.x) {
        const int tn = t + gridDim.x; const bool hn = tn < NT; const CTile nxt = conv_decode(P, hn ? tn : 0);
#pragma unroll
        for (int e = 0; e < 8; ++e) { const int idx = tid + e * 512, k = idx >> 6, n = idx & 63; nv[e] = (hn && nxt.n0 + n < nxt.N) ? nxt.src[(size_t)(nxt.k0 + k) * nxt.N + nxt.n0 + n] : 0.f; }
#pragma unroll
        for (int e = 0; e < 8; ++e) { const int idx = tid + e * 512, k = idx >> 6, n = idx & 63; T[k * 65 + n] = v[e]; }
        __syncthreads();
        { const int n = tid >> 3, kc = (tid & 7) * 8; float x[8];
#pragma unroll
          for (int j = 0; j < 8; ++j) x[j] = T[(kc + j) * 65 + n];
          u32x4 o; o[0] = pk2(x[0], x[1]); o[1] = pk2(x[2], x[3]); o[2] = pk2(x[4], x[5]); o[3] = pk2(x[6], x[7]);
          *(u32x4*)(cur.dst + (size_t)(cur.n0 + n) * cur.K + cur.k0 + kc) = o; }
        __syncthreads();
#pragma unroll
        for (int e = 0; e < 8; ++e) v[e] = nv[e];
        cur = nxt;
    }
    bf16_t* cact = (bf16_t*)(P.ws + WS_CACT);
    for (int i = blockIdx.x * 512 + otid(); i < 256 * 1024; i += gridDim.x * 512) {
        const int r = i >> 10, c = i & 1023; float v = 0.f;
        if (r < 4) v = siluf_(P.in[2][r * 1024 + c]); else if (r < NCOND) v = siluf_(P.in[3][(r - 4) * 1024 + c]);
        cact[i] = f2bf(v);
    }
}

__device__ __forceinline__ void phase_norm(const float* xp, const float* xs, const float* g, const float* modL, int shofs, int scofs, bf16_t* hout) {
    const int tid = otid(); const int w = tid >> 6, lane = tid & 63;
    for (int r = blockIdx.x * 8 + w; r < NTOK; r += gridDim.x * 8) {
        const float* x = r < NPR ? xp + (size_t)r * 1024 : xs + (size_t)(r - NPR) * 1024;
        const float* mr = modL + (size_t)cond_row(r) * 6144;
        f32x4 v[4]; float ss = 0.f;
#pragma unroll
        for (int i = 0; i < 4; ++i) { v[i] = *(const f32x4*)(x + i * 256 + lane * 4); ss += v[i][0] * v[i][0] + v[i][1] * v[i][1] + v[i][2] * v[i][2] + v[i][3] * v[i][3]; }
        ss = wave_sum(ss, lane); const float rs = rsqrtf(ss * (1.f / 1024.f) + EPSF);
#pragma unroll
        for (int i = 0; i < 4; ++i) { const int c = i * 256 + lane * 4;
            const f32x4 gv = *(const f32x4*)(g + c), sc = *(const f32x4*)(mr + scofs + c), sh = *(const f32x4*)(mr + shofs + c);
            f32x4 o = v[i] * rs * gv * (sc + 1.f) + sh;
            u32x2 pk; pk[0] = pk2(o[0], o[1]); pk[1] = pk2(o[2], o[3]);
            *(u32x2*)(hout + (size_t)r * 1024 + c) = pk; }
    }
}
__device__ __forceinline__ void phase_final_norm(float* x, const float* g) {
    const int tid = otid(); const int w = tid >> 6, lane = tid & 63;
    for (int r = blockIdx.x * 8 + w; r < NTOK; r += gridDim.x * 8) {
        float* xr = x + (size_t)r * 1024; f32x4 v[4]; float ss = 0.f;
#pragma unroll
        for (int i = 0; i < 4; ++i) { v[i] = *(const f32x4*)(xr + i * 256 + lane * 4); ss += v[i][0] * v[i][0] + v[i][1] * v[i][1] + v[i][2] * v[i][2] + v[i][3] * v[i][3]; }
        ss = wave_sum(ss, lane); const float rs = rsqrtf(ss * (1.f / 1024.f) + EPSF);
#pragma unroll
        for (int i = 0; i < 4; ++i) { const int c = i * 256 + lane * 4; const f32x4 gv = *(const f32x4*)(g + c); *(f32x4*)(xr + c) = v[i] * rs * gv; }
    }
}

template <int MODE>
__device__ __forceinline__ void ssd_item(const Params& P, int layer, int item, float* L) {
    const int tid = otid(), w = tid >> 6, lane = tid & 63;
    bf16_t* proj = (bf16_t*)(P.ws + WS_PROJ);
    float* states = (float*)(P.ws + WS_SSDST); float* decs = (float*)(P.ws + WS_SSDDEC);
    int r0, nsteps, half, seq0, b = 0, c = 0, sb = 0;
    if (MODE == 2) { sb = item >> 1; half = item & 1; r0 = NPR + sb * 4; nsteps = 4; seq0 = r0; }
    else { b = item >> 6; c = (item >> 1) & 31; half = item & 1; r0 = b * 4096 + c * 128; nsteps = 128; seq0 = b * 4096; }
    float* XS = L; float* ZS = XS + 16 * 512; float* BS = ZS + 16 * 512; float* CS = BS + 16 * 128; float* DTS = CS + 16 * 128; float* DAS = DTS + 128; float* SSQ = DAS + 128;
    const float* cw = P.in[14] + (size_t)layer * 4 * 1536; const float* cb = P.in[15] + (size_t)layer * 1536;
    const float* prev = P.in[5] + ((size_t)(layer * 128 + sb)) * 3 * 1536;
    const int hd = half * 8 + w, gl = w >> 2;
    float h[64];
    if (MODE == 0) {
#pragma unroll
        for (int n = 0; n < 64; ++n) h[n] = 0.f;
    } else {
        const float* s0p = (MODE == 1) ? states + ((size_t)((b * 32 + c) * 16 + hd)) * 4096 + lane * 64
                                       : P.in[4] + ((size_t)((layer * 128 + sb) * 16 + hd)) * 4096 + lane * 64;
#pragma unroll
        for (int n4 = 0; n4 < 16; ++n4) { const f32x4 v = *(const f32x4*)(s0p + n4 * 4); h[n4 * 4] = v[0]; h[n4 * 4 + 1] = v[1]; h[n4 * 4 + 2] = v[2]; h[n4 * 4 + 3] = v[3]; }
    }
    const float Dh = P.in[18][layer * 16 + hd];
    float decp = 1.f;
    for (int s0 = 0; s0 < nsteps; s0 += 16) {
        const int ns = (nsteps - s0) < 16 ? (nsteps - s0) : 16;
        __syncthreads();
        for (int idx = tid; idx < ns * 768; idx += 512) {
            const int t = idx / 768, ch = idx - t * 768;
            int cx;
            if (ch < 512) cx = half * 512 + ch; else if (ch < 640) cx = 1024 + half * 128 + (ch - 512); else cx = 1280 + half * 128 + (ch - 640);
            float a = cb[cx];
#pragma unroll
            for (int k = 0; k < 4; ++k) { const int step = s0 + t - 3 + k, rr = r0 + step; float raw;
                if (rr >= seq0) raw = bf2f(proj[(size_t)rr * LDP + C_XBC + cx]);
                else raw = (MODE == 2) ? prev[(3 + step) * 1536 + cx] : 0.f;
                a += cw[k * 1536 + cx] * raw; }
            a = siluf_(a);
            if (ch < 512) { XS[t * 512 + ch] = a; if (MODE != 0) ZS[t * 512 + ch] = bf2f(proj[(size_t)(r0 + s0 + t) * LDP + C_Z + cx]); }
            else if (ch < 640) BS[t * 128 + ch - 512] = a; else CS[t * 128 + ch - 640] = a;
        }
        if (tid < ns * 8) { const int t = tid >> 3, ww = tid & 7, hh = half * 8 + ww;
            const float dt = softplusf_(bf2f(proj[(size_t)(r0 + s0 + t) * LDP + C_DTR + hh]) + P.in[16][layer * 16 + hh]);
            DTS[t * 8 + ww] = dt; DAS[t * 8 + ww] = __expf(-dt * __expf(P.in[17][layer * 16 + hh])); }
        __syncthreads();
        for (int t = 0; t < ns; ++t) {
            const float a = DAS[t * 8 + w], dt = DTS[t * 8 + w], xv = XS[t * 512 + w * 64 + lane], xd = xv * dt; decp *= a;
            const f32x4* B4 = (const f32x4*)(BS + t * 128 + gl * 64);
#pragma unroll
            for (int n4 = 0; n4 < 16; ++n4) { const f32x4 bv = B4[n4];
                h[n4 * 4] = a * h[n4 * 4] + xd * bv[0]; h[n4 * 4 + 1] = a * h[n4 * 4 + 1] + xd * bv[1]; h[n4 * 4 + 2] = a * h[n4 * 4 + 2] + xd * bv[2]; h[n4 * 4 + 3] = a * h[n4 * 4 + 3] + xd * bv[3]; }
            if (MODE != 0) {
                const f32x4* C4 = (const f32x4*)(CS + t * 128 + gl * 64); float y0 = 0.f, y1 = 0.f;
#pragma unroll
                for (int n4 = 0; n4 < 16; ++n4) { const f32x4 cv = C4[n4]; y0 += h[n4 * 4] * cv[0] + h[n4 * 4 + 2] * cv[2]; y1 += h[n4 * 4 + 1] * cv[1] + h[n4 * 4 + 3] * cv[3]; }
                float y = y0 + y1 + Dh * xv; y *= siluf_(ZS[t * 512 + w * 64 + lane]);
                const float sq = wave_sum(y * y, lane); if (lane == 0) SSQ[(s0 + t) * 8 + w] = sq;
                proj[(size_t)(r0 + s0 + t) * LDP + C_Z + hd * 64 + lane] = f2bf(y);
            }
        }
    }
    if (MODE == 0) {
        float* sp = states + ((size_t)((b * 32 + c) * 16 + hd)) * 4096 + lane * 64;
#pragma unroll
        for (int n4 = 0; n4 < 16; ++n4) *(f32x4*)(sp + n4 * 4) = (f32x4){h[n4 * 4], h[n4 * 4 + 1], h[n4 * 4 + 2], h[n4 * 4 + 3]};
        if (lane == 0) decs[(b * 32 + c) * 16 + hd] = decp;
    }
    if (MODE == 2) {
        float* sp = P.out + O_SSSM + ((size_t)((layer * 128 + sb) * 16 + hd)) * 4096 + lane * 64;
#pragma unroll
        for (int n4 = 0; n4 < 16; ++n4) *(f32x4*)(sp + n4 * 4) = (f32x4){h[n4 * 4], h[n4 * 4 + 1], h[n4 * 4 + 2], h[n4 * 4 + 3]};
    }
    if (MODE != 0) {
        __syncthreads();
        const float ng = P.in[19][layer * 1024 + hd * 64 + lane];
        for (int t = 0; t < nsteps; ++t) {
            const float tot = SSQ[t * 8 + gl * 4] + SSQ[t * 8 + gl * 4 + 1] + SSQ[t * 8 + gl * 4 + 2] + SSQ[t * 8 + gl * 4 + 3];
            const float sc = rsqrtf(tot * (1.f / 256.f) + EPSF) * ng;
            bf16_t* ap = proj + (size_t)(r0 + t) * LDP + C_Z + hd * 64 + lane; *ap = f2bf(bf2f(*ap) * sc);
        }
    }
}

__device__ __forceinline__ int xt_idx(int row, int t) { return row * 136 + ((((t >> 3) ^ ((row >> 3) & 15)) << 3) | (t & 7)); }
__device__ __forceinline__ void ssd_stage_dt(const Params& P, int layer, const bf16_t* proj, size_t r0, int g, float* DT, float* ACS, int tid) {
    { const int hh = tid >> 7, t = tid & 127, hd = g * 4 + hh;
      const float dt = softplusf_(bf2f(proj[(r0 + t) * LDP + C_DTR + hd]) + P.in[16][layer * 16 + hd]);
      DT[hh * 128 + t] = dt; ACS[hh * 128 + t] = -dt * __expf(P.in[17][layer * 16 + hd]); }
    __syncthreads();
    if (tid < 256) { const int hh = tid >> 6, l = tid & 63; const float a0 = ACS[hh * 128 + 2 * l], a1 = ACS[hh * 128 + 2 * l + 1]; float sum = a0 + a1;
#pragma unroll
        for (int o = 1; o < 64; o <<= 1) { const float v = __int_as_float(__builtin_amdgcn_ds_bpermute(((l - o) & 63) << 2, __float_as_int(sum))); if (l >= o) sum += v; }
        ACS[hh * 128 + 2 * l] = sum - a1; ACS[hh * 128 + 2 * l + 1] = sum; }
    __syncthreads();
}
template <int PASS>
__device__ __forceinline__ void ssd_stage_conv(const Params& P, int layer, const bf16_t* proj, size_t r0, bool first, int g, const float* DT, const float* ACS, bf16_t* XT4, bf16_t* Bx, bf16_t* Cs, int tid) {
    const int slot = tid & 63, seg = tid >> 6;
    if (slot < (PASS ? 48 : 40)) {
        int cx; if (slot < 32) cx = g * 256 + slot * 8; else if (slot < 40) cx = 1024 + g * 64 + (slot - 32) * 8; else cx = 1280 + g * 64 + (slot - 40) * 8;
        const float* cw = P.in[14] + (size_t)layer * 4 * 1536 + cx; const float* cb = P.in[15] + (size_t)layer * 1536 + cx;
        float wt[4][8], bb[8], win[3][8];
#pragma unroll
        for (int k = 0; k < 4; ++k) { const f32x4 a = *(const f32x4*)(cw + k * 1536), c = *(const f32x4*)(cw + k * 1536 + 4);
#pragma unroll
            for (int i = 0; i < 4; ++i) { wt[k][i] = a[i]; wt[k][4 + i] = c[i]; } }
        { const f32x4 a = *(const f32x4*)cb, c = *(const f32x4*)(cb + 4);
#pragma unroll
          for (int i = 0; i < 4; ++i) { bb[i] = a[i]; bb[4 + i] = c[i]; } }
        const int t0 = seg * 16;
#pragma unroll
        for (int k = 0; k < 3; ++k) { u32x4 raw = (u32x4){0u, 0u, 0u, 0u};
            if (!(first && seg == 0)) raw = *(const u32x4*)(proj + (r0 + t0 - 3 + k) * LDP + C_XBC + cx);
#pragma unroll
            for (int i = 0; i < 4; ++i) { win[k][2 * i] = bflo(raw[i]); win[k][2 * i + 1] = bfhi(raw[i]); } }
        u32x4 cur4[4], nxt4[4];
#pragma unroll
        for (int q = 0; q < 4; ++q) { cur4[q] = *(const u32x4*)(proj + (r0 + t0 + q) * LDP + C_XBC + cx); nxt4[q] = cur4[q]; }
        for (int gq = 0; gq < 4; ++gq) {
            if (gq < 3) {
#pragma unroll
                for (int q = 0; q < 4; ++q) nxt4[q] = *(const u32x4*)(proj + (r0 + t0 + gq * 4 + 4 + q) * LDP + C_XBC + cx); }
#pragma unroll
            for (int q = 0; q < 4; ++q) {
                const int t = t0 + gq * 4 + q; const u32x4 raw = cur4[q];
                float cur[8], o[8];
#pragma unroll
                for (int i = 0; i < 4; ++i) { cur[2 * i] = bflo(raw[i]); cur[2 * i + 1] = bfhi(raw[i]); }
#pragma unroll
                for (int i = 0; i < 8; ++i) { o[i] = siluf_(bb[i] + wt[0][i] * win[0][i] + wt[1][i] * win[1][i] + wt[2][i] * win[2][i] + wt[3][i] * cur[i]); win[0][i] = win[1][i]; win[1][i] = win[2][i]; win[2][i] = cur[i]; }
                if (slot < 32) { const int hh = slot >> 3, p0 = (slot & 7) * 8; float sc = DT[hh * 128 + t]; if (PASS == 0) sc *= __expf(ACS[hh * 128 + 127] - ACS[hh * 128 + t]);
#pragma unroll
                    for (int i = 0; i < 8; ++i) XT4[xt_idx(hh * 64 + p0 + i, t)] = f2bf(o[i] * sc); }
                else if (slot < 40) { const int n0 = (slot - 32) * 8;
                    if (PASS == 0) {
#pragma unroll
                        for (int i = 0; i < 8; ++i) Bx[xt_idx(n0 + i, t)] = f2bf(o[i]); }
                    else { u32x4 pk; pk[0] = pk2(o[0], o[1]); pk[1] = pk2(o[2], o[3]); pk[2] = pk2(o[4], o[5]); pk[3] = pk2(o[6], o[7]); *(u32x4*)(Bx + t * 72 + n0) = pk; } }
                else { const int n0 = (slot - 40) * 8; u32x4 pk; pk[0] = pk2(o[0], o[1]); pk[1] = pk2(o[2], o[3]); pk[2] = pk2(o[4], o[5]); pk[3] = pk2(o[6], o[7]); *(u32x4*)(Cs + t * 72 + n0) = pk; }
            }
#pragma unroll
            for (int q = 0; q < 4; ++q) cur4[q] = nxt4[q];
        }
    }
}
__device__ __forceinline__ void ssd_pass1_item(const Params& P, int layer, int item, unsigned char* lds) {
    const int tid = otid(), w = __builtin_amdgcn_readfirstlane(tid >> 6), lane = tid & 63, fr = lane & 15, fq = lane >> 4;
    const int b = item >> 7, c = (item >> 2) & 31, g = item & 3; const size_t r0 = (size_t)b * 4096 + (size_t)c * 128;
    const bf16_t* proj = (const bf16_t*)(P.ws + WS_PROJ);
    float* states = (float*)(P.ws + WS_SSDST); float* decs = (float*)(P.ws + WS_SSDDEC);
    bf16_t* XT4 = (bf16_t*)lds; bf16_t* BT = XT4 + 256 * 136; float* DT = (float*)(BT + 64 * 136); float* ACS = DT + 512;
    __syncthreads();
    ssd_stage_dt(P, layer, proj, r0, g, DT, ACS, tid);
    ssd_stage_conv<0>(P, layer, proj, r0, c == 0, g, DT, ACS, XT4, BT, nullptr, tid);
    __syncthreads();
    const int hh = w >> 1, pb = (w & 1) * 2;
    f32x4 acc[2][4];
#pragma unroll
    for (int pi = 0; pi < 2; ++pi)
#pragma unroll
        for (int nt = 0; nt < 4; ++nt) acc[pi][nt] = (f32x4){0.f, 0.f, 0.f, 0.f};
#pragma unroll
    for (int ks = 0; ks < 4; ++ks) { bf16x8 a[2];
#pragma unroll
        for (int pi = 0; pi < 2; ++pi) a[pi] = *(const bf16x8*)(XT4 + xt_idx(hh * 64 + (pb + pi) * 16 + fr, ks * 32 + fq * 8));
#pragma unroll
        for (int nt = 0; nt < 4; ++nt) { const bf16x8 bv = *(const bf16x8*)(BT + xt_idx(nt * 16 + fr, ks * 32 + fq * 8));
#pragma unroll
            for (int pi = 0; pi < 2; ++pi) acc[pi][nt] = __builtin_amdgcn_mfma_f32_16x16x32_bf16(a[pi], bv, acc[pi][nt], 0, 0, 0); } }
    float* sp = states + ((size_t)((b * 32 + c) * 16 + g * 4 + hh)) * 4096;
#pragma unroll
    for (int pi = 0; pi < 2; ++pi)
#pragma unroll
        for (int nt = 0; nt < 4; ++nt)
#pragma unroll
            for (int j = 0; j < 4; ++j) sp[((pb + pi) * 16 + fq * 4 + j) * 64 + nt * 16 + fr] = acc[pi][nt][j];
    if (tid < 4) decs[(b * 32 + c) * 16 + g * 4 + tid] = __expf(ACS[tid * 128 + 127]);
}
__device__ __forceinline__ void ssd_pass3_item(const Params& P, int layer, int item, unsigned char* lds, bool dry = false) {
    const int tid = otid(), w = __builtin_amdgcn_readfirstlane(tid >> 6), lane = tid & 63, fr = lane & 15, fq = lane >> 4;
    const int b = item >> 7, c = (item >> 2) & 31, g = item & 3; const size_t r0 = (size_t)b * 4096 + (size_t)c * 128;
    bf16_t* proj = (bf16_t*)(P.ws + WS_PROJ);
    const float* states = (const float*)(P.ws + WS_SSDST);
    bf16_t* Cs = (bf16_t*)lds; bf16_t* Bs = Cs + 128 * 72; bf16_t* Sin = Bs; bf16_t* XT4 = Bs + 128 * 72; bf16_t* Ms = XT4 + 256 * 136; float* DT = (float*)(Ms + 128 * 136); float* ACS = DT + 512;
    __syncthreads();
    ssd_stage_dt(P, layer, proj, r0, g, DT, ACS, tid);
    ssd_stage_conv<1>(P, layer, proj, r0, c == 0, g, DT, ACS, XT4, Bs, Cs, tid);
    __syncthreads();
    f32x4 CB[8];
#pragma unroll
    for (int st = 0; st < 8; ++st) { CB[st] = (f32x4){0.f, 0.f, 0.f, 0.f};
        if (st <= w) {
#pragma unroll
            for (int ks = 0; ks < 2; ++ks) { const bf16x8 a = *(const bf16x8*)(Cs + (16 * w + fr) * 72 + ks * 32 + fq * 8), bv = *(const bf16x8*)(Bs + (16 * st + fr) * 72 + ks * 32 + fq * 8);
                CB[st] = __builtin_amdgcn_mfma_f32_16x16x32_bf16(a, bv, CB[st], 0, 0, 0); } } }
    float ssq[4] = {0.f, 0.f, 0.f, 0.f};
    const int nks = (w >> 1) + 1;
    bf16_t* zrow[4];
#pragma unroll
    for (int j = 0; j < 4; ++j) zrow[j] = proj + (r0 + 16 * w + fq * 4 + j) * LDP + C_Z + g * 256 + fr;
    f32x4 sna, snc;
    { const float* sp = states + ((size_t)((b * 32 + c) * 16 + g * 4)) * 4096 + (tid >> 3) * 64 + (tid & 7) * 8; sna = *(const f32x4*)sp; snc = *(const f32x4*)(sp + 4); }
    unsigned yg[4][4][2];
#pragma unroll
    for (int hh = 0; hh < 4; ++hh) {
        const int hd = g * 4 + hh;
        __syncthreads();
        { const int p = tid >> 3, n0 = (tid & 7) * 8;
          u32x4 pk; pk[0] = pk2(sna[0], sna[1]); pk[1] = pk2(sna[2], sna[3]); pk[2] = pk2(snc[0], snc[1]); pk[3] = pk2(snc[2], snc[3]);
          *(u32x4*)(Sin + p * 72 + n0) = pk;
          if (hh < 3) { const float* sp = states + ((size_t)((b * 32 + c) * 16 + hd + 1)) * 4096 + p * 64 + n0; sna = *(const f32x4*)sp; snc = *(const f32x4*)(sp + 4); } }
        float acs_t[4];
#pragma unroll
        for (int j = 0; j < 4; ++j) acs_t[j] = ACS[hh * 128 + 16 * w + fq * 4 + j];
#pragma unroll
        for (int st = 0; st < 8; ++st) { if (st <= (w | 1)) { const float acs_s = ACS[hh * 128 + 16 * st + fr];
#pragma unroll
            for (int j = 0; j < 4; ++j) { const int t = 16 * w + fq * 4 + j, sx = 16 * st + fr; const float v = (st <= w && sx <= t) ? CB[st][j] * __expf(acs_t[j] - acs_s) : 0.f; Ms[t * 136 + sx] = f2bf(v); } } }
        __syncthreads();
        bf16_t zv[4][4];
#pragma unroll
        for (int j = 0; j < 4; ++j)
#pragma unroll
            for (int pt = 0; pt < 4; ++pt) zv[j][pt] = *(zrow[j] + hh * 64 + pt * 16);
        f32x4 yd[4], yo[4];
#pragma unroll
        for (int pt = 0; pt < 4; ++pt) { yd[pt] = (f32x4){0.f, 0.f, 0.f, 0.f}; yo[pt] = (f32x4){0.f, 0.f, 0.f, 0.f}; }
        for (int ks = 0; ks < nks; ++ks) { const bf16x8 a = *(const bf16x8*)(Ms + (16 * w + fr) * 136 + ks * 32 + fq * 8);
#pragma unroll
            for (int pt = 0; pt < 4; ++pt) { const bf16x8 bv = *(const bf16x8*)(XT4 + xt_idx(hh * 64 + pt * 16 + fr, ks * 32 + fq * 8)); yd[pt] = __builtin_amdgcn_mfma_f32_16x16x32_bf16(a, bv, yd[pt], 0, 0, 0); } }
#pragma unroll
        for (int ks = 0; ks < 2; ++ks) { const bf16x8 a = *(const bf16x8*)(Cs + (16 * w + fr) * 72 + ks * 32 + fq * 8);
#pragma unroll
            for (int pt = 0; pt < 4; ++pt) { const bf16x8 bv = *(const bf16x8*)(Sin + (pt * 16 + fr) * 72 + ks * 32 + fq * 8); yo[pt] = __builtin_amdgcn_mfma_f32_16x16x32_bf16(a, bv, yo[pt], 0, 0, 0); } }
        const float Dh = P.in[18][layer * 16 + hd];
#pragma unroll
        for (int pt = 0; pt < 4; ++pt) { const int p = pt * 16 + fr; float yy[4];
#pragma unroll
            for (int j = 0; j < 4; ++j) { const int t = 16 * w + fq * 4 + j; const float et = __expf(acs_t[j]), idt = 1.f / DT[hh * 128 + t];
                const float x = bf2f(XT4[xt_idx(hh * 64 + p, t)]) * idt;
                float y = yd[pt][j] + et * yo[pt][j] + Dh * x; y *= silu_fast(bf2f(zv[j][pt])); ssq[j] += y * y; yy[j] = y; }
            yg[hh][pt][0] = pk2(yy[0], yy[1]); yg[hh][pt][1] = pk2(yy[2], yy[3]); }
    }
    const float* ng = P.in[19] + layer * 1024 + g * 256 + fr;
#pragma unroll
    for (int j = 0; j < 4; ++j) { float v = ssq[j];
#pragma unroll
        for (int o = 8; o > 0; o >>= 1) v += shx(v, o, lane);
        ssq[j] = rsqrtf(v * (1.f / 256.f) + EPSF); }
#pragma unroll
    for (int hh = 0; hh < 4; ++hh)
#pragma unroll
        for (int pt = 0; pt < 4; ++pt) { const float gv = ng[(hh * 4 + pt) * 16];
#pragma unroll
            for (int j = 0; j < 4; ++j) { const float yv = (j & 1) ? bfhi(yg[hh][pt][j >> 1]) : bflo(yg[hh][pt][j >> 1]); if (!dry) *(zrow[j] + (hh * 4 + pt) * 16) = f2bf(yv * ssq[j] * gv); } }
}
__device__ __forceinline__ void phase_ssd_scan(const Params& P, int layer) {
    float* states = (float*)(P.ws + WS_SSDST); const float* decs = (const float*)(P.ws + WS_SSDDEC);
    for (int e = blockIdx.x * 512 + otid(); e < 4 * 16 * 4096; e += gridDim.x * 512) {
        const int b = e >> 16, hd = (e >> 12) & 15, pn = e & 4095; float carry = 0.f;
        float st[32], dc[32];
#pragma unroll
        for (int c = 0; c < 32; ++c) { st[c] = states[((size_t)((b * 32 + c) * 16 + hd)) * 4096 + pn]; dc[c] = decs[(b * 32 + c) * 16 + hd]; }
#pragma unroll
        for (int c = 0; c < 32; ++c) { states[((size_t)((b * 32 + c) * 16 + hd)) * 4096 + pn] = carry; carry = carry * dc[c] + st[c]; }
        P.out[O_PSSM + ((size_t)((layer * 4 + b) * 16 + hd)) * 4096 + pn] = carry;
    }
}

__device__ __forceinline__ void attn_prompt_item(const Params& P, int layer, int item, unsigned char* lds, bool dry = false) {
    const int tid = otid(), w = tid >> 6, lane = tid & 63, fr = lane & 15, fq = lane >> 4;
    const int b = item >> 7, nb = (item >> 2) & 31, kvh = item & 3;
    bf16_t* proj = (bf16_t*)(P.ws + WS_PROJ);
    bf16_t* Ks = (bf16_t*)lds;
    bf16_t* Vt = Ks + 256 * 72;
    bf16_t* Pw = Vt + 64 * 280 + w * 16 * 168;
    const long rowK0 = (long)b * 4096 + (long)(nb - 1) * 128;
    const bf16_t* qbase = proj + ((size_t)b * 4096 + (size_t)nb * 128 + w * 16 + fr) * LDP + C_Q + kvh * 256 + fq * 8;
    bf16x8 qa[2], qn[2];
#pragma unroll
    for (int ks = 0; ks < 2; ++ks) { qa[ks] = *(const bf16x8*)(qbase + ks * 32); qn[ks] = qa[ks]; }
    __syncthreads();
#pragma unroll
    for (int idx = tid; idx < 2048; idx += 512) { const int kj = idx >> 3, seg = idx & 7; u32x4 v = (u32x4){0u, 0u, 0u, 0u};
        if (nb > 0 || kj >= 128) v = *(const u32x4*)(proj + (size_t)(rowK0 + kj) * LDP + C_K + kvh * 64 + seg * 8);
        *(u32x4*)(Ks + kj * 72 + seg * 8) = v; }
#pragma unroll
    for (int idx = tid; idx < 2048; idx += 512) { const int seg = idx >> 8, kj = idx & 255; u32x4 v = (u32x4){0u, 0u, 0u, 0u};
        if (nb > 0 || kj >= 128) v = *(const u32x4*)(proj + (size_t)(rowK0 + kj) * LDP + C_V + kvh * 64 + seg * 8);
#pragma unroll
        for (int i = 0; i < 8; ++i) Vt[(seg * 8 + i) * 280 + kj] = (bf16_t)((v[i >> 1] >> ((i & 1) * 16)) & 0xffffu); }
    for (int idx = tid; idx < 64 * 24; idx += 512) { const int d = idx / 24, cc = 256 + idx % 24; Vt[d * 280 + cc] = 0; }
    for (int i = lane; i < 384; i += 64) Pw[(i / 24) * 168 + 144 + i % 24] = 0;
    __syncthreads();
    const int q0 = w * 16;
    const size_t qrow0 = (size_t)b * 4096 + (size_t)nb * 128 + q0;
    for (int gi = 0; gi < 4; ++gi) {
        const int hq = kvh * 4 + gi;
        const float slope = exp2f(-0.5f * (float)(hq + 1));
        const float sink = P.in[21][layer * 16 + hq];
        if (gi < 3) {
#pragma unroll
            for (int ks = 0; ks < 2; ++ks) qn[ks] = *(const bf16x8*)(qbase + (gi + 1) * 64 + ks * 32); }
        f32x4 S[9];
#pragma unroll
        for (int nt = 0; nt < 9; ++nt) { f32x4 a = (f32x4){0.f, 0.f, 0.f, 0.f}; const bf16_t* kp = Ks + (q0 + nt * 16 + fr) * 72 + fq * 8;
#pragma unroll
            for (int ks = 0; ks < 2; ++ks) { const bf16x8 kb = *(const bf16x8*)(kp + ks * 32); a = __builtin_amdgcn_mfma_f32_16x16x32_bf16(qa[ks], kb, a, 0, 0, 0); }
            S[nt] = a; }
        float mx[4] = {-INFINITY, -INFINITY, -INFINITY, -INFINITY};
#pragma unroll
        for (int nt = 0; nt < 9; ++nt)
#pragma unroll
            for (int j = 0; j < 4; ++j) { const int dist = (fq * 4 + j) - (nt * 16 + fr) + 128; const bool valid = dist >= 0 && dist <= 128 && (nb > 0 || (q0 + nt * 16 + fr) >= 128);
                const float s = valid ? S[nt][j] * 0.125f - slope * (float)dist : -INFINITY; S[nt][j] = s; mx[j] = fmaxf(mx[j], s); }
        float inv[4];
#pragma unroll
        for (int j = 0; j < 4; ++j) { float m = mx[j];
#pragma unroll
            for (int o = 8; o > 0; o >>= 1) m = fmaxf(m, shx(m, o, lane));
            m = fmaxf(m, sink); float sum = 0.f;
#pragma unroll
            for (int nt = 0; nt < 9; ++nt) { const float p = __expf(S[nt][j] - m); S[nt][j] = p; sum += p; }
#pragma unroll
            for (int o = 8; o > 0; o >>= 1) sum += shx(sum, o, lane);
            inv[j] = 1.f / (sum + __expf(sink - m)); }
#pragma unroll
        for (int nt = 0; nt < 9; ++nt)
#pragma unroll
            for (int j = 0; j < 4; ++j) Pw[(fq * 4 + j) * 168 + nt * 16 + fr] = f2bf(S[nt][j]);
        asm volatile("s_waitcnt lgkmcnt(0)" ::: "memory"); __builtin_amdgcn_wave_barrier();
        f32x4 O[4];
#pragma unroll
        for (int dt = 0; dt < 4; ++dt) O[dt] = (f32x4){0.f, 0.f, 0.f, 0.f};
#pragma unroll
        for (int ks = 0; ks < 5; ++ks) { const bf16x8 pa = *(const bf16x8*)(Pw + fr * 168 + ks * 32 + fq * 8);
#pragma unroll
            for (int dt = 0; dt < 4; ++dt) { const bf16x8 vb = *(const bf16x8*)(Vt + (dt * 16 + fr) * 280 + q0 + ks * 32 + fq * 8); O[dt] = __builtin_amdgcn_mfma_f32_16x16x32_bf16(pa, vb, O[dt], 0, 0, 0); } }
        asm volatile("s_waitcnt lgkmcnt(0)" ::: "memory"); __builtin_amdgcn_wave_barrier();
#pragma unroll
        for (int dt = 0; dt < 4; ++dt)
#pragma unroll
            for (int j = 0; j < 4; ++j) { if (!dry) proj[(qrow0 + fq * 4 + j) * LDP + C_Q + hq * 64 + dt * 16 + fr] = f2bf(O[dt][j] * inv[j]); }
        qa[0] = qn[0]; qa[1] = qn[1];
    }
    if (nb == 31) {
        for (int idx = tid; idx < 128 * 64; idx += 512) { const int t = idx >> 6, d = idx & 63; const size_t row = (size_t)b * 4096 + 3968 + t;
            const size_t o = ((size_t)((layer * 4 + b) * 128 + t)) * 256 + kvh * 64 + d;
            P.out[O_PK + o] = bf2f(proj[row * LDP + C_K + kvh * 64 + d]); P.out[O_PV + o] = bf2f(proj[row * LDP + C_V + kvh * 64 + d]); }
    }
}
__device__ __forceinline__ void attn_sample_item(const Params& P, int layer, int item, float* L, bool dry = false) {
    const int tid = otid(), w = tid >> 6, lane = tid & 63;
    const int sb = item >> 2, kvh = item & 3, r0 = NPR + sb * 4;
    bf16_t* proj = (bf16_t*)(P.ws + WS_PROJ);
    float* Kf = L; float* Vf = Kf + 132 * 65; float* Q = Vf + 132 * 65; float* Sc = Q + 16 * 64;
    const float* ck = P.in[7] + ((size_t)(layer * 128 + sb)) * 128 * 256; const float* cv = P.in[8] + ((size_t)(layer * 128 + sb)) * 128 * 256;
    __syncthreads();
    {
        f32x4 kq[4], vq[4];
#pragma unroll
        for (int i = 0; i < 4; ++i) { const int idx = tid + i * 512, j = idx >> 4, d4 = (idx & 15) * 4; kq[i] = *(const f32x4*)(ck + (size_t)j * 256 + kvh * 64 + d4); vq[i] = *(const f32x4*)(cv + (size_t)j * 256 + kvh * 64 + d4); }
#pragma unroll
        for (int i = 0; i < 4; ++i) { const int idx = tid + i * 512, j = idx >> 4, d4 = (idx & 15) * 4;
#pragma unroll
            for (int e = 0; e < 4; ++e) { Kf[j * 65 + d4 + e] = kq[i][e]; Vf[j * 65 + d4 + e] = vq[i][e]; }
            if (j >= 4) { const size_t o = ((size_t)((layer * 128 + sb) * 128 + (j - 4))) * 256 + kvh * 64 + d4; *(f32x4*)(P.out + O_SK + o) = kq[i]; *(f32x4*)(P.out + O_SV + o) = vq[i]; } }
        if (tid < 256) { const int j = 128 + (tid >> 6), d = tid & 63; const float kv = bf2f(proj[(size_t)(r0 + j - 128) * LDP + C_K + kvh * 64 + d]), vv = bf2f(proj[(size_t)(r0 + j - 128) * LDP + C_V + kvh * 64 + d]);
            Kf[j * 65 + d] = kv; Vf[j * 65 + d] = vv; const size_t o = ((size_t)((layer * 128 + sb) * 128 + (j - 4))) * 256 + kvh * 64 + d; P.out[O_SK + o] = kv; P.out[O_SV + o] = vv; }
    }
    for (int idx = tid; idx < 1024; idx += 512) { const int qr = idx >> 6, d = idx & 63; Q[idx] = bf2f(proj[(size_t)(r0 + (qr >> 2)) * LDP + C_Q + (kvh * 4 + (qr & 3)) * 64 + d]); }
    __syncthreads();
    for (int idx = tid; idx < 16 * 132; idx += 512) { const int qr = idx / 132, j = idx - qr * 132; const int dist = 128 + (qr >> 2) - j; float s = -INFINITY;
        if (dist >= 0 && dist <= 128) { float a = 0.f;
#pragma unroll 8
            for (int d = 0; d < 64; ++d) a += Q[qr * 64 + d] * Kf[j * 65 + d];
            s = a * 0.125f - exp2f(-0.5f * (float)(kvh * 4 + (qr & 3) + 1)) * (float)dist; }
        Sc[qr * 136 + j] = s; }
    __syncthreads();
    for (int rr = 0; rr < 2; ++rr) { const int qr = w * 2 + rr; const float sink = P.in[21][layer * 16 + kvh * 4 + (qr & 3)];
        float v0 = Sc[qr * 136 + lane], v1 = Sc[qr * 136 + 64 + lane], v2 = lane < 4 ? Sc[qr * 136 + 128 + lane] : -INFINITY;
        float m = fmaxf(fmaxf(v0, v1), v2);
#pragma unroll
        for (int o = 32; o > 0; o >>= 1) m = fmaxf(m, shx(m, o, lane));
        m = fmaxf(m, sink);
        v0 = __expf(v0 - m); v1 = __expf(v1 - m); v2 = __expf(v2 - m);
        const float sum = wave_sum(v0 + v1 + v2, lane); const float inv = 1.f / (sum + __expf(sink - m));
        Sc[qr * 136 + lane] = v0 * inv; Sc[qr * 136 + 64 + lane] = v1 * inv; if (lane < 4) Sc[qr * 136 + 128 + lane] = v2 * inv; }
    __syncthreads();
    for (int idx = tid; idx < 1024; idx += 512) { const int qr = idx >> 6, d = idx & 63; float o = 0.f;
        for (int j = 0; j < 132; ++j) o += Sc[qr * 136 + j] * Vf[j * 65 + d];
        if (!dry) proj[(size_t)(r0 + (qr >> 2)) * LDP + C_Q + (kvh * 4 + (qr & 3)) * 64 + d] = f2bf(o); }
}

__device__ __forceinline__ void gmlp_prompt_item(const Params& P, int layer, int item, unsigned char* lds, bool dry = false) {
    const int tid = otid(), w = tid >> 6, lane = tid & 63, fr = lane & 15, fq = lane >> 4;
    const int b = item >> 8, chn = (item >> 3) & 31, g = item & 7;
    const size_t r0 = (size_t)b * 4096 + (size_t)chn * 128;
    bf16_t* proj = (bf16_t*)(P.ws + WS_PROJ);
    bf16_t* VT = (bf16_t*)lds; bf16_t* Wt = VT + 128 * 136; float* MU = (float*)(Wt + 128 * 136); float* RS = MU + 128;
    __syncthreads();
#pragma unroll
    for (int hb = 0; hb < 2; ++hb) { u32x4 av[8], cv8[8];
#pragma unroll
        for (int i = 0; i < 8; ++i) { const bf16_t* vp = proj + (r0 + w * 16 + hb * 8 + i) * LDP + C_UV + 1024 + lane * 16; av[i] = *(const u32x4*)vp; cv8[i] = *(const u32x4*)(vp + 8); }
#pragma unroll
        for (int i = 0; i < 8; ++i) { const int t = w * 16 + hb * 8 + i; float s = 0.f, sq = 0.f;
#pragma unroll
            for (int k = 0; k < 4; ++k) { float x0 = bflo(av[i][k]), x1 = bfhi(av[i][k]), x2 = bflo(cv8[i][k]), x3 = bfhi(cv8[i][k]); s += x0 + x1 + x2 + x3; sq += x0 * x0 + x1 * x1 + x2 * x2 + x3 * x3; }
            s = wave_sum(s, lane); sq = wave_sum(sq, lane);
            if (lane == 0) { const float mean = s * (1.f / 1024.f); const float var = fmaxf(sq * (1.f / 1024.f) - mean * mean, 0.f); MU[t] = mean; RS[t] = rsqrtf(var + EPSF); } } }
    const float* Wg = P.in[24] + ((size_t)(layer * 8 + g)) * 16384;
#pragma unroll
    for (int idx = tid; idx < 4096; idx += 512) { const int t = idx >> 5, s4 = (idx & 31) * 4; const f32x4 wv = *(const f32x4*)(Wg + t * 128 + s4);
        u32x2 o; o[0] = pk2(s4 <= t ? wv[0] : 0.f, s4 + 1 <= t ? wv[1] : 0.f); o[1] = pk2(s4 + 2 <= t ? wv[2] : 0.f, s4 + 3 <= t ? wv[3] : 0.f);
        *(u32x2*)(Wt + t * 136 + s4) = o; }
    __syncthreads();
    const float* lg = P.in[22] + layer * 1024 + g * 128; const float* lb = P.in[23] + layer * 1024 + g * 128;
#pragma unroll
    for (int idx = tid; idx < 2048; idx += 512) { const int s = idx & 127, fs = idx >> 7; const u32x4 v = *(const u32x4*)(proj + (r0 + s) * LDP + C_UV + 1024 + g * 128 + fs * 8);
        const float mu = MU[s], rs = RS[s];
#pragma unroll
        for (int i = 0; i < 8; ++i) { const int f = fs * 8 + i; const float x = (i & 1) ? bfhi(v[i >> 1]) : bflo(v[i >> 1]); VT[f * 136 + s] = f2bf((x - mu) * rs * lg[f] + lb[f]); } }
    __syncthreads();
    f32x4 acc[8];
#pragma unroll
    for (int ft = 0; ft < 8; ++ft) acc[ft] = (f32x4){0.f, 0.f, 0.f, 0.f};
    const int nks = (16 * w + 15) / 32 + 1;
    for (int ks = 0; ks < nks; ++ks) { const bf16x8 a = *(const bf16x8*)(Wt + (w * 16 + fr) * 136 + ks * 32 + fq * 8);
#pragma unroll
        for (int ft = 0; ft < 8; ++ft) { const bf16x8 bb = *(const bf16x8*)(VT + (ft * 16 + fr) * 136 + ks * 32 + fq * 8); acc[ft] = __builtin_amdgcn_mfma_f32_16x16x32_bf16(a, bb, acc[ft], 0, 0, 0); } }
    bf16_t uv[4][8]; float bsv[4];
#pragma unroll
    for (int j = 0; j < 4; ++j) { const int t = w * 16 + fq * 4 + j; bsv[j] = P.in[25][(layer * 8 + g) * 128 + t];
#pragma unroll
        for (int ft = 0; ft < 8; ++ft) uv[j][ft] = proj[(r0 + t) * LDP + C_UV + g * 128 + ft * 16 + fr]; }
#pragma unroll
    for (int j = 0; j < 4; ++j) { const int t = w * 16 + fq * 4 + j;
#pragma unroll
        for (int ft = 0; ft < 8; ++ft) { if (!dry) proj[(r0 + t) * LDP + C_UV + g * 128 + ft * 16 + fr] = f2bf(gelu_fast(bf2f(uv[j][ft])) * (acc[ft][j] + bsv[j])); } }
}
__device__ __forceinline__ void gmlp_sample_item(const Params& P, int layer, int sb, float* L) {
    const int tid = otid(), w = tid >> 6, lane = tid & 63; const size_t r0 = NPR + sb * 4;
    bf16_t* proj = (bf16_t*)(P.ws + WS_PROJ);
    float* Vn = L; float* MU = Vn + 4096; float* RS = MU + 4;
    __syncthreads();
    if (w < 4) { const bf16_t* vp = proj + (r0 + w) * LDP + C_UV + 1024 + lane * 16; const u32x4 a = *(const u32x4*)vp, c = *(const u32x4*)(vp + 8); float s = 0.f, sq = 0.f;
#pragma unroll
        for (int k = 0; k < 4; ++k) { float x0 = bflo(a[k]), x1 = bfhi(a[k]), x2 = bflo(c[k]), x3 = bfhi(c[k]); s += x0 + x1 + x2 + x3; sq += x0 * x0 + x1 * x1 + x2 * x2 + x3 * x3; }
        s = wave_sum(s, lane); sq = wave_sum(sq, lane);
        if (lane == 0) { const float mean = s * (1.f / 1024.f); const float var = fmaxf(sq * (1.f / 1024.f) - mean * mean, 0.f); MU[w] = mean; RS[w] = rsqrtf(var + EPSF); } }
    __syncthreads();
    for (int idx = tid; idx < 4096; idx += 512) { const int t = idx >> 10, c = idx & 1023;
        const float x = bf2f(proj[(r0 + t) * LDP + C_UV + 1024 + c]); const float vn = (x - MU[t]) * RS[t] * P.in[22][layer * 1024 + c] + P.in[23][layer * 1024 + c];
        Vn[idx] = vn; P.out[O_SGMV + ((size_t)((layer * 128 + sb) * 4 + t)) * 1024 + c] = vn; }
    __syncthreads();
    for (int idx = tid; idx < 4096; idx += 512) { const int t = idx >> 10, c = idx & 1023, g = c >> 7;
        const float* Wg = P.in[24] + ((size_t)(layer * 8 + g)) * 16384 + t * 128; float m = P.in[25][(layer * 8 + g) * 128 + t];
        for (int s = 0; s <= t; ++s) m += Wg[s] * Vn[s * 1024 + c];
        bf16_t* ap = proj + (r0 + t) * LDP + C_UV + c; *ap = f2bf(gelu_fast(bf2f(*ap)) * m); }
}

template <int R>
__device__ __forceinline__ void shortconv_rows(const Params& P, int layer, int r0, int tid, bool dry) {
    bf16_t* proj = (bf16_t*)(P.ws + WS_PROJ);
    const float* cw = P.in[20] + layer * 3 * 1024;
    const int j = tid * 2; const int ss = seq_start(r0); const bool havePrev = (r0 - 2 >= ss);
    unsigned cg[R + 2], xs[R + 2], bg[R];
#pragma unroll
    for (int k = 0; k < R + 2; ++k) { cg[k] = 0u; xs[k] = 0u;
        if (k >= 2 || havePrev) { const bf16_t* rp = proj + (size_t)(r0 - 2 + k) * LDP + C_BCX + j; cg[k] = *(const unsigned*)(rp + 1024); xs[k] = *(const unsigned*)(rp + 2048); } }
#pragma unroll
    for (int k = 0; k < R; ++k) bg[k] = *(const unsigned*)(proj + (size_t)(r0 + k) * LDP + C_BCX + j);
    float pr0[R + 2], pr1[R + 2];
#pragma unroll
    for (int k = 0; k < R + 2; ++k) { pr0[k] = bflo(cg[k]) * bflo(xs[k]); pr1[k] = bfhi(cg[k]) * bfhi(xs[k]); }
    if (!havePrev && r0 >= NPR) { const float* st = P.in[6] + ((size_t)(layer * 128 + ((r0 - NPR) >> 2)) * 2) * 1024 + j; pr0[0] = st[0]; pr1[0] = st[1]; pr0[1] = st[1024]; pr1[1] = st[1025]; }
    const float w0a = cw[j], w0b = cw[j + 1], w1a = cw[1024 + j], w1b = cw[1025 + j], w2a = cw[2048 + j], w2b = cw[2049 + j];
#pragma unroll
    for (int k = 0; k < R; ++k) { const float y0 = w0a * pr0[k] + w1a * pr0[k + 1] + w2a * pr0[k + 2], y1 = w0b * pr1[k] + w1b * pr1[k + 1] + w2b * pr1[k + 2];
        if (!dry) *(unsigned*)(proj + (size_t)(r0 + k) * LDP + C_BCX + j) = pk2(bflo(bg[k]) * y0, bfhi(bg[k]) * y1);
        const int r = r0 + k;
        if (r < NPR) { const int l = r & 4095; if (l >= 4094) { float* o = P.out + O_PSCC + ((size_t)((layer * 4 + (r >> 12)) * 2 + (l - 4094))) * 1024 + j; o[0] = pr0[k + 2]; o[1] = pr1[k + 2]; } }
        else { const int l = (r - NPR) & 3; if (l >= 2) { float* o = P.out + O_SSCC + ((size_t)((layer * 128 + ((r - NPR) >> 2)) * 2 + (l - 2))) * 1024 + j; o[0] = pr0[k + 2]; o[1] = pr1[k + 2]; } }
    }
}
__device__ __forceinline__ void shortconv_item(const Params& P, int layer, int item, bool dry = false) {
    const int tid = otid();
    if (item < 1024) shortconv_rows<16>(P, layer, item * 16, tid, dry); else shortconv_rows<4>(P, layer, NPR + (item - 1024) * 4, tid, dry);
}
__device__ __forceinline__ void ssdconv_state_item(const Params& P, int layer, int sq) {
    const bf16_t* proj = (const bf16_t*)(P.ws + WS_PROJ);
    const size_t rbase = sq < 4 ? (size_t)sq * 4096 + 4093 : (size_t)NPR + (size_t)(sq - 4) * 4 + 1;
    float* o = sq < 4 ? P.out + O_PSSDC + (size_t)(layer * 4 + sq) * 3 * 1536 : P.out + O_SSSDC + (size_t)(layer * 128 + (sq - 4)) * 3 * 1536;
    const int tid = otid(); bf16_t v[9];
#pragma unroll
    for (int i = 0; i < 9; ++i) { const int e = tid + i * 512, t = e / 1536, c = e - t * 1536; v[i] = proj[(rbase + t) * LDP + C_XBC + c]; }
#pragma unroll
    for (int i = 0; i < 9; ++i) o[tid + i * 512] = bf2f(v[i]);
}

template <int R>
__device__ __forceinline__ void ffn_act_unit(const Params& P, int layer, int r0, int oc) {
    const bf16_t* up = (const bf16_t*)(P.ws + WS_PROJ); bf16_t* act = (bf16_t*)(P.ws + WS_PROJ + UP_BYTES);
    const float* cw = P.in[30] + (size_t)layer * 3 * 5632; const float* cb = P.in[31] + (size_t)layer * 5632;
    const int j0 = oc * 8;
    float wa[3][8], wg[3][8], ba[8], bgv[8], pa[2][8], pg[2][8];
#pragma unroll
    for (int k = 0; k < 3; ++k) { const f32x4 a0 = *(const f32x4*)(cw + k * 5632 + j0), a1 = *(const f32x4*)(cw + k * 5632 + j0 + 4), g0 = *(const f32x4*)(cw + k * 5632 + 2816 + j0), g1 = *(const f32x4*)(cw + k * 5632 + 2816 + j0 + 4);
#pragma unroll
        for (int i = 0; i < 4; ++i) { wa[k][i] = a0[i]; wa[k][4 + i] = a1[i]; wg[k][i] = g0[i]; wg[k][4 + i] = g1[i]; } }
    { const f32x4 a0 = *(const f32x4*)(cb + j0), a1 = *(const f32x4*)(cb + j0 + 4), g0 = *(const f32x4*)(cb + 2816 + j0), g1 = *(const f32x4*)(cb + 2816 + j0 + 4);
#pragma unroll
      for (int i = 0; i < 4; ++i) { ba[i] = a0[i]; ba[4 + i] = a1[i]; bgv[i] = g0[i]; bgv[4 + i] = g1[i]; } }
    const int ss = seq_start(r0); const bool havePrev = (r0 - 2 >= ss);
#pragma unroll
    for (int k = 0; k < 2; ++k) {
        if (havePrev) { const u32x4 ua = *(const u32x4*)(up + (size_t)(r0 - 2 + k) * 5632 + j0), ug = *(const u32x4*)(up + (size_t)(r0 - 2 + k) * 5632 + 2816 + j0);
#pragma unroll
            for (int i = 0; i < 4; ++i) { pa[k][2 * i] = bflo(ua[i]); pa[k][2 * i + 1] = bfhi(ua[i]); pg[k][2 * i] = bflo(ug[i]); pg[k][2 * i + 1] = bfhi(ug[i]); } }
        else if (r0 >= NPR) { const float* pp = P.in[9] + ((size_t)(layer * 128 + ((r0 - NPR) >> 2)) * 2 + k) * 5632;
#pragma unroll
            for (int i = 0; i < 8; ++i) { pa[k][i] = pp[j0 + i]; pg[k][i] = pp[2816 + j0 + i]; } }
        else {
#pragma unroll
            for (int i = 0; i < 8; ++i) { pa[k][i] = 0.f; pg[k][i] = 0.f; } } }
#pragma unroll
    for (int kb = 0; kb < R; kb += 4) { u32x4 ua[4], ug[4];
#pragma unroll
        for (int q = 0; q < 4; ++q) { ua[q] = *(const u32x4*)(up + (size_t)(r0 + kb + q) * 5632 + j0); ug[q] = *(const u32x4*)(up + (size_t)(r0 + kb + q) * 5632 + 2816 + j0); }
#pragma unroll
        for (int q = 0; q < 4; ++q) { const int r = r0 + kb + q; float ca[8], cgv[8], o[8];
#pragma unroll
            for (int i = 0; i < 4; ++i) { ca[2 * i] = bflo(ua[q][i]); ca[2 * i + 1] = bfhi(ua[q][i]); cgv[2 * i] = bflo(ug[q][i]); cgv[2 * i + 1] = bfhi(ug[q][i]); }
#pragma unroll
            for (int i = 0; i < 8; ++i) { const float a = ba[i] + wa[0][i] * pa[0][i] + wa[1][i] * pa[1][i] + wa[2][i] * ca[i], g = bgv[i] + wg[0][i] * pg[0][i] + wg[1][i] * pg[1][i] + wg[2][i] * cgv[i];
                o[i] = silu_fast(a) * g; pa[0][i] = pa[1][i]; pa[1][i] = ca[i]; pg[0][i] = pg[1][i]; pg[1][i] = cgv[i]; }
            u32x4 ov; ov[0] = pk2(o[0], o[1]); ov[1] = pk2(o[2], o[3]); ov[2] = pk2(o[4], o[5]); ov[3] = pk2(o[6], o[7]);
            *(u32x4*)(act + (size_t)r * 2816 + j0) = ov;
            float* so = nullptr;
            if (r < NPR) { const int l = r & 4095; if (l >= 4094) so = P.out + O_PFFC + ((size_t)((layer * 4 + (r >> 12)) * 2 + (l - 4094))) * 5632; }
            else { const int l = (r - NPR) & 3; if (l >= 2) so = P.out + O_SFFC + ((size_t)((layer * 128 + ((r - NPR) >> 2)) * 2 + (l - 2))) * 5632; }
            if (so) {
#pragma unroll
                for (int i = 0; i < 8; ++i) { so[j0 + i] = ca[i]; so[2816 + j0 + i] = cgv[i]; } }
        } }
}
__device__ __forceinline__ void phase_ffn_act(const Params& P, int layer) {
    constexpr int NU_P = 2048 * 352, NU_S = 128 * 352;
    for (int u = blockIdx.x * 512 + otid(); u < NU_P + NU_S; u += gridDim.x * 512) {
        if (u < NU_P) { const int rb = u / 352, oc = u - rb * 352; ffn_act_unit<8>(P, layer, rb * 8, oc); }
        else { const int v = u - NU_P, sq = v / 352, oc = v - sq * 352; ffn_act_unit<4>(P, layer, NPR + sq * 4, oc); }
    }
}

__device__ __forceinline__ void sgemm_partial(const bf16_t* A, int lda, const bf16_t* Bt, int ldb, int K, int row0, int col0, float* red, int tid) {
    const int w = tid >> 6, lane = tid & 63, fr = lane & 15, fq = lane >> 4;
    const int kw = K >> 3, k0 = w * kw;
    f32x4 acc[2][4];
#pragma unroll
    for (int mt = 0; mt < 2; ++mt)
#pragma unroll
        for (int nt = 0; nt < 4; ++nt) acc[mt][nt] = (f32x4){0.f, 0.f, 0.f, 0.f};
    const bf16_t* ap = A + (size_t)(row0 + fr) * lda + k0 + fq * 8;
    const bf16_t* bp = Bt + (size_t)(col0 + fr) * ldb + k0 + fq * 8;
    const int nks = kw >> 5;
#pragma unroll 4
    for (int ks = 0; ks < nks; ++ks) { bf16x8 a[2], b[4];
#pragma unroll
        for (int mt = 0; mt < 2; ++mt) a[mt] = *(const bf16x8*)(ap + (size_t)mt * 16 * lda + ks * 32);
#pragma unroll
        for (int nt = 0; nt < 4; ++nt) b[nt] = *(const bf16x8*)(bp + (size_t)nt * 16 * ldb + ks * 32);
#pragma unroll
        for (int mt = 0; mt < 2; ++mt)
#pragma unroll
            for (int nt = 0; nt < 4; ++nt) acc[mt][nt] = __builtin_amdgcn_mfma_f32_16x16x32_bf16(a[mt], b[nt], acc[mt][nt], 0, 0, 0); }
#pragma unroll
    for (int mt = 0; mt < 2; ++mt)
#pragma unroll
        for (int nt = 0; nt < 4; ++nt)
#pragma unroll
            for (int j = 0; j < 4; ++j) red[(w * 32 + mt * 16 + fq * 4 + j) * 64 + nt * 16 + fr] = acc[mt][nt][j];
}
__device__ __forceinline__ f32x4 sgemm_reduce(const float* red, int tid) {
    const int row = tid >> 4, c4 = (tid & 15) * 4; f32x4 sacc = (f32x4){0.f, 0.f, 0.f, 0.f};
#pragma unroll
    for (int w = 0; w < 8; ++w) sacc += *(const f32x4*)(red + (w * 32 + row) * 64 + c4);
    return sacc;
}
__device__ __forceinline__ void sg_load4(const bf16_t* ap, int lda, const bf16_t* bp, int ldb, bf16x8 (&a)[4][2], bf16x8 (&b)[4][4]) {
#pragma unroll
    for (int ks = 0; ks < 4; ++ks) {
#pragma unroll
        for (int mt = 0; mt < 2; ++mt) a[ks][mt] = *(const bf16x8*)(ap + (size_t)mt * 16 * lda + ks * 32);
#pragma unroll
        for (int nt = 0; nt < 4; ++nt) b[ks][nt] = *(const bf16x8*)(bp + (size_t)nt * 16 * ldb + ks * 32); }
}
__device__ __forceinline__ void sample_branch(const Params& P, int layer, float* red) {
    const int tid = otid(), w = tid >> 6, lane = tid & 63, fr = lane & 15, fq = lane >> 4;
    const bf16_t* proj = (const bf16_t*)(P.ws + WS_PROJ); bf16_t* hbuf = (bf16_t*)(P.ws + WS_H);
    for (int piece = blockIdx.x; piece < 256; piece += gridDim.x) {
        const int row0 = (piece >> 4) * 32, col0 = (piece & 15) * 64; const size_t r = NPR + row0 + (tid >> 4); const int c = col0 + (tid & 15) * 4;
        const bf16_t* abase = proj + (size_t)(NPR + row0 + fr) * LDP + w * 128 + fq * 8;
        const bf16_t* bbase = (const bf16_t*)(P.ws + WS_WBR) + (size_t)layer * 4 * 1048576 + (size_t)(col0 + fr) * 1024 + w * 128 + fq * 8;
        bf16x8 a[4][2], b[4][4];
        sg_load4(abase + C_Z, LDP, bbase, 1024, a, b);
        f32x4 sum = (f32x4){0.f, 0.f, 0.f, 0.f};
        for (int z = 0; z < 4; ++z) {
            f32x4 acc[2][4];
#pragma unroll
            for (int mt = 0; mt < 2; ++mt)
#pragma unroll
                for (int nt = 0; nt < 4; ++nt) acc[mt][nt] = (f32x4){0.f, 0.f, 0.f, 0.f};
#pragma unroll
            for (int ks = 0; ks < 4; ++ks)
#pragma unroll
                for (int mt = 0; mt < 2; ++mt)
#pragma unroll
                    for (int nt = 0; nt < 4; ++nt) acc[mt][nt] = __builtin_amdgcn_mfma_f32_16x16x32_bf16(a[ks][mt], b[ks][nt], acc[mt][nt], 0, 0, 0);
            if (z < 3) { const int ao = z == 0 ? C_BCX : (z == 1 ? C_Q : C_UV); sg_load4(abase + ao, LDP, bbase + (size_t)(z + 1) * 1048576, 1024, a, b); }
            const u32x2 gv = *(const u32x2*)(proj + r * LDP + C_GATE + z * 1024 + c);
            __syncthreads();
#pragma unroll
            for (int mt = 0; mt < 2; ++mt)
#pragma unroll
                for (int nt = 0; nt < 4; ++nt)
#pragma unroll
                    for (int j = 0; j < 4; ++j) red[(w * 32 + mt * 16 + fq * 4 + j) * 64 + nt * 16 + fr] = acc[mt][nt][j];
            __syncthreads();
            const f32x4 v = sgemm_reduce(red, tid);
            sum[0] += sigmoid_fast(bflo(gv[0])) * v[0]; sum[1] += sigmoid_fast(bfhi(gv[0])) * v[1]; sum[2] += sigmoid_fast(bflo(gv[1])) * v[2]; sum[3] += sigmoid_fast(bfhi(gv[1])) * v[3];
        }
        u32x2 o; o[0] = pk2(sum[0], sum[1]); o[1] = pk2(sum[2], sum[3]); *(u32x2*)(hbuf + r * 1024 + c) = o;
        __syncthreads();
    }
}
__device__ __forceinline__ void sample_resid(const Params& P, const bf16_t* A, int lda, const bf16_t* Bt, int K, const float* xin_s, float* xout, const float* ga, float* red) {
    const int tid = otid();
    for (int piece = blockIdx.x; piece < 256; piece += gridDim.x) {
        const int row0 = (piece >> 4) * 32, col0 = (piece & 15) * 64; const int rs = row0 + (tid >> 4), c = col0 + (tid & 15) * 4;
        __syncthreads();
        sgemm_partial(A, lda, Bt, K, K, row0, col0, red, tid);
        __syncthreads();
        const f32x4 v = sgemm_reduce(red, tid);
        const f32x4 xv = *(const f32x4*)(xin_s + (size_t)rs * 1024 + c), gv = *(const f32x4*)(ga + (size_t)(4 + (rs >> 2)) * 6144 + c);
        *(f32x4*)(xout + (size_t)(NPR + rs) * 1024 + c) = xv + gv * v;
    }
}

__device__ __forceinline__ void grid_bar(unsigned* ctr, unsigned& epoch) {
    asm volatile("s_waitcnt vmcnt(0) lgkmcnt(0)" ::: "memory");
    __syncthreads();
    epoch += 1;
    if (otid() == 0) {
        __builtin_amdgcn_fence(__ATOMIC_RELEASE, "agent");
        asm volatile("s_waitcnt vmcnt(0) lgkmcnt(0)" ::: "memory");
        __hip_atomic_fetch_add(ctr, 1u, __ATOMIC_RELAXED, __HIP_MEMORY_SCOPE_AGENT);
        const unsigned target = epoch * gridDim.x;
        while (__hip_atomic_load(ctr, __ATOMIC_RELAXED, __HIP_MEMORY_SCOPE_AGENT) < target) __builtin_amdgcn_s_sleep(1);
        __builtin_amdgcn_fence(__ATOMIC_ACQUIRE, "agent");
        asm volatile("s_waitcnt vmcnt(0) lgkmcnt(0)" ::: "memory");
    }
    __syncthreads();
}

#ifndef PHMASK
#define PHMASK 0xFFFFFFFF
#endif
#define EN(x) ((PHMASK >> (x)) & 1)
#ifndef DRYM
#define DRYM 0
#endif
#ifndef DBL
#define DBL 0
#endif
#define REP(x) (((DBL >> (x)) & 1) ? 2 : 1)
constexpr int PH_PER_LAYER = 11, N_PHASES = 2 + 4 * PH_PER_LAYER + 1;

__global__ void __launch_bounds__(512, 2) mega_fwd(Params PK) {
    extern __shared__ __attribute__((aligned(16))) unsigned char lds_raw[];
    cg::grid_group grid = cg::this_grid();
    LAS unsigned char* ldsl = (LAS unsigned char*)lds_raw;
    unsigned epoch = 0;
    for (int ph = PK.ph_lo; ph < PK.ph_hi; ++ph) {
        Params P = PK;
        { unsigned char* w_ = P.ws; asm volatile("" : "+s"(w_)); P.ws = w_; float* o_ = P.out; asm volatile("" : "+s"(o_)); P.out = o_; }
        unsigned* barctr = (unsigned*)(P.ws + WS_BAR);
        bf16_t* proj = (bf16_t*)(P.ws + WS_PROJ);
        bf16_t* hbuf = (bf16_t*)(P.ws + WS_H);
        float* xbuf = P.out;
        float* mod = (float*)(P.ws + WS_MOD);
        if (ph == 0) { for (int rp = 0; rp < REP(0); ++rp) phase_convert(P, (float*)lds_raw); }
        else if (ph == 1) {
            Gemm g{(const bf16_t*)(P.ws + WS_CACT), (const bf16_t*)(P.ws + WS_WADA), 1024, 1024, 1024, 1, 96, 0, 0, 0, 0, 0};
            EpiMod E{mod, P.in[11]};
            for (int rp = 0; rp < REP(1); ++rp) gemm_phase<EpiMod, 1>(ldsl, g, E);
        }
        else if (ph == N_PHASES - 1) { phase_final_norm(xbuf, P.in[33]); }
        else {
            const int layer = (ph - 2) / PH_PER_LAYER, sp = (ph - 2) % PH_PER_LAYER;
            const float* modL = mod + (size_t)layer * NCOND * 6144;
            const float* xin_p = layer == 0 ? P.in[0] : xbuf; const float* xin_s = layer == 0 ? P.in[1] : xbuf + (size_t)NPR * 1024;
            if (sp == 0) { for (int rp = 0; rp < REP(16); ++rp) phase_norm(xin_p, xin_s, P.in[12] + layer * 1024, modL, 0, 1024, hbuf); }
            else if (sp == 1) {
                Gemm g{hbuf, (const bf16_t*)(P.ws + WS_WIN) + (size_t)layer * 13568 * 1024, 1024, 1024, 1024, 66, 53, 0, 0, 0, 0, 0};
                EpiProj E{proj};
                for (int rp = 0; rp < REP(2); ++rp) gemm_phase<EpiProj, 1>(ldsl, g, E);
            }
            else if (sp == 2) {
                for (int it = blockIdx.x; it < 3972 + 256; it += gridDim.x) {
                    if (it < 512) { for (int rp = 0; rp < REP(3); ++rp) ssd_pass1_item(P, layer, it, lds_raw); }
                    else if (it < 1024) { for (int rp = (DRYM & 1) ? 0 : 1; rp < 2; ++rp) attn_prompt_item(P, layer, it - 512, lds_raw, rp == 0 && P.ph_lo == 0); }
                    else if (it < 1536) { for (int rp = (DRYM & 2) ? 0 : 1; rp < 2; ++rp) attn_sample_item(P, layer, it - 1024, (float*)lds_raw, rp == 0 && P.ph_lo == 0); }
                    else if (it < 2560) { for (int rp = (DRYM & 4) ? 0 : 1; rp < 2; ++rp) gmlp_prompt_item(P, layer, it - 1536, lds_raw, rp == 0 && P.ph_lo == 0); }
                    else if (it < 2688) { if (EN(8)) gmlp_sample_item(P, layer, it - 2560, (float*)lds_raw); }
                    else if (it < 3840) { for (int rp = (DRYM & 8) ? 0 : 1; rp < 2; ++rp) shortconv_item(P, layer, it - 2688, rp == 0 && P.ph_lo == 0); }
                    else if (it < 3972) ssdconv_state_item(P, layer, it - 3840);
                    else ssd_item<2>(P, layer, it - 3972, (float*)lds_raw);
                }
            }
            else if (sp == 3) { phase_ssd_scan(P, layer); }
            else if (sp == 4) { for (int it = blockIdx.x; it < 512; it += gridDim.x) for (int rp = (DRYM & 16) ? 0 : 1; rp < 2; ++rp) ssd_pass3_item(P, layer, it, lds_raw, rp == 0 && P.ph_lo == 0); }
            else if (sp == 5) {
                Gemm g{proj, (const bf16_t*)(P.ws + WS_WBR) + (size_t)layer * 4 * 1048576, LDP, 1024, 1024, 64, 4, C_Z, C_BCX, C_Q, C_UV, (size_t)1048576};
                EpiBranch E{proj, (float*)(P.ws + WS_MSUM), hbuf};
                for (int rp = 0; rp < REP(11); ++rp) gemm_phase<EpiBranch, 4>(ldsl, g, E);
                for (int rp = 0; rp < REP(17); ++rp) sample_branch(P, layer, (float*)lds_raw);
            }
            else if (sp == 6) {
                Gemm g{hbuf, (const bf16_t*)(P.ws + WS_WO) + (size_t)layer * 1048576, 1024, 1024, 1024, 64, 4, 0, 0, 0, 0, 0};
                EpiResid E{xin_p, xin_s, xbuf, modL + 2048};
                if (EN(12)) gemm_phase<EpiResid, 1>(ldsl, g, E);
                sample_resid(P, hbuf + (size_t)NPR * 1024, 1024, (const bf16_t*)(P.ws + WS_WO) + (size_t)layer * 1048576, 1024, xin_s, xbuf, modL + 2048, (float*)lds_raw);
            }
            else if (sp == 7) { for (int rp = 0; rp < REP(16); ++rp) phase_norm(xbuf, xbuf + (size_t)NPR * 1024, P.in[28] + layer * 1024, modL, 3072, 4096, hbuf); }
            else if (sp == 8) {
                Gemm g{hbuf, (const bf16_t*)(P.ws + WS_WUP) + (size_t)layer * 5632 * 1024, 1024, 1024, 1024, 66, 22, 0, 0, 0, 0, 0};
                EpiUp E{proj};
                for (int rp = 0; rp < REP(13); ++rp) gemm_phase<EpiUp, 1>(ldsl, g, E);
            }
            else if (sp == 9) { for (int rp = 0; rp < REP(14); ++rp) phase_ffn_act(P, layer); }
            else {
                Gemm g{(const bf16_t*)(P.ws + WS_PROJ + UP_BYTES), (const bf16_t*)(P.ws + WS_WDN) + (size_t)layer * 1024 * 2816, 2816, 2816, 2816, 64, 4, 0, 0, 0, 0, 0};
                EpiResid E{xbuf, xbuf + (size_t)NPR * 1024, xbuf, modL + 5120};
                if (EN(15)) gemm_phase<EpiResid, 1>(ldsl, g, E);
                sample_resid(P, (const bf16_t*)(P.ws + WS_PROJ + UP_BYTES) + (size_t)NPR * 2816, 2816, (const bf16_t*)(P.ws + WS_WDN) + (size_t)layer * 1024 * 2816, 2816, xbuf + (size_t)NPR * 1024, xbuf, modL + 5120, (float*)lds_raw);
            }
        }
        if (ph + 1 < P.ph_hi) { if (ph == 0) grid.sync(); else grid_bar(barctr, epoch); }
    }
}

extern "C" void kernel_launch(void* const* d_in, const int* in_sizes, int n_in, void* d_out, int out_size, void* d_ws, size_t ws_size, hipStream_t stream) {
    static int grid_blocks = 0;
    if (grid_blocks == 0) {
        if (n_in != 34 || (size_t)out_size != O_END || ws_size < WS_END + 256) { fprintf(stderr, "kernel_launch: unexpected sizes n_in %d out %d ws %zu (need %zu)\n", n_in, out_size, ws_size, (size_t)WS_END); grid_blocks = -1; return; }
        int dev = 0, cus = 0, per_cu = 0;
        (void)hipGetDevice(&dev); (void)hipDeviceGetAttribute(&cus, hipDeviceAttributeMultiprocessorCount, dev);
        if (hipFuncSetAttribute((const void*)mega_fwd, hipFuncAttributeMaxDynamicSharedMemorySize, LDS_BYTES) != hipSuccess) { fprintf(stderr, "hipFuncSetAttribute failed\n"); grid_blocks = -1; return; }
        if (hipOccupancyMaxActiveBlocksPerMultiprocessor(&per_cu, (const void*)mega_fwd, 512, LDS_BYTES) != hipSuccess || per_cu < 1) per_cu = 1;
        grid_blocks = cus * 1;
    }
    if (grid_blocks < 0) return;
    Params p{};
    for (int i = 0; i < 34; ++i) p.in[i] = (const float*)d_in[i];
    p.out = (float*)d_out; p.ws = (unsigned char*)d_ws; p.ph_lo = 0; p.ph_hi = N_PHASES;
    (void)hipMemsetAsync((unsigned char*)d_ws + WS_BAR, 0, 256, stream);
    void* args[] = {&p};
    hipError_t e = hipLaunchCooperativeKernel((const void*)mega_fwd, dim3(grid_blocks), dim3(512), args, LDS_BYTES, stream);
    if (e != hipSuccess) fprintf(stderr, "cooperative launch failed: %s (grid %d)\n", hipGetErrorString(e), grid_blocks);
}
```

```cpp
#include <hip/hip_runtime.h>
#include <hip/hip_cooperative_groups.h>
#include <cstdio>
namespace cg = cooperative_groups;

typedef unsigned short bf16_t;
typedef short bf16x8 __attribute__((ext_vector_type(8)));
typedef float f32x4 __attribute__((ext_vector_type(4)));
typedef unsigned u32x4 __attribute__((ext_vector_type(4)));
typedef unsigned u32x2 __attribute__((ext_vector_type(2)));
#define LAS __attribute__((address_space(3)))

constexpr int NTOK = 16896, NPR = 16384;
constexpr int LDP = 13568;
constexpr int C_Z = 0, C_XBC = 1024, C_DTR = 2560, C_BCX = 2576, C_Q = 5648, C_K = 6672, C_V = 6928, C_UV = 7184, C_GATE = 9232, C_END = 13328;
constexpr int NCOND = 132;
constexpr float EPSF = 1e-6f;

constexpr size_t WS_WIN = 0;
constexpr size_t WS_WBR = WS_WIN + (size_t)4 * 13568 * 1024 * 2;
constexpr size_t WS_WO = WS_WBR + (size_t)16 * 1024 * 1024 * 2;
constexpr size_t WS_WUP = WS_WO + (size_t)4 * 1024 * 1024 * 2;
constexpr size_t WS_WDN = WS_WUP + (size_t)4 * 5632 * 1024 * 2;
constexpr size_t WS_WADA = WS_WDN + (size_t)4 * 1024 * 2816 * 2;
constexpr size_t WS_CACT = WS_WADA + (size_t)4 * 6144 * 1024 * 2;
constexpr size_t WS_MOD = WS_CACT + (size_t)256 * 1024 * 2;
constexpr size_t WS_H = WS_MOD + (size_t)4 * NCOND * 6144 * 4;
constexpr size_t WS_MSUM = WS_H + (size_t)NTOK * 1024 * 2;
constexpr size_t WS_PROJ = WS_MSUM + (size_t)NTOK * 1024 * 4;
constexpr size_t WS_END = WS_PROJ + (size_t)NTOK * LDP * 2;
constexpr size_t WS_BAR = WS_END;
constexpr size_t WS_SSDST = WS_WADA;
constexpr size_t WS_SSDDEC = WS_WADA + (size_t)4 * 32 * 16 * 4096 * 4;
constexpr size_t UP_BYTES = (size_t)NTOK * 5632 * 2;

constexpr size_t O_YP = 0, O_YS = 16777216, O_PSSM = O_YS + 524288, O_PSSDC = O_PSSM + 1048576, O_PSCC = O_PSSDC + 73728,
                 O_PK = O_PSCC + 32768, O_PV = O_PK + 524288, O_PFFC = O_PV + 524288, O_SSSM = O_PFFC + 180224,
                 O_SSSDC = O_SSSM + 33554432, O_SSCC = O_SSSDC + 2359296, O_SK = O_SSCC + 1048576, O_SV = O_SK + 16777216,
                 O_SFFC = O_SV + 16777216, O_SGMV = O_SFFC + 5767168, O_END = O_SGMV + 2097152;

struct Params { const float* in[34]; float* out; unsigned char* ws; int ph_lo, ph_hi; };

constexpr int LDS_BYTES = 155648;

__device__ __forceinline__ float bf2f(bf16_t v) { return __uint_as_float((unsigned)v << 16); }
__device__ __forceinline__ float bflo(unsigned v) { return __uint_as_float(v << 16); }
__device__ __forceinline__ float bfhi(unsigned v) { return __uint_as_float(v & 0xffff0000u); }
__device__ __forceinline__ unsigned pk2(float lo, float hi) { unsigned r; asm("v_cvt_pk_bf16_f32 %0, %1, %2" : "=v"(r) : "v"(lo), "v"(hi)); return r; }
__device__ __forceinline__ bf16_t f2bf(float f) { return (bf16_t)(pk2(f, 0.f) & 0xffffu); }
__device__ __forceinline__ float shx(float v, int o, int lane) { return __int_as_float(__builtin_amdgcn_ds_bpermute((lane ^ o) << 2, __float_as_int(v))); }
__device__ __forceinline__ float wave_sum(float v, int lane) {
#pragma unroll
    for (int o = 32; o > 0; o >>= 1) v += shx(v, o, lane);
    return v;
}
__device__ __forceinline__ int otid() { int t = threadIdx.x; asm volatile("" : "+v"(t)); return t; }
__device__ __forceinline__ float sigmoidf_(float x) { return __builtin_amdgcn_rcpf(1.f + __expf(-x)); }
__device__ __forceinline__ float siluf_(float x) { return x * __builtin_amdgcn_rcpf(1.f + __expf(-x)); }
__device__ __forceinline__ float geluf_(float x) { const float u = 0.7978845608f * (x + 0.044715f * x * x * x); return x / (1.f + __expf(-2.f * u)); }
__device__ __forceinline__ float softplusf_(float x) { return fmaxf(x, 0.f) + log1pf(__expf(-fabsf(x))); }
__device__ __forceinline__ float silu_fast(float x) { return x * __builtin_amdgcn_rcpf(1.f + __expf(-x)); }
__device__ __forceinline__ float sigmoid_fast(float x) { return __builtin_amdgcn_rcpf(1.f + __expf(-x)); }
__device__ __forceinline__ float gelu_fast(float x) { const float u = 0.7978845608f * (x + 0.044715f * x * x * x); return x * __builtin_amdgcn_rcpf(1.f + __expf(-2.f * u)); }
__device__ __forceinline__ int cond_row(int r) { return r < NPR ? (r >> 12) : 4 + ((r - NPR) >> 2); }
__device__ __forceinline__ int seq_start(int r) { return r < NPR ? (r & ~4095) : NPR + ((r - NPR) & ~3); }

constexpr int BM = 256, BK = 64, HALF = 128, HTB = HALF * BK * 2;
__device__ __forceinline__ int lds_byte(int r, int c) { const int st = (r >> 4) * 2 + (c >> 5), rr = r & 15, cc = c & 31, ob = rr * 64 + cc * 2; return st * 1024 + (ob ^ (((ob >> 9) & 1) << 5)); }
__device__ __forceinline__ void stage_rc(int b, int& R, int& C) { const int st = b / 1024, sb = b % 1024, swz = sb ^ (((sb >> 9) & 1) << 5); R = (st >> 1) * 16 + swz / 64; C = (st & 1) * 32 + (swz % 64) / 2; }
__device__ __forceinline__ int perm32(int rho) { const int n = rho >> 4, i = rho & 15; return 8 * (i >> 2) + 4 * n + (i & 3); }

struct Unit { int pm, pn, z; };
struct Gemm { const bf16_t* A; const bf16_t* Bt; int lda, ldb, K, nM, nN; int ao0, ao1, ao2, ao3; size_t zB; };
__device__ __forceinline__ int gemm_aofs(const Gemm& g, int z) { return z == 0 ? g.ao0 : (z == 1 ? g.ao1 : (z == 2 ? g.ao2 : g.ao3)); }

template <int ZN> __device__ __forceinline__ bool unit_next(const Gemm& g, int i, Unit& u) {
    const int tile = i / ZN; u.z = i - tile * ZN;
    const long L = (long)tile * gridDim.x + blockIdx.x; const int nwg = g.nM * g.nN; if (L >= nwg) return false;
    int wgid = (int)L; { const int q = nwg / 8, r = nwg % 8, xcd = wgid % 8, off = wgid / 8; wgid = (xcd < r ? xcd * (q + 1) : r * (q + 1) + (xcd - r) * q) + off; }
    const int nig = 4 * g.nN, gid = wgid / nig, fm = gid * 4, gsz = (g.nM - fm) < 4 ? (g.nM - fm) : 4;
    u.pm = fm + ((wgid % nig) % gsz); u.pn = (wgid % nig) / gsz; return true;
}

template <class Epi, int ZN>
__device__ __forceinline__ void gemm_phase(LAS unsigned char* lds, const Gemm g, const Epi& E) {
    const int tid = otid(), wid = __builtin_amdgcn_readfirstlane(tid >> 6), lane = tid & 63, wr = wid >> 2, wc = wid & 3, fr = lane & 15, fq = lane >> 4;
    const int K = g.K, nt = K / BK;
    unsigned voffA[2], voffB[2];
#pragma unroll
    for (int i = 0; i < 2; ++i) { int R, C; stage_rc(tid * 16 + i * 8192, R, C); const int Rb = Epi::PERM ? ((R & ~31) + perm32(R & 31)) : R;
        voffA[i] = (unsigned)(R * g.lda + C) * 2u; voffB[i] = (unsigned)(Rb * g.ldb + C) * 2u; }
    const size_t kstep = (size_t)(BK * 2);
    const size_t hstepA = (size_t)HALF * g.lda * 2, hstepB = (size_t)HALF * g.ldb * 2;
    const size_t tstepA = 2 * hstepA, tstepB = 2 * hstepB;
    const unsigned ldsw = (unsigned)wid * 1024u;
    const int aoff = lds_byte(wr * 64 + fr, fq * 8), boff = lds_byte(wc * 32 + fr, fq * 8);
#define PG8_SA(b, h) (((b) * 2 + (h)) * HTB)
#define PG8_SB(b, h) ((4 + (b) * 2 + (h)) * HTB)
#define PG8_STAGE(bufoff, gbase, voff) do { _Pragma("unroll") for (int _i = 0; _i < 2; ++_i) \
        __builtin_amdgcn_global_load_lds((const unsigned*)((const char*)(gbase) + (voff)[_i]), (LAS unsigned*)(lds + (bufoff) + ldsw + _i * 8192), 16, 0, 0); } while (0)
#define PG8_LDA(dst, b, h) do { _Pragma("unroll") for (int m = 0; m < 4; ++m) _Pragma("unroll") for (int k = 0; k < 2; ++k) dst[m][k] = *(const LAS bf16x8*)(lds + PG8_SA(b, h) + aoff + m * 2048 + k * 1024); } while (0)
#define PG8_LDB(dst, b, h) do { _Pragma("unroll") for (int n = 0; n < 2; ++n) _Pragma("unroll") for (int k = 0; k < 2; ++k) dst[n][k] = *(const LAS bf16x8*)(lds + PG8_SB(b, h) + boff + n * 2048 + k * 1024); } while (0)
#define PG8_MMA(ai, bj, At, Bt) do { __builtin_amdgcn_s_setprio(1); _Pragma("unroll") for (int m = 0; m < 4; ++m) _Pragma("unroll") for (int n = 0; n < 2; ++n) _Pragma("unroll") for (int k = 0; k < 2; ++k) \
        acc[ai][bj][m][n] = __builtin_amdgcn_mfma_f32_16x16x32_bf16(Bt[n][k], At[m][k], acc[ai][bj][m][n], 0, 0, 0); __builtin_amdgcn_s_setprio(0); } while (0)
#define PG8_WAIT_V(n) asm volatile("s_waitcnt vmcnt(" #n ")" ::: "memory")
#define PG8_WAIT_L(n) asm volatile("s_waitcnt lgkmcnt(" #n ")" ::: "memory")
#define PG8_BAR __builtin_amdgcn_s_barrier()
#define PG8_SCHED __builtin_amdgcn_sched_barrier(0)
    Unit cur, nxt; int ui = 0;
    if (!unit_next<ZN>(g, 0, cur)) return;
    f32x4 acc[2][2][4][2];
#pragma unroll
    for (int a = 0; a < 2; ++a)
#pragma unroll
        for (int b = 0; b < 2; ++b)
#pragma unroll
            for (int m = 0; m < 4; ++m)
#pragma unroll
                for (int n = 0; n < 2; ++n) acc[a][b][m][n] = (f32x4){0.f, 0.f, 0.f, 0.f};
    bf16x8 At[4][2], B0[2][2], B1[2][2];
    const char* cA = (const char*)g.A + (size_t)cur.pm * tstepA + (size_t)gemm_aofs(g, cur.z) * 2;
    const char* cB = (const char*)g.Bt + (size_t)cur.pn * tstepB + (size_t)cur.z * g.zB * 2;
    PG8_WAIT_V(0);
    PG8_STAGE(PG8_SB(0, 0), cB, voffB); PG8_STAGE(PG8_SA(0, 0), cA, voffA); PG8_STAGE(PG8_SB(0, 1), cB + hstepB, voffB); PG8_STAGE(PG8_SA(0, 1), cA + hstepA, voffA);
    if (wr == 1) PG8_BAR;
    PG8_WAIT_V(4); PG8_BAR;
    PG8_STAGE(PG8_SB(1, 0), cB + kstep, voffB); PG8_STAGE(PG8_SA(1, 0), cA + kstep, voffA); PG8_STAGE(PG8_SB(1, 1), cB + hstepB + kstep, voffB);
    PG8_WAIT_V(6); PG8_BAR;
    for (;;) {
        const bool has_next = unit_next<ZN>(g, ui + 1, nxt);
        const char* nA = has_next ? (const char*)g.A + (size_t)nxt.pm * tstepA + (size_t)gemm_aofs(g, nxt.z) * 2 : cA;
        const char* nB = has_next ? (const char*)g.Bt + (size_t)nxt.pn * tstepB + (size_t)nxt.z * g.zB * 2 : cB;
        for (int t = 0; t < nt; t += 2) {
            const bool last = (t == nt - 2);
            const char* a1 = cA + (size_t)(t + 1) * kstep;
            const char* a2 = last ? nA : cA + (size_t)(t + 2) * kstep; const char* b2 = last ? nB : cB + (size_t)(t + 2) * kstep;
            const char* a3 = a2 + kstep; const char* b3 = b2 + kstep;
            PG8_LDB(B0, 0, 0); PG8_SCHED; PG8_LDA(At, 0, 0); PG8_STAGE(PG8_SA(1, 1), a1 + hstepA, voffA);
            PG8_WAIT_L(8); PG8_BAR; PG8_WAIT_L(0); PG8_MMA(0, 0, At, B0); PG8_BAR; PG8_SCHED;
            PG8_LDB(B1, 0, 1); PG8_STAGE(PG8_SB(0, 0), b2, voffB);
            PG8_BAR; PG8_WAIT_L(0); PG8_MMA(0, 1, At, B1); PG8_BAR;
            PG8_LDA(At, 0, 1); PG8_STAGE(PG8_SA(0, 0), a2, voffA);
            PG8_BAR; PG8_WAIT_L(0); PG8_MMA(1, 0, At, B0); PG8_BAR; PG8_SCHED;
            PG8_STAGE(PG8_SB(0, 1), b2 + hstepB, voffB);
            PG8_WAIT_V(6); PG8_BAR; PG8_MMA(1, 1, At, B1); PG8_BAR;
            PG8_LDB(B0, 1, 0); PG8_SCHED; PG8_LDA(At, 1, 0); PG8_STAGE(PG8_SA(0, 1), a2 + hstepA, voffA);
            PG8_WAIT_L(8); PG8_BAR; PG8_WAIT_L(0); PG8_MMA(0, 0, At, B0); PG8_BAR; PG8_SCHED;
            PG8_LDB(B1, 1, 1); PG8_STAGE(PG8_SB(1, 0), b3, voffB);
            PG8_BAR; PG8_WAIT_L(0); PG8_MMA(0, 1, At, B1); PG8_BAR;
            PG8_LDA(At, 1, 1); PG8_STAGE(PG8_SA(1, 0), a3, voffA);
            PG8_BAR; PG8_WAIT_L(0); PG8_MMA(1, 0, At, B0); PG8_BAR; PG8_SCHED;
            PG8_STAGE(PG8_SB(1, 1), b3 + hstepB, voffB);
            PG8_WAIT_V(6); PG8_BAR; PG8_MMA(1, 1, At, B1); PG8_BAR;
        }
        E(acc, cur, wr, wc, fr, fq);
        if (!has_next) break;
#pragma unroll
        for (int a = 0; a < 2; ++a)
#pragma unroll
            for (int b = 0; b < 2; ++b)
#pragma unroll
                for (int m = 0; m < 4; ++m)
#pragma unroll
                    for (int n = 0; n < 2; ++n) acc[a][b][m][n] = (f32x4){0.f, 0.f, 0.f, 0.f};
        cur = nxt; cA = nA; cB = nB; ++ui;
    }
    PG8_WAIT_V(0);
    if (wr == 0) PG8_BAR;
    PG8_BAR;
#undef PG8_SA
#undef PG8_SB
#undef PG8_STAGE
#undef PG8_LDA
#undef PG8_LDB
#undef PG8_MMA
#undef PG8_WAIT_V
#undef PG8_WAIT_L
#undef PG8_BAR
#undef PG8_SCHED
}

struct EpiMod {
    static constexpr bool PERM = false;
    float* mod; const float* bada;
    __device__ __forceinline__ void operator()(const f32x4 (&acc)[2][2][4][2], const Unit& u, int wr, int wc, int fr, int fq) const {
        f32x4 bv[2][2];
#pragma unroll
        for (int bj = 0; bj < 2; ++bj)
#pragma unroll
            for (int n = 0; n < 2; ++n) bv[bj][n] = *(const f32x4*)(bada + u.pn * BM + bj * HALF + wc * 32 + n * 16 + fq * 4);
#pragma unroll
        for (int ai = 0; ai < 2; ++ai)
#pragma unroll
            for (int m = 0; m < 4; ++m) { const int r = u.pm * BM + ai * HALF + wr * 64 + m * 16 + fr; if (r >= NCOND) continue;
#pragma unroll
                for (int bj = 0; bj < 2; ++bj)
#pragma unroll
                    for (int n = 0; n < 2; ++n) { const int c = u.pn * BM + bj * HALF + wc * 32 + n * 16 + fq * 4; const int layer = c / 6144, cc = c - layer * 6144;
                        *(f32x4*)(mod + ((size_t)(layer * NCOND + r)) * 6144 + cc) = acc[ai][bj][m][n] + bv[bj][n]; } }
    }
};
struct EpiProj {
    static constexpr bool PERM = true;
    bf16_t* O;
    __device__ __forceinline__ void operator()(const f32x4 (&acc)[2][2][4][2], const Unit& u, int wr, int wc, int fr, int fq) const {
#pragma unroll
        for (int bj = 0; bj < 2; ++bj) { const int c = u.pn * BM + bj * HALF + wc * 32 + fq * 8; const int mode = (c >= C_UV + 1024 && c < C_GATE) ? 1 : 0;
#pragma unroll
            for (int ai = 0; ai < 2; ++ai)
#pragma unroll
                for (int m = 0; m < 4; ++m) { const int r = u.pm * BM + ai * HALF + wr * 64 + m * 16 + fr;
                    float v[8];
#pragma unroll
                    for (int i = 0; i < 8; ++i) { float x = acc[ai][bj][m][i >> 2][i & 3]; v[i] = (mode == 1 ? gelu_fast(x) : x); }
                    u32x4 o; o[0] = pk2(v[0], v[1]); o[1] = pk2(v[2], v[3]); o[2] = pk2(v[4], v[5]); o[3] = pk2(v[6], v[7]);
                    *(u32x4*)(O + (size_t)r * LDP + c) = o; } }
    }
};
struct EpiUp {
    static constexpr bool PERM = true;
    bf16_t* O;
    __device__ __forceinline__ void operator()(const f32x4 (&acc)[2][2][4][2], const Unit& u, int wr, int wc, int fr, int fq) const {
#pragma unroll
        for (int bj = 0; bj < 2; ++bj) { const int c = u.pn * BM + bj * HALF + wc * 32 + fq * 8;
#pragma unroll
            for (int ai = 0; ai < 2; ++ai)
#pragma unroll
                for (int m = 0; m < 4; ++m) { const int r = u.pm * BM + ai * HALF + wr * 64 + m * 16 + fr;
                    const f32x4 a = acc[ai][bj][m][0], b = acc[ai][bj][m][1];
                    u32x4 o; o[0] = pk2(a[0], a[1]); o[1] = pk2(a[2], a[3]); o[2] = pk2(b[0], b[1]); o[3] = pk2(b[2], b[3]);
                    *(u32x4*)(O + (size_t)r * 5632 + c) = o; } }
    }
};
struct EpiBranch {
    static constexpr bool PERM = true;
    const bf16_t* proj; float* msum; bf16_t* merged;
    __device__ __forceinline__ void operator()(const f32x4 (&acc)[2][2][4][2], const Unit& u, int wr, int wc, int fr, int fq) const {
        const int z = u.z;
        u32x4 gt[2][2], pv[2][2];
        const int c0 = u.pn * BM + wc * 32 + fq * 8, r0 = u.pm * BM + wr * 64 + fr;
#define EB_LOAD(k, buf) do { const int bj_ = (k) >> 2, ai_ = ((k) >> 1) & 1, m0_ = ((k) & 1) * 2; _Pragma("unroll") for (int mm = 0; mm < 2; ++mm) { const int r = r0 + ai_ * HALF + (m0_ + mm) * 16, c = c0 + bj_ * HALF; \
            gt[buf][mm] = *(const u32x4*)(proj + (size_t)r * LDP + C_GATE + z * 1024 + c); pv[buf][mm] = (u32x4){0u, 0u, 0u, 0u}; \
            if (z > 0) pv[buf][mm] = *(const u32x4*)(merged + (size_t)r * 1024 + c); } } while (0)
        EB_LOAD(0, 0);
#pragma unroll
        for (int k = 0; k < 8; ++k) { const int bj = k >> 2, ai = (k >> 1) & 1, m0 = (k & 1) * 2, buf = k & 1;
            if (k < 7) { if (buf == 0) EB_LOAD(k + 1, 1); else EB_LOAD(k + 1, 0); }
#pragma unroll
            for (int mm = 0; mm < 2; ++mm) { const int m = m0 + mm; const int r = r0 + ai * HALF + m * 16, c = c0 + bj * HALF;
                const f32x4 a = acc[ai][bj][m][0], b = acc[ai][bj][m][1]; const u32x4 gv = gt[buf][mm], p = pv[buf][mm];
                u32x4 o;
                o[0] = pk2(bflo(p[0]) + sigmoid_fast(bflo(gv[0])) * a[0], bfhi(p[0]) + sigmoid_fast(bfhi(gv[0])) * a[1]); o[1] = pk2(bflo(p[1]) + sigmoid_fast(bflo(gv[1])) * a[2], bfhi(p[1]) + sigmoid_fast(bfhi(gv[1])) * a[3]);
                o[2] = pk2(bflo(p[2]) + sigmoid_fast(bflo(gv[2])) * b[0], bfhi(p[2]) + sigmoid_fast(bfhi(gv[2])) * b[1]); o[3] = pk2(bflo(p[3]) + sigmoid_fast(bflo(gv[3])) * b[2], bfhi(p[3]) + sigmoid_fast(bfhi(gv[3])) * b[3]);
                *(u32x4*)(merged + (size_t)r * 1024 + c) = o; } }
#undef EB_LOAD
    }
};
struct EpiResid {
    static constexpr bool PERM = false;
    const float* xin_p; const float* xin_s; float* xout; const float* ga;
    __device__ __forceinline__ void operator()(const f32x4 (&acc)[2][2][4][2], const Unit& u, int wr, int wc, int fr, int fq) const {
        const float* gr = ga + (size_t)(u.pm >> 4) * 6144;
        const int c0 = u.pn * BM + wc * 32 + fq * 4, r0 = u.pm * BM + wr * 64 + fr;
        f32x4 gv[2][2];
#pragma unroll
        for (int bj = 0; bj < 2; ++bj)
#pragma unroll
            for (int n = 0; n < 2; ++n) gv[bj][n] = *(const f32x4*)(gr + c0 + bj * HALF + n * 16);
        f32x4 xv[2][2][2];
#define ER_LOAD(k, buf) do { const int r_ = r0 + ((k) >> 2) * HALF + ((k) & 3) * 16; _Pragma("unroll") for (int bj = 0; bj < 2; ++bj) _Pragma("unroll") for (int n = 0; n < 2; ++n) \
            xv[buf][bj][n] = *(const f32x4*)(xin_p + (size_t)r_ * 1024 + c0 + bj * HALF + n * 16); } while (0)
        ER_LOAD(0, 0);
#pragma unroll
        for (int k = 0; k < 8; ++k) { const int ai = k >> 2, m = k & 3, buf = k & 1; const int r = r0 + ai * HALF + m * 16;
            if (k < 7) { if (buf == 0) ER_LOAD(k + 1, 1); else ER_LOAD(k + 1, 0); }
#pragma unroll
            for (int bj = 0; bj < 2; ++bj)
#pragma unroll
                for (int n = 0; n < 2; ++n) *(f32x4*)(xout + (size_t)r * 1024 + c0 + bj * HALF + n * 16) = xv[buf][bj][n] + gv[bj][n] * acc[ai][bj][m][n]; }
#undef ER_LOAD
    }
};

struct CTile { const float* src; bf16_t* dst; int K, N, k0, n0; };
__device__ __forceinline__ CTile conv_decode(const Params& P, int t) {
    constexpr int T_IN = 3392, T_BR = 1024, T_O = 256, T_UP = 1408, T_DN = 704, T_ADA = 1536, T_L = T_IN + T_BR + T_O + T_UP + T_DN + T_ADA;
    const int layer = t / T_L; int r = t - layer * T_L; CTile c;
    if (r < T_IN) { c.src = P.in[13] + (size_t)layer * 1024 * 13328; c.dst = (bf16_t*)(P.ws + WS_WIN) + (size_t)layer * 13568 * 1024; c.K = 1024; c.N = 13328; c.k0 = (r / 212) * 64; c.n0 = (r % 212) * 64; return c; }
    r -= T_IN;
    if (r < T_BR) { const int br = r >> 8, q = r & 255; c.src = P.in[26] + (size_t)(layer * 4 + br) * 1048576; c.dst = (bf16_t*)(P.ws + WS_WBR) + (size_t)(layer * 4 + br) * 1048576; c.K = 1024; c.N = 1024; c.k0 = (q >> 4) * 64; c.n0 = (q & 15) * 64; return c; }
    r -= T_BR;
    if (r < T_O) { c.src = P.in[27] + (size_t)layer * 1048576; c.dst = (bf16_t*)(P.ws + WS_WO) + (size_t)layer * 1048576; c.K = 1024; c.N = 1024; c.k0 = (r >> 4) * 64; c.n0 = (r & 15) * 64; return c; }
    r -= T_O;
    if (r < T_UP) { c.src = P.in[29] + (size_t)layer * 1024 * 5632; c.dst = (bf16_t*)(P.ws + WS_WUP) + (size_t)layer * 5632 * 1024; c.K = 1024; c.N = 5632; c.k0 = (r / 88) * 64; c.n0 = (r % 88) * 64; return c; }
    r -= T_UP;
    if (r < T_DN) { c.src = P.in[32] + (size_t)layer * 2816 * 1024; c.dst = (bf16_t*)(P.ws + WS_WDN) + (size_t)layer * 1024 * 2816; c.K = 2816; c.N = 1024; c.k0 = (r >> 4) * 64; c.n0 = (r & 15) * 64; return c; }
    r -= T_DN;
    c.src = P.in[10] + (size_t)layer * 1024 * 6144; c.dst = (bf16_t*)(P.ws + WS_WADA) + (size_t)layer * 6144 * 1024; c.K = 1024; c.N = 6144; c.k0 = (r / 96) * 64; c.n0 = (r % 96) * 64; return c;
}
__device__ __forceinline__ void phase_convert(const Params& P, float* T) {
    constexpr int NT = 4 * 8320;
    const int tid = otid();
    int t = blockIdx.x;
    CTile cur = conv_decode(P, t < NT ? t : 0);
    float v[8], nv[8];
#pragma unroll
    for (int e = 0; e < 8; ++e) { const int idx = tid + e * 512, k = idx >> 6, n = idx & 63; v[e] = (t < NT && cur.n0 + n < cur.N) ? cur.src[(size_t)(cur.k0 + k) * cur.N + cur.n0 + n] : 0.f; }
    for (; t < NT; t += gridDim.x) {
        const int tn = t + gridDim.x; const bool hn = tn < NT; const CTile nxt = conv_decode(P, hn ? tn : 0);
#pragma unroll
        for (int e = 0; e < 8; ++e) { const int idx = tid + e * 512, k = idx >> 6, n = idx & 63; nv[e] = (hn && nxt.n0 + n < nxt.N) ? nxt.src[(size_t)(nxt.k0 + k) * nxt.N + nxt.n0 + n] : 0.f; }
#pragma unroll
        for (int e = 0; e < 8; ++e) { const int idx = tid + e * 512, k = idx >> 6, n = idx & 63; T[k * 65 + n] = v[e]; }
        __syncthreads();
        { const int n = tid >> 3, kc = (tid & 7) * 8; float x[8];
#pragma unroll
          for (int j = 0; j < 8; ++j) x[j] = T[(kc + j) * 65 + n];
          u32x4 o; o[0] = pk2(x[0], x[1]); o[1] = pk2(x[2], x[3]); o[2] = pk2(x[4], x[5]); o[3] = pk2(x[6], x[7]);
          *(u32x4*)(cur.dst + (size_t)(cur.n0 + n) * cur.K + cur.k0 + kc) = o; }
        __syncthreads();
#pragma unroll
        for (int e = 0; e < 8; ++e) v[e] = nv[e];
        cur = nxt;
    }
    bf16_t* cact = (bf16_t*)(P.ws + WS_CACT);
    for (int i = blockIdx.x * 512 + otid(); i < 256 * 1024; i += gridDim.x * 512) {
        const int r = i >> 10, c = i & 1023; float v = 0.f;
        if (r < 4) v = siluf_(P.in[2][r * 1024 + c]); else if (r < NCOND) v = siluf_(P.in[3][(r - 4) * 1024 + c]);
        cact[i] = f2bf(v);
    }
}

__device__ __forceinline__ void phase_norm(const float* xp, const float* xs, const float* g, const float* modL, int shofs, int scofs, bf16_t* hout) {
    const int tid = otid(); const int w = tid >> 6, lane = tid & 63;
    for (int r = blockIdx.x * 8 + w; r < NTOK; r += gridDim.x * 8) {
        const float* x = r < NPR ? xp + (size_t)r * 1024 : xs + (size_t)(r - NPR) * 1024;
        const float* mr = modL + (size_t)cond_row(r) * 6144;
        f32x4 v[4]; float ss = 0.f;
#pragma unroll
        for (int i = 0; i < 4; ++i) { v[i] = *(const f32x4*)(x + i * 256 + lane * 4); ss += v[i][0] * v[i][0] + v[i][1] * v[i][1] + v[i][2] * v[i][2] + v[i][3] * v[i][3]; }
        ss = wave_sum(ss, lane); const float rs = rsqrtf(ss * (1.f / 1024.f) + EPSF);
#pragma unroll
        for (int i = 0; i < 4; ++i) { const int c = i * 256 + lane * 4;
            const f32x4 gv = *(const f32x4*)(g + c), sc = *(const f32x4*)(mr + scofs + c), sh = *(const f32x4*)(mr + shofs + c);
            f32x4 o = v[i] * rs * gv * (sc + 1.f) + sh;
            u32x2 pk; pk[0] = pk2(o[0], o[1]); pk[1] = pk2(o[2], o[3]);
            *(u32x2*)(hout + (size_t)r * 1024 + c) = pk; }
    }
}
__device__ __forceinline__ void phase_final_norm(float* x, const float* g) {
    const int tid = otid(); const int w = tid >> 6, lane = tid & 63;
    for (int r = blockIdx.x * 8 + w; r < NTOK; r += gridDim.x * 8) {
        float* xr = x + (size_t)r * 1024; f32x4 v[4]; float ss = 0.f;
#pragma unroll
        for (int i = 0; i < 4; ++i) { v[i] = *(const f32x4*)(xr + i * 256 + lane * 4); ss += v[i][0] * v[i][0] + v[i][1] * v[i][1] + v[i][2] * v[i][2] + v[i][3] * v[i][3]; }
        ss = wave_sum(ss, lane); const float rs = rsqrtf(ss * (1.f / 1024.f) + EPSF);
#pragma unroll
        for (int i = 0; i < 4; ++i) { const int c = i * 256 + lane * 4; const f32x4 gv = *(const f32x4*)(g + c); *(f32x4*)(xr + c) = v[i] * rs * gv; }
    }
}

template <int MODE>
__device__ __forceinline__ void ssd_item(const Params& P, int layer, int item, float* L) {
    const int tid = otid(), w = tid >> 6, lane = tid & 63;
    bf16_t* proj = (bf16_t*)(P.ws + WS_PROJ);
    float* states = (float*)(P.ws + WS_SSDST); float* decs = (float*)(P.ws + WS_SSDDEC);
    int r0, nsteps, half, seq0, b = 0, c = 0, sb = 0;
    if (MODE == 2) { sb = item >> 1; half = item & 1; r0 = NPR + sb * 4; nsteps = 4; seq0 = r0; }
    else { b = item >> 6; c = (item >> 1) & 31; half = item & 1; r0 = b * 4096 + c * 128; nsteps = 128; seq0 = b * 4096; }
    float* XS = L; float* ZS = XS + 16 * 512; float* BS = ZS + 16 * 512; float* CS = BS + 16 * 128; float* DTS = CS + 16 * 128; float* DAS = DTS + 128; float* SSQ = DAS + 128;
    const float* cw = P.in[14] + (size_t)layer * 4 * 1536; const float* cb = P.in[15] + (size_t)layer * 1536;
    const float* prev = P.in[5] + ((size_t)(layer * 128 + sb)) * 3 * 1536;
    const int hd = half * 8 + w, gl = w >> 2;
    float h[64];
    if (MODE == 0) {
#pragma unroll
        for (int n = 0; n < 64; ++n) h[n] = 0.f;
    } else {
        const float* s0p = (MODE == 1) ? states + ((size_t)((b * 32 + c) * 16 + hd)) * 4096 + lane * 64
                                       : P.in[4] + ((size_t)((layer * 128 + sb) * 16 + hd)) * 4096 + lane * 64;
#pragma unroll
        for (int n4 = 0; n4 < 16; ++n4) { const f32x4 v = *(const f32x4*)(s0p + n4 * 4); h[n4 * 4] = v[0]; h[n4 * 4 + 1] = v[1]; h[n4 * 4 + 2] = v[2]; h[n4 * 4 + 3] = v[3]; }
    }
    const float Dh = P.in[18][layer * 16 + hd];
    float decp = 1.f;
    for (int s0 = 0; s0 < nsteps; s0 += 16) {
        const int ns = (nsteps - s0) < 16 ? (nsteps - s0) : 16;
        __syncthreads();
        for (int idx = tid; idx < ns * 768; idx += 512) {
            const int t = idx / 768, ch = idx - t * 768;
            int cx;
            if (ch < 512) cx = half * 512 + ch; else if (ch < 640) cx = 1024 + half * 128 + (ch - 512); else cx = 1280 + half * 128 + (ch - 640);
            float a = cb[cx];
#pragma unroll
            for (int k = 0; k < 4; ++k) { const int step = s0 + t - 3 + k, rr = r0 + step; float raw;
                if (rr >= seq0) raw = bf2f(proj[(size_t)rr * LDP + C_XBC + cx]);
                else raw = (MODE == 2) ? prev[(3 + step) * 1536 + cx] : 0.f;
                a += cw[k * 1536 + cx] * raw; }
            a = siluf_(a);
            if (ch < 512) { XS[t * 512 + ch] = a; if (MODE != 0) ZS[t * 512 + ch] = bf2f(proj[(size_t)(r0 + s0 + t) * LDP + C_Z + cx]); }
            else if (ch < 640) BS[t * 128 + ch - 512] = a; else CS[t * 128 + ch - 640] = a;
        }
        if (tid < ns * 8) { const int t = tid >> 3, ww = tid & 7, hh = half * 8 + ww;
            const float dt = softplusf_(bf2f(proj[(size_t)(r0 + s0 + t) * LDP + C_DTR + hh]) + P.in[16][layer * 16 + hh]);
            DTS[t * 8 + ww] = dt; DAS[t * 8 + ww] = __expf(-dt * __expf(P.in[17][layer * 16 + hh])); }
        __syncthreads();
        for (int t = 0; t < ns; ++t) {
            const float a = DAS[t * 8 + w], dt = DTS[t * 8 + w], xv = XS[t * 512 + w * 64 + lane], xd = xv * dt; decp *= a;
            const f32x4* B4 = (const f32x4*)(BS + t * 128 + gl * 64);
#pragma unroll
            for (int n4 = 0; n4 < 16; ++n4) { const f32x4 bv = B4[n4];
                h[n4 * 4] = a * h[n4 * 4] + xd * bv[0]; h[n4 * 4 + 1] = a * h[n4 * 4 + 1] + xd * bv[1]; h[n4 * 4 + 2] = a * h[n4 * 4 + 2] + xd * bv[2]; h[n4 * 4 + 3] = a * h[n4 * 4 + 3] + xd * bv[3]; }
            if (MODE != 0) {
                const f32x4* C4 = (const f32x4*)(CS + t * 128 + gl * 64); float y0 = 0.f, y1 = 0.f;
#pragma unroll
                for (int n4 = 0; n4 < 16; ++n4) { const f32x4 cv = C4[n4]; y0 += h[n4 * 4] * cv[0] + h[n4 * 4 + 2] * cv[2]; y1 += h[n4 * 4 + 1] * cv[1] + h[n4 * 4 + 3] * cv[3]; }
                float y = y0 + y1 + Dh * xv; y *= siluf_(ZS[t * 512 + w * 64 + lane]);
                const float sq = wave_sum(y * y, lane); if (lane == 0) SSQ[(s0 + t) * 8 + w] = sq;
                proj[(size_t)(r0 + s0 + t) * LDP + C_Z + hd * 64 + lane] = f2bf(y);
            }
        }
    }
    if (MODE == 0) {
        float* sp = states + ((size_t)((b * 32 + c) * 16 + hd)) * 4096 + lane * 64;
#pragma unroll
        for (int n4 = 0; n4 < 16; ++n4) *(f32x4*)(sp + n4 * 4) = (f32x4){h[n4 * 4], h[n4 * 4 + 1], h[n4 * 4 + 2], h[n4 * 4 + 3]};
        if (lane == 0) decs[(b * 32 + c) * 16 + hd] = decp;
    }
    if (MODE == 2) {
        float* sp = P.out + O_SSSM + ((size_t)((layer * 128 + sb) * 16 + hd)) * 4096 + lane * 64;
#pragma unroll
        for (int n4 = 0; n4 < 16; ++n4) *(f32x4*)(sp + n4 * 4) = (f32x4){h[n4 * 4], h[n4 * 4 + 1], h[n4 * 4 + 2], h[n4 * 4 + 3]};
    }
    if (MODE != 0) {
        __syncthreads();
        const float ng = P.in[19][layer * 1024 + hd * 64 + lane];
        for (int t = 0; t < nsteps; ++t) {
            const float tot = SSQ[t * 8 + gl * 4] + SSQ[t * 8 + gl * 4 + 1] + SSQ[t * 8 + gl * 4 + 2] + SSQ[t * 8 + gl * 4 + 3];
            const float sc = rsqrtf(tot * (1.f / 256.f) + EPSF) * ng;
            bf16_t* ap = proj + (size_t)(r0 + t) * LDP + C_Z + hd * 64 + lane; *ap = f2bf(bf2f(*ap) * sc);
        }
    }
}

__device__ __forceinline__ int xt_idx(int row, int t) { return row * 136 + ((((t >> 3) ^ ((row >> 3) & 15)) << 3) | (t & 7)); }
__device__ __forceinline__ void ssd_stage_dt(const Params& P, int layer, const bf16_t* proj, size_t r0, int g, float* DT, float* ACS, int tid) {
    { const int hh = tid >> 7, t = tid & 127, hd = g * 4 + hh;
      const float dt = softplusf_(bf2f(proj[(r0 + t) * LDP + C_DTR + hd]) + P.in[16][layer * 16 + hd]);
      DT[hh * 128 + t] = dt; ACS[hh * 128 + t] = -dt * __expf(P.in[17][layer * 16 + hd]); }
    __syncthreads();
    if (tid < 256) { const int hh = tid >> 6, l = tid & 63; const float a0 = ACS[hh * 128 + 2 * l], a1 = ACS[hh * 128 + 2 * l + 1]; float sum = a0 + a1;
#pragma unroll
        for (int o = 1; o < 64; o <<= 1) { const float v = __int_as_float(__builtin_amdgcn_ds_bpermute(((l - o) & 63) << 2, __float_as_int(sum))); if (l >= o) sum += v; }
        ACS[hh * 128 + 2 * l] = sum - a1; ACS[hh * 128 + 2 * l + 1] = sum; }
    __syncthreads();
}
template <int PASS>
__device__ __forceinline__ void ssd_stage_conv(const Params& P, int layer, const bf16_t* proj, size_t r0, bool first, int g, const float* DT, const float* ACS, bf16_t* XT4, bf16_t* Bx, bf16_t* Cs, int tid) {
    const int slot = tid & 63, seg = tid >> 6;
    if (slot < (PASS ? 48 : 40)) {
        int cx; if (slot < 32) cx = g * 256 + slot * 8; else if (slot < 40) cx = 1024 + g * 64 + (slot - 32) * 8; else cx = 1280 + g * 64 + (slot - 40) * 8;
        const float* cw = P.in[14] + (size_t)layer * 4 * 1536 + cx; const float* cb = P.in[15] + (size_t)layer * 1536 + cx;
        float wt[4][8], bb[8], win[3][8];
#pragma unroll
        for (int k = 0; k < 4; ++k) { const f32x4 a = *(const f32x4*)(cw + k * 1536), c = *(const f32x4*)(cw + k * 1536 + 4);
#pragma unroll
            for (int i = 0; i < 4; ++i) { wt[k][i] = a[i]; wt[k][4 + i] = c[i]; } }
        { const f32x4 a = *(const f32x4*)cb, c = *(const f32x4*)(cb + 4);
#pragma unroll
          for (int i = 0; i < 4; ++i) { bb[i] = a[i]; bb[4 + i] = c[i]; } }
        const int t0 = seg * 16;
#pragma unroll
        for (int k = 0; k < 3; ++k) { u32x4 raw = (u32x4){0u, 0u, 0u, 0u};
            if (!(first && seg == 0)) raw = *(const u32x4*)(proj + (r0 + t0 - 3 + k) * LDP + C_XBC + cx);
#pragma unroll
            for (int i = 0; i < 4; ++i) { win[k][2 * i] = bflo(raw[i]); win[k][2 * i + 1] = bfhi(raw[i]); } }
        u32x4 cur4[4], nxt4[4];
#pragma unroll
        for (int q = 0; q < 4; ++q) { cur4[q] = *(const u32x4*)(proj + (r0 + t0 + q) * LDP + C_XBC + cx); nxt4[q] = cur4[q]; }
        for (int gq = 0; gq < 4; ++gq) {
            if (gq < 3) {
#pragma unroll
                for (int q = 0; q < 4; ++q) nxt4[q] = *(const u32x4*)(proj + (r0 + t0 + gq * 4 + 4 + q) * LDP + C_XBC + cx); }
#pragma unroll
            for (int q = 0; q < 4; ++q) {
                const int t = t0 + gq * 4 + q; const u32x4 raw = cur4[q];
                float cur[8], o[8];
#pragma unroll
                for (int i = 0; i < 4; ++i) { cur[2 * i] = bflo(raw[i]); cur[2 * i + 1] = bfhi(raw[i]); }
#pragma unroll
                for (int i = 0; i < 8; ++i) { o[i] = siluf_(bb[i] + wt[0][i] * win[0][i] + wt[1][i] * win[1][i] + wt[2][i] * win[2][i] + wt[3][i] * cur[i]); win[0][i] = win[1][i]; win[1][i] = win[2][i]; win[2][i] = cur[i]; }
                if (slot < 32) { const int hh = slot >> 3, p0 = (slot & 7) * 8; float sc = DT[hh * 128 + t]; if (PASS == 0) sc *= __expf(ACS[hh * 128 + 127] - ACS[hh * 128 + t]);
#pragma unroll
                    for (int i = 0; i < 8; ++i) XT4[xt_idx(hh * 64 + p0 + i, t)] = f2bf(o[i] * sc); }
                else if (slot < 40) { const int n0 = (slot - 32) * 8;
                    if (PASS == 0) {
#pragma unroll
                        for (int i = 0; i < 8; ++i) Bx[xt_idx(n0 + i, t)] = f2bf(o[i]); }
                    else { u32x4 pk; pk[0] = pk2(o[0], o[1]); pk[1] = pk2(o[2], o[3]); pk[2] = pk2(o[4], o[5]); pk[3] = pk2(o[6], o[7]); *(u32x4*)(Bx + t * 72 + n0) = pk; } }
                else { const int n0 = (slot - 40) * 8; u32x4 pk; pk[0] = pk2(o[0], o[1]); pk[1] = pk2(o[2], o[3]); pk[2] = pk2(o[4], o[5]); pk[3] = pk2(o[6], o[7]); *(u32x4*)(Cs + t * 72 + n0) = pk; }
            }
#pragma unroll
            for (int q = 0; q < 4; ++q) cur4[q] = nxt4[q];
        }
    }
}
__device__ __forceinline__ void ssd_pass1_item(const Params& P, int layer, int item, unsigned char* lds) {
    const int tid = otid(), w = __builtin_amdgcn_readfirstlane(tid >> 6), lane = tid & 63, fr = lane & 15, fq = lane >> 4;
    const int b = item >> 7, c = (item >> 2) & 31, g = item & 3; const size_t r0 = (size_t)b * 4096 + (size_t)c * 128;
    const bf16_t* proj = (const bf16_t*)(P.ws + WS_PROJ);
    float* states = (float*)(P.ws + WS_SSDST); float* decs = (float*)(P.ws + WS_SSDDEC);
    bf16_t* XT4 = (bf16_t*)lds; bf16_t* BT = XT4 + 256 * 136; float* DT = (float*)(BT + 64 * 136); float* ACS = DT + 512;
    __syncthreads();
    ssd_stage_dt(P, layer, proj, r0, g, DT, ACS, tid);
    ssd_stage_conv<0>(P, layer, proj, r0, c == 0, g, DT, ACS, XT4, BT, nullptr, tid);
    __syncthreads();
    const int hh = w >> 1, pb = (w & 1) * 2;
    f32x4 acc[2][4];
#pragma unroll
    for (int pi = 0; pi < 2; ++pi)
#pragma unroll
        for (int nt = 0; nt < 4; ++nt) acc[pi][nt] = (f32x4){0.f, 0.f, 0.f, 0.f};
#pragma unroll
    for (int ks = 0; ks < 4; ++ks) { bf16x8 a[2];
#pragma unroll
        for (int pi = 0; pi < 2; ++pi) a[pi] = *(const bf16x8*)(XT4 + xt_idx(hh * 64 + (pb + pi) * 16 + fr, ks * 32 + fq * 8));
#pragma unroll
        for (int nt = 0; nt < 4; ++nt) { const bf16x8 bv = *(const bf16x8*)(BT + xt_idx(nt * 16 + fr, ks * 32 + fq * 8));
#pragma unroll
            for (int pi = 0; pi < 2; ++pi) acc[pi][nt] = __builtin_amdgcn_mfma_f32_16x16x32_bf16(a[pi], bv, acc[pi][nt], 0, 0, 0); } }
    float* sp = states + ((size_t)((b * 32 + c) * 16 + g * 4 + hh)) * 4096;
#pragma unroll
    for (int pi = 0; pi < 2; ++pi)
#pragma unroll
        for (int nt = 0; nt < 4; ++nt)
#pragma unroll
            for (int j = 0; j < 4; ++j) sp[((pb + pi) * 16 + fq * 4 + j) * 64 + nt * 16 + fr] = acc[pi][nt][j];
    if (tid < 4) decs[(b * 32 + c) * 16 + g * 4 + tid] = __expf(ACS[tid * 128 + 127]);
}
__device__ __forceinline__ void ssd_pass3_item(const Params& P, int layer, int item, unsigned char* lds, bool dry = false) {
    const int tid = otid(), w = __builtin_amdgcn_readfirstlane(tid >> 6), lane = tid & 63, fr = lane & 15, fq = lane >> 4;
    const int b = item >> 7, c = (item >> 2) & 31, g = item & 3; const size_t r0 = (size_t)b * 4096 + (size_t)c * 128;
    bf16_t* proj = (bf16_t*)(P.ws + WS_PROJ);
    const float* states = (const float*)(P.ws + WS_SSDST);
    bf16_t* Cs = (bf16_t*)lds; bf16_t* Bs = Cs + 128 * 72; bf16_t* Sin = Bs; bf16_t* XT4 = Bs + 128 * 72; bf16_t* Ms = XT4 + 256 * 136; float* DT = (float*)(Ms + 128 * 136); float* ACS = DT + 512;
    __syncthreads();
    ssd_stage_dt(P, layer, proj, r0, g, DT, ACS, tid);
    ssd_stage_conv<1>(P, layer, proj, r0, c == 0, g, DT, ACS, XT4, Bs, Cs, tid);
    __syncthreads();
    f32x4 CB[8];
#pragma unroll
    for (int st = 0; st < 8; ++st) { CB[st] = (f32x4){0.f, 0.f, 0.f, 0.f};
        if (st <= w) {
#pragma unroll
            for (int ks = 0; ks < 2; ++ks) { const bf16x8 a = *(const bf16x8*)(Cs + (16 * w + fr) * 72 + ks * 32 + fq * 8), bv = *(const bf16x8*)(Bs + (16 * st + fr) * 72 + ks * 32 + fq * 8);
                CB[st] = __builtin_amdgcn_mfma_f32_16x16x32_bf16(a, bv, CB[st], 0, 0, 0); } } }
    float ssq[4] = {0.f, 0.f, 0.f, 0.f};
    const int nks = (w >> 1) + 1;
    bf16_t* zrow[4];
#pragma unroll
    for (int j = 0; j < 4; ++j) zrow[j] = proj + (r0 + 16 * w + fq * 4 + j) * LDP + C_Z + g * 256 + fr;
    f32x4 sna, snc;
    { const float* sp = states + ((size_t)((b * 32 + c) * 16 + g * 4)) * 4096 + (tid >> 3) * 64 + (tid & 7) * 8; sna = *(const f32x4*)sp; snc = *(const f32x4*)(sp + 4); }
    unsigned yg[4][4][2];
#pragma unroll
    for (int hh = 0; hh < 4; ++hh) {
        const int hd = g * 4 + hh;
        __syncthreads();
        { const int p = tid >> 3, n0 = (tid & 7) * 8;
          u32x4 pk; pk[0] = pk2(sna[0], sna[1]); pk[1] = pk2(sna[2], sna[3]); pk[2] = pk2(snc[0], snc[1]); pk[3] = pk2(snc[2], snc[3]);
          *(u32x4*)(Sin + p * 72 + n0) = pk;
          if (hh < 3) { const float* sp = states + ((size_t)((b * 32 + c) * 16 + hd + 1)) * 4096 + p * 64 + n0; sna = *(const f32x4*)sp; snc = *(const f32x4*)(sp + 4); } }
        float acs_t[4];
#pragma unroll
        for (int j = 0; j < 4; ++j) acs_t[j] = ACS[hh * 128 + 16 * w + fq * 4 + j];
#pragma unroll
        for (int st = 0; st < 8; ++st) { if (st <= (w | 1)) { const float acs_s = ACS[hh * 128 + 16 * st + fr];
#pragma unroll
            for (int j = 0; j < 4; ++j) { const int t = 16 * w + fq * 4 + j, sx = 16 * st + fr; const float v = (st <= w && sx <= t) ? CB[st][j] * __expf(acs_t[j] - acs_s) : 0.f; Ms[t * 136 + sx] = f2bf(v); } } }
        __syncthreads();
        bf16_t zv[4][4];
#pragma unroll
        for (int j = 0; j < 4; ++j)
#pragma unroll
            for (int pt = 0; pt < 4; ++pt) zv[j][pt] = *(zrow[j] + hh * 64 + pt * 16);
        f32x4 yd[4], yo[4];
#pragma unroll
        for (int pt = 0; pt < 4; ++pt) { yd[pt] = (f32x4){0.f, 0.f, 0.f, 0.f}; yo[pt] = (f32x4){0.f, 0.f, 0.f, 0.f}; }
        for (int ks = 0; ks < nks; ++ks) { const bf16x8 a = *(const bf16x8*)(Ms + (16 * w + fr) * 136 + ks * 32 + fq * 8);
#pragma unroll
            for (int pt = 0; pt < 4; ++pt) { const bf16x8 bv = *(const bf16x8*)(XT4 + xt_idx(hh * 64 + pt * 16 + fr, ks * 32 + fq * 8)); yd[pt] = __builtin_amdgcn_mfma_f32_16x16x32_bf16(a, bv, yd[pt], 0, 0, 0); } }
#pragma unroll
        for (int ks = 0; ks < 2; ++ks) { const bf16x8 a = *(const bf16x8*)(Cs + (16 * w + fr) * 72 + ks * 32 + fq * 8);
#pragma unroll
            for (int pt = 0; pt < 4; ++pt) { const bf16x8 bv = *(const bf16x8*)(Sin + (pt * 16 + fr) * 72 + ks * 32 + fq * 8); yo[pt] = __builtin_amdgcn_mfma_f32_16x16x32_bf16(a, bv, yo[pt], 0, 0, 0); } }
        const float Dh = P.in[18][layer * 16 + hd];
#pragma unroll
        for (int pt = 0; pt < 4; ++pt) { const int p = pt * 16 + fr; float yy[4];
#pragma unroll
            for (int j = 0; j < 4; ++j) { const int t = 16 * w + fq * 4 + j; const float et = __expf(acs_t[j]), idt = 1.f / DT[hh * 128 + t];
                const float x = bf2f(XT4[xt_idx(hh * 64 + p, t)]) * idt;
                float y = yd[pt][j] + et * yo[pt][j] + Dh * x; y *= silu_fast(bf2f(zv[j][pt])); ssq[j] += y * y; yy[j] = y; }
            yg[hh][pt][0] = pk2(yy[0], yy[1]); yg[hh][pt][1] = pk2(yy[2], yy[3]); }
    }
    const float* ng = P.in[19] + layer * 1024 + g * 256 + fr;
#pragma unroll
    for (int j = 0; j < 4; ++j) { float v = ssq[j];
#pragma unroll
        for (int o = 8; o > 0; o >>= 1) v += shx(v, o, lane);
        ssq[j] = rsqrtf(v * (1.f / 256.f) + EPSF); }
#pragma unroll
    for (int hh = 0; hh < 4; ++hh)
#pragma unroll
        for (int pt = 0; pt < 4; ++pt) { const float gv = ng[(hh * 4 + pt) * 16];
#pragma unroll
            for (int j = 0; j < 4; ++j) { const float yv = (j & 1) ? bfhi(yg[hh][pt][j >> 1]) : bflo(yg[hh][pt][j >> 1]); if (!dry) *(zrow[j] + (hh * 4 + pt) * 16) = f2bf(yv * ssq[j] * gv); } }
}
__device__ __forceinline__ void phase_ssd_scan(const Params& P, int layer) {
    float* states = (float*)(P.ws + WS_SSDST); const float* decs = (const float*)(P.ws + WS_SSDDEC);
    for (int e = blockIdx.x * 512 + otid(); e < 4 * 16 * 4096; e += gridDim.x * 512) {
        const int b = e >> 16, hd = (e >> 12) & 15, pn = e & 4095; float carry = 0.f;
        float st[32], dc[32];
#pragma unroll
        for (int c = 0; c < 32; ++c) { st[c] = states[((size_t)((b * 32 + c) * 16 + hd)) * 4096 + pn]; dc[c] = decs[(b * 32 + c) * 16 + hd]; }
#pragma unroll
        for (int c = 0; c < 32; ++c) { states[((size_t)((b * 32 + c) * 16 + hd)) * 4096 + pn] = carry; carry = carry * dc[c] + st[c]; }
        P.out[O_PSSM + ((size_t)((layer * 4 + b) * 16 + hd)) * 4096 + pn] = carry;
    }
}

__device__ __forceinline__ void attn_prompt_item(const Params& P, int layer, int item, unsigned char* lds, bool dry = false) {
    const int tid = otid(), w = tid >> 6, lane = tid & 63, fr = lane & 15, fq = lane >> 4;
    const int b = item >> 7, nb = (item >> 2) & 31, kvh = item & 3;
    bf16_t* proj = (bf16_t*)(P.ws + WS_PROJ);
    bf16_t* Ks = (bf16_t*)lds;
    bf16_t* Vt = Ks + 256 * 72;
    bf16_t* Pw = Vt + 64 * 280 + w * 16 * 168;
    const long rowK0 = (long)b * 4096 + (long)(nb - 1) * 128;
    const bf16_t* qbase = proj + ((size_t)b * 4096 + (size_t)nb * 128 + w * 16 + fr) * LDP + C_Q + kvh * 256 + fq * 8;
    bf16x8 qa[2], qn[2];
#pragma unroll
    for (int ks = 0; ks < 2; ++ks) { qa[ks] = *(const bf16x8*)(qbase + ks * 32); qn[ks] = qa[ks]; }
    __syncthreads();
#pragma unroll
    for (int idx = tid; idx < 2048; idx += 512) { const int kj = idx >> 3, seg = idx & 7; u32x4 v = (u32x4){0u, 0u, 0u, 0u};
        if (nb > 0 || kj >= 128) v = *(const u32x4*)(proj + (size_t)(rowK0 + kj) * LDP + C_K + kvh * 64 + seg * 8);
        *(u32x4*)(Ks + kj * 72 + seg * 8) = v; }
#pragma unroll
    for (int idx = tid; idx < 2048; idx += 512) { const int seg = idx >> 8, kj = idx & 255; u32x4 v = (u32x4){0u, 0u, 0u, 0u};
        if (nb > 0 || kj >= 128) v = *(const u32x4*)(proj + (size_t)(rowK0 + kj) * LDP + C_V + kvh * 64 + seg * 8);
#pragma unroll
        for (int i = 0; i < 8; ++i) Vt[(seg * 8 + i) * 280 + kj] = (bf16_t)((v[i >> 1] >> ((i & 1) * 16)) & 0xffffu); }
    for (int idx = tid; idx < 64 * 24; idx += 512) { const int d = idx / 24, cc = 256 + idx % 24; Vt[d * 280 + cc] = 0; }
    for (int i = lane; i < 384; i += 64) Pw[(i / 24) * 168 + 144 + i % 24] = 0;
    __syncthreads();
    const int q0 = w * 16;
    const size_t qrow0 = (size_t)b * 4096 + (size_t)nb * 128 + q0;
    for (int gi = 0; gi < 4; ++gi) {
        const int hq = kvh * 4 + gi;
        const float slope = exp2f(-0.5f * (float)(hq + 1));
        const float sink = P.in[21][layer * 16 + hq];
        if (gi < 3) {
#pragma unroll
            for (int ks = 0; ks < 2; ++ks) qn[ks] = *(const bf16x8*)(qbase + (gi + 1) * 64 + ks * 32); }
        f32x4 S[9];
#pragma unroll
        for (int nt = 0; nt < 9; ++nt) { f32x4 a = (f32x4){0.f, 0.f, 0.f, 0.f}; const bf16_t* kp = Ks + (q0 + nt * 16 + fr) * 72 + fq * 8;
#pragma unroll
            for (int ks = 0; ks < 2; ++ks) { const bf16x8 kb = *(const bf16x8*)(kp + ks * 32); a = __builtin_amdgcn_mfma_f32_16x16x32_bf16(qa[ks], kb, a, 0, 0, 0); }
            S[nt] = a; }
        float mx[4] = {-INFINITY, -INFINITY, -INFINITY, -INFINITY};
#pragma unroll
        for (int nt = 0; nt < 9; ++nt)
#pragma unroll
            for (int j = 0; j < 4; ++j) { const int dist = (fq * 4 + j) - (nt * 16 + fr) + 128; const bool valid = dist >= 0 && dist <= 128 && (nb > 0 || (q0 + nt * 16 + fr) >= 128);
                const float s = valid ? S[nt][j] * 0.125f - slope * (float)dist : -INFINITY; S[nt][j] = s; mx[j] = fmaxf(mx[j], s); }
        float inv[4];
#pragma unroll
        for (int j = 0; j < 4; ++j) { float m = mx[j];
#pragma unroll
            for (int o = 8; o > 0; o >>= 1) m = fmaxf(m, shx(m, o, lane));
            m = fmaxf(m, sink); float sum = 0.f;
#pragma unroll
            for (int nt = 0; nt < 9; ++nt) { const float p = __expf(S[nt][j] - m); S[nt][j] = p; sum += p; }
#pragma unroll
            for (int o = 8; o > 0; o >>= 1) sum += shx(sum, o, lane);
            inv[j] = 1.f / (sum + __expf(sink - m)); }
#pragma unroll
        for (int nt = 0; nt < 9; ++nt)
#pragma unroll
            for (int j = 0; j < 4; ++j) Pw[(fq * 4 + j) * 168 + nt * 16 + fr] = f2bf(S[nt][j]);
        asm volatile("s_waitcnt lgkmcnt(0)" ::: "memory"); __builtin_amdgcn_wave_barrier();
        f32x4 O[4];
#pragma unroll
        for (int dt = 0; dt < 4; ++dt) O[dt] = (f32x4){0.f, 0.f, 0.f, 0.f};
#pragma unroll
        for (int ks = 0; ks < 5; ++ks) { const bf16x8 pa = *(const bf16x8*)(Pw + fr * 168 + ks * 32 + fq * 8);
#pragma unroll
            for (int dt = 0; dt < 4; ++dt) { const bf16x8 vb = *(const bf16x8*)(Vt + (dt * 16 + fr) * 280 + q0 + ks * 32 + fq * 8); O[dt] = __builtin_amdgcn_mfma_f32_16x16x32_bf16(pa, vb, O[dt], 0, 0, 0); } }
        asm volatile("s_waitcnt lgkmcnt(0)" ::: "memory"); __builtin_amdgcn_wave_barrier();
#pragma unroll
        for (int dt = 0; dt < 4; ++dt)
#pragma unroll
            for (int j = 0; j < 4; ++j) { if (!dry) proj[(qrow0 + fq * 4 + j) * LDP + C_Q + hq * 64 + dt * 16 + fr] = f2bf(O[dt][j] * inv[j]); }
        qa[0] = qn[0]; qa[1] = qn[1];
    }
    if (nb == 31) {
        for (int idx = tid; idx < 128 * 64; idx += 512) { const int t = idx >> 6, d = idx & 63; const size_t row = (size_t)b * 4096 + 3968 + t;
            const size_t o = ((size_t)((layer * 4 + b) * 128 + t)) * 256 + kvh * 64 + d;
            P.out[O_PK + o] = bf2f(proj[row * LDP + C_K + kvh * 64 + d]); P.out[O_PV + o] = bf2f(proj[row * LDP + C_V + kvh * 64 + d]); }
    }
}
__device__ __forceinline__ void attn_sample_item(const Params& P, int layer, int item, float* L, bool dry = false) {
    const int tid = otid(), w = tid >> 6, lane = tid & 63;
    const int sb = item >> 2, kvh = item & 3, r0 = NPR + sb * 4;
    bf16_t* proj = (bf16_t*)(P.ws + WS_PROJ);
    float* Kf = L; float* Vf = Kf + 132 * 65; float* Q = Vf + 132 * 65; float* Sc = Q + 16 * 64;
    const float* ck = P.in[7] + ((size_t)(layer * 128 + sb)) * 128 * 256; const float* cv = P.in[8] + ((size_t)(layer * 128 + sb)) * 128 * 256;
    __syncthreads();
    {
        f32x4 kq[4], vq[4];
#pragma unroll
        for (int i = 0; i < 4; ++i) { const int idx = tid + i * 512, j = idx >> 4, d4 = (idx & 15) * 4; kq[i] = *(const f32x4*)(ck + (size_t)j * 256 + kvh * 64 + d4); vq[i] = *(const f32x4*)(cv + (size_t)j * 256 + kvh * 64 + d4); }
#pragma unroll
        for (int i = 0; i < 4; ++i) { const int idx = tid + i * 512, j = idx >> 4, d4 = (idx & 15) * 4;
#pragma unroll
            for (int e = 0; e < 4; ++e) { Kf[j * 65 + d4 + e] = kq[i][e]; Vf[j * 65 + d4 + e] = vq[i][e]; }
            if (j >= 4) { const size_t o = ((size_t)((layer * 128 + sb) * 128 + (j - 4))) * 256 + kvh * 64 + d4; *(f32x4*)(P.out + O_SK + o) = kq[i]; *(f32x4*)(P.out + O_SV + o) = vq[i]; } }
        if (tid < 256) { const int j = 128 + (tid >> 6), d = tid & 63; const float kv = bf2f(proj[(size_t)(r0 + j - 128) * LDP + C_K + kvh * 64 + d]), vv = bf2f(proj[(size_t)(r0 + j - 128) * LDP + C_V + kvh * 64 + d]);
            Kf[j * 65 + d] = kv; Vf[j * 65 + d] = vv; const size_t o = ((size_t)((layer * 128 + sb) * 128 + (j - 4))) * 256 + kvh * 64 + d; P.out[O_SK + o] = kv; P.out[O_SV + o] = vv; }
    }
    for (int idx = tid; idx < 1024; idx += 512) { const int qr = idx >> 6, d = idx & 63; Q[idx] = bf2f(proj[(size_t)(r0 + (qr >> 2)) * LDP + C_Q + (kvh * 4 + (qr & 3)) * 64 + d]); }
    __syncthreads();
    for (int idx = tid; idx < 16 * 132; idx += 512) { const int qr = idx / 132, j = idx - qr * 132; const int dist = 128 + (qr >> 2) - j; float s = -INFINITY;
        if (dist >= 0 && dist <= 128) { float a = 0.f;
#pragma unroll 8
            for (int d = 0; d < 64; ++d) a += Q[qr * 64 + d] * Kf[j * 65 + d];
            s = a * 0.125f - exp2f(-0.5f * (float)(kvh * 4 + (qr & 3) + 1)) * (float)dist; }
        Sc[qr * 136 + j] = s; }
    __syncthreads();
    for (int rr = 0; rr < 2; ++rr) { const int qr = w * 2 + rr; const float sink = P.in[21][layer * 16 + kvh * 4 + (qr & 3)];
        float v0 = Sc[qr * 136 + lane], v1 = Sc[qr * 136 + 64 + lane], v2 = lane < 4 ? Sc[qr * 136 + 128 + lane] : -INFINITY;
        float m = fmaxf(fmaxf(v0, v1), v2);
#pragma unroll
        for (int o = 32; o > 0; o >>= 1) m = fmaxf(m, shx(m, o, lane));
        m = fmaxf(m, sink);
        v0 = __expf(v0 - m); v1 = __expf(v1 - m); v2 = __expf(v2 - m);
        const float sum = wave_sum(v0 + v1 + v2, lane); const float inv = 1.f / (sum + __expf(sink - m));
        Sc[qr * 136 + lane] = v0 * inv; Sc[qr * 136 + 64 + lane] = v1 * inv; if (lane < 4) Sc[qr * 136 + 128 + lane] = v2 * inv; }
    __syncthreads();
    for (int idx = tid; idx < 1024; idx += 512) { const int qr = idx >> 6, d = idx & 63; float o = 0.f;
        for (int j = 0; j < 132; ++j) o += Sc[qr * 136 + j] * Vf[j * 65 + d];
        if (!dry) proj[(size_t)(r0 + (qr >> 2)) * LDP + C_Q + (kvh * 4 + (qr & 3)) * 64 + d] = f2bf(o); }
}

__device__ __forceinline__ void gmlp_prompt_item(const Params& P, int layer, int item, unsigned char* lds, bool dry = false) {
    const int tid = otid(), w = tid >> 6, lane = tid & 63, fr = lane & 15, fq = lane >> 4;
    const int b = item >> 8, chn = (item >> 3) & 31, g = item & 7;
    const size_t r0 = (size_t)b * 4096 + (size_t)chn * 128;
    bf16_t* proj = (bf16_t*)(P.ws + WS_PROJ);
    bf16_t* VT = (bf16_t*)lds; bf16_t* Wt = VT + 128 * 136; float* MU = (float*)(Wt + 128 * 136); float* RS = MU + 128;
    __syncthreads();
#pragma unroll
    for (int hb = 0; hb < 2; ++hb) { u32x4 av[8], cv8[8];
#pragma unroll
        for (int i = 0; i < 8; ++i) { const bf16_t* vp = proj + (r0 + w * 16 + hb * 8 + i) * LDP + C_UV + 1024 + lane * 16; av[i] = *(const u32x4*)vp; cv8[i] = *(const u32x4*)(vp + 8); }
#pragma unroll
        for (int i = 0; i < 8; ++i) { const int t = w * 16 + hb * 8 + i; float s = 0.f, sq = 0.f;
#pragma unroll
            for (int k = 0; k < 4; ++k) { float x0 = bflo(av[i][k]), x1 = bfhi(av[i][k]), x2 = bflo(cv8[i][k]), x3 = bfhi(cv8[i][k]); s += x0 + x1 + x2 + x3; sq += x0 * x0 + x1 * x1 + x2 * x2 + x3 * x3; }
            s = wave_sum(s, lane); sq = wave_sum(sq, lane);
            if (lane == 0) { const float mean = s * (1.f / 1024.f); const float var = fmaxf(sq * (1.f / 1024.f) - mean * mean, 0.f); MU[t] = mean; RS[t] = rsqrtf(var + EPSF); } } }
    const float* Wg = P.in[24] + ((size_t)(layer * 8 + g)) * 16384;
#pragma unroll
    for (int idx = tid; idx < 4096; idx += 512) { const int t = idx >> 5, s4 = (idx & 31) * 4; const f32x4 wv = *(const f32x4*)(Wg + t * 128 + s4);
        u32x2 o; o[0] = pk2(s4 <= t ? wv[0] : 0.f, s4 + 1 <= t ? wv[1] : 0.f); o[1] = pk2(s4 + 2 <= t ? wv[2] : 0.f, s4 + 3 <= t ? wv[3] : 0.f);
        *(u32x2*)(Wt + t * 136 + s4) = o; }
    __syncthreads();
    const float* lg = P.in[22] + layer * 1024 + g * 128; const float* lb = P.in[23] + layer * 1024 + g * 128;
#pragma unroll
    for (int idx = tid; idx < 2048; idx += 512) { const int s = idx & 127, fs = idx >> 7; const u32x4 v = *(const u32x4*)(proj + (r0 + s) * LDP + C_UV + 1024 + g * 128 + fs * 8);
        const float mu = MU[s], rs = RS[s];
#pragma unroll
        for (int i = 0; i < 8; ++i) { const int f = fs * 8 + i; const float x = (i & 1) ? bfhi(v[i >> 1]) : bflo(v[i >> 1]); VT[f * 136 + s] = f2bf((x - mu) * rs * lg[f] + lb[f]); } }
    __syncthreads();
    bf16_t uv[4][8]; float bsv[4];
#pragma unroll
    for (int j = 0; j < 4; ++j) { const int t = w * 16 + fq * 4 + j; bsv[j] = P.in[25][(layer * 8 + g) * 128 + t];
#pragma unroll
        for (int ft = 0; ft < 8; ++ft) uv[j][ft] = proj[(r0 + t) * LDP + C_UV + g * 128 + ft * 16 + fr]; }
    f32x4 acc[8];
#pragma unroll
    for (int ft = 0; ft < 8; ++ft) acc[ft] = (f32x4){0.f, 0.f, 0.f, 0.f};
    const int nks = (16 * w + 15) / 32 + 1;
    for (int ks = 0; ks < nks; ++ks) { const bf16x8 a = *(const bf16x8*)(Wt + (w * 16 + fr) * 136 + ks * 32 + fq * 8);
#pragma unroll
        for (int ft = 0; ft < 8; ++ft) { const bf16x8 bb = *(const bf16x8*)(VT + (ft * 16 + fr) * 136 + ks * 32 + fq * 8); acc[ft] = __builtin_amdgcn_mfma_f32_16x16x32_bf16(a, bb, acc[ft], 0, 0, 0); } }
#pragma unroll
    for (int j = 0; j < 4; ++j) { const int t = w * 16 + fq * 4 + j;
#pragma unroll
        for (int ft = 0; ft < 8; ++ft) { if (!dry) proj[(r0 + t) * LDP + C_UV + g * 128 + ft * 16 + fr] = f2bf(gelu_fast(bf2f(uv[j][ft])) * (acc[ft][j] + bsv[j])); } }
}
__device__ __forceinline__ void gmlp_sample_item(const Params& P, int layer, int sb, float* L) {
    const int tid = otid(), w = tid >> 6, lane = tid & 63; const size_t r0 = NPR + sb * 4;
    bf16_t* proj = (bf16_t*)(P.ws + WS_PROJ);
    float* Vn = L; float* MU = Vn + 4096; float* RS = MU + 4;
    __syncthreads();
    if (w < 4) { const bf16_t* vp = proj + (r0 + w) * LDP + C_UV + 1024 + lane * 16; const u32x4 a = *(const u32x4*)vp, c = *(const u32x4*)(vp + 8); float s = 0.f, sq = 0.f;
#pragma unroll
        for (int k = 0; k < 4; ++k) { float x0 = bflo(a[k]), x1 = bfhi(a[k]), x2 = bflo(c[k]), x3 = bfhi(c[k]); s += x0 + x1 + x2 + x3; sq += x0 * x0 + x1 * x1 + x2 * x2 + x3 * x3; }
        s = wave_sum(s, lane); sq = wave_sum(sq, lane);
        if (lane == 0) { const float mean = s * (1.f / 1024.f); const float var = fmaxf(sq * (1.f / 1024.f) - mean * mean, 0.f); MU[w] = mean; RS[w] = rsqrtf(var + EPSF); } }
    __syncthreads();
    for (int idx = tid; idx < 4096; idx += 512) { const int t = idx >> 10, c = idx & 1023;
        const float x = bf2f(proj[(r0 + t) * LDP + C_UV + 1024 + c]); const float vn = (x - MU[t]) * RS[t] * P.in[22][layer * 1024 + c] + P.in[23][layer * 1024 + c];
        Vn[idx] = vn; P.out[O_SGMV + ((size_t)((layer * 128 + sb) * 4 + t)) * 1024 + c] = vn; }
    __syncthreads();
    for (int idx = tid; idx < 4096; idx += 512) { const int t = idx >> 10, c = idx & 1023, g = c >> 7;
        const float* Wg = P.in[24] + ((size_t)(layer * 8 + g)) * 16384 + t * 128; float m = P.in[25][(layer * 8 + g) * 128 + t];
        for (int s = 0; s <= t; ++s) m += Wg[s] * Vn[s * 1024 + c];
        bf16_t* ap = proj + (r0 + t) * LDP + C_UV + c; *ap = f2bf(gelu_fast(bf2f(*ap)) * m); }
}

template <int R>
__device__ __forceinline__ void shortconv_rows(const Params& P, int layer, int r0, int tid, bool dry) {
    bf16_t* proj = (bf16_t*)(P.ws + WS_PROJ);
    const float* cw = P.in[20] + layer * 3 * 1024;
    const int j = tid * 2; const int ss = seq_start(r0); const bool havePrev = (r0 - 2 >= ss);
    unsigned cg[R + 2], xs[R + 2], bg[R];
#pragma unroll
    for (int k = 0; k < R + 2; ++k) { cg[k] = 0u; xs[k] = 0u;
        if (k >= 2 || havePrev) { const bf16_t* rp = proj + (size_t)(r0 - 2 + k) * LDP + C_BCX + j; cg[k] = *(const unsigned*)(rp + 1024); xs[k] = *(const unsigned*)(rp + 2048); } }
#pragma unroll
    for (int k = 0; k < R; ++k) bg[k] = *(const unsigned*)(proj + (size_t)(r0 + k) * LDP + C_BCX + j);
    float pr0[R + 2], pr1[R + 2];
#pragma unroll
    for (int k = 0; k < R + 2; ++k) { pr0[k] = bflo(cg[k]) * bflo(xs[k]); pr1[k] = bfhi(cg[k]) * bfhi(xs[k]); }
    if (!havePrev && r0 >= NPR) { const float* st = P.in[6] + ((size_t)(layer * 128 + ((r0 - NPR) >> 2)) * 2) * 1024 + j; pr0[0] = st[0]; pr1[0] = st[1]; pr0[1] = st[1024]; pr1[1] = st[1025]; }
    const float w0a = cw[j], w0b = cw[j + 1], w1a = cw[1024 + j], w1b = cw[1025 + j], w2a = cw[2048 + j], w2b = cw[2049 + j];
#pragma unroll
    for (int k = 0; k < R; ++k) { const float y0 = w0a * pr0[k] + w1a * pr0[k + 1] + w2a * pr0[k + 2], y1 = w0b * pr1[k] + w1b * pr1[k + 1] + w2b * pr1[k + 2];
        if (!dry) *(unsigned*)(proj + (size_t)(r0 + k) * LDP + C_BCX + j) = pk2(bflo(bg[k]) * y0, bfhi(bg[k]) * y1);
        const int r = r0 + k;
        if (r < NPR) { const int l = r & 4095; if (l >= 4094) { float* o = P.out + O_PSCC + ((size_t)((layer * 4 + (r >> 12)) * 2 + (l - 4094))) * 1024 + j; o[0] = pr0[k + 2]; o[1] = pr1[k + 2]; } }
        else { const int l = (r - NPR) & 3; if (l >= 2) { float* o = P.out + O_SSCC + ((size_t)((layer * 128 + ((r - NPR) >> 2)) * 2 + (l - 2))) * 1024 + j; o[0] = pr0[k + 2]; o[1] = pr1[k + 2]; } }
    }
}
__device__ __forceinline__ void shortconv_item(const Params& P, int layer, int item, bool dry = false) {
    const int tid = otid();
    if (item < 1024) shortconv_rows<16>(P, layer, item * 16, tid, dry); else shortconv_rows<4>(P, layer, NPR + (item - 1024) * 4, tid, dry);
}
__device__ __forceinline__ void ssdconv_state_item(const Params& P, int layer, int sq) {
    const bf16_t* proj = (const bf16_t*)(P.ws + WS_PROJ);
    const size_t rbase = sq < 4 ? (size_t)sq * 4096 + 4093 : (size_t)NPR + (size_t)(sq - 4) * 4 + 1;
    float* o = sq < 4 ? P.out + O_PSSDC + (size_t)(layer * 4 + sq) * 3 * 1536 : P.out + O_SSSDC + (size_t)(layer * 128 + (sq - 4)) * 3 * 1536;
    const int tid = otid(); bf16_t v[9];
#pragma unroll
    for (int i = 0; i < 9; ++i) { const int e = tid + i * 512, t = e / 1536, c = e - t * 1536; v[i] = proj[(rbase + t) * LDP + C_XBC + c]; }
#pragma unroll
    for (int i = 0; i < 9; ++i) o[tid + i * 512] = bf2f(v[i]);
}

template <int R>
__device__ __forceinline__ void ffn_act_unit(const Params& P, int layer, int r0, int oc) {
    const bf16_t* up = (const bf16_t*)(P.ws + WS_PROJ); bf16_t* act = (bf16_t*)(P.ws + WS_PROJ + UP_BYTES);
    const float* cw = P.in[30] + (size_t)layer * 3 * 5632; const float* cb = P.in[31] + (size_t)layer * 5632;
    const int j0 = oc * 8;
    float wa[3][8], wg[3][8], ba[8], bgv[8], pa[2][8], pg[2][8];
#pragma unroll
    for (int k = 0; k < 3; ++k) { const f32x4 a0 = *(const f32x4*)(cw + k * 5632 + j0), a1 = *(const f32x4*)(cw + k * 5632 + j0 + 4), g0 = *(const f32x4*)(cw + k * 5632 + 2816 + j0), g1 = *(const f32x4*)(cw + k * 5632 + 2816 + j0 + 4);
#pragma unroll
        for (int i = 0; i < 4; ++i) { wa[k][i] = a0[i]; wa[k][4 + i] = a1[i]; wg[k][i] = g0[i]; wg[k][4 + i] = g1[i]; } }
    { const f32x4 a0 = *(const f32x4*)(cb + j0), a1 = *(const f32x4*)(cb + j0 + 4), g0 = *(const f32x4*)(cb + 2816 + j0), g1 = *(const f32x4*)(cb + 2816 + j0 + 4);
#pragma unroll
      for (int i = 0; i < 4; ++i) { ba[i] = a0[i]; ba[4 + i] = a1[i]; bgv[i] = g0[i]; bgv[4 + i] = g1[i]; } }
    const int ss = seq_start(r0); const bool havePrev = (r0 - 2 >= ss);
#pragma unroll
    for (int k = 0; k < 2; ++k) {
        if (havePrev) { const u32x4 ua = *(const u32x4*)(up + (size_t)(r0 - 2 + k) * 5632 + j0), ug = *(const u32x4*)(up + (size_t)(r0 - 2 + k) * 5632 + 2816 + j0);
#pragma unroll
            for (int i = 0; i < 4; ++i) { pa[k][2 * i] = bflo(ua[i]); pa[k][2 * i + 1] = bfhi(ua[i]); pg[k][2 * i] = bflo(ug[i]); pg[k][2 * i + 1] = bfhi(ug[i]); } }
        else if (r0 >= NPR) { const float* pp = P.in[9] + ((size_t)(layer * 128 + ((r0 - NPR) >> 2)) * 2 + k) * 5632;
#pragma unroll
            for (int i = 0; i < 8; ++i) { pa[k][i] = pp[j0 + i]; pg[k][i] = pp[2816 + j0 + i]; } }
        else {
#pragma unroll
            for (int i = 0; i < 8; ++i) { pa[k][i] = 0.f; pg[k][i] = 0.f; } } }
#pragma unroll
    for (int kb = 0; kb < R; kb += 4) { u32x4 ua[4], ug[4];
#pragma unroll
        for (int q = 0; q < 4; ++q) { ua[q] = *(const u32x4*)(up + (size_t)(r0 + kb + q) * 5632 + j0); ug[q] = *(const u32x4*)(up + (size_t)(r0 + kb + q) * 5632 + 2816 + j0); }
#pragma unroll
        for (int q = 0; q < 4; ++q) { const int r = r0 + kb + q; float ca[8], cgv[8], o[8];
#pragma unroll
            for (int i = 0; i < 4; ++i) { ca[2 * i] = bflo(ua[q][i]); ca[2 * i + 1] = bfhi(ua[q][i]); cgv[2 * i] = bflo(ug[q][i]); cgv[2 * i + 1] = bfhi(ug[q][i]); }
#pragma unroll
            for (int i = 0; i < 8; ++i) { const float a = ba[i] + wa[0][i] * pa[0][i] + wa[1][i] * pa[1][i] + wa[2][i] * ca[i], g = bgv[i] + wg[0][i] * pg[0][i] + wg[1][i] * pg[1][i] + wg[2][i] * cgv[i];
                o[i] = silu_fast(a) * g; pa[0][i] = pa[1][i]; pa[1][i] = ca[i]; pg[0][i] = pg[1][i]; pg[1][i] = cgv[i]; }
            u32x4 ov; ov[0] = pk2(o[0], o[1]); ov[1] = pk2(o[2], o[3]); ov[2] = pk2(o[4], o[5]); ov[3] = pk2(o[6], o[7]);
            *(u32x4*)(act + (size_t)r * 2816 + j0) = ov;
            float* so = nullptr;
            if (r < NPR) { const int l = r & 4095; if (l >= 4094) so = P.out + O_PFFC + ((size_t)((layer * 4 + (r >> 12)) * 2 + (l - 4094))) * 5632; }
            else { const int l = (r - NPR) & 3; if (l >= 2) so = P.out + O_SFFC + ((size_t)((layer * 128 + ((r - NPR) >> 2)) * 2 + (l - 2))) * 5632; }
            if (so) {
#pragma unroll
                for (int i = 0; i < 8; ++i) { so[j0 + i] = ca[i]; so[2816 + j0 + i] = cgv[i]; } }
        } }
}
__device__ __forceinline__ void phase_ffn_act(const Params& P, int layer) {
    constexpr int NU_P = 2048 * 352, NU_S = 128 * 352;
    for (int u = blockIdx.x * 512 + otid(); u < NU_P + NU_S; u += gridDim.x * 512) {
        if (u < NU_P) { const int rb = u / 352, oc = u - rb * 352; ffn_act_unit<8>(P, layer, rb * 8, oc); }
        else { const int v = u - NU_P, sq = v / 352, oc = v - sq * 352; ffn_act_unit<4>(P, layer, NPR + sq * 4, oc); }
    }
}

__device__ __forceinline__ void sgemm_partial(const bf16_t* A, int lda, const bf16_t* Bt, int ldb, int K, int row0, int col0, float* red, int tid) {
    const int w = tid >> 6, lane = tid & 63, fr = lane & 15, fq = lane >> 4;
    const int kw = K >> 3, k0 = w * kw;
    f32x4 acc[2][4];
#pragma unroll
    for (int mt = 0; mt < 2; ++mt)
#pragma unroll
        for (int nt = 0; nt < 4; ++nt) acc[mt][nt] = (f32x4){0.f, 0.f, 0.f, 0.f};
    const bf16_t* ap = A + (size_t)(row0 + fr) * lda + k0 + fq * 8;
    const bf16_t* bp = Bt + (size_t)(col0 + fr) * ldb + k0 + fq * 8;
    const int nks = kw >> 5;
#pragma unroll 4
    for (int ks = 0; ks < nks; ++ks) { bf16x8 a[2], b[4];
#pragma unroll
        for (int mt = 0; mt < 2; ++mt) a[mt] = *(const bf16x8*)(ap + (size_t)mt * 16 * lda + ks * 32);
#pragma unroll
        for (int nt = 0; nt < 4; ++nt) b[nt] = *(const bf16x8*)(bp + (size_t)nt * 16 * ldb + ks * 32);
#pragma unroll
        for (int mt = 0; mt < 2; ++mt)
#pragma unroll
            for (int nt = 0; nt < 4; ++nt) acc[mt][nt] = __builtin_amdgcn_mfma_f32_16x16x32_bf16(a[mt], b[nt], acc[mt][nt], 0, 0, 0); }
#pragma unroll
    for (int mt = 0; mt < 2; ++mt)
#pragma unroll
        for (int nt = 0; nt < 4; ++nt)
#pragma unroll
            for (int j = 0; j < 4; ++j) red[(w * 32 + mt * 16 + fq * 4 + j) * 64 + nt * 16 + fr] = acc[mt][nt][j];
}
__device__ __forceinline__ f32x4 sgemm_reduce(const float* red, int tid) {
    const int row = tid >> 4, c4 = (tid & 15) * 4; f32x4 sacc = (f32x4){0.f, 0.f, 0.f, 0.f};
#pragma unroll
    for (int w = 0; w < 8; ++w) sacc += *(const f32x4*)(red + (w * 32 + row) * 64 + c4);
    return sacc;
}
__device__ __forceinline__ void sg_load4(const bf16_t* ap, int lda, const bf16_t* bp, int ldb, bf16x8 (&a)[4][2], bf16x8 (&b)[4][4]) {
#pragma unroll
    for (int ks = 0; ks < 4; ++ks) {
#pragma unroll
        for (int mt = 0; mt < 2; ++mt) a[ks][mt] = *(const bf16x8*)(ap + (size_t)mt * 16 * lda + ks * 32);
#pragma unroll
        for (int nt = 0; nt < 4; ++nt) b[ks][nt] = *(const bf16x8*)(bp + (size_t)nt * 16 * ldb + ks * 32); }
}
__device__ __forceinline__ void sample_branch(const Params& P, int layer, float* red) {
    const int tid = otid(), w = tid >> 6, lane = tid & 63, fr = lane & 15, fq = lane >> 4;
    const bf16_t* proj = (const bf16_t*)(P.ws + WS_PROJ); bf16_t* hbuf = (bf16_t*)(P.ws + WS_H);
    for (int piece = blockIdx.x; piece < 256; piece += gridDim.x) {
        const int row0 = (piece >> 4) * 32, col0 = (piece & 15) * 64; const size_t r = NPR + row0 + (tid >> 4); const int c = col0 + (tid & 15) * 4;
        const bf16_t* abase = proj + (size_t)(NPR + row0 + fr) * LDP + w * 128 + fq * 8;
        const bf16_t* bbase = (const bf16_t*)(P.ws + WS_WBR) + (size_t)layer * 4 * 1048576 + (size_t)(col0 + fr) * 1024 + w * 128 + fq * 8;
        bf16x8 a[4][2], b[4][4];
        sg_load4(abase + C_Z, LDP, bbase, 1024, a, b);
        f32x4 sum = (f32x4){0.f, 0.f, 0.f, 0.f};
        for (int z = 0; z < 4; ++z) {
            f32x4 acc[2][4];
#pragma unroll
            for (int mt = 0; mt < 2; ++mt)
#pragma unroll
                for (int nt = 0; nt < 4; ++nt) acc[mt][nt] = (f32x4){0.f, 0.f, 0.f, 0.f};
#pragma unroll
            for (int ks = 0; ks < 4; ++ks)
#pragma unroll
                for (int mt = 0; mt < 2; ++mt)
#pragma unroll
                    for (int nt = 0; nt < 4; ++nt) acc[mt][nt] = __builtin_amdgcn_mfma_f32_16x16x32_bf16(a[ks][mt], b[ks][nt], acc[mt][nt], 0, 0, 0);
            if (z < 3) { const int ao = z == 0 ? C_BCX : (z == 1 ? C_Q : C_UV); sg_load4(abase + ao, LDP, bbase + (size_t)(z + 1) * 1048576, 1024, a, b); }
            const u32x2 gv = *(const u32x2*)(proj + r * LDP + C_GATE + z * 1024 + c);
            __syncthreads();
#pragma unroll
            for (int mt = 0; mt < 2; ++mt)
#pragma unroll
                for (int nt = 0; nt < 4; ++nt)
#pragma unroll
                    for (int j = 0; j < 4; ++j) red[(w * 32 + mt * 16 + fq * 4 + j) * 64 + nt * 16 + fr] = acc[mt][nt][j];
            __syncthreads();
            const f32x4 v = sgemm_reduce(red, tid);
            sum[0] += sigmoid_fast(bflo(gv[0])) * v[0]; sum[1] += sigmoid_fast(bfhi(gv[0])) * v[1]; sum[2] += sigmoid_fast(bflo(gv[1])) * v[2]; sum[3] += sigmoid_fast(bfhi(gv[1])) * v[3];
        }
        u32x2 o; o[0] = pk2(sum[0], sum[1]); o[1] = pk2(sum[2], sum[3]); *(u32x2*)(hbuf + r * 1024 + c) = o;
        __syncthreads();
    }
}
__device__ __forceinline__ void sample_resid(const Params& P, const bf16_t* A, int lda, const bf16_t* Bt, int K, const float* xin_s, float* xout, const float* ga, float* red) {
    const int tid = otid();
    for (int piece = blockIdx.x; piece < 256; piece += gridDim.x) {
        const int row0 = (piece >> 4) * 32, col0 = (piece & 15) * 64; const int rs = row0 + (tid >> 4), c = col0 + (tid & 15) * 4;
        const f32x4 xv = *(const f32x4*)(xin_s + (size_t)rs * 1024 + c), gv = *(const f32x4*)(ga + (size_t)(4 + (rs >> 2)) * 6144 + c);
        __syncthreads();
        sgemm_partial(A, lda, Bt, K, K, row0, col0, red, tid);
        __syncthreads();
        const f32x4 v = sgemm_reduce(red, tid);
        *(f32x4*)(xout + (size_t)(NPR + rs) * 1024 + c) = xv + gv * v;
    }
}

__device__ __forceinline__ void grid_bar(unsigned* ctr, unsigned& epoch) {
    asm volatile("s_waitcnt vmcnt(0) lgkmcnt(0)" ::: "memory");
    __syncthreads();
    epoch += 1;
    if (otid() == 0) {
        __builtin_amdgcn_fence(__ATOMIC_RELEASE, "agent");
        asm volatile("s_waitcnt vmcnt(0) lgkmcnt(0)" ::: "memory");
        __hip_atomic_fetch_add(ctr, 1u, __ATOMIC_RELAXED, __HIP_MEMORY_SCOPE_AGENT);
        const unsigned target = epoch * gridDim.x;
        while (__hip_atomic_load(ctr, __ATOMIC_RELAXED, __HIP_MEMORY_SCOPE_AGENT) < target) __builtin_amdgcn_s_sleep(1);
        __builtin_amdgcn_fence(__ATOMIC_ACQUIRE, "agent");
        asm volatile("s_waitcnt vmcnt(0) lgkmcnt(0)" ::: "memory");
    }
    __syncthreads();
}

#ifndef PHMASK
#define PHMASK 0xFFFFFFFF
#endif
#define EN(x) ((PHMASK >> (x)) & 1)
#ifndef DRYM
#define DRYM 0
#endif
#ifndef DBL
#define DBL 0
#endif
#define REP(x) (((DBL >> (x)) & 1) ? 2 : 1)
constexpr int PH_PER_LAYER = 11, N_PHASES = 2 + 4 * PH_PER_LAYER + 1;

__global__ void __launch_bounds__(512, 2) mega_fwd(Params PK) {
    extern __shared__ __attribute__((aligned(16))) unsigned char lds_raw[];
    cg::grid_group grid = cg::this_grid();
    LAS unsigned char* ldsl = (LAS unsigned char*)lds_raw;
    unsigned epoch = 0;
    for (int ph = PK.ph_lo; ph < PK.ph_hi; ++ph) {
        Params P = PK;
        { unsigned char* w_ = P.ws; asm volatile("" : "+s"(w_)); P.ws = w_; float* o_ = P.out; asm volatile("" : "+s"(o_)); P.out = o_; }
        unsigned* barctr = (unsigned*)(P.ws + WS_BAR);
        bf16_t* proj = (bf16_t*)(P.ws + WS_PROJ);
        bf16_t* hbuf = (bf16_t*)(P.ws + WS_H);
        float* xbuf = P.out;
        float* mod = (float*)(P.ws + WS_MOD);
        if (ph == 0) { for (int rp = 0; rp < REP(0); ++rp) phase_convert(P, (float*)lds_raw); }
        else if (ph == 1) {
            Gemm g{(const bf16_t*)(P.ws + WS_CACT), (const bf16_t*)(P.ws + WS_WADA), 1024, 1024, 1024, 1, 96, 0, 0, 0, 0, 0};
            EpiMod E{mod, P.in[11]};
            for (int rp = 0; rp < REP(1); ++rp) gemm_phase<EpiMod, 1>(ldsl, g, E);
        }
        else if (ph == N_PHASES - 1) { phase_final_norm(xbuf, P.in[33]); }
        else {
            const int layer = (ph - 2) / PH_PER_LAYER, sp = (ph - 2) % PH_PER_LAYER;
            const float* modL = mod + (size_t)layer * NCOND * 6144;
            const float* xin_p = layer == 0 ? P.in[0] : xbuf; const float* xin_s = layer == 0 ? P.in[1] : xbuf + (size_t)NPR * 1024;
            if (sp == 0) { for (int rp = 0; rp < REP(16); ++rp) phase_norm(xin_p, xin_s, P.in[12] + layer * 1024, modL, 0, 1024, hbuf); }
            else if (sp == 1) {
                Gemm g{hbuf, (const bf16_t*)(P.ws + WS_WIN) + (size_t)layer * 13568 * 1024, 1024, 1024, 1024, 66, 53, 0, 0, 0, 0, 0};
                EpiProj E{proj};
                for (int rp = 0; rp < REP(2); ++rp) gemm_phase<EpiProj, 1>(ldsl, g, E);
            }
            else if (sp == 2) {
                for (int it = blockIdx.x; it < 3972 + 256; it += gridDim.x) {
                    if (it < 512) { for (int rp = 0; rp < REP(3); ++rp) ssd_pass1_item(P, layer, it, lds_raw); }
                    else if (it < 1024) { for (int rp = (DRYM & 1) ? 0 : 1; rp < 2; ++rp) attn_prompt_item(P, layer, it - 512, lds_raw, rp == 0 && P.ph_lo == 0); }
                    else if (it < 1536) { for (int rp = (DRYM & 2) ? 0 : 1; rp < 2; ++rp) attn_sample_item(P, layer, it - 1024, (float*)lds_raw, rp == 0 && P.ph_lo == 0); }
                    else if (it < 2560) { for (int rp = (DRYM & 4) ? 0 : 1; rp < 2; ++rp) gmlp_prompt_item(P, layer, it - 1536, lds_raw, rp == 0 && P.ph_lo == 0); }
                    else if (it < 2688) { if (EN(8)) gmlp_sample_item(P, layer, it - 2560, (float*)lds_raw); }
                    else if (it < 3840) { for (int rp = (DRYM & 8) ? 0 : 1; rp < 2; ++rp) shortconv_item(P, layer, it - 2688, rp == 0 && P.ph_lo == 0); }
                    else if (it < 3972) ssdconv_state_item(P, layer, it - 3840);
                    else ssd_item<2>(P, layer, it - 3972, (float*)lds_raw);
                }
            }
            else if (sp == 3) { phase_ssd_scan(P, layer); }
            else if (sp == 4) { for (int it = blockIdx.x; it < 512; it += gridDim.x) for (int rp = (DRYM & 16) ? 0 : 1; rp < 2; ++rp) ssd_pass3_item(P, layer, it, lds_raw, rp == 0 && P.ph_lo == 0); }
            else if (sp == 5) {
                Gemm g{proj, (const bf16_t*)(P.ws + WS_WBR) + (size_t)layer * 4 * 1048576, LDP, 1024, 1024, 64, 4, C_Z, C_BCX, C_Q, C_UV, (size_t)1048576};
                EpiBranch E{proj, (float*)(P.ws + WS_MSUM), hbuf};
                for (int rp = 0; rp < REP(11); ++rp) gemm_phase<EpiBranch, 4>(ldsl, g, E);
                for (int rp = 0; rp < REP(17); ++rp) sample_branch(P, layer, (float*)lds_raw);
            }
            else if (sp == 6) {
                Gemm g{hbuf, (const bf16_t*)(P.ws + WS_WO) + (size_t)layer * 1048576, 1024, 1024, 1024, 64, 4, 0, 0, 0, 0, 0};
                EpiResid E{xin_p, xin_s, xbuf, modL + 2048};
                if (EN(12)) gemm_phase<EpiResid, 1>(ldsl, g, E);
                sample_resid(P, hbuf + (size_t)NPR * 1024, 1024, (const bf16_t*)(P.ws + WS_WO) + (size_t)layer * 1048576, 1024, xin_s, xbuf, modL + 2048, (float*)lds_raw);
            }
            else if (sp == 7) { for (int rp = 0; rp < REP(16); ++rp) phase_norm(xbuf, xbuf + (size_t)NPR * 1024, P.in[28] + layer * 1024, modL, 3072, 4096, hbuf); }
            else if (sp == 8) {
                Gemm g{hbuf, (const bf16_t*)(P.ws + WS_WUP) + (size_t)layer * 5632 * 1024, 1024, 1024, 1024, 66, 22, 0, 0, 0, 0, 0};
                EpiUp E{proj};
                for (int rp = 0; rp < REP(13); ++rp) gemm_phase<EpiUp, 1>(ldsl, g, E);
            }
            else if (sp == 9) { for (int rp = 0; rp < REP(14); ++rp) phase_ffn_act(P, layer); }
            else {
                Gemm g{(const bf16_t*)(P.ws + WS_PROJ + UP_BYTES), (const bf16_t*)(P.ws + WS_WDN) + (size_t)layer * 1024 * 2816, 2816, 2816, 2816, 64, 4, 0, 0, 0, 0, 0};
                EpiResid E{xbuf, xbuf + (size_t)NPR * 1024, xbuf, modL + 5120};
                if (EN(15)) gemm_phase<EpiResid, 1>(ldsl, g, E);
                sample_resid(P, (const bf16_t*)(P.ws + WS_PROJ + UP_BYTES) + (size_t)NPR * 2816, 2816, (const bf16_t*)(P.ws + WS_WDN) + (size_t)layer * 1024 * 2816, 2816, xbuf + (size_t)NPR * 1024, xbuf, modL + 5120, (float*)lds_raw);
            }
        }
        if (ph + 1 < P.ph_hi) { if (ph == 0) grid.sync(); else grid_bar(barctr, epoch); }
    }
}

extern "C" void kernel_launch(void* const* d_in, const int* in_sizes, int n_in, void* d_out, int out_size, void* d_ws, size_t ws_size, hipStream_t stream) {
    static int grid_blocks = 0;
    if (grid_blocks == 0) {
        if (n_in != 34 || (size_t)out_size != O_END || ws_size < WS_END + 256) { fprintf(stderr, "kernel_launch: unexpected sizes n_in %d out %d ws %zu (need %zu)\n", n_in, out_size, ws_size, (size_t)WS_END); grid_blocks = -1; return; }
        int dev = 0, cus = 0, per_cu = 0;
        (void)hipGetDevice(&dev); (void)hipDeviceGetAttribute(&cus, hipDeviceAttributeMultiprocessorCount, dev);
        if (hipFuncSetAttribute((const void*)mega_fwd, hipFuncAttributeMaxDynamicSharedMemorySize, LDS_BYTES) != hipSuccess) { fprintf(stderr, "hipFuncSetAttribute failed\n"); grid_blocks = -1; return; }
        if (hipOccupancyMaxActiveBlocksPerMultiprocessor(&per_cu, (const void*)mega_fwd, 512, LDS_BYTES) != hipSuccess || per_cu < 1) per_cu = 1;
        grid_blocks = cus * 1;
    }
    if (grid_blocks < 0) return;
    Params p{};
    for (int i = 0; i < 34; ++i) p.in[i] = (const float*)d_in[i];
    p.out = (float*)d_out; p.ws = (unsigned char*)d_ws; p.ph_lo = 0; p.ph_hi = N_PHASES;
    (void)hipMemsetAsync((unsigned char*)d_ws + WS_BAR, 0, 256, stream);
    void* args[] = {&p};
    hipError_t e = hipLaunchCooperativeKernel((const void*)mega_fwd, dim3(grid_blocks), dim3(512), args, LDS_BYTES, stream);
    if (e != hipSuccess) fprintf(stderr, "cooperative launch failed: %s (grid %d)\n", hipGetErrorString(e), grid_blocks);
}
```

```cpp
#include <hip/hip_runtime.h>
#include <hip/hip_cooperative_groups.h>
#include <cstdio>
namespace cg = cooperative_groups;

typedef unsigned short bf16_t;
typedef short bf16x8 __attribute__((ext_vector_type(8)));
typedef float f32x4 __attribute__((ext_vector_type(4)));
typedef unsigned u32x4 __attribute__((ext_vector_type(4)));
typedef unsigned u32x2 __attribute__((ext_vector_type(2)));
#define LAS __attribute__((address_space(3)))

constexpr int NTOK = 16896, NPR = 16384;
constexpr int LDP = 13568;
constexpr int C_Z = 0, C_XBC = 1024, C_DTR = 2560, C_BCX = 2576, C_Q = 5648, C_K = 6672, C_V = 6928, C_UV = 7184, C_GATE = 9232, C_END = 13328;
constexpr int NCOND = 132;
constexpr float EPSF = 1e-6f;

constexpr size_t WS_WIN = 0;
constexpr size_t WS_WBR = WS_WIN + (size_t)4 * 13568 * 1024 * 2;
constexpr size_t WS_WO = WS_WBR + (size_t)16 * 1024 * 1024 * 2;
constexpr size_t WS_WUP = WS_WO + (size_t)4 * 1024 * 1024 * 2;
constexpr size_t WS_WDN = WS_WUP + (size_t)4 * 5632 * 1024 * 2;
constexpr size_t WS_WADA = WS_WDN + (size_t)4 * 1024 * 2816 * 2;
constexpr size_t WS_CACT = WS_WADA + (size_t)4 * 6144 * 1024 * 2;
constexpr size_t WS_MOD = WS_CACT + (size_t)256 * 1024 * 2;
constexpr size_t WS_H = WS_MOD + (size_t)4 * NCOND * 6144 * 4;
constexpr size_t WS_MSUM = WS_H + (size_t)NTOK * 1024 * 2;
constexpr size_t WS_PROJ = WS_MSUM + (size_t)NTOK * 1024 * 4;
constexpr size_t WS_END = WS_PROJ + (size_t)NTOK * LDP * 2;
constexpr size_t WS_BAR = WS_END;
constexpr size_t WS_SSDST = WS_WADA;
constexpr size_t WS_SSDDEC = WS_WADA + (size_t)4 * 32 * 16 * 4096 * 4;
constexpr size_t UP_BYTES = (size_t)NTOK * 5632 * 2;

constexpr size_t O_YP = 0, O_YS = 16777216, O_PSSM = O_YS + 524288, O_PSSDC = O_PSSM + 1048576, O_PSCC = O_PSSDC + 73728,
                 O_PK = O_PSCC + 32768, O_PV = O_PK + 524288, O_PFFC = O_PV + 524288, O_SSSM = O_PFFC + 180224,
                 O_SSSDC = O_SSSM + 33554432, O_SSCC = O_SSSDC + 2359296, O_SK = O_SSCC + 1048576, O_SV = O_SK + 16777216,
                 O_SFFC = O_SV + 16777216, O_SGMV = O_SFFC + 5767168, O_END = O_SGMV + 2097152;

struct Params { const float* in[34]; float* out; unsigned char* ws; int ph_lo, ph_hi; };

constexpr int LDS_BYTES = 155648;

__device__ __forceinline__ float bf2f(bf16_t v) { return __uint_as_float((unsigned)v << 16); }
__device__ __forceinline__ float bflo(unsigned v) { return __uint_as_float(v << 16); }
__device__ __forceinline__ float bfhi(unsigned v) { return __uint_as_float(v & 0xffff0000u); }
__device__ __forceinline__ unsigned pk2(float lo, float hi) { unsigned r; asm("v_cvt_pk_bf16_f32 %0, %1, %2" : "=v"(r) : "v"(lo), "v"(hi)); return r; }
__device__ __forceinline__ bf16_t f2bf(float f) { return (bf16_t)(pk2(f, 0.f) & 0xffffu); }
__device__ __forceinline__ float shx(float v, int o, int lane) { return __int_as_float(__builtin_amdgcn_ds_bpermute((lane ^ o) << 2, __float_as_int(v))); }
__device__ __forceinline__ float wave_sum(float v, int lane) {
#pragma unroll
    for (int o = 32; o > 0; o >>= 1) v += shx(v, o, lane);
    return v;
}
__device__ __forceinline__ int otid() { int t = threadIdx.x; asm volatile("" : "+v"(t)); return t; }
__device__ __forceinline__ float sigmoidf_(float x) { return __builtin_amdgcn_rcpf(1.f + __expf(-x)); }
__device__ __forceinline__ float siluf_(float x) { return x * __builtin_amdgcn_rcpf(1.f + __expf(-x)); }
__device__ __forceinline__ float geluf_(float x) { const float u = 0.7978845608f * (x + 0.044715f * x * x * x); return x / (1.f + __expf(-2.f * u)); }
__device__ __forceinline__ float softplusf_(float x) { return fmaxf(x, 0.f) + log1pf(__expf(-fabsf(x))); }
__device__ __forceinline__ float silu_fast(float x) { return x * __builtin_amdgcn_rcpf(1.f + __expf(-x)); }
__device__ __forceinline__ float sigmoid_fast(float x) { return __builtin_amdgcn_rcpf(1.f + __expf(-x)); }
__device__ __forceinline__ float gelu_fast(float x) { const float u = 0.7978845608f * (x + 0.044715f * x * x * x); return x * __builtin_amdgcn_rcpf(1.f + __expf(-2.f * u)); }
__device__ __forceinline__ int cond_row(int r) { return r < NPR ? (r >> 12) : 4 + ((r - NPR) >> 2); }
__device__ __forceinline__ int seq_start(int r) { return r < NPR ? (r & ~4095) : NPR + ((r - NPR) & ~3); }

constexpr int BM = 256, BK = 64, HALF = 128, HTB = HALF * BK * 2;
__device__ __forceinline__ int lds_byte(int r, int c) { const int st = (r >> 4) * 2 + (c >> 5), rr = r & 15, cc = c & 31, ob = rr * 64 + cc * 2; return st * 1024 + (ob ^ (((ob >> 9) & 1) << 5)); }
__device__ __forceinline__ void stage_rc(int b, int& R, int& C) { const int st = b / 1024, sb = b % 1024, swz = sb ^ (((sb >> 9) & 1) << 5); R = (st >> 1) * 16 + swz / 64; C = (st & 1) * 32 + (swz % 64) / 2; }
__device__ __forceinline__ int perm32(int rho) { const int n = rho >> 4, i = rho & 15; return 8 * (i >> 2) + 4 * n + (i & 3); }

struct Unit { int pm, pn, z; };
struct Gemm { const bf16_t* A; const bf16_t* Bt; int lda, ldb, K, nM, nN; int ao0, ao1, ao2, ao3; size_t zB; };
__device__ __forceinline__ int gemm_aofs(const Gemm& g, int z) { return z == 0 ? g.ao0 : (z == 1 ? g.ao1 : (z == 2 ? g.ao2 : g.ao3)); }

template <int ZN> __device__ __forceinline__ bool unit_next(const Gemm& g, int i, Unit& u) {
    const int tile = i / ZN; u.z = i - tile * ZN;
    const long L = (long)tile * gridDim.x + blockIdx.x; const int nwg = g.nM * g.nN; if (L >= nwg) return false;
    int wgid = (int)L; { const int q = nwg / 8, r = nwg % 8, xcd = wgid % 8, off = wgid / 8; wgid = (xcd < r ? xcd * (q + 1) : r * (q + 1) + (xcd - r) * q) + off; }
    const int nig = 4 * g.nN, gid = wgid / nig, fm = gid * 4, gsz = (g.nM - fm) < 4 ? (g.nM - fm) : 4;
    u.pm = fm + ((wgid % nig) % gsz); u.pn = (wgid % nig) / gsz; return true;
}

template <class Epi, int ZN>
__device__ __forceinline__ void gemm_phase(LAS unsigned char* lds, const Gemm g, const Epi& E) {
    const int tid = otid(), wid = __builtin_amdgcn_readfirstlane(tid >> 6), lane = tid & 63, wr = wid >> 2, wc = wid & 3, fr = lane & 15, fq = lane >> 4;
    const int K = g.K, nt = K / BK;
    unsigned voffA[2], voffB[2];
#pragma unroll
    for (int i = 0; i < 2; ++i) { int R, C; stage_rc(tid * 16 + i * 8192, R, C); const int Rb = Epi::PERM ? ((R & ~31) + perm32(R & 31)) : R;
        voffA[i] = (unsigned)(R * g.lda + C) * 2u; voffB[i] = (unsigned)(Rb * g.ldb + C) * 2u; }
    const size_t kstep = (size_t)(BK * 2);
    const size_t hstepA = (size_t)HALF * g.lda * 2, hstepB = (size_t)HALF * g.ldb * 2;
    const size_t tstepA = 2 * hstepA, tstepB = 2 * hstepB;
    const unsigned ldsw = (unsigned)wid * 1024u;
    const int aoff = lds_byte(wr * 64 + fr, fq * 8), boff = lds_byte(wc * 32 + fr, fq * 8);
#define PG8_SA(b, h) (((b) * 2 + (h)) * HTB)
#define PG8_SB(b, h) ((4 + (b) * 2 + (h)) * HTB)
#define PG8_STAGE(bufoff, gbase, voff) do { _Pragma("unroll") for (int _i = 0; _i < 2; ++_i) \
        __builtin_amdgcn_global_load_lds((const unsigned*)((const char*)(gbase) + (voff)[_i]), (LAS unsigned*)(lds + (bufoff) + ldsw + _i * 8192), 16, 0, 0); } while (0)
#define PG8_LDA(dst, b, h) do { _Pragma("unroll") for (int m = 0; m < 4; ++m) _Pragma("unroll") for (int k = 0; k < 2; ++k) dst[m][k] = *(const LAS bf16x8*)(lds + PG8_SA(b, h) + aoff + m * 2048 + k * 1024); } while (0)
#define PG8_LDB(dst, b, h) do { _Pragma("unroll") for (int n = 0; n < 2; ++n) _Pragma("unroll") for (int k = 0; k < 2; ++k) dst[n][k] = *(const LAS bf16x8*)(lds + PG8_SB(b, h) + boff + n * 2048 + k * 1024); } while (0)
#define PG8_MMA(ai, bj, At, Bt) do { __builtin_amdgcn_s_setprio(1); _Pragma("unroll") for (int m = 0; m < 4; ++m) _Pragma("unroll") for (int n = 0; n < 2; ++n) _Pragma("unroll") for (int k = 0; k < 2; ++k) \
        acc[ai][bj][m][n] = __builtin_amdgcn_mfma_f32_16x16x32_bf16(Bt[n][k], At[m][k], acc[ai][bj][m][n], 0, 0, 0); __builtin_amdgcn_s_setprio(0); } while (0)
#define PG8_WAIT_V(n) asm volatile("s_waitcnt vmcnt(" #n ")" ::: "memory")
#define PG8_WAIT_L(n) asm volatile("s_waitcnt lgkmcnt(" #n ")" ::: "memory")
#define PG8_BAR __builtin_amdgcn_s_barrier()
#define PG8_SCHED __builtin_amdgcn_sched_barrier(0)
    Unit cur, nxt; int ui = 0;
    if (!unit_next<ZN>(g, 0, cur)) return;
    f32x4 acc[2][2][4][2];
#pragma unroll
    for (int a = 0; a < 2; ++a)
#pragma unroll
        for (int b = 0; b < 2; ++b)
#pragma unroll
            for (int m = 0; m < 4; ++m)
#pragma unroll
                for (int n = 0; n < 2; ++n) acc[a][b][m][n] = (f32x4){0.f, 0.f, 0.f, 0.f};
    bf16x8 At[4][2], B0[2][2], B1[2][2];
    const char* cA = (const char*)g.A + (size_t)cur.pm * tstepA + (size_t)gemm_aofs(g, cur.z) * 2;
    const char* cB = (const char*)g.Bt + (size_t)cur.pn * tstepB + (size_t)cur.z * g.zB * 2;
    PG8_WAIT_V(0);
    PG8_STAGE(PG8_SB(0, 0), cB, voffB); PG8_STAGE(PG8_SA(0, 0), cA, voffA); PG8_STAGE(PG8_SB(0, 1), cB + hstepB, voffB); PG8_STAGE(PG8_SA(0, 1), cA + hstepA, voffA);
    if (wr == 1) PG8_BAR;
    PG8_WAIT_V(4); PG8_BAR;
    PG8_STAGE(PG8_SB(1, 0), cB + kstep, voffB); PG8_STAGE(PG8_SA(1, 0), cA + kstep, voffA); PG8_STAGE(PG8_SB(1, 1), cB + hstepB + kstep, voffB);
    PG8_WAIT_V(6); PG8_BAR;
    for (;;) {
        const bool has_next = unit_next<ZN>(g, ui + 1, nxt);
        const char* nA = has_next ? (const char*)g.A + (size_t)nxt.pm * tstepA + (size_t)gemm_aofs(g, nxt.z) * 2 : cA;
        const char* nB = has_next ? (const char*)g.Bt + (size_t)nxt.pn * tstepB + (size_t)nxt.z * g.zB * 2 : cB;
        for (int t = 0; t < nt; t += 2) {
            const bool last = (t == nt - 2);
            const char* a1 = cA + (size_t)(t + 1) * kstep;
            const char* a2 = last ? nA : cA + (size_t)(t + 2) * kstep; const char* b2 = last ? nB : cB + (size_t)(t + 2) * kstep;
            const char* a3 = a2 + kstep; const char* b3 = b2 + kstep;
            PG8_LDB(B0, 0, 0); PG8_SCHED; PG8_LDA(At, 0, 0); PG8_STAGE(PG8_SA(1, 1), a1 + hstepA, voffA);
            PG8_WAIT_L(8); PG8_BAR; PG8_WAIT_L(0); PG8_MMA(0, 0, At, B0); PG8_BAR; PG8_SCHED;
            PG8_LDB(B1, 0, 1); PG8_STAGE(PG8_SB(0, 0), b2, voffB);
            PG8_BAR; PG8_WAIT_L(0); PG8_MMA(0, 1, At, B1); PG8_BAR;
            PG8_LDA(At, 0, 1); PG8_STAGE(PG8_SA(0, 0), a2, voffA);
            PG8_BAR; PG8_WAIT_L(0); PG8_MMA(1, 0, At, B0); PG8_BAR; PG8_SCHED;
            PG8_STAGE(PG8_SB(0, 1), b2 + hstepB, voffB);
            PG8_WAIT_V(6); PG8_BAR; PG8_MMA(1, 1, At, B1); PG8_BAR;
            PG8_LDB(B0, 1, 0); PG8_SCHED; PG8_LDA(At, 1, 0); PG8_STAGE(PG8_SA(0, 1), a2 + hstepA, voffA);
            PG8_WAIT_L(8); PG8_BAR; PG8_WAIT_L(0); PG8_MMA(0, 0, At, B0); PG8_BAR; PG8_SCHED;
            PG8_LDB(B1, 1, 1); PG8_STAGE(PG8_SB(1, 0), b3, voffB);
            PG8_BAR; PG8_WAIT_L(0); PG8_MMA(0, 1, At, B1); PG8_BAR;
            PG8_LDA(At, 1, 1); PG8_STAGE(PG8_SA(1, 0), a3, voffA);
            PG8_BAR; PG8_WAIT_L(0); PG8_MMA(1, 0, At, B0); PG8_BAR; PG8_SCHED;
            PG8_STAGE(PG8_SB(1, 1), b3 + hstepB, voffB);
            PG8_WAIT_V(6); PG8_BAR; PG8_MMA(1, 1, At, B1); PG8_BAR;
        }
        E(acc, cur, wr, wc, fr, fq);
        if (!has_next) break;
#pragma unroll
        for (int a = 0; a < 2; ++a)
#pragma unroll
            for (int b = 0; b < 2; ++b)
#pragma unroll
                for (int m = 0; m < 4; ++m)
#pragma unroll
                    for (int n = 0; n < 2; ++n) acc[a][b][m][n] = (f32x4){0.f, 0.f, 0.f, 0.f};
        cur = nxt; cA = nA; cB = nB; ++ui;
    }
    PG8_WAIT_V(0);
    if (wr == 0) PG8_BAR;
    PG8_BAR;
#undef PG8_SA
#undef PG8_SB
#undef PG8_STAGE
#undef PG8_LDA
#undef PG8_LDB
#undef PG8_MMA
#undef PG8_WAIT_V
#undef PG8_WAIT_L
#undef PG8_BAR
#undef PG8_SCHED
}

struct EpiMod {
    static constexpr bool PERM = false;
    float* mod; const float* bada;
    __device__ __forceinline__ void operator()(const f32x4 (&acc)[2][2][4][2], const Unit& u, int wr, int wc, int fr, int fq) const {
        f32x4 bv[2][2];
#pragma unroll
        for (int bj = 0; bj < 2; ++bj)
#pragma unroll
            for (int n = 0; n < 2; ++n) bv[bj][n] = *(const f32x4*)(bada + u.pn * BM + bj * HALF + wc * 32 + n * 16 + fq * 4);
#pragma unroll
        for (int ai = 0; ai < 2; ++ai)
#pragma unroll
            for (int m = 0; m < 4; ++m) { const int r = u.pm * BM + ai * HALF + wr * 64 + m * 16 + fr; if (r >= NCOND) continue;
#pragma unroll
                for (int bj = 0; bj < 2; ++bj)
#pragma unroll
                    for (int n = 0; n < 2; ++n) { const int c = u.pn * BM + bj * HALF + wc * 32 + n * 16 + fq * 4; const int layer = c / 6144, cc = c - layer * 6144;
                        *(f32x4*)(mod + ((size_t)(layer * NCOND + r)) * 6144 + cc) = acc[ai][bj][m][n] + bv[bj][n]; } }
    }
};
struct EpiProj {
    static constexpr bool PERM = true;
    bf16_t* O;
    __device__ __forceinline__ void operator()(const f32x4 (&acc)[2][2][4][2], const Unit& u, int wr, int wc, int fr, int fq) const {
#pragma unroll
        for (int bj = 0; bj < 2; ++bj) { const int c = u.pn * BM + bj * HALF + wc * 32 + fq * 8; const int mode = (c >= C_UV + 1024 && c < C_GATE) ? 1 : 0;
#pragma unroll
            for (int ai = 0; ai < 2; ++ai)
#pragma unroll
                for (int m = 0; m < 4; ++m) { const int r = u.pm * BM + ai * HALF + wr * 64 + m * 16 + fr;
                    float v[8];
#pragma unroll
                    for (int i = 0; i < 8; ++i) { float x = acc[ai][bj][m][i >> 2][i & 3]; v[i] = (mode == 1 ? gelu_fast(x) : x); }
                    u32x4 o; o[0] = pk2(v[0], v[1]); o[1] = pk2(v[2], v[3]); o[2] = pk2(v[4], v[5]); o[3] = pk2(v[6], v[7]);
                    *(u32x4*)(O + (size_t)r * LDP + c) = o; } }
    }
};
struct EpiUp {
    static constexpr bool PERM = true;
    bf16_t* O;
    __device__ __forceinline__ void operator()(const f32x4 (&acc)[2][2][4][2], const Unit& u, int wr, int wc, int fr, int fq) const {
#pragma unroll
        for (int bj = 0; bj < 2; ++bj) { const int c = u.pn * BM + bj * HALF + wc * 32 + fq * 8;
#pragma unroll
            for (int ai = 0; ai < 2; ++ai)
#pragma unroll
                for (int m = 0; m < 4; ++m) { const int r = u.pm * BM + ai * HALF + wr * 64 + m * 16 + fr;
                    const f32x4 a = acc[ai][bj][m][0], b = acc[ai][bj][m][1];
                    u32x4 o; o[0] = pk2(a[0], a[1]); o[1] = pk2(a[2], a[3]); o[2] = pk2(b[0], b[1]); o[3] = pk2(b[2], b[3]);
                    *(u32x4*)(O + (size_t)r * 5632 + c) = o; } }
    }
};
struct EpiBranch {
    static constexpr bool PERM = true;
    const bf16_t* proj; float* msum; bf16_t* merged;
    __device__ __forceinline__ void operator()(const f32x4 (&acc)[2][2][4][2], const Unit& u, int wr, int wc, int fr, int fq) const {
        const int z = u.z;
        u32x4 gt[2][2], pv[2][2];
        const int c0 = u.pn * BM + wc * 32 + fq * 8, r0 = u.pm * BM + wr * 64 + fr;
#define EB_LOAD(k, buf) do { const int bj_ = (k) >> 2, ai_ = ((k) >> 1) & 1, m0_ = ((k) & 1) * 2; _Pragma("unroll") for (int mm = 0; mm < 2; ++mm) { const int r = r0 + ai_ * HALF + (m0_ + mm) * 16, c = c0 + bj_ * HALF; \
            gt[buf][mm] = *(const u32x4*)(proj + (size_t)r * LDP + C_GATE + z * 1024 + c); pv[buf][mm] = (u32x4){0u, 0u, 0u, 0u}; \
            if (z > 0) pv[buf][mm] = *(const u32x4*)(merged + (size_t)r * 1024 + c); } } while (0)
        EB_LOAD(0, 0);
#pragma unroll
        for (int k = 0; k < 8; ++k) { const int bj = k >> 2, ai = (k >> 1) & 1, m0 = (k & 1) * 2, buf = k & 1;
            if (k < 7) { if (buf == 0) EB_LOAD(k + 1, 1); else EB_LOAD(k + 1, 0); }
#pragma unroll
            for (int mm = 0; mm < 2; ++mm) { const int m = m0 + mm; const int r = r0 + ai * HALF + m * 16, c = c0 + bj * HALF;
                const f32x4 a = acc[ai][bj][m][0], b = acc[ai][bj][m][1]; const u32x4 gv = gt[buf][mm], p = pv[buf][mm];
                u32x4 o;
                o[0] = pk2(bflo(p[0]) + sigmoid_fast(bflo(gv[0])) * a[0], bfhi(p[0]) + sigmoid_fast(bfhi(gv[0])) * a[1]); o[1] = pk2(bflo(p[1]) + sigmoid_fast(bflo(gv[1])) * a[2], bfhi(p[1]) + sigmoid_fast(bfhi(gv[1])) * a[3]);
                o[2] = pk2(bflo(p[2]) + sigmoid_fast(bflo(gv[2])) * b[0], bfhi(p[2]) + sigmoid_fast(bfhi(gv[2])) * b[1]); o[3] = pk2(bflo(p[3]) + sigmoid_fast(bflo(gv[3])) * b[2], bfhi(p[3]) + sigmoid_fast(bfhi(gv[3])) * b[3]);
                *(u32x4*)(merged + (size_t)r * 1024 + c) = o; } }
#undef EB_LOAD
    }
};
struct EpiResid {
    static constexpr bool PERM = false;
    const float* xin_p; const float* xin_s; float* xout; const float* ga;
    __device__ __forceinline__ void operator()(const f32x4 (&acc)[2][2][4][2], const Unit& u, int wr, int wc, int fr, int fq) const {
        const float* gr = ga + (size_t)(u.pm >> 4) * 6144;
        const int c0 = u.pn * BM + wc * 32 + fq * 4, r0 = u.pm * BM + wr * 64 + fr;
        f32x4 gv[2][2];
#pragma unroll
        for (int bj = 0; bj < 2; ++bj)
#pragma unroll
            for (int n = 0; n < 2; ++n) gv[bj][n] = *(const f32x4*)(gr + c0 + bj * HALF + n * 16);
        f32x4 xv[2][2][2];
#define ER_LOAD(k, buf) do { const int r_ = r0 + ((k) >> 2) * HALF + ((k) & 3) * 16; _Pragma("unroll") for (int bj = 0; bj < 2; ++bj) _Pragma("unroll") for (int n = 0; n < 2; ++n) \
            xv[buf][bj][n] = *(const f32x4*)(xin_p + (size_t)r_ * 1024 + c0 + bj * HALF + n * 16); } while (0)
        ER_LOAD(0, 0);
#pragma unroll
        for (int k = 0; k < 8; ++k) { const int ai = k >> 2, m = k & 3, buf = k & 1; const int r = r0 + ai * HALF + m * 16;
            if (k < 7) { if (buf == 0) ER_LOAD(k + 1, 1); else ER_LOAD(k + 1, 0); }
#pragma unroll
            for (int bj = 0; bj < 2; ++bj)
#pragma unroll
                for (int n = 0; n < 2; ++n) *(f32x4*)(xout + (size_t)r * 1024 + c0 + bj * HALF + n * 16) = xv[buf][bj][n] + gv[bj][n] * acc[ai][bj][m][n]; }
#undef ER_LOAD
    }
};

struct CTile { const float* src; bf16_t* dst; int K, N, k0, n0; };
__device__ __forceinline__ CTile conv_decode(const Params& P, int t) {
    constexpr int T_IN = 3392, T_BR = 1024, T_O = 256, T_UP = 1408, T_DN = 704, T_ADA = 1536, T_L = T_IN + T_BR + T_O + T_UP + T_DN + T_ADA;
    const int layer = t / T_L; int r = t - layer * T_L; CTile c;
    if (r < T_IN) { c.src = P.in[13] + (size_t)layer * 1024 * 13328; c.dst = (bf16_t*)(P.ws + WS_WIN) + (size_t)layer * 13568 * 1024; c.K = 1024; c.N = 13328; c.k0 = (r / 212) * 64; c.n0 = (r % 212) * 64; return c; }
    r -= T_IN;
    if (r < T_BR) { const int br = r >> 8, q = r & 255; c.src = P.in[26] + (size_t)(layer * 4 + br) * 1048576; c.dst = (bf16_t*)(P.ws + WS_WBR) + (size_t)(layer * 4 + br) * 1048576; c.K = 1024; c.N = 1024; c.k0 = (q >> 4) * 64; c.n0 = (q & 15) * 64; return c; }
    r -= T_BR;
    if (r < T_O) { c.src = P.in[27] + (size_t)layer * 1048576; c.dst = (bf16_t*)(P.ws + WS_WO) + (size_t)layer * 1048576; c.K = 1024; c.N = 1024; c.k0 = (r >> 4) * 64; c.n0 = (r & 15) * 64; return c; }
    r -= T_O;
    if (r < T_UP) { c.src = P.in[29] + (size_t)layer * 1024 * 5632; c.dst = (bf16_t*)(P.ws + WS_WUP) + (size_t)layer * 5632 * 1024; c.K = 1024; c.N = 5632; c.k0 = (r / 88) * 64; c.n0 = (r % 88) * 64; return c; }
    r -= T_UP;
    if (r < T_DN) { c.src = P.in[32] + (size_t)layer * 2816 * 1024; c.dst = (bf16_t*)(P.ws + WS_WDN) + (size_t)layer * 1024 * 2816; c.K = 2816; c.N = 1024; c.k0 = (r >> 4) * 64; c.n0 = (r & 15) * 64; return c; }
    r -= T_DN;
    c.src = P.in[10] + (size_t)layer * 1024 * 6144; c.dst = (bf16_t*)(P.ws + WS_WADA) + (size_t)layer * 6144 * 1024; c.K = 1024; c.N = 6144; c.k0 = (r / 96) * 64; c.n0 = (r % 96) * 64; return c;
}
__device__ __forceinline__ void phase_convert(const Params& P, float* T) {
    constexpr int NT = 4 * 8320;
    const int tid = otid();
    int t = blockIdx.x;
    CTile cur = conv_decode(P, t < NT ? t : 0);
    float v[8], nv[8];
#pragma unroll
    for (int e = 0; e < 8; ++e) { const int idx = tid + e * 512, k = idx >> 6, n = idx & 63; v[e] = (t < NT && cur.n0 + n < cur.N) ? cur.src[(size_t)(cur.k0 + k) * cur.N + cur.n0 + n] : 0.f; }
    for (; t < NT; t += gridDim.x) {
        const int tn = t + gridDim.x; const bool hn = tn < NT; const CTile nxt = conv_decode(P, hn ? tn : 0);
#pragma unroll
        for (int e = 0; e < 8; ++e) { const int idx = tid + e * 512, k = idx >> 6, n = idx & 63; nv[e] = (hn && nxt.n0 + n < nxt.N) ? nxt.src[(size_t)(nxt.k0 + k) * nxt.N + nxt.n0 + n] : 0.f; }
#pragma unroll
        for (int e = 0; e < 8; ++e) { const int idx = tid + e * 512, k = idx >> 6, n = idx & 63; T[k * 65 + n] = v[e]; }
        __syncthreads();
        { const int n = tid >> 3, kc = (tid & 7) * 8; float x[8];
#pragma unroll
          for (int j = 0; j < 8; ++j) x[j] = T[(kc + j) * 65 + n];
          u32x4 o; o[0] = pk2(x[0], x[1]); o[1] = pk2(x[2], x[3]); o[2] = pk2(x[4], x[5]); o[3] = pk2(x[6], x[7]);
          *(u32x4*)(cur.dst + (size_t)(cur.n0 + n) * cur.K + cur.k0 + kc) = o; }
        __syncthreads();
#pragma unroll
        for (int e = 0; e < 8; ++e) v[e] = nv[e];
        cur = nxt;
    }
    bf16_t* cact = (bf16_t*)(P.ws + WS_CACT);
    for (int i = blockIdx.x * 512 + otid(); i < 256 * 1024; i += gridDim.x * 512) {
        const int r = i >> 10, c = i & 1023; float v = 0.f;
        if (r < 4) v = siluf_(P.in[2][r * 1024 + c]); else if (r < NCOND) v = siluf_(P.in[3][(r - 4) * 1024 + c]);
        cact[i] = f2bf(v);
    }
}

__device__ __forceinline__ void phase_norm(const float* xp, const float* xs, const float* g, const float* modL, int shofs, int scofs, bf16_t* hout) {
    const int tid = otid(); const int w = tid >> 6, lane = tid & 63;
    const int stride = gridDim.x * 8;
    for (int r = blockIdx.x * 8 + w; r < NTOK; r += 2 * stride) {
        const int rb = (r + stride < NTOK) ? r + stride : r;
        const float* xa = r < NPR ? xp + (size_t)r * 1024 : xs + (size_t)(r - NPR) * 1024;
        const float* xb = rb < NPR ? xp + (size_t)rb * 1024 : xs + (size_t)(rb - NPR) * 1024;
        const float* ma = modL + (size_t)cond_row(r) * 6144; const float* mb = modL + (size_t)cond_row(rb) * 6144;
        f32x4 va[4], vb[4], gv[4], sca[4], sha[4], scb[4], shb[4]; float sa = 0.f, sb = 0.f;
#pragma unroll
        for (int i = 0; i < 4; ++i) { const int c = i * 256 + lane * 4; va[i] = *(const f32x4*)(xa + c); vb[i] = *(const f32x4*)(xb + c); gv[i] = *(const f32x4*)(g + c);
            sca[i] = *(const f32x4*)(ma + scofs + c); sha[i] = *(const f32x4*)(ma + shofs + c); scb[i] = *(const f32x4*)(mb + scofs + c); shb[i] = *(const f32x4*)(mb + shofs + c); }
#pragma unroll
        for (int i = 0; i < 4; ++i) { sa += va[i][0] * va[i][0] + va[i][1] * va[i][1] + va[i][2] * va[i][2] + va[i][3] * va[i][3]; sb += vb[i][0] * vb[i][0] + vb[i][1] * vb[i][1] + vb[i][2] * vb[i][2] + vb[i][3] * vb[i][3]; }
        sa = wave_sum(sa, lane); sb = wave_sum(sb, lane);
        const float rsa = rsqrtf(sa * (1.f / 1024.f) + EPSF), rsb = rsqrtf(sb * (1.f / 1024.f) + EPSF);
#pragma unroll
        for (int i = 0; i < 4; ++i) { const int c = i * 256 + lane * 4;
            { const f32x4 o = va[i] * rsa * gv[i] * (sca[i] + 1.f) + sha[i]; u32x2 pk; pk[0] = pk2(o[0], o[1]); pk[1] = pk2(o[2], o[3]); *(u32x2*)(hout + (size_t)r * 1024 + c) = pk; }
            { const f32x4 o = vb[i] * rsb * gv[i] * (scb[i] + 1.f) + shb[i]; u32x2 pk; pk[0] = pk2(o[0], o[1]); pk[1] = pk2(o[2], o[3]); *(u32x2*)(hout + (size_t)rb * 1024 + c) = pk; } }
    }
}
__device__ __forceinline__ void phase_final_norm(float* x, const float* g) {
    const int tid = otid(); const int w = tid >> 6, lane = tid & 63;
    for (int r = blockIdx.x * 8 + w; r < NTOK; r += gridDim.x * 8) {
        float* xr = x + (size_t)r * 1024; f32x4 v[4]; float ss = 0.f;
#pragma unroll
        for (int i = 0; i < 4; ++i) { v[i] = *(const f32x4*)(xr + i * 256 + lane * 4); ss += v[i][0] * v[i][0] + v[i][1] * v[i][1] + v[i][2] * v[i][2] + v[i][3] * v[i][3]; }
        ss = wave_sum(ss, lane); const float rs = rsqrtf(ss * (1.f / 1024.f) + EPSF);
#pragma unroll
        for (int i = 0; i < 4; ++i) { const int c = i * 256 + lane * 4; const f32x4 gv = *(const f32x4*)(g + c); *(f32x4*)(xr + c) = v[i] * rs * gv; }
    }
}

template <int MODE>
__device__ __forceinline__ void ssd_item(const Params& P, int layer, int item, float* L) {
    const int tid = otid(), w = tid >> 6, lane = tid & 63;
    bf16_t* proj = (bf16_t*)(P.ws + WS_PROJ);
    float* states = (float*)(P.ws + WS_SSDST); float* decs = (float*)(P.ws + WS_SSDDEC);
    int r0, nsteps, half, seq0, b = 0, c = 0, sb = 0;
    if (MODE == 2) { sb = item >> 1; half = item & 1; r0 = NPR + sb * 4; nsteps = 4; seq0 = r0; }
    else { b = item >> 6; c = (item >> 1) & 31; half = item & 1; r0 = b * 4096 + c * 128; nsteps = 128; seq0 = b * 4096; }
    float* XS = L; float* ZS = XS + 16 * 512; float* BS = ZS + 16 * 512; float* CS = BS + 16 * 128; float* DTS = CS + 16 * 128; float* DAS = DTS + 128; float* SSQ = DAS + 128;
    const float* cw = P.in[14] + (size_t)layer * 4 * 1536; const float* cb = P.in[15] + (size_t)layer * 1536;
    const float* prev = P.in[5] + ((size_t)(layer * 128 + sb)) * 3 * 1536;
    const int hd = half * 8 + w, gl = w >> 2;
    float h[64];
    if (MODE == 0) {
#pragma unroll
        for (int n = 0; n < 64; ++n) h[n] = 0.f;
    } else {
        const float* s0p = (MODE == 1) ? states + ((size_t)((b * 32 + c) * 16 + hd)) * 4096 + lane * 64
                                       : P.in[4] + ((size_t)((layer * 128 + sb) * 16 + hd)) * 4096 + lane * 64;
#pragma unroll
        for (int n4 = 0; n4 < 16; ++n4) { const f32x4 v = *(const f32x4*)(s0p + n4 * 4); h[n4 * 4] = v[0]; h[n4 * 4 + 1] = v[1]; h[n4 * 4 + 2] = v[2]; h[n4 * 4 + 3] = v[3]; }
    }
    const float Dh = P.in[18][layer * 16 + hd];
    float decp = 1.f;
    for (int s0 = 0; s0 < nsteps; s0 += 16) {
        const int ns = (nsteps - s0) < 16 ? (nsteps - s0) : 16;
        __syncthreads();
        for (int idx = tid; idx < ns * 768; idx += 512) {
            const int t = idx / 768, ch = idx - t * 768;
            int cx;
            if (ch < 512) cx = half * 512 + ch; else if (ch < 640) cx = 1024 + half * 128 + (ch - 512); else cx = 1280 + half * 128 + (ch - 640);
            float a = cb[cx];
#pragma unroll
            for (int k = 0; k < 4; ++k) { const int step = s0 + t - 3 + k, rr = r0 + step; float raw;
                if (rr >= seq0) raw = bf2f(proj[(size_t)rr * LDP + C_XBC + cx]);
                else raw = (MODE == 2) ? prev[(3 + step) * 1536 + cx] : 0.f;
                a += cw[k * 1536 + cx] * raw; }
            a = siluf_(a);
            if (ch < 512) { XS[t * 512 + ch] = a; if (MODE != 0) ZS[t * 512 + ch] = bf2f(proj[(size_t)(r0 + s0 + t) * LDP + C_Z + cx]); }
            else if (ch < 640) BS[t * 128 + ch - 512] = a; else CS[t * 128 + ch - 640] = a;
        }
        if (tid < ns * 8) { const int t = tid >> 3, ww = tid & 7, hh = half * 8 + ww;
            const float dt = softplusf_(bf2f(proj[(size_t)(r0 + s0 + t) * LDP + C_DTR + hh]) + P.in[16][layer * 16 + hh]);
            DTS[t * 8 + ww] = dt; DAS[t * 8 + ww] = __expf(-dt * __expf(P.in[17][layer * 16 + hh])); }
        __syncthreads();
        for (int t = 0; t < ns; ++t) {
            const float a = DAS[t * 8 + w], dt = DTS[t * 8 + w], xv = XS[t * 512 + w * 64 + lane], xd = xv * dt; decp *= a;
            const f32x4* B4 = (const f32x4*)(BS + t * 128 + gl * 64);
#pragma unroll
            for (int n4 = 0; n4 < 16; ++n4) { const f32x4 bv = B4[n4];
                h[n4 * 4] = a * h[n4 * 4] + xd * bv[0]; h[n4 * 4 + 1] = a * h[n4 * 4 + 1] + xd * bv[1]; h[n4 * 4 + 2] = a * h[n4 * 4 + 2] + xd * bv[2]; h[n4 * 4 + 3] = a * h[n4 * 4 + 3] + xd * bv[3]; }
            if (MODE != 0) {
                const f32x4* C4 = (const f32x4*)(CS + t * 128 + gl * 64); float y0 = 0.f, y1 = 0.f;
#pragma unroll
                for (int n4 = 0; n4 < 16; ++n4) { const f32x4 cv = C4[n4]; y0 += h[n4 * 4] * cv[0] + h[n4 * 4 + 2] * cv[2]; y1 += h[n4 * 4 + 1] * cv[1] + h[n4 * 4 + 3] * cv[3]; }
                float y = y0 + y1 + Dh * xv; y *= siluf_(ZS[t * 512 + w * 64 + lane]);
                const float sq = wave_sum(y * y, lane); if (lane == 0) SSQ[(s0 + t) * 8 + w] = sq;
                proj[(size_t)(r0 + s0 + t) * LDP + C_Z + hd * 64 + lane] = f2bf(y);
            }
        }
    }
    if (MODE == 0) {
        float* sp = states + ((size_t)((b * 32 + c) * 16 + hd)) * 4096 + lane * 64;
#pragma unroll
        for (int n4 = 0; n4 < 16; ++n4) *(f32x4*)(sp + n4 * 4) = (f32x4){h[n4 * 4], h[n4 * 4 + 1], h[n4 * 4 + 2], h[n4 * 4 + 3]};
        if (lane == 0) decs[(b * 32 + c) * 16 + hd] = decp;
    }
    if (MODE == 2) {
        float* sp = P.out + O_SSSM + ((size_t)((layer * 128 + sb) * 16 + hd)) * 4096 + lane * 64;
#pragma unroll
        for (int n4 = 0; n4 < 16; ++n4) *(f32x4*)(sp + n4 * 4) = (f32x4){h[n4 * 4], h[n4 * 4 + 1], h[n4 * 4 + 2], h[n4 * 4 + 3]};
    }
    if (MODE != 0) {
        __syncthreads();
        const float ng = P.in[19][layer * 1024 + hd * 64 + lane];
        for (int t = 0; t < nsteps; ++t) {
            const float tot = SSQ[t * 8 + gl * 4] + SSQ[t * 8 + gl * 4 + 1] + SSQ[t * 8 + gl * 4 + 2] + SSQ[t * 8 + gl * 4 + 3];
            const float sc = rsqrtf(tot * (1.f / 256.f) + EPSF) * ng;
            bf16_t* ap = proj + (size_t)(r0 + t) * LDP + C_Z + hd * 64 + lane; *ap = f2bf(bf2f(*ap) * sc);
        }
    }
}

__device__ __forceinline__ int xt_idx(int row, int t) { return row * 136 + ((((t >> 3) ^ ((row >> 3) & 15)) << 3) | (t & 7)); }
__device__ __forceinline__ void ssd_stage_dt(const Params& P, int layer, const bf16_t* proj, size_t r0, int g, float* DT, float* ACS, int tid) {
    { const int hh = tid >> 7, t = tid & 127, hd = g * 4 + hh;
      const float dt = softplusf_(bf2f(proj[(r0 + t) * LDP + C_DTR + hd]) + P.in[16][layer * 16 + hd]);
      DT[hh * 128 + t] = dt; ACS[hh * 128 + t] = -dt * __expf(P.in[17][layer * 16 + hd]); }
    __syncthreads();
    if (tid < 256) { const int hh = tid >> 6, l = tid & 63; const float a0 = ACS[hh * 128 + 2 * l], a1 = ACS[hh * 128 + 2 * l + 1]; float sum = a0 + a1;
#pragma unroll
        for (int o = 1; o < 64; o <<= 1) { const float v = __int_as_float(__builtin_amdgcn_ds_bpermute(((l - o) & 63) << 2, __float_as_int(sum))); if (l >= o) sum += v; }
        ACS[hh * 128 + 2 * l] = sum - a1; ACS[hh * 128 + 2 * l + 1] = sum; }
    __syncthreads();
}
template <int PASS>
__device__ __forceinline__ void ssd_stage_conv(const Params& P, int layer, const bf16_t* proj, size_t r0, bool first, int g, const float* DT, const float* ACS, bf16_t* XT4, bf16_t* Bx, bf16_t* Cs, int tid) {
    const int slot = tid & 63, seg = tid >> 6;
    if (slot < (PASS ? 48 : 40)) {
        int cx; if (slot < 32) cx = g * 256 + slot * 8; else if (slot < 40) cx = 1024 + g * 64 + (slot - 32) * 8; else cx = 1280 + g * 64 + (slot - 40) * 8;
        const float* cw = P.in[14] + (size_t)layer * 4 * 1536 + cx; const float* cb = P.in[15] + (size_t)layer * 1536 + cx;
        float wt[4][8], bb[8], win[3][8];
#pragma unroll
        for (int k = 0; k < 4; ++k) { const f32x4 a = *(const f32x4*)(cw + k * 1536), c = *(const f32x4*)(cw + k * 1536 + 4);
#pragma unroll
            for (int i = 0; i < 4; ++i) { wt[k][i] = a[i]; wt[k][4 + i] = c[i]; } }
        { const f32x4 a = *(const f32x4*)cb, c = *(const f32x4*)(cb + 4);
#pragma unroll
          for (int i = 0; i < 4; ++i) { bb[i] = a[i]; bb[4 + i] = c[i]; } }
        const int t0 = seg * 16;
#pragma unroll
        for (int k = 0; k < 3; ++k) { u32x4 raw = (u32x4){0u, 0u, 0u, 0u};
            if (!(first && seg == 0)) raw = *(const u32x4*)(proj + (r0 + t0 - 3 + k) * LDP + C_XBC + cx);
#pragma unroll
            for (int i = 0; i < 4; ++i) { win[k][2 * i] = bflo(raw[i]); win[k][2 * i + 1] = bfhi(raw[i]); } }
        u32x4 cur4[4], nxt4[4];
#pragma unroll
        for (int q = 0; q < 4; ++q) { cur4[q] = *(const u32x4*)(proj + (r0 + t0 + q) * LDP + C_XBC + cx); nxt4[q] = cur4[q]; }
        for (int gq = 0; gq < 4; ++gq) {
            if (gq < 3) {
#pragma unroll
                for (int q = 0; q < 4; ++q) nxt4[q] = *(const u32x4*)(proj + (r0 + t0 + gq * 4 + 4 + q) * LDP + C_XBC + cx); }
#pragma unroll
            for (int q = 0; q < 4; ++q) {
                const int t = t0 + gq * 4 + q; const u32x4 raw = cur4[q];
                float cur[8], o[8];
#pragma unroll
                for (int i = 0; i < 4; ++i) { cur[2 * i] = bflo(raw[i]); cur[2 * i + 1] = bfhi(raw[i]); }
#pragma unroll
                for (int i = 0; i < 8; ++i) { o[i] = siluf_(bb[i] + wt[0][i] * win[0][i] + wt[1][i] * win[1][i] + wt[2][i] * win[2][i] + wt[3][i] * cur[i]); win[0][i] = win[1][i]; win[1][i] = win[2][i]; win[2][i] = cur[i]; }
                if (slot < 32) { const int hh = slot >> 3, p0 = (slot & 7) * 8; float sc = DT[hh * 128 + t]; if (PASS == 0) sc *= __expf(ACS[hh * 128 + 127] - ACS[hh * 128 + t]);
#pragma unroll
                    for (int i = 0; i < 8; ++i) XT4[xt_idx(hh * 64 + p0 + i, t)] = f2bf(o[i] * sc); }
                else if (slot < 40) { const int n0 = (slot - 32) * 8;
                    if (PASS == 0) {
#pragma unroll
                        for (int i = 0; i < 8; ++i) Bx[xt_idx(n0 + i, t)] = f2bf(o[i]); }
                    else { u32x4 pk; pk[0] = pk2(o[0], o[1]); pk[1] = pk2(o[2], o[3]); pk[2] = pk2(o[4], o[5]); pk[3] = pk2(o[6], o[7]); *(u32x4*)(Bx + t * 72 + n0) = pk; } }
                else { const int n0 = (slot - 40) * 8; u32x4 pk; pk[0] = pk2(o[0], o[1]); pk[1] = pk2(o[2], o[3]); pk[2] = pk2(o[4], o[5]); pk[3] = pk2(o[6], o[7]); *(u32x4*)(Cs + t * 72 + n0) = pk; }
            }
#pragma unroll
            for (int q = 0; q < 4; ++q) cur4[q] = nxt4[q];
        }
    }
}
__device__ __forceinline__ void ssd_pass1_item(const Params& P, int layer, int item, unsigned char* lds) {
    const int tid = otid(), w = __builtin_amdgcn_readfirstlane(tid >> 6), lane = tid & 63, fr = lane & 15, fq = lane >> 4;
    const int b = item >> 7, c = (item >> 2) & 31, g = item & 3; const size_t r0 = (size_t)b * 4096 + (size_t)c * 128;
    const bf16_t* proj = (const bf16_t*)(P.ws + WS_PROJ);
    float* states = (float*)(P.ws + WS_SSDST); float* decs = (float*)(P.ws + WS_SSDDEC);
    bf16_t* XT4 = (bf16_t*)lds; bf16_t* BT = XT4 + 256 * 136; float* DT = (float*)(BT + 64 * 136); float* ACS = DT + 512;
    __syncthreads();
    ssd_stage_dt(P, layer, proj, r0, g, DT, ACS, tid);
    ssd_stage_conv<0>(P, layer, proj, r0, c == 0, g, DT, ACS, XT4, BT, nullptr, tid);
    __syncthreads();
    const int hh = w >> 1, pb = (w & 1) * 2;
    f32x4 acc[2][4];
#pragma unroll
    for (int pi = 0; pi < 2; ++pi)
#pragma unroll
        for (int nt = 0; nt < 4; ++nt) acc[pi][nt] = (f32x4){0.f, 0.f, 0.f, 0.f};
#pragma unroll
    for (int ks = 0; ks < 4; ++ks) { bf16x8 a[2];
#pragma unroll
        for (int pi = 0; pi < 2; ++pi) a[pi] = *(const bf16x8*)(XT4 + xt_idx(hh * 64 + (pb + pi) * 16 + fr, ks * 32 + fq * 8));
#pragma unroll
        for (int nt = 0; nt < 4; ++nt) { const bf16x8 bv = *(const bf16x8*)(BT + xt_idx(nt * 16 + fr, ks * 32 + fq * 8));
#pragma unroll
            for (int pi = 0; pi < 2; ++pi) acc[pi][nt] = __builtin_amdgcn_mfma_f32_16x16x32_bf16(a[pi], bv, acc[pi][nt], 0, 0, 0); } }
    float* sp = states + ((size_t)((b * 32 + c) * 16 + g * 4 + hh)) * 4096;
#pragma unroll
    for (int pi = 0; pi < 2; ++pi)
#pragma unroll
        for (int nt = 0; nt < 4; ++nt)
#pragma unroll
            for (int j = 0; j < 4; ++j) sp[((pb + pi) * 16 + fq * 4 + j) * 64 + nt * 16 + fr] = acc[pi][nt][j];
    if (tid < 4) decs[(b * 32 + c) * 16 + g * 4 + tid] = __expf(ACS[tid * 128 + 127]);
}
__device__ __forceinline__ void ssd_pass3_item(const Params& P, int layer, int item, unsigned char* lds, bool dry = false) {
    const int tid = otid(), w = __builtin_amdgcn_readfirstlane(tid >> 6), lane = tid & 63, fr = lane & 15, fq = lane >> 4;
    const int b = item >> 7, c = (item >> 2) & 31, g = item & 3; const size_t r0 = (size_t)b * 4096 + (size_t)c * 128;
    bf16_t* proj = (bf16_t*)(P.ws + WS_PROJ);
    const float* states = (const float*)(P.ws + WS_SSDST);
    bf16_t* Cs = (bf16_t*)lds; bf16_t* Bs = Cs + 128 * 72; bf16_t* Sin = Bs; bf16_t* XT4 = Bs + 128 * 72; bf16_t* Ms = XT4 + 256 * 136; float* DT = (float*)(Ms + 128 * 136); float* ACS = DT + 512;
    __syncthreads();
    ssd_stage_dt(P, layer, proj, r0, g, DT, ACS, tid);
    ssd_stage_conv<1>(P, layer, proj, r0, c == 0, g, DT, ACS, XT4, Bs, Cs, tid);
    __syncthreads();
    f32x4 CB[8];
#pragma unroll
    for (int st = 0; st < 8; ++st) { CB[st] = (f32x4){0.f, 0.f, 0.f, 0.f};
        if (st <= w) {
#pragma unroll
            for (int ks = 0; ks < 2; ++ks) { const bf16x8 a = *(const bf16x8*)(Cs + (16 * w + fr) * 72 + ks * 32 + fq * 8), bv = *(const bf16x8*)(Bs + (16 * st + fr) * 72 + ks * 32 + fq * 8);
                CB[st] = __builtin_amdgcn_mfma_f32_16x16x32_bf16(a, bv, CB[st], 0, 0, 0); } } }
    float ssq[4] = {0.f, 0.f, 0.f, 0.f};
    const int nks = (w >> 1) + 1;
    bf16_t* zrow[4];
#pragma unroll
    for (int j = 0; j < 4; ++j) zrow[j] = proj + (r0 + 16 * w + fq * 4 + j) * LDP + C_Z + g * 256 + fr;
    f32x4 sna, snc;
    { const float* sp = states + ((size_t)((b * 32 + c) * 16 + g * 4)) * 4096 + (tid >> 3) * 64 + (tid & 7) * 8; sna = *(const f32x4*)sp; snc = *(const f32x4*)(sp + 4); }
    unsigned yg[4][4][2];
#pragma unroll
    for (int hh = 0; hh < 4; ++hh) {
        const int hd = g * 4 + hh;
        __syncthreads();
        { const int p = tid >> 3, n0 = (tid & 7) * 8;
          u32x4 pk; pk[0] = pk2(sna[0], sna[1]); pk[1] = pk2(sna[2], sna[3]); pk[2] = pk2(snc[0], snc[1]); pk[3] = pk2(snc[2], snc[3]);
          *(u32x4*)(Sin + p * 72 + n0) = pk;
          if (hh < 3) { const float* sp = states + ((size_t)((b * 32 + c) * 16 + hd + 1)) * 4096 + p * 64 + n0; sna = *(const f32x4*)sp; snc = *(const f32x4*)(sp + 4); } }
        float acs_t[4];
#pragma unroll
        for (int j = 0; j < 4; ++j) acs_t[j] = ACS[hh * 128 + 16 * w + fq * 4 + j];
#pragma unroll
        for (int st = 0; st < 8; ++st) { if (st <= (w | 1)) { const float acs_s = ACS[hh * 128 + 16 * st + fr];
#pragma unroll
            for (int j = 0; j < 4; ++j) { const int t = 16 * w + fq * 4 + j, sx = 16 * st + fr; const float v = (st <= w && sx <= t) ? CB[st][j] * __expf(acs_t[j] - acs_s) : 0.f; Ms[t * 136 + sx] = f2bf(v); } } }
        __syncthreads();
        bf16_t zv[4][4];
#pragma unroll
        for (int j = 0; j < 4; ++j)
#pragma unroll
            for (int pt = 0; pt < 4; ++pt) zv[j][pt] = *(zrow[j] + hh * 64 + pt * 16);
        f32x4 yd[4], yo[4];
#pragma unroll
        for (int pt = 0; pt < 4; ++pt) { yd[pt] = (f32x4){0.f, 0.f, 0.f, 0.f}; yo[pt] = (f32x4){0.f, 0.f, 0.f, 0.f}; }
        for (int ks = 0; ks < nks; ++ks) { const bf16x8 a = *(const bf16x8*)(Ms + (16 * w + fr) * 136 + ks * 32 + fq * 8);
#pragma unroll
            for (int pt = 0; pt < 4; ++pt) { const bf16x8 bv = *(const bf16x8*)(XT4 + xt_idx(hh * 64 + pt * 16 + fr, ks * 32 + fq * 8)); yd[pt] = __builtin_amdgcn_mfma_f32_16x16x32_bf16(a, bv, yd[pt], 0, 0, 0); } }
#pragma unroll
        for (int ks = 0; ks < 2; ++ks) { const bf16x8 a = *(const bf16x8*)(Cs + (16 * w + fr) * 72 + ks * 32 + fq * 8);
#pragma unroll
            for (int pt = 0; pt < 4; ++pt) { const bf16x8 bv = *(const bf16x8*)(Sin + (pt * 16 + fr) * 72 + ks * 32 + fq * 8); yo[pt] = __builtin_amdgcn_mfma_f32_16x16x32_bf16(a, bv, yo[pt], 0, 0, 0); } }
        const float Dh = P.in[18][layer * 16 + hd];
#pragma unroll
        for (int pt = 0; pt < 4; ++pt) { const int p = pt * 16 + fr; float yy[4];
#pragma unroll
            for (int j = 0; j < 4; ++j) { const int t = 16 * w + fq * 4 + j; const float et = __expf(acs_t[j]), idt = 1.f / DT[hh * 128 + t];
                const float x = bf2f(XT4[xt_idx(hh * 64 + p, t)]) * idt;
                float y = yd[pt][j] + et * yo[pt][j] + Dh * x; y *= silu_fast(bf2f(zv[j][pt])); ssq[j] += y * y; yy[j] = y; }
            yg[hh][pt][0] = pk2(yy[0], yy[1]); yg[hh][pt][1] = pk2(yy[2], yy[3]); }
    }
    const float* ng = P.in[19] + layer * 1024 + g * 256 + fr;
#pragma unroll
    for (int j = 0; j < 4; ++j) { float v = ssq[j];
#pragma unroll
        for (int o = 8; o > 0; o >>= 1) v += shx(v, o, lane);
        ssq[j] = rsqrtf(v * (1.f / 256.f) + EPSF); }
#pragma unroll
    for (int hh = 0; hh < 4; ++hh)
#pragma unroll
        for (int pt = 0; pt < 4; ++pt) { const float gv = ng[(hh * 4 + pt) * 16];
#pragma unroll
            for (int j = 0; j < 4; ++j) { const float yv = (j & 1) ? bfhi(yg[hh][pt][j >> 1]) : bflo(yg[hh][pt][j >> 1]); if (!dry) *(zrow[j] + (hh * 4 + pt) * 16) = f2bf(yv * ssq[j] * gv); } }
}
__device__ __forceinline__ void phase_ssd_scan(const Params& P, int layer) {
    float* states = (float*)(P.ws + WS_SSDST); const float* decs = (const float*)(P.ws + WS_SSDDEC);
    for (int e = blockIdx.x * 512 + otid(); e < 4 * 16 * 4096; e += gridDim.x * 512) {
        const int b = e >> 16, hd = (e >> 12) & 15, pn = e & 4095; float carry = 0.f;
        float st[32], dc[32];
#pragma unroll
        for (int c = 0; c < 32; ++c) { st[c] = states[((size_t)((b * 32 + c) * 16 + hd)) * 4096 + pn]; dc[c] = decs[(b * 32 + c) * 16 + hd]; }
#pragma unroll
        for (int c = 0; c < 32; ++c) { states[((size_t)((b * 32 + c) * 16 + hd)) * 4096 + pn] = carry; carry = carry * dc[c] + st[c]; }
        P.out[O_PSSM + ((size_t)((layer * 4 + b) * 16 + hd)) * 4096 + pn] = carry;
    }
}

__device__ __forceinline__ void attn_prompt_item(const Params& P, int layer, int item, unsigned char* lds, bool dry = false) {
    const int tid = otid(), w = tid >> 6, lane = tid & 63, fr = lane & 15, fq = lane >> 4;
    const int b = item >> 7, nb = (item >> 2) & 31, kvh = item & 3;
    bf16_t* proj = (bf16_t*)(P.ws + WS_PROJ);
    bf16_t* Ks = (bf16_t*)lds;
    bf16_t* Vt = Ks + 256 * 72;
    bf16_t* Pw = Vt + 64 * 280 + w * 16 * 168;
    const long rowK0 = (long)b * 4096 + (long)(nb - 1) * 128;
    const bf16_t* qbase = proj + ((size_t)b * 4096 + (size_t)nb * 128 + w * 16 + fr) * LDP + C_Q + kvh * 256 + fq * 8;
    bf16x8 qa[2], qn[2];
#pragma unroll
    for (int ks = 0; ks < 2; ++ks) { qa[ks] = *(const bf16x8*)(qbase + ks * 32); qn[ks] = qa[ks]; }
    __syncthreads();
#pragma unroll
    for (int idx = tid; idx < 2048; idx += 512) { const int kj = idx >> 3, seg = idx & 7; u32x4 v = (u32x4){0u, 0u, 0u, 0u};
        if (nb > 0 || kj >= 128) v = *(const u32x4*)(proj + (size_t)(rowK0 + kj) * LDP + C_K + kvh * 64 + seg * 8);
        *(u32x4*)(Ks + kj * 72 + seg * 8) = v; }
#pragma unroll
    for (int idx = tid; idx < 2048; idx += 512) { const int seg = idx >> 8, kj = idx & 255; u32x4 v = (u32x4){0u, 0u, 0u, 0u};
        if (nb > 0 || kj >= 128) v = *(const u32x4*)(proj + (size_t)(rowK0 + kj) * LDP + C_V + kvh * 64 + seg * 8);
#pragma unroll
        for (int i = 0; i < 8; ++i) Vt[(seg * 8 + i) * 280 + kj] = (bf16_t)((v[i >> 1] >> ((i & 1) * 16)) & 0xffffu); }
    for (int idx = tid; idx < 64 * 24; idx += 512) { const int d = idx / 24, cc = 256 + idx % 24; Vt[d * 280 + cc] = 0; }
    for (int i = lane; i < 384; i += 64) Pw[(i / 24) * 168 + 144 + i % 24] = 0;
    __syncthreads();
    const int q0 = w * 16;
    const size_t qrow0 = (size_t)b * 4096 + (size_t)nb * 128 + q0;
    for (int gi = 0; gi < 4; ++gi) {
        const int hq = kvh * 4 + gi;
        const float slope = exp2f(-0.5f * (float)(hq + 1));
        const float sink = P.in[21][layer * 16 + hq];
        if (gi < 3) {
#pragma unroll
            for (int ks = 0; ks < 2; ++ks) qn[ks] = *(const bf16x8*)(qbase + (gi + 1) * 64 + ks * 32); }
        f32x4 S[9];
#pragma unroll
        for (int nt = 0; nt < 9; ++nt) { f32x4 a = (f32x4){0.f, 0.f, 0.f, 0.f}; const bf16_t* kp = Ks + (q0 + nt * 16 + fr) * 72 + fq * 8;
#pragma unroll
            for (int ks = 0; ks < 2; ++ks) { const bf16x8 kb = *(const bf16x8*)(kp + ks * 32); a = __builtin_amdgcn_mfma_f32_16x16x32_bf16(qa[ks], kb, a, 0, 0, 0); }
            S[nt] = a; }
        float mx[4] = {-INFINITY, -INFINITY, -INFINITY, -INFINITY};
#pragma unroll
        for (int nt = 0; nt < 9; ++nt)
#pragma unroll
            for (int j = 0; j < 4; ++j) { const int dist = (fq * 4 + j) - (nt * 16 + fr) + 128; const bool valid = dist >= 0 && dist <= 128 && (nb > 0 || (q0 + nt * 16 + fr) >= 128);
                const float s = valid ? S[nt][j] * 0.125f - slope * (float)dist : -INFINITY; S[nt][j] = s; mx[j] = fmaxf(mx[j], s); }
        float inv[4];
#pragma unroll
        for (int j = 0; j < 4; ++j) { float m = mx[j];
#pragma unroll
            for (int o = 8; o > 0; o >>= 1) m = fmaxf(m, shx(m, o, lane));
            m = fmaxf(m, sink); float sum = 0.f;
#pragma unroll
            for (int nt = 0; nt < 9; ++nt) { const float p = __expf(S[nt][j] - m); S[nt][j] = p; sum += p; }
#pragma unroll
            for (int o = 8; o > 0; o >>= 1) sum += shx(sum, o, lane);
            inv[j] = 1.f / (sum + __expf(sink - m)); }
#pragma unroll
        for (int nt = 0; nt < 9; ++nt)
#pragma unroll
            for (int j = 0; j < 4; ++j) Pw[(fq * 4 + j) * 168 + nt * 16 + fr] = f2bf(S[nt][j]);
        asm volatile("s_waitcnt lgkmcnt(0)" ::: "memory"); __builtin_amdgcn_wave_barrier();
        f32x4 O[4];
#pragma unroll
        for (int dt = 0; dt < 4; ++dt) O[dt] = (f32x4){0.f, 0.f, 0.f, 0.f};
#pragma unroll
        for (int ks = 0; ks < 5; ++ks) { const bf16x8 pa = *(const bf16x8*)(Pw + fr * 168 + ks * 32 + fq * 8);
#pragma unroll
            for (int dt = 0; dt < 4; ++dt) { const bf16x8 vb = *(const bf16x8*)(Vt + (dt * 16 + fr) * 280 + q0 + ks * 32 + fq * 8); O[dt] = __builtin_amdgcn_mfma_f32_16x16x32_bf16(pa, vb, O[dt], 0, 0, 0); } }
        asm volatile("s_waitcnt lgkmcnt(0)" ::: "memory"); __builtin_amdgcn_wave_barrier();
#pragma unroll
        for (int dt = 0; dt < 4; ++dt)
#pragma unroll
            for (int j = 0; j < 4; ++j) { if (!dry) proj[(qrow0 + fq * 4 + j) * LDP + C_Q + hq * 64 + dt * 16 + fr] = f2bf(O[dt][j] * inv[j]); }
        qa[0] = qn[0]; qa[1] = qn[1];
    }
    if (nb == 31) {
        for (int idx = tid; idx < 128 * 64; idx += 512) { const int t = idx >> 6, d = idx & 63; const size_t row = (size_t)b * 4096 + 3968 + t;
            const size_t o = ((size_t)((layer * 4 + b) * 128 + t)) * 256 + kvh * 64 + d;
            P.out[O_PK + o] = bf2f(proj[row * LDP + C_K + kvh * 64 + d]); P.out[O_PV + o] = bf2f(proj[row * LDP + C_V + kvh * 64 + d]); }
    }
}
__device__ __forceinline__ void attn_sample_item(const Params& P, int layer, int item, float* L, bool dry = false) {
    const int tid = otid(), w = tid >> 6, lane = tid & 63;
    const int sb = item >> 2, kvh = item & 3, r0 = NPR + sb * 4;
    bf16_t* proj = (bf16_t*)(P.ws + WS_PROJ);
    float* Kf = L; float* Vf = Kf + 132 * 65; float* Q = Vf + 132 * 65; float* Sc = Q + 16 * 64;
    const float* ck = P.in[7] + ((size_t)(layer * 128 + sb)) * 128 * 256; const float* cv = P.in[8] + ((size_t)(layer * 128 + sb)) * 128 * 256;
    __syncthreads();
    {
        f32x4 kq[4], vq[4];
#pragma unroll
        for (int i = 0; i < 4; ++i) { const int idx = tid + i * 512, j = idx >> 4, d4 = (idx & 15) * 4; kq[i] = *(const f32x4*)(ck + (size_t)j * 256 + kvh * 64 + d4); vq[i] = *(const f32x4*)(cv + (size_t)j * 256 + kvh * 64 + d4); }
#pragma unroll
        for (int i = 0; i < 4; ++i) { const int idx = tid + i * 512, j = idx >> 4, d4 = (idx & 15) * 4;
#pragma unroll
            for (int e = 0; e < 4; ++e) { Kf[j * 65 + d4 + e] = kq[i][e]; Vf[j * 65 + d4 + e] = vq[i][e]; }
            if (j >= 4) { const size_t o = ((size_t)((layer * 128 + sb) * 128 + (j - 4))) * 256 + kvh * 64 + d4; *(f32x4*)(P.out + O_SK + o) = kq[i]; *(f32x4*)(P.out + O_SV + o) = vq[i]; } }
        if (tid < 256) { const int j = 128 + (tid >> 6), d = tid & 63; const float kv = bf2f(proj[(size_t)(r0 + j - 128) * LDP + C_K + kvh * 64 + d]), vv = bf2f(proj[(size_t)(r0 + j - 128) * LDP + C_V + kvh * 64 + d]);
            Kf[j * 65 + d] = kv; Vf[j * 65 + d] = vv; const size_t o = ((size_t)((layer * 128 + sb) * 128 + (j - 4))) * 256 + kvh * 64 + d; P.out[O_SK + o] = kv; P.out[O_SV + o] = vv; }
    }
    for (int idx = tid; idx < 1024; idx += 512) { const int qr = idx >> 6, d = idx & 63; Q[idx] = bf2f(proj[(size_t)(r0 + (qr >> 2)) * LDP + C_Q + (kvh * 4 + (qr & 3)) * 64 + d]); }
    __syncthreads();
    for (int idx = tid; idx < 16 * 132; idx += 512) { const int qr = idx / 132, j = idx - qr * 132; const int dist = 128 + (qr >> 2) - j; float s = -INFINITY;
        if (dist >= 0 && dist <= 128) { float a = 0.f;
#pragma unroll 8
            for (int d = 0; d < 64; ++d) a += Q[qr * 64 + d] * Kf[j * 65 + d];
            s = a * 0.125f - exp2f(-0.5f * (float)(kvh * 4 + (qr & 3) + 1)) * (float)dist; }
        Sc[qr * 136 + j] = s; }
    __syncthreads();
    for (int rr = 0; rr < 2; ++rr) { const int qr = w * 2 + rr; const float sink = P.in[21][layer * 16 + kvh * 4 + (qr & 3)];
        float v0 = Sc[qr * 136 + lane], v1 = Sc[qr * 136 + 64 + lane], v2 = lane < 4 ? Sc[qr * 136 + 128 + lane] : -INFINITY;
        float m = fmaxf(fmaxf(v0, v1), v2);
#pragma unroll
        for (int o = 32; o > 0; o >>= 1) m = fmaxf(m, shx(m, o, lane));
        m = fmaxf(m, sink);
        v0 = __expf(v0 - m); v1 = __expf(v1 - m); v2 = __expf(v2 - m);
        const float sum = wave_sum(v0 + v1 + v2, lane); const float inv = 1.f / (sum + __expf(sink - m));
        Sc[qr * 136 + lane] = v0 * inv; Sc[qr * 136 + 64 + lane] = v1 * inv; if (lane < 4) Sc[qr * 136 + 128 + lane] = v2 * inv; }
    __syncthreads();
    for (int idx = tid; idx < 1024; idx += 512) { const int qr = idx >> 6, d = idx & 63; float o = 0.f;
        for (int j = 0; j < 132; ++j) o += Sc[qr * 136 + j] * Vf[j * 65 + d];
        if (!dry) proj[(size_t)(r0 + (qr >> 2)) * LDP + C_Q + (kvh * 4 + (qr & 3)) * 64 + d] = f2bf(o); }
}

__device__ __forceinline__ void gmlp_prompt_item(const Params& P, int layer, int item, unsigned char* lds, bool dry = false) {
    const int tid = otid(), w = tid >> 6, lane = tid & 63, fr = lane & 15, fq = lane >> 4;
    const int b = item >> 8, chn = (item >> 3) & 31, g = item & 7;
    const size_t r0 = (size_t)b * 4096 + (size_t)chn * 128;
    bf16_t* proj = (bf16_t*)(P.ws + WS_PROJ);
    bf16_t* VT = (bf16_t*)lds; bf16_t* Wt = VT + 128 * 136; float* MU = (float*)(Wt + 128 * 136); float* RS = MU + 128;
    __syncthreads();
#pragma unroll
    for (int hb = 0; hb < 2; ++hb) { u32x4 av[8], cv8[8];
#pragma unroll
        for (int i = 0; i < 8; ++i) { const bf16_t* vp = proj + (r0 + w * 16 + hb * 8 + i) * LDP + C_UV + 1024 + lane * 16; av[i] = *(const u32x4*)vp; cv8[i] = *(const u32x4*)(vp + 8); }
#pragma unroll
        for (int i = 0; i < 8; ++i) { const int t = w * 16 + hb * 8 + i; float s = 0.f, sq = 0.f;
#pragma unroll
            for (int k = 0; k < 4; ++k) { float x0 = bflo(av[i][k]), x1 = bfhi(av[i][k]), x2 = bflo(cv8[i][k]), x3 = bfhi(cv8[i][k]); s += x0 + x1 + x2 + x3; sq += x0 * x0 + x1 * x1 + x2 * x2 + x3 * x3; }
            s = wave_sum(s, lane); sq = wave_sum(sq, lane);
            if (lane == 0) { const float mean = s * (1.f / 1024.f); const float var = fmaxf(sq * (1.f / 1024.f) - mean * mean, 0.f); MU[t] = mean; RS[t] = rsqrtf(var + EPSF); } } }
    const float* Wg = P.in[24] + ((size_t)(layer * 8 + g)) * 16384;
#pragma unroll
    for (int idx = tid; idx < 4096; idx += 512) { const int t = idx >> 5, s4 = (idx & 31) * 4; const f32x4 wv = *(const f32x4*)(Wg + t * 128 + s4);
        u32x2 o; o[0] = pk2(s4 <= t ? wv[0] : 0.f, s4 + 1 <= t ? wv[1] : 0.f); o[1] = pk2(s4 + 2 <= t ? wv[2] : 0.f, s4 + 3 <= t ? wv[3] : 0.f);
        *(u32x2*)(Wt + t * 136 + s4) = o; }
    __syncthreads();
    const float* lg = P.in[22] + layer * 1024 + g * 128; const float* lb = P.in[23] + layer * 1024 + g * 128;
#pragma unroll
    for (int idx = tid; idx < 2048; idx += 512) { const int s = idx & 127, fs = idx >> 7; const u32x4 v = *(const u32x4*)(proj + (r0 + s) * LDP + C_UV + 1024 + g * 128 + fs * 8);
        const float mu = MU[s], rs = RS[s];
#pragma unroll
        for (int i = 0; i < 8; ++i) { const int f = fs * 8 + i; const float x = (i & 1) ? bfhi(v[i >> 1]) : bflo(v[i >> 1]); VT[f * 136 + s] = f2bf((x - mu) * rs * lg[f] + lb[f]); } }
    __syncthreads();
    bf16_t uv[4][8]; float bsv[4];
#pragma unroll
    for (int j = 0; j < 4; ++j) { const int t = w * 16 + fq * 4 + j; bsv[j] = P.in[25][(layer * 8 + g) * 128 + t];
#pragma unroll
        for (int ft = 0; ft < 8; ++ft) uv[j][ft] = proj[(r0 + t) * LDP + C_UV + g * 128 + ft * 16 + fr]; }
    f32x4 acc[8];
#pragma unroll
    for (int ft = 0; ft < 8; ++ft) acc[ft] = (f32x4){0.f, 0.f, 0.f, 0.f};
    const int nks = (16 * w + 15) / 32 + 1;
    for (int ks = 0; ks < nks; ++ks) { const bf16x8 a = *(const bf16x8*)(Wt + (w * 16 + fr) * 136 + ks * 32 + fq * 8);
#pragma unroll
        for (int ft = 0; ft < 8; ++ft) { const bf16x8 bb = *(const bf16x8*)(VT + (ft * 16 + fr) * 136 + ks * 32 + fq * 8); acc[ft] = __builtin_amdgcn_mfma_f32_16x16x32_bf16(a, bb, acc[ft], 0, 0, 0); } }
#pragma unroll
    for (int j = 0; j < 4; ++j) { const int t = w * 16 + fq * 4 + j;
#pragma unroll
        for (int ft = 0; ft < 8; ++ft) { if (!dry) proj[(r0 + t) * LDP + C_UV + g * 128 + ft * 16 + fr] = f2bf(gelu_fast(bf2f(uv[j][ft])) * (acc[ft][j] + bsv[j])); } }
}
__device__ __forceinline__ void gmlp_sample_item(const Params& P, int layer, int sb, float* L) {
    const int tid = otid(), w = tid >> 6, lane = tid & 63; const size_t r0 = NPR + sb * 4;
    bf16_t* proj = (bf16_t*)(P.ws + WS_PROJ);
    float* Vn = L; float* MU = Vn + 4096; float* RS = MU + 4;
    __syncthreads();
    if (w < 4) { const bf16_t* vp = proj + (r0 + w) * LDP + C_UV + 1024 + lane * 16; const u32x4 a = *(const u32x4*)vp, c = *(const u32x4*)(vp + 8); float s = 0.f, sq = 0.f;
#pragma unroll
        for (int k = 0; k < 4; ++k) { float x0 = bflo(a[k]), x1 = bfhi(a[k]), x2 = bflo(c[k]), x3 = bfhi(c[k]); s += x0 + x1 + x2 + x3; sq += x0 * x0 + x1 * x1 + x2 * x2 + x3 * x3; }
        s = wave_sum(s, lane); sq = wave_sum(sq, lane);
        if (lane == 0) { const float mean = s * (1.f / 1024.f); const float var = fmaxf(sq * (1.f / 1024.f) - mean * mean, 0.f); MU[w] = mean; RS[w] = rsqrtf(var + EPSF); } }
    __syncthreads();
    for (int idx = tid; idx < 4096; idx += 512) { const int t = idx >> 10, c = idx & 1023;
        const float x = bf2f(proj[(r0 + t) * LDP + C_UV + 1024 + c]); const float vn = (x - MU[t]) * RS[t] * P.in[22][layer * 1024 + c] + P.in[23][layer * 1024 + c];
        Vn[idx] = vn; P.out[O_SGMV + ((size_t)((layer * 128 + sb) * 4 + t)) * 1024 + c] = vn; }
    __syncthreads();
    for (int idx = tid; idx < 4096; idx += 512) { const int t = idx >> 10, c = idx & 1023, g = c >> 7;
        const float* Wg = P.in[24] + ((size_t)(layer * 8 + g)) * 16384 + t * 128; float m = P.in[25][(layer * 8 + g) * 128 + t];
        for (int s = 0; s <= t; ++s) m += Wg[s] * Vn[s * 1024 + c];
        bf16_t* ap = proj + (r0 + t) * LDP + C_UV + c; *ap = f2bf(gelu_fast(bf2f(*ap)) * m); }
}

template <int R>
__device__ __forceinline__ void shortconv_rows(const Params& P, int layer, int r0, int tid, bool dry) {
    bf16_t* proj = (bf16_t*)(P.ws + WS_PROJ);
    const float* cw = P.in[20] + layer * 3 * 1024;
    const int j = tid * 2; const int ss = seq_start(r0); const bool havePrev = (r0 - 2 >= ss);
    unsigned cg[R + 2], xs[R + 2], bg[R];
#pragma unroll
    for (int k = 0; k < R + 2; ++k) { cg[k] = 0u; xs[k] = 0u;
        if (k >= 2 || havePrev) { const bf16_t* rp = proj + (size_t)(r0 - 2 + k) * LDP + C_BCX + j; cg[k] = *(const unsigned*)(rp + 1024); xs[k] = *(const unsigned*)(rp + 2048); } }
#pragma unroll
    for (int k = 0; k < R; ++k) bg[k] = *(const unsigned*)(proj + (size_t)(r0 + k) * LDP + C_BCX + j);
    float pr0[R + 2], pr1[R + 2];
#pragma unroll
    for (int k = 0; k < R + 2; ++k) { pr0[k] = bflo(cg[k]) * bflo(xs[k]); pr1[k] = bfhi(cg[k]) * bfhi(xs[k]); }
    if (!havePrev && r0 >= NPR) { const float* st = P.in[6] + ((size_t)(layer * 128 + ((r0 - NPR) >> 2)) * 2) * 1024 + j; pr0[0] = st[0]; pr1[0] = st[1]; pr0[1] = st[1024]; pr1[1] = st[1025]; }
    const float w0a = cw[j], w0b = cw[j + 1], w1a = cw[1024 + j], w1b = cw[1025 + j], w2a = cw[2048 + j], w2b = cw[2049 + j];
#pragma unroll
    for (int k = 0; k < R; ++k) { const float y0 = w0a * pr0[k] + w1a * pr0[k + 1] + w2a * pr0[k + 2], y1 = w0b * pr1[k] + w1b * pr1[k + 1] + w2b * pr1[k + 2];
        if (!dry) *(unsigned*)(proj + (size_t)(r0 + k) * LDP + C_BCX + j) = pk2(bflo(bg[k]) * y0, bfhi(bg[k]) * y1);
        const int r = r0 + k;
        if (r < NPR) { const int l = r & 4095; if (l >= 4094) { float* o = P.out + O_PSCC + ((size_t)((layer * 4 + (r >> 12)) * 2 + (l - 4094))) * 1024 + j; o[0] = pr0[k + 2]; o[1] = pr1[k + 2]; } }
        else { const int l = (r - NPR) & 3; if (l >= 2) { float* o = P.out + O_SSCC + ((size_t)((layer * 128 + ((r - NPR) >> 2)) * 2 + (l - 2))) * 1024 + j; o[0] = pr0[k + 2]; o[1] = pr1[k + 2]; } }
    }
}
__device__ __forceinline__ void shortconv_item(const Params& P, int layer, int item, bool dry = false) {
    const int tid = otid();
    if (item < 1024) shortconv_rows<16>(P, layer, item * 16, tid, dry); else shortconv_rows<4>(P, layer, NPR + (item - 1024) * 4, tid, dry);
}
__device__ __forceinline__ void ssdconv_state_item(const Params& P, int layer, int sq) {
    const bf16_t* proj = (const bf16_t*)(P.ws + WS_PROJ);
    const size_t rbase = sq < 4 ? (size_t)sq * 4096 + 4093 : (size_t)NPR + (size_t)(sq - 4) * 4 + 1;
    float* o = sq < 4 ? P.out + O_PSSDC + (size_t)(layer * 4 + sq) * 3 * 1536 : P.out + O_SSSDC + (size_t)(layer * 128 + (sq - 4)) * 3 * 1536;
    const int tid = otid(); bf16_t v[9];
#pragma unroll
    for (int i = 0; i < 9; ++i) { const int e = tid + i * 512, t = e / 1536, c = e - t * 1536; v[i] = proj[(rbase + t) * LDP + C_XBC + c]; }
#pragma unroll
    for (int i = 0; i < 9; ++i) o[tid + i * 512] = bf2f(v[i]);
}

template <int R>
__device__ __forceinline__ void ffn_act_unit(const Params& P, int layer, int r0, int oc) {
    const bf16_t* up = (const bf16_t*)(P.ws + WS_PROJ); bf16_t* act = (bf16_t*)(P.ws + WS_PROJ + UP_BYTES);
    const float* cw = P.in[30] + (size_t)layer * 3 * 5632; const float* cb = P.in[31] + (size_t)layer * 5632;
    const int j0 = oc * 8;
    float wa[3][8], wg[3][8], ba[8], bgv[8], pa[2][8], pg[2][8];
#pragma unroll
    for (int k = 0; k < 3; ++k) { const f32x4 a0 = *(const f32x4*)(cw + k * 5632 + j0), a1 = *(const f32x4*)(cw + k * 5632 + j0 + 4), g0 = *(const f32x4*)(cw + k * 5632 + 2816 + j0), g1 = *(const f32x4*)(cw + k * 5632 + 2816 + j0 + 4);
#pragma unroll
        for (int i = 0; i < 4; ++i) { wa[k][i] = a0[i]; wa[k][4 + i] = a1[i]; wg[k][i] = g0[i]; wg[k][4 + i] = g1[i]; } }
    { const f32x4 a0 = *(const f32x4*)(cb + j0), a1 = *(const f32x4*)(cb + j0 + 4), g0 = *(const f32x4*)(cb + 2816 + j0), g1 = *(const f32x4*)(cb + 2816 + j0 + 4);
#pragma unroll
      for (int i = 0; i < 4; ++i) { ba[i] = a0[i]; ba[4 + i] = a1[i]; bgv[i] = g0[i]; bgv[4 + i] = g1[i]; } }
    const int ss = seq_start(r0); const bool havePrev = (r0 - 2 >= ss);
#pragma unroll
    for (int k = 0; k < 2; ++k) {
        if (havePrev) { const u32x4 ua = *(const u32x4*)(up + (size_t)(r0 - 2 + k) * 5632 + j0), ug = *(const u32x4*)(up + (size_t)(r0 - 2 + k) * 5632 + 2816 + j0);
#pragma unroll
            for (int i = 0; i < 4; ++i) { pa[k][2 * i] = bflo(ua[i]); pa[k][2 * i + 1] = bfhi(ua[i]); pg[k][2 * i] = bflo(ug[i]); pg[k][2 * i + 1] = bfhi(ug[i]); } }
        else if (r0 >= NPR) { const float* pp = P.in[9] + ((size_t)(layer * 128 + ((r0 - NPR) >> 2)) * 2 + k) * 5632;
#pragma unroll
            for (int i = 0; i < 8; ++i) { pa[k][i] = pp[j0 + i]; pg[k][i] = pp[2816 + j0 + i]; } }
        else {
#pragma unroll
            for (int i = 0; i < 8; ++i) { pa[k][i] = 0.f; pg[k][i] = 0.f; } } }
#pragma unroll
    for (int kb = 0; kb < R; kb += 4) { u32x4 ua[4], ug[4];
#pragma unroll
        for (int q = 0; q < 4; ++q) { ua[q] = *(const u32x4*)(up + (size_t)(r0 + kb + q) * 5632 + j0); ug[q] = *(const u32x4*)(up + (size_t)(r0 + kb + q) * 5632 + 2816 + j0); }
#pragma unroll
        for (int q = 0; q < 4; ++q) { const int r = r0 + kb + q; float ca[8], cgv[8], o[8];
#pragma unroll
            for (int i = 0; i < 4; ++i) { ca[2 * i] = bflo(ua[q][i]); ca[2 * i + 1] = bfhi(ua[q][i]); cgv[2 * i] = bflo(ug[q][i]); cgv[2 * i + 1] = bfhi(ug[q][i]); }
#pragma unroll
            for (int i = 0; i < 8; ++i) { const float a = ba[i] + wa[0][i] * pa[0][i] + wa[1][i] * pa[1][i] + wa[2][i] * ca[i], g = bgv[i] + wg[0][i] * pg[0][i] + wg[1][i] * pg[1][i] + wg[2][i] * cgv[i];
                o[i] = silu_fast(a) * g; pa[0][i] = pa[1][i]; pa[1][i] = ca[i]; pg[0][i] = pg[1][i]; pg[1][i] = cgv[i]; }
            u32x4 ov; ov[0] = pk2(o[0], o[1]); ov[1] = pk2(o[2], o[3]); ov[2] = pk2(o[4], o[5]); ov[3] = pk2(o[6], o[7]);
            *(u32x4*)(act + (size_t)r * 2816 + j0) = ov;
            float* so = nullptr;
            if (r < NPR) { const int l = r & 4095; if (l >= 4094) so = P.out + O_PFFC + ((size_t)((layer * 4 + (r >> 12)) * 2 + (l - 4094))) * 5632; }
            else { const int l = (r - NPR) & 3; if (l >= 2) so = P.out + O_SFFC + ((size_t)((layer * 128 + ((r - NPR) >> 2)) * 2 + (l - 2))) * 5632; }
            if (so) {
#pragma unroll
                for (int i = 0; i < 8; ++i) { so[j0 + i] = ca[i]; so[2816 + j0 + i] = cgv[i]; } }
        } }
}
__device__ __forceinline__ void phase_ffn_act(const Params& P, int layer) {
    constexpr int NU_P = 2048 * 352, NU_S = 128 * 352;
    for (int u = blockIdx.x * 512 + otid(); u < NU_P + NU_S; u += gridDim.x * 512) {
        if (u < NU_P) { const int rb = u / 352, oc = u - rb * 352; ffn_act_unit<8>(P, layer, rb * 8, oc); }
        else { const int v = u - NU_P, sq = v / 352, oc = v - sq * 352; ffn_act_unit<4>(P, layer, NPR + sq * 4, oc); }
    }
}

__device__ __forceinline__ void sgemm_partial(const bf16_t* A, int lda, const bf16_t* Bt, int ldb, int K, int row0, int col0, float* red, int tid) {
    const int w = tid >> 6, lane = tid & 63, fr = lane & 15, fq = lane >> 4;
    const int kw = K >> 3, k0 = w * kw;
    f32x4 acc[2][4];
#pragma unroll
    for (int mt = 0; mt < 2; ++mt)
#pragma unroll
        for (int nt = 0; nt < 4; ++nt) acc[mt][nt] = (f32x4){0.f, 0.f, 0.f, 0.f};
    const bf16_t* ap = A + (size_t)(row0 + fr) * lda + k0 + fq * 8;
    const bf16_t* bp = Bt + (size_t)(col0 + fr) * ldb + k0 + fq * 8;
    const int nks = kw >> 5;
#pragma unroll 4
    for (int ks = 0; ks < nks; ++ks) { bf16x8 a[2], b[4];
#pragma unroll
        for (int mt = 0; mt < 2; ++mt) a[mt] = *(const bf16x8*)(ap + (size_t)mt * 16 * lda + ks * 32);
#pragma unroll
        for (int nt = 0; nt < 4; ++nt) b[nt] = *(const bf16x8*)(bp + (size_t)nt * 16 * ldb + ks * 32);
#pragma unroll
        for (int mt = 0; mt < 2; ++mt)
#pragma unroll
            for (int nt = 0; nt < 4; ++nt) acc[mt][nt] = __builtin_amdgcn_mfma_f32_16x16x32_bf16(a[mt], b[nt], acc[mt][nt], 0, 0, 0); }
#pragma unroll
    for (int mt = 0; mt < 2; ++mt)
#pragma unroll
        for (int nt = 0; nt < 4; ++nt)
#pragma unroll
            for (int j = 0; j < 4; ++j) red[(w * 32 + mt * 16 + fq * 4 + j) * 64 + nt * 16 + fr] = acc[mt][nt][j];
}
__device__ __forceinline__ f32x4 sgemm_reduce(const float* red, int tid) {
    const int row = tid >> 4, c4 = (tid & 15) * 4; f32x4 sacc = (f32x4){0.f, 0.f, 0.f, 0.f};
#pragma unroll
    for (int w = 0; w < 8; ++w) sacc += *(const f32x4*)(red + (w * 32 + row) * 64 + c4);
    return sacc;
}
__device__ __forceinline__ void sg_load4(const bf16_t* ap, int lda, const bf16_t* bp, int ldb, bf16x8 (&a)[4][2], bf16x8 (&b)[4][4]) {
#pragma unroll
    for (int ks = 0; ks < 4; ++ks) {
#pragma unroll
        for (int mt = 0; mt < 2; ++mt) a[ks][mt] = *(const bf16x8*)(ap + (size_t)mt * 16 * lda + ks * 32);
#pragma unroll
        for (int nt = 0; nt < 4; ++nt) b[ks][nt] = *(const bf16x8*)(bp + (size_t)nt * 16 * ldb + ks * 32); }
}
__device__ __forceinline__ void sample_branch(const Params& P, int layer, float* red) {
    const int tid = otid(), w = tid >> 6, lane = tid & 63, fr = lane & 15, fq = lane >> 4;
    const bf16_t* proj = (const bf16_t*)(P.ws + WS_PROJ); bf16_t* hbuf = (bf16_t*)(P.ws + WS_H);
    for (int piece = blockIdx.x; piece < 256; piece += gridDim.x) {
        const int row0 = (piece >> 4) * 32, col0 = (piece & 15) * 64; const size_t r = NPR + row0 + (tid >> 4); const int c = col0 + (tid & 15) * 4;
        const bf16_t* abase = proj + (size_t)(NPR + row0 + fr) * LDP + w * 128 + fq * 8;
        const bf16_t* bbase = (const bf16_t*)(P.ws + WS_WBR) + (size_t)layer * 4 * 1048576 + (size_t)(col0 + fr) * 1024 + w * 128 + fq * 8;
        bf16x8 a[4][2], b[4][4];
        sg_load4(abase + C_Z, LDP, bbase, 1024, a, b);
        f32x4 sum = (f32x4){0.f, 0.f, 0.f, 0.f};
        for (int z = 0; z < 4; ++z) {
            f32x4 acc[2][4];
#pragma unroll
            for (int mt = 0; mt < 2; ++mt)
#pragma unroll
                for (int nt = 0; nt < 4; ++nt) acc[mt][nt] = (f32x4){0.f, 0.f, 0.f, 0.f};
#pragma unroll
            for (int ks = 0; ks < 4; ++ks)
#pragma unroll
                for (int mt = 0; mt < 2; ++mt)
#pragma unroll
                    for (int nt = 0; nt < 4; ++nt) acc[mt][nt] = __builtin_amdgcn_mfma_f32_16x16x32_bf16(a[ks][mt], b[ks][nt], acc[mt][nt], 0, 0, 0);
            if (z < 3) { const int ao = z == 0 ? C_BCX : (z == 1 ? C_Q : C_UV); sg_load4(abase + ao, LDP, bbase + (size_t)(z + 1) * 1048576, 1024, a, b); }
            const u32x2 gv = *(const u32x2*)(proj + r * LDP + C_GATE + z * 1024 + c);
            __syncthreads();
#pragma unroll
            for (int mt = 0; mt < 2; ++mt)
#pragma unroll
                for (int nt = 0; nt < 4; ++nt)
#pragma unroll
                    for (int j = 0; j < 4; ++j) red[(w * 32 + mt * 16 + fq * 4 + j) * 64 + nt * 16 + fr] = acc[mt][nt][j];
            __syncthreads();
            const f32x4 v = sgemm_reduce(red, tid);
            sum[0] += sigmoid_fast(bflo(gv[0])) * v[0]; sum[1] += sigmoid_fast(bfhi(gv[0])) * v[1]; sum[2] += sigmoid_fast(bflo(gv[1])) * v[2]; sum[3] += sigmoid_fast(bfhi(gv[1])) * v[3];
        }
        u32x2 o; o[0] = pk2(sum[0], sum[1]); o[1] = pk2(sum[2], sum[3]); *(u32x2*)(hbuf + r * 1024 + c) = o;
        __syncthreads();
    }
}
__device__ __forceinline__ void sample_resid(const Params& P, const bf16_t* A, int lda, const bf16_t* Bt, int K, const float* xin_s, float* xout, const float* ga, float* red) {
    const int tid = otid();
    for (int piece = blockIdx.x; piece < 256; piece += gridDim.x) {
        const int row0 = (piece >> 4) * 32, col0 = (piece & 15) * 64; const int rs = row0 + (tid >> 4), c = col0 + (tid & 15) * 4;
        const f32x4 xv = *(const f32x4*)(xin_s + (size_t)rs * 1024 + c), gv = *(const f32x4*)(ga + (size_t)(4 + (rs >> 2)) * 6144 + c);
        __syncthreads();
        sgemm_partial(A, lda, Bt, K, K, row0, col0, red, tid);
        __syncthreads();
        const f32x4 v = sgemm_reduce(red, tid);
        *(f32x4*)(xout + (size_t)(NPR + rs) * 1024 + c) = xv + gv * v;
    }
}

__device__ __forceinline__ void grid_bar(unsigned* ctr, unsigned& epoch) {
    asm volatile("s_waitcnt vmcnt(0) lgkmcnt(0)" ::: "memory");
    __syncthreads();
    epoch += 1;
    if (otid() == 0) {
        __builtin_amdgcn_fence(__ATOMIC_RELEASE, "agent");
        asm volatile("s_waitcnt vmcnt(0) lgkmcnt(0)" ::: "memory");
        __hip_atomic_fetch_add(ctr, 1u, __ATOMIC_RELAXED, __HIP_MEMORY_SCOPE_AGENT);
        const unsigned target = epoch * gridDim.x;
        while (__hip_atomic_load(ctr, __ATOMIC_RELAXED, __HIP_MEMORY_SCOPE_AGENT) < target) __builtin_amdgcn_s_sleep(1);
        __builtin_amdgcn_fence(__ATOMIC_ACQUIRE, "agent");
        asm volatile("s_waitcnt vmcnt(0) lgkmcnt(0)" ::: "memory");
    }
    __syncthreads();
}

#ifndef PHMASK
#define PHMASK 0xFFFFFFFF
#endif
#define EN(x) ((PHMASK >> (x)) & 1)
#ifndef DRYM
#define DRYM 0
#endif
#ifndef DBL
#define DBL 0
#endif
#define REP(x) (((DBL >> (x)) & 1) ? 2 : 1)
constexpr int PH_PER_LAYER = 11, N_PHASES = 2 + 4 * PH_PER_LAYER + 1;

__global__ void __launch_bounds__(512, 2) mega_fwd(Params PK) {
    extern __shared__ __attribute__((aligned(16))) unsigned char lds_raw[];
    cg::grid_group grid = cg::this_grid();
    LAS unsigned char* ldsl = (LAS unsigned char*)lds_raw;
    unsigned epoch = 0;
    for (int ph = PK.ph_lo; ph < PK.ph_hi; ++ph) {
        Params P = PK;
        { unsigned char* w_ = P.ws; asm volatile("" : "+s"(w_)); P.ws = w_; float* o_ = P.out; asm volatile("" : "+s"(o_)); P.out = o_; }
        unsigned* barctr = (unsigned*)(P.ws + WS_BAR);
        bf16_t* proj = (bf16_t*)(P.ws + WS_PROJ);
        bf16_t* hbuf = (bf16_t*)(P.ws + WS_H);
        float* xbuf = P.out;
        float* mod = (float*)(P.ws + WS_MOD);
        if (ph == 0) { for (int rp = 0; rp < REP(0); ++rp) phase_convert(P, (float*)lds_raw); }
        else if (ph == 1) {
            Gemm g{(const bf16_t*)(P.ws + WS_CACT), (const bf16_t*)(P.ws + WS_WADA), 1024, 1024, 1024, 1, 96, 0, 0, 0, 0, 0};
            EpiMod E{mod, P.in[11]};
            for (int rp = 0; rp < REP(1); ++rp) gemm_phase<EpiMod, 1>(ldsl, g, E);
        }
        else if (ph == N_PHASES - 1) { phase_final_norm(xbuf, P.in[33]); }
        else {
            const int layer = (ph - 2) / PH_PER_LAYER, sp = (ph - 2) % PH_PER_LAYER;
            const float* modL = mod + (size_t)layer * NCOND * 6144;
            const float* xin_p = layer == 0 ? P.in[0] : xbuf; const float* xin_s = layer == 0 ? P.in[1] : xbuf + (size_t)NPR * 1024;
            if (sp == 0) { for (int rp = 0; rp < REP(16); ++rp) phase_norm(xin_p, xin_s, P.in[12] + layer * 1024, modL, 0, 1024, hbuf); }
            else if (sp == 1) {
                Gemm g{hbuf, (const bf16_t*)(P.ws + WS_WIN) + (size_t)layer * 13568 * 1024, 1024, 1024, 1024, 66, 53, 0, 0, 0, 0, 0};
                EpiProj E{proj};
                for (int rp = 0; rp < REP(2); ++rp) gemm_phase<EpiProj, 1>(ldsl, g, E);
            }
            else if (sp == 2) {
                for (int it = blockIdx.x; it < 3972 + 256; it += gridDim.x) {
                    if (it < 512) { for (int rp = 0; rp < REP(3); ++rp) ssd_pass1_item(P, layer, it, lds_raw); }
                    else if (it < 1024) { for (int rp = (DRYM & 1) ? 0 : 1; rp < 2; ++rp) attn_prompt_item(P, layer, it - 512, lds_raw, rp == 0 && P.ph_lo == 0); }
                    else if (it < 1536) { for (int rp = (DRYM & 2) ? 0 : 1; rp < 2; ++rp) attn_sample_item(P, layer, it - 1024, (float*)lds_raw, rp == 0 && P.ph_lo == 0); }
                    else if (it < 2560) { for (int rp = (DRYM & 4) ? 0 : 1; rp < 2; ++rp) gmlp_prompt_item(P, layer, it - 1536, lds_raw, rp == 0 && P.ph_lo == 0); }
                    else if (it < 2688) { if (EN(8)) gmlp_sample_item(P, layer, it - 2560, (float*)lds_raw); }
                    else if (it < 3840) { for (int rp = (DRYM & 8) ? 0 : 1; rp < 2; ++rp) shortconv_item(P, layer, it - 2688, rp == 0 && P.ph_lo == 0); }
                    else if (it < 3972) ssdconv_state_item(P, layer, it - 3840);
                    else ssd_item<2>(P, layer, it - 3972, (float*)lds_raw);
                }
            }
            else if (sp == 3) { phase_ssd_scan(P, layer); }
            else if (sp == 4) { for (int it = blockIdx.x; it < 512; it += gridDim.x) for (int rp = (DRYM & 16) ? 0 : 1; rp < 2; ++rp) ssd_pass3_item(P, layer, it, lds_raw, rp == 0 && P.ph_lo == 0); }
            else if (sp == 5) {
                Gemm g{proj, (const bf16_t*)(P.ws + WS_WBR) + (size_t)layer * 4 * 1048576, LDP, 1024, 1024, 64, 4, C_Z, C_BCX, C_Q, C_UV, (size_t)1048576};
                EpiBranch E{proj, (float*)(P.ws + WS_MSUM), hbuf};
                for (int rp = 0; rp < REP(11); ++rp) gemm_phase<EpiBranch, 4>(ldsl, g, E);
                for (int rp = 0; rp < REP(17); ++rp) sample_branch(P, layer, (float*)lds_raw);
            }
            else if (sp == 6) {
                Gemm g{hbuf, (const bf16_t*)(P.ws + WS_WO) + (size_t)layer * 1048576, 1024, 1024, 1024, 64, 4, 0, 0, 0, 0, 0};
                EpiResid E{xin_p, xin_s, xbuf, modL + 2048};
                if (EN(12)) gemm_phase<EpiResid, 1>(ldsl, g, E);
                sample_resid(P, hbuf + (size_t)NPR * 1024, 1024, (const bf16_t*)(P.ws + WS_WO) + (size_t)layer * 1048576, 1024, xin_s, xbuf, modL + 2048, (float*)lds_raw);
            }
            else if (sp == 7) { for (int rp = 0; rp < REP(16); ++rp) phase_norm(xbuf, xbuf + (size_t)NPR * 1024, P.in[28] + layer * 1024, modL, 3072, 4096, hbuf); }
            else if (sp == 8) {
                Gemm g{hbuf, (const bf16_t*)(P.ws + WS_WUP) + (size_t)layer * 5632 * 1024, 1024, 1024, 1024, 66, 22, 0, 0, 0, 0, 0};
                EpiUp E{proj};
                for (int rp = 0; rp < REP(13); ++rp) gemm_phase<EpiUp, 1>(ldsl, g, E);
            }
            else if (sp == 9) { for (int rp = 0; rp < REP(14); ++rp) phase_ffn_act(P, layer); }
            else {
                Gemm g{(const bf16_t*)(P.ws + WS_PROJ + UP_BYTES), (const bf16_t*)(P.ws + WS_WDN) + (size_t)layer * 1024 * 2816, 2816, 2816, 2816, 64, 4, 0, 0, 0, 0, 0};
                EpiResid E{xbuf, xbuf + (size_t)NPR * 1024, xbuf, modL + 5120};
                if (EN(15)) gemm_phase<EpiResid, 1>(ldsl, g, E);
                sample_resid(P, (const bf16_t*)(P.ws + WS_PROJ + UP_BYTES) + (size_t)NPR * 2816, 2816, (const bf16_t*)(P.ws + WS_WDN) + (size_t)layer * 1024 * 2816, 2816, xbuf + (size_t)NPR * 1024, xbuf, modL + 5120, (float*)lds_raw);
            }
        }
        if (ph + 1 < P.ph_hi) { if (ph == 0) grid.sync(); else grid_bar(barctr, epoch); }
    }
}

extern "C" void kernel_launch(void* const* d_in, const int* in_sizes, int n_in, void* d_out, int out_size, void* d_ws, size_t ws_size, hipStream_t stream) {
    static int grid_blocks = 0;
    if (grid_blocks == 0) {
        if (n_in != 34 || (size_t)out_size != O_END || ws_size < WS_END + 256) { fprintf(stderr, "kernel_launch: unexpected sizes n_in %d out %d ws %zu (need %zu)\n", n_in, out_size, ws_size, (size_t)WS_END); grid_blocks = -1; return; }
        int dev = 0, cus = 0, per_cu = 0;
        (void)hipGetDevice(&dev); (void)hipDeviceGetAttribute(&cus, hipDeviceAttributeMultiprocessorCount, dev);
        if (hipFuncSetAttribute((const void*)mega_fwd, hipFuncAttributeMaxDynamicSharedMemorySize, LDS_BYTES) != hipSuccess) { fprintf(stderr, "hipFuncSetAttribute failed\n"); grid_blocks = -1; return; }
        if (hipOccupancyMaxActiveBlocksPerMultiprocessor(&per_cu, (const void*)mega_fwd, 512, LDS_BYTES) != hipSuccess || per_cu < 1) per_cu = 1;
        grid_blocks = cus * 1;
    }
    if (grid_blocks < 0) return;
    Params p{};
    for (int i = 0; i < 34; ++i) p.in[i] = (const float*)d_in[i];
    p.out = (float*)d_out; p.ws = (unsigned char*)d_ws; p.ph_lo = 0; p.ph_hi = N_PHASES;
    (void)hipMemsetAsync((unsigned char*)d_ws + WS_BAR, 0, 256, stream);
    void* args[] = {&p};
    hipError_t e = hipLaunchCooperativeKernel((const void*)mega_fwd, dim3(grid_blocks), dim3(512), args, LDS_BYTES, stream);
    if (e != hipSuccess) fprintf(stderr, "cooperative launch failed: %s (grid %d)\n", hipGetErrorString(e), grid_blocks);
}
```

```cpp
#include <hip/hip_runtime.h>
#include <hip/hip_cooperative_groups.h>
#include <cstdio>
namespace cg = cooperative_groups;

typedef unsigned short bf16_t;
typedef short bf16x8 __attribute__((ext_vector_type(8)));
typedef float f32x4 __attribute__((ext_vector_type(4)));
typedef unsigned u32x4 __attribute__((ext_vector_type(4)));
typedef unsigned u32x2 __attribute__((ext_vector_type(2)));
#define LAS __attribute__((address_space(3)))

constexpr int NTOK = 16896, NPR = 16384;
constexpr int LDP = 13568;
constexpr int C_Z = 0, C_XBC = 1024, C_DTR = 2560, C_BCX = 2576, C_Q = 5648, C_K = 6672, C_V = 6928, C_UV = 7184, C_GATE = 9232, C_END = 13328;
constexpr int NCOND = 132;
constexpr float EPSF = 1e-6f;

constexpr size_t WS_WIN = 0;
constexpr size_t WS_WBR = WS_WIN + (size_t)4 * 13568 * 1024 * 2;
constexpr size_t WS_WO = WS_WBR + (size_t)16 * 1024 * 1024 * 2;
constexpr size_t WS_WUP = WS_WO + (size_t)4 * 1024 * 1024 * 2;
constexpr size_t WS_WDN = WS_WUP + (size_t)4 * 5632 * 1024 * 2;
constexpr size_t WS_WADA = WS_WDN + (size_t)4 * 1024 * 2816 * 2;
constexpr size_t WS_CACT = WS_WADA + (size_t)4 * 6144 * 1024 * 2;
constexpr size_t WS_MOD = WS_CACT + (size_t)256 * 1024 * 2;
constexpr size_t WS_H = WS_MOD + (size_t)4 * NCOND * 6144 * 4;
constexpr size_t WS_MSUM = WS_H + (size_t)NTOK * 1024 * 2;
constexpr size_t WS_PROJ = WS_MSUM + (size_t)NTOK * 1024 * 4;
constexpr size_t WS_END = WS_PROJ + (size_t)NTOK * LDP * 2;
constexpr size_t WS_BAR = WS_END;
constexpr size_t WS_SSDST = WS_WADA;
constexpr size_t WS_SSDDEC = WS_WADA + (size_t)4 * 32 * 16 * 4096 * 4;
constexpr size_t UP_BYTES = (size_t)NTOK * 5632 * 2;

constexpr size_t O_YP = 0, O_YS = 16777216, O_PSSM = O_YS + 524288, O_PSSDC = O_PSSM + 1048576, O_PSCC = O_PSSDC + 73728,
                 O_PK = O_PSCC + 32768, O_PV = O_PK + 524288, O_PFFC = O_PV + 524288, O_SSSM = O_PFFC + 180224,
                 O_SSSDC = O_SSSM + 33554432, O_SSCC = O_SSSDC + 2359296, O_SK = O_SSCC + 1048576, O_SV = O_SK + 16777216,
                 O_SFFC = O_SV + 16777216, O_SGMV = O_SFFC + 5767168, O_END = O_SGMV + 2097152;

struct Params { const float* in[34]; float* out; unsigned char* ws; int ph_lo, ph_hi; };

constexpr int LDS_BYTES = 155648;

__device__ __forceinline__ float bf2f(bf16_t v) { return __uint_as_float((unsigned)v << 16); }
__device__ __forceinline__ float bflo(unsigned v) { return __uint_as_float(v << 16); }
__device__ __forceinline__ float bfhi(unsigned v) { return __uint_as_float(v & 0xffff0000u); }
__device__ __forceinline__ unsigned pk2(float lo, float hi) { unsigned r; asm("v_cvt_pk_bf16_f32 %0, %1, %2" : "=v"(r) : "v"(lo), "v"(hi)); return r; }
__device__ __forceinline__ bf16_t f2bf(float f) { return (bf16_t)(pk2(f, 0.f) & 0xffffu); }
__device__ __forceinline__ float shx(float v, int o, int lane) { return __int_as_float(__builtin_amdgcn_ds_bpermute((lane ^ o) << 2, __float_as_int(v))); }
__device__ __forceinline__ float wave_sum(float v, int lane) {
#pragma unroll
    for (int o = 32; o > 0; o >>= 1) v += shx(v, o, lane);
    return v;
}
__device__ __forceinline__ int otid() { int t = threadIdx.x; asm volatile("" : "+v"(t)); return t; }
__device__ __forceinline__ float sigmoidf_(float x) { return __builtin_amdgcn_rcpf(1.f + __expf(-x)); }
__device__ __forceinline__ float siluf_(float x) { return x * __builtin_amdgcn_rcpf(1.f + __expf(-x)); }
__device__ __forceinline__ float geluf_(float x) { const float u = 0.7978845608f * (x + 0.044715f * x * x * x); return x / (1.f + __expf(-2.f * u)); }
__device__ __forceinline__ float softplusf_(float x) { return fmaxf(x, 0.f) + log1pf(__expf(-fabsf(x))); }
__device__ __forceinline__ float silu_fast(float x) { return x * __builtin_amdgcn_rcpf(1.f + __expf(-x)); }
__device__ __forceinline__ float sigmoid_fast(float x) { return __builtin_amdgcn_rcpf(1.f + __expf(-x)); }
__device__ __forceinline__ float gelu_fast(float x) { const float u = 0.7978845608f * (x + 0.044715f * x * x * x); return x * __builtin_amdgcn_rcpf(1.f + __expf(-2.f * u)); }
__device__ __forceinline__ int cond_row(int r) { return r < NPR ? (r >> 12) : 4 + ((r - NPR) >> 2); }
__device__ __forceinline__ int seq_start(int r) { return r < NPR ? (r & ~4095) : NPR + ((r - NPR) & ~3); }

constexpr int BM = 256, BK = 64, HALF = 128, HTB = HALF * BK * 2;
__device__ __forceinline__ int lds_byte(int r, int c) { const int st = (r >> 4) * 2 + (c >> 5), rr = r & 15, cc = c & 31, ob = rr * 64 + cc * 2; return st * 1024 + (ob ^ (((ob >> 9) & 1) << 5)); }
__device__ __forceinline__ void stage_rc(int b, int& R, int& C) { const int st = b / 1024, sb = b % 1024, swz = sb ^ (((sb >> 9) & 1) << 5); R = (st >> 1) * 16 + swz / 64; C = (st & 1) * 32 + (swz % 64) / 2; }
__device__ __forceinline__ int perm32(int rho) { const int n = rho >> 4, i = rho & 15; return 8 * (i >> 2) + 4 * n + (i & 3); }

struct Unit { int pm, pn, z; };
struct Gemm { const bf16_t* A; const bf16_t* Bt; int lda, ldb, K, nM, nN; int ao0, ao1, ao2, ao3; size_t zB; };
__device__ __forceinline__ int gemm_aofs(const Gemm& g, int z) { return z == 0 ? g.ao0 : (z == 1 ? g.ao1 : (z == 2 ? g.ao2 : g.ao3)); }

template <int ZN> __device__ __forceinline__ bool unit_next(const Gemm& g, int i, Unit& u) {
    const int tile = i / ZN; u.z = i - tile * ZN;
    const long L = (long)tile * gridDim.x + blockIdx.x; const int nwg = g.nM * g.nN; if (L >= nwg) return false;
    int wgid = (int)L; { const int q = nwg / 8, r = nwg % 8, xcd = wgid % 8, off = wgid / 8; wgid = (xcd < r ? xcd * (q + 1) : r * (q + 1) + (xcd - r) * q) + off; }
    const int nig = 4 * g.nN, gid = wgid / nig, fm = gid * 4, gsz = (g.nM - fm) < 4 ? (g.nM - fm) : 4;
    u.pm = fm + ((wgid % nig) % gsz); u.pn = (wgid % nig) / gsz; return true;
}

template <class Epi, int ZN>
__device__ __forceinline__ void gemm_phase(LAS unsigned char* lds, const Gemm g, const Epi& E) {
    const int tid = otid(), wid = __builtin_amdgcn_readfirstlane(tid >> 6), lane = tid & 63, wr = wid >> 2, wc = wid & 3, fr = lane & 15, fq = lane >> 4;
    const int K = g.K, nt = K / BK;
    unsigned voffA[2], voffB[2];
#pragma unroll
    for (int i = 0; i < 2; ++i) { int R, C; stage_rc(tid * 16 + i * 8192, R, C); const int Rb = Epi::PERM ? ((R & ~31) + perm32(R & 31)) : R;
        voffA[i] = (unsigned)(R * g.lda + C) * 2u; voffB[i] = (unsigned)(Rb * g.ldb + C) * 2u; }
    const size_t kstep = (size_t)(BK * 2);
    const size_t hstepA = (size_t)HALF * g.lda * 2, hstepB = (size_t)HALF * g.ldb * 2;
    const size_t tstepA = 2 * hstepA, tstepB = 2 * hstepB;
    const unsigned ldsw = (unsigned)wid * 1024u;
    const int aoff = lds_byte(wr * 64 + fr, fq * 8), boff = lds_byte(wc * 32 + fr, fq * 8);
#define PG8_SA(b, h) (((b) * 2 + (h)) * HTB)
#define PG8_SB(b, h) ((4 + (b) * 2 + (h)) * HTB)
#define PG8_STAGE(bufoff, gbase, voff) do { _Pragma("unroll") for (int _i = 0; _i < 2; ++_i) \
        __builtin_amdgcn_global_load_lds((const unsigned*)((const char*)(gbase) + (voff)[_i]), (LAS unsigned*)(lds + (bufoff) + ldsw + _i * 8192), 16, 0, 0); } while (0)
#define PG8_LDA(dst, b, h) do { _Pragma("unroll") for (int m = 0; m < 4; ++m) _Pragma("unroll") for (int k = 0; k < 2; ++k) dst[m][k] = *(const LAS bf16x8*)(lds + PG8_SA(b, h) + aoff + m * 2048 + k * 1024); } while (0)
#define PG8_LDB(dst, b, h) do { _Pragma("unroll") for (int n = 0; n < 2; ++n) _Pragma("unroll") for (int k = 0; k < 2; ++k) dst[n][k] = *(const LAS bf16x8*)(lds + PG8_SB(b, h) + boff + n * 2048 + k * 1024); } while (0)
#define PG8_MMA(ai, bj, At, Bt) do { __builtin_amdgcn_s_setprio(1); _Pragma("unroll") for (int m = 0; m < 4; ++m) _Pragma("unroll") for (int n = 0; n < 2; ++n) _Pragma("unroll") for (int k = 0; k < 2; ++k) \
        acc[ai][bj][m][n] = __builtin_amdgcn_mfma_f32_16x16x32_bf16(Bt[n][k], At[m][k], acc[ai][bj][m][n], 0, 0, 0); __builtin_amdgcn_s_setprio(0); } while (0)
#define PG8_WAIT_V(n) asm volatile("s_waitcnt vmcnt(" #n ")" ::: "memory")
#define PG8_WAIT_L(n) asm volatile("s_waitcnt lgkmcnt(" #n ")" ::: "memory")
#define PG8_BAR __builtin_amdgcn_s_barrier()
#define PG8_SCHED __builtin_amdgcn_sched_barrier(0)
    Unit cur, nxt; int ui = 0;
    if (!unit_next<ZN>(g, 0, cur)) return;
    f32x4 acc[2][2][4][2];
#pragma unroll
    for (int a = 0; a < 2; ++a)
#pragma unroll
        for (int b = 0; b < 2; ++b)
#pragma unroll
            for (int m = 0; m < 4; ++m)
#pragma unroll
                for (int n = 0; n < 2; ++n) acc[a][b][m][n] = (f32x4){0.f, 0.f, 0.f, 0.f};
    bf16x8 At[4][2], B0[2][2], B1[2][2];
    const char* cA = (const char*)g.A + (size_t)cur.pm * tstepA + (size_t)gemm_aofs(g, cur.z) * 2;
    const char* cB = (const char*)g.Bt + (size_t)cur.pn * tstepB + (size_t)cur.z * g.zB * 2;
    PG8_WAIT_V(0);
    PG8_STAGE(PG8_SB(0, 0), cB, voffB); PG8_STAGE(PG8_SA(0, 0), cA, voffA); PG8_STAGE(PG8_SB(0, 1), cB + hstepB, voffB); PG8_STAGE(PG8_SA(0, 1), cA + hstepA, voffA);
    if (wr == 1) PG8_BAR;
    PG8_WAIT_V(4); PG8_BAR;
    PG8_STAGE(PG8_SB(1, 0), cB + kstep, voffB); PG8_STAGE(PG8_SA(1, 0), cA + kstep, voffA); PG8_STAGE(PG8_SB(1, 1), cB + hstepB + kstep, voffB);
    PG8_WAIT_V(6); PG8_BAR;
    for (;;) {
        const bool has_next = unit_next<ZN>(g, ui + 1, nxt);
        const char* nA = has_next ? (const char*)g.A + (size_t)nxt.pm * tstepA + (size_t)gemm_aofs(g, nxt.z) * 2 : cA;
        const char* nB = has_next ? (const char*)g.Bt + (size_t)nxt.pn * tstepB + (size_t)nxt.z * g.zB * 2 : cB;
        for (int t = 0; t < nt; t += 2) {
            const bool last = (t == nt - 2);
            const char* a1 = cA + (size_t)(t + 1) * kstep;
            const char* a2 = last ? nA : cA + (size_t)(t + 2) * kstep; const char* b2 = last ? nB : cB + (size_t)(t + 2) * kstep;
            const char* a3 = a2 + kstep; const char* b3 = b2 + kstep;
            PG8_LDB(B0, 0, 0); PG8_SCHED; PG8_LDA(At, 0, 0); PG8_STAGE(PG8_SA(1, 1), a1 + hstepA, voffA);
            PG8_WAIT_L(8); PG8_BAR; PG8_WAIT_L(0); PG8_MMA(0, 0, At, B0); PG8_BAR; PG8_SCHED;
            PG8_LDB(B1, 0, 1); PG8_STAGE(PG8_SB(0, 0), b2, voffB);
            PG8_BAR; PG8_WAIT_L(0); PG8_MMA(0, 1, At, B1); PG8_BAR;
            PG8_LDA(At, 0, 1); PG8_STAGE(PG8_SA(0, 0), a2, voffA);
            PG8_BAR; PG8_WAIT_L(0); PG8_MMA(1, 0, At, B0); PG8_BAR; PG8_SCHED;
            PG8_STAGE(PG8_SB(0, 1), b2 + hstepB, voffB);
            PG8_WAIT_V(6); PG8_BAR; PG8_MMA(1, 1, At, B1); PG8_BAR;
            PG8_LDB(B0, 1, 0); PG8_SCHED; PG8_LDA(At, 1, 0); PG8_STAGE(PG8_SA(0, 1), a2 + hstepA, voffA);
            PG8_WAIT_L(8); PG8_BAR; PG8_WAIT_L(0); PG8_MMA(0, 0, At, B0); PG8_BAR; PG8_SCHED;
            PG8_LDB(B1, 1, 1); PG8_STAGE(PG8_SB(1, 0), b3, voffB);
            PG8_BAR; PG8_WAIT_L(0); PG8_MMA(0, 1, At, B1); PG8_BAR;
            PG8_LDA(At, 1, 1); PG8_STAGE(PG8_SA(1, 0), a3, voffA);
            PG8_BAR; PG8_WAIT_L(0); PG8_MMA(1, 0, At, B0); PG8_BAR; PG8_SCHED;
            PG8_STAGE(PG8_SB(1, 1), b3 + hstepB, voffB);
            PG8_WAIT_V(6); PG8_BAR; PG8_MMA(1, 1, At, B1); PG8_BAR;
        }
        E(acc, cur, wr, wc, fr, fq);
        if (!has_next) break;
#pragma unroll
        for (int a = 0; a < 2; ++a)
#pragma unroll
            for (int b = 0; b < 2; ++b)
#pragma unroll
                for (int m = 0; m < 4; ++m)
#pragma unroll
                    for (int n = 0; n < 2; ++n) acc[a][b][m][n] = (f32x4){0.f, 0.f, 0.f, 0.f};
        cur = nxt; cA = nA; cB = nB; ++ui;
    }
    PG8_WAIT_V(0);
    if (wr == 0) PG8_BAR;
    PG8_BAR;
#undef PG8_SA
#undef PG8_SB
#undef PG8_STAGE
#undef PG8_LDA
#undef PG8_LDB
#undef PG8_MMA
#undef PG8_WAIT_V
#undef PG8_WAIT_L
#undef PG8_BAR
#undef PG8_SCHED
}

struct EpiMod {
    static constexpr bool PERM = false;
    float* mod; const float* bada;
    __device__ __forceinline__ void operator()(const f32x4 (&acc)[2][2][4][2], const Unit& u, int wr, int wc, int fr, int fq) const {
        f32x4 bv[2][2];
#pragma unroll
        for (int bj = 0; bj < 2; ++bj)
#pragma unroll
            for (int n = 0; n < 2; ++n) bv[bj][n] = *(const f32x4*)(bada + u.pn * BM + bj * HALF + wc * 32 + n * 16 + fq * 4);
#pragma unroll
        for (int ai = 0; ai < 2; ++ai)
#pragma unroll
            for (int m = 0; m < 4; ++m) { const int r = u.pm * BM + ai * HALF + wr * 64 + m * 16 + fr; if (r >= NCOND) continue;
#pragma unroll
                for (int bj = 0; bj < 2; ++bj)
#pragma unroll
                    for (int n = 0; n < 2; ++n) { const int c = u.pn * BM + bj * HALF + wc * 32 + n * 16 + fq * 4; const int layer = c / 6144, cc = c - layer * 6144;
                        *(f32x4*)(mod + ((size_t)(layer * NCOND + r)) * 6144 + cc) = acc[ai][bj][m][n] + bv[bj][n]; } }
    }
};
struct EpiProj {
    static constexpr bool PERM = true;
    bf16_t* O;
    __device__ __forceinline__ void operator()(const f32x4 (&acc)[2][2][4][2], const Unit& u, int wr, int wc, int fr, int fq) const {
#pragma unroll
        for (int bj = 0; bj < 2; ++bj) { const int c = u.pn * BM + bj * HALF + wc * 32 + fq * 8; const int mode = (c >= C_UV + 1024 && c < C_GATE) ? 1 : 0;
#pragma unroll
            for (int ai = 0; ai < 2; ++ai)
#pragma unroll
                for (int m = 0; m < 4; ++m) { const int r = u.pm * BM + ai * HALF + wr * 64 + m * 16 + fr;
                    float v[8];
#pragma unroll
                    for (int i = 0; i < 8; ++i) { float x = acc[ai][bj][m][i >> 2][i & 3]; v[i] = (mode == 1 ? gelu_fast(x) : x); }
                    u32x4 o; o[0] = pk2(v[0], v[1]); o[1] = pk2(v[2], v[3]); o[2] = pk2(v[4], v[5]); o[3] = pk2(v[6], v[7]);
                    *(u32x4*)(O + (size_t)r * LDP + c) = o; } }
    }
};
struct EpiUp {
    static constexpr bool PERM = true;
    bf16_t* O;
    __device__ __forceinline__ void operator()(const f32x4 (&acc)[2][2][4][2], const Unit& u, int wr, int wc, int fr, int fq) const {
#pragma unroll
        for (int bj = 0; bj < 2; ++bj) { const int c = u.pn * BM + bj * HALF + wc * 32 + fq * 8;
#pragma unroll
            for (int ai = 0; ai < 2; ++ai)
#pragma unroll
                for (int m = 0; m < 4; ++m) { const int r = u.pm * BM + ai * HALF + wr * 64 + m * 16 + fr;
                    const f32x4 a = acc[ai][bj][m][0], b = acc[ai][bj][m][1];
                    u32x4 o; o[0] = pk2(a[0], a[1]); o[1] = pk2(a[2], a[3]); o[2] = pk2(b[0], b[1]); o[3] = pk2(b[2], b[3]);
                    *(u32x4*)(O + (size_t)r * 5632 + c) = o; } }
    }
};
struct EpiBranch {
    static constexpr bool PERM = true;
    const bf16_t* proj; float* msum; bf16_t* merged;
    __device__ __forceinline__ void operator()(const f32x4 (&acc)[2][2][4][2], const Unit& u, int wr, int wc, int fr, int fq) const {
        const int z = u.z;
        u32x4 gt[2][2], pv[2][2];
        const int c0 = u.pn * BM + wc * 32 + fq * 8, r0 = u.pm * BM + wr * 64 + fr;
#define EB_LOAD(k, buf) do { const int bj_ = (k) >> 2, ai_ = ((k) >> 1) & 1, m0_ = ((k) & 1) * 2; _Pragma("unroll") for (int mm = 0; mm < 2; ++mm) { const int r = r0 + ai_ * HALF + (m0_ + mm) * 16, c = c0 + bj_ * HALF; \
            gt[buf][mm] = *(const u32x4*)(proj + (size_t)r * LDP + C_GATE + z * 1024 + c); pv[buf][mm] = (u32x4){0u, 0u, 0u, 0u}; \
            if (z > 0) pv[buf][mm] = *(const u32x4*)(merged + (size_t)r * 1024 + c); } } while (0)
        EB_LOAD(0, 0);
#pragma unroll
        for (int k = 0; k < 8; ++k) { const int bj = k >> 2, ai = (k >> 1) & 1, m0 = (k & 1) * 2, buf = k & 1;
            if (k < 7) { if (buf == 0) EB_LOAD(k + 1, 1); else EB_LOAD(k + 1, 0); }
#pragma unroll
            for (int mm = 0; mm < 2; ++mm) { const int m = m0 + mm; const int r = r0 + ai * HALF + m * 16, c = c0 + bj * HALF;
                const f32x4 a = acc[ai][bj][m][0], b = acc[ai][bj][m][1]; const u32x4 gv = gt[buf][mm], p = pv[buf][mm];
                u32x4 o;
                o[0] = pk2(bflo(p[0]) + sigmoid_fast(bflo(gv[0])) * a[0], bfhi(p[0]) + sigmoid_fast(bfhi(gv[0])) * a[1]); o[1] = pk2(bflo(p[1]) + sigmoid_fast(bflo(gv[1])) * a[2], bfhi(p[1]) + sigmoid_fast(bfhi(gv[1])) * a[3]);
                o[2] = pk2(bflo(p[2]) + sigmoid_fast(bflo(gv[2])) * b[0], bfhi(p[2]) + sigmoid_fast(bfhi(gv[2])) * b[1]); o[3] = pk2(bflo(p[3]) + sigmoid_fast(bflo(gv[3])) * b[2], bfhi(p[3]) + sigmoid_fast(bfhi(gv[3])) * b[3]);
                *(u32x4*)(merged + (size_t)r * 1024 + c) = o; } }
#undef EB_LOAD
    }
};
struct EpiResid {
    static constexpr bool PERM = false;
    const float* xin_p; const float* xin_s; float* xout; const float* ga;
    __device__ __forceinline__ void operator()(const f32x4 (&acc)[2][2][4][2], const Unit& u, int wr, int wc, int fr, int fq) const {
        const float* gr = ga + (size_t)(u.pm >> 4) * 6144;
        const int c0 = u.pn * BM + wc * 32 + fq * 4, r0 = u.pm * BM + wr * 64 + fr;
        f32x4 gv[2][2];
#pragma unroll
        for (int bj = 0; bj < 2; ++bj)
#pragma unroll
            for (int n = 0; n < 2; ++n) gv[bj][n] = *(const f32x4*)(gr + c0 + bj * HALF + n * 16);
        f32x4 xv[2][2][2];
#define ER_LOAD(k, buf) do { const int r_ = r0 + ((k) >> 2) * HALF + ((k) & 3) * 16; _Pragma("unroll") for (int bj = 0; bj < 2; ++bj) _Pragma("unroll") for (int n = 0; n < 2; ++n) \
            xv[buf][bj][n] = *(const f32x4*)(xin_p + (size_t)r_ * 1024 + c0 + bj * HALF + n * 16); } while (0)
        ER_LOAD(0, 0);
#pragma unroll
        for (int k = 0; k < 8; ++k) { const int ai = k >> 2, m = k & 3, buf = k & 1; const int r = r0 + ai * HALF + m * 16;
            if (k < 7) { if (buf == 0) ER_LOAD(k + 1, 1); else ER_LOAD(k + 1, 0); }
#pragma unroll
            for (int bj = 0; bj < 2; ++bj)
#pragma unroll
                for (int n = 0; n < 2; ++n) *(f32x4*)(xout + (size_t)r * 1024 + c0 + bj * HALF + n * 16) = xv[buf][bj][n] + gv[bj][n] * acc[ai][bj][m][n]; }
#undef ER_LOAD
    }
};

struct CTile { const float* src; bf16_t* dst; int K, N, k0, n0; };
__device__ __forceinline__ CTile conv_decode(const Params& P, int t) {
    constexpr int T_IN = 3392, T_BR = 1024, T_O = 256, T_UP = 1408, T_DN = 704, T_ADA = 1536, T_L = T_IN + T_BR + T_O + T_UP + T_DN + T_ADA;
    const int layer = t / T_L; int r = t - layer * T_L; CTile c;
    if (r < T_IN) { c.src = P.in[13] + (size_t)layer * 1024 * 13328; c.dst = (bf16_t*)(P.ws + WS_WIN) + (size_t)layer * 13568 * 1024; c.K = 1024; c.N = 13328; c.k0 = (r / 212) * 64; c.n0 = (r % 212) * 64; return c; }
    r -= T_IN;
    if (r < T_BR) { const int br = r >> 8, q = r & 255; c.src = P.in[26] + (size_t)(layer * 4 + br) * 1048576; c.dst = (bf16_t*)(P.ws + WS_WBR) + (size_t)(layer * 4 + br) * 1048576; c.K = 1024; c.N = 1024; c.k0 = (q >> 4) * 64; c.n0 = (q & 15) * 64; return c; }
    r -= T_BR;
    if (r < T_O) { c.src = P.in[27] + (size_t)layer * 1048576; c.dst = (bf16_t*)(P.ws + WS_WO) + (size_t)layer * 1048576; c.K = 1024; c.N = 1024; c.k0 = (r >> 4) * 64; c.n0 = (r & 15) * 64; return c; }
    r -= T_O;
    if (r < T_UP) { c.src = P.in[29] + (size_t)layer * 1024 * 5632; c.dst = (bf16_t*)(P.ws + WS_WUP) + (size_t)layer * 5632 * 1024; c.K = 1024; c.N = 5632; c.k0 = (r / 88) * 64; c.n0 = (r % 88) * 64; return c; }
    r -= T_UP;
    if (r < T_DN) { c.src = P.in[32] + (size_t)layer * 2816 * 1024; c.dst = (bf16_t*)(P.ws + WS_WDN) + (size_t)layer * 1024 * 2816; c.K = 2816; c.N = 1024; c.k0 = (r >> 4) * 64; c.n0 = (r & 15) * 64; return c; }
    r -= T_DN;
    c.src = P.in[10] + (size_t)layer * 1024 * 6144; c.dst = (bf16_t*)(P.ws + WS_WADA) + (size_t)layer * 6144 * 1024; c.K = 1024; c.N = 6144; c.k0 = (r / 96) * 64; c.n0 = (r % 96) * 64; return c;
}
__device__ __forceinline__ void phase_convert(const Params& P, float* T) {
    constexpr int NT = 4 * 8320;
    const int tid = otid();
    int t = blockIdx.x;
    CTile cur = conv_decode(P, t < NT ? t : 0);
    float v[8], nv[8];
#pragma unroll
    for (int e = 0; e < 8; ++e) { const int idx = tid + e * 512, k = idx >> 6, n = idx & 63; v[e] = (t < NT && cur.n0 + n < cur.N) ? cur.src[(size_t)(cur.k0 + k) * cur.N + cur.n0 + n] : 0.f; }
    for (; t < NT; t += gridDim.x) {
        const int tn = t + gridDim.x; const bool hn = tn < NT; const CTile nxt = conv_decode(P, hn ? tn : 0);
#pragma unroll
        for (int e = 0; e < 8; ++e) { const int idx = tid + e * 512, k = idx >> 6, n = idx & 63; nv[e] = (hn && nxt.n0 + n < nxt.N) ? nxt.src[(size_t)(nxt.k0 + k) * nxt.N + nxt.n0 + n] : 0.f; }
#pragma unroll
        for (int e = 0; e < 8; ++e) { const int idx = tid + e * 512, k = idx >> 6, n = idx & 63; T[k * 65 + n] = v[e]; }
        __syncthreads();
        { const int n = tid >> 3, kc = (tid & 7) * 8; float x[8];
#pragma unroll
          for (int j = 0; j < 8; ++j) x[j] = T[(kc + j) * 65 + n];
          u32x4 o; o[0] = pk2(x[0], x[1]); o[1] = pk2(x[2], x[3]); o[2] = pk2(x[4], x[5]); o[3] = pk2(x[6], x[7]);
          *(u32x4*)(cur.dst + (size_t)(cur.n0 + n) * cur.K + cur.k0 + kc) = o; }
        __syncthreads();
#pragma unroll
        for (int e = 0; e < 8; ++e) v[e] = nv[e];
        cur = nxt;
    }
    bf16_t* cact = (bf16_t*)(P.ws + WS_CACT);
    for (int i = blockIdx.x * 512 + otid(); i < 256 * 1024; i += gridDim.x * 512) {
        const int r = i >> 10, c = i & 1023; float v = 0.f;
        if (r < 4) v = siluf_(P.in[2][r * 1024 + c]); else if (r < NCOND) v = siluf_(P.in[3][(r - 4) * 1024 + c]);
        cact[i] = f2bf(v);
    }
}

__device__ __forceinline__ void phase_norm(const float* xp, const float* xs, const float* g, const float* modL, int shofs, int scofs, bf16_t* hout) {
    const int tid = otid(); const int w = tid >> 6, lane = tid & 63;
    const int stride = gridDim.x * 8;
    for (int r = blockIdx.x * 8 + w; r < NTOK; r += 2 * stride) {
        const int rb = (r + stride < NTOK) ? r + stride : r;
        const float* xa = r < NPR ? xp + (size_t)r * 1024 : xs + (size_t)(r - NPR) * 1024;
        const float* xb = rb < NPR ? xp + (size_t)rb * 1024 : xs + (size_t)(rb - NPR) * 1024;
        const float* ma = modL + (size_t)cond_row(r) * 6144; const float* mb = modL + (size_t)cond_row(rb) * 6144;
        f32x4 va[4], vb[4], gv[4], sca[4], sha[4], scb[4], shb[4]; float sa = 0.f, sb = 0.f;
#pragma unroll
        for (int i = 0; i < 4; ++i) { const int c = i * 256 + lane * 4; va[i] = *(const f32x4*)(xa + c); vb[i] = *(const f32x4*)(xb + c); gv[i] = *(const f32x4*)(g + c);
            sca[i] = *(const f32x4*)(ma + scofs + c); sha[i] = *(const f32x4*)(ma + shofs + c); scb[i] = *(const f32x4*)(mb + scofs + c); shb[i] = *(const f32x4*)(mb + shofs + c); }
#pragma unroll
        for (int i = 0; i < 4; ++i) { sa += va[i][0] * va[i][0] + va[i][1] * va[i][1] + va[i][2] * va[i][2] + va[i][3] * va[i][3]; sb += vb[i][0] * vb[i][0] + vb[i][1] * vb[i][1] + vb[i][2] * vb[i][2] + vb[i][3] * vb[i][3]; }
        sa = wave_sum(sa, lane); sb = wave_sum(sb, lane);
        const float rsa = rsqrtf(sa * (1.f / 1024.f) + EPSF), rsb = rsqrtf(sb * (1.f / 1024.f) + EPSF);
#pragma unroll
        for (int i = 0; i < 4; ++i) { const int c = i * 256 + lane * 4;
            { const f32x4 o = va[i] * rsa * gv[i] * (sca[i] + 1.f) + sha[i]; u32x2 pk; pk[0] = pk2(o[0], o[1]); pk[1] = pk2(o[2], o[3]); *(u32x2*)(hout + (size_t)r * 1024 + c) = pk; }
            { const f32x4 o = vb[i] * rsb * gv[i] * (scb[i] + 1.f) + shb[i]; u32x2 pk; pk[0] = pk2(o[0], o[1]); pk[1] = pk2(o[2], o[3]); *(u32x2*)(hout + (size_t)rb * 1024 + c) = pk; } }
    }
}
__device__ __forceinline__ void phase_final_norm(float* x, const float* g) {
    const int tid = otid(); const int w = tid >> 6, lane = tid & 63; const int stride = gridDim.x * 8;
    for (int r = blockIdx.x * 8 + w; r < NTOK; r += 2 * stride) {
        const int rb = (r + stride < NTOK) ? r + stride : r;
        float* xa = x + (size_t)r * 1024; float* xb = x + (size_t)rb * 1024; f32x4 va[4], vb[4], gv[4]; float sa = 0.f, sb = 0.f;
#pragma unroll
        for (int i = 0; i < 4; ++i) { const int c = i * 256 + lane * 4; va[i] = *(const f32x4*)(xa + c); vb[i] = *(const f32x4*)(xb + c); gv[i] = *(const f32x4*)(g + c); }
#pragma unroll
        for (int i = 0; i < 4; ++i) { sa += va[i][0] * va[i][0] + va[i][1] * va[i][1] + va[i][2] * va[i][2] + va[i][3] * va[i][3]; sb += vb[i][0] * vb[i][0] + vb[i][1] * vb[i][1] + vb[i][2] * vb[i][2] + vb[i][3] * vb[i][3]; }
        sa = wave_sum(sa, lane); sb = wave_sum(sb, lane);
        const float rsa = rsqrtf(sa * (1.f / 1024.f) + EPSF), rsb = rsqrtf(sb * (1.f / 1024.f) + EPSF);
#pragma unroll
        for (int i = 0; i < 4; ++i) { const int c = i * 256 + lane * 4; *(f32x4*)(xa + c) = va[i] * rsa * gv[i]; if (rb != r) *(f32x4*)(xb + c) = vb[i] * rsb * gv[i]; }
    }
}

template <int MODE>
__device__ __forceinline__ void ssd_item(const Params& P, int layer, int item, float* L) {
    const int tid = otid(), w = tid >> 6, lane = tid & 63;
    bf16_t* proj = (bf16_t*)(P.ws + WS_PROJ);
    float* states = (float*)(P.ws + WS_SSDST); float* decs = (float*)(P.ws + WS_SSDDEC);
    int r0, nsteps, half, seq0, b = 0, c = 0, sb = 0;
    if (MODE == 2) { sb = item >> 1; half = item & 1; r0 = NPR + sb * 4; nsteps = 4; seq0 = r0; }
    else { b = item >> 6; c = (item >> 1) & 31; half = item & 1; r0 = b * 4096 + c * 128; nsteps = 128; seq0 = b * 4096; }
    float* XS = L; float* ZS = XS + 16 * 512; float* BS = ZS + 16 * 512; float* CS = BS + 16 * 128; float* DTS = CS + 16 * 128; float* DAS = DTS + 128; float* SSQ = DAS + 128;
    const float* cw = P.in[14] + (size_t)layer * 4 * 1536; const float* cb = P.in[15] + (size_t)layer * 1536;
    const float* prev = P.in[5] + ((size_t)(layer * 128 + sb)) * 3 * 1536;
    const int hd = half * 8 + w, gl = w >> 2;
    float h[64];
    if (MODE == 0) {
#pragma unroll
        for (int n = 0; n < 64; ++n) h[n] = 0.f;
    } else {
        const float* s0p = (MODE == 1) ? states + ((size_t)((b * 32 + c) * 16 + hd)) * 4096 + lane * 64
                                       : P.in[4] + ((size_t)((layer * 128 + sb) * 16 + hd)) * 4096 + lane * 64;
#pragma unroll
        for (int n4 = 0; n4 < 16; ++n4) { const f32x4 v = *(const f32x4*)(s0p + n4 * 4); h[n4 * 4] = v[0]; h[n4 * 4 + 1] = v[1]; h[n4 * 4 + 2] = v[2]; h[n4 * 4 + 3] = v[3]; }
    }
    const float Dh = P.in[18][layer * 16 + hd];
    float decp = 1.f;
    for (int s0 = 0; s0 < nsteps; s0 += 16) {
        const int ns = (nsteps - s0) < 16 ? (nsteps - s0) : 16;
        __syncthreads();
        for (int idx = tid; idx < ns * 768; idx += 512) {
            const int t = idx / 768, ch = idx - t * 768;
            int cx;
            if (ch < 512) cx = half * 512 + ch; else if (ch < 640) cx = 1024 + half * 128 + (ch - 512); else cx = 1280 + half * 128 + (ch - 640);
            float a = cb[cx];
#pragma unroll
            for (int k = 0; k < 4; ++k) { const int step = s0 + t - 3 + k, rr = r0 + step; float raw;
                if (rr >= seq0) raw = bf2f(proj[(size_t)rr * LDP + C_XBC + cx]);
                else raw = (MODE == 2) ? prev[(3 + step) * 1536 + cx] : 0.f;
                a += cw[k * 1536 + cx] * raw; }
            a = siluf_(a);
            if (ch < 512) { XS[t * 512 + ch] = a; if (MODE != 0) ZS[t * 512 + ch] = bf2f(proj[(size_t)(r0 + s0 + t) * LDP + C_Z + cx]); }
            else if (ch < 640) BS[t * 128 + ch - 512] = a; else CS[t * 128 + ch - 640] = a;
        }
        if (tid < ns * 8) { const int t = tid >> 3, ww = tid & 7, hh = half * 8 + ww;
            const float dt = softplusf_(bf2f(proj[(size_t)(r0 + s0 + t) * LDP + C_DTR + hh]) + P.in[16][layer * 16 + hh]);
            DTS[t * 8 + ww] = dt; DAS[t * 8 + ww] = __expf(-dt * __expf(P.in[17][layer * 16 + hh])); }
        __syncthreads();
        for (int t = 0; t < ns; ++t) {
            const float a = DAS[t * 8 + w], dt = DTS[t * 8 + w], xv = XS[t * 512 + w * 64 + lane], xd = xv * dt; decp *= a;
            const f32x4* B4 = (const f32x4*)(BS + t * 128 + gl * 64);
#pragma unroll
            for (int n4 = 0; n4 < 16; ++n4) { const f32x4 bv = B4[n4];
                h[n4 * 4] = a * h[n4 * 4] + xd * bv[0]; h[n4 * 4 + 1] = a * h[n4 * 4 + 1] + xd * bv[1]; h[n4 * 4 + 2] = a * h[n4 * 4 + 2] + xd * bv[2]; h[n4 * 4 + 3] = a * h[n4 * 4 + 3] + xd * bv[3]; }
            if (MODE != 0) {
                const f32x4* C4 = (const f32x4*)(CS + t * 128 + gl * 64); float y0 = 0.f, y1 = 0.f;
#pragma unroll
                for (int n4 = 0; n4 < 16; ++n4) { const f32x4 cv = C4[n4]; y0 += h[n4 * 4] * cv[0] + h[n4 * 4 + 2] * cv[2]; y1 += h[n4 * 4 + 1] * cv[1] + h[n4 * 4 + 3] * cv[3]; }
                float y = y0 + y1 + Dh * xv; y *= siluf_(ZS[t * 512 + w * 64 + lane]);
                const float sq = wave_sum(y * y, lane); if (lane == 0) SSQ[(s0 + t) * 8 + w] = sq;
                proj[(size_t)(r0 + s0 + t) * LDP + C_Z + hd * 64 + lane] = f2bf(y);
            }
        }
    }
    if (MODE == 0) {
        float* sp = states + ((size_t)((b * 32 + c) * 16 + hd)) * 4096 + lane * 64;
#pragma unroll
        for (int n4 = 0; n4 < 16; ++n4) *(f32x4*)(sp + n4 * 4) = (f32x4){h[n4 * 4], h[n4 * 4 + 1], h[n4 * 4 + 2], h[n4 * 4 + 3]};
        if (lane == 0) decs[(b * 32 + c) * 16 + hd] = decp;
    }
    if (MODE == 2) {
        float* sp = P.out + O_SSSM + ((size_t)((layer * 128 + sb) * 16 + hd)) * 4096 + lane * 64;
#pragma unroll
        for (int n4 = 0; n4 < 16; ++n4) *(f32x4*)(sp + n4 * 4) = (f32x4){h[n4 * 4], h[n4 * 4 + 1], h[n4 * 4 + 2], h[n4 * 4 + 3]};
    }
    if (MODE != 0) {
        __syncthreads();
        const float ng = P.in[19][layer * 1024 + hd * 64 + lane];
        for (int t = 0; t < nsteps; ++t) {
            const float tot = SSQ[t * 8 + gl * 4] + SSQ[t * 8 + gl * 4 + 1] + SSQ[t * 8 + gl * 4 + 2] + SSQ[t * 8 + gl * 4 + 3];
            const float sc = rsqrtf(tot * (1.f / 256.f) + EPSF) * ng;
            bf16_t* ap = proj + (size_t)(r0 + t) * LDP + C_Z + hd * 64 + lane; *ap = f2bf(bf2f(*ap) * sc);
        }
    }
}

__device__ __forceinline__ int xt_idx(int row, int t) { return row * 136 + ((((t >> 3) ^ ((row >> 3) & 15)) << 3) | (t & 7)); }
__device__ __forceinline__ void ssd_stage_dt(const Params& P, int layer, const bf16_t* proj, size_t r0, int g, float* DT, float* ACS, int tid) {
    { const int hh = tid >> 7, t = tid & 127, hd = g * 4 + hh;
      const float dt = softplusf_(bf2f(proj[(r0 + t) * LDP + C_DTR + hd]) + P.in[16][layer * 16 + hd]);
      DT[hh * 128 + t] = dt; ACS[hh * 128 + t] = -dt * __expf(P.in[17][layer * 16 + hd]); }
    __syncthreads();
    if (tid < 256) { const int hh = tid >> 6, l = tid & 63; const float a0 = ACS[hh * 128 + 2 * l], a1 = ACS[hh * 128 + 2 * l + 1]; float sum = a0 + a1;
#pragma unroll
        for (int o = 1; o < 64; o <<= 1) { const float v = __int_as_float(__builtin_amdgcn_ds_bpermute(((l - o) & 63) << 2, __float_as_int(sum))); if (l >= o) sum += v; }
        ACS[hh * 128 + 2 * l] = sum - a1; ACS[hh * 128 + 2 * l + 1] = sum; }
    __syncthreads();
}
template <int PASS>
__device__ __forceinline__ void ssd_stage_conv(const Params& P, int layer, const bf16_t* proj, size_t r0, bool first, int g, const float* DT, const float* ACS, bf16_t* XT4, bf16_t* Bx, bf16_t* Cs, int tid) {
    const int slot = tid & 63, seg = tid >> 6;
    if (slot < (PASS ? 48 : 40)) {
        int cx; if (slot < 32) cx = g * 256 + slot * 8; else if (slot < 40) cx = 1024 + g * 64 + (slot - 32) * 8; else cx = 1280 + g * 64 + (slot - 40) * 8;
        const float* cw = P.in[14] + (size_t)layer * 4 * 1536 + cx; const float* cb = P.in[15] + (size_t)layer * 1536 + cx;
        float wt[4][8], bb[8], win[3][8];
#pragma unroll
        for (int k = 0; k < 4; ++k) { const f32x4 a = *(const f32x4*)(cw + k * 1536), c = *(const f32x4*)(cw + k * 1536 + 4);
#pragma unroll
            for (int i = 0; i < 4; ++i) { wt[k][i] = a[i]; wt[k][4 + i] = c[i]; } }
        { const f32x4 a = *(const f32x4*)cb, c = *(const f32x4*)(cb + 4);
#pragma unroll
          for (int i = 0; i < 4; ++i) { bb[i] = a[i]; bb[4 + i] = c[i]; } }
        const int t0 = seg * 16;
#pragma unroll
        for (int k = 0; k < 3; ++k) { u32x4 raw = (u32x4){0u, 0u, 0u, 0u};
            if (!(first && seg == 0)) raw = *(const u32x4*)(proj + (r0 + t0 - 3 + k) * LDP + C_XBC + cx);
#pragma unroll
            for (int i = 0; i < 4; ++i) { win[k][2 * i] = bflo(raw[i]); win[k][2 * i + 1] = bfhi(raw[i]); } }
        u32x4 cur4[4], nxt4[4];
#pragma unroll
        for (int q = 0; q < 4; ++q) { cur4[q] = *(const u32x4*)(proj + (r0 + t0 + q) * LDP + C_XBC + cx); nxt4[q] = cur4[q]; }
        for (int gq = 0; gq < 4; ++gq) {
            if (gq < 3) {
#pragma unroll
                for (int q = 0; q < 4; ++q) nxt4[q] = *(const u32x4*)(proj + (r0 + t0 + gq * 4 + 4 + q) * LDP + C_XBC + cx); }
#pragma unroll
            for (int q = 0; q < 4; ++q) {
                const int t = t0 + gq * 4 + q; const u32x4 raw = cur4[q];
                float cur[8], o[8];
#pragma unroll
                for (int i = 0; i < 4; ++i) { cur[2 * i] = bflo(raw[i]); cur[2 * i + 1] = bfhi(raw[i]); }
#pragma unroll
                for (int i = 0; i < 8; ++i) { o[i] = siluf_(bb[i] + wt[0][i] * win[0][i] + wt[1][i] * win[1][i] + wt[2][i] * win[2][i] + wt[3][i] * cur[i]); win[0][i] = win[1][i]; win[1][i] = win[2][i]; win[2][i] = cur[i]; }
                if (slot < 32) { const int hh = slot >> 3, p0 = (slot & 7) * 8; float sc = DT[hh * 128 + t]; if (PASS == 0) sc *= __expf(ACS[hh * 128 + 127] - ACS[hh * 128 + t]);
#pragma unroll
                    for (int i = 0; i < 8; ++i) XT4[xt_idx(hh * 64 + p0 + i, t)] = f2bf(o[i] * sc); }
                else if (slot < 40) { const int n0 = (slot - 32) * 8;
                    if (PASS == 0) {
#pragma unroll
                        for (int i = 0; i < 8; ++i) Bx[xt_idx(n0 + i, t)] = f2bf(o[i]); }
                    else { u32x4 pk; pk[0] = pk2(o[0], o[1]); pk[1] = pk2(o[2], o[3]); pk[2] = pk2(o[4], o[5]); pk[3] = pk2(o[6], o[7]); *(u32x4*)(Bx + t * 72 + n0) = pk; } }
                else { const int n0 = (slot - 40) * 8; u32x4 pk; pk[0] = pk2(o[0], o[1]); pk[1] = pk2(o[2], o[3]); pk[2] = pk2(o[4], o[5]); pk[3] = pk2(o[6], o[7]); *(u32x4*)(Cs + t * 72 + n0) = pk; }
            }
#pragma unroll
            for (int q = 0; q < 4; ++q) cur4[q] = nxt4[q];
        }
    }
}
__device__ __forceinline__ void ssd_pass1_item(const Params& P, int layer, int item, unsigned char* lds) {
    const int tid = otid(), w = __builtin_amdgcn_readfirstlane(tid >> 6), lane = tid & 63, fr = lane & 15, fq = lane >> 4;
    const int b = item >> 7, c = (item >> 2) & 31, g = item & 3; const size_t r0 = (size_t)b * 4096 + (size_t)c * 128;
    const bf16_t* proj = (const bf16_t*)(P.ws + WS_PROJ);
    float* states = (float*)(P.ws + WS_SSDST); float* decs = (float*)(P.ws + WS_SSDDEC);
    bf16_t* XT4 = (bf16_t*)lds; bf16_t* BT = XT4 + 256 * 136; float* DT = (float*)(BT + 64 * 136); float* ACS = DT + 512;
    __syncthreads();
    ssd_stage_dt(P, layer, proj, r0, g, DT, ACS, tid);
    ssd_stage_conv<0>(P, layer, proj, r0, c == 0, g, DT, ACS, XT4, BT, nullptr, tid);
    __syncthreads();
    const int hh = w >> 1, pb = (w & 1) * 2;
    f32x4 acc[2][4];
#pragma unroll
    for (int pi = 0; pi < 2; ++pi)
#pragma unroll
        for (int nt = 0; nt < 4; ++nt) acc[pi][nt] = (f32x4){0.f, 0.f, 0.f, 0.f};
#pragma unroll
    for (int ks = 0; ks < 4; ++ks) { bf16x8 a[2];
#pragma unroll
        for (int pi = 0; pi < 2; ++pi) a[pi] = *(const bf16x8*)(XT4 + xt_idx(hh * 64 + (pb + pi) * 16 + fr, ks * 32 + fq * 8));
#pragma unroll
        for (int nt = 0; nt < 4; ++nt) { const bf16x8 bv = *(const bf16x8*)(BT + xt_idx(nt * 16 + fr, ks * 32 + fq * 8));
#pragma unroll
            for (int pi = 0; pi < 2; ++pi) acc[pi][nt] = __builtin_amdgcn_mfma_f32_16x16x32_bf16(a[pi], bv, acc[pi][nt], 0, 0, 0); } }
    float* sp = states + ((size_t)((b * 32 + c) * 16 + g * 4 + hh)) * 4096;
#pragma unroll
    for (int pi = 0; pi < 2; ++pi)
#pragma unroll
        for (int nt = 0; nt < 4; ++nt)
#pragma unroll
            for (int j = 0; j < 4; ++j) sp[((pb + pi) * 16 + fq * 4 + j) * 64 + nt * 16 + fr] = acc[pi][nt][j];
    if (tid < 4) decs[(b * 32 + c) * 16 + g * 4 + tid] = __expf(ACS[tid * 128 + 127]);
}
__device__ __forceinline__ void ssd_pass3_item(const Params& P, int layer, int item, unsigned char* lds, bool dry = false) {
    const int tid = otid(), w = __builtin_amdgcn_readfirstlane(tid >> 6), lane = tid & 63, fr = lane & 15, fq = lane >> 4;
    const int b = item >> 7, c = (item >> 2) & 31, g = item & 3; const size_t r0 = (size_t)b * 4096 + (size_t)c * 128;
    bf16_t* proj = (bf16_t*)(P.ws + WS_PROJ);
    const float* states = (const float*)(P.ws + WS_SSDST);
    bf16_t* Cs = (bf16_t*)lds; bf16_t* Bs = Cs + 128 * 72; bf16_t* Sin = Bs; bf16_t* XT4 = Bs + 128 * 72; bf16_t* Ms = XT4 + 256 * 136; float* DT = (float*)(Ms + 128 * 136); float* ACS = DT + 512;
    __syncthreads();
    ssd_stage_dt(P, layer, proj, r0, g, DT, ACS, tid);
    ssd_stage_conv<1>(P, layer, proj, r0, c == 0, g, DT, ACS, XT4, Bs, Cs, tid);
    __syncthreads();
    f32x4 CB[8];
#pragma unroll
    for (int st = 0; st < 8; ++st) { CB[st] = (f32x4){0.f, 0.f, 0.f, 0.f};
        if (st <= w) {
#pragma unroll
            for (int ks = 0; ks < 2; ++ks) { const bf16x8 a = *(const bf16x8*)(Cs + (16 * w + fr) * 72 + ks * 32 + fq * 8), bv = *(const bf16x8*)(Bs + (16 * st + fr) * 72 + ks * 32 + fq * 8);
                CB[st] = __builtin_amdgcn_mfma_f32_16x16x32_bf16(a, bv, CB[st], 0, 0, 0); } } }
    float ssq[4] = {0.f, 0.f, 0.f, 0.f};
    const int nks = (w >> 1) + 1;
    bf16_t* zrow[4];
#pragma unroll
    for (int j = 0; j < 4; ++j) zrow[j] = proj + (r0 + 16 * w + fq * 4 + j) * LDP + C_Z + g * 256 + fr;
    f32x4 sna, snc;
    { const float* sp = states + ((size_t)((b * 32 + c) * 16 + g * 4)) * 4096 + (tid >> 3) * 64 + (tid & 7) * 8; sna = *(const f32x4*)sp; snc = *(const f32x4*)(sp + 4); }
    unsigned yg[4][4][2];
#pragma unroll
    for (int hh = 0; hh < 4; ++hh) {
        const int hd = g * 4 + hh;
        __syncthreads();
        { const int p = tid >> 3, n0 = (tid & 7) * 8;
          u32x4 pk; pk[0] = pk2(sna[0], sna[1]); pk[1] = pk2(sna[2], sna[3]); pk[2] = pk2(snc[0], snc[1]); pk[3] = pk2(snc[2], snc[3]);
          *(u32x4*)(Sin + p * 72 + n0) = pk;
          if (hh < 3) { const float* sp = states + ((size_t)((b * 32 + c) * 16 + hd + 1)) * 4096 + p * 64 + n0; sna = *(const f32x4*)sp; snc = *(const f32x4*)(sp + 4); } }
        float acs_t[4];
#pragma unroll
        for (int j = 0; j < 4; ++j) acs_t[j] = ACS[hh * 128 + 16 * w + fq * 4 + j];
#pragma unroll
        for (int st = 0; st < 8; ++st) { if (st <= (w | 1)) { const float acs_s = ACS[hh * 128 + 16 * st + fr];
#pragma unroll
            for (int j = 0; j < 4; ++j) { const int t = 16 * w + fq * 4 + j, sx = 16 * st + fr; const float v = (st <= w && sx <= t) ? CB[st][j] * __expf(acs_t[j] - acs_s) : 0.f; Ms[t * 136 + sx] = f2bf(v); } } }
        __syncthreads();
        bf16_t zv[4][4];
#pragma unroll
        for (int j = 0; j < 4; ++j)
#pragma unroll
            for (int pt = 0; pt < 4; ++pt) zv[j][pt] = *(zrow[j] + hh * 64 + pt * 16);
        f32x4 yd[4], yo[4];
#pragma unroll
        for (int pt = 0; pt < 4; ++pt) { yd[pt] = (f32x4){0.f, 0.f, 0.f, 0.f}; yo[pt] = (f32x4){0.f, 0.f, 0.f, 0.f}; }
        for (int ks = 0; ks < nks; ++ks) { const bf16x8 a = *(const bf16x8*)(Ms + (16 * w + fr) * 136 + ks * 32 + fq * 8);
#pragma unroll
            for (int pt = 0; pt < 4; ++pt) { const bf16x8 bv = *(const bf16x8*)(XT4 + xt_idx(hh * 64 + pt * 16 + fr, ks * 32 + fq * 8)); yd[pt] = __builtin_amdgcn_mfma_f32_16x16x32_bf16(a, bv, yd[pt], 0, 0, 0); } }
#pragma unroll
        for (int ks = 0; ks < 2; ++ks) { const bf16x8 a = *(const bf16x8*)(Cs + (16 * w + fr) * 72 + ks * 32 + fq * 8);
#pragma unroll
            for (int pt = 0; pt < 4; ++pt) { const bf16x8 bv = *(const bf16x8*)(Sin + (pt * 16 + fr) * 72 + ks * 32 + fq * 8); yo[pt] = __builtin_amdgcn_mfma_f32_16x16x32_bf16(a, bv, yo[pt], 0, 0, 0); } }
        const float Dh = P.in[18][layer * 16 + hd];
#pragma unroll
        for (int pt = 0; pt < 4; ++pt) { const int p = pt * 16 + fr; float yy[4];
#pragma unroll
            for (int j = 0; j < 4; ++j) { const int t = 16 * w + fq * 4 + j; const float et = __expf(acs_t[j]), idt = 1.f / DT[hh * 128 + t];
                const float x = bf2f(XT4[xt_idx(hh * 64 + p, t)]) * idt;
                float y = yd[pt][j] + et * yo[pt][j] + Dh * x; y *= silu_fast(bf2f(zv[j][pt])); ssq[j] += y * y; yy[j] = y; }
            yg[hh][pt][0] = pk2(yy[0], yy[1]); yg[hh][pt][1] = pk2(yy[2], yy[3]); }
    }
    const float* ng = P.in[19] + layer * 1024 + g * 256 + fr;
#pragma unroll
    for (int j = 0; j < 4; ++j) { float v = ssq[j];
#pragma unroll
        for (int o = 8; o > 0; o >>= 1) v += shx(v, o, lane);
        ssq[j] = rsqrtf(v * (1.f / 256.f) + EPSF); }
#pragma unroll
    for (int hh = 0; hh < 4; ++hh)
#pragma unroll
        for (int pt = 0; pt < 4; ++pt) { const float gv = ng[(hh * 4 + pt) * 16];
#pragma unroll
            for (int j = 0; j < 4; ++j) { const float yv = (j & 1) ? bfhi(yg[hh][pt][j >> 1]) : bflo(yg[hh][pt][j >> 1]); if (!dry) *(zrow[j] + (hh * 4 + pt) * 16) = f2bf(yv * ssq[j] * gv); } }
}
__device__ __forceinline__ void phase_ssd_scan(const Params& P, int layer) {
    float* states = (float*)(P.ws + WS_SSDST); const float* decs = (const float*)(P.ws + WS_SSDDEC);
    for (int e = blockIdx.x * 512 + otid(); e < 4 * 16 * 4096; e += gridDim.x * 512) {
        const int b = e >> 16, hd = (e >> 12) & 15, pn = e & 4095; float carry = 0.f;
        float st[32], dc[32];
#pragma unroll
        for (int c = 0; c < 32; ++c) { st[c] = states[((size_t)((b * 32 + c) * 16 + hd)) * 4096 + pn]; dc[c] = decs[(b * 32 + c) * 16 + hd]; }
#pragma unroll
        for (int c = 0; c < 32; ++c) { states[((size_t)((b * 32 + c) * 16 + hd)) * 4096 + pn] = carry; carry = carry * dc[c] + st[c]; }
        P.out[O_PSSM + ((size_t)((layer * 4 + b) * 16 + hd)) * 4096 + pn] = carry;
    }
}

__device__ __forceinline__ void attn_prompt_item(const Params& P, int layer, int item, unsigned char* lds, bool dry = false) {
    const int tid = otid(), w = tid >> 6, lane = tid & 63, fr = lane & 15, fq = lane >> 4;
    const int b = item >> 7, nb = (item >> 2) & 31, kvh = item & 3;
    bf16_t* proj = (bf16_t*)(P.ws + WS_PROJ);
    bf16_t* Ks = (bf16_t*)lds;
    bf16_t* Vt = Ks + 256 * 72;
    bf16_t* Pw = Vt + 64 * 280 + w * 16 * 168;
    const long rowK0 = (long)b * 4096 + (long)(nb - 1) * 128;
    const bf16_t* qbase = proj + ((size_t)b * 4096 + (size_t)nb * 128 + w * 16 + fr) * LDP + C_Q + kvh * 256 + fq * 8;
    bf16x8 qa[2], qn[2];
#pragma unroll
    for (int ks = 0; ks < 2; ++ks) { qa[ks] = *(const bf16x8*)(qbase + ks * 32); qn[ks] = qa[ks]; }
    __syncthreads();
#pragma unroll
    for (int idx = tid; idx < 2048; idx += 512) { const int kj = idx >> 3, seg = idx & 7; u32x4 v = (u32x4){0u, 0u, 0u, 0u};
        if (nb > 0 || kj >= 128) v = *(const u32x4*)(proj + (size_t)(rowK0 + kj) * LDP + C_K + kvh * 64 + seg * 8);
        *(u32x4*)(Ks + kj * 72 + seg * 8) = v; }
#pragma unroll
    for (int idx = tid; idx < 2048; idx += 512) { const int seg = idx >> 8, kj = idx & 255; u32x4 v = (u32x4){0u, 0u, 0u, 0u};
        if (nb > 0 || kj >= 128) v = *(const u32x4*)(proj + (size_t)(rowK0 + kj) * LDP + C_V + kvh * 64 + seg * 8);
#pragma unroll
        for (int i = 0; i < 8; ++i) Vt[(seg * 8 + i) * 280 + kj] = (bf16_t)((v[i >> 1] >> ((i & 1) * 16)) & 0xffffu); }
    for (int idx = tid; idx < 64 * 24; idx += 512) { const int d = idx / 24, cc = 256 + idx % 24; Vt[d * 280 + cc] = 0; }
    for (int i = lane; i < 384; i += 64) Pw[(i / 24) * 168 + 144 + i % 24] = 0;
    __syncthreads();
    const int q0 = w * 16;
    const size_t qrow0 = (size_t)b * 4096 + (size_t)nb * 128 + q0;
    for (int gi = 0; gi < 4; ++gi) {
        const int hq = kvh * 4 + gi;
        const float slope = exp2f(-0.5f * (float)(hq + 1));
        const float sink = P.in[21][layer * 16 + hq];
        if (gi < 3) {
#pragma unroll
            for (int ks = 0; ks < 2; ++ks) qn[ks] = *(const bf16x8*)(qbase + (gi + 1) * 64 + ks * 32); }
        f32x4 S[9];
#pragma unroll
        for (int nt = 0; nt < 9; ++nt) { f32x4 a = (f32x4){0.f, 0.f, 0.f, 0.f}; const bf16_t* kp = Ks + (q0 + nt * 16 + fr) * 72 + fq * 8;
#pragma unroll
            for (int ks = 0; ks < 2; ++ks) { const bf16x8 kb = *(const bf16x8*)(kp + ks * 32); a = __builtin_amdgcn_mfma_f32_16x16x32_bf16(qa[ks], kb, a, 0, 0, 0); }
            S[nt] = a; }
        float mx[4] = {-INFINITY, -INFINITY, -INFINITY, -INFINITY};
#pragma unroll
        for (int nt = 0; nt < 9; ++nt)
#pragma unroll
            for (int j = 0; j < 4; ++j) { const int dist = (fq * 4 + j) - (nt * 16 + fr) + 128; const bool valid = dist >= 0 && dist <= 128 && (nb > 0 || (q0 + nt * 16 + fr) >= 128);
                const float s = valid ? S[nt][j] * 0.125f - slope * (float)dist : -INFINITY; S[nt][j] = s; mx[j] = fmaxf(mx[j], s); }
        float inv[4];
#pragma unroll
        for (int j = 0; j < 4; ++j) { float m = mx[j];
#pragma unroll
            for (int o = 8; o > 0; o >>= 1) m = fmaxf(m, shx(m, o, lane));
            m = fmaxf(m, sink); float sum = 0.f;
#pragma unroll
            for (int nt = 0; nt < 9; ++nt) { const float p = __expf(S[nt][j] - m); S[nt][j] = p; sum += p; }
#pragma unroll
            for (int o = 8; o > 0; o >>= 1) sum += shx(sum, o, lane);
            inv[j] = 1.f / (sum + __expf(sink - m)); }
#pragma unroll
        for (int nt = 0; nt < 9; ++nt)
#pragma unroll
            for (int j = 0; j < 4; ++j) Pw[(fq * 4 + j) * 168 + nt * 16 + fr] = f2bf(S[nt][j]);
        asm volatile("s_waitcnt lgkmcnt(0)" ::: "memory"); __builtin_amdgcn_wave_barrier();
        f32x4 O[4];
#pragma unroll
        for (int dt = 0; dt < 4; ++dt) O[dt] = (f32x4){0.f, 0.f, 0.f, 0.f};
#pragma unroll
        for (int ks = 0; ks < 5; ++ks) { const bf16x8 pa = *(const bf16x8*)(Pw + fr * 168 + ks * 32 + fq * 8);
#pragma unroll
            for (int dt = 0; dt < 4; ++dt) { const bf16x8 vb = *(const bf16x8*)(Vt + (dt * 16 + fr) * 280 + q0 + ks * 32 + fq * 8); O[dt] = __builtin_amdgcn_mfma_f32_16x16x32_bf16(pa, vb, O[dt], 0, 0, 0); } }
        asm volatile("s_waitcnt lgkmcnt(0)" ::: "memory"); __builtin_amdgcn_wave_barrier();
#pragma unroll
        for (int dt = 0; dt < 4; ++dt)
#pragma unroll
            for (int j = 0; j < 4; ++j) { if (!dry) proj[(qrow0 + fq * 4 + j) * LDP + C_Q + hq * 64 + dt * 16 + fr] = f2bf(O[dt][j] * inv[j]); }
        qa[0] = qn[0]; qa[1] = qn[1];
    }
    if (nb == 31) {
        for (int idx = tid; idx < 128 * 64; idx += 512) { const int t = idx >> 6, d = idx & 63; const size_t row = (size_t)b * 4096 + 3968 + t;
            const size_t o = ((size_t)((layer * 4 + b) * 128 + t)) * 256 + kvh * 64 + d;
            P.out[O_PK + o] = bf2f(proj[row * LDP + C_K + kvh * 64 + d]); P.out[O_PV + o] = bf2f(proj[row * LDP + C_V + kvh * 64 + d]); }
    }
}
__device__ __forceinline__ void attn_sample_item(const Params& P, int layer, int item, float* L, bool dry = false) {
    const int tid = otid(), w = tid >> 6, lane = tid & 63;
    const int sb = item >> 2, kvh = item & 3, r0 = NPR + sb * 4;
    bf16_t* proj = (bf16_t*)(P.ws + WS_PROJ);
    float* Kf = L; float* Vf = Kf + 132 * 65; float* Q = Vf + 132 * 65; float* Sc = Q + 16 * 64;
    const float* ck = P.in[7] + ((size_t)(layer * 128 + sb)) * 128 * 256; const float* cv = P.in[8] + ((size_t)(layer * 128 + sb)) * 128 * 256;
    __syncthreads();
    {
        f32x4 kq[4], vq[4];
#pragma unroll
        for (int i = 0; i < 4; ++i) { const int idx = tid + i * 512, j = idx >> 4, d4 = (idx & 15) * 4; kq[i] = *(const f32x4*)(ck + (size_t)j * 256 + kvh * 64 + d4); vq[i] = *(const f32x4*)(cv + (size_t)j * 256 + kvh * 64 + d4); }
#pragma unroll
        for (int i = 0; i < 4; ++i) { const int idx = tid + i * 512, j = idx >> 4, d4 = (idx & 15) * 4;
#pragma unroll
            for (int e = 0; e < 4; ++e) { Kf[j * 65 + d4 + e] = kq[i][e]; Vf[j * 65 + d4 + e] = vq[i][e]; }
            if (j >= 4) { const size_t o = ((size_t)((layer * 128 + sb) * 128 + (j - 4))) * 256 + kvh * 64 + d4; *(f32x4*)(P.out + O_SK + o) = kq[i]; *(f32x4*)(P.out + O_SV + o) = vq[i]; } }
        if (tid < 256) { const int j = 128 + (tid >> 6), d = tid & 63; const float kv = bf2f(proj[(size_t)(r0 + j - 128) * LDP + C_K + kvh * 64 + d]), vv = bf2f(proj[(size_t)(r0 + j - 128) * LDP + C_V + kvh * 64 + d]);
            Kf[j * 65 + d] = kv; Vf[j * 65 + d] = vv; const size_t o = ((size_t)((layer * 128 + sb) * 128 + (j - 4))) * 256 + kvh * 64 + d; P.out[O_SK + o] = kv; P.out[O_SV + o] = vv; }
    }
    for (int idx = tid; idx < 1024; idx += 512) { const int qr = idx >> 6, d = idx & 63; Q[idx] = bf2f(proj[(size_t)(r0 + (qr >> 2)) * LDP + C_Q + (kvh * 4 + (qr & 3)) * 64 + d]); }
    __syncthreads();
    for (int idx = tid; idx < 16 * 132; idx += 512) { const int qr = idx / 132, j = idx - qr * 132; const int dist = 128 + (qr >> 2) - j; float s = -INFINITY;
        if (dist >= 0 && dist <= 128) { float a = 0.f;
#pragma unroll 8
            for (int d = 0; d < 64; ++d) a += Q[qr * 64 + d] * Kf[j * 65 + d];
            s = a * 0.125f - exp2f(-0.5f * (float)(kvh * 4 + (qr & 3) + 1)) * (float)dist; }
        Sc[qr * 136 + j] = s; }
    __syncthreads();
    for (int rr = 0; rr < 2; ++rr) { const int qr = w * 2 + rr; const float sink = P.in[21][layer * 16 + kvh * 4 + (qr & 3)];
        float v0 = Sc[qr * 136 + lane], v1 = Sc[qr * 136 + 64 + lane], v2 = lane < 4 ? Sc[qr * 136 + 128 + lane] : -INFINITY;
        float m = fmaxf(fmaxf(v0, v1), v2);
#pragma unroll
        for (int o = 32; o > 0; o >>= 1) m = fmaxf(m, shx(m, o, lane));
        m = fmaxf(m, sink);
        v0 = __expf(v0 - m); v1 = __expf(v1 - m); v2 = __expf(v2 - m);
        const float sum = wave_sum(v0 + v1 + v2, lane); const float inv = 1.f / (sum + __expf(sink - m));
        Sc[qr * 136 + lane] = v0 * inv; Sc[qr * 136 + 64 + lane] = v1 * inv; if (lane < 4) Sc[qr * 136 + 128 + lane] = v2 * inv; }
    __syncthreads();
    for (int idx = tid; idx < 1024; idx += 512) { const int qr = idx >> 6, d = idx & 63; float o = 0.f;
        for (int j = 0; j < 132; ++j) o += Sc[qr * 136 + j] * Vf[j * 65 + d];
        if (!dry) proj[(size_t)(r0 + (qr >> 2)) * LDP + C_Q + (kvh * 4 + (qr & 3)) * 64 + d] = f2bf(o); }
}

__device__ __forceinline__ void gmlp_prompt_item(const Params& P, int layer, int item, unsigned char* lds, bool dry = false) {
    const int tid = otid(), w = tid >> 6, lane = tid & 63, fr = lane & 15, fq = lane >> 4;
    const int b = item >> 8, chn = (item >> 3) & 31, g = item & 7;
    const size_t r0 = (size_t)b * 4096 + (size_t)chn * 128;
    bf16_t* proj = (bf16_t*)(P.ws + WS_PROJ);
    bf16_t* VT = (bf16_t*)lds; bf16_t* Wt = VT + 128 * 136; float* MU = (float*)(Wt + 128 * 136); float* RS = MU + 128;
    __syncthreads();
#pragma unroll
    for (int hb = 0; hb < 2; ++hb) { u32x4 av[8], cv8[8];
#pragma unroll
        for (int i = 0; i < 8; ++i) { const bf16_t* vp = proj + (r0 + w * 16 + hb * 8 + i) * LDP + C_UV + 1024 + lane * 16; av[i] = *(const u32x4*)vp; cv8[i] = *(const u32x4*)(vp + 8); }
#pragma unroll
        for (int i = 0; i < 8; ++i) { const int t = w * 16 + hb * 8 + i; float s = 0.f, sq = 0.f;
#pragma unroll
            for (int k = 0; k < 4; ++k) { float x0 = bflo(av[i][k]), x1 = bfhi(av[i][k]), x2 = bflo(cv8[i][k]), x3 = bfhi(cv8[i][k]); s += x0 + x1 + x2 + x3; sq += x0 * x0 + x1 * x1 + x2 * x2 + x3 * x3; }
            s = wave_sum(s, lane); sq = wave_sum(sq, lane);
            if (lane == 0) { const float mean = s * (1.f / 1024.f); const float var = fmaxf(sq * (1.f / 1024.f) - mean * mean, 0.f); MU[t] = mean; RS[t] = rsqrtf(var + EPSF); } } }
    const float* Wg = P.in[24] + ((size_t)(layer * 8 + g)) * 16384;
#pragma unroll
    for (int idx = tid; idx < 4096; idx += 512) { const int t = idx >> 5, s4 = (idx & 31) * 4; const f32x4 wv = *(const f32x4*)(Wg + t * 128 + s4);
        u32x2 o; o[0] = pk2(s4 <= t ? wv[0] : 0.f, s4 + 1 <= t ? wv[1] : 0.f); o[1] = pk2(s4 + 2 <= t ? wv[2] : 0.f, s4 + 3 <= t ? wv[3] : 0.f);
        *(u32x2*)(Wt + t * 136 + s4) = o; }
    __syncthreads();
    const float* lg = P.in[22] + layer * 1024 + g * 128; const float* lb = P.in[23] + layer * 1024 + g * 128;
#pragma unroll
    for (int idx = tid; idx < 2048; idx += 512) { const int s = idx & 127, fs = idx >> 7; const u32x4 v = *(const u32x4*)(proj + (r0 + s) * LDP + C_UV + 1024 + g * 128 + fs * 8);
        const float mu = MU[s], rs = RS[s];
#pragma unroll
        for (int i = 0; i < 8; ++i) { const int f = fs * 8 + i; const float x = (i & 1) ? bfhi(v[i >> 1]) : bflo(v[i >> 1]); VT[f * 136 + s] = f2bf((x - mu) * rs * lg[f] + lb[f]); } }
    __syncthreads();
    bf16_t uv[4][8]; float bsv[4];
#pragma unroll
    for (int j = 0; j < 4; ++j) { const int t = w * 16 + fq * 4 + j; bsv[j] = P.in[25][(layer * 8 + g) * 128 + t];
#pragma unroll
        for (int ft = 0; ft < 8; ++ft) uv[j][ft] = proj[(r0 + t) * LDP + C_UV + g * 128 + ft * 16 + fr]; }
    f32x4 acc[8];
#pragma unroll
    for (int ft = 0; ft < 8; ++ft) acc[ft] = (f32x4){0.f, 0.f, 0.f, 0.f};
    const int nks = (16 * w + 15) / 32 + 1;
    for (int ks = 0; ks < nks; ++ks) { const bf16x8 a = *(const bf16x8*)(Wt + (w * 16 + fr) * 136 + ks * 32 + fq * 8);
#pragma unroll
        for (int ft = 0; ft < 8; ++ft) { const bf16x8 bb = *(const bf16x8*)(VT + (ft * 16 + fr) * 136 + ks * 32 + fq * 8); acc[ft] = __builtin_amdgcn_mfma_f32_16x16x32_bf16(a, bb, acc[ft], 0, 0, 0); } }
#pragma unroll
    for (int j = 0; j < 4; ++j) { const int t = w * 16 + fq * 4 + j;
#pragma unroll
        for (int ft = 0; ft < 8; ++ft) { if (!dry) proj[(r0 + t) * LDP + C_UV + g * 128 + ft * 16 + fr] = f2bf(gelu_fast(bf2f(uv[j][ft])) * (acc[ft][j] + bsv[j])); } }
}
__device__ __forceinline__ void gmlp_sample_item(const Params& P, int layer, int sb, float* L) {
    const int tid = otid(), w = tid >> 6, lane = tid & 63; const size_t r0 = NPR + sb * 4;
    bf16_t* proj = (bf16_t*)(P.ws + WS_PROJ);
    float* Vn = L; float* MU = Vn + 4096; float* RS = MU + 4;
    __syncthreads();
    if (w < 4) { const bf16_t* vp = proj + (r0 + w) * LDP + C_UV + 1024 + lane * 16; const u32x4 a = *(const u32x4*)vp, c = *(const u32x4*)(vp + 8); float s = 0.f, sq = 0.f;
#pragma unroll
        for (int k = 0; k < 4; ++k) { float x0 = bflo(a[k]), x1 = bfhi(a[k]), x2 = bflo(c[k]), x3 = bfhi(c[k]); s += x0 + x1 + x2 + x3; sq += x0 * x0 + x1 * x1 + x2 * x2 + x3 * x3; }
        s = wave_sum(s, lane); sq = wave_sum(sq, lane);
        if (lane == 0) { const float mean = s * (1.f / 1024.f); const float var = fmaxf(sq * (1.f / 1024.f) - mean * mean, 0.f); MU[w] = mean; RS[w] = rsqrtf(var + EPSF); } }
    __syncthreads();
    for (int idx = tid; idx < 4096; idx += 512) { const int t = idx >> 10, c = idx & 1023;
        const float x = bf2f(proj[(r0 + t) * LDP + C_UV + 1024 + c]); const float vn = (x - MU[t]) * RS[t] * P.in[22][layer * 1024 + c] + P.in[23][layer * 1024 + c];
        Vn[idx] = vn; P.out[O_SGMV + ((size_t)((layer * 128 + sb) * 4 + t)) * 1024 + c] = vn; }
    __syncthreads();
    for (int idx = tid; idx < 4096; idx += 512) { const int t = idx >> 10, c = idx & 1023, g = c >> 7;
        const float* Wg = P.in[24] + ((size_t)(layer * 8 + g)) * 16384 + t * 128; float m = P.in[25][(layer * 8 + g) * 128 + t];
        for (int s = 0; s <= t; ++s) m += Wg[s] * Vn[s * 1024 + c];
        bf16_t* ap = proj + (r0 + t) * LDP + C_UV + c; *ap = f2bf(gelu_fast(bf2f(*ap)) * m); }
}

template <int R>
__device__ __forceinline__ void shortconv_rows(const Params& P, int layer, int r0, int tid, bool dry) {
    bf16_t* proj = (bf16_t*)(P.ws + WS_PROJ);
    const float* cw = P.in[20] + layer * 3 * 1024;
    const int j = tid * 2; const int ss = seq_start(r0); const bool havePrev = (r0 - 2 >= ss);
    unsigned cg[R + 2], xs[R + 2], bg[R];
#pragma unroll
    for (int k = 0; k < R + 2; ++k) { cg[k] = 0u; xs[k] = 0u;
        if (k >= 2 || havePrev) { const bf16_t* rp = proj + (size_t)(r0 - 2 + k) * LDP + C_BCX + j; cg[k] = *(const unsigned*)(rp + 1024); xs[k] = *(const unsigned*)(rp + 2048); } }
#pragma unroll
    for (int k = 0; k < R; ++k) bg[k] = *(const unsigned*)(proj + (size_t)(r0 + k) * LDP + C_BCX + j);
    float pr0[R + 2], pr1[R + 2];
#pragma unroll
    for (int k = 0; k < R + 2; ++k) { pr0[k] = bflo(cg[k]) * bflo(xs[k]); pr1[k] = bfhi(cg[k]) * bfhi(xs[k]); }
    if (!havePrev && r0 >= NPR) { const float* st = P.in[6] + ((size_t)(layer * 128 + ((r0 - NPR) >> 2)) * 2) * 1024 + j; pr0[0] = st[0]; pr1[0] = st[1]; pr0[1] = st[1024]; pr1[1] = st[1025]; }
    const float w0a = cw[j], w0b = cw[j + 1], w1a = cw[1024 + j], w1b = cw[1025 + j], w2a = cw[2048 + j], w2b = cw[2049 + j];
#pragma unroll
    for (int k = 0; k < R; ++k) { const float y0 = w0a * pr0[k] + w1a * pr0[k + 1] + w2a * pr0[k + 2], y1 = w0b * pr1[k] + w1b * pr1[k + 1] + w2b * pr1[k + 2];
        if (!dry) *(unsigned*)(proj + (size_t)(r0 + k) * LDP + C_BCX + j) = pk2(bflo(bg[k]) * y0, bfhi(bg[k]) * y1);
        const int r = r0 + k;
        if (r < NPR) { const int l = r & 4095; if (l >= 4094) { float* o = P.out + O_PSCC + ((size_t)((layer * 4 + (r >> 12)) * 2 + (l - 4094))) * 1024 + j; o[0] = pr0[k + 2]; o[1] = pr1[k + 2]; } }
        else { const int l = (r - NPR) & 3; if (l >= 2) { float* o = P.out + O_SSCC + ((size_t)((layer * 128 + ((r - NPR) >> 2)) * 2 + (l - 2))) * 1024 + j; o[0] = pr0[k + 2]; o[1] = pr1[k + 2]; } }
    }
}
__device__ __forceinline__ void shortconv_item(const Params& P, int layer, int item, bool dry = false) {
    const int tid = otid();
    if (item < 1024) shortconv_rows<16>(P, layer, item * 16, tid, dry); else shortconv_rows<4>(P, layer, NPR + (item - 1024) * 4, tid, dry);
}
__device__ __forceinline__ void ssdconv_state_item(const Params& P, int layer, int sq) {
    const bf16_t* proj = (const bf16_t*)(P.ws + WS_PROJ);
    const size_t rbase = sq < 4 ? (size_t)sq * 4096 + 4093 : (size_t)NPR + (size_t)(sq - 4) * 4 + 1;
    float* o = sq < 4 ? P.out + O_PSSDC + (size_t)(layer * 4 + sq) * 3 * 1536 : P.out + O_SSSDC + (size_t)(layer * 128 + (sq - 4)) * 3 * 1536;
    const int tid = otid(); bf16_t v[9];
#pragma unroll
    for (int i = 0; i < 9; ++i) { const int e = tid + i * 512, t = e / 1536, c = e - t * 1536; v[i] = proj[(rbase + t) * LDP + C_XBC + c]; }
#pragma unroll
    for (int i = 0; i < 9; ++i) o[tid + i * 512] = bf2f(v[i]);
}

template <int R>
__device__ __forceinline__ void ffn_act_unit(const Params& P, int layer, int r0, int oc) {
    const bf16_t* up = (const bf16_t*)(P.ws + WS_PROJ); bf16_t* act = (bf16_t*)(P.ws + WS_PROJ + UP_BYTES);
    const float* cw = P.in[30] + (size_t)layer * 3 * 5632; const float* cb = P.in[31] + (size_t)layer * 5632;
    const int j0 = oc * 8;
    float wa[3][8], wg[3][8], ba[8], bgv[8], pa[2][8], pg[2][8];
#pragma unroll
    for (int k = 0; k < 3; ++k) { const f32x4 a0 = *(const f32x4*)(cw + k * 5632 + j0), a1 = *(const f32x4*)(cw + k * 5632 + j0 + 4), g0 = *(const f32x4*)(cw + k * 5632 + 2816 + j0), g1 = *(const f32x4*)(cw + k * 5632 + 2816 + j0 + 4);
#pragma unroll
        for (int i = 0; i < 4; ++i) { wa[k][i] = a0[i]; wa[k][4 + i] = a1[i]; wg[k][i] = g0[i]; wg[k][4 + i] = g1[i]; } }
    { const f32x4 a0 = *(const f32x4*)(cb + j0), a1 = *(const f32x4*)(cb + j0 + 4), g0 = *(const f32x4*)(cb + 2816 + j0), g1 = *(const f32x4*)(cb + 2816 + j0 + 4);
#pragma unroll
      for (int i = 0; i < 4; ++i) { ba[i] = a0[i]; ba[4 + i] = a1[i]; bgv[i] = g0[i]; bgv[4 + i] = g1[i]; } }
    const int ss = seq_start(r0); const bool havePrev = (r0 - 2 >= ss);
#pragma unroll
    for (int k = 0; k < 2; ++k) {
        if (havePrev) { const u32x4 ua = *(const u32x4*)(up + (size_t)(r0 - 2 + k) * 5632 + j0), ug = *(const u32x4*)(up + (size_t)(r0 - 2 + k) * 5632 + 2816 + j0);
#pragma unroll
            for (int i = 0; i < 4; ++i) { pa[k][2 * i] = bflo(ua[i]); pa[k][2 * i + 1] = bfhi(ua[i]); pg[k][2 * i] = bflo(ug[i]); pg[k][2 * i + 1] = bfhi(ug[i]); } }
        else if (r0 >= NPR) { const float* pp = P.in[9] + ((size_t)(layer * 128 + ((r0 - NPR) >> 2)) * 2 + k) * 5632;
#pragma unroll
            for (int i = 0; i < 8; ++i) { pa[k][i] = pp[j0 + i]; pg[k][i] = pp[2816 + j0 + i]; } }
        else {
#pragma unroll
            for (int i = 0; i < 8; ++i) { pa[k][i] = 0.f; pg[k][i] = 0.f; } } }
#pragma unroll
    for (int kb = 0; kb < R; kb += 4) { u32x4 ua[4], ug[4];
#pragma unroll
        for (int q = 0; q < 4; ++q) { ua[q] = *(const u32x4*)(up + (size_t)(r0 + kb + q) * 5632 + j0); ug[q] = *(const u32x4*)(up + (size_t)(r0 + kb + q) * 5632 + 2816 + j0); }
#pragma unroll
        for (int q = 0; q < 4; ++q) { const int r = r0 + kb + q; float ca[8], cgv[8], o[8];
#pragma unroll
            for (int i = 0; i < 4; ++i) { ca[2 * i] = bflo(ua[q][i]); ca[2 * i + 1] = bfhi(ua[q][i]); cgv[2 * i] = bflo(ug[q][i]); cgv[2 * i + 1] = bfhi(ug[q][i]); }
#pragma unroll
            for (int i = 0; i < 8; ++i) { const float a = ba[i] + wa[0][i] * pa[0][i] + wa[1][i] * pa[1][i] + wa[2][i] * ca[i], g = bgv[i] + wg[0][i] * pg[0][i] + wg[1][i] * pg[1][i] + wg[2][i] * cgv[i];
                o[i] = silu_fast(a) * g; pa[0][i] = pa[1][i]; pa[1][i] = ca[i]; pg[0][i] = pg[1][i]; pg[1][i] = cgv[i]; }
            u32x4 ov; ov[0] = pk2(o[0], o[1]); ov[1] = pk2(o[2], o[3]); ov[2] = pk2(o[4], o[5]); ov[3] = pk2(o[6], o[7]);
            *(u32x4*)(act + (size_t)r * 2816 + j0) = ov;
            float* so = nullptr;
            if (r < NPR) { const int l = r & 4095; if (l >= 4094) so = P.out + O_PFFC + ((size_t)((layer * 4 + (r >> 12)) * 2 + (l - 4094))) * 5632; }
            else { const int l = (r - NPR) & 3; if (l >= 2) so = P.out + O_SFFC + ((size_t)((layer * 128 + ((r - NPR) >> 2)) * 2 + (l - 2))) * 5632; }
            if (so) {
#pragma unroll
                for (int i = 0; i < 8; ++i) { so[j0 + i] = ca[i]; so[2816 + j0 + i] = cgv[i]; } }
        } }
}
__device__ __forceinline__ void phase_ffn_act(const Params& P, int layer) {
    constexpr int NU_P = 2048 * 352, NU_S = 128 * 352;
    for (int u = blockIdx.x * 512 + otid(); u < NU_P + NU_S; u += gridDim.x * 512) {
        if (u < NU_P) { const int rb = u / 352, oc = u - rb * 352; ffn_act_unit<8>(P, layer, rb * 8, oc); }
        else { const int v = u - NU_P, sq = v / 352, oc = v - sq * 352; ffn_act_unit<4>(P, layer, NPR + sq * 4, oc); }
    }
}

__device__ __forceinline__ void sgemm_partial(const bf16_t* A, int lda, const bf16_t* Bt, int ldb, int K, int row0, int col0, float* red, int tid) {
    const int w = tid >> 6, lane = tid & 63, fr = lane & 15, fq = lane >> 4;
    const int kw = K >> 3, k0 = w * kw;
    f32x4 acc[2][4];
#pragma unroll
    for (int mt = 0; mt < 2; ++mt)
#pragma unroll
        for (int nt = 0; nt < 4; ++nt) acc[mt][nt] = (f32x4){0.f, 0.f, 0.f, 0.f};
    const bf16_t* ap = A + (size_t)(row0 + fr) * lda + k0 + fq * 8;
    const bf16_t* bp = Bt + (size_t)(col0 + fr) * ldb + k0 + fq * 8;
    const int nks = kw >> 5;
#pragma unroll 4
    for (int ks = 0; ks < nks; ++ks) { bf16x8 a[2], b[4];
#pragma unroll
        for (int mt = 0; mt < 2; ++mt) a[mt] = *(const bf16x8*)(ap + (size_t)mt * 16 * lda + ks * 32);
#pragma unroll
        for (int nt = 0; nt < 4; ++nt) b[nt] = *(const bf16x8*)(bp + (size_t)nt * 16 * ldb + ks * 32);
#pragma unroll
        for (int mt = 0; mt < 2; ++mt)
#pragma unroll
            for (int nt = 0; nt < 4; ++nt) acc[mt][nt] = __builtin_amdgcn_mfma_f32_16x16x32_bf16(a[mt], b[nt], acc[mt][nt], 0, 0, 0); }
#pragma unroll
    for (int mt = 0; mt < 2; ++mt)
#pragma unroll
        for (int nt = 0; nt < 4; ++nt)
#pragma unroll
            for (int j = 0; j < 4; ++j) red[(w * 32 + mt * 16 + fq * 4 + j) * 64 + nt * 16 + fr] = acc[mt][nt][j];
}
__device__ __forceinline__ f32x4 sgemm_reduce(const float* red, int tid) {
    const int row = tid >> 4, c4 = (tid & 15) * 4; f32x4 sacc = (f32x4){0.f, 0.f, 0.f, 0.f};
#pragma unroll
    for (int w = 0; w < 8; ++w) sacc += *(const f32x4*)(red + (w * 32 + row) * 64 + c4);
    return sacc;
}
__device__ __forceinline__ void sg_load4(const bf16_t* ap, int lda, const bf16_t* bp, int ldb, bf16x8 (&a)[4][2], bf16x8 (&b)[4][4]) {
#pragma unroll
    for (int ks = 0; ks < 4; ++ks) {
#pragma unroll
        for (int mt = 0; mt < 2; ++mt) a[ks][mt] = *(const bf16x8*)(ap + (size_t)mt * 16 * lda + ks * 32);
#pragma unroll
        for (int nt = 0; nt < 4; ++nt) b[ks][nt] = *(const bf16x8*)(bp + (size_t)nt * 16 * ldb + ks * 32); }
}
__device__ __forceinline__ void sample_branch(const Params& P, int layer, float* red) {
    const int tid = otid(), w = tid >> 6, lane = tid & 63, fr = lane & 15, fq = lane >> 4;
    const bf16_t* proj = (const bf16_t*)(P.ws + WS_PROJ); bf16_t* hbuf = (bf16_t*)(P.ws + WS_H);
    for (int piece = blockIdx.x; piece < 256; piece += gridDim.x) {
        const int row0 = (piece >> 4) * 32, col0 = (piece & 15) * 64; const size_t r = NPR + row0 + (tid >> 4); const int c = col0 + (tid & 15) * 4;
        const bf16_t* abase = proj + (size_t)(NPR + row0 + fr) * LDP + w * 128 + fq * 8;
        const bf16_t* bbase = (const bf16_t*)(P.ws + WS_WBR) + (size_t)layer * 4 * 1048576 + (size_t)(col0 + fr) * 1024 + w * 128 + fq * 8;
        bf16x8 a[4][2], b[4][4];
        sg_load4(abase + C_Z, LDP, bbase, 1024, a, b);
        f32x4 sum = (f32x4){0.f, 0.f, 0.f, 0.f};
        for (int z = 0; z < 4; ++z) {
            f32x4 acc[2][4];
#pragma unroll
            for (int mt = 0; mt < 2; ++mt)
#pragma unroll
                for (int nt = 0; nt < 4; ++nt) acc[mt][nt] = (f32x4){0.f, 0.f, 0.f, 0.f};
#pragma unroll
            for (int ks = 0; ks < 4; ++ks)
#pragma unroll
                for (int mt = 0; mt < 2; ++mt)
#pragma unroll
                    for (int nt = 0; nt < 4; ++nt) acc[mt][nt] = __builtin_amdgcn_mfma_f32_16x16x32_bf16(a[ks][mt], b[ks][nt], acc[mt][nt], 0, 0, 0);
            if (z < 3) { const int ao = z == 0 ? C_BCX : (z == 1 ? C_Q : C_UV); sg_load4(abase + ao, LDP, bbase + (size_t)(z + 1) * 1048576, 1024, a, b); }
            const u32x2 gv = *(const u32x2*)(proj + r * LDP + C_GATE + z * 1024 + c);
            __syncthreads();
#pragma unroll
            for (int mt = 0; mt < 2; ++mt)
#pragma unroll
                for (int nt = 0; nt < 4; ++nt)
#pragma unroll
                    for (int j = 0; j < 4; ++j) red[(w * 32 + mt * 16 + fq * 4 + j) * 64 + nt * 16 + fr] = acc[mt][nt][j];
            __syncthreads();
            const f32x4 v = sgemm_reduce(red, tid);
            sum[0] += sigmoid_fast(bflo(gv[0])) * v[0]; sum[1] += sigmoid_fast(bfhi(gv[0])) * v[1]; sum[2] += sigmoid_fast(bflo(gv[1])) * v[2]; sum[3] += sigmoid_fast(bfhi(gv[1])) * v[3];
        }
        u32x2 o; o[0] = pk2(sum[0], sum[1]); o[1] = pk2(sum[2], sum[3]); *(u32x2*)(hbuf + r * 1024 + c) = o;
        __syncthreads();
    }
}
__device__ __forceinline__ void sample_resid(const Params& P, const bf16_t* A, int lda, const bf16_t* Bt, int K, const float* xin_s, float* xout, const float* ga, float* red) {
    const int tid = otid();
    for (int piece = blockIdx.x; piece < 256; piece += gridDim.x) {
        const int row0 = (piece >> 4) * 32, col0 = (piece & 15) * 64; const int rs = row0 + (tid >> 4), c = col0 + (tid & 15) * 4;
        const f32x4 xv = *(const f32x4*)(xin_s + (size_t)rs * 1024 + c), gv = *(const f32x4*)(ga + (size_t)(4 + (rs >> 2)) * 6144 + c);
        __syncthreads();
        sgemm_partial(A, lda, Bt, K, K, row0, col0, red, tid);
        __syncthreads();
        const f32x4 v = sgemm_reduce(red, tid);
        *(f32x4*)(xout + (size_t)(NPR + rs) * 1024 + c) = xv + gv * v;
    }
}

__device__ __forceinline__ void grid_bar(unsigned* ctr, unsigned& epoch) {
    asm volatile("s_waitcnt vmcnt(0) lgkmcnt(0)" ::: "memory");
    __syncthreads();
    epoch += 1;
    if (otid() == 0) {
        __builtin_amdgcn_fence(__ATOMIC_RELEASE, "agent");
        asm volatile("s_waitcnt vmcnt(0) lgkmcnt(0)" ::: "memory");
        __hip_atomic_fetch_add(ctr, 1u, __ATOMIC_RELAXED, __HIP_MEMORY_SCOPE_AGENT);
        const unsigned target = epoch * gridDim.x;
        while (__hip_atomic_load(ctr, __ATOMIC_RELAXED, __HIP_MEMORY_SCOPE_AGENT) < target) __builtin_amdgcn_s_sleep(1);
        __builtin_amdgcn_fence(__ATOMIC_ACQUIRE, "agent");
        asm volatile("s_waitcnt vmcnt(0) lgkmcnt(0)" ::: "memory");
    }
    __syncthreads();
}

#ifndef PHMASK
#define PHMASK 0xFFFFFFFF
#endif
#define EN(x) ((PHMASK >> (x)) & 1)
#ifndef DRYM
#define DRYM 0
#endif
#ifndef DBL
#define DBL 0
#endif
#define REP(x) (((DBL >> (x)) & 1) ? 2 : 1)
constexpr int PH_PER_LAYER = 11, N_PHASES = 2 + 4 * PH_PER_LAYER + 1;

__global__ void __launch_bounds__(512, 2) mega_fwd(Params PK) {
    extern __shared__ __attribute__((aligned(16))) unsigned char lds_raw[];
    cg::grid_group grid = cg::this_grid();
    LAS unsigned char* ldsl = (LAS unsigned char*)lds_raw;
    unsigned epoch = 0;
    for (int ph = PK.ph_lo; ph < PK.ph_hi; ++ph) {
        Params P = PK;
        { unsigned char* w_ = P.ws; asm volatile("" : "+s"(w_)); P.ws = w_; float* o_ = P.out; asm volatile("" : "+s"(o_)); P.out = o_; }
        unsigned* barctr = (unsigned*)(P.ws + WS_BAR);
        bf16_t* proj = (bf16_t*)(P.ws + WS_PROJ);
        bf16_t* hbuf = (bf16_t*)(P.ws + WS_H);
        float* xbuf = P.out;
        float* mod = (float*)(P.ws + WS_MOD);
        if (ph == 0) { for (int rp = 0; rp < REP(0); ++rp) phase_convert(P, (float*)lds_raw); }
        else if (ph == 1) {
            Gemm g{(const bf16_t*)(P.ws + WS_CACT), (const bf16_t*)(P.ws + WS_WADA), 1024, 1024, 1024, 1, 96, 0, 0, 0, 0, 0};
            EpiMod E{mod, P.in[11]};
            for (int rp = 0; rp < REP(1); ++rp) gemm_phase<EpiMod, 1>(ldsl, g, E);
        }
        else if (ph == N_PHASES - 1) { phase_final_norm(xbuf, P.in[33]); }
        else {
            const int layer = (ph - 2) / PH_PER_LAYER, sp = (ph - 2) % PH_PER_LAYER;
            const float* modL = mod + (size_t)layer * NCOND * 6144;
            const float* xin_p = layer == 0 ? P.in[0] : xbuf; const float* xin_s = layer == 0 ? P.in[1] : xbuf + (size_t)NPR * 1024;
            if (sp == 0) { for (int rp = 0; rp < REP(16); ++rp) phase_norm(xin_p, xin_s, P.in[12] + layer * 1024, modL, 0, 1024, hbuf); }
            else if (sp == 1) {
                Gemm g{hbuf, (const bf16_t*)(P.ws + WS_WIN) + (size_t)layer * 13568 * 1024, 1024, 1024, 1024, 66, 53, 0, 0, 0, 0, 0};
                EpiProj E{proj};
                for (int rp = 0; rp < REP(2); ++rp) gemm_phase<EpiProj, 1>(ldsl, g, E);
            }
            else if (sp == 2) {
                for (int it = blockIdx.x; it < 3972 + 256; it += gridDim.x) {
                    if (it < 512) { for (int rp = 0; rp < REP(3); ++rp) ssd_pass1_item(P, layer, it, lds_raw); }
                    else if (it < 1024) { for (int rp = (DRYM & 1) ? 0 : 1; rp < 2; ++rp) attn_prompt_item(P, layer, it - 512, lds_raw, rp == 0 && P.ph_lo == 0); }
                    else if (it < 1536) { for (int rp = (DRYM & 2) ? 0 : 1; rp < 2; ++rp) attn_sample_item(P, layer, it - 1024, (float*)lds_raw, rp == 0 && P.ph_lo == 0); }
                    else if (it < 2560) { for (int rp = (DRYM & 4) ? 0 : 1; rp < 2; ++rp) gmlp_prompt_item(P, layer, it - 1536, lds_raw, rp == 0 && P.ph_lo == 0); }
                    else if (it < 2688) { if (EN(8)) gmlp_sample_item(P, layer, it - 2560, (float*)lds_raw); }
                    else if (it < 3840) { for (int rp = (DRYM & 8) ? 0 : 1; rp < 2; ++rp) shortconv_item(P, layer, it - 2688, rp == 0 && P.ph_lo == 0); }
                    else if (it < 3972) ssdconv_state_item(P, layer, it - 3840);
                    else ssd_item<2>(P, layer, it - 3972, (float*)lds_raw);
                }
            }
            else if (sp == 3) { phase_ssd_scan(P, layer); }
            else if (sp == 4) { for (int it = blockIdx.x; it < 512; it += gridDim.x) for (int rp = (DRYM & 16) ? 0 : 1; rp < 2; ++rp) ssd_pass3_item(P, layer, it, lds_raw, rp == 0 && P.ph_lo == 0); }
            else if (sp == 5) {
                Gemm g{proj, (const bf16_t*)(P.ws + WS_WBR) + (size_t)layer * 4 * 1048576, LDP, 1024, 1024, 64, 4, C_Z, C_BCX, C_Q, C_UV, (size_t)1048576};
                EpiBranch E{proj, (float*)(P.ws + WS_MSUM), hbuf};
                for (int rp = 0; rp < REP(11); ++rp) gemm_phase<EpiBranch, 4>(ldsl, g, E);
                for (int rp = 0; rp < REP(17); ++rp) sample_branch(P, layer, (float*)lds_raw);
            }
            else if (sp == 6) {
                Gemm g{hbuf, (const bf16_t*)(P.ws + WS_WO) + (size_t)layer * 1048576, 1024, 1024, 1024, 64, 4, 0, 0, 0, 0, 0};
                EpiResid E{xin_p, xin_s, xbuf, modL + 2048};
                if (EN(12)) gemm_phase<EpiResid, 1>(ldsl, g, E);
                sample_resid(P, hbuf + (size_t)NPR * 1024, 1024, (const bf16_t*)(P.ws + WS_WO) + (size_t)layer * 1048576, 1024, xin_s, xbuf, modL + 2048, (float*)lds_raw);
            }
            else if (sp == 7) { for (int rp = 0; rp < REP(16); ++rp) phase_norm(xbuf, xbuf + (size_t)NPR * 1024, P.in[28] + layer * 1024, modL, 3072, 4096, hbuf); }
            else if (sp == 8) {
                Gemm g{hbuf, (const bf16_t*)(P.ws + WS_WUP) + (size_t)layer * 5632 * 1024, 1024, 1024, 1024, 66, 22, 0, 0, 0, 0, 0};
                EpiUp E{proj};
                for (int rp = 0; rp < REP(13); ++rp) gemm_phase<EpiUp, 1>(ldsl, g, E);
            }
            else if (sp == 9) { for (int rp = 0; rp < REP(14); ++rp) phase_ffn_act(P, layer); }
            else {
                Gemm g{(const bf16_t*)(P.ws + WS_PROJ + UP_BYTES), (const bf16_t*)(P.ws + WS_WDN) + (size_t)layer * 1024 * 2816, 2816, 2816, 2816, 64, 4, 0, 0, 0, 0, 0};
                EpiResid E{xbuf, xbuf + (size_t)NPR * 1024, xbuf, modL + 5120};
                if (EN(15)) gemm_phase<EpiResid, 1>(ldsl, g, E);
                sample_resid(P, (const bf16_t*)(P.ws + WS_PROJ + UP_BYTES) + (size_t)NPR * 2816, 2816, (const bf16_t*)(P.ws + WS_WDN) + (size_t)layer * 1024 * 2816, 2816, xbuf + (size_t)NPR * 1024, xbuf, modL + 5120, (float*)lds_raw);
            }
        }
        if (ph + 1 < P.ph_hi) { if (ph == 0) grid.sync(); else grid_bar(barctr, epoch); }
    }
}

extern "C" void kernel_launch(void* const* d_in, const int* in_sizes, int n_in, void* d_out, int out_size, void* d_ws, size_t ws_size, hipStream_t stream) {
    static int grid_blocks = 0;
    if (grid_blocks == 0) {
        if (n_in != 34 || (size_t)out_size != O_END || ws_size < WS_END + 256) { fprintf(stderr, "kernel_launch: unexpected sizes n_in %d out %d ws %zu (need %zu)\n", n_in, out_size, ws_size, (size_t)WS_END); grid_blocks = -1; return; }
        int dev = 0, cus = 0, per_cu = 0;
        (void)hipGetDevice(&dev); (void)hipDeviceGetAttribute(&cus, hipDeviceAttributeMultiprocessorCount, dev);
        if (hipFuncSetAttribute((const void*)mega_fwd, hipFuncAttributeMaxDynamicSharedMemorySize, LDS_BYTES) != hipSuccess) { fprintf(stderr, "hipFuncSetAttribute failed\n"); grid_blocks = -1; return; }
        if (hipOccupancyMaxActiveBlocksPerMultiprocessor(&per_cu, (const void*)mega_fwd, 512, LDS_BYTES) != hipSuccess || per_cu < 1) per_cu = 1;
        grid_blocks = cus * 1;
    }
    if (grid_blocks < 0) return;
    Params p{};
    for (int i = 0; i < 34; ++i) p.in[i] = (const float*)d_in[i];
    p.out = (float*)d_out; p.ws = (unsigned char*)d_ws; p.ph_lo = 0; p.ph_hi = N_PHASES;
    (void)hipMemsetAsync((unsigned char*)d_ws + WS_BAR, 0, 256, stream);
    void* args[] = {&p};
    hipError_t e = hipLaunchCooperativeKernel((const void*)mega_fwd, dim3(grid_blocks), dim3(512), args, LDS_BYTES, stream);
    if (e != hipSuccess) fprintf(stderr, "cooperative launch failed: %s (grid %d)\n", hipGetErrorString(e), grid_blocks);
}
```
